# Optimizing an MI355X kernel written in HIP

```python
import math
import jax, jax.numpy as jnp
from jax import lax
import numpy as np

D_MODEL = 1024
BATCH = 8
SEQ = 4096
DEPTH = 2

MIX_W = D_MODEL
N_MIXERS = 4
GROUP_W = MIX_W // N_MIXERS
NORM_EPS = 1e-6

A_HEADS = 4
A_HEAD_DIM = GROUP_W // A_HEADS
DILATED_PATTERNS = ((128, 1), (512, 4), (2048, 16))
N_BUCKETS = 32
REL_MAX_DIST = 2048

CONV_WIDTH = 31
CONV_GROUPS = 4
CONV_LN_EPS = 1e-5

RWKV_HEADS = 4
RWKV_HEAD_DIM = GROUP_W // RWKV_HEADS
RWKV_DECAY_LORA = 32
RWKV_AAA_LORA = 32
RWKV_GATE_LORA = 64
RWKV_LN_EPS = 64e-5

GLA_HEADS = 4
GLA_KEY_DIM = GROUP_W // 2 // GLA_HEADS
GLA_VAL_DIM = GROUP_W // GLA_HEADS
GLA_GATE_LORA = 16
GLA_TAU = 16.0
GLA_CHUNK = 64

D_FF = 2816
N_EXPERTS = 8
TOP_K = 2
MOE_BLOCK = 256
N_DENSE = (DEPTH + 1) // 2
N_MOE = DEPTH // 2

SPLIT_A = (GROUP_W, GROUP_W, GROUP_W)
SPLIT_B = (GROUP_W, GROUP_W)
SPLIT_C = (GROUP_W, GROUP_W, GROUP_W, RWKV_DECAY_LORA, RWKV_AAA_LORA, RWKV_GATE_LORA)
SPLIT_D = (GLA_HEADS * GLA_KEY_DIM, GLA_HEADS * GLA_KEY_DIM, GROUP_W, GLA_GATE_LORA, GROUP_W)
SEGMENTS = (sum(SPLIT_A), sum(SPLIT_B), sum(SPLIT_C), sum(SPLIT_D))
C_IN_W = sum(SPLIT_C)
IN_W = sum(SEGMENTS)

kernel_name = 'hybrid_dilated_conv_rwkv7_gla_moe'


def _split(z, sizes):
    return jnp.split(z, np.cumsum(sizes)[:-1].tolist(), axis=-1)


def _rms_norm(x, g, eps=NORM_EPS):
    xf = x.astype(jnp.float32)
    return xf * lax.rsqrt(jnp.mean(xf * xf, axis=-1, keepdims=True) + eps) * g.astype(jnp.float32)


def _layer_norm(x, eps):
    mu = jnp.mean(x, axis=-1, keepdims=True)
    xc = x - mu
    return xc * lax.rsqrt(jnp.mean(xc * xc, axis=-1, keepdims=True) + eps)


def _t5_bucket(dist):
    max_exact = N_BUCKETS // 2
    n = np.maximum(dist, 0)
    large = max_exact + (np.log(np.maximum(n, 1) / max_exact) / math.log(REL_MAX_DIST / max_exact)
                         * (N_BUCKETS - max_exact)).astype(np.int32)
    large = np.minimum(large, N_BUCKETS - 1)
    return np.where(n < max_exact, n, large).astype(np.int32)


def _dilated_branch(q, k, v, rel_bias, window, dilation):
    B, S, H, E = q.shape
    W = window // dilation
    L = S // dilation
    nb = -(-L // W)
    Lp = nb * W

    def to_blocks(z):
        z = z.reshape(B, L, dilation, H, E).transpose(0, 2, 3, 1, 4)
        z = jnp.pad(z, ((0, 0), (0, 0), (0, 0), (0, Lp - L), (0, 0)))
        return z.reshape(B, dilation, H, nb, W, E)

    def with_prev(z):
        prev = jnp.pad(z[:, :, :, :-1], ((0, 0), (0, 0), (0, 0), (1, 0), (0, 0), (0, 0)))
        return jnp.concatenate([prev, z], axis=4)

    qb = to_blocks(q)
    kb = with_prev(to_blocks(k))
    vb = with_prev(to_blocks(v))
    s = jnp.einsum('bdhnqe,bdhnke->bdhnqk', qb, kb)

    delta = np.arange(W)[:, None] + W - np.arange(2 * W)[None, :]
    band = (delta >= 0) & (delta <= W)
    bucket = _t5_bucket(np.clip(delta, 0, W) * dilation)
    bias = jnp.transpose(rel_bias.astype(jnp.float32)[bucket], (2, 0, 1))
    key_ok = ~((np.arange(nb)[:, None] == 0) & (np.arange(2 * W)[None, :] < W))
    mask = band[None] & key_ok[:, None, :]

    s = jnp.where(mask, s + bias[:, None], -jnp.inf)
    m = jnp.max(s, axis=-1, keepdims=True)
    p = jnp.exp(s - m)
    den = jnp.sum(p, axis=-1, keepdims=True)
    o = jnp.einsum('bdhnqk,bdhnke->bdhnqe', p, vb) / den
    lse = (m + jnp.log(den))[..., 0]
    o = o.reshape(B, dilation, H, Lp, E)[:, :, :, :L].transpose(0, 3, 1, 2, 4).reshape(B, S, H, E)
    lse = lse.reshape(B, dilation, H, Lp)[:, :, :, :L].transpose(0, 3, 1, 2).reshape(B, S, H)
    return o, lse


def _mixer_dilated(za, q_g, k_g, rel_bias):
    B, S, _ = za.shape
    qa, ka, va = _split(za, SPLIT_A)
    shp = (B, S, A_HEADS, A_HEAD_DIM)
    q = _rms_norm(qa.reshape(shp), q_g) * (A_HEAD_DIM ** -0.5)
    k = _rms_norm(ka.reshape(shp), k_g)
    v = va.reshape(shp).astype(jnp.float32)
    outs, lses = [], []
    for window, dilation in DILATED_PATTERNS:
        o, lse = _dilated_branch(q, k, v, rel_bias, window, dilation)
        outs.append(o)
        lses.append(lse)
    wts = jax.nn.softmax(jnp.stack(lses, 0), axis=0)
    o = jnp.sum(wts[..., None] * jnp.stack(outs, 0), axis=0)
    return o.reshape(B, S, GROUP_W)


def _mixer_conv(zb, conv_w, conv_b, ln_g, ln_b):
    B, S, _ = zb.shape
    u, gate = _split(zb.astype(jnp.float32), SPLIT_B)
    h = u * jax.nn.sigmoid(gate)
    h = lax.conv_general_dilated(h, conv_w.astype(jnp.float32)[:, None, :], window_strides=(1,),
                                 padding=[(CONV_WIDTH - 1, 0)], dimension_numbers=('NWC', 'WIO', 'NWC'),
                                 feature_group_count=GROUP_W) + conv_b.astype(jnp.float32)
    h = _layer_norm(h.reshape(B, S, CONV_GROUPS, GROUP_W // CONV_GROUPS), CONV_LN_EPS).reshape(B, S, GROUP_W)
    h = h * ln_g.astype(jnp.float32) + ln_b.astype(jnp.float32)
    return jax.nn.silu(h)


def _mixer_rwkv7(zc, mu, w0, w2, a0, a2, g2, k_k, k_a, r_k, ln_g, ln_b):
    B, S, _ = zc.shape
    f32 = jnp.float32
    zc = zc.astype(f32)
    prev = jnp.pad(zc[:, :-1], ((0, 0), (1, 0), (0, 0)))
    zc = zc + (prev - zc) * mu.astype(f32)
    r, k, v, wd, ad, gd = _split(zc, SPLIT_C)
    w_log = -jax.nn.softplus(-(w0.astype(f32) + jnp.tanh(wd) @ w2.astype(f32))) - 0.5
    decay = jnp.exp(-jnp.exp(w_log))
    a = jax.nn.sigmoid(a0.astype(f32) + ad @ a2.astype(f32))
    g = jax.nn.sigmoid(gd) @ g2.astype(f32)

    def heads(t):
        return t.reshape(B, S, RWKV_HEADS, RWKV_HEAD_DIM)

    kk = heads(k * k_k.astype(f32))
    kk = kk / jnp.maximum(jnp.linalg.norm(kk, axis=-1, keepdims=True), 1e-12)
    k = heads(k * (1.0 + (a - 1.0) * k_a.astype(f32)))
    r, v, decay, a = heads(r), heads(v), heads(decay), heads(a)

    def step(state, inp):
        r_t, w_t, k_t, v_t, kk_t, a_t = inp
        sa = jnp.einsum('bhvk,bhk->bhv', state, -kk_t)
        state = (state * w_t[:, :, None, :] + sa[..., None] * (kk_t * a_t)[:, :, None, :]
                 + v_t[..., None] * k_t[:, :, None, :])
        return state, jnp.einsum('bhvk,bhk->bhv', state, r_t)

    xs = tuple(jnp.moveaxis(t, 1, 0) for t in (r, decay, k, v, kk, a))
    s0 = jnp.zeros((B, RWKV_HEADS, RWKV_HEAD_DIM, RWKV_HEAD_DIM), f32)
    _, out = lax.scan(step, s0, xs)
    out = jnp.moveaxis(out, 0, 1)
    out = _layer_norm(out, RWKV_LN_EPS).reshape(B, S, GROUP_W) * ln_g.astype(f32) + ln_b.astype(f32)
    bonus = jnp.sum(r * k * r_k.astype(f32), axis=-1, keepdims=True) * v
    out = out + bonus.reshape(B, S, GROUP_W)
    return out * g


def _gla_chunked(q, k, v, gk):
    B, S, H, K = q.shape
    V = v.shape[-1]
    n = S // GLA_CHUNK

    def chunks(z):
        return z.reshape(B, n, GLA_CHUNK, H, z.shape[-1]).transpose(0, 3, 1, 2, 4)

    q, k, v, gk = chunks(q), chunks(k), chunks(v), chunks(gk)
    b = jnp.cumsum(gk, axis=3)
    q_d = q * jnp.exp(b)
    k_d = k * jnp.exp(-b)
    causal = np.tril(np.ones((GLA_CHUNK, GLA_CHUNK), dtype=bool))
    att = jnp.where(causal, jnp.einsum('bhncd,bhnjd->bhncj', q_d, k_d), 0.0)
    o = jnp.einsum('bhncj,bhnje->bhnce', att, v)
    b_last = b[:, :, :, -1:]
    contrib = jnp.einsum('bhncd,bhnce->bhnde', k * jnp.exp(b_last - b), v)
    chunk_decay = jnp.exp(b_last[:, :, :, 0])

    def step(state, inp):
        dec, con = inp
        return dec[..., None] * state + con, state

    _, s_prev = lax.scan(step, jnp.zeros((B, H, K, V), jnp.float32),
                         (jnp.moveaxis(chunk_decay, 2, 0), jnp.moveaxis(contrib, 2, 0)))
    s_prev = jnp.moveaxis(s_prev, 0, 2)
    o = o + jnp.einsum('bhncd,bhnde->bhnce', q_d, s_prev)
    return o.transpose(0, 2, 3, 1, 4).reshape(B, S, H, V)


def _mixer_gla(zd, g2, gb, norm_g):
    B, S, _ = zd.shape
    f32 = jnp.float32
    qd, kd, vd, gd, og = _split(zd.astype(f32), SPLIT_D)
    q = qd.reshape(B, S, GLA_HEADS, GLA_KEY_DIM) * (GLA_KEY_DIM ** -0.5)
    k = kd.reshape(B, S, GLA_HEADS, GLA_KEY_DIM)
    v = vd.reshape(B, S, GLA_HEADS, GLA_VAL_DIM)
    gk = jax.nn.log_sigmoid(gd @ g2.astype(f32) + gb.astype(f32)) / GLA_TAU
    o = _gla_chunked(q, k, v, gk.reshape(B, S, GLA_HEADS, GLA_KEY_DIM))
    o = _rms_norm(o, norm_g) * jax.nn.silu(og.reshape(B, S, GLA_HEADS, GLA_VAL_DIM))
    return o.reshape(B, S, GROUP_W)


def _swiglu(x, wg, wu, wd):
    return (jax.nn.silu(x @ wg) * (x @ wu)) @ wd


def _moe(xn, router, wg, wu, wd):
    B, S, D = xn.shape
    T = B * S
    xt = xn.reshape(T, D)
    logits = (xt @ router).astype(jnp.float32)
    top_logits, top_idx = lax.top_k(logits, TOP_K)
    gates = jax.nn.softmax(top_logits, axis=-1)
    n_assign = T * TOP_K
    exp_id = top_idx.reshape(-1).astype(jnp.int32)
    tok_id = jnp.repeat(jnp.arange(T, dtype=jnp.int32), TOP_K)
    order = jnp.argsort(exp_id)
    e_sorted, t_sorted, g_sorted = exp_id[order], tok_id[order], gates.reshape(-1)[order]
    counts = jax.ops.segment_sum(jnp.ones_like(exp_id), exp_id, num_segments=N_EXPERTS)
    starts = jnp.cumsum(counts) - counts
    padded = (counts + MOE_BLOCK - 1) // MOE_BLOCK * MOE_BLOCK
    pends = jnp.cumsum(padded)
    pstarts = pends - padded
    dest = pstarts[e_sorted] + jnp.arange(n_assign, dtype=jnp.int32) - starts[e_sorted]
    n_blocks = -(-n_assign // MOE_BLOCK) + N_EXPERTS
    buf = jnp.zeros((n_blocks * MOE_BLOCK, D), xt.dtype).at[dest].set(xt[t_sorted])
    block_expert = jnp.minimum(jnp.searchsorted(pends, jnp.arange(n_blocks) * MOE_BLOCK, side='right'),
                               N_EXPERTS - 1)

    def run_block(args):
        xb, e = args
        return _swiglu(xb, wg[e], wu[e], wd[e])

    yb = lax.map(run_block, (buf.reshape(n_blocks, MOE_BLOCK, D), block_expert))
    y_sorted = yb.reshape(-1, D)[dest].astype(jnp.float32) * g_sorted[:, None]
    y = jnp.zeros((T, D), jnp.float32).at[t_sorted].add(y_sorted)
    return y.reshape(B, S, D)


def setup_inputs(seed: int = 0) -> dict:
    key = jax.random.key(seed)
    ks = iter(jax.random.split(key, 40))
    f32 = jnp.float32

    def nrm(shape, scale):
        return scale * jax.random.normal(next(ks), shape, f32)

    def gain(shape):
        return 1.0 + nrm(shape, 0.1)

    def unif(shape, lo, hi):
        return jax.random.uniform(next(ks), shape, f32, lo, hi)

    return {
        'x': nrm((BATCH, SEQ, D_MODEL), 1.0),
        'rel_bias': nrm((N_BUCKETS, A_HEADS), 0.5),
        'mix_norm_g': gain((DEPTH, D_MODEL)),
        'w_in': nrm((DEPTH, D_MODEL, IN_W), D_MODEL ** -0.5),
        'w_out': nrm((DEPTH, MIX_W, D_MODEL), MIX_W ** -0.5),
        'ffn_norm_g': gain((DEPTH, D_MODEL)),
        'attn_q_norm_g': gain((DEPTH, A_HEAD_DIM)),
        'attn_k_norm_g': gain((DEPTH, A_HEAD_DIM)),
        'conv_w': nrm((DEPTH, CONV_WIDTH, GROUP_W), CONV_WIDTH ** -0.5),
        'conv_b': nrm((DEPTH, GROUP_W), 0.02),
        'conv_ln_g': gain((DEPTH, GROUP_W)),
        'conv_ln_b': nrm((DEPTH, GROUP_W), 0.02),
        'rwkv_mu': unif((DEPTH, C_IN_W), 0.0, 1.0),
        'rwkv_w0': unif((DEPTH, GROUP_W), -5.0, 1.0),
        'rwkv_w2': nrm((DEPTH, RWKV_DECAY_LORA, GROUP_W), 0.1),
        'rwkv_a0': nrm((DEPTH, GROUP_W), 0.5),
        'rwkv_a2': nrm((DEPTH, RWKV_AAA_LORA, GROUP_W), 0.5 * RWKV_AAA_LORA ** -0.5),
        'rwkv_g2': nrm((DEPTH, RWKV_GATE_LORA, GROUP_W), RWKV_GATE_LORA ** -0.5),
        'rwkv_k_k': 0.85 + nrm((DEPTH, GROUP_W), 0.1),
        'rwkv_k_a': gain((DEPTH, GROUP_W)),
        'rwkv_r_k': nrm((DEPTH, RWKV_HEADS, RWKV_HEAD_DIM), 0.1),
        'rwkv_ln_g': gain((DEPTH, GROUP_W)),
        'rwkv_ln_b': nrm((DEPTH, GROUP_W), 0.02),
        'gla_g2': nrm((DEPTH, GLA_GATE_LORA, GLA_HEADS * GLA_KEY_DIM), GLA_GATE_LORA ** -0.5),
        'gla_gb': nrm((DEPTH, GLA_HEADS * GLA_KEY_DIM), 0.5),
        'gla_norm_g': gain((DEPTH, GLA_VAL_DIM)),
        'ffn_wg': nrm((N_DENSE, D_MODEL, D_FF), D_MODEL ** -0.5),
        'ffn_wu': nrm((N_DENSE, D_MODEL, D_FF), D_MODEL ** -0.5),
        'ffn_wd': nrm((N_DENSE, D_FF, D_MODEL), D_FF ** -0.5),
        'moe_router': nrm((N_MOE, D_MODEL, N_EXPERTS), D_MODEL ** -0.5),
        'moe_wg': nrm((N_MOE, N_EXPERTS, D_MODEL, D_FF), D_MODEL ** -0.5),
        'moe_wu': nrm((N_MOE, N_EXPERTS, D_MODEL, D_FF), D_MODEL ** -0.5),
        'moe_wd': nrm((N_MOE, N_EXPERTS, D_FF, D_MODEL), D_FF ** -0.5),
    }


def reference(x, rel_bias, mix_norm_g, w_in, w_out, ffn_norm_g, attn_q_norm_g, attn_k_norm_g,
              conv_w, conv_b, conv_ln_g, conv_ln_b, rwkv_mu, rwkv_w0, rwkv_w2, rwkv_a0, rwkv_a2,
              rwkv_g2, rwkv_k_k, rwkv_k_a, rwkv_r_k, rwkv_ln_g, rwkv_ln_b, gla_g2, gla_gb, gla_norm_g,
              ffn_wg, ffn_wu, ffn_wd, moe_router, moe_wg, moe_wu, moe_wd):
    h = x
    for layer in range(DEPTH):
        xn = _rms_norm(h, mix_norm_g[layer]).astype(h.dtype)
        z = xn @ w_in[layer]
        za, zb, zc, zd = _split(z, SEGMENTS)
        ya = _mixer_dilated(za, attn_q_norm_g[layer], attn_k_norm_g[layer], rel_bias)
        yb = _mixer_conv(zb, conv_w[layer], conv_b[layer], conv_ln_g[layer], conv_ln_b[layer])
        yc = _mixer_rwkv7(zc, rwkv_mu[layer], rwkv_w0[layer], rwkv_w2[layer], rwkv_a0[layer], rwkv_a2[layer],
                          rwkv_g2[layer], rwkv_k_k[layer], rwkv_k_a[layer], rwkv_r_k[layer],
                          rwkv_ln_g[layer], rwkv_ln_b[layer])
        yd = _mixer_gla(zd, gla_g2[layer], gla_gb[layer], gla_norm_g[layer])
        y = jnp.concatenate([ya, yb, yc, yd], axis=-1).astype(h.dtype)
        h = h + (y @ w_out[layer]).astype(h.dtype)
        hn = _rms_norm(h, ffn_norm_g[layer]).astype(h.dtype)
        i = layer // 2
        if layer % 2 == 0:
            f = _swiglu(hn, ffn_wg[i], ffn_wu[i], ffn_wd[i])
        else:
            f = _moe(hn, moe_router[i], moe_wg[i], moe_wu[i], moe_wd[i])
        h = h + f.astype(h.dtype)
    return h
```

```cpp
#include <hip/hip_runtime.h>
#include <cstdio>
#include <cstdint>

#define LAS __attribute__((address_space(3)))
#define GAS __attribute__((address_space(1)))
typedef unsigned short bf16;
typedef short bf16x8 __attribute__((ext_vector_type(8)));
typedef short s16x4 __attribute__((ext_vector_type(4)));
typedef float f32x4 __attribute__((ext_vector_type(4)));
typedef float f32x2 __attribute__((ext_vector_type(2)));
typedef unsigned u32x4 __attribute__((ext_vector_type(4)));
typedef unsigned u32x2 __attribute__((ext_vector_type(2)));

constexpr int DM = 1024, NB = 8, SEQ = 4096, NTOK = NB * SEQ, INW = 2960, NPADW = 3072, DFF = 2816, NEXP = 8;
constexpr int ZA = 0, ZB = 768, ZC = 1280, ZD = 2176;
constexpr float NORM_EPS = 1e-6f;
constexpr int MOE_ROWS = NTOK + NEXP * 256;

constexpr size_t MiB = 1u << 20;
constexpr size_t WS_CTL = 0, CTL_ZERO_BYTES = 64 * 1024;
constexpr size_t WS_WIN = 1 * MiB;
constexpr size_t WS_WOUT = 13 * MiB;
constexpr size_t WS_WGU = 17 * MiB;
constexpr size_t WS_WD = 28 * MiB;
constexpr size_t WS_SSQ = 34 * MiB;
constexpr size_t WS_RT = 36 * MiB;
constexpr size_t WS_HB = 40 * MiB;
constexpr size_t WS_Z = 104 * MiB;
constexpr size_t WS_Y = 297 * MiB;
constexpr size_t WS_MOEW = 367 * MiB;
constexpr size_t WS_END = 499 * MiB;
constexpr size_t MOEW_GU_BYTES = (size_t)2 * DFF * DM * 2, MOEW_D_BYTES = (size_t)DM * DFF * 2, MOEW_E_BYTES = MOEW_GU_BYTES + MOEW_D_BYTES;
static_assert(WS_Z + (size_t)MOE_ROWS * DFF * 2 <= WS_Y && WS_Y + (size_t)MOE_ROWS * DM * 2 <= WS_MOEW && WS_MOEW + NEXP * MOEW_E_BYTES <= WS_END, "ws map");
constexpr size_t WS_OP = WS_HB;
constexpr size_t WS_LSE = WS_HB + 48 * MiB;
constexpr size_t RT_TOPE = 0;
constexpr size_t RT_GATE = RT_TOPE + (size_t)NTOK * 8;
constexpr size_t RT_RANK = RT_GATE + (size_t)NTOK * 8;
constexpr size_t RT_RSTD = RT_RANK + (size_t)NTOK * 8;
constexpr size_t RT_HIST = RT_RSTD + (size_t)NTOK * 4;
constexpr size_t RT_ROWTOK = RT_HIST + 256 * 16 * 4;
constexpr size_t RT_ROWGATE = RT_ROWTOK + (size_t)2 * MOE_ROWS * 4;
constexpr size_t RT_ROWRSTD = RT_ROWGATE + (size_t)2 * MOE_ROWS * 4;
constexpr size_t RT_TILEE = RT_ROWRSTD + (size_t)2 * MOE_ROWS * 4;
constexpr size_t RT_NTILES = RT_TILEE + 2 * 256 * 4;
static_assert(RT_NTILES + 64 <= 4 * MiB, "routing arrays");

constexpr int CW_BAR = 1024;

constexpr int RING_BYTES = 131072, LDSCTL_OFF = RING_BYTES, MISC_OFF = LDSCTL_OFF + 320, LDS_BYTES = 147456;
constexpr int NWAVES = 8, NTHREADS = 512;

#define LDS_WAIT() asm volatile("s_waitcnt lgkmcnt(0)" ::: "memory")
#define VM_WAIT() asm volatile("s_waitcnt vmcnt(0)" ::: "memory")
__device__ __forceinline__ unsigned f2bf(float f) { unsigned u = __builtin_bit_cast(unsigned, f); return (u + 0x7fffu + ((u >> 16) & 1u)) >> 16; }
__device__ __forceinline__ unsigned pk2(float lo, float hi) { return f2bf(lo) | (f2bf(hi) << 16); }
__device__ __forceinline__ float bflo(unsigned w) { return __builtin_bit_cast(float, w << 16); }
__device__ __forceinline__ float bfhi(unsigned w) { return __builtin_bit_cast(float, w & 0xffff0000u); }
__device__ __forceinline__ float bf1(bf16 b) { return __builtin_bit_cast(float, (unsigned)b << 16); }
__device__ __forceinline__ float wave_sum(float v) {
#pragma unroll
    for (int o = 1; o < 64; o <<= 1) v += __shfl_xor(v, o);
    return v;
}
__device__ __forceinline__ float red16(float v) { v += __shfl_xor(v, 1); v += __shfl_xor(v, 2); v += __shfl_xor(v, 4); v += __shfl_xor(v, 8); return v; }
__device__ __forceinline__ float red8(float v) { v += __shfl_xor(v, 1); v += __shfl_xor(v, 2); v += __shfl_xor(v, 4); return v; }
__device__ __forceinline__ float sigmoidf_(float x) { return 1.0f / (1.0f + __expf(-x)); }
__device__ __forceinline__ float siluf_(float x) { return x / (1.0f + __expf(-x)); }
__device__ __forceinline__ float softplusf_(float x) { return fmaxf(x, 0.f) + log1pf(__expf(-fabsf(x))); }
__device__ __forceinline__ void unpack8(const u32x4 w, float (&f)[8]) {
    f[0] = bflo(w.x); f[1] = bfhi(w.x); f[2] = bflo(w.y); f[3] = bfhi(w.y); f[4] = bflo(w.z); f[5] = bfhi(w.z); f[6] = bflo(w.w); f[7] = bfhi(w.w);
}

namespace pg8 {
#define PG8_LAS __attribute__((address_space(3)))
typedef unsigned short bf16_t;
constexpr int BM = 256, BK = 64, HALF = 128, HTB = HALF * BK * 2  , STAGE_BYTES = 8 * HTB, NXCD = 8, WGM = 8;

__host__ __device__ __forceinline__ int lds_byte(int r, int c) { const int st = (r >> 4) * 2 + (c >> 5), rr = r & 15, cc = c & 31, ob = rr * 64 + cc * 2; return st * 1024 + (ob ^ (((ob >> 9) & 1) << 5)); }
__host__ __device__ __forceinline__ void stage_rc(int b, int& R, int& C) { const int st = b / 1024, sb = b % 1024, swz = sb ^ (((sb >> 9) & 1) << 5); R = (st >> 1) * 16 + swz / 64; C = (st & 1) * 32 + (swz % 64) / 2; }
__host__ __device__ __forceinline__ int perm32(int rho) { const int n = rho >> 4, i = rho & 15; return 8 * (i >> 2) + 4 * n + (i & 3); }

struct Unit { int pm, pn; };
struct Gemm { const bf16_t* A; const bf16_t* Bt; int M, N, K; };

struct StaticOrder {
    int nM, nN, nwg, G, c; const int* tile_e; size_t estride;
    __device__ void init(int nM_, int nN_, int G_, int c_, const int* te = nullptr, size_t es = 0) { nM = nM_; nN = nN_; nwg = nM * nN; G = G_; c = c_; tile_e = te; estride = es; }
    __device__ bool next(int i, Unit& u) const {
        const long L = (long)i * G + c; if (L >= nwg) return false;
        int wgid = (int)L; { const int q = nwg / NXCD, r = nwg % NXCD, xcd = wgid % NXCD, off = wgid / NXCD; wgid = (xcd < r ? xcd * (q + 1) : r * (q + 1) + (xcd - r) * q) + off; }
        const int nig = WGM * nN, gid = wgid / nig, fm = gid * WGM, gsz = (nM - fm) < WGM ? (nM - fm) : WGM;
        u.pm = fm + ((wgid % nig) % gsz); u.pn = (wgid % nig) / gsz; return true;
    }
    __device__ __forceinline__ size_t bofs(const Unit& u, size_t tstep) const { return (size_t)u.pn * tstep + (tile_e ? (size_t)__builtin_amdgcn_readfirstlane(tile_e[u.pm]) * estride : (size_t)0); }
    __device__ __forceinline__ void a_ready(const Unit&) const {}
    __device__ __forceinline__ void done(const Unit&) const {}
};

__device__ __forceinline__ unsigned cvt_pk_bf16(float lo, float hi) { unsigned r; asm volatile("v_cvt_pk_bf16_f32 %0, %1, %2" : "=v"(r) : "v"(lo), "v"(hi)); return r; }

__device__ __forceinline__ float row_rstd16(const float* ssq, int r, int fq) {
    const f32x4 p = *(const f32x4*)(ssq + (size_t)r * 16 + 4 * fq);
    float s = (p[0] + p[1]) + (p[2] + p[3]); s += __shfl_xor(s, 16); s += __shfl_xor(s, 32);
    return __builtin_amdgcn_rsqf(s * (1.0f / DM) + NORM_EPS);
}

struct EpiZ {
    static constexpr bool PERM = true, AFTER_DRAIN = false;
    bf16_t* Z; int ldc, ncols; const float* ssq;
    __device__ __forceinline__ void operator()(const f32x4 (&acc)[2][2][4][2], const Unit& u, int wr, int wc, int fr, int fq) const {
        const int row0 = u.pm * BM + wr * 64 + fr, col0 = u.pn * BM + wc * 32 + 8 * fq;
#pragma unroll
        for (int ai = 0; ai < 2; ++ai)
#pragma unroll
            for (int m = 0; m < 4; ++m) { const int r = row0 + ai * HALF + m * 16; const float rs = row_rstd16(ssq, r, fq); bf16_t* rowp = Z + (size_t)r * ldc + col0;
#pragma unroll
                for (int bj = 0; bj < 2; ++bj) { const f32x4 v0 = acc[ai][bj][m][0] * rs, v1 = acc[ai][bj][m][1] * rs;
                    u32x4 w; w.x = cvt_pk_bf16(v0[0], v0[1]); w.y = cvt_pk_bf16(v0[2], v0[3]); w.z = cvt_pk_bf16(v1[0], v1[1]); w.w = cvt_pk_bf16(v1[2], v1[3]);
                    if (col0 + bj * HALF < ncols) *(u32x4*)(rowp + bj * HALF) = w; } }
    }
};
template <bool MOE> struct EpiSwiGLU {
    static constexpr bool PERM = true, AFTER_DRAIN = false;
    bf16_t* O; const float* ssq; const float* row_rstd;
    __device__ __forceinline__ void operator()(const f32x4 (&acc)[2][2][4][2], const Unit& u, int wr, int wc, int fr, int fq) const {
        const int row0 = u.pm * BM + wr * 64 + fr, col0 = u.pn * HALF + wc * 32 + 8 * fq;
#pragma unroll
        for (int ai = 0; ai < 2; ++ai)
#pragma unroll
            for (int m = 0; m < 4; ++m) { const int r = row0 + ai * HALF + m * 16; float rs; if (MOE) rs = row_rstd[r]; else rs = row_rstd16(ssq, r, fq);
                const f32x4 g0 = acc[ai][0][m][0] * rs, g1 = acc[ai][0][m][1] * rs, u0 = acc[ai][1][m][0] * rs, u1 = acc[ai][1][m][1] * rs; f32x4 a0, a1;
#pragma unroll
                for (int j = 0; j < 4; ++j) { a0[j] = g0[j] * __builtin_amdgcn_rcpf(1.0f + __expf(-g0[j])) * u0[j]; a1[j] = g1[j] * __builtin_amdgcn_rcpf(1.0f + __expf(-g1[j])) * u1[j]; }
                u32x4 w; w.x = cvt_pk_bf16(a0[0], a0[1]); w.y = cvt_pk_bf16(a0[2], a0[3]); w.z = cvt_pk_bf16(a1[0], a1[1]); w.w = cvt_pk_bf16(a1[2], a1[3]);
                *(u32x4*)(O + (size_t)r * DFF + col0) = w; }
    }
};
struct EpiRes {
    static constexpr bool PERM = false, AFTER_DRAIN = false;
    const float* base; float* out; bf16_t* hb; float* ssq;
    __device__ __forceinline__ void operator()(const f32x4 (&acc)[2][2][4][2], const Unit& u, int wr, int wc, int fr, int fq) const {
        const int col0 = u.pn * BM + wc * 32 + 4 * fq;
#pragma unroll
        for (int ai = 0; ai < 2; ++ai)
#pragma unroll
            for (int m = 0; m < 4; ++m) { const int r = u.pm * BM + ai * HALF + wr * 64 + m * 16 + fr; const size_t off = (size_t)r * DM + col0; float ss = 0.f;
#pragma unroll
                for (int bj = 0; bj < 2; ++bj)
#pragma unroll
                    for (int n = 0; n < 2; ++n) { const f32x4 v = *(const f32x4*)(base + off + bj * HALF + n * 16) + acc[ai][bj][m][n];
                        *(f32x4*)(out + off + bj * HALF + n * 16) = v; ss += (v[0] * v[0] + v[1] * v[1]) + (v[2] * v[2] + v[3] * v[3]);
                        if (hb) { u32x2 w; w.x = cvt_pk_bf16(v[0], v[1]); w.y = cvt_pk_bf16(v[2], v[3]); *(u32x2*)(hb + off + bj * HALF + n * 16) = w; } }
                ss += __shfl_xor(ss, 16); ss += __shfl_xor(ss, 32);
                if (ssq && fq == 0) ssq[(size_t)r * 16 + u.pn * 4 + wc] = ss;
                if (m & 1) asm volatile("" ::: "memory"); }
    }
};
struct EpiMoeDown {
    static constexpr bool PERM = false, AFTER_DRAIN = false;
    float* out; const int* row_tok; const float* row_gate;
    __device__ __forceinline__ void operator()(const f32x4 (&acc)[2][2][4][2], const Unit& u, int wr, int wc, int fr, int fq) const {
        const int col0 = u.pn * BM + wc * 32 + 4 * fq;
#pragma unroll
        for (int ai = 0; ai < 2; ++ai)
#pragma unroll
            for (int m = 0; m < 4; ++m) { const int r = u.pm * BM + ai * HALF + wr * 64 + m * 16 + fr; const int tok = row_tok[r]; const float gt = row_gate[r];
                if (tok >= 0) { float* op = out + (size_t)tok * DM + col0;
#pragma unroll
                    for (int bj = 0; bj < 2; ++bj)
#pragma unroll
                        for (int n = 0; n < 2; ++n) { float* p = op + bj * HALF + n * 16; *(f32x4*)p = *(const f32x4*)p + acc[ai][bj][m][n] * gt; } }
                if (m & 1) asm volatile("" ::: "memory"); }
    }
};

template <class Epi, class Sched, bool ALIGN_EPI = false, bool SP2 = false>
__device__ __forceinline__ void gemm_phase(PG8_LAS unsigned char* lds, const Gemm g, const Sched& S, const Epi& E) {
    int tid_ = threadIdx.x; asm volatile("" : "+v"(tid_));
    const int tid = tid_, wid = __builtin_amdgcn_readfirstlane(tid >> 6), lane = tid & 63, wr = wid >> 2, wc = wid & 3, fr = lane & 15, fq = lane >> 4;
    const int K = g.K, nt = K / BK;
    unsigned voffA[2], voffB[2];
#pragma unroll
    for (int i = 0; i < 2; ++i) { int R, C; stage_rc(tid * 16 + i * 8192, R, C); const int Rb = Epi::PERM ? ((R & ~31) + perm32(R & 31)) : R;
        voffA[i] = (unsigned)(R * K + C) * 2u; voffB[i] = (unsigned)(Rb * K + C) * 2u; }
    const size_t kstep = (size_t)(BK * 2);
    const size_t hstep = (size_t)HALF * K * 2;
    const size_t tstep = 2 * hstep;
    const unsigned ldsw = (unsigned)wid * 1024u;
    const int aoff = lds_byte(wr * 64 + fr, fq * 8), boff = lds_byte(wc * 32 + fr, fq * 8);
#define PG8_SA(b, h) (((b) * 2 + (h)) * HTB)
#define PG8_SB(b, h) ((4 + (b) * 2 + (h)) * HTB)
#define PG8_STAGE(bufoff, gbase, voff) do { _Pragma("unroll") for (int _i = 0; _i < 2; ++_i) \
        __builtin_amdgcn_global_load_lds((const unsigned*)((const char*)(gbase) + (voff)[_i]), (PG8_LAS unsigned*)(lds + (bufoff) + ldsw + _i * 8192), 16, 0, 0); } while (0)
#define PG8_LDA(dst, b, h) do { _Pragma("unroll") for (int m = 0; m < 4; ++m) _Pragma("unroll") for (int k = 0; k < 2; ++k) dst[m][k] = *(const PG8_LAS bf16x8*)(lds + PG8_SA(b, h) + aoff + m * 2048 + k * 1024); } while (0)
#define PG8_LDB(dst, b, h) do { _Pragma("unroll") for (int n = 0; n < 2; ++n) _Pragma("unroll") for (int k = 0; k < 2; ++k) dst[n][k] = *(const PG8_LAS bf16x8*)(lds + PG8_SB(b, h) + boff + n * 2048 + k * 1024); } while (0)
#define PG8_MMA(ai, bj, At, Bt) do { __builtin_amdgcn_s_setprio(1); _Pragma("unroll") for (int m = 0; m < 4; ++m) _Pragma("unroll") for (int n = 0; n < 2; ++n) _Pragma("unroll") for (int k = 0; k < 2; ++k) \
        acc[ai][bj][m][n] = __builtin_amdgcn_mfma_f32_16x16x32_bf16(Bt[n][k], At[m][k], acc[ai][bj][m][n], 0, 0, 0); __builtin_amdgcn_s_setprio(0); } while (0)
#define PG8_WAIT_V(n) asm volatile("s_waitcnt vmcnt(" #n ")" ::: "memory")
#define PG8_WAIT_L(n) asm volatile("s_waitcnt lgkmcnt(" #n ")" ::: "memory")
#define PG8_BAR __builtin_amdgcn_s_barrier()
#define PG8_SCHED __builtin_amdgcn_sched_barrier(0)
    Unit cur, nxt; int ui = 0;
    if (!S.next(0, cur)) return;
    f32x4 acc[2][2][4][2];
#pragma unroll
    for (int a = 0; a < 2; ++a)
#pragma unroll
        for (int b = 0; b < 2; ++b)
#pragma unroll
            for (int m = 0; m < 4; ++m)
#pragma unroll
                for (int n = 0; n < 2; ++n) acc[a][b][m][n] = (f32x4){0.f, 0.f, 0.f, 0.f};
    bf16x8 At[4][2], B0[2][2], B1[2][2];
    const char* cA = (const char*)g.A + (size_t)cur.pm * tstep; const char* cB = (const char*)g.Bt + S.bofs(cur, tstep);
    S.a_ready(cur);
    if constexpr (SP2) {
        PG8_STAGE(PG8_SB(0, 0), cB, voffB); PG8_STAGE(PG8_SB(0, 1), cB + hstep, voffB); PG8_STAGE(PG8_SA(0, 0), cA, voffA); PG8_STAGE(PG8_SA(0, 1), cA + hstep, voffA);
        if (wr == 1) PG8_BAR;
        PG8_WAIT_V(2); PG8_BAR;
        PG8_STAGE(PG8_SB(1, 0), cB + kstep, voffB); PG8_STAGE(PG8_SA(1, 0), cA + kstep, voffA); PG8_STAGE(PG8_SB(1, 1), cB + hstep + kstep, voffB);
        PG8_WAIT_V(6); PG8_BAR;
    } else {
        PG8_STAGE(PG8_SB(0, 0), cB, voffB); PG8_STAGE(PG8_SA(0, 0), cA, voffA); PG8_STAGE(PG8_SB(0, 1), cB + hstep, voffB); PG8_STAGE(PG8_SA(0, 1), cA + hstep, voffA);
        if (wr == 1) PG8_BAR;
        PG8_WAIT_V(4); PG8_BAR;
        PG8_STAGE(PG8_SB(1, 0), cB + kstep, voffB); PG8_STAGE(PG8_SA(1, 0), cA + kstep, voffA); PG8_STAGE(PG8_SB(1, 1), cB + hstep + kstep, voffB);
        PG8_WAIT_V(6); PG8_BAR;
    }
    for (;;) {
        const bool has_next = S.next(ui + 1, nxt);
        const char* nA = has_next ? (const char*)g.A + (size_t)nxt.pm * tstep : cA; const char* nB = has_next ? (const char*)g.Bt + S.bofs(nxt, tstep) : cB;
        for (int t = 0; t < nt; t += 2) {
            const bool last = (t == nt - 2);
            const char* a1 = cA + (size_t)(t + 1) * kstep;
            const char* a2 = last ? nA : cA + (size_t)(t + 2) * kstep; const char* b2 = last ? nB : cB + (size_t)(t + 2) * kstep;
            const char* a3 = a2 + kstep; const char* b3 = b2 + kstep;
            if (last && has_next) S.a_ready(nxt);
            if constexpr (SP2) {
            PG8_LDB(B0, 0, 0); PG8_LDB(B1, 0, 1); PG8_SCHED; PG8_LDA(At, 0, 0); PG8_STAGE(PG8_SA(1, 1), a1 + hstep, voffA);
            PG8_WAIT_V(8); PG8_WAIT_L(0); PG8_BAR; PG8_MMA(0, 0, At, B0); PG8_MMA(0, 1, At, B1); PG8_BAR; PG8_SCHED;
            PG8_LDA(At, 0, 1); PG8_STAGE(PG8_SB(0, 0), b2, voffB); PG8_STAGE(PG8_SB(0, 1), b2 + hstep, voffB); PG8_STAGE(PG8_SA(0, 0), a2, voffA);
            PG8_WAIT_V(8); PG8_WAIT_L(0); PG8_BAR; PG8_MMA(1, 0, At, B0); PG8_MMA(1, 1, At, B1); PG8_BAR; PG8_SCHED;
            PG8_LDB(B0, 1, 0); PG8_LDB(B1, 1, 1); PG8_SCHED; PG8_LDA(At, 1, 0); PG8_STAGE(PG8_SA(0, 1), a2 + hstep, voffA);
            PG8_WAIT_V(8); PG8_WAIT_L(0); PG8_BAR; PG8_MMA(0, 0, At, B0); PG8_MMA(0, 1, At, B1); PG8_BAR; PG8_SCHED;
            PG8_LDA(At, 1, 1); PG8_STAGE(PG8_SB(1, 0), b3, voffB); PG8_STAGE(PG8_SB(1, 1), b3 + hstep, voffB); PG8_STAGE(PG8_SA(1, 0), a3, voffA);
            PG8_WAIT_V(8); PG8_WAIT_L(0); PG8_BAR; PG8_MMA(1, 0, At, B0); PG8_MMA(1, 1, At, B1); PG8_BAR; PG8_SCHED;
            } else {
            PG8_LDB(B0, 0, 0); PG8_SCHED; PG8_LDA(At, 0, 0); PG8_STAGE(PG8_SA(1, 1), a1 + hstep, voffA);
            PG8_WAIT_L(8); PG8_BAR; PG8_WAIT_L(0); PG8_MMA(0, 0, At, B0); PG8_BAR; PG8_SCHED;
            PG8_LDB(B1, 0, 1); PG8_STAGE(PG8_SB(0, 0), b2, voffB);
            PG8_BAR; PG8_WAIT_L(0); PG8_MMA(0, 1, At, B1); PG8_BAR;
            PG8_LDA(At, 0, 1); PG8_STAGE(PG8_SA(0, 0), a2, voffA);
            PG8_BAR; PG8_WAIT_L(0); PG8_MMA(1, 0, At, B0); PG8_BAR; PG8_SCHED;
            PG8_STAGE(PG8_SB(0, 1), b2 + hstep, voffB);
            PG8_WAIT_V(6); PG8_BAR; PG8_MMA(1, 1, At, B1); PG8_BAR;
            PG8_LDB(B0, 1, 0); PG8_SCHED; PG8_LDA(At, 1, 0); PG8_STAGE(PG8_SA(0, 1), a2 + hstep, voffA);
            PG8_WAIT_L(8); PG8_BAR; PG8_WAIT_L(0); PG8_MMA(0, 0, At, B0); PG8_BAR; PG8_SCHED;
            PG8_LDB(B1, 1, 1); PG8_STAGE(PG8_SB(1, 0), b3, voffB);
            PG8_BAR; PG8_WAIT_L(0); PG8_MMA(0, 1, At, B1); PG8_BAR;
            PG8_LDA(At, 1, 1); PG8_STAGE(PG8_SA(1, 0), a3, voffA);
            PG8_BAR; PG8_WAIT_L(0); PG8_MMA(1, 0, At, B0); PG8_BAR; PG8_SCHED;
            PG8_STAGE(PG8_SB(1, 1), b3 + hstep, voffB);
            PG8_WAIT_V(6); PG8_BAR; PG8_MMA(1, 1, At, B1); PG8_BAR;
            }
        }
        if constexpr (ALIGN_EPI) { if (wr == 0) PG8_BAR; }
        if constexpr (!Epi::AFTER_DRAIN) { E(acc, cur, wr, wc, fr, fq); S.done(cur); }
        if (!has_next) break;
#pragma unroll
        for (int a = 0; a < 2; ++a)
#pragma unroll
            for (int b = 0; b < 2; ++b)
#pragma unroll
                for (int m = 0; m < 4; ++m)
#pragma unroll
                    for (int n = 0; n < 2; ++n) acc[a][b][m][n] = (f32x4){0.f, 0.f, 0.f, 0.f};
        cur = nxt; cA = nA; cB = nB; ++ui;
        if constexpr (ALIGN_EPI) { if (wr == 1) PG8_BAR; }
    }
    PG8_WAIT_V(0);
    if constexpr (!ALIGN_EPI) { if (wr == 0) PG8_BAR; }
    PG8_BAR;
    if constexpr (Epi::AFTER_DRAIN) { E.fused(acc, cur, wr, wc, fr, fq, lds, wid, lane); S.done(cur); }
#undef PG8_SA
#undef PG8_SB
#undef PG8_STAGE
#undef PG8_LDA
#undef PG8_LDB
#undef PG8_MMA
#undef PG8_WAIT_V
#undef PG8_WAIT_L
#undef PG8_BAR
#undef PG8_SCHED
}
}
#define XB_TMO      128
#define XB_XCNT(j)  (256  + 64 * (j))
#define XB_XSUB(j)  (1280 + 64 * (j))
#define XB_XGEN(j)  (2304 + 64 * (j))
#define XB_TOP      3328
#define XB_TOPGEN   3392
#define XCD_BAR_WORDS 3456
#define XB_SPIN_CAP (1u << 18)

__device__ __forceinline__ unsigned xb_ld(unsigned* p)              { return __hip_atomic_load(p, __ATOMIC_RELAXED, __HIP_MEMORY_SCOPE_AGENT); }
__device__ __forceinline__ unsigned xb_add(unsigned* p, unsigned v) { return __hip_atomic_fetch_add(p, v, __ATOMIC_RELAXED, __HIP_MEMORY_SCOPE_AGENT); }
__device__ __forceinline__ unsigned xb_xcc_id() { return (unsigned)__builtin_amdgcn_s_getreg((3 << 11) | 20) & 0xFu; }
#define XB_SPIN(cond, bar) do { unsigned _sp = 0; while (cond) { __builtin_amdgcn_s_sleep(1); \
    if ((++_sp & 255u) == 0u) { if (xb_ld(&(bar)[XB_TMO])) break; if (_sp > XB_SPIN_CAP) { atomicAdd(&(bar)[XB_TMO], 1u); break; } } } } while (0)

struct XcdBarrier {
    unsigned* bar; unsigned x;
    volatile LAS unsigned* st;
};

__device__ __forceinline__ XcdBarrier xcd_barrier_post(unsigned* bar, volatile LAS unsigned* st) {
    XcdBarrier b; b.bar = bar; b.x = xb_xcc_id(); b.st = st;
    if (threadIdx.x == 0) (void)xb_add(&bar[XB_XCNT(b.x)], 1u);
    return b;
}
__device__ __forceinline__ void xcd_barrier_complete(unsigned* bar, unsigned x, unsigned& nloc, unsigned& nx) {
    const unsigned G = gridDim.x * gridDim.y * gridDim.z;
    unsigned sum, cnt, mine, sp = 0u;
    for (;;) {
        sum = 0u; cnt = 0u; mine = 0u;
#pragma unroll
        for (unsigned j = 0; j < 16; ++j) { const unsigned c = xb_ld(&bar[XB_XCNT(j)]); sum += c; cnt += (c > 0u) ? 1u : 0u; mine = (j == x) ? c : mine; }
        if (sum == G) break;
        __builtin_amdgcn_s_sleep(1);
        if ((++sp & 255u) == 0u) { if (xb_ld(&bar[XB_TMO])) break; if (sp > XB_SPIN_CAP) { atomicAdd(&bar[XB_TMO], 1u); break; } }
    }
    nloc = mine > 0u ? mine : 1u; nx = cnt > 0u ? cnt : 1u;
}

__device__ __forceinline__ void xcd_barrier(const XcdBarrier& b) {
    asm volatile("s_waitcnt vmcnt(0)" ::: "memory");
    __syncthreads();
    if (threadIdx.x == 0) {
        unsigned* bar = b.bar;
        __builtin_amdgcn_s_waitcnt(0);
        unsigned nloc = b.st[0], nx = b.st[1];
        if (nloc == 0u) { xcd_barrier_complete(bar, b.x, nloc, nx); b.st[0] = nloc; b.st[1] = nx; }
        const unsigned old = xb_add(&bar[XB_XSUB(b.x)], 1u);
        const unsigned gen = old / nloc;
        if (old + 1u == (gen + 1u) * nloc) {
            __builtin_amdgcn_fence(__ATOMIC_RELEASE, "agent");
            asm volatile("s_waitcnt vmcnt(0)" ::: "memory");
            const unsigned og = xb_add(&bar[XB_TOP], 1u);
            const unsigned tg = og / nx;
            if (og + 1u == (tg + 1u) * nx) xb_add(&bar[XB_TOPGEN], 1u);
            else XB_SPIN(xb_ld(&bar[XB_TOPGEN]) == tg, bar);
            __builtin_amdgcn_fence(__ATOMIC_ACQUIRE, "agent");
            xb_add(&bar[XB_XGEN(b.x)], 1u);
            asm volatile("s_waitcnt vmcnt(0)" ::: "memory");
        } else {
            XB_SPIN(xb_ld(&bar[XB_XGEN(b.x)]) == gen, bar);
            __builtin_amdgcn_fence(__ATOMIC_ACQUIRE, "agent");
            asm volatile("s_waitcnt vmcnt(0)" ::: "memory");
        }
    }
    __syncthreads();
}

struct Params {
    const float* in[33];
    float* out; unsigned char* ws;
    int ph_lo, ph_hi;
};
struct Frame {
    LAS unsigned char* lds;
    int blk, G;
    float* out; unsigned char* ws;
};
constexpr int PTAB_OFF = LDSCTL_OFF + 1024;
__device__ __forceinline__ int mytid() { int t = threadIdx.x; asm volatile("" : "+v"(t)); return t; }
__device__ __forceinline__ const float* inptr(const Frame& F, int k) {
    volatile LAS unsigned* t = (volatile LAS unsigned*)(F.lds + PTAB_OFF) + 2 * k;
    const unsigned lo = __builtin_amdgcn_readfirstlane(t[0]), hi = __builtin_amdgcn_readfirstlane(t[1]);
    return (const float*)(((unsigned long long)hi << 32) | (unsigned long long)lo);
}
#define IN_X 0
#define IN_RELB 1
#define IN_MIXG 2
#define IN_WIN 3
#define IN_WOUT 4
#define IN_FFNG 5
#define IN_QG 6
#define IN_KG 7
#define IN_CW 8
#define IN_CB 9
#define IN_CLG 10
#define IN_CLB 11
#define IN_MU 12
#define IN_W0 13
#define IN_W2 14
#define IN_A0 15
#define IN_A2 16
#define IN_G2 17
#define IN_KK 18
#define IN_KA 19
#define IN_RK 20
#define IN_RLG 21
#define IN_RLB 22
#define IN_GG2 23
#define IN_GGB 24
#define IN_GNG 25
#define IN_FWG 26
#define IN_FWU 27
#define IN_FWD 28
#define IN_ROUTER 29
#define IN_MWG 30
#define IN_MWU 31
#define IN_MWD 32

__device__ __forceinline__ void p0_transpose_item(const float* W, int K, int N, int nblk, const float* gk, bf16* WT, int mode, LAS float* scr, int item, int lane) {
    const int kb = item / nblk, nb = item % nblk, k0 = 64 * kb, n0 = 32 * nb;
    const int n = n0 + (lane & 31);
#pragma unroll 8
    for (int i = 0; i < 32; ++i) { const int kk = 2 * i + (lane >> 5); float v = (n < N) ? W[(size_t)(k0 + kk) * N + n] : 0.f; if (gk) v *= gk[k0 + kk]; scr[kk * 33 + (lane & 31)] = v; }
    LDS_WAIT(); asm volatile("" ::: "memory");
    const int c = lane & 7;
    const int rowbase = (mode == 0) ? n0 : ((n0 >> 7) * 256 + (mode == 2 ? 128 : 0) + (n0 & 127));
#pragma unroll
    for (int j = 0; j < 4; ++j) { const int nn = (lane >> 3) + 8 * j; const LAS float* s = scr + (8 * c) * 33 + nn;
        u32x4 o; o.x = pk2(s[0 * 33], s[1 * 33]); o.y = pk2(s[2 * 33], s[3 * 33]); o.z = pk2(s[4 * 33], s[5 * 33]); o.w = pk2(s[6 * 33], s[7 * 33]);
        *(u32x4*)(WT + (size_t)(rowbase + nn) * K + k0 + 8 * c) = o; }
    LDS_WAIT(); asm volatile("" ::: "memory");
}
__device__ __forceinline__ void p0_prologue(Frame& F) {
    const int tid = mytid(), lane = tid & 63, wave = __builtin_amdgcn_readfirstlane(tid >> 6); (void)lane; (void)wave;
    LAS float* scr = (LAS float*)(F.lds + wave * 16384);
    const int gw = F.blk * NWAVES + wave, NGW = F.G * NWAVES;
    constexpr int I_IN = 16 * 96, I_OUT = 16 * 32, I_GU = 16 * 88, I_D = 44 * 32, I_SET = 2 * I_GU + I_D;
    constexpr int NITEMS = 2 * I_IN + 2 * I_OUT + 9 * I_SET;
    unsigned char* ws = F.ws;
    for (int it = gw; it < NITEMS; it += NGW) {
        int r = it;
        if (r < 2 * I_IN) { const int l = r / I_IN; r -= l * I_IN;
            p0_transpose_item(inptr(F, IN_WIN) + (size_t)l * DM * INW, DM, INW, 96, inptr(F, IN_MIXG) + l * DM, (bf16*)(ws + WS_WIN) + (size_t)l * NPADW * DM, 0, scr, r, lane); continue; }
        r -= 2 * I_IN;
        if (r < 2 * I_OUT) { const int l = r / I_OUT; r -= l * I_OUT;
            p0_transpose_item(inptr(F, IN_WOUT) + (size_t)l * DM * DM, DM, DM, 32, nullptr, (bf16*)(ws + WS_WOUT) + (size_t)l * DM * DM, 0, scr, r, lane); continue; }
        r -= 2 * I_OUT;
        const int set = r / I_SET; r -= set * I_SET;
        const float* wg = set == 0 ? inptr(F, IN_FWG) : inptr(F, IN_MWG) + (size_t)(set - 1) * DM * DFF;
        const float* wu = set == 0 ? inptr(F, IN_FWU) : inptr(F, IN_MWU) + (size_t)(set - 1) * DM * DFF;
        const float* wd = set == 0 ? inptr(F, IN_FWD) : inptr(F, IN_MWD) + (size_t)(set - 1) * DFF * DM;
        const float* gk = inptr(F, IN_FFNG) + (set == 0 ? 0 : DM);
        bf16* dgu = set == 0 ? (bf16*)(ws + WS_WGU) : (bf16*)(ws + WS_MOEW + (size_t)(set - 1) * MOEW_E_BYTES);
        bf16* dd = set == 0 ? (bf16*)(ws + WS_WD) : (bf16*)(ws + WS_MOEW + (size_t)(set - 1) * MOEW_E_BYTES + MOEW_GU_BYTES);
        if (r < I_GU) { p0_transpose_item(wg, DM, DFF, 88, gk, dgu, 1, scr, r, lane); continue; } r -= I_GU;
        if (r < I_GU) { p0_transpose_item(wu, DM, DFF, 88, gk, dgu, 2, scr, r, lane); continue; } r -= I_GU;
        p0_transpose_item(wd, DFF, DM, 32, nullptr, dd, 0, scr, r, lane);
    }
    const float* x = inptr(F, IN_X); bf16* hb = (bf16*)(ws + WS_HB); float* ssq = (float*)(ws + WS_SSQ);
    for (int m = gw; m < NTOK; m += NGW) {
        const f32x4* xr = (const f32x4*)(x + (size_t)m * DM) + lane; f32x4 v[4]; float s = 0.f;
#pragma unroll
        for (int j = 0; j < 4; ++j) { v[j] = xr[64 * j]; s += (v[j][0] * v[j][0] + v[j][1] * v[j][1]) + (v[j][2] * v[j][2] + v[j][3] * v[j][3]); }
        s = wave_sum(s);
        u32x2* o8 = (u32x2*)(hb + (size_t)m * DM) + lane;
#pragma unroll
        for (int j = 0; j < 4; ++j) { u32x2 w; w.x = pk2(v[j][0], v[j][1]); w.y = pk2(v[j][2], v[j][3]); o8[64 * j] = w; }
        if (lane < 16) ssq[(size_t)m * 16 + lane] = (lane == 0) ? s : 0.f;
    }
}

__device__ const unsigned char T5B[3][132] = {
 {0,1,2,3,4,5,6,7,8,9,10,11,12,13,14,15,16,16,16,16,16,16,17,17,17,17,17,17,17,17,18,18,18,18,18,18,18,18,18,18,19,19,19,19,19,19,19,19,19,19,19,19,19,19,20,20,20,20,20,20,20,20,20,20,20,20,20,20,20,20,20,20,20,21,21,21,21,21,21,21,21,21,21,21,21,21,21,21,21,21,21,21,21,21,21,21,21,21,21,22,22,22,22,22,22,22,22,22,22,22,22,22,22,22,22,22,22,22,22,22,22,22,22,22,22,22,22,22,22,0,0,0},
 {0,4,8,12,16,16,17,17,18,18,19,19,19,19,20,20,20,20,20,21,21,21,21,21,21,22,22,22,22,22,22,22,22,22,23,23,23,23,23,23,23,23,23,23,23,23,24,24,24,24,24,24,24,24,24,24,24,24,24,24,24,24,25,25,25,25,25,25,25,25,25,25,25,25,25,25,25,25,25,25,25,25,25,26,26,26,26,26,26,26,26,26,26,26,26,26,26,26,26,26,26,26,26,26,26,26,26,26,26,26,26,26,26,27,27,27,27,27,27,27,27,27,27,27,27,27,27,27,27,0,0,0},
 {0,16,18,19,20,21,21,22,22,23,23,23,24,24,24,24,25,25,25,25,25,26,26,26,26,26,26,26,26,27,27,27,27,27,27,27,27,27,27,28,28,28,28,28,28,28,28,28,28,28,28,28,29,29,29,29,29,29,29,29,29,29,29,29,29,29,29,29,29,29,30,30,30,30,30,30,30,30,30,30,30,30,30,30,30,30,30,30,30,30,30,30,30,30,30,31,31,31,31,31,31,31,31,31,31,31,31,31,31,31,31,31,31,31,31,31,31,31,31,31,31,31,31,31,31,31,31,31,31,0,0,0}};

__device__ __forceinline__ void attn_tile(LAS unsigned char* lds, const bf16* Z, bf16* OP, float* LSE, const float* rel_bias, const float* qg, const float* kg, int tile, int tid) {
    const int lane = tid & 63, w = __builtin_amdgcn_readfirstlane(tid >> 6), fr = lane & 15, g = lane >> 4;
    const int br = tile >> 10, rem = tile & 1023, b = rem >> 7, h = (rem >> 5) & 3, sub = rem & 31;
    const int dsh = 2 * br, nbl = 32 >> dsh, r = sub >> (5 - dsh), n = sub & (nbl - 1);
    LAS unsigned char* Qs = lds;
    LAS unsigned char* Ks = lds + 16384;
    LAS unsigned char* Vt = lds + 49152;
    LAS float* BT = (LAS float*)(lds + 49152 + 33792);
    const size_t zrow0 = (size_t)b * SEQ;
    if (tid < 129) BT[tid] = rel_bias[(int)T5B[br][tid] * 4 + h];
    {
        const int j = tid >> 1, half = tid & 1;
        {
            const int lk = 128 * (n - 1) + j; u32x4 p[4];
            if (lk >= 0) { const u32x4* src = (const u32x4*)(Z + (zrow0 + ((size_t)lk << dsh) + r) * INW + ZA + 256 + h * 64 + half * 32);
#pragma unroll
                for (int c = 0; c < 4; ++c) p[c] = src[c]; }
            else {
#pragma unroll
                for (int c = 0; c < 4; ++c) p[c] = (u32x4){0u, 0u, 0u, 0u}; }
            float f[4][8]; float ss = 0.f;
#pragma unroll
            for (int c = 0; c < 4; ++c) { unpack8(p[c], f[c]);
#pragma unroll
                for (int e = 0; e < 8; ++e) ss += f[c][e] * f[c][e]; }
            ss += __shfl_xor(ss, 1);
            const float rs = __builtin_amdgcn_rsqf(ss * (1.0f / 64.0f) + NORM_EPS);
#pragma unroll
            for (int c = 0; c < 4; ++c) { const float* gp = kg + half * 32 + c * 8; u32x4 o;
                o.x = pk2(f[c][0] * rs * gp[0], f[c][1] * rs * gp[1]); o.y = pk2(f[c][2] * rs * gp[2], f[c][3] * rs * gp[3]);
                o.z = pk2(f[c][4] * rs * gp[4], f[c][5] * rs * gp[5]); o.w = pk2(f[c][6] * rs * gp[6], f[c][7] * rs * gp[7]);
                *(LAS u32x4*)(Ks + j * 128 + (((half * 4 + c) ^ (j & 7)) << 4)) = o; }
        }
        if (tid < 256) {
            const int lq = 128 * n + j; u32x4 p[4];
            const u32x4* src = (const u32x4*)(Z + (zrow0 + ((size_t)lq << dsh) + r) * INW + ZA + h * 64 + half * 32);
#pragma unroll
            for (int c = 0; c < 4; ++c) p[c] = src[c];
            float f[4][8]; float ss = 0.f;
#pragma unroll
            for (int c = 0; c < 4; ++c) { unpack8(p[c], f[c]);
#pragma unroll
                for (int e = 0; e < 8; ++e) ss += f[c][e] * f[c][e]; }
            ss += __shfl_xor(ss, 1);
            const float rs = __builtin_amdgcn_rsqf(ss * (1.0f / 64.0f) + NORM_EPS) * 0.125f;
#pragma unroll
            for (int c = 0; c < 4; ++c) { const float* gp = qg + half * 32 + c * 8; u32x4 o;
                o.x = pk2(f[c][0] * rs * gp[0], f[c][1] * rs * gp[1]); o.y = pk2(f[c][2] * rs * gp[2], f[c][3] * rs * gp[3]);
                o.z = pk2(f[c][4] * rs * gp[4], f[c][5] * rs * gp[5]); o.w = pk2(f[c][6] * rs * gp[6], f[c][7] * rs * gp[7]);
                *(LAS u32x4*)(Qs + j * 128 + (((half * 4 + c) ^ (j & 7)) << 4)) = o; }
        }
    }
#pragma unroll
    for (int it = 0; it < 4; ++it) { const int idx = tid + 512 * it, chunk = idx >> 8, key = idx & 255, lk = 128 * (n - 1) + key; u32x4 p = (u32x4){0u, 0u, 0u, 0u};
        if (lk >= 0) p = *(const u32x4*)(Z + (zrow0 + ((size_t)lk << dsh) + r) * INW + ZA + 512 + h * 64 + chunk * 8);
        LAS unsigned short* vp = (LAS unsigned short*)(Vt + (chunk * 8) * 528 + key * 2);
        vp[0 * 264] = (unsigned short)(p.x & 0xffffu); vp[1 * 264] = (unsigned short)(p.x >> 16); vp[2 * 264] = (unsigned short)(p.y & 0xffffu); vp[3 * 264] = (unsigned short)(p.y >> 16);
        vp[4 * 264] = (unsigned short)(p.z & 0xffffu); vp[5 * 264] = (unsigned short)(p.z >> 16); vp[6 * 264] = (unsigned short)(p.w & 0xffffu); vp[7 * 264] = (unsigned short)(p.w >> 16); }
    __syncthreads();
    bf16x8 qf[2];
#pragma unroll
    for (int ks = 0; ks < 2; ++ks) qf[ks] = *(const LAS bf16x8*)(Qs + (16 * w + fr) * 128 + (((ks * 4 + g) ^ (fr & 7)) << 4));
    f32x4 s[16];
#pragma unroll
    for (int kb = 0; kb < 16; ++kb) { s[kb] = (f32x4){0.f, 0.f, 0.f, 0.f};
#pragma unroll
        for (int ks = 0; ks < 2; ++ks) { const bf16x8 kf = *(const LAS bf16x8*)(Ks + (16 * kb + fr) * 128 + (((ks * 4 + g) ^ (fr & 7)) << 4));
            s[kb] = __builtin_amdgcn_mfma_f32_16x16x32_bf16(kf, qf[ks], s[kb], 0, 0, 0); } }
    const int q = 16 * w + fr; float mx = -3.0e38f;
#pragma unroll
    for (int kb = 0; kb < 16; ++kb)
#pragma unroll
        for (int rg = 0; rg < 4; ++rg) { const int key = 16 * kb + 4 * g + rg, delta = q + 128 - key; const bool valid = (delta >= 0) && (delta <= 128) && (n > 0 || key >= 128);
            const int di = delta < 0 ? 0 : (delta > 128 ? 128 : delta);
            const float v = valid ? s[kb][rg] + BT[di] : -3.0e38f; s[kb][rg] = v; mx = fmaxf(mx, v); }
    mx = fmaxf(mx, __shfl_xor(mx, 16)); mx = fmaxf(mx, __shfl_xor(mx, 32));
    float den = 0.f;
#pragma unroll
    for (int kb = 0; kb < 16; ++kb)
#pragma unroll
        for (int rg = 0; rg < 4; ++rg) { const float v = s[kb][rg]; const float p = (v > -1.0e38f) ? __expf(v - mx) : 0.f; s[kb][rg] = p; den += p; }
    den += __shfl_xor(den, 16); den += __shfl_xor(den, 32);
    f32x4 o[4];
#pragma unroll
    for (int eb = 0; eb < 4; ++eb) o[eb] = (f32x4){0.f, 0.f, 0.f, 0.f};
#pragma unroll
    for (int s8 = 0; s8 < 8; ++s8) {
        u32x4 pw; pw.x = pk2(s[2 * s8][0], s[2 * s8][1]); pw.y = pk2(s[2 * s8][2], s[2 * s8][3]); pw.z = pk2(s[2 * s8 + 1][0], s[2 * s8 + 1][1]); pw.w = pk2(s[2 * s8 + 1][2], s[2 * s8 + 1][3]);
        const bf16x8 pb = __builtin_bit_cast(bf16x8, pw);
#pragma unroll
        for (int eb = 0; eb < 4; ++eb) { const LAS unsigned char* vp = Vt + (16 * eb + fr) * 528 + (32 * s8 + 4 * g) * 2;
            const u32x2 lo = *(const LAS u32x2*)vp, hi = *(const LAS u32x2*)(vp + 32); u32x4 aw; aw.x = lo.x; aw.y = lo.y; aw.z = hi.x; aw.w = hi.y;
            o[eb] = __builtin_amdgcn_mfma_f32_16x16x32_bf16(__builtin_bit_cast(bf16x8, aw), pb, o[eb], 0, 0, 0); } }
    const float inv = 1.0f / den; const size_t tokq = zrow0 + ((size_t)(128 * n + q) << dsh) + r;
    bf16* op = OP + ((size_t)br * NTOK + tokq) * 256 + h * 64 + 4 * g;
#pragma unroll
    for (int eb = 0; eb < 4; ++eb) { u32x2 wv; wv.x = pk2(o[eb][0] * inv, o[eb][1] * inv); wv.y = pk2(o[eb][2] * inv, o[eb][3] * inv); *(u32x2*)(op + 16 * eb) = wv; }
    if (g == 0) LSE[((size_t)br * NTOK + tokq) * 4 + h] = mx + __logf(den);
    __syncthreads();
}

__device__ __forceinline__ void attn_merge(Frame& F, const bf16* OP, const float* LSE, bf16* Y) {
    const int tid = mytid(), lane = tid & 63, wave = __builtin_amdgcn_readfirstlane(tid >> 6); (void)lane; (void)wave;
    const int gt = F.blk * NTHREADS + tid, NGT = F.G * NTHREADS;
    for (int idx = gt; idx < NTOK * 32; idx += NGT) { const int tok = idx >> 5, c8 = idx & 31, h = c8 >> 3;
        const float l0 = LSE[((size_t)0 * NTOK + tok) * 4 + h], l1 = LSE[((size_t)1 * NTOK + tok) * 4 + h], l2 = LSE[((size_t)2 * NTOK + tok) * 4 + h];
        const float m = fmaxf(l0, fmaxf(l1, l2)); float w0 = __expf(l0 - m), w1 = __expf(l1 - m), w2 = __expf(l2 - m); const float inv = 1.0f / (w0 + w1 + w2); w0 *= inv; w1 *= inv; w2 *= inv;
        const u32x4 a = *(const u32x4*)(OP + ((size_t)0 * NTOK + tok) * 256 + c8 * 8), bq = *(const u32x4*)(OP + ((size_t)1 * NTOK + tok) * 256 + c8 * 8), c = *(const u32x4*)(OP + ((size_t)2 * NTOK + tok) * 256 + c8 * 8);
        float fa[8], fb[8], fc[8]; unpack8(a, fa); unpack8(bq, fb); unpack8(c, fc); float r[8];
#pragma unroll
        for (int e = 0; e < 8; ++e) r[e] = w0 * fa[e] + w1 * fb[e] + w2 * fc[e];
        u32x4 o; o.x = pk2(r[0], r[1]); o.y = pk2(r[2], r[3]); o.z = pk2(r[4], r[5]); o.w = pk2(r[6], r[7]);
        *(u32x4*)(Y + (size_t)tok * DM + c8 * 8) = o; }
}

__device__ __forceinline__ void conv_item(Frame& F, const bf16* Z, bf16* Y, const float* cw, const float* cb, const float* lg, const float* lb, int item) {
    const int tid = mytid(), b = item >> 6, t0 = (item & 63) * 64;
    LAS float* HG = (LAS float*)F.lds;
    LAS float* WL = (LAS float*)(F.lds + 96256);
    for (int i = tid; i < 31 * 256; i += NTHREADS) WL[i] = cw[i];
    for (int p = tid; p < 94 * 32; p += NTHREADS) { const int row = p >> 5, c8 = p & 31, t = t0 - 30 + row; float hv[8];
        if (t >= 0) { const bf16* zr = Z + ((size_t)b * SEQ + t) * INW + ZB + c8 * 8; const u32x4 uu = *(const u32x4*)zr, gg = *(const u32x4*)(zr + 256); float fu[8], fg[8]; unpack8(uu, fu); unpack8(gg, fg);
#pragma unroll
            for (int e = 0; e < 8; ++e) hv[e] = fu[e] * sigmoidf_(fg[e]); }
        else {
#pragma unroll
            for (int e = 0; e < 8; ++e) hv[e] = 0.f; }
        LAS f32x4* d = (LAS f32x4*)(HG + row * 256 + c8 * 8); d[0] = (f32x4){hv[0], hv[1], hv[2], hv[3]}; d[1] = (f32x4){hv[4], hv[5], hv[6], hv[7]}; }
    __syncthreads();
    const int tt = tid >> 3, cs = tid & 7;
    f32x4 acc[8];
#pragma unroll
    for (int i = 0; i < 8; ++i) acc[i] = *(const f32x4*)(cb + 4 * (cs + 8 * i));
    for (int j = 0; j < 31; ++j) {
#pragma unroll
        for (int i = 0; i < 8; ++i) { const int qd = cs + 8 * i; acc[i] += *(const LAS f32x4*)(HG + (tt + j) * 256 + 4 * qd) * *(const LAS f32x4*)(WL + j * 256 + 4 * qd); } }
    bf16* yr = Y + ((size_t)b * SEQ + t0 + tt) * DM + 256;
#pragma unroll
    for (int gi = 0; gi < 4; ++gi) {
        const f32x4 x0 = acc[2 * gi], x1 = acc[2 * gi + 1];
        float s = ((x0[0] + x0[1]) + (x0[2] + x0[3])) + ((x1[0] + x1[1]) + (x1[2] + x1[3])); s = red8(s);
        const float mean = s * (1.0f / 64.0f); const f32x4 d0 = x0 - mean, d1 = x1 - mean;
        float ss = ((d0[0] * d0[0] + d0[1] * d0[1]) + (d0[2] * d0[2] + d0[3] * d0[3])) + ((d1[0] * d1[0] + d1[1] * d1[1]) + (d1[2] * d1[2] + d1[3] * d1[3])); ss = red8(ss);
        const float rstd = __builtin_amdgcn_rsqf(ss * (1.0f / 64.0f) + 1e-5f);
#pragma unroll
        for (int k = 0; k < 2; ++k) { const int qd = cs + 8 * (2 * gi + k); const f32x4 dd = k ? d1 : d0; const f32x4 gv = *(const f32x4*)(lg + 4 * qd), bv = *(const f32x4*)(lb + 4 * qd); float y[4];
#pragma unroll
            for (int e = 0; e < 4; ++e) y[e] = siluf_(dd[e] * rstd * gv[e] + bv[e]);
            u32x2 wv; wv.x = pk2(y[0], y[1]); wv.y = pk2(y[2], y[3]); *(u32x2*)(yr + 4 * qd) = wv; } }
    __syncthreads();
}

__device__ __forceinline__ void gla_chain(Frame& F, const bf16* Z, bf16* Y, const float* g2, const float* gb, const float* ng, int b, int h) {
    const int tid = mytid(), lane = tid & 63, w = __builtin_amdgcn_readfirstlane(tid >> 6);
    LAS float* L = (LAS float*)F.lds;
    LAS float* QF = L, *KF = L + 1024, *VF = L + 2048, *GD = L + 4096, *OG = L + 4608, *G2 = L + 6656, *PK = L + 7168, *OPART = L + 10240;
    G2[tid] = g2[(tid >> 5) * 128 + h * 32 + (tid & 31)];
    const float gbv0 = gb[h * 32 + (tid & 31)];
    const bf16* zb = Z + (size_t)b * SEQ * INW;
    int ptt[2], pcol[2], pdst[2]; bool pok[2];
#pragma unroll
    for (int it = 0; it < 2; ++it) { const int p = tid + 512 * it; pok[it] = p < 832; const int tt = p / 26, qd = p % 26; ptt[it] = tt;
        int col, dst;
        if (qd < 4) { col = ZD + h * 32 + 8 * qd; dst = tt * 32 + 8 * qd; }
        else if (qd < 8) { col = ZD + 128 + h * 32 + 8 * (qd - 4); dst = 1024 + tt * 32 + 8 * (qd - 4); }
        else if (qd < 16) { col = ZD + 256 + h * 64 + 8 * (qd - 8); dst = 2048 + tt * 64 + 8 * (qd - 8); }
        else if (qd < 18) { col = ZD + 512 + 8 * (qd - 16); dst = 4096 + tt * 16 + 8 * (qd - 16); }
        else { col = ZD + 528 + h * 64 + 8 * (qd - 18); dst = 4608 + tt * 64 + 8 * (qd - 18); }
        pcol[it] = col; pdst[it] = dst; }
    u32x4 pre[2];
#pragma unroll
    for (int it = 0; it < 2; ++it) pre[it] = pok[it] ? *(const u32x4*)(zb + (size_t)ptt[it] * INW + pcol[it]) : (u32x4){0u, 0u, 0u, 0u};
    float S[4] = {0.f, 0.f, 0.f, 0.f};
    for (int ch = 0; ch < SEQ / 32; ++ch) {
        const int t0 = ch * 32;
#pragma unroll
        for (int it = 0; it < 2; ++it) if (pok[it]) { float f[8]; unpack8(pre[it], f); LAS f32x4* d = (LAS f32x4*)(L + pdst[it]); d[0] = (f32x4){f[0], f[1], f[2], f[3]}; d[1] = (f32x4){f[4], f[5], f[6], f[7]}; }
        if (ch + 1 < SEQ / 32) {
#pragma unroll
            for (int it = 0; it < 2; ++it) if (pok[it]) pre[it] = *(const u32x4*)(zb + (size_t)(t0 + 32 + ptt[it]) * INW + pcol[it]); }
        __syncthreads();
#pragma unroll
        for (int it = 0; it < 2; ++it) { const int o = tid + 512 * it, tt = o >> 5, kk = o & 31; float x = gbv0;
#pragma unroll
            for (int j = 0; j < 16; ++j) x += GD[tt * 16 + j] * G2[j * 32 + kk];
            const float gk = -softplusf_(-x) * (1.0f / 16.0f); const int ww = kk >> 2, i = kk & 3; LAS float* pk = PK + (tt * 8 + ww) * 12;
            pk[i] = __expf(gk); pk[4 + i] = KF[tt * 32 + kk]; pk[8 + i] = QF[tt * 32 + kk] * 0.17677669529663687f; }
        __syncthreads();
        for (int tt = 0; tt < 32; ++tt) { const LAS f32x4* pk = (const LAS f32x4*)(PK + (tt * 8 + w) * 12); const f32x4 e4 = pk[0], k4 = pk[1], q4 = pk[2]; const float vv = VF[tt * 64 + lane];
            float o = 0.f;
#pragma unroll
            for (int i = 0; i < 4; ++i) { S[i] = e4[i] * S[i] + k4[i] * vv; o += q4[i] * S[i]; }
            OPART[(tt * 8 + w) * 64 + lane] = o; }
        __syncthreads();
        { const int tt = tid >> 4, v4 = (tid & 15) * 4; f32x4 o = (f32x4){0.f, 0.f, 0.f, 0.f};
#pragma unroll
            for (int ww = 0; ww < 8; ++ww) o += *(const LAS f32x4*)(OPART + (tt * 8 + ww) * 64 + v4);
            float ss = (o[0] * o[0] + o[1] * o[1]) + (o[2] * o[2] + o[3] * o[3]); ss = red16(ss);
            const float rs = __builtin_amdgcn_rsqf(ss * (1.0f / 64.0f) + NORM_EPS); const f32x4 gv = *(const f32x4*)(ng + v4), og = *(const LAS f32x4*)(OG + tt * 64 + v4); float y[4];
#pragma unroll
            for (int e = 0; e < 4; ++e) y[e] = o[e] * rs * gv[e] * siluf_(og[e]);
            u32x2 wv; wv.x = pk2(y[0], y[1]); wv.y = pk2(y[2], y[3]); *(u32x2*)(Y + ((size_t)b * SEQ + t0 + tt) * DM + 768 + h * 64 + v4) = wv; }
        __syncthreads();
    }
}

struct RwkvP { const float *mu, *w0, *w2, *a0, *a2, *g2, *kk, *ka, *rk, *lg, *lb; };
__device__ __forceinline__ void rwkv_chain(Frame& F, const bf16* Z, bf16* Y, const RwkvP P, int b, int h) {
    const int tid = mytid();
    LAS float* L = (LAS float*)F.lds;
    LAS float *R = L, *KP = L + 2048, *V = L + 4096, *KK = L + 6144, *W = L + 8192, *KKA = L + 10240, *G = L + 12288, *OUT = L + 14336, *TW = L + 16384, *AD = L + 17408, *SG = L + 18432,
              *W2H = L + 20480, *A2H = L + 22528, *G2H = L + 24576, *BON = L + 28672;
    for (int i = tid; i < 2048; i += NTHREADS) { const int j = i >> 6, c = i & 63; W2H[i] = P.w2[j * 256 + h * 64 + c]; A2H[i] = P.a2[j * 256 + h * 64 + c]; }
    for (int i = tid; i < 4096; i += NTHREADS) { const int j = i >> 6, c = i & 63; G2H[i] = P.g2[j * 256 + h * 64 + c]; }
    const bf16* zb = Z + (size_t)b * SEQ * INW;
    int ptt[3], pcol[3], pdst[3], pkind[3]; bool pok[3];
#pragma unroll
    for (int it = 0; it < 3; ++it) { const int p = tid + 512 * it; pok[it] = p < 1280; const int tt = p / 40, qd = p % 40; ptt[it] = tt; int col, dst, kind;
        if (qd < 8) { col = ZC + h * 64 + 8 * qd; dst = tt * 64 + 8 * qd; kind = 0; }
        else if (qd < 16) { col = ZC + 256 + h * 64 + 8 * (qd - 8); dst = 2048 + tt * 64 + 8 * (qd - 8); kind = 0; }
        else if (qd < 24) { col = ZC + 512 + h * 64 + 8 * (qd - 16); dst = 4096 + tt * 64 + 8 * (qd - 16); kind = 0; }
        else if (qd < 28) { col = ZC + 768 + 8 * (qd - 24); dst = 16384 + tt * 32 + 8 * (qd - 24); kind = 1; }
        else if (qd < 32) { col = ZC + 800 + 8 * (qd - 28); dst = 17408 + tt * 32 + 8 * (qd - 28); kind = 0; }
        else { col = ZC + 832 + 8 * (qd - 32); dst = 18432 + tt * 64 + 8 * (qd - 32); kind = 2; }
        pcol[it] = col; pdst[it] = dst; pkind[it] = kind; }
    u32x4 cur[3], prv[3];
#pragma unroll
    for (int it = 0; it < 3; ++it) { cur[it] = (u32x4){0u, 0u, 0u, 0u}; prv[it] = (u32x4){0u, 0u, 0u, 0u};
        if (pok[it]) { cur[it] = *(const u32x4*)(zb + (size_t)ptt[it] * INW + pcol[it]); if (ptt[it] > 0) prv[it] = *(const u32x4*)(zb + (size_t)(ptt[it] - 1) * INW + pcol[it]); } }
    float S[8];
#pragma unroll
    for (int j = 0; j < 8; ++j) S[j] = 0.f;
    __syncthreads();
    for (int ch = 0; ch < SEQ / 32; ++ch) {
        const int t0 = ch * 32;
#pragma unroll
        for (int it = 0; it < 3; ++it) if (pok[it]) { float fc[8], fp[8]; unpack8(cur[it], fc); unpack8(prv[it], fp); const float* mu = P.mu + (pcol[it] - ZC); float x[8];
#pragma unroll
            for (int e = 0; e < 8; ++e) { x[e] = fc[e] + (fp[e] - fc[e]) * mu[e]; if (pkind[it] == 1) x[e] = tanhf(x[e]); else if (pkind[it] == 2) x[e] = sigmoidf_(x[e]); }
            LAS f32x4* d = (LAS f32x4*)(L + pdst[it]); d[0] = (f32x4){x[0], x[1], x[2], x[3]}; d[1] = (f32x4){x[4], x[5], x[6], x[7]}; }
        if (ch + 1 < SEQ / 32) {
#pragma unroll
            for (int it = 0; it < 3; ++it) if (pok[it]) { const bf16* p = zb + (size_t)(t0 + 32 + ptt[it]) * INW + pcol[it]; cur[it] = *(const u32x4*)p; prv[it] = *(const u32x4*)(p - INW); } }
        __syncthreads();
        { const int tt = tid >> 4, c4 = (tid & 15) * 4, hc = h * 64 + c4;
            f32x4 wl = *(const f32x4*)(P.w0 + hc), al = *(const f32x4*)(P.a0 + hc), gg = (f32x4){0.f, 0.f, 0.f, 0.f};
#pragma unroll 8
            for (int j = 0; j < 32; ++j) { wl += *(const LAS f32x4*)(W2H + j * 64 + c4) * TW[tt * 32 + j]; al += *(const LAS f32x4*)(A2H + j * 64 + c4) * AD[tt * 32 + j]; }
#pragma unroll 8
            for (int j = 0; j < 64; ++j) gg += *(const LAS f32x4*)(G2H + j * 64 + c4) * SG[tt * 64 + j];
            const f32x4 kr = *(const LAS f32x4*)(KP + tt * 64 + c4), rr = *(const LAS f32x4*)(R + tt * 64 + c4);
            const f32x4 kkw = *(const f32x4*)(P.kk + hc), kaw = *(const f32x4*)(P.ka + hc), rkw = *(const f32x4*)(P.rk + hc);
            f32x4 dec, a, kk, kp; float ss = 0.f, bon = 0.f;
#pragma unroll
            for (int e = 0; e < 4; ++e) { const float wlog = -softplusf_(-wl[e]) - 0.5f; dec[e] = __expf(-__expf(wlog)); a[e] = sigmoidf_(al[e]); kk[e] = kr[e] * kkw[e]; ss += kk[e] * kk[e];
                kp[e] = kr[e] * (1.0f + (a[e] - 1.0f) * kaw[e]); bon += rr[e] * kp[e] * rkw[e]; }
            ss = red16(ss); bon = red16(bon);
            const float inv = 1.0f / fmaxf(sqrtf(ss), 1e-12f); kk = kk * inv;
            *(LAS f32x4*)(KK + tt * 64 + c4) = kk; *(LAS f32x4*)(W + tt * 64 + c4) = dec; *(LAS f32x4*)(KKA + tt * 64 + c4) = kk * a; *(LAS f32x4*)(KP + tt * 64 + c4) = kp; *(LAS f32x4*)(G + tt * 64 + c4) = gg;
            if ((tid & 15) == 0) BON[tt] = bon; }
        __syncthreads();
        { const int row = tid >> 3, ks = tid & 7;
            for (int tt = 0; tt < 32; ++tt) { const int o8 = tt * 64 + 8 * ks;
                const f32x4 k0 = *(const LAS f32x4*)(KK + o8), k1 = *(const LAS f32x4*)(KK + o8 + 4), w0 = *(const LAS f32x4*)(W + o8), w1 = *(const LAS f32x4*)(W + o8 + 4);
                const f32x4 b0 = *(const LAS f32x4*)(KKA + o8), b1 = *(const LAS f32x4*)(KKA + o8 + 4), p0 = *(const LAS f32x4*)(KP + o8), p1 = *(const LAS f32x4*)(KP + o8 + 4);
                const f32x4 r0 = *(const LAS f32x4*)(R + o8), r1 = *(const LAS f32x4*)(R + o8 + 4); const float vv = V[tt * 64 + row];
                float sa = 0.f;
#pragma unroll
                for (int j = 0; j < 4; ++j) sa += S[j] * k0[j] + S[4 + j] * k1[j];
                sa = -red8(sa);
                float o = 0.f;
#pragma unroll
                for (int j = 0; j < 4; ++j) { S[j] = S[j] * w0[j] + sa * b0[j] + vv * p0[j]; S[4 + j] = S[4 + j] * w1[j] + sa * b1[j] + vv * p1[j]; o += S[j] * r0[j] + S[4 + j] * r1[j]; }
                o = red8(o);
                if (ks == 0) OUT[tt * 64 + row] = o; } }
        __syncthreads();
        { const int tt = tid >> 4, c4 = (tid & 15) * 4, hc = h * 64 + c4; const f32x4 o = *(const LAS f32x4*)(OUT + tt * 64 + c4);
            float s = (o[0] + o[1]) + (o[2] + o[3]); s = red16(s); const float mean = s * (1.0f / 64.0f); const f32x4 d = o - mean;
            float ss = (d[0] * d[0] + d[1] * d[1]) + (d[2] * d[2] + d[3] * d[3]); ss = red16(ss); const float rstd = __builtin_amdgcn_rsqf(ss * (1.0f / 64.0f) + 64e-5f);
            const f32x4 lg = *(const f32x4*)(P.lg + hc), lb = *(const f32x4*)(P.lb + hc), vv = *(const LAS f32x4*)(V + tt * 64 + c4), gg = *(const LAS f32x4*)(G + tt * 64 + c4); const float bon = BON[tt]; float y[4];
#pragma unroll
            for (int e = 0; e < 4; ++e) y[e] = (d[e] * rstd * lg[e] + lb[e] + bon * vv[e]) * gg[e];
            u32x2 wv; wv.x = pk2(y[0], y[1]); wv.y = pk2(y[2], y[3]); *(u32x2*)(Y + ((size_t)b * SEQ + t0 + tt) * DM + 512 + hc) = wv; }
        __syncthreads();
    }
}

__device__ __forceinline__ void moe_route(Frame& F, const float* hres, const float* gffn, const float* router) {
    const int tid = mytid(), lane = tid & 63, wave = __builtin_amdgcn_readfirstlane(tid >> 6); (void)lane; (void)wave;
    unsigned char* rt = F.ws + WS_RT;
    int* tope = (int*)(rt + RT_TOPE); float* gate = (float*)(rt + RT_GATE); int* rank = (int*)(rt + RT_RANK); float* rstd = (float*)(rt + RT_RSTD); int* hist = (int*)(rt + RT_HIST); int* rowtok = (int*)(rt + RT_ROWTOK);
    LAS float* RW = (LAS float*)F.lds;
    LAS int* LH = (LAS int*)(F.lds + 32768);
    for (int i = tid; i < 8192; i += NTHREADS) RW[i] = router[i];
    if (tid < 16) LH[tid] = 0;
    for (int i = F.blk * NTHREADS + tid; i < 2 * MOE_ROWS; i += F.G * NTHREADS) rowtok[i] = -1;
    __syncthreads();
    const int tpb = NTOK / F.G;
    for (int i = wave; i < tpb; i += NWAVES) { const int t = F.blk * tpb + i;
        const f32x4* hr = (const f32x4*)(hres + (size_t)t * DM) + lane; f32x4 v[4]; float ss = 0.f;
#pragma unroll
        for (int j = 0; j < 4; ++j) { v[j] = hr[64 * j]; ss += (v[j][0] * v[j][0] + v[j][1] * v[j][1]) + (v[j][2] * v[j][2] + v[j][3] * v[j][3]); }
        ss = wave_sum(ss); const float rs = __builtin_amdgcn_rsqf(ss * (1.0f / DM) + NORM_EPS);
        float lg[8];
#pragma unroll
        for (int e = 0; e < 8; ++e) lg[e] = 0.f;
#pragma unroll
        for (int j = 0; j < 4; ++j) { const f32x4 gv = *((const f32x4*)gffn + 64 * j + lane);
#pragma unroll
            for (int c = 0; c < 4; ++c) { const int k = 256 * j + 4 * lane + c; const float xn = v[j][c] * rs * gv[c]; const f32x4 r0 = *(const LAS f32x4*)(RW + k * 8), r1 = *(const LAS f32x4*)(RW + k * 8 + 4);
                lg[0] += xn * r0[0]; lg[1] += xn * r0[1]; lg[2] += xn * r0[2]; lg[3] += xn * r0[3]; lg[4] += xn * r1[0]; lg[5] += xn * r1[1]; lg[6] += xn * r1[2]; lg[7] += xn * r1[3]; } }
#pragma unroll
        for (int e = 0; e < 8; ++e) lg[e] = wave_sum(lg[e]);
        int i1 = 0; float m1 = lg[0];
#pragma unroll
        for (int e = 1; e < 8; ++e) if (lg[e] > m1) { m1 = lg[e]; i1 = e; }
        int i2 = -1; float m2 = -3.0e38f;
#pragma unroll
        for (int e = 0; e < 8; ++e) if (e != i1 && lg[e] > m2) { m2 = lg[e]; i2 = e; }
        if (lane == 0) { const float g1 = 1.0f / (1.0f + __expf(m2 - m1));
            const int r1 = atomicAdd((int*)&LH[i1], 1), r2 = atomicAdd((int*)&LH[8 + i2], 1);
            tope[2 * t] = i1; tope[2 * t + 1] = i2; gate[2 * t] = g1; gate[2 * t + 1] = 1.0f - g1; rank[2 * t] = r1; rank[2 * t + 1] = r2; rstd[t] = rs; }
    }
    __syncthreads();
    if (tid < 16) hist[F.blk * 16 + tid] = LH[tid];
}
__device__ __forceinline__ void moe_gather(Frame& F, int slot, const bf16* hb, bf16* asort) {
    const int tid = mytid(), lane = tid & 63, wave = __builtin_amdgcn_readfirstlane(tid >> 6); (void)lane; (void)wave;
    unsigned char* rt = F.ws + WS_RT;
    const int* tope = (const int*)(rt + RT_TOPE); const float* gate = (const float*)(rt + RT_GATE); const int* rank = (const int*)(rt + RT_RANK); const float* rstd = (const float*)(rt + RT_RSTD); const int* hist = (const int*)(rt + RT_HIST);
    int* rowtok = (int*)(rt + RT_ROWTOK) + slot * MOE_ROWS; float* rowgate = (float*)(rt + RT_ROWGATE) + slot * MOE_ROWS; float* rowrstd = (float*)(rt + RT_ROWRSTD) + slot * MOE_ROWS;
    int* tilee = (int*)(rt + RT_TILEE) + slot * 256; int* ntiles = (int*)(rt + RT_NTILES);
    LAS int* BASE = (LAS int*)(F.lds + 40960);
    LAS int* TOT = BASE + 8;
    __syncthreads();
    if (tid < 8) { int before = 0, tot = 0;
        for (int bb = 0; bb < F.G; ++bb) { const int c = hist[bb * 16 + slot * 8 + tid]; if (bb < F.blk) before += c; tot += c; }
        BASE[tid] = before; TOT[tid] = tot; }
    __syncthreads();
    if (tid == 0) { int ps = 0, nt = 0;
        for (int e = 0; e < 8; ++e) { const int tl = (TOT[e] + 255) >> 8; BASE[e] += ps; if (F.blk == 0) for (int i = 0; i < tl; ++i) tilee[nt + i] = e; ps += tl * 256; nt += tl; }
        if (F.blk == 0) ntiles[slot] = nt; }
    __syncthreads();
    const int tpb = NTOK / F.G;
    for (int i = wave; i < tpb; i += NWAVES) { const int t = F.blk * tpb + i; const int e = tope[2 * t + slot]; const int dest = BASE[e] + rank[2 * t + slot];
        if (lane == 0) { rowtok[dest] = t; rowgate[dest] = gate[2 * t + slot]; rowrstd[dest] = rstd[t]; }
        const u32x4* s = (const u32x4*)(hb + (size_t)t * DM) + lane; u32x4* d = (u32x4*)(asort + (size_t)dest * DM) + lane;
        const u32x4 a = s[0], c = s[64]; d[0] = a; d[64] = c; }
}

#ifndef MK_PER_PHASE
#define MK_PER_PHASE 1
#endif
constexpr int N_PHASES = 17;
__global__ void __launch_bounds__(NTHREADS, 2) mk_fwd(Params prm) {
    extern __shared__ __attribute__((aligned(16))) unsigned char lds_raw[];
    Frame F;
    F.lds = (LAS unsigned char*)lds_raw;
    F.blk = blockIdx.x; F.G = gridDim.x; F.out = prm.out; F.ws = prm.ws;
    volatile LAS unsigned* MISC = (volatile LAS unsigned*)(F.lds + MISC_OFF);
    for (int u = threadIdx.x; u < (LDS_BYTES - LDSCTL_OFF) / 4; u += NTHREADS) ((LAS unsigned*)(F.lds + LDSCTL_OFF))[u] = 0u;
    __syncthreads();
    if (threadIdx.x == 0) { LAS unsigned long long* tab = (LAS unsigned long long*)(F.lds + PTAB_OFF);
#pragma unroll
        for (int i_ = 0; i_ < 33; ++i_) tab[i_] = (unsigned long long)prm.in[i_]; }
    __syncthreads();
    const int lo = prm.ph_lo, hi = prm.ph_hi;
    unsigned* ctl = (unsigned*)(F.ws + WS_CTL);
    XcdBarrier bar; bar.bar = ctl + CW_BAR; bar.x = 0; bar.st = nullptr;
    if (hi - lo > 1) bar = xcd_barrier_post(ctl + CW_BAR, MISC + 8);
    unsigned char* ws = F.ws;
    bf16* hb = (bf16*)(ws + WS_HB); bf16* z = (bf16*)(ws + WS_Z); bf16* act = (bf16*)(ws + WS_Z); bf16* y = (bf16*)(ws + WS_Y); bf16* asort = (bf16*)(ws + WS_Y);
    float* ssq = (float*)(ws + WS_SSQ); bf16* opart = (bf16*)(ws + WS_OP); float* lse = (float*)(ws + WS_LSE);
    unsigned char* rt = ws + WS_RT;
#define IN(k) (lo <= (k) && (k) < hi)
#define SEAM(k) do { if (IN(k) && IN((k) + 1)) xcd_barrier(bar); } while (0)

    if (IN(0)) p0_prologue(F);
    SEAM(0);
#pragma unroll 1
    for (int layer = 0; layer < 2; ++layer) {
        const int pb = layer == 0 ? 1 : 7;
        if (IN(pb)) {
            pg8::Gemm g{hb, (const bf16*)(ws + WS_WIN) + (size_t)layer * NPADW * DM, NTOK, NPADW, DM}; pg8::StaticOrder S; S.init(NTOK / 256, NPADW / 256, F.G, F.blk);
            pg8::EpiZ E{z, INW, INW, ssq};
            pg8::gemm_phase<pg8::EpiZ, pg8::StaticOrder, true, true>(F.lds, g, S, E);
        }
        SEAM(pb);
        if (IN(pb + 1)) {
            if (F.blk < 32) {
                RwkvP P{inptr(F, IN_MU) + layer * 896, inptr(F, IN_W0) + layer * 256, inptr(F, IN_W2) + layer * 32 * 256, inptr(F, IN_A0) + layer * 256, inptr(F, IN_A2) + layer * 32 * 256, inptr(F, IN_G2) + layer * 64 * 256,
                        inptr(F, IN_KK) + layer * 256, inptr(F, IN_KA) + layer * 256, inptr(F, IN_RK) + layer * 256, inptr(F, IN_RLG) + layer * 256, inptr(F, IN_RLB) + layer * 256};
                rwkv_chain(F, z, y, P, F.blk >> 2, F.blk & 3);
            } else if (F.blk < 64) {
                gla_chain(F, z, y, inptr(F, IN_GG2) + layer * 16 * 128, inptr(F, IN_GGB) + layer * 128, inptr(F, IN_GNG) + layer * 64, (F.blk - 32) >> 2, (F.blk - 32) & 3);
            } else {
                const int wi = F.blk - 64, nw = F.G - 64;
                for (int tile = wi; tile < 3072; tile += nw) attn_tile(F.lds, z, opart, lse, inptr(F, IN_RELB), inptr(F, IN_QG) + layer * 64, inptr(F, IN_KG) + layer * 64, tile, mytid());
                for (int item = wi; item < 512; item += nw) conv_item(F, z, y, inptr(F, IN_CW) + layer * 31 * 256, inptr(F, IN_CB) + layer * 256, inptr(F, IN_CLG) + layer * 256, inptr(F, IN_CLB) + layer * 256, item);
            }
        }
        SEAM(pb + 1);
        if (IN(pb + 2)) attn_merge(F, opart, lse, y);
        SEAM(pb + 2);
        if (IN(pb + 3)) {
            pg8::Gemm g{y, (const bf16*)(ws + WS_WOUT) + (size_t)layer * DM * DM, NTOK, DM, DM}; pg8::StaticOrder S; S.init(NTOK / 256, DM / 256, F.G, F.blk);
            pg8::EpiRes E{layer == 0 ? inptr(F, IN_X) : (const float*)F.out, F.out, hb, ssq};
            pg8::gemm_phase<pg8::EpiRes, pg8::StaticOrder, true, true>(F.lds, g, S, E);
        }
        SEAM(pb + 3);
        if (layer == 0) {
            if (IN(5)) {
                pg8::Gemm g{hb, (const bf16*)(ws + WS_WGU), NTOK, 2 * DFF, DM}; pg8::StaticOrder S; S.init(NTOK / 256, 2 * DFF / 256, F.G, F.blk);
                pg8::EpiSwiGLU<false> E{act, ssq, nullptr};
                pg8::gemm_phase<pg8::EpiSwiGLU<false>, pg8::StaticOrder, true, true>(F.lds, g, S, E);
            }
            SEAM(5);
            if (IN(6)) {
                pg8::Gemm g{act, (const bf16*)(ws + WS_WD), NTOK, DM, DFF}; pg8::StaticOrder S; S.init(NTOK / 256, DM / 256, F.G, F.blk);
                pg8::EpiRes E{F.out, F.out, hb, ssq};
                pg8::gemm_phase<pg8::EpiRes, pg8::StaticOrder, true, true>(F.lds, g, S, E);
            }
            SEAM(6);
        }
    }
    if (IN(11)) moe_route(F, F.out, inptr(F, IN_FFNG) + DM, inptr(F, IN_ROUTER));
    SEAM(11);
    if (IN(12)) moe_gather(F, 0, hb, asort);
    SEAM(12);
#pragma unroll 1
    for (int slot = 0; slot < 2; ++slot) {
        const int pg = 13 + 2 * slot;
        const int* tilee = (const int*)(rt + RT_TILEE) + slot * 256;
        if (IN(pg)) {
            const int nt = __builtin_amdgcn_readfirstlane(((const int*)(rt + RT_NTILES))[slot]);
            pg8::Gemm g{asort, (const bf16*)(ws + WS_MOEW), nt * 256, 2 * DFF, DM}; pg8::StaticOrder S; S.init(nt, 2 * DFF / 256, F.G, F.blk, tilee, MOEW_E_BYTES);
            pg8::EpiSwiGLU<true> E{act, nullptr, (const float*)(rt + RT_ROWRSTD) + slot * MOE_ROWS};
            pg8::gemm_phase<pg8::EpiSwiGLU<true>, pg8::StaticOrder, true, true>(F.lds, g, S, E);
        }
        SEAM(pg);
        if (IN(pg + 1)) {
            const int nt = __builtin_amdgcn_readfirstlane(((const int*)(rt + RT_NTILES))[slot]);
            pg8::Gemm g{act, (const bf16*)(ws + WS_MOEW + MOEW_GU_BYTES), nt * 256, DM, DFF}; pg8::StaticOrder S; S.init(nt, DM / 256, F.G, F.blk, tilee, MOEW_E_BYTES);
            pg8::EpiMoeDown E{F.out, (const int*)(rt + RT_ROWTOK) + slot * MOE_ROWS, (const float*)(rt + RT_ROWGATE) + slot * MOE_ROWS};
            pg8::gemm_phase<pg8::EpiMoeDown, pg8::StaticOrder, true, true>(F.lds, g, S, E);
            if (slot == 0) moe_gather(F, 1, hb, asort);
        }
        if (slot == 0) SEAM(pg + 1);
    }
#undef IN
#undef SEAM
}

extern "C" void kernel_launch(void* const* d_in, const int* in_sizes, int n_in, void* d_out, int out_size, void* d_ws, size_t ws_size, hipStream_t stream) {
    static int grid = 0;
    if (grid == 0) {
        if (n_in != 33 || out_size != NTOK * DM || ws_size < WS_END) { fprintf(stderr, "kernel_launch: unexpected problem (n_in %d out %d ws %zu)\n", n_in, out_size, ws_size); grid = -1; return; }
        int dev = 0, cus = 0;
        if (hipGetDevice(&dev) != hipSuccess || hipDeviceGetAttribute(&cus, hipDeviceAttributeMultiprocessorCount, dev) != hipSuccess) { grid = -1; return; }
        if (hipFuncSetAttribute((const void*)mk_fwd, hipFuncAttributeMaxDynamicSharedMemorySize, LDS_BYTES) != hipSuccess) { fprintf(stderr, "kernel_launch: hipFuncSetAttribute failed\n"); grid = -1; return; }
        (void)hipGetLastError();
        grid = cus;
        if (grid != 256) fprintf(stderr, "kernel_launch: %d CUs (built for 256)\n", grid);
    }
    if (grid < 0) return;
    (void)hipMemsetAsync((char*)d_ws + WS_CTL, 0, CTL_ZERO_BYTES, stream);
    Params p{};
    for (int i = 0; i < 33; ++i) p.in[i] = (const float*)d_in[i];
    p.out = (float*)d_out; p.ws = (unsigned char*)d_ws;
#if MK_PER_PHASE
    for (int k = 0; k < N_PHASES; ++k) { p.ph_lo = k; p.ph_hi = k + 1; hipLaunchKernelGGL(mk_fwd, dim3(grid), dim3(NTHREADS), LDS_BYTES, stream, p); }
#else
    p.ph_lo = 0; p.ph_hi = N_PHASES;
    hipLaunchKernelGGL(mk_fwd, dim3(grid), dim3(NTHREADS), LDS_BYTES, stream, p);
#endif
}
```

```cpp
#include <hip/hip_runtime.h>
#include <cstdio>
#include <cstdint>

#define LAS __attribute__((address_space(3)))
#define GAS __attribute__((address_space(1)))
typedef unsigned short bf16;
typedef short bf16x8 __attribute__((ext_vector_type(8)));
typedef short s16x4 __attribute__((ext_vector_type(4)));
typedef float f32x4 __attribute__((ext_vector_type(4)));
typedef float f32x2 __attribute__((ext_vector_type(2)));
typedef unsigned u32x4 __attribute__((ext_vector_type(4)));
typedef unsigned u32x2 __attribute__((ext_vector_type(2)));

constexpr int DM = 1024, NB = 8, SEQ = 4096, NTOK = NB * SEQ, INW = 2960, NPADW = 3072, DFF = 2816, NEXP = 8;
constexpr int ZA = 0, ZB = 768, ZC = 1280, ZD = 2176;
constexpr float NORM_EPS = 1e-6f;
constexpr int MOE_ROWS = NTOK + NEXP * 256;

constexpr size_t MiB = 1u << 20;
constexpr size_t WS_CTL = 0, CTL_ZERO_BYTES = 64 * 1024;
constexpr size_t WS_WIN = 1 * MiB;
constexpr size_t WS_WOUT = 13 * MiB;
constexpr size_t WS_WGU = 17 * MiB;
constexpr size_t WS_WD = 28 * MiB;
constexpr size_t WS_SSQ = 34 * MiB;
constexpr size_t WS_RT = 36 * MiB;
constexpr size_t WS_HB = 40 * MiB;
constexpr size_t WS_Z = 104 * MiB;
constexpr size_t WS_Y = 297 * MiB;
constexpr size_t WS_MOEW = 367 * MiB;
constexpr size_t WS_END = 499 * MiB;
constexpr size_t MOEW_GU_BYTES = (size_t)2 * DFF * DM * 2, MOEW_D_BYTES = (size_t)DM * DFF * 2, MOEW_E_BYTES = MOEW_GU_BYTES + MOEW_D_BYTES;
static_assert(WS_Z + (size_t)MOE_ROWS * DFF * 2 <= WS_Y && WS_Y + (size_t)MOE_ROWS * DM * 2 <= WS_MOEW && WS_MOEW + NEXP * MOEW_E_BYTES <= WS_END, "ws map");
constexpr size_t WS_OP = WS_HB;
constexpr size_t WS_LSE = WS_HB + 48 * MiB;
constexpr size_t RT_TOPE = 0;
constexpr size_t RT_GATE = RT_TOPE + (size_t)NTOK * 8;
constexpr size_t RT_RANK = RT_GATE + (size_t)NTOK * 8;
constexpr size_t RT_RSTD = RT_RANK + (size_t)NTOK * 8;
constexpr size_t RT_HIST = RT_RSTD + (size_t)NTOK * 4;
constexpr size_t RT_ROWTOK = RT_HIST + 256 * 16 * 4;
constexpr size_t RT_ROWGATE = RT_ROWTOK + (size_t)2 * MOE_ROWS * 4;
constexpr size_t RT_ROWRSTD = RT_ROWGATE + (size_t)2 * MOE_ROWS * 4;
constexpr size_t RT_TILEE = RT_ROWRSTD + (size_t)2 * MOE_ROWS * 4;
constexpr size_t RT_NTILES = RT_TILEE + 2 * 256 * 4;
static_assert(RT_NTILES + 64 <= 4 * MiB, "routing arrays");

constexpr int CW_BAR = 1024;

constexpr int RING_BYTES = 131072, LDSCTL_OFF = RING_BYTES, MISC_OFF = LDSCTL_OFF + 320, LDS_BYTES = 147456;
constexpr int NWAVES = 8, NTHREADS = 512;

#define LDS_WAIT() asm volatile("s_waitcnt lgkmcnt(0)" ::: "memory")
#define VM_WAIT() asm volatile("s_waitcnt vmcnt(0)" ::: "memory")
__device__ __forceinline__ unsigned f2bf(float f) { unsigned u = __builtin_bit_cast(unsigned, f); return (u + 0x7fffu + ((u >> 16) & 1u)) >> 16; }
__device__ __forceinline__ unsigned pk2(float lo, float hi) { return f2bf(lo) | (f2bf(hi) << 16); }
__device__ __forceinline__ float bflo(unsigned w) { return __builtin_bit_cast(float, w << 16); }
__device__ __forceinline__ float bfhi(unsigned w) { return __builtin_bit_cast(float, w & 0xffff0000u); }
__device__ __forceinline__ float bf1(bf16 b) { return __builtin_bit_cast(float, (unsigned)b << 16); }
__device__ __forceinline__ float wave_sum(float v) {
#pragma unroll
    for (int o = 1; o < 64; o <<= 1) v += __shfl_xor(v, o);
    return v;
}
__device__ __forceinline__ float red16(float v) { v += __shfl_xor(v, 1); v += __shfl_xor(v, 2); v += __shfl_xor(v, 4); v += __shfl_xor(v, 8); return v; }
__device__ __forceinline__ float red8(float v) { v += __shfl_xor(v, 1); v += __shfl_xor(v, 2); v += __shfl_xor(v, 4); return v; }
__device__ __forceinline__ float sigmoidf_(float x) { return 1.0f / (1.0f + __expf(-x)); }
__device__ __forceinline__ float siluf_(float x) { return x / (1.0f + __expf(-x)); }
__device__ __forceinline__ float softplusf_(float x) { return fmaxf(x, 0.f) + log1pf(__expf(-fabsf(x))); }
__device__ __forceinline__ void unpack8(const u32x4 w, float (&f)[8]) {
    f[0] = bflo(w.x); f[1] = bfhi(w.x); f[2] = bflo(w.y); f[3] = bfhi(w.y); f[4] = bflo(w.z); f[5] = bfhi(w.z); f[6] = bflo(w.w); f[7] = bfhi(w.w);
}

namespace pg8 {
#define PG8_LAS __attribute__((address_space(3)))
typedef unsigned short bf16_t;
constexpr int BM = 256, BK = 64, HALF = 128, HTB = HALF * BK * 2  , STAGE_BYTES = 8 * HTB, NXCD = 8, WGM = 8;

__host__ __device__ __forceinline__ int lds_byte(int r, int c) { const int st = (r >> 4) * 2 + (c >> 5), rr = r & 15, cc = c & 31, ob = rr * 64 + cc * 2; return st * 1024 + (ob ^ (((ob >> 9) & 1) << 5)); }
__host__ __device__ __forceinline__ void stage_rc(int b, int& R, int& C) { const int st = b / 1024, sb = b % 1024, swz = sb ^ (((sb >> 9) & 1) << 5); R = (st >> 1) * 16 + swz / 64; C = (st & 1) * 32 + (swz % 64) / 2; }
__host__ __device__ __forceinline__ int perm32(int rho) { const int n = rho >> 4, i = rho & 15; return 8 * (i >> 2) + 4 * n + (i & 3); }

struct Unit { int pm, pn; };
struct Gemm { const bf16_t* A; const bf16_t* Bt; int M, N, K; };

struct StaticOrder {
    int nM, nN, nwg, G, c; const int* tile_e; size_t estride;
    __device__ void init(int nM_, int nN_, int G_, int c_, const int* te = nullptr, size_t es = 0) { nM = nM_; nN = nN_; nwg = nM * nN; G = G_; c = c_; tile_e = te; estride = es; }
    __device__ bool next(int i, Unit& u) const {
        const long L = (long)i * G + c; if (L >= nwg) return false;
        int wgid = (int)L; { const int q = nwg / NXCD, r = nwg % NXCD, xcd = wgid % NXCD, off = wgid / NXCD; wgid = (xcd < r ? xcd * (q + 1) : r * (q + 1) + (xcd - r) * q) + off; }
        const int nig = WGM * nN, gid = wgid / nig, fm = gid * WGM, gsz = (nM - fm) < WGM ? (nM - fm) : WGM;
        u.pm = fm + ((wgid % nig) % gsz); u.pn = (wgid % nig) / gsz; return true;
    }
    __device__ __forceinline__ size_t bofs(const Unit& u, size_t tstep) const { return (size_t)u.pn * tstep + (tile_e ? (size_t)__builtin_amdgcn_readfirstlane(tile_e[u.pm]) * estride : (size_t)0); }
    __device__ __forceinline__ void a_ready(const Unit&) const {}
    __device__ __forceinline__ void done(const Unit&) const {}
};

__device__ __forceinline__ unsigned cvt_pk_bf16(float lo, float hi) { unsigned r; asm volatile("v_cvt_pk_bf16_f32 %0, %1, %2" : "=v"(r) : "v"(lo), "v"(hi)); return r; }

__device__ __forceinline__ float row_rstd16(const float* ssq, int r, int fq) {
    const f32x4 p = *(const f32x4*)(ssq + (size_t)r * 16 + 4 * fq);
    float s = (p[0] + p[1]) + (p[2] + p[3]); s += __shfl_xor(s, 16); s += __shfl_xor(s, 32);
    return __builtin_amdgcn_rsqf(s * (1.0f / DM) + NORM_EPS);
}

struct EpiZ {
    static constexpr bool PERM = true, AFTER_DRAIN = false;
    bf16_t* Z; int ldc, ncols; const float* ssq;
    __device__ __forceinline__ void operator()(const f32x4 (&acc)[2][2][4][2], const Unit& u, int wr, int wc, int fr, int fq) const {
        const int row0 = u.pm * BM + wr * 64 + fr, col0 = u.pn * BM + wc * 32 + 8 * fq;
#pragma unroll
        for (int ai = 0; ai < 2; ++ai)
#pragma unroll
            for (int m = 0; m < 4; ++m) { const int r = row0 + ai * HALF + m * 16; const float rs = row_rstd16(ssq, r, fq); bf16_t* rowp = Z + (size_t)r * ldc + col0;
#pragma unroll
                for (int bj = 0; bj < 2; ++bj) { const f32x4 v0 = acc[ai][bj][m][0] * rs, v1 = acc[ai][bj][m][1] * rs;
                    u32x4 w; w.x = cvt_pk_bf16(v0[0], v0[1]); w.y = cvt_pk_bf16(v0[2], v0[3]); w.z = cvt_pk_bf16(v1[0], v1[1]); w.w = cvt_pk_bf16(v1[2], v1[3]);
                    if (col0 + bj * HALF < ncols) *(u32x4*)(rowp + bj * HALF) = w; } }
    }
};
template <bool MOE> struct EpiSwiGLU {
    static constexpr bool PERM = true, AFTER_DRAIN = false;
    bf16_t* O; const float* ssq; const float* row_rstd;
    __device__ __forceinline__ void operator()(const f32x4 (&acc)[2][2][4][2], const Unit& u, int wr, int wc, int fr, int fq) const {
        const int row0 = u.pm * BM + wr * 64 + fr, col0 = u.pn * HALF + wc * 32 + 8 * fq;
#pragma unroll
        for (int ai = 0; ai < 2; ++ai)
#pragma unroll
            for (int m = 0; m < 4; ++m) { const int r = row0 + ai * HALF + m * 16; float rs; if (MOE) rs = row_rstd[r]; else rs = row_rstd16(ssq, r, fq);
                const f32x4 g0 = acc[ai][0][m][0] * rs, g1 = acc[ai][0][m][1] * rs, u0 = acc[ai][1][m][0] * rs, u1 = acc[ai][1][m][1] * rs; f32x4 a0, a1;
#pragma unroll
                for (int j = 0; j < 4; ++j) { a0[j] = g0[j] * __builtin_amdgcn_rcpf(1.0f + __expf(-g0[j])) * u0[j]; a1[j] = g1[j] * __builtin_amdgcn_rcpf(1.0f + __expf(-g1[j])) * u1[j]; }
                u32x4 w; w.x = cvt_pk_bf16(a0[0], a0[1]); w.y = cvt_pk_bf16(a0[2], a0[3]); w.z = cvt_pk_bf16(a1[0], a1[1]); w.w = cvt_pk_bf16(a1[2], a1[3]);
                *(u32x4*)(O + (size_t)r * DFF + col0) = w; }
    }
};
struct EpiRes {
    static constexpr bool PERM = false, AFTER_DRAIN = false;
    const float* base; float* out; bf16_t* hb; float* ssq;
    __device__ __forceinline__ void operator()(const f32x4 (&acc)[2][2][4][2], const Unit& u, int wr, int wc, int fr, int fq) const {
        const int col0 = u.pn * BM + wc * 32 + 4 * fq;
#pragma unroll
        for (int ai = 0; ai < 2; ++ai)
#pragma unroll
            for (int m = 0; m < 4; ++m) { const int r = u.pm * BM + ai * HALF + wr * 64 + m * 16 + fr; const size_t off = (size_t)r * DM + col0; float ss = 0.f;
#pragma unroll
                for (int bj = 0; bj < 2; ++bj)
#pragma unroll
                    for (int n = 0; n < 2; ++n) { const f32x4 v = *(const f32x4*)(base + off + bj * HALF + n * 16) + acc[ai][bj][m][n];
                        *(f32x4*)(out + off + bj * HALF + n * 16) = v; ss += (v[0] * v[0] + v[1] * v[1]) + (v[2] * v[2] + v[3] * v[3]);
                        if (hb) { u32x2 w; w.x = cvt_pk_bf16(v[0], v[1]); w.y = cvt_pk_bf16(v[2], v[3]); *(u32x2*)(hb + off + bj * HALF + n * 16) = w; } }
                ss += __shfl_xor(ss, 16); ss += __shfl_xor(ss, 32);
                if (ssq && fq == 0) ssq[(size_t)r * 16 + u.pn * 4 + wc] = ss;
                if (m & 1) asm volatile("" ::: "memory"); }
    }
};
struct EpiMoeDown {
    static constexpr bool PERM = false, AFTER_DRAIN = false;
    float* out; const int* row_tok; const float* row_gate;
    __device__ __forceinline__ void operator()(const f32x4 (&acc)[2][2][4][2], const Unit& u, int wr, int wc, int fr, int fq) const {
        const int col0 = u.pn * BM + wc * 32 + 4 * fq;
#pragma unroll
        for (int ai = 0; ai < 2; ++ai)
#pragma unroll
            for (int m = 0; m < 4; ++m) { const int r = u.pm * BM + ai * HALF + wr * 64 + m * 16 + fr; const int tok = row_tok[r]; const float gt = row_gate[r];
                if (tok >= 0) { float* op = out + (size_t)tok * DM + col0;
#pragma unroll
                    for (int bj = 0; bj < 2; ++bj)
#pragma unroll
                        for (int n = 0; n < 2; ++n) { float* p = op + bj * HALF + n * 16; *(f32x4*)p = *(const f32x4*)p + acc[ai][bj][m][n] * gt; } }
                if (m & 1) asm volatile("" ::: "memory"); }
    }
};

template <class Epi, class Sched, bool ALIGN_EPI = false, bool SP2 = false>
__device__ __forceinline__ void gemm_phase(PG8_LAS unsigned char* lds, const Gemm g, const Sched& S, const Epi& E) {
    int tid_ = threadIdx.x; asm volatile("" : "+v"(tid_));
    const int tid = tid_, wid = __builtin_amdgcn_readfirstlane(tid >> 6), lane = tid & 63, wr = wid >> 2, wc = wid & 3, fr = lane & 15, fq = lane >> 4;
    const int K = g.K, nt = K / BK;
    unsigned voffA[2], voffB[2];
#pragma unroll
    for (int i = 0; i < 2; ++i) { int R, C; stage_rc(tid * 16 + i * 8192, R, C); const int Rb = Epi::PERM ? ((R & ~31) + perm32(R & 31)) : R;
        voffA[i] = (unsigned)(R * K + C) * 2u; voffB[i] = (unsigned)(Rb * K + C) * 2u; }
    const size_t kstep = (size_t)(BK * 2);
    const size_t hstep = (size_t)HALF * K * 2;
    const size_t tstep = 2 * hstep;
    const unsigned ldsw = (unsigned)wid * 1024u;
    const int aoff = lds_byte(wr * 64 + fr, fq * 8), boff = lds_byte(wc * 32 + fr, fq * 8);
#define PG8_SA(b, h) (((b) * 2 + (h)) * HTB)
#define PG8_SB(b, h) ((4 + (b) * 2 + (h)) * HTB)
#define PG8_STAGE(bufoff, gbase, voff) do { _Pragma("unroll") for (int _i = 0; _i < 2; ++_i) \
        __builtin_amdgcn_global_load_lds((const unsigned*)((const char*)(gbase) + (voff)[_i]), (PG8_LAS unsigned*)(lds + (bufoff) + ldsw + _i * 8192), 16, 0, 0); } while (0)
#define PG8_LDA(dst, b, h) do { _Pragma("unroll") for (int m = 0; m < 4; ++m) _Pragma("unroll") for (int k = 0; k < 2; ++k) dst[m][k] = *(const PG8_LAS bf16x8*)(lds + PG8_SA(b, h) + aoff + m * 2048 + k * 1024); } while (0)
#define PG8_LDB(dst, b, h) do { _Pragma("unroll") for (int n = 0; n < 2; ++n) _Pragma("unroll") for (int k = 0; k < 2; ++k) dst[n][k] = *(const PG8_LAS bf16x8*)(lds + PG8_SB(b, h) + boff + n * 2048 + k * 1024); } while (0)
#define PG8_MMA(ai, bj, At, Bt) do { __builtin_amdgcn_s_setprio(1); _Pragma("unroll") for (int m = 0; m < 4; ++m) _Pragma("unroll") for (int n = 0; n < 2; ++n) _Pragma("unroll") for (int k = 0; k < 2; ++k) \
        acc[ai][bj][m][n] = __builtin_amdgcn_mfma_f32_16x16x32_bf16(Bt[n][k], At[m][k], acc[ai][bj][m][n], 0, 0, 0); __builtin_amdgcn_s_setprio(0); } while (0)
#define PG8_WAIT_V(n) asm volatile("s_waitcnt vmcnt(" #n ")" ::: "memory")
#define PG8_WAIT_L(n) asm volatile("s_waitcnt lgkmcnt(" #n ")" ::: "memory")
#define PG8_BAR __builtin_amdgcn_s_barrier()
#define PG8_SCHED __builtin_amdgcn_sched_barrier(0)
    Unit cur, nxt; int ui = 0;
    if (!S.next(0, cur)) return;
    f32x4 acc[2][2][4][2];
#pragma unroll
    for (int a = 0; a < 2; ++a)
#pragma unroll
        for (int b = 0; b < 2; ++b)
#pragma unroll
            for (int m = 0; m < 4; ++m)
#pragma unroll
                for (int n = 0; n < 2; ++n) acc[a][b][m][n] = (f32x4){0.f, 0.f, 0.f, 0.f};
    bf16x8 At[4][2], B0[2][2], B1[2][2];
    const char* cA = (const char*)g.A + (size_t)cur.pm * tstep; const char* cB = (const char*)g.Bt + S.bofs(cur, tstep);
    S.a_ready(cur);
    if constexpr (SP2) {
        PG8_STAGE(PG8_SB(0, 0), cB, voffB); PG8_STAGE(PG8_SB(0, 1), cB + hstep, voffB); PG8_STAGE(PG8_SA(0, 0), cA, voffA); PG8_STAGE(PG8_SA(0, 1), cA + hstep, voffA);
        if (wr == 1) PG8_BAR;
        PG8_WAIT_V(2); PG8_BAR;
        PG8_STAGE(PG8_SB(1, 0), cB + kstep, voffB); PG8_STAGE(PG8_SA(1, 0), cA + kstep, voffA); PG8_STAGE(PG8_SB(1, 1), cB + hstep + kstep, voffB);
        PG8_WAIT_V(6); PG8_BAR;
    } else {
        PG8_STAGE(PG8_SB(0, 0), cB, voffB); PG8_STAGE(PG8_SA(0, 0), cA, voffA); PG8_STAGE(PG8_SB(0, 1), cB + hstep, voffB); PG8_STAGE(PG8_SA(0, 1), cA + hstep, voffA);
        if (wr == 1) PG8_BAR;
        PG8_WAIT_V(4); PG8_BAR;
        PG8_STAGE(PG8_SB(1, 0), cB + kstep, voffB); PG8_STAGE(PG8_SA(1, 0), cA + kstep, voffA); PG8_STAGE(PG8_SB(1, 1), cB + hstep + kstep, voffB);
        PG8_WAIT_V(6); PG8_BAR;
    }
    for (;;) {
        const bool has_next = S.next(ui + 1, nxt);
        const char* nA = has_next ? (const char*)g.A + (size_t)nxt.pm * tstep : cA; const char* nB = has_next ? (const char*)g.Bt + S.bofs(nxt, tstep) : cB;
        for (int t = 0; t < nt; t += 2) {
            const bool last = (t == nt - 2);
            const char* a1 = cA + (size_t)(t + 1) * kstep;
            const char* a2 = last ? nA : cA + (size_t)(t + 2) * kstep; const char* b2 = last ? nB : cB + (size_t)(t + 2) * kstep;
            const char* a3 = a2 + kstep; const char* b3 = b2 + kstep;
            if (last && has_next) S.a_ready(nxt);
            if constexpr (SP2) {
            PG8_LDB(B0, 0, 0); PG8_LDB(B1, 0, 1); PG8_SCHED; PG8_LDA(At, 0, 0); PG8_STAGE(PG8_SA(1, 1), a1 + hstep, voffA);
            PG8_WAIT_V(8); PG8_WAIT_L(0); PG8_BAR; PG8_MMA(0, 0, At, B0); PG8_MMA(0, 1, At, B1); PG8_BAR; PG8_SCHED;
            PG8_LDA(At, 0, 1); PG8_STAGE(PG8_SB(0, 0), b2, voffB); PG8_STAGE(PG8_SB(0, 1), b2 + hstep, voffB); PG8_STAGE(PG8_SA(0, 0), a2, voffA);
            PG8_WAIT_V(8); PG8_WAIT_L(0); PG8_BAR; PG8_MMA(1, 0, At, B0); PG8_MMA(1, 1, At, B1); PG8_BAR; PG8_SCHED;
            PG8_LDB(B0, 1, 0); PG8_LDB(B1, 1, 1); PG8_SCHED; PG8_LDA(At, 1, 0); PG8_STAGE(PG8_SA(0, 1), a2 + hstep, voffA);
            PG8_WAIT_V(8); PG8_WAIT_L(0); PG8_BAR; PG8_MMA(0, 0, At, B0); PG8_MMA(0, 1, At, B1); PG8_BAR; PG8_SCHED;
            PG8_LDA(At, 1, 1); PG8_STAGE(PG8_SB(1, 0), b3, voffB); PG8_STAGE(PG8_SB(1, 1), b3 + hstep, voffB); PG8_STAGE(PG8_SA(1, 0), a3, voffA);
            PG8_WAIT_V(8); PG8_WAIT_L(0); PG8_BAR; PG8_MMA(1, 0, At, B0); PG8_MMA(1, 1, At, B1); PG8_BAR; PG8_SCHED;
            } else {
            PG8_LDB(B0, 0, 0); PG8_SCHED; PG8_LDA(At, 0, 0); PG8_STAGE(PG8_SA(1, 1), a1 + hstep, voffA);
            PG8_WAIT_L(8); PG8_BAR; PG8_WAIT_L(0); PG8_MMA(0, 0, At, B0); PG8_BAR; PG8_SCHED;
            PG8_LDB(B1, 0, 1); PG8_STAGE(PG8_SB(0, 0), b2, voffB);
            PG8_BAR; PG8_WAIT_L(0); PG8_MMA(0, 1, At, B1); PG8_BAR;
            PG8_LDA(At, 0, 1); PG8_STAGE(PG8_SA(0, 0), a2, voffA);
            PG8_BAR; PG8_WAIT_L(0); PG8_MMA(1, 0, At, B0); PG8_BAR; PG8_SCHED;
            PG8_STAGE(PG8_SB(0, 1), b2 + hstep, voffB);
            PG8_WAIT_V(6); PG8_BAR; PG8_MMA(1, 1, At, B1); PG8_BAR;
            PG8_LDB(B0, 1, 0); PG8_SCHED; PG8_LDA(At, 1, 0); PG8_STAGE(PG8_SA(0, 1), a2 + hstep, voffA);
            PG8_WAIT_L(8); PG8_BAR; PG8_WAIT_L(0); PG8_MMA(0, 0, At, B0); PG8_BAR; PG8_SCHED;
            PG8_LDB(B1, 1, 1); PG8_STAGE(PG8_SB(1, 0), b3, voffB);
            PG8_BAR; PG8_WAIT_L(0); PG8_MMA(0, 1, At, B1); PG8_BAR;
            PG8_LDA(At, 1, 1); PG8_STAGE(PG8_SA(1, 0), a3, voffA);
            PG8_BAR; PG8_WAIT_L(0); PG8_MMA(1, 0, At, B0); PG8_BAR; PG8_SCHED;
            PG8_STAGE(PG8_SB(1, 1), b3 + hstep, voffB);
            PG8_WAIT_V(6); PG8_BAR; PG8_MMA(1, 1, At, B1); PG8_BAR;
            }
        }
        if constexpr (ALIGN_EPI) { if (wr == 0) PG8_BAR; }
        if constexpr (!Epi::AFTER_DRAIN) { E(acc, cur, wr, wc, fr, fq); S.done(cur); }
        if (!has_next) break;
#pragma unroll
        for (int a = 0; a < 2; ++a)
#pragma unroll
            for (int b = 0; b < 2; ++b)
#pragma unroll
                for (int m = 0; m < 4; ++m)
#pragma unroll
                    for (int n = 0; n < 2; ++n) acc[a][b][m][n] = (f32x4){0.f, 0.f, 0.f, 0.f};
        cur = nxt; cA = nA; cB = nB; ++ui;
        if constexpr (ALIGN_EPI) { if (wr == 1) PG8_BAR; }
    }
    PG8_WAIT_V(0);
    if constexpr (!ALIGN_EPI) { if (wr == 0) PG8_BAR; }
    PG8_BAR;
    if constexpr (Epi::AFTER_DRAIN) { E.fused(acc, cur, wr, wc, fr, fq, lds, wid, lane); S.done(cur); }
#undef PG8_SA
#undef PG8_SB
#undef PG8_STAGE
#undef PG8_LDA
#undef PG8_LDB
#undef PG8_MMA
#undef PG8_WAIT_V
#undef PG8_WAIT_L
#undef PG8_BAR
#undef PG8_SCHED
}
}
#define XB_TMO      128
#define XB_XCNT(j)  (256  + 64 * (j))
#define XB_XSUB(j)  (1280 + 64 * (j))
#define XB_XGEN(j)  (2304 + 64 * (j))
#define XB_TOP      3328
#define XB_TOPGEN   3392
#define XCD_BAR_WORDS 3456
#define XB_SPIN_CAP (1u << 18)

__device__ __forceinline__ unsigned xb_ld(unsigned* p)              { return __hip_atomic_load(p, __ATOMIC_RELAXED, __HIP_MEMORY_SCOPE_AGENT); }
__device__ __forceinline__ unsigned xb_add(unsigned* p, unsigned v) { return __hip_atomic_fetch_add(p, v, __ATOMIC_RELAXED, __HIP_MEMORY_SCOPE_AGENT); }
__device__ __forceinline__ unsigned xb_xcc_id() { return (unsigned)__builtin_amdgcn_s_getreg((3 << 11) | 20) & 0xFu; }
#define XB_SPIN(cond, bar) do { unsigned _sp = 0; while (cond) { __builtin_amdgcn_s_sleep(1); \
    if ((++_sp & 255u) == 0u) { if (xb_ld(&(bar)[XB_TMO])) break; if (_sp > XB_SPIN_CAP) { atomicAdd(&(bar)[XB_TMO], 1u); break; } } } } while (0)

struct XcdBarrier {
    unsigned* bar; unsigned x;
    volatile LAS unsigned* st;
};

__device__ __forceinline__ XcdBarrier xcd_barrier_post(unsigned* bar, volatile LAS unsigned* st) {
    XcdBarrier b; b.bar = bar; b.x = xb_xcc_id(); b.st = st;
    if (threadIdx.x == 0) (void)xb_add(&bar[XB_XCNT(b.x)], 1u);
    return b;
}
__device__ __forceinline__ void xcd_barrier_complete(unsigned* bar, unsigned x, unsigned& nloc, unsigned& nx) {
    const unsigned G = gridDim.x * gridDim.y * gridDim.z;
    unsigned sum, cnt, mine, sp = 0u;
    for (;;) {
        sum = 0u; cnt = 0u; mine = 0u;
#pragma unroll
        for (unsigned j = 0; j < 16; ++j) { const unsigned c = xb_ld(&bar[XB_XCNT(j)]); sum += c; cnt += (c > 0u) ? 1u : 0u; mine = (j == x) ? c : mine; }
        if (sum == G) break;
        __builtin_amdgcn_s_sleep(1);
        if ((++sp & 255u) == 0u) { if (xb_ld(&bar[XB_TMO])) break; if (sp > XB_SPIN_CAP) { atomicAdd(&bar[XB_TMO], 1u); break; } }
    }
    nloc = mine > 0u ? mine : 1u; nx = cnt > 0u ? cnt : 1u;
}

__device__ __forceinline__ void xcd_barrier(const XcdBarrier& b) {
    asm volatile("s_waitcnt vmcnt(0)" ::: "memory");
    __syncthreads();
    if (threadIdx.x == 0) {
        unsigned* bar = b.bar;
        __builtin_amdgcn_s_waitcnt(0);
        unsigned nloc = b.st[0], nx = b.st[1];
        if (nloc == 0u) { xcd_barrier_complete(bar, b.x, nloc, nx); b.st[0] = nloc; b.st[1] = nx; }
        const unsigned old = xb_add(&bar[XB_XSUB(b.x)], 1u);
        const unsigned gen = old / nloc;
        if (old + 1u == (gen + 1u) * nloc) {
            __builtin_amdgcn_fence(__ATOMIC_RELEASE, "agent");
            asm volatile("s_waitcnt vmcnt(0)" ::: "memory");
            const unsigned og = xb_add(&bar[XB_TOP], 1u);
            const unsigned tg = og / nx;
            if (og + 1u == (tg + 1u) * nx) xb_add(&bar[XB_TOPGEN], 1u);
            else XB_SPIN(xb_ld(&bar[XB_TOPGEN]) == tg, bar);
            __builtin_amdgcn_fence(__ATOMIC_ACQUIRE, "agent");
            xb_add(&bar[XB_XGEN(b.x)], 1u);
            asm volatile("s_waitcnt vmcnt(0)" ::: "memory");
        } else {
            XB_SPIN(xb_ld(&bar[XB_XGEN(b.x)]) == gen, bar);
            __builtin_amdgcn_fence(__ATOMIC_ACQUIRE, "agent");
            asm volatile("s_waitcnt vmcnt(0)" ::: "memory");
        }
    }
    __syncthreads();
}

struct Params {
    const float* in[33];
    float* out; unsigned char* ws;
    int ph_lo, ph_hi;
};
struct Frame {
    LAS unsigned char* lds;
    int blk, G;
    float* out; unsigned char* ws;
};
constexpr int PTAB_OFF = LDSCTL_OFF + 1024;
__device__ __forceinline__ int mytid() { int t = threadIdx.x; asm volatile("" : "+v"(t)); return t; }
__device__ __forceinline__ const float* inptr(const Frame& F, int k) {
    volatile LAS unsigned* t = (volatile LAS unsigned*)(F.lds + PTAB_OFF) + 2 * k;
    const unsigned lo = __builtin_amdgcn_readfirstlane(t[0]), hi = __builtin_amdgcn_readfirstlane(t[1]);
    return (const float*)(((unsigned long long)hi << 32) | (unsigned long long)lo);
}
#define IN_X 0
#define IN_RELB 1
#define IN_MIXG 2
#define IN_WIN 3
#define IN_WOUT 4
#define IN_FFNG 5
#define IN_QG 6
#define IN_KG 7
#define IN_CW 8
#define IN_CB 9
#define IN_CLG 10
#define IN_CLB 11
#define IN_MU 12
#define IN_W0 13
#define IN_W2 14
#define IN_A0 15
#define IN_A2 16
#define IN_G2 17
#define IN_KK 18
#define IN_KA 19
#define IN_RK 20
#define IN_RLG 21
#define IN_RLB 22
#define IN_GG2 23
#define IN_GGB 24
#define IN_GNG 25
#define IN_FWG 26
#define IN_FWU 27
#define IN_FWD 28
#define IN_ROUTER 29
#define IN_MWG 30
#define IN_MWU 31
#define IN_MWD 32

__device__ __forceinline__ void p0_transpose_item(const float* W, int K, int N, int nblk, const float* gk, bf16* WT, int mode, LAS float* scr, int item, int lane) {
    const int kb = item / nblk, nb = item % nblk, k0 = 64 * kb, n0 = 32 * nb;
    const int n = n0 + (lane & 31);
#pragma unroll 8
    for (int i = 0; i < 32; ++i) { const int kk = 2 * i + (lane >> 5); float v = (n < N) ? W[(size_t)(k0 + kk) * N + n] : 0.f; if (gk) v *= gk[k0 + kk]; scr[kk * 33 + (lane & 31)] = v; }
    LDS_WAIT(); asm volatile("" ::: "memory");
    const int c = lane & 7;
    const int rowbase = (mode == 0) ? n0 : ((n0 >> 7) * 256 + (mode == 2 ? 128 : 0) + (n0 & 127));
#pragma unroll
    for (int j = 0; j < 4; ++j) { const int nn = (lane >> 3) + 8 * j; const LAS float* s = scr + (8 * c) * 33 + nn;
        u32x4 o; o.x = pk2(s[0 * 33], s[1 * 33]); o.y = pk2(s[2 * 33], s[3 * 33]); o.z = pk2(s[4 * 33], s[5 * 33]); o.w = pk2(s[6 * 33], s[7 * 33]);
        *(u32x4*)(WT + (size_t)(rowbase + nn) * K + k0 + 8 * c) = o; }
    LDS_WAIT(); asm volatile("" ::: "memory");
}
__device__ __forceinline__ void p0_prologue(Frame& F) {
    const int tid = mytid(), lane = tid & 63, wave = __builtin_amdgcn_readfirstlane(tid >> 6); (void)lane; (void)wave;
    LAS float* scr = (LAS float*)(F.lds + wave * 16384);
    const int gw = F.blk * NWAVES + wave, NGW = F.G * NWAVES;
    constexpr int I_IN = 16 * 96, I_OUT = 16 * 32, I_GU = 16 * 88, I_D = 44 * 32, I_SET = 2 * I_GU + I_D;
    constexpr int NITEMS = 2 * I_IN + 2 * I_OUT + 9 * I_SET;
    unsigned char* ws = F.ws;
    for (int it = gw; it < NITEMS; it += NGW) {
        int r = it;
        if (r < 2 * I_IN) { const int l = r / I_IN; r -= l * I_IN;
            p0_transpose_item(inptr(F, IN_WIN) + (size_t)l * DM * INW, DM, INW, 96, inptr(F, IN_MIXG) + l * DM, (bf16*)(ws + WS_WIN) + (size_t)l * NPADW * DM, 0, scr, r, lane); continue; }
        r -= 2 * I_IN;
        if (r < 2 * I_OUT) { const int l = r / I_OUT; r -= l * I_OUT;
            p0_transpose_item(inptr(F, IN_WOUT) + (size_t)l * DM * DM, DM, DM, 32, nullptr, (bf16*)(ws + WS_WOUT) + (size_t)l * DM * DM, 0, scr, r, lane); continue; }
        r -= 2 * I_OUT;
        const int set = r / I_SET; r -= set * I_SET;
        const float* wg = set == 0 ? inptr(F, IN_FWG) : inptr(F, IN_MWG) + (size_t)(set - 1) * DM * DFF;
        const float* wu = set == 0 ? inptr(F, IN_FWU) : inptr(F, IN_MWU) + (size_t)(set - 1) * DM * DFF;
        const float* wd = set == 0 ? inptr(F, IN_FWD) : inptr(F, IN_MWD) + (size_t)(set - 1) * DFF * DM;
        const float* gk = inptr(F, IN_FFNG) + (set == 0 ? 0 : DM);
        bf16* dgu = set == 0 ? (bf16*)(ws + WS_WGU) : (bf16*)(ws + WS_MOEW + (size_t)(set - 1) * MOEW_E_BYTES);
        bf16* dd = set == 0 ? (bf16*)(ws + WS_WD) : (bf16*)(ws + WS_MOEW + (size_t)(set - 1) * MOEW_E_BYTES + MOEW_GU_BYTES);
        if (r < I_GU) { p0_transpose_item(wg, DM, DFF, 88, gk, dgu, 1, scr, r, lane); continue; } r -= I_GU;
        if (r < I_GU) { p0_transpose_item(wu, DM, DFF, 88, gk, dgu, 2, scr, r, lane); continue; } r -= I_GU;
        p0_transpose_item(wd, DFF, DM, 32, nullptr, dd, 0, scr, r, lane);
    }
    const float* x = inptr(F, IN_X); bf16* hb = (bf16*)(ws + WS_HB); float* ssq = (float*)(ws + WS_SSQ);
    for (int m = gw; m < NTOK; m += NGW) {
        const f32x4* xr = (const f32x4*)(x + (size_t)m * DM) + lane; f32x4 v[4]; float s = 0.f;
#pragma unroll
        for (int j = 0; j < 4; ++j) { v[j] = xr[64 * j]; s += (v[j][0] * v[j][0] + v[j][1] * v[j][1]) + (v[j][2] * v[j][2] + v[j][3] * v[j][3]); }
        s = wave_sum(s);
        u32x2* o8 = (u32x2*)(hb + (size_t)m * DM) + lane;
#pragma unroll
        for (int j = 0; j < 4; ++j) { u32x2 w; w.x = pk2(v[j][0], v[j][1]); w.y = pk2(v[j][2], v[j][3]); o8[64 * j] = w; }
        if (lane < 16) ssq[(size_t)m * 16 + lane] = (lane == 0) ? s : 0.f;
    }
}

__device__ const unsigned char T5B[3][132] = {
 {0,1,2,3,4,5,6,7,8,9,10,11,12,13,14,15,16,16,16,16,16,16,17,17,17,17,17,17,17,17,18,18,18,18,18,18,18,18,18,18,19,19,19,19,19,19,19,19,19,19,19,19,19,19,20,20,20,20,20,20,20,20,20,20,20,20,20,20,20,20,20,20,20,21,21,21,21,21,21,21,21,21,21,21,21,21,21,21,21,21,21,21,21,21,21,21,21,21,21,22,22,22,22,22,22,22,22,22,22,22,22,22,22,22,22,22,22,22,22,22,22,22,22,22,22,22,22,22,22,0,0,0},
 {0,4,8,12,16,16,17,17,18,18,19,19,19,19,20,20,20,20,20,21,21,21,21,21,21,22,22,22,22,22,22,22,22,22,23,23,23,23,23,23,23,23,23,23,23,23,24,24,24,24,24,24,24,24,24,24,24,24,24,24,24,24,25,25,25,25,25,25,25,25,25,25,25,25,25,25,25,25,25,25,25,25,25,26,26,26,26,26,26,26,26,26,26,26,26,26,26,26,26,26,26,26,26,26,26,26,26,26,26,26,26,26,26,27,27,27,27,27,27,27,27,27,27,27,27,27,27,27,27,0,0,0},
 {0,16,18,19,20,21,21,22,22,23,23,23,24,24,24,24,25,25,25,25,25,26,26,26,26,26,26,26,26,27,27,27,27,27,27,27,27,27,27,28,28,28,28,28,28,28,28,28,28,28,28,28,29,29,29,29,29,29,29,29,29,29,29,29,29,29,29,29,29,29,30,30,30,30,30,30,30,30,30,30,30,30,30,30,30,30,30,30,30,30,30,30,30,30,30,31,31,31,31,31,31,31,31,31,31,31,31,31,31,31,31,31,31,31,31,31,31,31,31,31,31,31,31,31,31,31,31,31,31,0,0,0}};

__device__ __forceinline__ void attn_tile(LAS unsigned char* lds, const bf16* Z, bf16* OP, float* LSE, const float* rel_bias, const float* qg, const float* kg, int tile, int tid) {
    const int lane = tid & 63, w = __builtin_amdgcn_readfirstlane(tid >> 6), fr = lane & 15, g = lane >> 4;
    const int br = tile >> 10, rem = tile & 1023, b = rem >> 7, h = (rem >> 5) & 3, sub = rem & 31;
    const int dsh = 2 * br, nbl = 32 >> dsh, r = sub >> (5 - dsh), n = sub & (nbl - 1);
    LAS unsigned char* Qs = lds;
    LAS unsigned char* Ks = lds + 16384;
    LAS unsigned char* Vt = lds + 49152;
    LAS float* BT = (LAS float*)(lds + 49152 + 33792);
    const size_t zrow0 = (size_t)b * SEQ;
    if (tid < 129) BT[tid] = rel_bias[(int)T5B[br][tid] * 4 + h];
    {
        const int j = tid >> 1, half = tid & 1;
        {
            const int lk = 128 * (n - 1) + j; u32x4 p[4];
            if (lk >= 0) { const u32x4* src = (const u32x4*)(Z + (zrow0 + ((size_t)lk << dsh) + r) * INW + ZA + 256 + h * 64 + half * 32);
#pragma unroll
                for (int c = 0; c < 4; ++c) p[c] = src[c]; }
            else {
#pragma unroll
                for (int c = 0; c < 4; ++c) p[c] = (u32x4){0u, 0u, 0u, 0u}; }
            float f[4][8]; float ss = 0.f;
#pragma unroll
            for (int c = 0; c < 4; ++c) { unpack8(p[c], f[c]);
#pragma unroll
                for (int e = 0; e < 8; ++e) ss += f[c][e] * f[c][e]; }
            ss += __shfl_xor(ss, 1);
            const float rs = __builtin_amdgcn_rsqf(ss * (1.0f / 64.0f) + NORM_EPS);
#pragma unroll
            for (int c = 0; c < 4; ++c) { const float* gp = kg + half * 32 + c * 8; u32x4 o;
                o.x = pk2(f[c][0] * rs * gp[0], f[c][1] * rs * gp[1]); o.y = pk2(f[c][2] * rs * gp[2], f[c][3] * rs * gp[3]);
                o.z = pk2(f[c][4] * rs * gp[4], f[c][5] * rs * gp[5]); o.w = pk2(f[c][6] * rs * gp[6], f[c][7] * rs * gp[7]);
                *(LAS u32x4*)(Ks + j * 128 + (((half * 4 + c) ^ (j & 7)) << 4)) = o; }
        }
        if (tid < 256) {
            const int lq = 128 * n + j; u32x4 p[4];
            const u32x4* src = (const u32x4*)(Z + (zrow0 + ((size_t)lq << dsh) + r) * INW + ZA + h * 64 + half * 32);
#pragma unroll
            for (int c = 0; c < 4; ++c) p[c] = src[c];
            float f[4][8]; float ss = 0.f;
#pragma unroll
            for (int c = 0; c < 4; ++c) { unpack8(p[c], f[c]);
#pragma unroll
                for (int e = 0; e < 8; ++e) ss += f[c][e] * f[c][e]; }
            ss += __shfl_xor(ss, 1);
            const float rs = __builtin_amdgcn_rsqf(ss * (1.0f / 64.0f) + NORM_EPS) * 0.125f;
#pragma unroll
            for (int c = 0; c < 4; ++c) { const float* gp = qg + half * 32 + c * 8; u32x4 o;
                o.x = pk2(f[c][0] * rs * gp[0], f[c][1] * rs * gp[1]); o.y = pk2(f[c][2] * rs * gp[2], f[c][3] * rs * gp[3]);
                o.z = pk2(f[c][4] * rs * gp[4], f[c][5] * rs * gp[5]); o.w = pk2(f[c][6] * rs * gp[6], f[c][7] * rs * gp[7]);
                *(LAS u32x4*)(Qs + j * 128 + (((half * 4 + c) ^ (j & 7)) << 4)) = o; }
        }
    }
#pragma unroll
    for (int it = 0; it < 4; ++it) { const int idx = tid + 512 * it, chunk = idx >> 8, key = idx & 255, lk = 128 * (n - 1) + key; u32x4 p = (u32x4){0u, 0u, 0u, 0u};
        if (lk >= 0) p = *(const u32x4*)(Z + (zrow0 + ((size_t)lk << dsh) + r) * INW + ZA + 512 + h * 64 + chunk * 8);
        LAS unsigned short* vp = (LAS unsigned short*)(Vt + (chunk * 8) * 528 + key * 2);
        vp[0 * 264] = (unsigned short)(p.x & 0xffffu); vp[1 * 264] = (unsigned short)(p.x >> 16); vp[2 * 264] = (unsigned short)(p.y & 0xffffu); vp[3 * 264] = (unsigned short)(p.y >> 16);
        vp[4 * 264] = (unsigned short)(p.z & 0xffffu); vp[5 * 264] = (unsigned short)(p.z >> 16); vp[6 * 264] = (unsigned short)(p.w & 0xffffu); vp[7 * 264] = (unsigned short)(p.w >> 16); }
    __syncthreads();
    bf16x8 qf[2];
#pragma unroll
    for (int ks = 0; ks < 2; ++ks) qf[ks] = *(const LAS bf16x8*)(Qs + (16 * w + fr) * 128 + (((ks * 4 + g) ^ (fr & 7)) << 4));
    f32x4 s[16];
#pragma unroll
    for (int kb = 0; kb < 16; ++kb) { s[kb] = (f32x4){0.f, 0.f, 0.f, 0.f};
#pragma unroll
        for (int ks = 0; ks < 2; ++ks) { const bf16x8 kf = *(const LAS bf16x8*)(Ks + (16 * kb + fr) * 128 + (((ks * 4 + g) ^ (fr & 7)) << 4));
            s[kb] = __builtin_amdgcn_mfma_f32_16x16x32_bf16(kf, qf[ks], s[kb], 0, 0, 0); } }
    const int q = 16 * w + fr; float mx = -3.0e38f;
#pragma unroll
    for (int kb = 0; kb < 16; ++kb)
#pragma unroll
        for (int rg = 0; rg < 4; ++rg) { const int key = 16 * kb + 4 * g + rg, delta = q + 128 - key; const bool valid = (delta >= 0) && (delta <= 128) && (n > 0 || key >= 128);
            const int di = delta < 0 ? 0 : (delta > 128 ? 128 : delta);
            const float v = valid ? s[kb][rg] + BT[di] : -3.0e38f; s[kb][rg] = v; mx = fmaxf(mx, v); }
    mx = fmaxf(mx, __shfl_xor(mx, 16)); mx = fmaxf(mx, __shfl_xor(mx, 32));
    float den = 0.f;
#pragma unroll
    for (int kb = 0; kb < 16; ++kb)
#pragma unroll
        for (int rg = 0; rg < 4; ++rg) { const float v = s[kb][rg]; const float p = (v > -1.0e38f) ? __expf(v - mx) : 0.f; s[kb][rg] = p; den += p; }
    den += __shfl_xor(den, 16); den += __shfl_xor(den, 32);
    f32x4 o[4];
#pragma unroll
    for (int eb = 0; eb < 4; ++eb) o[eb] = (f32x4){0.f, 0.f, 0.f, 0.f};
#pragma unroll
    for (int s8 = 0; s8 < 8; ++s8) {
        u32x4 pw; pw.x = pk2(s[2 * s8][0], s[2 * s8][1]); pw.y = pk2(s[2 * s8][2], s[2 * s8][3]); pw.z = pk2(s[2 * s8 + 1][0], s[2 * s8 + 1][1]); pw.w = pk2(s[2 * s8 + 1][2], s[2 * s8 + 1][3]);
        const bf16x8 pb = __builtin_bit_cast(bf16x8, pw);
#pragma unroll
        for (int eb = 0; eb < 4; ++eb) { const LAS unsigned char* vp = Vt + (16 * eb + fr) * 528 + (32 * s8 + 4 * g) * 2;
            const u32x2 lo = *(const LAS u32x2*)vp, hi = *(const LAS u32x2*)(vp + 32); u32x4 aw; aw.x = lo.x; aw.y = lo.y; aw.z = hi.x; aw.w = hi.y;
            o[eb] = __builtin_amdgcn_mfma_f32_16x16x32_bf16(__builtin_bit_cast(bf16x8, aw), pb, o[eb], 0, 0, 0); } }
    const float inv = 1.0f / den; const size_t tokq = zrow0 + ((size_t)(128 * n + q) << dsh) + r;
    bf16* op = OP + ((size_t)br * NTOK + tokq) * 256 + h * 64 + 4 * g;
#pragma unroll
    for (int eb = 0; eb < 4; ++eb) { u32x2 wv; wv.x = pk2(o[eb][0] * inv, o[eb][1] * inv); wv.y = pk2(o[eb][2] * inv, o[eb][3] * inv); *(u32x2*)(op + 16 * eb) = wv; }
    if (g == 0) LSE[((size_t)br * NTOK + tokq) * 4 + h] = mx + __logf(den);
    __syncthreads();
}

__device__ __forceinline__ void attn_merge(Frame& F, const bf16* OP, const float* LSE, bf16* Y) {
    const int tid = mytid(), lane = tid & 63, wave = __builtin_amdgcn_readfirstlane(tid >> 6); (void)lane; (void)wave;
    const int gt = F.blk * NTHREADS + tid, NGT = F.G * NTHREADS;
    for (int idx = gt; idx < NTOK * 32; idx += NGT) { const int tok = idx >> 5, c8 = idx & 31, h = c8 >> 3;
        const float l0 = LSE[((size_t)0 * NTOK + tok) * 4 + h], l1 = LSE[((size_t)1 * NTOK + tok) * 4 + h], l2 = LSE[((size_t)2 * NTOK + tok) * 4 + h];
        const float m = fmaxf(l0, fmaxf(l1, l2)); float w0 = __expf(l0 - m), w1 = __expf(l1 - m), w2 = __expf(l2 - m); const float inv = 1.0f / (w0 + w1 + w2); w0 *= inv; w1 *= inv; w2 *= inv;
        const u32x4 a = *(const u32x4*)(OP + ((size_t)0 * NTOK + tok) * 256 + c8 * 8), bq = *(const u32x4*)(OP + ((size_t)1 * NTOK + tok) * 256 + c8 * 8), c = *(const u32x4*)(OP + ((size_t)2 * NTOK + tok) * 256 + c8 * 8);
        float fa[8], fb[8], fc[8]; unpack8(a, fa); unpack8(bq, fb); unpack8(c, fc); float r[8];
#pragma unroll
        for (int e = 0; e < 8; ++e) r[e] = w0 * fa[e] + w1 * fb[e] + w2 * fc[e];
        u32x4 o; o.x = pk2(r[0], r[1]); o.y = pk2(r[2], r[3]); o.z = pk2(r[4], r[5]); o.w = pk2(r[6], r[7]);
        *(u32x4*)(Y + (size_t)tok * DM + c8 * 8) = o; }
}

__device__ __forceinline__ void conv_item(Frame& F, const bf16* Z, bf16* Y, const float* cw, const float* cb, const float* lg, const float* lb, int item) {
    const int tid = mytid(), b = item >> 6, t0 = (item & 63) * 64;
    LAS float* HG = (LAS float*)F.lds;
    LAS float* WL = (LAS float*)(F.lds + 96256);
    for (int i = tid; i < 31 * 256; i += NTHREADS) WL[i] = cw[i];
    for (int p = tid; p < 94 * 32; p += NTHREADS) { const int row = p >> 5, c8 = p & 31, t = t0 - 30 + row; float hv[8];
        if (t >= 0) { const bf16* zr = Z + ((size_t)b * SEQ + t) * INW + ZB + c8 * 8; const u32x4 uu = *(const u32x4*)zr, gg = *(const u32x4*)(zr + 256); float fu[8], fg[8]; unpack8(uu, fu); unpack8(gg, fg);
#pragma unroll
            for (int e = 0; e < 8; ++e) hv[e] = fu[e] * sigmoidf_(fg[e]); }
        else {
#pragma unroll
            for (int e = 0; e < 8; ++e) hv[e] = 0.f; }
        LAS f32x4* d = (LAS f32x4*)(HG + row * 256 + c8 * 8); d[0] = (f32x4){hv[0], hv[1], hv[2], hv[3]}; d[1] = (f32x4){hv[4], hv[5], hv[6], hv[7]}; }
    __syncthreads();
    const int tt = tid >> 3, cs = tid & 7;
    f32x4 acc[8];
#pragma unroll
    for (int i = 0; i < 8; ++i) acc[i] = *(const f32x4*)(cb + 4 * (cs + 8 * i));
    for (int j = 0; j < 31; ++j) {
#pragma unroll
        for (int i = 0; i < 8; ++i) { const int qd = cs + 8 * i; acc[i] += *(const LAS f32x4*)(HG + (tt + j) * 256 + 4 * qd) * *(const LAS f32x4*)(WL + j * 256 + 4 * qd); } }
    bf16* yr = Y + ((size_t)b * SEQ + t0 + tt) * DM + 256;
#pragma unroll
    for (int gi = 0; gi < 4; ++gi) {
        const f32x4 x0 = acc[2 * gi], x1 = acc[2 * gi + 1];
        float s = ((x0[0] + x0[1]) + (x0[2] + x0[3])) + ((x1[0] + x1[1]) + (x1[2] + x1[3])); s = red8(s);
        const float mean = s * (1.0f / 64.0f); const f32x4 d0 = x0 - mean, d1 = x1 - mean;
        float ss = ((d0[0] * d0[0] + d0[1] * d0[1]) + (d0[2] * d0[2] + d0[3] * d0[3])) + ((d1[0] * d1[0] + d1[1] * d1[1]) + (d1[2] * d1[2] + d1[3] * d1[3])); ss = red8(ss);
        const float rstd = __builtin_amdgcn_rsqf(ss * (1.0f / 64.0f) + 1e-5f);
#pragma unroll
        for (int k = 0; k < 2; ++k) { const int qd = cs + 8 * (2 * gi + k); const f32x4 dd = k ? d1 : d0; const f32x4 gv = *(const f32x4*)(lg + 4 * qd), bv = *(const f32x4*)(lb + 4 * qd); float y[4];
#pragma unroll
            for (int e = 0; e < 4; ++e) y[e] = siluf_(dd[e] * rstd * gv[e] + bv[e]);
            u32x2 wv; wv.x = pk2(y[0], y[1]); wv.y = pk2(y[2], y[3]); *(u32x2*)(yr + 4 * qd) = wv; } }
    __syncthreads();
}

__device__ __forceinline__ void gla_chain(Frame& F, const bf16* Z, bf16* Y, const float* g2, const float* gb, const float* ng, int b, int h) {
    const int tid = mytid(), lane = tid & 63, w = __builtin_amdgcn_readfirstlane(tid >> 6);
    LAS float* L = (LAS float*)F.lds;
    LAS float* QF = L, *KF = L + 1024, *VF = L + 2048, *GD = L + 4096, *OG = L + 4608, *G2 = L + 6656, *PK = L + 7168, *OPART = L + 10240;
    G2[tid] = g2[(tid >> 5) * 128 + h * 32 + (tid & 31)];
    const float gbv0 = gb[h * 32 + (tid & 31)];
    const bf16* zb = Z + (size_t)b * SEQ * INW;
    int ptt[2], pcol[2], pdst[2]; bool pok[2];
#pragma unroll
    for (int it = 0; it < 2; ++it) { const int p = tid + 512 * it; pok[it] = p < 832; const int tt = p / 26, qd = p % 26; ptt[it] = tt;
        int col, dst;
        if (qd < 4) { col = ZD + h * 32 + 8 * qd; dst = tt * 32 + 8 * qd; }
        else if (qd < 8) { col = ZD + 128 + h * 32 + 8 * (qd - 4); dst = 1024 + tt * 32 + 8 * (qd - 4); }
        else if (qd < 16) { col = ZD + 256 + h * 64 + 8 * (qd - 8); dst = 2048 + tt * 64 + 8 * (qd - 8); }
        else if (qd < 18) { col = ZD + 512 + 8 * (qd - 16); dst = 4096 + tt * 16 + 8 * (qd - 16); }
        else { col = ZD + 528 + h * 64 + 8 * (qd - 18); dst = 4608 + tt * 64 + 8 * (qd - 18); }
        pcol[it] = col; pdst[it] = dst; }
    u32x4 pre[2];
#pragma unroll
    for (int it = 0; it < 2; ++it) pre[it] = pok[it] ? *(const u32x4*)(zb + (size_t)ptt[it] * INW + pcol[it]) : (u32x4){0u, 0u, 0u, 0u};
    float S[4] = {0.f, 0.f, 0.f, 0.f};
    for (int ch = 0; ch < SEQ / 32; ++ch) {
        const int t0 = ch * 32;
#pragma unroll
        for (int it = 0; it < 2; ++it) if (pok[it]) { float f[8]; unpack8(pre[it], f); LAS f32x4* d = (LAS f32x4*)(L + pdst[it]); d[0] = (f32x4){f[0], f[1], f[2], f[3]}; d[1] = (f32x4){f[4], f[5], f[6], f[7]}; }
        if (ch + 1 < SEQ / 32) {
#pragma unroll
            for (int it = 0; it < 2; ++it) if (pok[it]) pre[it] = *(const u32x4*)(zb + (size_t)(t0 + 32 + ptt[it]) * INW + pcol[it]); }
        __syncthreads();
#pragma unroll
        for (int it = 0; it < 2; ++it) { const int o = tid + 512 * it, tt = o >> 5, kk = o & 31; float x = gbv0;
#pragma unroll
            for (int j = 0; j < 16; ++j) x += GD[tt * 16 + j] * G2[j * 32 + kk];
            const float gk = -softplusf_(-x) * (1.0f / 16.0f); const int ww = kk >> 2, i = kk & 3; LAS float* pk = PK + (tt * 8 + ww) * 12;
            pk[i] = __expf(gk); pk[4 + i] = KF[tt * 32 + kk]; pk[8 + i] = QF[tt * 32 + kk] * 0.17677669529663687f; }
        __syncthreads();
        for (int tt = 0; tt < 32; ++tt) { const LAS f32x4* pk = (const LAS f32x4*)(PK + (tt * 8 + w) * 12); const f32x4 e4 = pk[0], k4 = pk[1], q4 = pk[2]; const float vv = VF[tt * 64 + lane];
            float o = 0.f;
#pragma unroll
            for (int i = 0; i < 4; ++i) { S[i] = e4[i] * S[i] + k4[i] * vv; o += q4[i] * S[i]; }
            OPART[(tt * 8 + w) * 64 + lane] = o; }
        __syncthreads();
        { const int tt = tid >> 4, v4 = (tid & 15) * 4; f32x4 o = (f32x4){0.f, 0.f, 0.f, 0.f};
#pragma unroll
            for (int ww = 0; ww < 8; ++ww) o += *(const LAS f32x4*)(OPART + (tt * 8 + ww) * 64 + v4);
            float ss = (o[0] * o[0] + o[1] * o[1]) + (o[2] * o[2] + o[3] * o[3]); ss = red16(ss);
            const float rs = __builtin_amdgcn_rsqf(ss * (1.0f / 64.0f) + NORM_EPS); const f32x4 gv = *(const f32x4*)(ng + v4), og = *(const LAS f32x4*)(OG + tt * 64 + v4); float y[4];
#pragma unroll
            for (int e = 0; e < 4; ++e) y[e] = o[e] * rs * gv[e] * siluf_(og[e]);
            u32x2 wv; wv.x = pk2(y[0], y[1]); wv.y = pk2(y[2], y[3]); *(u32x2*)(Y + ((size_t)b * SEQ + t0 + tt) * DM + 768 + h * 64 + v4) = wv; }
        __syncthreads();
    }
}

struct RwkvP { const float *mu, *w0, *w2, *a0, *a2, *g2, *kk, *ka, *rk, *lg, *lb; };
__device__ __forceinline__ void rwkv_chain(Frame& F, const bf16* Z, bf16* Y, const RwkvP P, int b, int h) {
    const int tid = mytid();
    LAS float* L = (LAS float*)F.lds;
    LAS float *R = L, *KP = L + 2048, *V = L + 4096, *KK = L + 6144, *W = L + 8192, *KKA = L + 10240, *G = L + 12288, *OUT = L + 14336, *TW = L + 16384, *AD = L + 17408, *SG = L + 18432,
              *W2H = L + 20480, *A2H = L + 22528, *G2H = L + 24576, *BON = L + 28672;
    for (int i = tid; i < 2048; i += NTHREADS) { const int j = i >> 6, c = i & 63; W2H[i] = P.w2[j * 256 + h * 64 + c]; A2H[i] = P.a2[j * 256 + h * 64 + c]; }
    for (int i = tid; i < 4096; i += NTHREADS) { const int j = i >> 6, c = i & 63; G2H[i] = P.g2[j * 256 + h * 64 + c]; }
    const bf16* zb = Z + (size_t)b * SEQ * INW;
    int ptt[3], pcol[3], pdst[3], pkind[3]; bool pok[3];
#pragma unroll
    for (int it = 0; it < 3; ++it) { const int p = tid + 512 * it; pok[it] = p < 1280; const int tt = p / 40, qd = p % 40; ptt[it] = tt; int col, dst, kind;
        if (qd < 8) { col = ZC + h * 64 + 8 * qd; dst = tt * 64 + 8 * qd; kind = 0; }
        else if (qd < 16) { col = ZC + 256 + h * 64 + 8 * (qd - 8); dst = 2048 + tt * 64 + 8 * (qd - 8); kind = 0; }
        else if (qd < 24) { col = ZC + 512 + h * 64 + 8 * (qd - 16); dst = 4096 + tt * 64 + 8 * (qd - 16); kind = 0; }
        else if (qd < 28) { col = ZC + 768 + 8 * (qd - 24); dst = 16384 + tt * 32 + 8 * (qd - 24); kind = 1; }
        else if (qd < 32) { col = ZC + 800 + 8 * (qd - 28); dst = 17408 + tt * 32 + 8 * (qd - 28); kind = 0; }
        else { col = ZC + 832 + 8 * (qd - 32); dst = 18432 + tt * 64 + 8 * (qd - 32); kind = 2; }
        pcol[it] = col; pdst[it] = dst; pkind[it] = kind; }
    u32x4 cur[3], prv[3];
#pragma unroll
    for (int it = 0; it < 3; ++it) { cur[it] = (u32x4){0u, 0u, 0u, 0u}; prv[it] = (u32x4){0u, 0u, 0u, 0u};
        if (pok[it]) { cur[it] = *(const u32x4*)(zb + (size_t)ptt[it] * INW + pcol[it]); if (ptt[it] > 0) prv[it] = *(const u32x4*)(zb + (size_t)(ptt[it] - 1) * INW + pcol[it]); } }
    float S[8];
#pragma unroll
    for (int j = 0; j < 8; ++j) S[j] = 0.f;
    __syncthreads();
    for (int ch = 0; ch < SEQ / 32; ++ch) {
        const int t0 = ch * 32;
#pragma unroll
        for (int it = 0; it < 3; ++it) if (pok[it]) { float fc[8], fp[8]; unpack8(cur[it], fc); unpack8(prv[it], fp); const float* mu = P.mu + (pcol[it] - ZC); float x[8];
#pragma unroll
            for (int e = 0; e < 8; ++e) { x[e] = fc[e] + (fp[e] - fc[e]) * mu[e]; if (pkind[it] == 1) x[e] = tanhf(x[e]); else if (pkind[it] == 2) x[e] = sigmoidf_(x[e]); }
            LAS f32x4* d = (LAS f32x4*)(L + pdst[it]); d[0] = (f32x4){x[0], x[1], x[2], x[3]}; d[1] = (f32x4){x[4], x[5], x[6], x[7]}; }
        if (ch + 1 < SEQ / 32) {
#pragma unroll
            for (int it = 0; it < 3; ++it) if (pok[it]) { const bf16* p = zb + (size_t)(t0 + 32 + ptt[it]) * INW + pcol[it]; cur[it] = *(const u32x4*)p; prv[it] = *(const u32x4*)(p - INW); } }
        __syncthreads();
        { const int tt = tid >> 4, c4 = (tid & 15) * 4, hc = h * 64 + c4;
            f32x4 wl = *(const f32x4*)(P.w0 + hc), al = *(const f32x4*)(P.a0 + hc), gg = (f32x4){0.f, 0.f, 0.f, 0.f};
#pragma unroll 8
            for (int j = 0; j < 32; ++j) { wl += *(const LAS f32x4*)(W2H + j * 64 + c4) * TW[tt * 32 + j]; al += *(const LAS f32x4*)(A2H + j * 64 + c4) * AD[tt * 32 + j]; }
#pragma unroll 8
            for (int j = 0; j < 64; ++j) gg += *(const LAS f32x4*)(G2H + j * 64 + c4) * SG[tt * 64 + j];
            const f32x4 kr = *(const LAS f32x4*)(KP + tt * 64 + c4), rr = *(const LAS f32x4*)(R + tt * 64 + c4);
            const f32x4 kkw = *(const f32x4*)(P.kk + hc), kaw = *(const f32x4*)(P.ka + hc), rkw = *(const f32x4*)(P.rk + hc);
            f32x4 dec, a, kk, kp; float ss = 0.f, bon = 0.f;
#pragma unroll
            for (int e = 0; e < 4; ++e) { const float wlog = -softplusf_(-wl[e]) - 0.5f; dec[e] = __expf(-__expf(wlog)); a[e] = sigmoidf_(al[e]); kk[e] = kr[e] * kkw[e]; ss += kk[e] * kk[e];
                kp[e] = kr[e] * (1.0f + (a[e] - 1.0f) * kaw[e]); bon += rr[e] * kp[e] * rkw[e]; }
            ss = red16(ss); bon = red16(bon);
            const float inv = 1.0f / fmaxf(sqrtf(ss), 1e-12f); kk = kk * inv;
            *(LAS f32x4*)(KK + tt * 64 + c4) = kk; *(LAS f32x4*)(W + tt * 64 + c4) = dec; *(LAS f32x4*)(KKA + tt * 64 + c4) = kk * a; *(LAS f32x4*)(KP + tt * 64 + c4) = kp; *(LAS f32x4*)(G + tt * 64 + c4) = gg;
            if ((tid & 15) == 0) BON[tt] = bon; }
        __syncthreads();
        { const int row = tid >> 3, ks = tid & 7;
            for (int tt = 0; tt < 32; ++tt) { const int o8 = tt * 64 + 8 * ks;
                const f32x4 k0 = *(const LAS f32x4*)(KK + o8), k1 = *(const LAS f32x4*)(KK + o8 + 4), w0 = *(const LAS f32x4*)(W + o8), w1 = *(const LAS f32x4*)(W + o8 + 4);
                const f32x4 b0 = *(const LAS f32x4*)(KKA + o8), b1 = *(const LAS f32x4*)(KKA + o8 + 4), p0 = *(const LAS f32x4*)(KP + o8), p1 = *(const LAS f32x4*)(KP + o8 + 4);
                const f32x4 r0 = *(const LAS f32x4*)(R + o8), r1 = *(const LAS f32x4*)(R + o8 + 4); const float vv = V[tt * 64 + row];
                float sa = 0.f;
#pragma unroll
                for (int j = 0; j < 4; ++j) sa += S[j] * k0[j] + S[4 + j] * k1[j];
                sa = -red8(sa);
                float o = 0.f;
#pragma unroll
                for (int j = 0; j < 4; ++j) { S[j] = S[j] * w0[j] + sa * b0[j] + vv * p0[j]; S[4 + j] = S[4 + j] * w1[j] + sa * b1[j] + vv * p1[j]; o += S[j] * r0[j] + S[4 + j] * r1[j]; }
                o = red8(o);
                if (ks == 0) OUT[tt * 64 + row] = o; } }
        __syncthreads();
        { const int tt = tid >> 4, c4 = (tid & 15) * 4, hc = h * 64 + c4; const f32x4 o = *(const LAS f32x4*)(OUT + tt * 64 + c4);
            float s = (o[0] + o[1]) + (o[2] + o[3]); s = red16(s); const float mean = s * (1.0f / 64.0f); const f32x4 d = o - mean;
            float ss = (d[0] * d[0] + d[1] * d[1]) + (d[2] * d[2] + d[3] * d[3]); ss = red16(ss); const float rstd = __builtin_amdgcn_rsqf(ss * (1.0f / 64.0f) + 64e-5f);
            const f32x4 lg = *(const f32x4*)(P.lg + hc), lb = *(const f32x4*)(P.lb + hc), vv = *(const LAS f32x4*)(V + tt * 64 + c4), gg = *(const LAS f32x4*)(G + tt * 64 + c4); const float bon = BON[tt]; float y[4];
#pragma unroll
            for (int e = 0; e < 4; ++e) y[e] = (d[e] * rstd * lg[e] + lb[e] + bon * vv[e]) * gg[e];
            u32x2 wv; wv.x = pk2(y[0], y[1]); wv.y = pk2(y[2], y[3]); *(u32x2*)(Y + ((size_t)b * SEQ + t0 + tt) * DM + 512 + hc) = wv; }
        __syncthreads();
    }
}

__device__ __forceinline__ void moe_route(Frame& F, const float* hres, const float* gffn, const float* router) {
    const int tid = mytid(), lane = tid & 63, wave = __builtin_amdgcn_readfirstlane(tid >> 6); (void)lane; (void)wave;
    unsigned char* rt = F.ws + WS_RT;
    int* tope = (int*)(rt + RT_TOPE); float* gate = (float*)(rt + RT_GATE); int* rank = (int*)(rt + RT_RANK); float* rstd = (float*)(rt + RT_RSTD); int* hist = (int*)(rt + RT_HIST); int* rowtok = (int*)(rt + RT_ROWTOK);
    LAS float* RW = (LAS float*)F.lds;
    LAS int* LH = (LAS int*)(F.lds + 32768);
    for (int i = tid; i < 8192; i += NTHREADS) RW[i] = router[i];
    if (tid < 16) LH[tid] = 0;
    for (int i = F.blk * NTHREADS + tid; i < 2 * MOE_ROWS; i += F.G * NTHREADS) rowtok[i] = -1;
    __syncthreads();
    const int tpb = NTOK / F.G;
    for (int i = wave; i < tpb; i += NWAVES) { const int t = F.blk * tpb + i;
        const f32x4* hr = (const f32x4*)(hres + (size_t)t * DM) + lane; f32x4 v[4]; float ss = 0.f;
#pragma unroll
        for (int j = 0; j < 4; ++j) { v[j] = hr[64 * j]; ss += (v[j][0] * v[j][0] + v[j][1] * v[j][1]) + (v[j][2] * v[j][2] + v[j][3] * v[j][3]); }
        ss = wave_sum(ss); const float rs = __builtin_amdgcn_rsqf(ss * (1.0f / DM) + NORM_EPS);
        float lg[8];
#pragma unroll
        for (int e = 0; e < 8; ++e) lg[e] = 0.f;
#pragma unroll
        for (int j = 0; j < 4; ++j) { const f32x4 gv = *((const f32x4*)gffn + 64 * j + lane);
#pragma unroll
            for (int c = 0; c < 4; ++c) { const int k = 256 * j + 4 * lane + c; const float xn = v[j][c] * rs * gv[c]; const f32x4 r0 = *(const LAS f32x4*)(RW + k * 8), r1 = *(const LAS f32x4*)(RW + k * 8 + 4);
                lg[0] += xn * r0[0]; lg[1] += xn * r0[1]; lg[2] += xn * r0[2]; lg[3] += xn * r0[3]; lg[4] += xn * r1[0]; lg[5] += xn * r1[1]; lg[6] += xn * r1[2]; lg[7] += xn * r1[3]; } }
#pragma unroll
        for (int e = 0; e < 8; ++e) lg[e] = wave_sum(lg[e]);
        int i1 = 0; float m1 = lg[0];
#pragma unroll
        for (int e = 1; e < 8; ++e) if (lg[e] > m1) { m1 = lg[e]; i1 = e; }
        int i2 = -1; float m2 = -3.0e38f;
#pragma unroll
        for (int e = 0; e < 8; ++e) if (e != i1 && lg[e] > m2) { m2 = lg[e]; i2 = e; }
        if (lane == 0) { const float g1 = 1.0f / (1.0f + __expf(m2 - m1));
            const int r1 = atomicAdd((int*)&LH[i1], 1), r2 = atomicAdd((int*)&LH[8 + i2], 1);
            tope[2 * t] = i1; tope[2 * t + 1] = i2; gate[2 * t] = g1; gate[2 * t + 1] = 1.0f - g1; rank[2 * t] = r1; rank[2 * t + 1] = r2; rstd[t] = rs; }
    }
    __syncthreads();
    if (tid < 16) hist[F.blk * 16 + tid] = LH[tid];
}
__device__ __forceinline__ void moe_gather(Frame& F, int slot, const bf16* hb, bf16* asort) {
    const int tid = mytid(), lane = tid & 63, wave = __builtin_amdgcn_readfirstlane(tid >> 6); (void)lane; (void)wave;
    unsigned char* rt = F.ws + WS_RT;
    const int* tope = (const int*)(rt + RT_TOPE); const float* gate = (const float*)(rt + RT_GATE); const int* rank = (const int*)(rt + RT_RANK); const float* rstd = (const float*)(rt + RT_RSTD); const int* hist = (const int*)(rt + RT_HIST);
    int* rowtok = (int*)(rt + RT_ROWTOK) + slot * MOE_ROWS; float* rowgate = (float*)(rt + RT_ROWGATE) + slot * MOE_ROWS; float* rowrstd = (float*)(rt + RT_ROWRSTD) + slot * MOE_ROWS;
    int* tilee = (int*)(rt + RT_TILEE) + slot * 256; int* ntiles = (int*)(rt + RT_NTILES);
    LAS int* BASE = (LAS int*)(F.lds + 40960);
    LAS int* TOT = BASE + 8;
    __syncthreads();
    if (tid < 8) { int before = 0, tot = 0;
        for (int bb = 0; bb < F.G; ++bb) { const int c = hist[bb * 16 + slot * 8 + tid]; if (bb < F.blk) before += c; tot += c; }
        BASE[tid] = before; TOT[tid] = tot; }
    __syncthreads();
    if (tid == 0) { int ps = 0, nt = 0;
        for (int e = 0; e < 8; ++e) { const int tl = (TOT[e] + 255) >> 8; BASE[e] += ps; if (F.blk == 0) for (int i = 0; i < tl; ++i) tilee[nt + i] = e; ps += tl * 256; nt += tl; }
        if (F.blk == 0) ntiles[slot] = nt; }
    __syncthreads();
    const int tpb = NTOK / F.G;
    for (int i = wave; i < tpb; i += NWAVES) { const int t = F.blk * tpb + i; const int e = tope[2 * t + slot]; const int dest = BASE[e] + rank[2 * t + slot];
        if (lane == 0) { rowtok[dest] = t; rowgate[dest] = gate[2 * t + slot]; rowrstd[dest] = rstd[t]; }
        const u32x4* s = (const u32x4*)(hb + (size_t)t * DM) + lane; u32x4* d = (u32x4*)(asort + (size_t)dest * DM) + lane;
        const u32x4 a = s[0], c = s[64]; d[0] = a; d[64] = c; }
}

#ifndef MK_PER_PHASE
#define MK_PER_PHASE 0
#endif
constexpr int N_PHASES = 17;
__global__ void __launch_bounds__(NTHREADS, 2) mk_fwd(Params prm) {
    extern __shared__ __attribute__((aligned(16))) unsigned char lds_raw[];
    Frame F;
    F.lds = (LAS unsigned char*)lds_raw;
    F.blk = blockIdx.x; F.G = gridDim.x; F.out = prm.out; F.ws = prm.ws;
    volatile LAS unsigned* MISC = (volatile LAS unsigned*)(F.lds + MISC_OFF);
    for (int u = threadIdx.x; u < (LDS_BYTES - LDSCTL_OFF) / 4; u += NTHREADS) ((LAS unsigned*)(F.lds + LDSCTL_OFF))[u] = 0u;
    __syncthreads();
    if (threadIdx.x == 0) { LAS unsigned long long* tab = (LAS unsigned long long*)(F.lds + PTAB_OFF);
#pragma unroll
        for (int i_ = 0; i_ < 33; ++i_) tab[i_] = (unsigned long long)prm.in[i_]; }
    __syncthreads();
    const int lo = prm.ph_lo, hi = prm.ph_hi;
    unsigned* ctl = (unsigned*)(F.ws + WS_CTL);
    XcdBarrier bar; bar.bar = ctl + CW_BAR; bar.x = 0; bar.st = nullptr;
    if (hi - lo > 1) bar = xcd_barrier_post(ctl + CW_BAR, MISC + 8);
    unsigned char* ws = F.ws;
    bf16* hb = (bf16*)(ws + WS_HB); bf16* z = (bf16*)(ws + WS_Z); bf16* act = (bf16*)(ws + WS_Z); bf16* y = (bf16*)(ws + WS_Y); bf16* asort = (bf16*)(ws + WS_Y);
    float* ssq = (float*)(ws + WS_SSQ); bf16* opart = (bf16*)(ws + WS_OP); float* lse = (float*)(ws + WS_LSE);
    unsigned char* rt = ws + WS_RT;
#define IN(k) (lo <= (k) && (k) < hi)
#define SEAM(k) do { if (IN(k) && IN((k) + 1)) xcd_barrier(bar); } while (0)

    if (IN(0)) p0_prologue(F);
    SEAM(0);
#pragma unroll 1
    for (int layer = 0; layer < 2; ++layer) {
        const int pb = layer == 0 ? 1 : 7;
        if (IN(pb)) {
            pg8::Gemm g{hb, (const bf16*)(ws + WS_WIN) + (size_t)layer * NPADW * DM, NTOK, NPADW, DM}; pg8::StaticOrder S; S.init(NTOK / 256, NPADW / 256, F.G, F.blk);
            pg8::EpiZ E{z, INW, INW, ssq};
            pg8::gemm_phase<pg8::EpiZ, pg8::StaticOrder, true, true>(F.lds, g, S, E);
        }
        SEAM(pb);
        if (IN(pb + 1)) {
            if (F.blk < 32) {
                RwkvP P{inptr(F, IN_MU) + layer * 896, inptr(F, IN_W0) + layer * 256, inptr(F, IN_W2) + layer * 32 * 256, inptr(F, IN_A0) + layer * 256, inptr(F, IN_A2) + layer * 32 * 256, inptr(F, IN_G2) + layer * 64 * 256,
                        inptr(F, IN_KK) + layer * 256, inptr(F, IN_KA) + layer * 256, inptr(F, IN_RK) + layer * 256, inptr(F, IN_RLG) + layer * 256, inptr(F, IN_RLB) + layer * 256};
                rwkv_chain(F, z, y, P, F.blk >> 2, F.blk & 3);
            } else if (F.blk < 64) {
                gla_chain(F, z, y, inptr(F, IN_GG2) + layer * 16 * 128, inptr(F, IN_GGB) + layer * 128, inptr(F, IN_GNG) + layer * 64, (F.blk - 32) >> 2, (F.blk - 32) & 3);
            } else {
                const int wi = F.blk - 64, nw = F.G - 64;
                for (int tile = wi; tile < 3072; tile += nw) attn_tile(F.lds, z, opart, lse, inptr(F, IN_RELB), inptr(F, IN_QG) + layer * 64, inptr(F, IN_KG) + layer * 64, tile, mytid());
                for (int item = wi; item < 512; item += nw) conv_item(F, z, y, inptr(F, IN_CW) + layer * 31 * 256, inptr(F, IN_CB) + layer * 256, inptr(F, IN_CLG) + layer * 256, inptr(F, IN_CLB) + layer * 256, item);
            }
        }
        SEAM(pb + 1);
        if (IN(pb + 2)) attn_merge(F, opart, lse, y);
        SEAM(pb + 2);
        if (IN(pb + 3)) {
            pg8::Gemm g{y, (const bf16*)(ws + WS_WOUT) + (size_t)layer * DM * DM, NTOK, DM, DM}; pg8::StaticOrder S; S.init(NTOK / 256, DM / 256, F.G, F.blk);
            pg8::EpiRes E{layer == 0 ? inptr(F, IN_X) : (const float*)F.out, F.out, hb, ssq};
            pg8::gemm_phase<pg8::EpiRes, pg8::StaticOrder, true, true>(F.lds, g, S, E);
        }
        SEAM(pb + 3);
        if (layer == 0) {
            if (IN(5)) {
                pg8::Gemm g{hb, (const bf16*)(ws + WS_WGU), NTOK, 2 * DFF, DM}; pg8::StaticOrder S; S.init(NTOK / 256, 2 * DFF / 256, F.G, F.blk);
                pg8::EpiSwiGLU<false> E{act, ssq, nullptr};
                pg8::gemm_phase<pg8::EpiSwiGLU<false>, pg8::StaticOrder, true, true>(F.lds, g, S, E);
            }
            SEAM(5);
            if (IN(6)) {
                pg8::Gemm g{act, (const bf16*)(ws + WS_WD), NTOK, DM, DFF}; pg8::StaticOrder S; S.init(NTOK / 256, DM / 256, F.G, F.blk);
                pg8::EpiRes E{F.out, F.out, hb, ssq};
                pg8::gemm_phase<pg8::EpiRes, pg8::StaticOrder, true, true>(F.lds, g, S, E);
            }
            SEAM(6);
        }
    }
    if (IN(11)) moe_route(F, F.out, inptr(F, IN_FFNG) + DM, inptr(F, IN_ROUTER));
    SEAM(11);
    if (IN(12)) moe_gather(F, 0, hb, asort);
    SEAM(12);
#pragma unroll 1
    for (int slot = 0; slot < 2; ++slot) {
        const int pg = 13 + 2 * slot;
        const int* tilee = (const int*)(rt + RT_TILEE) + slot * 256;
        if (IN(pg)) {
            const int nt = __builtin_amdgcn_readfirstlane(((const int*)(rt + RT_NTILES))[slot]);
            pg8::Gemm g{asort, (const bf16*)(ws + WS_MOEW), nt * 256, 2 * DFF, DM}; pg8::StaticOrder S; S.init(nt, 2 * DFF / 256, F.G, F.blk, tilee, MOEW_E_BYTES);
            pg8::EpiSwiGLU<true> E{act, nullptr, (const float*)(rt + RT_ROWRSTD) + slot * MOE_ROWS};
            pg8::gemm_phase<pg8::EpiSwiGLU<true>, pg8::StaticOrder, true, true>(F.lds, g, S, E);
        }
        SEAM(pg);
        if (IN(pg + 1)) {
            const int nt = __builtin_amdgcn_readfirstlane(((const int*)(rt + RT_NTILES))[slot]);
            pg8::Gemm g{act, (const bf16*)(ws + WS_MOEW + MOEW_GU_BYTES), nt * 256, DM, DFF}; pg8::StaticOrder S; S.init(nt, DM / 256, F.G, F.blk, tilee, MOEW_E_BYTES);
            pg8::EpiMoeDown E{F.out, (const int*)(rt + RT_ROWTOK) + slot * MOE_ROWS, (const float*)(rt + RT_ROWGATE) + slot * MOE_ROWS};
            pg8::gemm_phase<pg8::EpiMoeDown, pg8::StaticOrder, true, true>(F.lds, g, S, E);
            if (slot == 0) moe_gather(F, 1, hb, asort);
        }
        if (slot == 0) SEAM(pg + 1);
    }
#undef IN
#undef SEAM
}

extern "C" void kernel_launch(void* const* d_in, const int* in_sizes, int n_in, void* d_out, int out_size, void* d_ws, size_t ws_size, hipStream_t stream) {
    static int grid = 0;
    if (grid == 0) {
        if (n_in != 33 || out_size != NTOK * DM || ws_size < WS_END) { fprintf(stderr, "kernel_launch: unexpected problem (n_in %d out %d ws %zu)\n", n_in, out_size, ws_size); grid = -1; return; }
        int dev = 0, cus = 0;
        if (hipGetDevice(&dev) != hipSuccess || hipDeviceGetAttribute(&cus, hipDeviceAttributeMultiprocessorCount, dev) != hipSuccess) { grid = -1; return; }
        if (hipFuncSetAttribute((const void*)mk_fwd, hipFuncAttributeMaxDynamicSharedMemorySize, LDS_BYTES) != hipSuccess) { fprintf(stderr, "kernel_launch: hipFuncSetAttribute failed\n"); grid = -1; return; }
        (void)hipGetLastError();
        grid = cus;
        if (grid != 256) fprintf(stderr, "kernel_launch: %d CUs (built for 256)\n", grid);
    }
    if (grid < 0) return;
    (void)hipMemsetAsync((char*)d_ws + WS_CTL, 0, CTL_ZERO_BYTES, stream);
    Params p{};
    for (int i = 0; i < 33; ++i) p.in[i] = (const float*)d_in[i];
    p.out = (float*)d_out; p.ws = (unsigned char*)d_ws;
#if MK_PER_PHASE
    for (int k = 0; k < N_PHASES; ++k) { p.ph_lo = k; p.ph_hi = k + 1; hipLaunchKernelGGL(mk_fwd, dim3(grid), dim3(NTHREADS), LDS_BYTES, stream, p); }
#else
    p.ph_lo = 0; p.ph_hi = N_PHASES;
    hipLaunchKernelGGL(mk_fwd, dim3(grid), dim3(NTHREADS), LDS_BYTES, stream, p);
#endif
}
```

```cpp
#include <hip/hip_runtime.h>
#include <cstdio>
#include <cstdint>

#define LAS __attribute__((address_space(3)))
#define GAS __attribute__((address_space(1)))
typedef unsigned short bf16;
typedef short bf16x8 __attribute__((ext_vector_type(8)));
typedef short s16x4 __attribute__((ext_vector_type(4)));
typedef float f32x4 __attribute__((ext_vector_type(4)));
typedef float f32x2 __attribute__((ext_vector_type(2)));
typedef unsigned u32x4 __attribute__((ext_vector_type(4)));
typedef unsigned u32x2 __attribute__((ext_vector_type(2)));

constexpr int DM = 1024, NB = 8, SEQ = 4096, NTOK = NB * SEQ, INW = 2960, NPADW = 3072, DFF = 2816, NEXP = 8;
constexpr int ZA = 0, ZB = 768, ZC = 1280, ZD = 2176;
constexpr float NORM_EPS = 1e-6f;
constexpr int MOE_ROWS = NTOK + NEXP * 256;

constexpr size_t MiB = 1u << 20;
constexpr size_t WS_CTL = 0, CTL_ZERO_BYTES = 64 * 1024;
constexpr size_t WS_WIN = 1 * MiB;
constexpr size_t WS_WOUT = 13 * MiB;
constexpr size_t WS_WGU = 17 * MiB;
constexpr size_t WS_WD = 28 * MiB;
constexpr size_t WS_SSQ = 34 * MiB;
constexpr size_t WS_RT = 36 * MiB;
constexpr size_t WS_HB = 40 * MiB;
constexpr size_t WS_Z = 104 * MiB;
constexpr size_t WS_Y = 297 * MiB;
constexpr size_t WS_MOEW = 367 * MiB;
constexpr size_t WS_END = 499 * MiB;
constexpr size_t MOEW_GU_BYTES = (size_t)2 * DFF * DM * 2, MOEW_D_BYTES = (size_t)DM * DFF * 2, MOEW_E_BYTES = MOEW_GU_BYTES + MOEW_D_BYTES;
static_assert(WS_Z + (size_t)MOE_ROWS * DFF * 2 <= WS_Y && WS_Y + (size_t)MOE_ROWS * DM * 2 <= WS_MOEW && WS_MOEW + NEXP * MOEW_E_BYTES <= WS_END, "ws map");
constexpr size_t WS_OP = WS_HB;
constexpr size_t WS_LSE = WS_HB + 48 * MiB;
constexpr size_t RT_TOPE = 0;
constexpr size_t RT_GATE = RT_TOPE + (size_t)NTOK * 8;
constexpr size_t RT_RANK = RT_GATE + (size_t)NTOK * 8;
constexpr size_t RT_RSTD = RT_RANK + (size_t)NTOK * 8;
constexpr size_t RT_HIST = RT_RSTD + (size_t)NTOK * 4;
constexpr size_t RT_ROWTOK = RT_HIST + 256 * 16 * 4;
constexpr size_t RT_ROWGATE = RT_ROWTOK + (size_t)2 * MOE_ROWS * 4;
constexpr size_t RT_ROWRSTD = RT_ROWGATE + (size_t)2 * MOE_ROWS * 4;
constexpr size_t RT_TILEE = RT_ROWRSTD + (size_t)2 * MOE_ROWS * 4;
constexpr size_t RT_NTILES = RT_TILEE + 2 * 256 * 4;
static_assert(RT_NTILES + 64 <= 4 * MiB, "routing arrays");

constexpr int CW_BAR = 1024;

constexpr int RING_BYTES = 131072, LDSCTL_OFF = RING_BYTES, MISC_OFF = LDSCTL_OFF + 320, LDS_BYTES = 147456;
constexpr int NWAVES = 8, NTHREADS = 512;

#define LDS_WAIT() asm volatile("s_waitcnt lgkmcnt(0)" ::: "memory")
#define VM_WAIT() asm volatile("s_waitcnt vmcnt(0)" ::: "memory")
#define BAR() do { asm volatile("s_waitcnt lgkmcnt(0)" ::: "memory"); __builtin_amdgcn_s_barrier(); asm volatile("" ::: "memory"); } while (0)
__device__ __forceinline__ unsigned f2bf(float f) { unsigned u = __builtin_bit_cast(unsigned, f); return (u + 0x7fffu + ((u >> 16) & 1u)) >> 16; }
__device__ __forceinline__ unsigned pk2(float lo, float hi) { return f2bf(lo) | (f2bf(hi) << 16); }
__device__ __forceinline__ float bflo(unsigned w) { return __builtin_bit_cast(float, w << 16); }
__device__ __forceinline__ float bfhi(unsigned w) { return __builtin_bit_cast(float, w & 0xffff0000u); }
__device__ __forceinline__ float bf1(bf16 b) { return __builtin_bit_cast(float, (unsigned)b << 16); }
__device__ __forceinline__ float wave_sum(float v) {
#pragma unroll
    for (int o = 1; o < 64; o <<= 1) v += __shfl_xor(v, o);
    return v;
}
#define DPP_ADD(v, ctrl) ((v) + __builtin_bit_cast(float, __builtin_amdgcn_update_dpp(0, __builtin_bit_cast(int, (v)), (ctrl), 0xf, 0xf, true)))
__device__ __forceinline__ float red8(float v) { v = DPP_ADD(v, 0xB1); v = DPP_ADD(v, 0x4E); v = DPP_ADD(v, 0x141); return v; }
__device__ __forceinline__ float red16(float v) { v = DPP_ADD(v, 0xB1); v = DPP_ADD(v, 0x4E); v = DPP_ADD(v, 0x141); v = DPP_ADD(v, 0x140); return v; }
__device__ __forceinline__ float sigmoidf_(float x) { return 1.0f / (1.0f + __expf(-x)); }
__device__ __forceinline__ float siluf_(float x) { return x / (1.0f + __expf(-x)); }
__device__ __forceinline__ float softplusf_(float x) { return fmaxf(x, 0.f) + __logf(1.0f + __expf(-fabsf(x))); }
__device__ __forceinline__ float tanhf_(float x) { const float e = __expf(2.0f * x); return 1.0f - 2.0f / (e + 1.0f); }
__device__ __forceinline__ void unpack8(const u32x4 w, float (&f)[8]) {
    f[0] = bflo(w.x); f[1] = bfhi(w.x); f[2] = bflo(w.y); f[3] = bfhi(w.y); f[4] = bflo(w.z); f[5] = bfhi(w.z); f[6] = bflo(w.w); f[7] = bfhi(w.w);
}

namespace pg8 {
#define PG8_LAS __attribute__((address_space(3)))
typedef unsigned short bf16_t;
constexpr int BM = 256, BK = 64, HALF = 128, HTB = HALF * BK * 2  , STAGE_BYTES = 8 * HTB, NXCD = 8, WGM = 8;

__host__ __device__ __forceinline__ int lds_byte(int r, int c) { const int st = (r >> 4) * 2 + (c >> 5), rr = r & 15, cc = c & 31, ob = rr * 64 + cc * 2; return st * 1024 + (ob ^ (((ob >> 9) & 1) << 5)); }
__host__ __device__ __forceinline__ void stage_rc(int b, int& R, int& C) { const int st = b / 1024, sb = b % 1024, swz = sb ^ (((sb >> 9) & 1) << 5); R = (st >> 1) * 16 + swz / 64; C = (st & 1) * 32 + (swz % 64) / 2; }
__host__ __device__ __forceinline__ int perm32(int rho) { const int n = rho >> 4, i = rho & 15; return 8 * (i >> 2) + 4 * n + (i & 3); }

struct Unit { int pm, pn; };
struct Gemm { const bf16_t* A; const bf16_t* Bt; int M, N, K, wv; };

struct StaticOrder {
    int nM, nN, nwg, G, c; const int* tile_e; size_t estride;
    __device__ void init(int nM_, int nN_, int G_, int c_, const int* te = nullptr, size_t es = 0) { nM = nM_; nN = nN_; nwg = nM * nN; G = G_; c = c_; tile_e = te; estride = es; }
    __device__ bool next(int i, Unit& u) const {
        const long L = (long)i * G + c; if (L >= nwg) return false;
        int wgid = (int)L; { const int q = nwg / NXCD, r = nwg % NXCD, xcd = wgid % NXCD, off = wgid / NXCD; wgid = (xcd < r ? xcd * (q + 1) : r * (q + 1) + (xcd - r) * q) + off; }
        const int nig = WGM * nN, gid = wgid / nig, fm = gid * WGM, gsz = (nM - fm) < WGM ? (nM - fm) : WGM;
        u.pm = fm + ((wgid % nig) % gsz); u.pn = (wgid % nig) / gsz; return true;
    }
    __device__ __forceinline__ size_t bofs(const Unit& u, size_t tstep) const { return (size_t)u.pn * tstep + (tile_e ? (size_t)__builtin_amdgcn_readfirstlane(tile_e[u.pm]) * estride : (size_t)0); }
    __device__ __forceinline__ void a_ready(const Unit&) const {}
    __device__ __forceinline__ void done(const Unit&) const {}
};

__device__ __forceinline__ unsigned cvt_pk_bf16(float lo, float hi) { unsigned r; asm volatile("v_cvt_pk_bf16_f32 %0, %1, %2" : "=v"(r) : "v"(lo), "v"(hi)); return r; }

__device__ __forceinline__ float row_rstd16(const float* ssq, int r, int fq) {
    const f32x4 p = *(const f32x4*)(ssq + (size_t)r * 16 + 4 * fq);
    float s = (p[0] + p[1]) + (p[2] + p[3]); s += __shfl_xor(s, 16); s += __shfl_xor(s, 32);
    return __builtin_amdgcn_rsqf(s * (1.0f / DM) + NORM_EPS);
}

struct EpiZ {
    static constexpr bool PERM = true, AFTER_DRAIN = false;
    bf16_t* Z; int ldc, ncols; const float* ssq;
    __device__ __forceinline__ void operator()(const f32x4 (&acc)[2][2][4][2], const Unit& u, int wr, int wc, int fr, int fq) const {
        const int row0 = u.pm * BM + wr * 64 + fr, col0 = u.pn * BM + wc * 32 + 8 * fq;
#pragma unroll
        for (int ai = 0; ai < 2; ++ai)
#pragma unroll
            for (int m = 0; m < 4; ++m) { const int r = row0 + ai * HALF + m * 16; const float rs = row_rstd16(ssq, r, fq); bf16_t* rowp = Z + (size_t)r * ldc + col0;
#pragma unroll
                for (int bj = 0; bj < 2; ++bj) { const f32x4 v0 = acc[ai][bj][m][0] * rs, v1 = acc[ai][bj][m][1] * rs;
                    u32x4 w; w.x = cvt_pk_bf16(v0[0], v0[1]); w.y = cvt_pk_bf16(v0[2], v0[3]); w.z = cvt_pk_bf16(v1[0], v1[1]); w.w = cvt_pk_bf16(v1[2], v1[3]);
                    if (col0 + bj * HALF < ncols) *(u32x4*)(rowp + bj * HALF) = w; } }
    }
};
template <bool MOE> struct EpiSwiGLU {
    static constexpr bool PERM = true, AFTER_DRAIN = false;
    bf16_t* O; const float* ssq; const float* row_rstd;
    __device__ __forceinline__ void operator()(const f32x4 (&acc)[2][2][4][2], const Unit& u, int wr, int wc, int fr, int fq) const {
        const int row0 = u.pm * BM + wr * 64 + fr, col0 = u.pn * HALF + wc * 32 + 8 * fq;
#pragma unroll
        for (int ai = 0; ai < 2; ++ai)
#pragma unroll
            for (int m = 0; m < 4; ++m) { const int r = row0 + ai * HALF + m * 16; float rs; if (MOE) rs = row_rstd[r]; else rs = row_rstd16(ssq, r, fq);
                const f32x4 g0 = acc[ai][0][m][0] * rs, g1 = acc[ai][0][m][1] * rs, u0 = acc[ai][1][m][0] * rs, u1 = acc[ai][1][m][1] * rs; f32x4 a0, a1;
#pragma unroll
                for (int j = 0; j < 4; ++j) { a0[j] = g0[j] * __builtin_amdgcn_rcpf(1.0f + __expf(-g0[j])) * u0[j]; a1[j] = g1[j] * __builtin_amdgcn_rcpf(1.0f + __expf(-g1[j])) * u1[j]; }
                u32x4 w; w.x = cvt_pk_bf16(a0[0], a0[1]); w.y = cvt_pk_bf16(a0[2], a0[3]); w.z = cvt_pk_bf16(a1[0], a1[1]); w.w = cvt_pk_bf16(a1[2], a1[3]);
                *(u32x4*)(O + (size_t)r * DFF + col0) = w; }
    }
};
struct EpiRes {
    static constexpr bool PERM = false, AFTER_DRAIN = false;
    const float* base; float* out; bf16_t* hb; float* ssq;
    __device__ __forceinline__ void operator()(const f32x4 (&acc)[2][2][4][2], const Unit& u, int wr, int wc, int fr, int fq) const {
        const int col0 = u.pn * BM + wc * 32 + 4 * fq;
#pragma unroll
        for (int ai = 0; ai < 2; ++ai)
#pragma unroll
            for (int m = 0; m < 4; ++m) { const int r = u.pm * BM + ai * HALF + wr * 64 + m * 16 + fr; const size_t off = (size_t)r * DM + col0; float ss = 0.f;
#pragma unroll
                for (int bj = 0; bj < 2; ++bj)
#pragma unroll
                    for (int n = 0; n < 2; ++n) { const f32x4 v = *(const f32x4*)(base + off + bj * HALF + n * 16) + acc[ai][bj][m][n];
                        *(f32x4*)(out + off + bj * HALF + n * 16) = v; ss += (v[0] * v[0] + v[1] * v[1]) + (v[2] * v[2] + v[3] * v[3]);
                        if (hb) { u32x2 w; w.x = cvt_pk_bf16(v[0], v[1]); w.y = cvt_pk_bf16(v[2], v[3]); *(u32x2*)(hb + off + bj * HALF + n * 16) = w; } }
                ss += __shfl_xor(ss, 16); ss += __shfl_xor(ss, 32);
                if (ssq && fq == 0) ssq[(size_t)r * 16 + u.pn * 4 + wc] = ss;
                if (m & 1) asm volatile("" ::: "memory"); }
    }
};
struct EpiMoeDown {
    static constexpr bool PERM = false, AFTER_DRAIN = false;
    float* out; const int* row_tok; const float* row_gate;
    __device__ __forceinline__ void operator()(const f32x4 (&acc)[2][2][4][2], const Unit& u, int wr, int wc, int fr, int fq) const {
        const int col0 = u.pn * BM + wc * 32 + 4 * fq;
#pragma unroll
        for (int ai = 0; ai < 2; ++ai)
#pragma unroll
            for (int m = 0; m < 4; ++m) { const int r = u.pm * BM + ai * HALF + wr * 64 + m * 16 + fr; const int tok = row_tok[r]; const float gt = row_gate[r];
                if (tok >= 0) { float* op = out + (size_t)tok * DM + col0;
#pragma unroll
                    for (int bj = 0; bj < 2; ++bj)
#pragma unroll
                        for (int n = 0; n < 2; ++n) { float* p = op + bj * HALF + n * 16; *(f32x4*)p = *(const f32x4*)p + acc[ai][bj][m][n] * gt; } }
                if (m & 1) asm volatile("" ::: "memory"); }
    }
};

template <class Epi, class Sched, bool ALIGN_EPI = false, bool SP2 = false>
__device__ __forceinline__ void gemm_phase(PG8_LAS unsigned char* lds, const Gemm g, const Sched& S, const Epi& E) {
    int tid_ = g.wv * 64 + (int)__builtin_amdgcn_mbcnt_hi(~0u, __builtin_amdgcn_mbcnt_lo(~0u, 0u)); asm volatile("" : "+v"(tid_));
    const int tid = tid_, wid = __builtin_amdgcn_readfirstlane(tid >> 6), lane = tid & 63, wr = wid >> 2, wc = wid & 3, fr = lane & 15, fq = lane >> 4;
    const int K = g.K, nt = K / BK;
    unsigned voffA[2], voffB[2];
#pragma unroll
    for (int i = 0; i < 2; ++i) { int R, C; stage_rc(tid * 16 + i * 8192, R, C); const int Rb = Epi::PERM ? ((R & ~31) + perm32(R & 31)) : R;
        voffA[i] = (unsigned)(R * K + C) * 2u; voffB[i] = (unsigned)(Rb * K + C) * 2u; }
    const size_t kstep = (size_t)(BK * 2);
    const size_t hstep = (size_t)HALF * K * 2;
    const size_t tstep = 2 * hstep;
    const unsigned ldsw = (unsigned)wid * 1024u;
    const int aoff = lds_byte(wr * 64 + fr, fq * 8), boff = lds_byte(wc * 32 + fr, fq * 8);
#define PG8_SA(b, h) (((b) * 2 + (h)) * HTB)
#define PG8_SB(b, h) ((4 + (b) * 2 + (h)) * HTB)
#define PG8_STAGE(bufoff, gbase, voff) do { _Pragma("unroll") for (int _i = 0; _i < 2; ++_i) \
        __builtin_amdgcn_global_load_lds((const unsigned*)((const char*)(gbase) + (voff)[_i]), (PG8_LAS unsigned*)(lds + (bufoff) + ldsw + _i * 8192), 16, 0, 0); } while (0)
#define PG8_LDA(dst, b, h) do { _Pragma("unroll") for (int m = 0; m < 4; ++m) _Pragma("unroll") for (int k = 0; k < 2; ++k) dst[m][k] = *(const PG8_LAS bf16x8*)(lds + PG8_SA(b, h) + aoff + m * 2048 + k * 1024); } while (0)
#define PG8_LDB(dst, b, h) do { _Pragma("unroll") for (int n = 0; n < 2; ++n) _Pragma("unroll") for (int k = 0; k < 2; ++k) dst[n][k] = *(const PG8_LAS bf16x8*)(lds + PG8_SB(b, h) + boff + n * 2048 + k * 1024); } while (0)
#define PG8_MMA(ai, bj, At, Bt) do { __builtin_amdgcn_s_setprio(1); _Pragma("unroll") for (int m = 0; m < 4; ++m) _Pragma("unroll") for (int n = 0; n < 2; ++n) _Pragma("unroll") for (int k = 0; k < 2; ++k) \
        acc[ai][bj][m][n] = __builtin_amdgcn_mfma_f32_16x16x32_bf16(Bt[n][k], At[m][k], acc[ai][bj][m][n], 0, 0, 0); __builtin_amdgcn_s_setprio(0); } while (0)
#define PG8_WAIT_V(n) asm volatile("s_waitcnt vmcnt(" #n ")" ::: "memory")
#define PG8_WAIT_L(n) asm volatile("s_waitcnt lgkmcnt(" #n ")" ::: "memory")
#define PG8_BAR __builtin_amdgcn_s_barrier()
#define PG8_SCHED __builtin_amdgcn_sched_barrier(0)
    Unit cur, nxt; int ui = 0;
    if (!S.next(0, cur)) return;
    f32x4 acc[2][2][4][2];
#pragma unroll
    for (int a = 0; a < 2; ++a)
#pragma unroll
        for (int b = 0; b < 2; ++b)
#pragma unroll
            for (int m = 0; m < 4; ++m)
#pragma unroll
                for (int n = 0; n < 2; ++n) acc[a][b][m][n] = (f32x4){0.f, 0.f, 0.f, 0.f};
    bf16x8 At[4][2], B0[2][2], B1[2][2];
    const char* cA = (const char*)g.A + (size_t)cur.pm * tstep; const char* cB = (const char*)g.Bt + S.bofs(cur, tstep);
    S.a_ready(cur);
    if constexpr (SP2) {
        PG8_STAGE(PG8_SB(0, 0), cB, voffB); PG8_STAGE(PG8_SB(0, 1), cB + hstep, voffB); PG8_STAGE(PG8_SA(0, 0), cA, voffA); PG8_STAGE(PG8_SA(0, 1), cA + hstep, voffA);
        if (wr == 1) PG8_BAR;
        PG8_WAIT_V(2); PG8_BAR;
        PG8_STAGE(PG8_SB(1, 0), cB + kstep, voffB); PG8_STAGE(PG8_SA(1, 0), cA + kstep, voffA); PG8_STAGE(PG8_SB(1, 1), cB + hstep + kstep, voffB);
        PG8_WAIT_V(6); PG8_BAR;
    } else {
        PG8_STAGE(PG8_SB(0, 0), cB, voffB); PG8_STAGE(PG8_SA(0, 0), cA, voffA); PG8_STAGE(PG8_SB(0, 1), cB + hstep, voffB); PG8_STAGE(PG8_SA(0, 1), cA + hstep, voffA);
        if (wr == 1) PG8_BAR;
        PG8_WAIT_V(4); PG8_BAR;
        PG8_STAGE(PG8_SB(1, 0), cB + kstep, voffB); PG8_STAGE(PG8_SA(1, 0), cA + kstep, voffA); PG8_STAGE(PG8_SB(1, 1), cB + hstep + kstep, voffB);
        PG8_WAIT_V(6); PG8_BAR;
    }
    for (;;) {
        const bool has_next = S.next(ui + 1, nxt);
        const char* nA = has_next ? (const char*)g.A + (size_t)nxt.pm * tstep : cA; const char* nB = has_next ? (const char*)g.Bt + S.bofs(nxt, tstep) : cB;
        for (int t = 0; t < nt; t += 2) {
            const bool last = (t == nt - 2);
            const char* a1 = cA + (size_t)(t + 1) * kstep;
            const char* a2 = last ? nA : cA + (size_t)(t + 2) * kstep; const char* b2 = last ? nB : cB + (size_t)(t + 2) * kstep;
            const char* a3 = a2 + kstep; const char* b3 = b2 + kstep;
            if (last && has_next) S.a_ready(nxt);
            if constexpr (SP2) {
            PG8_LDB(B0, 0, 0); PG8_LDB(B1, 0, 1); PG8_SCHED; PG8_LDA(At, 0, 0); PG8_STAGE(PG8_SA(1, 1), a1 + hstep, voffA);
            PG8_WAIT_V(8); PG8_WAIT_L(0); PG8_BAR; PG8_MMA(0, 0, At, B0); PG8_MMA(0, 1, At, B1); PG8_BAR; PG8_SCHED;
            PG8_LDA(At, 0, 1); PG8_STAGE(PG8_SB(0, 0), b2, voffB); PG8_STAGE(PG8_SB(0, 1), b2 + hstep, voffB); PG8_STAGE(PG8_SA(0, 0), a2, voffA);
            PG8_WAIT_V(8); PG8_WAIT_L(0); PG8_BAR; PG8_MMA(1, 0, At, B0); PG8_MMA(1, 1, At, B1); PG8_BAR; PG8_SCHED;
            PG8_LDB(B0, 1, 0); PG8_LDB(B1, 1, 1); PG8_SCHED; PG8_LDA(At, 1, 0); PG8_STAGE(PG8_SA(0, 1), a2 + hstep, voffA);
            PG8_WAIT_V(8); PG8_WAIT_L(0); PG8_BAR; PG8_MMA(0, 0, At, B0); PG8_MMA(0, 1, At, B1); PG8_BAR; PG8_SCHED;
            PG8_LDA(At, 1, 1); PG8_STAGE(PG8_SB(1, 0), b3, voffB); PG8_STAGE(PG8_SB(1, 1), b3 + hstep, voffB); PG8_STAGE(PG8_SA(1, 0), a3, voffA);
            PG8_WAIT_V(8); PG8_WAIT_L(0); PG8_BAR; PG8_MMA(1, 0, At, B0); PG8_MMA(1, 1, At, B1); PG8_BAR; PG8_SCHED;
            } else {
            PG8_LDB(B0, 0, 0); PG8_SCHED; PG8_LDA(At, 0, 0); PG8_STAGE(PG8_SA(1, 1), a1 + hstep, voffA);
            PG8_WAIT_L(8); PG8_BAR; PG8_WAIT_L(0); PG8_MMA(0, 0, At, B0); PG8_BAR; PG8_SCHED;
            PG8_LDB(B1, 0, 1); PG8_STAGE(PG8_SB(0, 0), b2, voffB);
            PG8_BAR; PG8_WAIT_L(0); PG8_MMA(0, 1, At, B1); PG8_BAR;
            PG8_LDA(At, 0, 1); PG8_STAGE(PG8_SA(0, 0), a2, voffA);
            PG8_BAR; PG8_WAIT_L(0); PG8_MMA(1, 0, At, B0); PG8_BAR; PG8_SCHED;
            PG8_STAGE(PG8_SB(0, 1), b2 + hstep, voffB);
            PG8_WAIT_V(6); PG8_BAR; PG8_MMA(1, 1, At, B1); PG8_BAR;
            PG8_LDB(B0, 1, 0); PG8_SCHED; PG8_LDA(At, 1, 0); PG8_STAGE(PG8_SA(0, 1), a2 + hstep, voffA);
            PG8_WAIT_L(8); PG8_BAR; PG8_WAIT_L(0); PG8_MMA(0, 0, At, B0); PG8_BAR; PG8_SCHED;
            PG8_LDB(B1, 1, 1); PG8_STAGE(PG8_SB(1, 0), b3, voffB);
            PG8_BAR; PG8_WAIT_L(0); PG8_MMA(0, 1, At, B1); PG8_BAR;
            PG8_LDA(At, 1, 1); PG8_STAGE(PG8_SA(1, 0), a3, voffA);
            PG8_BAR; PG8_WAIT_L(0); PG8_MMA(1, 0, At, B0); PG8_BAR; PG8_SCHED;
            PG8_STAGE(PG8_SB(1, 1), b3 + hstep, voffB);
            PG8_WAIT_V(6); PG8_BAR; PG8_MMA(1, 1, At, B1); PG8_BAR;
            }
        }
        if constexpr (ALIGN_EPI) { if (wr == 0) PG8_BAR; }
        if constexpr (!Epi::AFTER_DRAIN) { E(acc, cur, wr, wc, fr, fq); S.done(cur); }
        if (!has_next) break;
#pragma unroll
        for (int a = 0; a < 2; ++a)
#pragma unroll
            for (int b = 0; b < 2; ++b)
#pragma unroll
                for (int m = 0; m < 4; ++m)
#pragma unroll
                    for (int n = 0; n < 2; ++n) acc[a][b][m][n] = (f32x4){0.f, 0.f, 0.f, 0.f};
        cur = nxt; cA = nA; cB = nB; ++ui;
        if constexpr (ALIGN_EPI) { if (wr == 1) PG8_BAR; }
    }
    PG8_WAIT_V(0);
    if constexpr (!ALIGN_EPI) { if (wr == 0) PG8_BAR; }
    PG8_BAR;
    if constexpr (Epi::AFTER_DRAIN) { E.fused(acc, cur, wr, wc, fr, fq, lds, wid, lane); S.done(cur); }
#undef PG8_SA
#undef PG8_SB
#undef PG8_STAGE
#undef PG8_LDA
#undef PG8_LDB
#undef PG8_MMA
#undef PG8_WAIT_V
#undef PG8_WAIT_L
#undef PG8_BAR
#undef PG8_SCHED
}
}
#define XB_TMO      128
#define XB_XCNT(j)  (256  + 64 * (j))
#define XB_XSUB(j)  (1280 + 64 * (j))
#define XB_XGEN(j)  (2304 + 64 * (j))
#define XB_TOP      3328
#define XB_TOPGEN   3392
#define XCD_BAR_WORDS 3456
#define XB_SPIN_CAP (1u << 18)

__device__ __forceinline__ unsigned xb_ld(unsigned* p)              { return __hip_atomic_load(p, __ATOMIC_RELAXED, __HIP_MEMORY_SCOPE_AGENT); }
__device__ __forceinline__ unsigned xb_add(unsigned* p, unsigned v) { return __hip_atomic_fetch_add(p, v, __ATOMIC_RELAXED, __HIP_MEMORY_SCOPE_AGENT); }
__device__ __forceinline__ unsigned xb_xcc_id() { return (unsigned)__builtin_amdgcn_s_getreg((3 << 11) | 20) & 0xFu; }
#define XB_SPIN(cond, bar) do { unsigned _sp = 0; while (cond) { __builtin_amdgcn_s_sleep(1); \
    if ((++_sp & 255u) == 0u) { if (xb_ld(&(bar)[XB_TMO])) break; if (_sp > XB_SPIN_CAP) { atomicAdd(&(bar)[XB_TMO], 1u); break; } } } } while (0)

struct XcdBarrier {
    unsigned* bar; unsigned x;
    volatile LAS unsigned* st;
};

__device__ __forceinline__ XcdBarrier xcd_barrier_post(unsigned* bar, volatile LAS unsigned* st) {
    XcdBarrier b; b.bar = bar; b.x = xb_xcc_id(); b.st = st;
    if (threadIdx.x == 0) (void)xb_add(&bar[XB_XCNT(b.x)], 1u);
    return b;
}
__device__ __forceinline__ void xcd_barrier_complete(unsigned* bar, unsigned x, unsigned& nloc, unsigned& nx) {
    const unsigned G = gridDim.x * gridDim.y * gridDim.z;
    unsigned sum, cnt, mine, sp = 0u;
    for (;;) {
        sum = 0u; cnt = 0u; mine = 0u;
#pragma unroll
        for (unsigned j = 0; j < 16; ++j) { const unsigned c = xb_ld(&bar[XB_XCNT(j)]); sum += c; cnt += (c > 0u) ? 1u : 0u; mine = (j == x) ? c : mine; }
        if (sum == G) break;
        __builtin_amdgcn_s_sleep(1);
        if ((++sp & 255u) == 0u) { if (xb_ld(&bar[XB_TMO])) break; if (sp > XB_SPIN_CAP) { atomicAdd(&bar[XB_TMO], 1u); break; } }
    }
    nloc = mine > 0u ? mine : 1u; nx = cnt > 0u ? cnt : 1u;
}

__device__ __forceinline__ void xcd_barrier(const XcdBarrier& b) {
    asm volatile("s_waitcnt vmcnt(0)" ::: "memory");
    __syncthreads();
    if (threadIdx.x == 0) {
        unsigned* bar = b.bar;
        __builtin_amdgcn_s_waitcnt(0);
        unsigned nloc = b.st[0], nx = b.st[1];
        if (nloc == 0u) { xcd_barrier_complete(bar, b.x, nloc, nx); b.st[0] = nloc; b.st[1] = nx; }
        const unsigned old = xb_add(&bar[XB_XSUB(b.x)], 1u);
        const unsigned gen = old / nloc;
        if (old + 1u == (gen + 1u) * nloc) {
            __builtin_amdgcn_fence(__ATOMIC_RELEASE, "agent");
            asm volatile("s_waitcnt vmcnt(0)" ::: "memory");
            const unsigned og = xb_add(&bar[XB_TOP], 1u);
            const unsigned tg = og / nx;
            if (og + 1u == (tg + 1u) * nx) xb_add(&bar[XB_TOPGEN], 1u);
            else XB_SPIN(xb_ld(&bar[XB_TOPGEN]) == tg, bar);
            __builtin_amdgcn_fence(__ATOMIC_ACQUIRE, "agent");
            xb_add(&bar[XB_XGEN(b.x)], 1u);
            asm volatile("s_waitcnt vmcnt(0)" ::: "memory");
        } else {
            XB_SPIN(xb_ld(&bar[XB_XGEN(b.x)]) == gen, bar);
            __builtin_amdgcn_fence(__ATOMIC_ACQUIRE, "agent");
            asm volatile("s_waitcnt vmcnt(0)" ::: "memory");
        }
    }
    __syncthreads();
}

struct Params {
    const float* in[33];
    float* out; unsigned char* ws;
    int ph_lo, ph_hi;
};
struct Frame {
    LAS unsigned char* lds;
    int blk, G, wv;
    float* out; unsigned char* ws;
};
constexpr int PTAB_OFF = LDSCTL_OFF + 1024;
__device__ __forceinline__ int lane_id() { return (int)__builtin_amdgcn_mbcnt_hi(~0u, __builtin_amdgcn_mbcnt_lo(~0u, 0u)); }
__device__ __forceinline__ int mytid(const Frame& F) { int t = F.wv * 64 + lane_id(); asm volatile("" : "+v"(t)); return t; }
__device__ __forceinline__ const float* inptr(const Frame& F, int k) {
    volatile LAS unsigned* t = (volatile LAS unsigned*)(F.lds + PTAB_OFF) + 2 * k;
    const unsigned lo = __builtin_amdgcn_readfirstlane(t[0]), hi = __builtin_amdgcn_readfirstlane(t[1]);
    const GAS float* gp = (const GAS float*)(((unsigned long long)hi << 32) | (unsigned long long)lo);
    return (const float*)gp;
}
#define IN_X 0
#define IN_RELB 1
#define IN_MIXG 2
#define IN_WIN 3
#define IN_WOUT 4
#define IN_FFNG 5
#define IN_QG 6
#define IN_KG 7
#define IN_CW 8
#define IN_CB 9
#define IN_CLG 10
#define IN_CLB 11
#define IN_MU 12
#define IN_W0 13
#define IN_W2 14
#define IN_A0 15
#define IN_A2 16
#define IN_G2 17
#define IN_KK 18
#define IN_KA 19
#define IN_RK 20
#define IN_RLG 21
#define IN_RLB 22
#define IN_GG2 23
#define IN_GGB 24
#define IN_GNG 25
#define IN_FWG 26
#define IN_FWU 27
#define IN_FWD 28
#define IN_ROUTER 29
#define IN_MWG 30
#define IN_MWU 31
#define IN_MWD 32

__device__ __forceinline__ void p0_transpose_item(const float* W, int K, int N, int nblk, const float* gk, bf16* WT, int mode, LAS float* scr, int item, int lane) {
    const int kb = item / nblk, nb = item % nblk, k0 = 64 * kb, n0 = 32 * nb;
    const int n = n0 + (lane & 31);
#pragma unroll 8
    for (int i = 0; i < 32; ++i) { const int kk = 2 * i + (lane >> 5); float v = (n < N) ? W[(size_t)(k0 + kk) * N + n] : 0.f; if (gk) v *= gk[k0 + kk]; scr[kk * 33 + (lane & 31)] = v; }
    LDS_WAIT(); asm volatile("" ::: "memory");
    const int c = lane & 7;
    const int rowbase = (mode == 0) ? n0 : ((n0 >> 7) * 256 + (mode == 2 ? 128 : 0) + (n0 & 127));
#pragma unroll
    for (int j = 0; j < 4; ++j) { const int nn = (lane >> 3) + 8 * j; const LAS float* s = scr + (8 * c) * 33 + nn;
        u32x4 o; o.x = pk2(s[0 * 33], s[1 * 33]); o.y = pk2(s[2 * 33], s[3 * 33]); o.z = pk2(s[4 * 33], s[5 * 33]); o.w = pk2(s[6 * 33], s[7 * 33]);
        *(u32x4*)(WT + (size_t)(rowbase + nn) * K + k0 + 8 * c) = o; }
    LDS_WAIT(); asm volatile("" ::: "memory");
}
__device__ __forceinline__ void p0_prologue(Frame& F, const int part) {
    const int tid = mytid(F), lane = tid & 63, wave = __builtin_amdgcn_readfirstlane(tid >> 6); (void)lane; (void)wave;
    LAS float* scr = (LAS float*)(F.lds + wave * 16384);
    const int gw = F.blk * NWAVES + wave, NGW = F.G * NWAVES;
    constexpr int I_IN = 16 * 96, I_OUT = 16 * 32, I_GU = 16 * 88, I_D = 44 * 32, I_SET = 2 * I_GU + I_D;
    constexpr int NITEMS = 2 * I_IN + 2 * I_OUT + 9 * I_SET;
    unsigned char* ws = F.ws;
    constexpr int NPART0 = 2 * I_IN + 2 * I_OUT + I_SET;
    for (int it = (part == 0 ? 0 : NPART0) + gw; it < (part == 0 ? NPART0 : NITEMS); it += NGW) {
        int r = it;
        if (r < 2 * I_IN) { const int l = r / I_IN; r -= l * I_IN;
            p0_transpose_item(inptr(F, IN_WIN) + (size_t)l * DM * INW, DM, INW, 96, inptr(F, IN_MIXG) + l * DM, (bf16*)(ws + WS_WIN) + (size_t)l * NPADW * DM, 0, scr, r, lane); continue; }
        r -= 2 * I_IN;
        if (r < 2 * I_OUT) { const int l = r / I_OUT; r -= l * I_OUT;
            p0_transpose_item(inptr(F, IN_WOUT) + (size_t)l * DM * DM, DM, DM, 32, nullptr, (bf16*)(ws + WS_WOUT) + (size_t)l * DM * DM, 0, scr, r, lane); continue; }
        r -= 2 * I_OUT;
        const int set = r / I_SET; r -= set * I_SET;
        const float* wg = set == 0 ? inptr(F, IN_FWG) : inptr(F, IN_MWG) + (size_t)(set - 1) * DM * DFF;
        const float* wu = set == 0 ? inptr(F, IN_FWU) : inptr(F, IN_MWU) + (size_t)(set - 1) * DM * DFF;
        const float* wd = set == 0 ? inptr(F, IN_FWD) : inptr(F, IN_MWD) + (size_t)(set - 1) * DFF * DM;
        const float* gk = inptr(F, IN_FFNG) + (set == 0 ? 0 : DM);
        bf16* dgu = set == 0 ? (bf16*)(ws + WS_WGU) : (bf16*)(ws + WS_MOEW + (size_t)(set - 1) * MOEW_E_BYTES);
        bf16* dd = set == 0 ? (bf16*)(ws + WS_WD) : (bf16*)(ws + WS_MOEW + (size_t)(set - 1) * MOEW_E_BYTES + MOEW_GU_BYTES);
        if (r < I_GU) { p0_transpose_item(wg, DM, DFF, 88, gk, dgu, 1, scr, r, lane); continue; } r -= I_GU;
        if (r < I_GU) { p0_transpose_item(wu, DM, DFF, 88, gk, dgu, 2, scr, r, lane); continue; } r -= I_GU;
        p0_transpose_item(wd, DFF, DM, 32, nullptr, dd, 0, scr, r, lane);
    }
    if (part != 0) return;
    const float* x = inptr(F, IN_X); bf16* hb = (bf16*)(ws + WS_HB); float* ssq = (float*)(ws + WS_SSQ);
    for (int m = gw; m < NTOK; m += NGW) {
        const f32x4* xr = (const f32x4*)(x + (size_t)m * DM) + lane; f32x4 v[4]; float s = 0.f;
#pragma unroll
        for (int j = 0; j < 4; ++j) { v[j] = xr[64 * j]; s += (v[j][0] * v[j][0] + v[j][1] * v[j][1]) + (v[j][2] * v[j][2] + v[j][3] * v[j][3]); }
        s = wave_sum(s);
        u32x2* o8 = (u32x2*)(hb + (size_t)m * DM) + lane;
#pragma unroll
        for (int j = 0; j < 4; ++j) { u32x2 w; w.x = pk2(v[j][0], v[j][1]); w.y = pk2(v[j][2], v[j][3]); o8[64 * j] = w; }
        if (lane < 16) ssq[(size_t)m * 16 + lane] = (lane == 0) ? s : 0.f;
    }
}

__device__ const unsigned char T5B[3][132] = {
 {0,1,2,3,4,5,6,7,8,9,10,11,12,13,14,15,16,16,16,16,16,16,17,17,17,17,17,17,17,17,18,18,18,18,18,18,18,18,18,18,19,19,19,19,19,19,19,19,19,19,19,19,19,19,20,20,20,20,20,20,20,20,20,20,20,20,20,20,20,20,20,20,20,21,21,21,21,21,21,21,21,21,21,21,21,21,21,21,21,21,21,21,21,21,21,21,21,21,21,22,22,22,22,22,22,22,22,22,22,22,22,22,22,22,22,22,22,22,22,22,22,22,22,22,22,22,22,22,22,0,0,0},
 {0,4,8,12,16,16,17,17,18,18,19,19,19,19,20,20,20,20,20,21,21,21,21,21,21,22,22,22,22,22,22,22,22,22,23,23,23,23,23,23,23,23,23,23,23,23,24,24,24,24,24,24,24,24,24,24,24,24,24,24,24,24,25,25,25,25,25,25,25,25,25,25,25,25,25,25,25,25,25,25,25,25,25,26,26,26,26,26,26,26,26,26,26,26,26,26,26,26,26,26,26,26,26,26,26,26,26,26,26,26,26,26,26,27,27,27,27,27,27,27,27,27,27,27,27,27,27,27,27,0,0,0},
 {0,16,18,19,20,21,21,22,22,23,23,23,24,24,24,24,25,25,25,25,25,26,26,26,26,26,26,26,26,27,27,27,27,27,27,27,27,27,27,28,28,28,28,28,28,28,28,28,28,28,28,28,29,29,29,29,29,29,29,29,29,29,29,29,29,29,29,29,29,29,30,30,30,30,30,30,30,30,30,30,30,30,30,30,30,30,30,30,30,30,30,30,30,30,30,31,31,31,31,31,31,31,31,31,31,31,31,31,31,31,31,31,31,31,31,31,31,31,31,31,31,31,31,31,31,31,31,31,31,0,0,0}};

__device__ __forceinline__ void attn_tile(LAS unsigned char* lds, const bf16* Z, bf16* OP, float* LSE, const float* rel_bias, const float* qg, const float* kg, int tile, int tid) {
    const int lane = tid & 63, w = __builtin_amdgcn_readfirstlane(tid >> 6), fr = lane & 15, g = lane >> 4;
    const int br = tile >> 10, rem = tile & 1023, b = rem >> 7, h = (rem >> 5) & 3, sub = rem & 31;
    const int dsh = 2 * br, nbl = 32 >> dsh, r = sub >> (5 - dsh), n = sub & (nbl - 1);
    LAS unsigned char* Qs = lds;
    LAS unsigned char* Ks = lds + 16384;
    LAS unsigned char* Vt = lds + 49152;
    LAS float* BT = (LAS float*)(lds + 49152 + 33792);
    const size_t zrow0 = (size_t)b * SEQ;
    if (tid < 129) BT[tid] = rel_bias[(int)T5B[br][tid] * 4 + h];
    {
        const int j = tid >> 1, half = tid & 1;
        {
            const int lk = 128 * (n - 1) + j; u32x4 p[4];
            if (lk >= 0) { const u32x4* src = (const u32x4*)(Z + (zrow0 + ((size_t)lk << dsh) + r) * INW + ZA + 256 + h * 64 + half * 32);
#pragma unroll
                for (int c = 0; c < 4; ++c) p[c] = src[c]; }
            else {
#pragma unroll
                for (int c = 0; c < 4; ++c) p[c] = (u32x4){0u, 0u, 0u, 0u}; }
            float f[4][8]; float ss = 0.f;
#pragma unroll
            for (int c = 0; c < 4; ++c) { unpack8(p[c], f[c]);
#pragma unroll
                for (int e = 0; e < 8; ++e) ss += f[c][e] * f[c][e]; }
            ss += __shfl_xor(ss, 1);
            const float rs = __builtin_amdgcn_rsqf(ss * (1.0f / 64.0f) + NORM_EPS);
#pragma unroll
            for (int c = 0; c < 4; ++c) { const float* gp = kg + half * 32 + c * 8; u32x4 o;
                o.x = pk2(f[c][0] * rs * gp[0], f[c][1] * rs * gp[1]); o.y = pk2(f[c][2] * rs * gp[2], f[c][3] * rs * gp[3]);
                o.z = pk2(f[c][4] * rs * gp[4], f[c][5] * rs * gp[5]); o.w = pk2(f[c][6] * rs * gp[6], f[c][7] * rs * gp[7]);
                *(LAS u32x4*)(Ks + j * 128 + (((half * 4 + c) ^ (j & 7)) << 4)) = o; }
        }
        if (tid < 256) {
            const int lq = 128 * n + j; u32x4 p[4];
            const u32x4* src = (const u32x4*)(Z + (zrow0 + ((size_t)lq << dsh) + r) * INW + ZA + h * 64 + half * 32);
#pragma unroll
            for (int c = 0; c < 4; ++c) p[c] = src[c];
            float f[4][8]; float ss = 0.f;
#pragma unroll
            for (int c = 0; c < 4; ++c) { unpack8(p[c], f[c]);
#pragma unroll
                for (int e = 0; e < 8; ++e) ss += f[c][e] * f[c][e]; }
            ss += __shfl_xor(ss, 1);
            const float rs = __builtin_amdgcn_rsqf(ss * (1.0f / 64.0f) + NORM_EPS) * 0.125f;
#pragma unroll
            for (int c = 0; c < 4; ++c) { const float* gp = qg + half * 32 + c * 8; u32x4 o;
                o.x = pk2(f[c][0] * rs * gp[0], f[c][1] * rs * gp[1]); o.y = pk2(f[c][2] * rs * gp[2], f[c][3] * rs * gp[3]);
                o.z = pk2(f[c][4] * rs * gp[4], f[c][5] * rs * gp[5]); o.w = pk2(f[c][6] * rs * gp[6], f[c][7] * rs * gp[7]);
                *(LAS u32x4*)(Qs + j * 128 + (((half * 4 + c) ^ (j & 7)) << 4)) = o; }
        }
    }
#pragma unroll
    for (int it = 0; it < 4; ++it) { const int idx = tid + 512 * it, chunk = idx >> 8, key = idx & 255, lk = 128 * (n - 1) + key; u32x4 p = (u32x4){0u, 0u, 0u, 0u};
        if (lk >= 0) p = *(const u32x4*)(Z + (zrow0 + ((size_t)lk << dsh) + r) * INW + ZA + 512 + h * 64 + chunk * 8);
        LAS unsigned short* vp = (LAS unsigned short*)(Vt + (chunk * 8) * 528 + key * 2);
        vp[0 * 264] = (unsigned short)(p.x & 0xffffu); vp[1 * 264] = (unsigned short)(p.x >> 16); vp[2 * 264] = (unsigned short)(p.y & 0xffffu); vp[3 * 264] = (unsigned short)(p.y >> 16);
        vp[4 * 264] = (unsigned short)(p.z & 0xffffu); vp[5 * 264] = (unsigned short)(p.z >> 16); vp[6 * 264] = (unsigned short)(p.w & 0xffffu); vp[7 * 264] = (unsigned short)(p.w >> 16); }
    BAR();
    bf16x8 qf[2];
#pragma unroll
    for (int ks = 0; ks < 2; ++ks) qf[ks] = *(const LAS bf16x8*)(Qs + (16 * w + fr) * 128 + (((ks * 4 + g) ^ (fr & 7)) << 4));
    f32x4 s[16];
#pragma unroll
    for (int kb = 0; kb < 16; ++kb) { s[kb] = (f32x4){0.f, 0.f, 0.f, 0.f};
#pragma unroll
        for (int ks = 0; ks < 2; ++ks) { const bf16x8 kf = *(const LAS bf16x8*)(Ks + (16 * kb + fr) * 128 + (((ks * 4 + g) ^ (fr & 7)) << 4));
            s[kb] = __builtin_amdgcn_mfma_f32_16x16x32_bf16(kf, qf[ks], s[kb], 0, 0, 0); } }
    const int q = 16 * w + fr; float mx = -3.0e38f;
#pragma unroll
    for (int kb = 0; kb < 16; ++kb)
#pragma unroll
        for (int rg = 0; rg < 4; ++rg) { const int key = 16 * kb + 4 * g + rg, delta = q + 128 - key; const bool valid = (delta >= 0) && (delta <= 128) && (n > 0 || key >= 128);
            const int di = delta < 0 ? 0 : (delta > 128 ? 128 : delta);
            const float v = valid ? s[kb][rg] + BT[di] : -3.0e38f; s[kb][rg] = v; mx = fmaxf(mx, v); }
    mx = fmaxf(mx, __shfl_xor(mx, 16)); mx = fmaxf(mx, __shfl_xor(mx, 32));
    float den = 0.f;
#pragma unroll
    for (int kb = 0; kb < 16; ++kb)
#pragma unroll
        for (int rg = 0; rg < 4; ++rg) { const float v = s[kb][rg]; const float p = (v > -1.0e38f) ? __expf(v - mx) : 0.f; s[kb][rg] = p; den += p; }
    den += __shfl_xor(den, 16); den += __shfl_xor(den, 32);
    f32x4 o[4];
#pragma unroll
    for (int eb = 0; eb < 4; ++eb) o[eb] = (f32x4){0.f, 0.f, 0.f, 0.f};
#pragma unroll
    for (int s8 = 0; s8 < 8; ++s8) {
        u32x4 pw; pw.x = pk2(s[2 * s8][0], s[2 * s8][1]); pw.y = pk2(s[2 * s8][2], s[2 * s8][3]); pw.z = pk2(s[2 * s8 + 1][0], s[2 * s8 + 1][1]); pw.w = pk2(s[2 * s8 + 1][2], s[2 * s8 + 1][3]);
        const bf16x8 pb = __builtin_bit_cast(bf16x8, pw);
#pragma unroll
        for (int eb = 0; eb < 4; ++eb) { const LAS unsigned char* vp = Vt + (16 * eb + fr) * 528 + (32 * s8 + 4 * g) * 2;
            const u32x2 lo = *(const LAS u32x2*)vp, hi = *(const LAS u32x2*)(vp + 32); u32x4 aw; aw.x = lo.x; aw.y = lo.y; aw.z = hi.x; aw.w = hi.y;
            o[eb] = __builtin_amdgcn_mfma_f32_16x16x32_bf16(__builtin_bit_cast(bf16x8, aw), pb, o[eb], 0, 0, 0); } }
    const float inv = 1.0f / den; const size_t tokq = zrow0 + ((size_t)(128 * n + q) << dsh) + r;
    bf16* op = OP + ((size_t)br * NTOK + tokq) * 256 + h * 64 + 4 * g;
#pragma unroll
    for (int eb = 0; eb < 4; ++eb) { u32x2 wv; wv.x = pk2(o[eb][0] * inv, o[eb][1] * inv); wv.y = pk2(o[eb][2] * inv, o[eb][3] * inv); *(u32x2*)(op + 16 * eb) = wv; }
    if (g == 0) LSE[((size_t)br * NTOK + tokq) * 4 + h] = mx + __logf(den);
    BAR();
}

__device__ __forceinline__ void attn_merge(Frame& F, const bf16* OP, const float* LSE, bf16* Y) {
    const int tid = mytid(F), lane = tid & 63, wave = __builtin_amdgcn_readfirstlane(tid >> 6); (void)lane; (void)wave;
    const int gt = (F.blk - 32) * NTHREADS + tid, NGT = (F.G - 32) * NTHREADS;
    for (int idx = gt; idx < NTOK * 32; idx += NGT) { const int tok = idx >> 5, c8 = idx & 31, h = c8 >> 3;
        const float l0 = LSE[((size_t)0 * NTOK + tok) * 4 + h], l1 = LSE[((size_t)1 * NTOK + tok) * 4 + h], l2 = LSE[((size_t)2 * NTOK + tok) * 4 + h];
        const float m = fmaxf(l0, fmaxf(l1, l2)); float w0 = __expf(l0 - m), w1 = __expf(l1 - m), w2 = __expf(l2 - m); const float inv = 1.0f / (w0 + w1 + w2); w0 *= inv; w1 *= inv; w2 *= inv;
        const u32x4 a = *(const u32x4*)(OP + ((size_t)0 * NTOK + tok) * 256 + c8 * 8), bq = *(const u32x4*)(OP + ((size_t)1 * NTOK + tok) * 256 + c8 * 8), c = *(const u32x4*)(OP + ((size_t)2 * NTOK + tok) * 256 + c8 * 8);
        float fa[8], fb[8], fc[8]; unpack8(a, fa); unpack8(bq, fb); unpack8(c, fc); float r[8];
#pragma unroll
        for (int e = 0; e < 8; ++e) r[e] = w0 * fa[e] + w1 * fb[e] + w2 * fc[e];
        u32x4 o; o.x = pk2(r[0], r[1]); o.y = pk2(r[2], r[3]); o.z = pk2(r[4], r[5]); o.w = pk2(r[6], r[7]);
        *(u32x4*)(Y + (size_t)tok * DM + c8 * 8) = o; }
}

__device__ __forceinline__ void conv_item(Frame& F, const bf16* Z, bf16* Y, const float* cw, const float* cb, const float* lg, const float* lb, int item) {
    const int tid = mytid(F), b = item >> 6, t0 = (item & 63) * 64;
    LAS float* HG = (LAS float*)F.lds;
    LAS float* WL = (LAS float*)(F.lds + 96256);
    for (int i = tid; i < 31 * 256; i += NTHREADS) WL[i] = cw[i];
    for (int p = tid; p < 94 * 32; p += NTHREADS) { const int row = p >> 5, c8 = p & 31, t = t0 - 30 + row; float hv[8];
        if (t >= 0) { const bf16* zr = Z + ((size_t)b * SEQ + t) * INW + ZB + c8 * 8; const u32x4 uu = *(const u32x4*)zr, gg = *(const u32x4*)(zr + 256); float fu[8], fg[8]; unpack8(uu, fu); unpack8(gg, fg);
#pragma unroll
            for (int e = 0; e < 8; ++e) hv[e] = fu[e] * sigmoidf_(fg[e]); }
        else {
#pragma unroll
            for (int e = 0; e < 8; ++e) hv[e] = 0.f; }
        LAS f32x4* d = (LAS f32x4*)(HG + row * 256 + c8 * 8); d[0] = (f32x4){hv[0], hv[1], hv[2], hv[3]}; d[1] = (f32x4){hv[4], hv[5], hv[6], hv[7]}; }
    BAR();
    const int tt = tid >> 3, cs = tid & 7;
    f32x4 acc[8];
#pragma unroll
    for (int i = 0; i < 8; ++i) acc[i] = *(const f32x4*)(cb + 4 * (cs + 8 * i));
    for (int j = 0; j < 31; ++j) {
#pragma unroll
        for (int i = 0; i < 8; ++i) { const int qd = cs + 8 * i; acc[i] += *(const LAS f32x4*)(HG + (tt + j) * 256 + 4 * qd) * *(const LAS f32x4*)(WL + j * 256 + 4 * qd); } }
    bf16* yr = Y + ((size_t)b * SEQ + t0 + tt) * DM + 256;
#pragma unroll
    for (int gi = 0; gi < 4; ++gi) {
        const f32x4 x0 = acc[2 * gi], x1 = acc[2 * gi + 1];
        float s = ((x0[0] + x0[1]) + (x0[2] + x0[3])) + ((x1[0] + x1[1]) + (x1[2] + x1[3])); s = red8(s);
        const float mean = s * (1.0f / 64.0f); const f32x4 d0 = x0 - mean, d1 = x1 - mean;
        float ss = ((d0[0] * d0[0] + d0[1] * d0[1]) + (d0[2] * d0[2] + d0[3] * d0[3])) + ((d1[0] * d1[0] + d1[1] * d1[1]) + (d1[2] * d1[2] + d1[3] * d1[3])); ss = red8(ss);
        const float rstd = __builtin_amdgcn_rsqf(ss * (1.0f / 64.0f) + 1e-5f);
#pragma unroll
        for (int k = 0; k < 2; ++k) { const int qd = cs + 8 * (2 * gi + k); const f32x4 dd = k ? d1 : d0; const f32x4 gv = *(const f32x4*)(lg + 4 * qd), bv = *(const f32x4*)(lb + 4 * qd); float y[4];
#pragma unroll
            for (int e = 0; e < 4; ++e) y[e] = siluf_(dd[e] * rstd * gv[e] + bv[e]);
            u32x2 wv; wv.x = pk2(y[0], y[1]); wv.y = pk2(y[2], y[3]); *(u32x2*)(yr + 4 * qd) = wv; } }
    BAR();
}

__device__ __forceinline__ bf16x8 ldfrag(const LAS unsigned char* base, int stride, int row0, int kb0, int fr, int g) {
    return *(const LAS bf16x8*)(base + (row0 + fr) * stride + kb0 + 16 * g);
}
#define MFMA16(a, b, c) __builtin_amdgcn_mfma_f32_16x16x32_bf16((a), (b), (c), 0, 0, 0)

__device__ __forceinline__ void gla_chain(Frame& F, const bf16* Z, bf16* Y, const float* g2, const float* gb, const float* ng, int b, int h) {
    const int tid = mytid(F), lane = tid & 63, w = __builtin_amdgcn_readfirstlane(tid >> 6), fr = lane & 15, g = lane >> 4;
    LAS unsigned char* L = F.lds;
    LAS float* G2 = (LAS float*)(L + 0);
    LAS float* QF = (LAS float*)(L + 2048);
    LAS float* KF = (LAS float*)(L + 6144);
    LAS float* GK = (LAS float*)(L + 10240);
    LAS float* GD = (LAS float*)(L + 14336);
    LAS float* OG = (LAS float*)(L + 16384);
    LAS unsigned char* QT = L + 24576;
    LAS unsigned char* KB = L + 27136;
    LAS unsigned char* KHT = L + 29696;
    LAS unsigned char* VT = L + 32256;
    LAS unsigned char* ATT = L + 37376;
    LAS unsigned char* ST = L + 39936;
    LAS float* EC = (LAS float*)(L + 50176);
    LAS float* OB = (LAS float*)(L + 50304);
    G2[tid] = g2[(tid >> 5) * 128 + h * 32 + (tid & 31)];
    const float gbv0 = gb[h * 32 + (tid & 31)];
    for (int i = tid; i < 2 * 64 * 40 / 2; i += NTHREADS) ((LAS unsigned*)ST)[i] = 0u;
    const bf16* zb = Z + (size_t)b * SEQ * INW;
    int ptt[2], pcol[2], pkind[2], poff[2]; bool pok[2];
#pragma unroll
    for (int it = 0; it < 2; ++it) { const int p = tid + 512 * it; pok[it] = p < 832; const int tt = p / 26, qd = p % 26; ptt[it] = tt; int col, kind, off;
        if (qd < 4) { col = ZD + h * 32 + 8 * qd; kind = 0; off = tt * 32 + 8 * qd; }
        else if (qd < 8) { col = ZD + 128 + h * 32 + 8 * (qd - 4); kind = 1; off = tt * 32 + 8 * (qd - 4); }
        else if (qd < 16) { col = ZD + 256 + h * 64 + 8 * (qd - 8); kind = 2; off = 8 * (qd - 8); }
        else if (qd < 18) { col = ZD + 512 + 8 * (qd - 16); kind = 3; off = tt * 16 + 8 * (qd - 16); }
        else { col = ZD + 528 + h * 64 + 8 * (qd - 18); kind = 4; off = tt * 64 + 8 * (qd - 18); }
        pcol[it] = col; pkind[it] = kind; poff[it] = off; }
    u32x4 pre[2];
#pragma unroll
    for (int it = 0; it < 2; ++it) pre[it] = pok[it] ? *(const u32x4*)(zb + (size_t)ptt[it] * INW + pcol[it]) : (u32x4){0u, 0u, 0u, 0u};
    const f32x4 png = *(const f32x4*)(ng + (tid & 15) * 4);
    f32x4 accS = (f32x4){0.f, 0.f, 0.f, 0.f};
    const int tb = w >> 2, vb = w & 3;
    BAR();
    for (int ch = 0; ch < SEQ / 32; ++ch) {
        const int t0 = ch * 32, cur = ch & 1;
#pragma unroll
        for (int it = 0; it < 2; ++it) if (pok[it]) { float f[8]; unpack8(pre[it], f);
            if (pkind[it] == 2) { LAS unsigned short* vp = (LAS unsigned short*)(VT + (poff[it]) * 80 + ptt[it] * 2);
                vp[0 * 40] = (unsigned short)(pre[it].x & 0xffffu); vp[1 * 40] = (unsigned short)(pre[it].x >> 16); vp[2 * 40] = (unsigned short)(pre[it].y & 0xffffu); vp[3 * 40] = (unsigned short)(pre[it].y >> 16);
                vp[4 * 40] = (unsigned short)(pre[it].z & 0xffffu); vp[5 * 40] = (unsigned short)(pre[it].z >> 16); vp[6 * 40] = (unsigned short)(pre[it].w & 0xffffu); vp[7 * 40] = (unsigned short)(pre[it].w >> 16); }
            else { LAS float* dst = (pkind[it] == 0 ? QF : pkind[it] == 1 ? KF : pkind[it] == 3 ? GD : OG) + poff[it]; const float sc = pkind[it] == 0 ? 0.17677669529663687f : 1.0f;
                ((LAS f32x4*)dst)[0] = (f32x4){f[0] * sc, f[1] * sc, f[2] * sc, f[3] * sc}; ((LAS f32x4*)dst)[1] = (f32x4){f[4] * sc, f[5] * sc, f[6] * sc, f[7] * sc}; } }
        if (ch + 1 < SEQ / 32) {
#pragma unroll
            for (int it = 0; it < 2; ++it) if (pok[it]) pre[it] = *(const u32x4*)(zb + (size_t)(t0 + 32 + ptt[it]) * INW + pcol[it]); }
        BAR();
#pragma unroll
        for (int it = 0; it < 2; ++it) { const int o = tid + 512 * it, tt = o >> 5, kk = o & 31; float x = gbv0;
#pragma unroll
            for (int j = 0; j < 16; ++j) x += GD[tt * 16 + j] * G2[j * 32 + kk];
            GK[tt * 32 + kk] = -softplusf_(-x) * (1.0f / 16.0f); }
        BAR();
        { const int t = tid >> 4, k2 = (tid & 15) * 2; float c0 = 0.f, c1 = 0.f, b0 = 0.f, b1 = 0.f;
#pragma unroll 8
            for (int s = 0; s < 32; ++s) { const f32x2 gk = *(const LAS f32x2*)(GK + s * 32 + k2); c0 += gk[0]; c1 += gk[1]; if (s == t) { b0 = c0; b1 = c1; } }
            const f32x2 q = *(const LAS f32x2*)(QF + t * 32 + k2), k = *(const LAS f32x2*)(KF + t * 32 + k2);
            *(LAS unsigned*)(QT + t * 80 + k2 * 2) = pk2(q[0] * __expf(b0), q[1] * __expf(b1));
            *(LAS unsigned*)(KB + t * 80 + k2 * 2) = pk2(k[0] * __expf(-b0), k[1] * __expf(-b1));
            *(LAS unsigned short*)(KHT + k2 * 80 + t * 2) = (unsigned short)f2bf(k[0] * __expf(c0 - b0)); *(LAS unsigned short*)(KHT + (k2 + 1) * 80 + t * 2) = (unsigned short)f2bf(k[1] * __expf(c1 - b1));
            if (t == 0) { EC[k2] = __expf(c0); EC[k2 + 1] = __expf(c1); } }
        BAR();
        if (w < 3) { const int atb = w == 0 ? 0 : 1, asb = w == 2 ? 1 : 0;
            f32x4 d = (f32x4){0.f, 0.f, 0.f, 0.f}; d = MFMA16(ldfrag(KB, 80, 16 * asb, 0, fr, g), ldfrag(QT, 80, 16 * atb, 0, fr, g), d);
            const int t = 16 * atb + fr; float v[4];
#pragma unroll
            for (int r = 0; r < 4; ++r) { const int s = 16 * asb + 4 * g + r; v[r] = (s <= t) ? d[r] : 0.f; }
            u32x2 o; o.x = pk2(v[0], v[1]); o.y = pk2(v[2], v[3]); *(LAS u32x2*)(ATT + t * 80 + (16 * asb + 4 * g) * 2) = o; }
        else if (w == 3) { *(LAS u32x2*)(ATT + fr * 80 + (16 + 4 * g) * 2) = (u32x2){0u, 0u}; }
        BAR();
        { const LAS unsigned char* STc = ST + cur * 5120; LAS unsigned char* STn = ST + (cur ^ 1) * 5120;
            const bf16x8 vfrag = ldfrag(VT, 80, 16 * vb, 0, fr, g);
            f32x4 o = (f32x4){0.f, 0.f, 0.f, 0.f};
            o = MFMA16(ldfrag(ATT, 80, 16 * tb, 0, fr, g), vfrag, o);
            o = MFMA16(ldfrag(QT, 80, 16 * tb, 0, fr, g), ldfrag(STc, 80, 16 * vb, 0, fr, g), o);
#pragma unroll
            for (int r = 0; r < 4; ++r) OB[(16 * tb + 4 * g + r) * 64 + 16 * vb + fr] = o[r];
            const f32x4 ec = *(const LAS f32x4*)(EC + 16 * tb + 4 * g);
            accS = accS * ec;
            accS = MFMA16(ldfrag(KHT, 80, 16 * tb, 0, fr, g), vfrag, accS);
            u32x2 so; so.x = pk2(accS[0], accS[1]); so.y = pk2(accS[2], accS[3]); *(LAS u32x2*)(STn + (16 * vb + fr) * 80 + (16 * tb + 4 * g) * 2) = so; }
        BAR();
        if (tid < 256) {
#pragma unroll
            for (int hh = 0; hh < 2; ++hh) { const int tt = (tid >> 4) + 16 * hh, v4 = (tid & 15) * 4; const f32x4 o = *(const LAS f32x4*)(OB + tt * 64 + v4);
                float ss = (o[0] * o[0] + o[1] * o[1]) + (o[2] * o[2] + o[3] * o[3]); ss = red16(ss);
                const float rs = __builtin_amdgcn_rsqf(ss * (1.0f / 64.0f) + NORM_EPS); const f32x4 gv = png, og = *(const LAS f32x4*)(OG + tt * 64 + v4); float y[4];
#pragma unroll
                for (int e = 0; e < 4; ++e) y[e] = o[e] * rs * gv[e] * siluf_(og[e]);
                u32x2 wv; wv.x = pk2(y[0], y[1]); wv.y = pk2(y[2], y[3]); *(u32x2*)(Y + ((size_t)b * SEQ + t0 + tt) * DM + 768 + h * 64 + v4) = wv; } }
        BAR();
    }
}

struct RwkvP { const float *mu, *w0, *w2, *a0, *a2, *g2, *kk, *ka, *rk, *lg, *lb; };
constexpr int RC_AR = 0  , RC_BKT = 4096  , RC_V = 8192  , RC_AAK = 10240  ,
              RC_RBK = 10752  , RC_T = 11776  , RC_GC = 12288  , RC_G = 12544  , RC_BON = 14592  , RC_STRIDE = 14848;
constexpr int RC_CHUNKS16 = 916;
static_assert((size_t)NB * 4 * (SEQ / 16) * RC_STRIDE <= NEXP * MOEW_E_BYTES, "RWKV records overlay the (not yet converted) MoE weight region");
constexpr int RW_W2T = 0, RW_A2T = 5120, RW_G2T = 10240, RW_MU = 19456  , RW_TW = 23040, RW_AD = 24320, RW_SG = 25600, RW_R = 27904, RW_K = 32000, RW_V = 36096, RW_WL = 40192, RW_AL = 44288,
              RW_G = 48384, RW_KK = 52480, RW_KP = 56576, RW_BON = 60672, RW_GC = 60736, RW_AR = 60992, RW_BK = 65600, RW_BKT = 70208, RW_ZAK = 75328, RW_RBK = 76608, RW_AAB = 77888, RW_END = 78912;

__device__ __forceinline__ void rwkv_prep_init(Frame& F, const RwkvP P, int h) {
    const int tid = mytid(F); LAS unsigned char* L = F.lds;
    for (int i = tid; i < 64 * 32; i += NTHREADS) { const int c = i >> 5, j = i & 31;
        *(LAS unsigned short*)(L + RW_W2T + c * 80 + j * 2) = (unsigned short)f2bf(P.w2[j * 256 + h * 64 + c]); *(LAS unsigned short*)(L + RW_A2T + c * 80 + j * 2) = (unsigned short)f2bf(P.a2[j * 256 + h * 64 + c]); }
    for (int i = tid; i < 64 * 64; i += NTHREADS) { const int c = i >> 6, j = i & 63; *(LAS unsigned short*)(L + RW_G2T + c * 144 + j * 2) = (unsigned short)f2bf(P.g2[j * 256 + h * 64 + c]); }
    for (int i = tid; i < 896; i += NTHREADS) ((LAS float*)(L + RW_MU))[i] = P.mu[i];
}
__device__ __forceinline__ void rwkv_prep_load(const bf16* Z, int b, int h, int ch, int w, int lane, u32x4 (&cur)[2], u32x4 (&prv)[2]) {
    const int kind = w & 3, p = (w >> 2) * 64 + lane, tt = p >> 3, j = p & 7;
    const int col = (kind < 3 ? ZC + kind * 256 + h * 64 : ZC + 832) + 8 * j;
    const int t = ch * 16 + tt; const bf16* zr = Z + ((size_t)b * SEQ + t) * INW + col;
    cur[0] = *(const u32x4*)zr; prv[0] = (t > 0) ? *(const u32x4*)(zr - INW) : (u32x4){0u, 0u, 0u, 0u};
    if (w < 2) { const int t2 = ch * 16 + (lane >> 2); const bf16* z2 = Z + ((size_t)b * SEQ + t2) * INW + ZC + 768 + w * 32 + 8 * (lane & 3);
        cur[1] = *(const u32x4*)z2; prv[1] = (t2 > 0) ? *(const u32x4*)(z2 - INW) : (u32x4){0u, 0u, 0u, 0u}; }
    else { cur[1] = (u32x4){0u, 0u, 0u, 0u}; prv[1] = cur[1]; }
}
__device__ __forceinline__ void rwkv_prep_item(Frame& F, unsigned char* rec, const RwkvP P, int h, const u32x4 (&cur)[2], const u32x4 (&prv)[2]) {
    const int tid = mytid(F), lane = tid & 63, w = __builtin_amdgcn_readfirstlane(tid >> 6), fr = lane & 15, g = lane >> 4;
    LAS unsigned char* L = F.lds;
    LAS float *R = (LAS float*)(L + RW_R), *KR = (LAS float*)(L + RW_K), *V = (LAS float*)(L + RW_V), *WL = (LAS float*)(L + RW_WL), *AL = (LAS float*)(L + RW_AL), *G = (LAS float*)(L + RW_G),
              *KK = (LAS float*)(L + RW_KK), *KP = (LAS float*)(L + RW_KP), *BON = (LAS float*)(L + RW_BON), *GC = (LAS float*)(L + RW_GC), *AAB = (LAS float*)(L + RW_AAB), *MU = (LAS float*)(L + RW_MU);
    { const int kind = w & 3, p = (w >> 2) * 64 + lane, tt = p >> 3, j = p & 7; float fc[8], fp[8], x[8]; unpack8(cur[0], fc); unpack8(prv[0], fp);
        const LAS float* mu = MU + (kind < 3 ? kind * 256 + h * 64 : 832) + 8 * j;
#pragma unroll
        for (int e = 0; e < 8; ++e) x[e] = fc[e] + (fp[e] - fc[e]) * mu[e];
        if (kind < 3) { LAS f32x4* d = (LAS f32x4*)((kind == 0 ? R : kind == 1 ? KR : V) + tt * 64 + 8 * j); d[0] = (f32x4){x[0], x[1], x[2], x[3]}; d[1] = (f32x4){x[4], x[5], x[6], x[7]}; }
        else {
#pragma unroll
            for (int e = 0; e < 8; ++e) x[e] = __builtin_amdgcn_rcpf(1.0f + __expf(-x[e]));
            u32x4 o; o.x = pk2(x[0], x[1]); o.y = pk2(x[2], x[3]); o.z = pk2(x[4], x[5]); o.w = pk2(x[6], x[7]); *(LAS u32x4*)(L + RW_SG + tt * 144 + 16 * j) = o; }
        if (w < 2) { const int t2 = lane >> 2, j2 = lane & 3; unpack8(cur[1], fc); unpack8(prv[1], fp); const LAS float* mu2 = MU + 768 + w * 32 + 8 * j2;
#pragma unroll
            for (int e = 0; e < 8; ++e) { x[e] = fc[e] + (fp[e] - fc[e]) * mu2[e]; if (w == 0) x[e] = 2.0f * __builtin_amdgcn_rcpf(1.0f + __expf(-2.0f * x[e])) - 1.0f; }
            u32x4 o; o.x = pk2(x[0], x[1]); o.y = pk2(x[2], x[3]); o.z = pk2(x[4], x[5]); o.w = pk2(x[6], x[7]); *(LAS u32x4*)(L + (w == 0 ? RW_TW : RW_AD) + t2 * 80 + 16 * j2) = o; } }
    BAR();
    if (w < 4) { f32x4 dw = (f32x4){0.f, 0.f, 0.f, 0.f}, da = dw;
        dw = MFMA16(ldfrag(L + RW_W2T, 80, 16 * w, 0, fr, g), ldfrag(L + RW_TW, 80, 0, 0, fr, g), dw);
        da = MFMA16(ldfrag(L + RW_A2T, 80, 16 * w, 0, fr, g), ldfrag(L + RW_AD, 80, 0, 0, fr, g), da);
        *(LAS f32x4*)(WL + fr * 64 + 16 * w + 4 * g) = dw; *(LAS f32x4*)(AL + fr * 64 + 16 * w + 4 * g) = da; }
    else { const int cb = w - 4; f32x4 dg = (f32x4){0.f, 0.f, 0.f, 0.f};
        dg = MFMA16(ldfrag(L + RW_G2T, 144, 16 * cb, 0, fr, g), ldfrag(L + RW_SG, 144, 0, 0, fr, g), dg);
        dg = MFMA16(ldfrag(L + RW_G2T, 144, 16 * cb, 64, fr, g), ldfrag(L + RW_SG, 144, 0, 64, fr, g), dg);
        *(LAS f32x4*)(G + fr * 64 + 16 * cb + 4 * g) = dg; }
    BAR();
    { const int t = tid >> 5, c2 = (tid & 31) * 2, hc = h * 64 + c2;
        const f32x2 wl = *(const LAS f32x2*)(WL + t * 64 + c2) + *(const f32x2*)(P.w0 + hc), al = *(const LAS f32x2*)(AL + t * 64 + c2) + *(const f32x2*)(P.a0 + hc);
        const f32x2 kr = *(const LAS f32x2*)(KR + t * 64 + c2), rr = *(const LAS f32x2*)(R + t * 64 + c2);
        const f32x2 kkw = *(const f32x2*)(P.kk + hc), kaw = *(const f32x2*)(P.ka + hc), rkw = *(const f32x2*)(P.rk + hc);
        f32x2 lw, a, kk, kp; float ss = 0.f, bon = 0.f;
#pragma unroll
        for (int e = 0; e < 2; ++e) { const float wlog = -softplusf_(-wl[e]) - 0.5f; lw[e] = -__expf(wlog); a[e] = __builtin_amdgcn_rcpf(1.0f + __expf(-al[e])); kk[e] = kr[e] * kkw[e]; ss += kk[e] * kk[e];
            kp[e] = kr[e] * (1.0f + (a[e] - 1.0f) * kaw[e]); bon += rr[e] * kp[e] * rkw[e]; }
        ss = red16(ss); bon = red16(bon); ss += __shfl_xor(ss, 16); bon += __shfl_xor(bon, 16);
        const float inv = 1.0f / fmaxf(sqrtf(ss), 1e-12f); kk = kk * inv;
        *(LAS f32x2*)(WL + t * 64 + c2) = lw; *(LAS f32x2*)(AL + t * 64 + c2) = a; *(LAS f32x2*)(KK + t * 64 + c2) = kk; *(LAS f32x2*)(KP + t * 64 + c2) = kp;
        if ((tid & 31) == 0) BON[t] = bon; }
    BAR();
    { const int t = tid >> 5, c2 = (tid & 31) * 2;
        f32x2 cs = (f32x2){0.f, 0.f}, ct = cs;
#pragma unroll
        for (int s = 0; s < 16; ++s) { cs += *(const LAS f32x2*)(WL + s * 64 + c2); if (s == t) ct = cs; }
        const f32x2 lwt = *(const LAS f32x2*)(WL + t * 64 + c2), a = *(const LAS f32x2*)(AL + t * 64 + c2), kk = *(const LAS f32x2*)(KK + t * 64 + c2), kp = *(const LAS f32x2*)(KP + t * 64 + c2), rr = *(const LAS f32x2*)(R + t * 64 + c2);
        float at[2], rt[2], bb[2], kb[2], bh[2], kh[2];
#pragma unroll
        for (int e = 0; e < 2; ++e) { const float eP = __expf(ct[e] - lwt[e]), eT = __expf(ct[e]), eI = __expf(-ct[e]), eC = __expf(cs[e] - ct[e]); const float bv = kk[e] * a[e];
            at[e] = -kk[e] * eP; rt[e] = rr[e] * eT; bb[e] = bv * eI; kb[e] = kp[e] * eI; bh[e] = bv * eC; kh[e] = kp[e] * eC; }
        *(LAS unsigned*)(L + RW_AR + t * 144 + c2 * 2) = pk2(at[0], at[1]); *(LAS unsigned*)(L + RW_AR + (16 + t) * 144 + c2 * 2) = pk2(rt[0], rt[1]);
        *(LAS unsigned*)(L + RW_BK + t * 144 + c2 * 2) = pk2(bb[0], bb[1]); *(LAS unsigned*)(L + RW_BK + (16 + t) * 144 + c2 * 2) = pk2(kb[0], kb[1]);
#pragma unroll
        for (int e = 0; e < 2; ++e) { *(LAS unsigned short*)(L + RW_BKT + (c2 + e) * 80 + t * 2) = (unsigned short)f2bf(bh[e]); *(LAS unsigned short*)(L + RW_BKT + (c2 + e) * 80 + (16 + t) * 2) = (unsigned short)f2bf(kh[e]); }
        if (t == 0) { GC[c2] = __expf(cs[0]); GC[c2 + 1] = __expf(cs[1]); } }
    BAR();
    if (w < 4) { const int arow = (w & 1) ? 16 : 0  , brow = (w & 2) ? 16 : 0  ;
        f32x4 d = (f32x4){0.f, 0.f, 0.f, 0.f};
        d = MFMA16(ldfrag(L + RW_BK, 144, arow, 0, fr, g), ldfrag(L + RW_AR, 144, brow, 0, fr, g), d);
        d = MFMA16(ldfrag(L + RW_BK, 144, arow, 64, fr, g), ldfrag(L + RW_AR, 144, brow, 64, fr, g), d);
        const int t = fr; float v[4];
#pragma unroll
        for (int r = 0; r < 4; ++r) { const int s = 4 * g + r; const bool keep = (w < 2) ? (s < t) : (s <= t); v[r] = keep ? d[r] : 0.f; }
        if (w == 0) *(LAS f32x4*)(AAB + t * 16 + 4 * g) = (f32x4){v[0], v[1], v[2], v[3]};
        else { u32x2 o; o.x = pk2(v[0], v[1]); o.y = pk2(v[2], v[3]);
            LAS unsigned char* dst = (w == 1) ? (L + RW_ZAK + t * 80 + (16 + 4 * g) * 2) : (w == 2) ? (L + RW_RBK + t * 80 + (4 * g) * 2) : (L + RW_RBK + t * 80 + (16 + 4 * g) * 2);
            *(LAS u32x2*)dst = o; } }
    BAR();
    if (w == 7) { if (lane < 16) { float col[16];
#pragma unroll
            for (int t = 0; t < 16; ++t) { float acc = (t == lane) ? 1.0f : 0.f;
#pragma unroll
                for (int s = 0; s < t; ++s) acc += AAB[t * 16 + s] * col[s];
                col[t] = acc; }
#pragma unroll
            for (int t = 0; t < 16; ++t) *(unsigned short*)(rec + RC_T + t * 32 + lane * 2) = (unsigned short)f2bf(col[t]); } }
    else { for (int p = tid; p < 884; p += 448) {
            if (p < 256) { const int r = p >> 3, j = p & 7; *(u32x4*)(rec + RC_AR + r * 128 + 16 * j) = *(const LAS u32x4*)(L + RW_AR + r * 144 + 16 * j); }
            else if (p < 512) { const int q = p - 256, r = q >> 2, j = q & 3; *(u32x4*)(rec + RC_BKT + r * 64 + 16 * j) = *(const LAS u32x4*)(L + RW_BKT + r * 80 + 16 * j); }
            else if (p < 640) { const int q = p - 512; const f32x4 a = *(const LAS f32x4*)(V + q * 8), c = *(const LAS f32x4*)(V + q * 8 + 4); u32x4 o; o.x = pk2(a[0], a[1]); o.y = pk2(a[2], a[3]); o.z = pk2(c[0], c[1]); o.w = pk2(c[2], c[3]); *(u32x4*)(rec + RC_V + 16 * q) = o; }
            else if (p < 672) { const int q = p - 640, r = q >> 1, j = q & 1; *(u32x4*)(rec + RC_AAK + r * 32 + 16 * j) = *(const LAS u32x4*)(L + RW_ZAK + r * 80 + 32 + 16 * j); }
            else if (p < 736) { const int q = p - 672, r = q >> 2, j = q & 3; *(u32x4*)(rec + RC_RBK + r * 64 + 16 * j) = *(const LAS u32x4*)(L + RW_RBK + r * 80 + 16 * j); }
            else if (p < 752) { const int q = p - 736; *(f32x4*)(rec + RC_GC + 16 * q) = *(const LAS f32x4*)(GC + 4 * q); }
            else if (p < 880) { const int q = p - 752; const f32x4 a = *(const LAS f32x4*)(G + q * 8), c = *(const LAS f32x4*)(G + q * 8 + 4); u32x4 o; o.x = pk2(a[0], a[1]); o.y = pk2(a[2], a[3]); o.z = pk2(c[0], c[1]); o.w = pk2(c[2], c[3]); *(u32x4*)(rec + RC_G + 16 * q) = o; }
            else { const int q = p - 880; *(f32x4*)(rec + RC_BON + 16 * q) = *(const LAS f32x4*)(BON + 4 * q); } } }
    BAR();
}

constexpr int SB_AR = 0  , SB_BKT = 4608  , SB_UVT = 9728  , SB_ZAK = 14848, SB_RBK = 16128, SB_TT = 17408, SB_GC = 18688,
              SB_G = 18944  , SB_V = 20992  , SB_BON = 23040, SB_STRIDE = 23296;
constexpr int ST_S = 3 * SB_STRIDE  , ST_YT = ST_S + 9216  , ST_OB = ST_YT + 5120  , ST_END = ST_OB + 8192;
static_assert(ST_END <= RING_BYTES, "state pass LDS");
__device__ __forceinline__ void rwkv_state(Frame& F, const unsigned char* recs, bf16* Y, const RwkvP P, int b, int h) {
    const int tid = mytid(F), lane = tid & 63, w = __builtin_amdgcn_readfirstlane(tid >> 6), fr = lane & 15, g = lane >> 4;
    LAS unsigned char* L = F.lds;
    for (int i = tid; i < ST_END / 4; i += NTHREADS) ((LAS unsigned*)L)[i] = 0u;
    const unsigned char* rbase = recs + (size_t)(b * 4 + h) * (SEQ / 16) * RC_STRIDE;
    const int lt = tid - 256;
    int psrc[4], pdst[4], pkind[4];
#pragma unroll
    for (int i = 0; i < 4; ++i) { const int p = lt + 256 * i; int src = 0, dst = 0, kind = -1;
        if (lt >= 0 && p < RC_CHUNKS16) { src = 16 * p;
            if (p < 256) { const int r = p >> 3, j = p & 7; dst = SB_AR + r * 144 + 16 * j; kind = 0; }
            else if (p < 512) { const int q = p - 256, r = q >> 2, j = q & 3; dst = SB_BKT + r * 80 + 16 * j; kind = 0; }
            else if (p < 640) { const int q = p - 512; dst = q; kind = 1; }
            else if (p < 672) { const int q = p - 640, r = q >> 1, j = q & 1; dst = SB_ZAK + r * 80 + 32 + 16 * j; kind = 0; }
            else if (p < 736) { const int q = p - 672, r = q >> 2, j = q & 3; dst = SB_RBK + r * 80 + 16 * j; kind = 0; }
            else if (p < 768) { const int q = p - 736, r = q >> 1, j = q & 1; dst = SB_TT + r * 80 + 16 * j; kind = 0; }
            else if (p < 784) { dst = SB_GC + 16 * (p - 768); kind = 0; }
            else if (p < 912) { dst = SB_G + 16 * (p - 784); kind = 0; }
            else { dst = SB_BON + 16 * (p - 912); kind = 0; } }
        psrc[i] = src; pdst[i] = dst; pkind[i] = kind; }
    const f32x4 plg = *(const f32x4*)(P.lg + h * 64 + (tid & 15) * 4), plb = *(const f32x4*)(P.lb + h * 64 + (tid & 15) * 4);
    u32x4 pre[4];
#pragma unroll
    for (int i = 0; i < 4; ++i) pre[i] = (pkind[i] >= 0) ? *(const u32x4*)(rbase + psrc[i]) : (u32x4){0u, 0u, 0u, 0u};
    f32x4 accS[4];
#pragma unroll
    for (int i = 0; i < 4; ++i) accS[i] = (f32x4){0.f, 0.f, 0.f, 0.f};
    BAR();
    constexpr int NCH = SEQ / 16;
    for (int c = -1; c <= NCH; ++c) {
        if (w >= 4) {
            if (c + 1 < NCH) { LAS unsigned char* B = L + ((c + 1) % 3) * SB_STRIDE;
#pragma unroll
                for (int i = 0; i < 4; ++i) { if (pkind[i] == 0) *(LAS u32x4*)(B + pdst[i]) = pre[i];
                    else if (pkind[i] == 1) { *(LAS u32x4*)(B + SB_V + 16 * pdst[i]) = pre[i]; const int tt = pdst[i] >> 3, c0 = (pdst[i] & 7) * 8;
                        LAS unsigned short* vp = (LAS unsigned short*)(B + SB_UVT + c0 * 80 + (16 + tt) * 2);
                        vp[0 * 40] = (unsigned short)(pre[i].x & 0xffffu); vp[1 * 40] = (unsigned short)(pre[i].x >> 16); vp[2 * 40] = (unsigned short)(pre[i].y & 0xffffu); vp[3 * 40] = (unsigned short)(pre[i].y >> 16);
                        vp[4 * 40] = (unsigned short)(pre[i].z & 0xffffu); vp[5 * 40] = (unsigned short)(pre[i].z >> 16); vp[6 * 40] = (unsigned short)(pre[i].w & 0xffffu); vp[7 * 40] = (unsigned short)(pre[i].w >> 16); } } }
            if (c + 2 < NCH) { const unsigned char* rp = rbase + (size_t)(c + 2) * RC_STRIDE;
#pragma unroll
                for (int i = 0; i < 4; ++i) if (pkind[i] >= 0) pre[i] = *(const u32x4*)(rp + psrc[i]); }
            if (c >= 1) { const int ce = c - 1; const LAS unsigned char* B = L + (ce % 3) * SB_STRIDE; const LAS float* OB = (const LAS float*)(L + ST_OB + (ce & 1) * 4096);
                const int tt = lt >> 4, c4 = (lt & 15) * 4; const f32x4 o = *(const LAS f32x4*)(OB + tt * 64 + c4);
                float s = (o[0] + o[1]) + (o[2] + o[3]); s = red16(s); const float mean = s * (1.0f / 64.0f); const f32x4 d = o - mean;
                float ss = (d[0] * d[0] + d[1] * d[1]) + (d[2] * d[2] + d[3] * d[3]); ss = red16(ss); const float rstd = __builtin_amdgcn_rsqf(ss * (1.0f / 64.0f) + 64e-5f);
                const u32x2 vw = *(const LAS u32x2*)(B + SB_V + tt * 128 + c4 * 2), gw = *(const LAS u32x2*)(B + SB_G + tt * 128 + c4 * 2); const float bon = ((const LAS float*)(B + SB_BON))[tt];
                const float vv[4] = {bflo(vw.x), bfhi(vw.x), bflo(vw.y), bfhi(vw.y)}, gg[4] = {bflo(gw.x), bfhi(gw.x), bflo(gw.y), bfhi(gw.y)}; float y[4];
#pragma unroll
                for (int e = 0; e < 4; ++e) y[e] = (d[e] * rstd * plg[e] + plb[e] + bon * vv[e]) * gg[e];
                u32x2 wv; wv.x = pk2(y[0], y[1]); wv.y = pk2(y[2], y[3]); *(u32x2*)(Y + ((size_t)b * SEQ + ce * 16 + tt) * DM + 512 + h * 64 + c4) = wv; }
        } else if (c >= 0 && c < NCH) { const int vb = w; LAS unsigned char* B = L + (c % 3) * SB_STRIDE; LAS float* OB = (LAS float*)(L + ST_OB + (c & 1) * 4096);
            const bf16x8 s0 = ldfrag(L + ST_S, 144, 16 * vb, 0, fr, g), s1 = ldfrag(L + ST_S, 144, 16 * vb, 64, fr, g);
            f32x4 y = (f32x4){0.f, 0.f, 0.f, 0.f}, accO = y;
            y = MFMA16(ldfrag(B + SB_AR, 144, 0, 0, fr, g), s0, y); y = MFMA16(ldfrag(B + SB_AR, 144, 0, 64, fr, g), s1, y);
            y = MFMA16(ldfrag(B + SB_ZAK, 80, 0, 0, fr, g), ldfrag(B + SB_UVT, 80, 16 * vb, 0, fr, g), y);
            { u32x2 o; o.x = pk2(y[0], y[1]); o.y = pk2(y[2], y[3]); *(LAS u32x2*)(L + ST_YT + (16 * vb + fr) * 80 + (4 * g) * 2) = o; }
            accO = MFMA16(ldfrag(B + SB_AR, 144, 16, 0, fr, g), s0, accO); accO = MFMA16(ldfrag(B + SB_AR, 144, 16, 64, fr, g), s1, accO);
            LDS_WAIT();
            f32x4 u = (f32x4){0.f, 0.f, 0.f, 0.f};
            u = MFMA16(ldfrag(B + SB_TT, 80, 0, 0, fr, g), ldfrag(L + ST_YT, 80, 16 * vb, 0, fr, g), u);
            { u32x2 o; o.x = pk2(u[0], u[1]); o.y = pk2(u[2], u[3]); *(LAS u32x2*)(B + SB_UVT + (16 * vb + fr) * 80 + (4 * g) * 2) = o; }
            LDS_WAIT();
            const bf16x8 uv = ldfrag(B + SB_UVT, 80, 16 * vb, 0, fr, g);
            accO = MFMA16(ldfrag(B + SB_RBK, 80, 0, 0, fr, g), uv, accO);
#pragma unroll
            for (int r = 0; r < 4; ++r) OB[(4 * g + r) * 64 + 16 * vb + fr] = accO[r];
#pragma unroll
            for (int kb = 0; kb < 4; ++kb) { const f32x4 gc = *(const LAS f32x4*)(B + SB_GC + (16 * kb + 4 * g) * 4); accS[kb] = accS[kb] * gc; accS[kb] = MFMA16(ldfrag(B + SB_BKT, 80, 16 * kb, 0, fr, g), uv, accS[kb]);
                u32x2 o; o.x = pk2(accS[kb][0], accS[kb][1]); o.y = pk2(accS[kb][2], accS[kb][3]); *(LAS u32x2*)(L + ST_S + (16 * vb + fr) * 144 + (16 * kb + 4 * g) * 2) = o; }
            LDS_WAIT();
        }
        BAR();
    }
}

__device__ __forceinline__ void moe_route(Frame& F, const float* hres, const float* gffn, const float* router) {
    const int tid = mytid(F), lane = tid & 63, wave = __builtin_amdgcn_readfirstlane(tid >> 6); (void)lane; (void)wave;
    unsigned char* rt = F.ws + WS_RT;
    int* tope = (int*)(rt + RT_TOPE); float* gate = (float*)(rt + RT_GATE); int* rank = (int*)(rt + RT_RANK); float* rstd = (float*)(rt + RT_RSTD); int* hist = (int*)(rt + RT_HIST); int* rowtok = (int*)(rt + RT_ROWTOK);
    LAS float* RW = (LAS float*)F.lds;
    LAS int* LH = (LAS int*)(F.lds + 32768);
    for (int i = tid; i < 8192; i += NTHREADS) RW[i] = router[i];
    if (tid < 16) LH[tid] = 0;
    for (int i = F.blk * NTHREADS + tid; i < 2 * MOE_ROWS; i += F.G * NTHREADS) rowtok[i] = -1;
    __syncthreads();
    const int tpb = NTOK / F.G;
    for (int i = wave; i < tpb; i += NWAVES) { const int t = F.blk * tpb + i;
        const f32x4* hr = (const f32x4*)(hres + (size_t)t * DM) + lane; f32x4 v[4]; float ss = 0.f;
#pragma unroll
        for (int j = 0; j < 4; ++j) { v[j] = hr[64 * j]; ss += (v[j][0] * v[j][0] + v[j][1] * v[j][1]) + (v[j][2] * v[j][2] + v[j][3] * v[j][3]); }
        ss = wave_sum(ss); const float rs = __builtin_amdgcn_rsqf(ss * (1.0f / DM) + NORM_EPS);
        float lg[8];
#pragma unroll
        for (int e = 0; e < 8; ++e) lg[e] = 0.f;
#pragma unroll
        for (int j = 0; j < 4; ++j) { const f32x4 gv = *((const f32x4*)gffn + 64 * j + lane);
#pragma unroll
            for (int c = 0; c < 4; ++c) { const int k = 256 * j + 4 * lane + c; const float xn = v[j][c] * rs * gv[c]; const f32x4 r0 = *(const LAS f32x4*)(RW + k * 8), r1 = *(const LAS f32x4*)(RW + k * 8 + 4);
                lg[0] += xn * r0[0]; lg[1] += xn * r0[1]; lg[2] += xn * r0[2]; lg[3] += xn * r0[3]; lg[4] += xn * r1[0]; lg[5] += xn * r1[1]; lg[6] += xn * r1[2]; lg[7] += xn * r1[3]; } }
#pragma unroll
        for (int e = 0; e < 8; ++e) lg[e] = wave_sum(lg[e]);
        int i1 = 0; float m1 = lg[0];
#pragma unroll
        for (int e = 1; e < 8; ++e) if (lg[e] > m1) { m1 = lg[e]; i1 = e; }
        int i2 = -1; float m2 = -3.0e38f;
#pragma unroll
        for (int e = 0; e < 8; ++e) if (e != i1 && lg[e] > m2) { m2 = lg[e]; i2 = e; }
        if (lane == 0) { const float g1 = 1.0f / (1.0f + __expf(m2 - m1));
            const int r1 = atomicAdd((int*)&LH[i1], 1), r2 = atomicAdd((int*)&LH[8 + i2], 1);
            tope[2 * t] = i1; tope[2 * t + 1] = i2; gate[2 * t] = g1; gate[2 * t + 1] = 1.0f - g1; rank[2 * t] = r1; rank[2 * t + 1] = r2; rstd[t] = rs; }
    }
    __syncthreads();
    if (tid < 16) hist[F.blk * 16 + tid] = LH[tid];
}
__device__ __forceinline__ void moe_gather(Frame& F, int slot, const bf16* hb, bf16* asort) {
    const int tid = mytid(F), lane = tid & 63, wave = __builtin_amdgcn_readfirstlane(tid >> 6); (void)lane; (void)wave;
    unsigned char* rt = F.ws + WS_RT;
    const int* tope = (const int*)(rt + RT_TOPE); const float* gate = (const float*)(rt + RT_GATE); const int* rank = (const int*)(rt + RT_RANK); const float* rstd = (const float*)(rt + RT_RSTD); const int* hist = (const int*)(rt + RT_HIST);
    int* rowtok = (int*)(rt + RT_ROWTOK) + slot * MOE_ROWS; float* rowgate = (float*)(rt + RT_ROWGATE) + slot * MOE_ROWS; float* rowrstd = (float*)(rt + RT_ROWRSTD) + slot * MOE_ROWS;
    int* tilee = (int*)(rt + RT_TILEE) + slot * 256; int* ntiles = (int*)(rt + RT_NTILES);
    LAS int* BASE = (LAS int*)(F.lds + 40960);
    LAS int* TOT = BASE + 8;
    __syncthreads();
    if (tid < 8) { int before = 0, tot = 0;
        for (int bb = 0; bb < F.G; ++bb) { const int c = hist[bb * 16 + slot * 8 + tid]; if (bb < F.blk) before += c; tot += c; }
        BASE[tid] = before; TOT[tid] = tot; }
    __syncthreads();
    if (tid == 0) { int ps = 0, nt = 0;
        for (int e = 0; e < 8; ++e) { const int tl = (TOT[e] + 255) >> 8; BASE[e] += ps; if (F.blk == 0) for (int i = 0; i < tl; ++i) tilee[nt + i] = e; ps += tl * 256; nt += tl; }
        if (F.blk == 0) ntiles[slot] = nt; }
    __syncthreads();
    const int tpb = NTOK / F.G;
    for (int i = wave; i < tpb; i += NWAVES) { const int t = F.blk * tpb + i; const int e = tope[2 * t + slot]; const int dest = BASE[e] + rank[2 * t + slot];
        if (lane == 0) { rowtok[dest] = t; rowgate[dest] = gate[2 * t + slot]; rowrstd[dest] = rstd[t]; }
        const u32x4* s = (const u32x4*)(hb + (size_t)t * DM) + lane; u32x4* d = (u32x4*)(asort + (size_t)dest * DM) + lane;
        const u32x4 a = s[0], c = s[64]; d[0] = a; d[64] = c; }
}

#ifndef MK_PER_PHASE
#define MK_PER_PHASE 0
#endif
constexpr int N_PHASES = 17;
__global__ void __launch_bounds__(NTHREADS, 2) mk_fwd(Params prm) {
    extern __shared__ __attribute__((aligned(16))) unsigned char lds_raw[];
    Frame F;
    F.lds = (LAS unsigned char*)lds_raw;
    F.blk = blockIdx.x; F.G = gridDim.x; F.out = prm.out; F.ws = prm.ws; F.wv = __builtin_amdgcn_readfirstlane(threadIdx.x >> 6);
    volatile LAS unsigned* MISC = (volatile LAS unsigned*)(F.lds + MISC_OFF);
    for (int u = threadIdx.x; u < (LDS_BYTES - LDSCTL_OFF) / 4; u += NTHREADS) ((LAS unsigned*)(F.lds + LDSCTL_OFF))[u] = 0u;
    __syncthreads();
    if (threadIdx.x == 0) { LAS unsigned long long* tab = (LAS unsigned long long*)(F.lds + PTAB_OFF);
#pragma unroll
        for (int i_ = 0; i_ < 33; ++i_) tab[i_] = (unsigned long long)prm.in[i_]; }
    __syncthreads();
    const int lo = prm.ph_lo, hi = prm.ph_hi;
    unsigned* ctl = (unsigned*)(F.ws + WS_CTL);
    XcdBarrier bar; bar.bar = ctl + CW_BAR; bar.x = 0; bar.st = nullptr;
    if (hi - lo > 1) bar = xcd_barrier_post(ctl + CW_BAR, MISC + 8);
    unsigned char* ws = F.ws;
    bf16* hb = (bf16*)(ws + WS_HB); bf16* z = (bf16*)(ws + WS_Z); bf16* act = (bf16*)(ws + WS_Z); bf16* y = (bf16*)(ws + WS_Y); bf16* asort = (bf16*)(ws + WS_Y);
    float* ssq = (float*)(ws + WS_SSQ); bf16* opart = (bf16*)(ws + WS_OP); float* lse = (float*)(ws + WS_LSE);
    unsigned char* rt = ws + WS_RT;
#define IN(k) (lo <= (k) && (k) < hi)
#ifndef PROBE_MASK
#define PROBE_MASK 0
#endif
#if PROBE_MASK
#define STAMP(k) do { if (blockIdx.x == 0 && threadIdx.x == 0) ((volatile LAS unsigned long long*)(F.lds + LDSCTL_OFF + 2048))[k] = __builtin_amdgcn_s_memrealtime(); } while (0)
#else
#define STAMP(k) do { } while (0)
#endif
#define SEAM(k) do { if (IN(k) && IN((k) + 1)) xcd_barrier(bar); STAMP((k) + 1); } while (0)

    STAMP(0);
    if (IN(0)) p0_prologue(F, 0);
    SEAM(0);
#pragma unroll 1
    for (int layer = 0; layer < 2; ++layer) {
        const int pb = layer == 0 ? 1 : 7;
        if (IN(pb)) {
            pg8::Gemm g{hb, (const bf16*)(ws + WS_WIN) + (size_t)layer * NPADW * DM, NTOK, NPADW, DM, F.wv}; pg8::StaticOrder S; S.init(NTOK / 256, NPADW / 256, F.G, F.blk);
            pg8::EpiZ E{z, INW, INW, ssq};
            pg8::gemm_phase<pg8::EpiZ, pg8::StaticOrder, true, true>(F.lds, g, S, E);
        }
        SEAM(pb);
#if defined(PROBE_SUB)
        const unsigned long long tsub0 = __builtin_amdgcn_s_memrealtime();
#endif
        if (IN(pb + 1)) {
            if (F.blk < 32) {
                gla_chain(F, z, y, inptr(F, IN_GG2) + layer * 16 * 128, inptr(F, IN_GGB) + layer * 128, inptr(F, IN_GNG) + layer * 64, F.blk >> 2, F.blk & 3);
            } else {
                const int wi = F.blk - 32, nw = F.G - 32;
                const RwkvP RP{inptr(F, IN_MU) + layer * 896, inptr(F, IN_W0) + layer * 256, inptr(F, IN_W2) + layer * 32 * 256, inptr(F, IN_A0) + layer * 256, inptr(F, IN_A2) + layer * 32 * 256, inptr(F, IN_G2) + layer * 64 * 256,
                               inptr(F, IN_KK) + layer * 256, inptr(F, IN_KA) + layer * 256, inptr(F, IN_RK) + layer * 256, inptr(F, IN_RLG) + layer * 256, inptr(F, IN_RLB) + layer * 256};
                unsigned char* recs = ws + WS_MOEW;
                for (int tile = wi; tile < 3072; tile += nw) attn_tile(F.lds, z, opart, lse, inptr(F, IN_RELB), inptr(F, IN_QG) + layer * 64, inptr(F, IN_KG) + layer * 64, tile, mytid(F));
                for (int item = wi; item < 512; item += nw) conv_item(F, z, y, inptr(F, IN_CW) + layer * 31 * 256, inptr(F, IN_CB) + layer * 256, inptr(F, IN_CLG) + layer * 256, inptr(F, IN_CLB) + layer * 256, item);
                { const int tid_ = mytid(F), lane_ = tid_ & 63, w_ = __builtin_amdgcn_readfirstlane(tid_ >> 6);
#pragma unroll 1
                    for (int h = 0; h < 4; ++h) {
                        rwkv_prep_init(F, RP, h); BAR();
                        u32x4 cur[2], prv[2], ncur[2], nprv[2];
#pragma unroll
                        for (int q = 0; q < 2; ++q) { cur[q] = (u32x4){0u, 0u, 0u, 0u}; prv[q] = cur[q]; ncur[q] = cur[q]; nprv[q] = cur[q]; }
                        if (wi < 2048) rwkv_prep_load(z, wi >> 8, h, wi & 255, w_, lane_, cur, prv);
#pragma unroll 1
                        for (int it = wi; it < 2048; it += nw) { const int nx = it + nw;
                            if (nx < 2048) rwkv_prep_load(z, nx >> 8, h, nx & 255, w_, lane_, ncur, nprv);
                            rwkv_prep_item(F, recs + (size_t)(((it >> 8) * 4 + h) * 256 + (it & 255)) * RC_STRIDE, RP, h, cur, prv);
#pragma unroll
                            for (int q = 0; q < 2; ++q) { cur[q] = ncur[q]; prv[q] = nprv[q]; } }
                        BAR(); } }
            }
        }
        SEAM(pb + 1);
        if (IN(pb + 2)) {
            if (F.blk < 32) {
                const RwkvP RP{inptr(F, IN_MU) + layer * 896, inptr(F, IN_W0) + layer * 256, inptr(F, IN_W2) + layer * 32 * 256, inptr(F, IN_A0) + layer * 256, inptr(F, IN_A2) + layer * 32 * 256, inptr(F, IN_G2) + layer * 64 * 256,
                               inptr(F, IN_KK) + layer * 256, inptr(F, IN_KA) + layer * 256, inptr(F, IN_RK) + layer * 256, inptr(F, IN_RLG) + layer * 256, inptr(F, IN_RLB) + layer * 256};
                unsigned char* recs = ws + WS_MOEW;
                rwkv_state(F, recs, y, RP, F.blk >> 2, F.blk & 3); }
            else attn_merge(F, opart, lse, y);
        }
        SEAM(pb + 2);
        if (IN(pb + 3)) {
            pg8::Gemm g{y, (const bf16*)(ws + WS_WOUT) + (size_t)layer * DM * DM, NTOK, DM, DM, F.wv}; pg8::StaticOrder S; S.init(NTOK / 256, DM / 256, F.G, F.blk);
            pg8::EpiRes E{layer == 0 ? inptr(F, IN_X) : (const float*)F.out, F.out, hb, ssq};
            pg8::gemm_phase<pg8::EpiRes, pg8::StaticOrder, true, true>(F.lds, g, S, E);
        }
        SEAM(pb + 3);
        if (layer == 0) {
            if (IN(5)) {
                pg8::Gemm g{hb, (const bf16*)(ws + WS_WGU), NTOK, 2 * DFF, DM, F.wv}; pg8::StaticOrder S; S.init(NTOK / 256, 2 * DFF / 256, F.G, F.blk);
                pg8::EpiSwiGLU<false> E{act, ssq, nullptr};
                pg8::gemm_phase<pg8::EpiSwiGLU<false>, pg8::StaticOrder, true, true>(F.lds, g, S, E);
            }
            SEAM(5);
            if (IN(6)) {
                pg8::Gemm g{act, (const bf16*)(ws + WS_WD), NTOK, DM, DFF, F.wv}; pg8::StaticOrder S; S.init(NTOK / 256, DM / 256, F.G, F.blk);
                pg8::EpiRes E{F.out, F.out, hb, ssq};
                pg8::gemm_phase<pg8::EpiRes, pg8::StaticOrder, true, true>(F.lds, g, S, E);
            }
            SEAM(6);
        }
    }
    if (IN(11)) { moe_route(F, F.out, inptr(F, IN_FFNG) + DM, inptr(F, IN_ROUTER)); __syncthreads(); p0_prologue(F, 1); }
    SEAM(11);
    if (IN(12)) moe_gather(F, 0, hb, asort);
    SEAM(12);
#pragma unroll 1
    for (int slot = 0; slot < 2; ++slot) {
        const int pg = 13 + 2 * slot;
        const int* tilee = (const int*)(rt + RT_TILEE) + slot * 256;
        if (IN(pg)) {
            const int nt = __builtin_amdgcn_readfirstlane(((const int*)(rt + RT_NTILES))[slot]);
            pg8::Gemm g{asort, (const bf16*)(ws + WS_MOEW), nt * 256, 2 * DFF, DM, F.wv}; pg8::StaticOrder S; S.init(nt, 2 * DFF / 256, F.G, F.blk, tilee, MOEW_E_BYTES);
            pg8::EpiSwiGLU<true> E{act, nullptr, (const float*)(rt + RT_ROWRSTD) + slot * MOE_ROWS};
            pg8::gemm_phase<pg8::EpiSwiGLU<true>, pg8::StaticOrder, true, true>(F.lds, g, S, E);
        }
        SEAM(pg);
        if (IN(pg + 1)) {
            const int nt = __builtin_amdgcn_readfirstlane(((const int*)(rt + RT_NTILES))[slot]);
            pg8::Gemm g{act, (const bf16*)(ws + WS_MOEW + MOEW_GU_BYTES), nt * 256, DM, DFF, F.wv}; pg8::StaticOrder S; S.init(nt, DM / 256, F.G, F.blk, tilee, MOEW_E_BYTES);
            pg8::EpiMoeDown E{F.out, (const int*)(rt + RT_ROWTOK) + slot * MOE_ROWS, (const float*)(rt + RT_ROWGATE) + slot * MOE_ROWS};
            pg8::gemm_phase<pg8::EpiMoeDown, pg8::StaticOrder, true, true>(F.lds, g, S, E);
            if (slot == 0) moe_gather(F, 1, hb, asort);
        }
        if (slot == 0) SEAM(pg + 1);
    }
#if PROBE_MASK
    __syncthreads();
    if (blockIdx.x == 0 && threadIdx.x == 0) { STAMP(17); volatile LAS unsigned long long* ts = (volatile LAS unsigned long long*)(F.lds + LDSCTL_OFF + 2048); unsigned long long tot = 0;
        for (int k = 0; k < 17; ++k) if ((PROBE_MASK >> k) & 1) tot += ts[k + 1] - ts[k];
#if defined(PROBE_SUB)
        tot = (PROBE_SUB == 0) ? ((volatile unsigned long long*)(F.ws + 32768))[0] : ((volatile unsigned long long*)(F.ws + 32768))[PROBE_SUB] + ((volatile unsigned long long*)(F.ws + 32768))[4 + PROBE_SUB];
#endif
        const unsigned long long t0 = __builtin_amdgcn_s_memrealtime(); while (__builtin_amdgcn_s_memrealtime() - t0 < tot) __builtin_amdgcn_s_sleep(8); }
#endif
#undef IN
#undef SEAM
}

extern "C" void kernel_launch(void* const* d_in, const int* in_sizes, int n_in, void* d_out, int out_size, void* d_ws, size_t ws_size, hipStream_t stream) {
    static int grid = 0;
    if (grid == 0) {
        if (n_in != 33 || out_size != NTOK * DM || ws_size < WS_END) { fprintf(stderr, "kernel_launch: unexpected problem (n_in %d out %d ws %zu)\n", n_in, out_size, ws_size); grid = -1; return; }
        int dev = 0, cus = 0;
        if (hipGetDevice(&dev) != hipSuccess || hipDeviceGetAttribute(&cus, hipDeviceAttributeMultiprocessorCount, dev) != hipSuccess) { grid = -1; return; }
        if (hipFuncSetAttribute((const void*)mk_fwd, hipFuncAttributeMaxDynamicSharedMemorySize, LDS_BYTES) != hipSuccess) { fprintf(stderr, "kernel_launch: hipFuncSetAttribute failed\n"); grid = -1; return; }
        (void)hipGetLastError();
        grid = cus;
        if (grid != 256) fprintf(stderr, "kernel_launch: %d CUs (built for 256)\n", grid);
    }
    if (grid < 0) return;
    (void)hipMemsetAsync((char*)d_ws + WS_CTL, 0, CTL_ZERO_BYTES, stream);
    Params p{};
    for (int i = 0; i < 33; ++i) p.in[i] = (const float*)d_in[i];
    p.out = (float*)d_out; p.ws = (unsigned char*)d_ws;
#if MK_PER_PHASE
    for (int k = 0; k < N_PHASES; ++k) { p.ph_lo = k; p.ph_hi = k + 1; hipLaunchKernelGGL(mk_fwd, dim3(grid), dim3(NTHREADS), LDS_BYTES, stream, p); }
#else
    p.ph_lo = 0; p.ph_hi = N_PHASES;
    hipLaunchKernelGGL(mk_fwd, dim3(grid), dim3(NTHREADS), LDS_BYTES, stream, p);
#endif
}
```

```cpp
#include <hip/hip_runtime.h>
#include <cstdio>
#include <cstdint>

#define LAS __attribute__((address_space(3)))
#define GAS __attribute__((address_space(1)))
typedef unsigned short bf16;
typedef short bf16x8 __attribute__((ext_vector_type(8)));
typedef short s16x4 __attribute__((ext_vector_type(4)));
typedef float f32x4 __attribute__((ext_vector_type(4)));
typedef float f32x2 __attribute__((ext_vector_type(2)));
typedef unsigned u32x4 __attribute__((ext_vector_type(4)));
typedef unsigned u32x2 __attribute__((ext_vector_type(2)));

constexpr int DM = 1024, NB = 8, SEQ = 4096, NTOK = NB * SEQ, INW = 2960, NPADW = 3072, DFF = 2816, NEXP = 8;
constexpr int ZA = 0, ZB = 768, ZC = 1280, ZD = 2176;
constexpr float NORM_EPS = 1e-6f;
constexpr int MOE_ROWS = NTOK + NEXP * 256;

constexpr size_t MiB = 1u << 20;
constexpr size_t WS_CTL = 0, CTL_ZERO_BYTES = 64 * 1024;
constexpr size_t WS_WIN = 1 * MiB;
constexpr size_t WS_WOUT = 13 * MiB;
constexpr size_t WS_WGU = 17 * MiB;
constexpr size_t WS_WD = 28 * MiB;
constexpr size_t WS_SSQ = 34 * MiB;
constexpr size_t WS_RT = 36 * MiB;
constexpr size_t WS_HB = 40 * MiB;
constexpr size_t WS_Z = 104 * MiB;
constexpr size_t WS_Y = 297 * MiB;
constexpr size_t WS_MOEW = 367 * MiB;
constexpr size_t WS_END = 499 * MiB;
constexpr size_t WS_GLAEC = 499 * MiB;
constexpr size_t WS_TOTAL = 500 * MiB;
constexpr size_t MOEW_GU_BYTES = (size_t)2 * DFF * DM * 2, MOEW_D_BYTES = (size_t)DM * DFF * 2, MOEW_E_BYTES = MOEW_GU_BYTES + MOEW_D_BYTES;
static_assert(WS_Z + (size_t)MOE_ROWS * DFF * 2 <= WS_Y && WS_Y + (size_t)MOE_ROWS * DM * 2 <= WS_MOEW && WS_MOEW + NEXP * MOEW_E_BYTES <= WS_END, "ws map");
constexpr size_t WS_OP = WS_HB;
constexpr size_t WS_LSE = WS_HB + 48 * MiB;
constexpr size_t RT_TOPE = 0;
constexpr size_t RT_GATE = RT_TOPE + (size_t)NTOK * 8;
constexpr size_t RT_RANK = RT_GATE + (size_t)NTOK * 8;
constexpr size_t RT_RSTD = RT_RANK + (size_t)NTOK * 8;
constexpr size_t RT_HIST = RT_RSTD + (size_t)NTOK * 4;
constexpr size_t RT_ROWTOK = RT_HIST + 256 * 16 * 4;
constexpr size_t RT_ROWGATE = RT_ROWTOK + (size_t)2 * MOE_ROWS * 4;
constexpr size_t RT_ROWRSTD = RT_ROWGATE + (size_t)2 * MOE_ROWS * 4;
constexpr size_t RT_TILEE = RT_ROWRSTD + (size_t)2 * MOE_ROWS * 4;
constexpr size_t RT_NTILES = RT_TILEE + 2 * 256 * 4;
static_assert(RT_NTILES + 64 <= 4 * MiB, "routing arrays");

constexpr int CW_BAR = 1024;

constexpr int RING_BYTES = 131072, LDSCTL_OFF = RING_BYTES, MISC_OFF = LDSCTL_OFF + 320, LDS_BYTES = 147456;
constexpr int NWAVES = 8, NTHREADS = 512;

#define LDS_WAIT() asm volatile("s_waitcnt lgkmcnt(0)" ::: "memory")
#define VM_WAIT() asm volatile("s_waitcnt vmcnt(0)" ::: "memory")
#define BAR() do { asm volatile("s_waitcnt lgkmcnt(0)" ::: "memory"); __builtin_amdgcn_s_barrier(); asm volatile("" ::: "memory"); } while (0)
__device__ __forceinline__ unsigned f2bf(float f) { unsigned u = __builtin_bit_cast(unsigned, f); return (u + 0x7fffu + ((u >> 16) & 1u)) >> 16; }
typedef __bf16 bf16x2_hw __attribute__((ext_vector_type(2)));
__device__ __forceinline__ unsigned pk2(float lo, float hi) { const f32x2 v = {lo, hi}; const bf16x2_hw b = __builtin_convertvector(v, bf16x2_hw); return __builtin_bit_cast(unsigned, b); }
__device__ __forceinline__ float bflo(unsigned w) { return __builtin_bit_cast(float, w << 16); }
__device__ __forceinline__ float bfhi(unsigned w) { return __builtin_bit_cast(float, w & 0xffff0000u); }
__device__ __forceinline__ float bf1(bf16 b) { return __builtin_bit_cast(float, (unsigned)b << 16); }
__device__ __forceinline__ float wave_sum(float v) {
#pragma unroll
    for (int o = 1; o < 64; o <<= 1) v += __shfl_xor(v, o);
    return v;
}
#define DPP_ADD(v, ctrl) ((v) + __builtin_bit_cast(float, __builtin_amdgcn_update_dpp(0, __builtin_bit_cast(int, (v)), (ctrl), 0xf, 0xf, true)))
__device__ __forceinline__ float red8(float v) { v = DPP_ADD(v, 0xB1); v = DPP_ADD(v, 0x4E); v = DPP_ADD(v, 0x141); return v; }
__device__ __forceinline__ float red16(float v) { v = DPP_ADD(v, 0xB1); v = DPP_ADD(v, 0x4E); v = DPP_ADD(v, 0x141); v = DPP_ADD(v, 0x140); return v; }
__device__ __forceinline__ float sigmoidf_(float x) { return 1.0f / (1.0f + __expf(-x)); }
__device__ __forceinline__ float siluf_(float x) { return x / (1.0f + __expf(-x)); }
__device__ __forceinline__ float softplusf_(float x) { return fmaxf(x, 0.f) + __logf(1.0f + __expf(-fabsf(x))); }
__device__ __forceinline__ float tanhf_(float x) { const float e = __expf(2.0f * x); return 1.0f - 2.0f / (e + 1.0f); }
__device__ __forceinline__ void unpack8(const u32x4 w, float (&f)[8]) {
    f[0] = bflo(w.x); f[1] = bfhi(w.x); f[2] = bflo(w.y); f[3] = bfhi(w.y); f[4] = bflo(w.z); f[5] = bfhi(w.z); f[6] = bflo(w.w); f[7] = bfhi(w.w);
}

namespace pg8 {
#define PG8_LAS __attribute__((address_space(3)))
typedef unsigned short bf16_t;
constexpr int BM = 256, BK = 64, HALF = 128, HTB = HALF * BK * 2  , STAGE_BYTES = 8 * HTB, NXCD = 8, WGM = 8;

__host__ __device__ __forceinline__ int lds_byte(int r, int c) { const int st = (r >> 4) * 2 + (c >> 5), rr = r & 15, cc = c & 31, ob = rr * 64 + cc * 2; return st * 1024 + (ob ^ (((ob >> 9) & 1) << 5)); }
__host__ __device__ __forceinline__ void stage_rc(int b, int& R, int& C) { const int st = b / 1024, sb = b % 1024, swz = sb ^ (((sb >> 9) & 1) << 5); R = (st >> 1) * 16 + swz / 64; C = (st & 1) * 32 + (swz % 64) / 2; }
__host__ __device__ __forceinline__ int perm32(int rho) { const int n = rho >> 4, i = rho & 15; return 8 * (i >> 2) + 4 * n + (i & 3); }

struct Unit { int pm, pn; };
struct Gemm { const bf16_t* A; const bf16_t* Bt; int M, N, K, wv; };

struct StaticOrder {
    int nM, nN, nwg, G, c; const int* tile_e; size_t estride;
    __device__ void init(int nM_, int nN_, int G_, int c_, const int* te = nullptr, size_t es = 0) { nM = nM_; nN = nN_; nwg = nM * nN; G = G_; c = c_; tile_e = te; estride = es; }
    __device__ bool next(int i, Unit& u) const {
        const long L = (long)i * G + c; if (L >= nwg) return false;
        int wgid = (int)L; { const int q = nwg / NXCD, r = nwg % NXCD, xcd = wgid % NXCD, off = wgid / NXCD; wgid = (xcd < r ? xcd * (q + 1) : r * (q + 1) + (xcd - r) * q) + off; }
        const int nig = WGM * nN, gid = wgid / nig, fm = gid * WGM, gsz = (nM - fm) < WGM ? (nM - fm) : WGM;
        u.pm = fm + ((wgid % nig) % gsz); u.pn = (wgid % nig) / gsz; return true;
    }
    __device__ __forceinline__ size_t bofs(const Unit& u, size_t tstep) const { return (size_t)u.pn * tstep + (tile_e ? (size_t)__builtin_amdgcn_readfirstlane(tile_e[u.pm]) * estride : (size_t)0); }
    __device__ __forceinline__ void a_ready(const Unit&) const {}
    __device__ __forceinline__ void done(const Unit&) const {}
};

__device__ __forceinline__ unsigned cvt_pk_bf16(float lo, float hi) { unsigned r; asm volatile("v_cvt_pk_bf16_f32 %0, %1, %2" : "=v"(r) : "v"(lo), "v"(hi)); return r; }

__device__ __forceinline__ float row_rstd16(const float* ssq, int r, int fq) {
    const f32x4 p = *(const f32x4*)(ssq + (size_t)r * 16 + 4 * fq);
    float s = (p[0] + p[1]) + (p[2] + p[3]); s += __shfl_xor(s, 16); s += __shfl_xor(s, 32);
    return __builtin_amdgcn_rsqf(s * (1.0f / DM) + NORM_EPS);
}

struct EpiZ {
    static constexpr bool PERM = true, AFTER_DRAIN = false;
    bf16_t* Z; int ldc, ncols; const float* ssq;
    __device__ __forceinline__ void operator()(const f32x4 (&acc)[2][2][4][2], const Unit& u, int wr, int wc, int fr, int fq) const {
        const int row0 = u.pm * BM + wr * 64 + fr, col0 = u.pn * BM + wc * 32 + 8 * fq;
#pragma unroll
        for (int ai = 0; ai < 2; ++ai)
#pragma unroll
            for (int m = 0; m < 4; ++m) { const int r = row0 + ai * HALF + m * 16; const float rs = row_rstd16(ssq, r, fq); bf16_t* rowp = Z + (size_t)r * ldc + col0;
#pragma unroll
                for (int bj = 0; bj < 2; ++bj) { const f32x4 v0 = acc[ai][bj][m][0] * rs, v1 = acc[ai][bj][m][1] * rs;
                    u32x4 w; w.x = cvt_pk_bf16(v0[0], v0[1]); w.y = cvt_pk_bf16(v0[2], v0[3]); w.z = cvt_pk_bf16(v1[0], v1[1]); w.w = cvt_pk_bf16(v1[2], v1[3]);
                    if (col0 + bj * HALF < ncols) *(u32x4*)(rowp + bj * HALF) = w; } }
    }
};
template <bool MOE> struct EpiSwiGLU {
    static constexpr bool PERM = true, AFTER_DRAIN = false;
    bf16_t* O; const float* ssq; const float* row_rstd;
    __device__ __forceinline__ void operator()(const f32x4 (&acc)[2][2][4][2], const Unit& u, int wr, int wc, int fr, int fq) const {
        const int row0 = u.pm * BM + wr * 64 + fr, col0 = u.pn * HALF + wc * 32 + 8 * fq;
#pragma unroll
        for (int ai = 0; ai < 2; ++ai)
#pragma unroll
            for (int m = 0; m < 4; ++m) { const int r = row0 + ai * HALF + m * 16; float rs; if (MOE) rs = row_rstd[r]; else rs = row_rstd16(ssq, r, fq);
                const f32x4 g0 = acc[ai][0][m][0] * rs, g1 = acc[ai][0][m][1] * rs, u0 = acc[ai][1][m][0] * rs, u1 = acc[ai][1][m][1] * rs; f32x4 a0, a1;
#pragma unroll
                for (int j = 0; j < 4; ++j) { a0[j] = g0[j] * __builtin_amdgcn_rcpf(1.0f + __expf(-g0[j])) * u0[j]; a1[j] = g1[j] * __builtin_amdgcn_rcpf(1.0f + __expf(-g1[j])) * u1[j]; }
                u32x4 w; w.x = cvt_pk_bf16(a0[0], a0[1]); w.y = cvt_pk_bf16(a0[2], a0[3]); w.z = cvt_pk_bf16(a1[0], a1[1]); w.w = cvt_pk_bf16(a1[2], a1[3]);
                *(u32x4*)(O + (size_t)r * DFF + col0) = w; }
    }
};
struct EpiRes {
    static constexpr bool PERM = false, AFTER_DRAIN = false;
    const float* base; float* out; bf16_t* hb; float* ssq;
    __device__ __forceinline__ void operator()(const f32x4 (&acc)[2][2][4][2], const Unit& u, int wr, int wc, int fr, int fq) const {
        const int col0 = u.pn * BM + wc * 32 + 4 * fq;
#pragma unroll
        for (int ai = 0; ai < 2; ++ai)
#pragma unroll
            for (int m = 0; m < 4; ++m) { const int r = u.pm * BM + ai * HALF + wr * 64 + m * 16 + fr; const size_t off = (size_t)r * DM + col0; float ss = 0.f;
#pragma unroll
                for (int bj = 0; bj < 2; ++bj)
#pragma unroll
                    for (int n = 0; n < 2; ++n) { const f32x4 v = *(const f32x4*)(base + off + bj * HALF + n * 16) + acc[ai][bj][m][n];
                        *(f32x4*)(out + off + bj * HALF + n * 16) = v; ss += (v[0] * v[0] + v[1] * v[1]) + (v[2] * v[2] + v[3] * v[3]);
                        if (hb) { u32x2 w; w.x = cvt_pk_bf16(v[0], v[1]); w.y = cvt_pk_bf16(v[2], v[3]); *(u32x2*)(hb + off + bj * HALF + n * 16) = w; } }
                ss += __shfl_xor(ss, 16); ss += __shfl_xor(ss, 32);
                if (ssq && fq == 0) ssq[(size_t)r * 16 + u.pn * 4 + wc] = ss;
                if (m & 1) asm volatile("" ::: "memory"); }
    }
};
struct EpiMoeDown {
    static constexpr bool PERM = false, AFTER_DRAIN = false;
    float* out; const int* row_tok; const float* row_gate;
    __device__ __forceinline__ void operator()(const f32x4 (&acc)[2][2][4][2], const Unit& u, int wr, int wc, int fr, int fq) const {
        const int col0 = u.pn * BM + wc * 32 + 4 * fq;
#pragma unroll
        for (int ai = 0; ai < 2; ++ai)
#pragma unroll
            for (int m = 0; m < 4; ++m) { const int r = u.pm * BM + ai * HALF + wr * 64 + m * 16 + fr; const int tok = row_tok[r]; const float gt = row_gate[r];
                if (tok >= 0) { float* op = out + (size_t)tok * DM + col0;
#pragma unroll
                    for (int bj = 0; bj < 2; ++bj)
#pragma unroll
                        for (int n = 0; n < 2; ++n) { float* p = op + bj * HALF + n * 16; *(f32x4*)p = *(const f32x4*)p + acc[ai][bj][m][n] * gt; } }
                if (m & 1) asm volatile("" ::: "memory"); }
    }
};

template <class Epi, class Sched, bool ALIGN_EPI = false, bool SP2 = false>
__device__ __forceinline__ void gemm_phase(PG8_LAS unsigned char* lds, const Gemm g, const Sched& S, const Epi& E) {
    int lid_; asm volatile("v_mbcnt_lo_u32_b32 %0, -1, 0\n\tv_mbcnt_hi_u32_b32 %0, -1, %0" : "=v"(lid_)); int tid_ = g.wv * 64 + lid_; asm volatile("" : "+v"(tid_));
    const int tid = tid_, wid = __builtin_amdgcn_readfirstlane(tid >> 6), lane = tid & 63, wr = wid >> 2, wc = wid & 3, fr = lane & 15, fq = lane >> 4;
    const int K = g.K, nt = K / BK;
    unsigned voffA[2], voffB[2];
#pragma unroll
    for (int i = 0; i < 2; ++i) { int R, C; stage_rc(tid * 16 + i * 8192, R, C); const int Rb = Epi::PERM ? ((R & ~31) + perm32(R & 31)) : R;
        voffA[i] = (unsigned)(R * K + C) * 2u; voffB[i] = (unsigned)(Rb * K + C) * 2u; }
    const size_t kstep = (size_t)(BK * 2);
    const size_t hstep = (size_t)HALF * K * 2;
    const size_t tstep = 2 * hstep;
    const unsigned ldsw = (unsigned)wid * 1024u;
    const int aoff = lds_byte(wr * 64 + fr, fq * 8), boff = lds_byte(wc * 32 + fr, fq * 8);
#define PG8_SA(b, h) (((b) * 2 + (h)) * HTB)
#define PG8_SB(b, h) ((4 + (b) * 2 + (h)) * HTB)
#define PG8_STAGE(bufoff, gbase, voff) do { _Pragma("unroll") for (int _i = 0; _i < 2; ++_i) \
        __builtin_amdgcn_global_load_lds((const unsigned*)((const char*)(gbase) + (voff)[_i]), (PG8_LAS unsigned*)(lds + (bufoff) + ldsw + _i * 8192), 16, 0, 0); } while (0)
#define PG8_LDA(dst, b, h) do { _Pragma("unroll") for (int m = 0; m < 4; ++m) _Pragma("unroll") for (int k = 0; k < 2; ++k) dst[m][k] = *(const PG8_LAS bf16x8*)(lds + PG8_SA(b, h) + aoff + m * 2048 + k * 1024); } while (0)
#define PG8_LDB(dst, b, h) do { _Pragma("unroll") for (int n = 0; n < 2; ++n) _Pragma("unroll") for (int k = 0; k < 2; ++k) dst[n][k] = *(const PG8_LAS bf16x8*)(lds + PG8_SB(b, h) + boff + n * 2048 + k * 1024); } while (0)
#define PG8_MMA(ai, bj, At, Bt) do { __builtin_amdgcn_s_setprio(1); _Pragma("unroll") for (int m = 0; m < 4; ++m) _Pragma("unroll") for (int n = 0; n < 2; ++n) _Pragma("unroll") for (int k = 0; k < 2; ++k) \
        acc[ai][bj][m][n] = __builtin_amdgcn_mfma_f32_16x16x32_bf16(Bt[n][k], At[m][k], acc[ai][bj][m][n], 0, 0, 0); __builtin_amdgcn_s_setprio(0); } while (0)
#define PG8_WAIT_V(n) asm volatile("s_waitcnt vmcnt(" #n ")" ::: "memory")
#define PG8_WAIT_L(n) asm volatile("s_waitcnt lgkmcnt(" #n ")" ::: "memory")
#define PG8_BAR __builtin_amdgcn_s_barrier()
#define PG8_SCHED __builtin_amdgcn_sched_barrier(0)
    Unit cur, nxt; int ui = 0;
    if (!S.next(0, cur)) return;
    f32x4 acc[2][2][4][2];
#pragma unroll
    for (int a = 0; a < 2; ++a)
#pragma unroll
        for (int b = 0; b < 2; ++b)
#pragma unroll
            for (int m = 0; m < 4; ++m)
#pragma unroll
                for (int n = 0; n < 2; ++n) acc[a][b][m][n] = (f32x4){0.f, 0.f, 0.f, 0.f};
    bf16x8 At[4][2], B0[2][2], B1[2][2];
    const char* cA = (const char*)g.A + (size_t)cur.pm * tstep; const char* cB = (const char*)g.Bt + S.bofs(cur, tstep);
    S.a_ready(cur);
    if constexpr (SP2) {
        PG8_STAGE(PG8_SB(0, 0), cB, voffB); PG8_STAGE(PG8_SB(0, 1), cB + hstep, voffB); PG8_STAGE(PG8_SA(0, 0), cA, voffA); PG8_STAGE(PG8_SA(0, 1), cA + hstep, voffA);
        if (wr == 1) PG8_BAR;
        PG8_WAIT_V(2); PG8_BAR;
        PG8_STAGE(PG8_SB(1, 0), cB + kstep, voffB); PG8_STAGE(PG8_SA(1, 0), cA + kstep, voffA); PG8_STAGE(PG8_SB(1, 1), cB + hstep + kstep, voffB);
        PG8_WAIT_V(6); PG8_BAR;
    } else {
        PG8_STAGE(PG8_SB(0, 0), cB, voffB); PG8_STAGE(PG8_SA(0, 0), cA, voffA); PG8_STAGE(PG8_SB(0, 1), cB + hstep, voffB); PG8_STAGE(PG8_SA(0, 1), cA + hstep, voffA);
        if (wr == 1) PG8_BAR;
        PG8_WAIT_V(4); PG8_BAR;
        PG8_STAGE(PG8_SB(1, 0), cB + kstep, voffB); PG8_STAGE(PG8_SA(1, 0), cA + kstep, voffA); PG8_STAGE(PG8_SB(1, 1), cB + hstep + kstep, voffB);
        PG8_WAIT_V(6); PG8_BAR;
    }
    for (;;) {
        const bool has_next = S.next(ui + 1, nxt);
        const char* nA = has_next ? (const char*)g.A + (size_t)nxt.pm * tstep : cA; const char* nB = has_next ? (const char*)g.Bt + S.bofs(nxt, tstep) : cB;
        for (int t = 0; t < nt; t += 2) {
            const bool last = (t == nt - 2);
            const char* a1 = cA + (size_t)(t + 1) * kstep;
            const char* a2 = last ? nA : cA + (size_t)(t + 2) * kstep; const char* b2 = last ? nB : cB + (size_t)(t + 2) * kstep;
            const char* a3 = a2 + kstep; const char* b3 = b2 + kstep;
            if (last && has_next) S.a_ready(nxt);
            if constexpr (SP2) {
            PG8_LDB(B0, 0, 0); PG8_LDB(B1, 0, 1); PG8_SCHED; PG8_LDA(At, 0, 0); PG8_STAGE(PG8_SA(1, 1), a1 + hstep, voffA);
            PG8_WAIT_V(8); PG8_WAIT_L(0); PG8_BAR; PG8_MMA(0, 0, At, B0); PG8_MMA(0, 1, At, B1); PG8_BAR; PG8_SCHED;
            PG8_LDA(At, 0, 1); PG8_STAGE(PG8_SB(0, 0), b2, voffB); PG8_STAGE(PG8_SB(0, 1), b2 + hstep, voffB); PG8_STAGE(PG8_SA(0, 0), a2, voffA);
            PG8_WAIT_V(8); PG8_WAIT_L(0); PG8_BAR; PG8_MMA(1, 0, At, B0); PG8_MMA(1, 1, At, B1); PG8_BAR; PG8_SCHED;
            PG8_LDB(B0, 1, 0); PG8_LDB(B1, 1, 1); PG8_SCHED; PG8_LDA(At, 1, 0); PG8_STAGE(PG8_SA(0, 1), a2 + hstep, voffA);
            PG8_WAIT_V(8); PG8_WAIT_L(0); PG8_BAR; PG8_MMA(0, 0, At, B0); PG8_MMA(0, 1, At, B1); PG8_BAR; PG8_SCHED;
            PG8_LDA(At, 1, 1); PG8_STAGE(PG8_SB(1, 0), b3, voffB); PG8_STAGE(PG8_SB(1, 1), b3 + hstep, voffB); PG8_STAGE(PG8_SA(1, 0), a3, voffA);
            PG8_WAIT_V(8); PG8_WAIT_L(0); PG8_BAR; PG8_MMA(1, 0, At, B0); PG8_MMA(1, 1, At, B1); PG8_BAR; PG8_SCHED;
            } else {
            PG8_LDB(B0, 0, 0); PG8_SCHED; PG8_LDA(At, 0, 0); PG8_STAGE(PG8_SA(1, 1), a1 + hstep, voffA);
            PG8_WAIT_L(8); PG8_BAR; PG8_WAIT_L(0); PG8_MMA(0, 0, At, B0); PG8_BAR; PG8_SCHED;
            PG8_LDB(B1, 0, 1); PG8_STAGE(PG8_SB(0, 0), b2, voffB);
            PG8_BAR; PG8_WAIT_L(0); PG8_MMA(0, 1, At, B1); PG8_BAR;
            PG8_LDA(At, 0, 1); PG8_STAGE(PG8_SA(0, 0), a2, voffA);
            PG8_BAR; PG8_WAIT_L(0); PG8_MMA(1, 0, At, B0); PG8_BAR; PG8_SCHED;
            PG8_STAGE(PG8_SB(0, 1), b2 + hstep, voffB);
            PG8_WAIT_V(6); PG8_BAR; PG8_MMA(1, 1, At, B1); PG8_BAR;
            PG8_LDB(B0, 1, 0); PG8_SCHED; PG8_LDA(At, 1, 0); PG8_STAGE(PG8_SA(0, 1), a2 + hstep, voffA);
            PG8_WAIT_L(8); PG8_BAR; PG8_WAIT_L(0); PG8_MMA(0, 0, At, B0); PG8_BAR; PG8_SCHED;
            PG8_LDB(B1, 1, 1); PG8_STAGE(PG8_SB(1, 0), b3, voffB);
            PG8_BAR; PG8_WAIT_L(0); PG8_MMA(0, 1, At, B1); PG8_BAR;
            PG8_LDA(At, 1, 1); PG8_STAGE(PG8_SA(1, 0), a3, voffA);
            PG8_BAR; PG8_WAIT_L(0); PG8_MMA(1, 0, At, B0); PG8_BAR; PG8_SCHED;
            PG8_STAGE(PG8_SB(1, 1), b3 + hstep, voffB);
            PG8_WAIT_V(6); PG8_BAR; PG8_MMA(1, 1, At, B1); PG8_BAR;
            }
        }
        if constexpr (ALIGN_EPI) { if (wr == 0) PG8_BAR; }
        if constexpr (!Epi::AFTER_DRAIN) { E(acc, cur, wr, wc, fr, fq); S.done(cur); }
        if (!has_next) break;
#pragma unroll
        for (int a = 0; a < 2; ++a)
#pragma unroll
            for (int b = 0; b < 2; ++b)
#pragma unroll
                for (int m = 0; m < 4; ++m)
#pragma unroll
                    for (int n = 0; n < 2; ++n) acc[a][b][m][n] = (f32x4){0.f, 0.f, 0.f, 0.f};
        cur = nxt; cA = nA; cB = nB; ++ui;
        if constexpr (ALIGN_EPI) { if (wr == 1) PG8_BAR; }
    }
    PG8_WAIT_V(0);
    if constexpr (!ALIGN_EPI) { if (wr == 0) PG8_BAR; }
    PG8_BAR;
    if constexpr (Epi::AFTER_DRAIN) { E.fused(acc, cur, wr, wc, fr, fq, lds, wid, lane); S.done(cur); }
#undef PG8_SA
#undef PG8_SB
#undef PG8_STAGE
#undef PG8_LDA
#undef PG8_LDB
#undef PG8_MMA
#undef PG8_WAIT_V
#undef PG8_WAIT_L
#undef PG8_BAR
#undef PG8_SCHED
}
}
#define XB_TMO      128
#define XB_XCNT(j)  (256  + 64 * (j))
#define XB_XSUB(j)  (1280 + 64 * (j))
#define XB_XGEN(j)  (2304 + 64 * (j))
#define XB_TOP      3328
#define XB_TOPGEN   3392
#define XCD_BAR_WORDS 3456
#define XB_SPIN_CAP (1u << 18)

__device__ __forceinline__ unsigned xb_ld(unsigned* p)              { return __hip_atomic_load(p, __ATOMIC_RELAXED, __HIP_MEMORY_SCOPE_AGENT); }
__device__ __forceinline__ unsigned xb_add(unsigned* p, unsigned v) { return __hip_atomic_fetch_add(p, v, __ATOMIC_RELAXED, __HIP_MEMORY_SCOPE_AGENT); }
__device__ __forceinline__ unsigned xb_xcc_id() { return (unsigned)__builtin_amdgcn_s_getreg((3 << 11) | 20) & 0xFu; }
#define XB_SPIN(cond, bar) do { unsigned _sp = 0; while (cond) { __builtin_amdgcn_s_sleep(1); \
    if ((++_sp & 255u) == 0u) { if (xb_ld(&(bar)[XB_TMO])) break; if (_sp > XB_SPIN_CAP) { atomicAdd(&(bar)[XB_TMO], 1u); break; } } } } while (0)

struct XcdBarrier {
    unsigned* bar; unsigned x;
    volatile LAS unsigned* st;
};

__device__ __forceinline__ XcdBarrier xcd_barrier_post(unsigned* bar, volatile LAS unsigned* st) {
    XcdBarrier b; b.bar = bar; b.x = xb_xcc_id(); b.st = st;
    if (threadIdx.x == 0) (void)xb_add(&bar[XB_XCNT(b.x)], 1u);
    return b;
}
__device__ __forceinline__ void xcd_barrier_complete(unsigned* bar, unsigned x, unsigned& nloc, unsigned& nx) {
    const unsigned G = gridDim.x * gridDim.y * gridDim.z;
    unsigned sum, cnt, mine, sp = 0u;
    for (;;) {
        sum = 0u; cnt = 0u; mine = 0u;
#pragma unroll
        for (unsigned j = 0; j < 16; ++j) { const unsigned c = xb_ld(&bar[XB_XCNT(j)]); sum += c; cnt += (c > 0u) ? 1u : 0u; mine = (j == x) ? c : mine; }
        if (sum == G) break;
        __builtin_amdgcn_s_sleep(1);
        if ((++sp & 255u) == 0u) { if (xb_ld(&bar[XB_TMO])) break; if (sp > XB_SPIN_CAP) { atomicAdd(&bar[XB_TMO], 1u); break; } }
    }
    nloc = mine > 0u ? mine : 1u; nx = cnt > 0u ? cnt : 1u;
}

__device__ __forceinline__ void xcd_barrier(const XcdBarrier& b) {
    asm volatile("s_waitcnt vmcnt(0)" ::: "memory");
    __syncthreads();
    if (threadIdx.x == 0) {
        unsigned* bar = b.bar;
        __builtin_amdgcn_s_waitcnt(0);
        unsigned nloc = b.st[0], nx = b.st[1];
        if (nloc == 0u) { xcd_barrier_complete(bar, b.x, nloc, nx); b.st[0] = nloc; b.st[1] = nx; }
        const unsigned old = xb_add(&bar[XB_XSUB(b.x)], 1u);
        const unsigned gen = old / nloc;
        if (old + 1u == (gen + 1u) * nloc) {
            __builtin_amdgcn_fence(__ATOMIC_RELEASE, "agent");
            asm volatile("s_waitcnt vmcnt(0)" ::: "memory");
            const unsigned og = xb_add(&bar[XB_TOP], 1u);
            const unsigned tg = og / nx;
            if (og + 1u == (tg + 1u) * nx) xb_add(&bar[XB_TOPGEN], 1u);
            else XB_SPIN(xb_ld(&bar[XB_TOPGEN]) == tg, bar);
            __builtin_amdgcn_fence(__ATOMIC_ACQUIRE, "agent");
            xb_add(&bar[XB_XGEN(b.x)], 1u);
            asm volatile("s_waitcnt vmcnt(0)" ::: "memory");
        } else {
            XB_SPIN(xb_ld(&bar[XB_XGEN(b.x)]) == gen, bar);
            __builtin_amdgcn_fence(__ATOMIC_ACQUIRE, "agent");
            asm volatile("s_waitcnt vmcnt(0)" ::: "memory");
        }
    }
    __syncthreads();
}

struct Params {
    const float* in[33];
    float* out; unsigned char* ws;
    int ph_lo, ph_hi;
};
struct Frame {
    LAS unsigned char* lds;
    int blk, G, wv;
    float* out; unsigned char* ws;
};
constexpr int PTAB_OFF = LDSCTL_OFF + 1024;
__device__ __forceinline__ int lane_id() { int l; asm volatile("v_mbcnt_lo_u32_b32 %0, -1, 0\n\tv_mbcnt_hi_u32_b32 %0, -1, %0" : "=v"(l)); return l; }
__device__ __forceinline__ int mytid(const Frame& F) { int t = F.wv * 64 + lane_id(); asm volatile("" : "+v"(t)); return t; }
__device__ __forceinline__ const float* inptr(const Frame& F, int k) {
    volatile LAS unsigned* t = (volatile LAS unsigned*)(F.lds + PTAB_OFF) + 2 * k;
    const unsigned lo = __builtin_amdgcn_readfirstlane(t[0]), hi = __builtin_amdgcn_readfirstlane(t[1]);
    const GAS float* gp = (const GAS float*)(((unsigned long long)hi << 32) | (unsigned long long)lo);
    return (const float*)gp;
}
#define IN_X 0
#define IN_RELB 1
#define IN_MIXG 2
#define IN_WIN 3
#define IN_WOUT 4
#define IN_FFNG 5
#define IN_QG 6
#define IN_KG 7
#define IN_CW 8
#define IN_CB 9
#define IN_CLG 10
#define IN_CLB 11
#define IN_MU 12
#define IN_W0 13
#define IN_W2 14
#define IN_A0 15
#define IN_A2 16
#define IN_G2 17
#define IN_KK 18
#define IN_KA 19
#define IN_RK 20
#define IN_RLG 21
#define IN_RLB 22
#define IN_GG2 23
#define IN_GGB 24
#define IN_GNG 25
#define IN_FWG 26
#define IN_FWU 27
#define IN_FWD 28
#define IN_ROUTER 29
#define IN_MWG 30
#define IN_MWU 31
#define IN_MWD 32

__device__ __forceinline__ void p0_transpose_item(const float* W, int K, int N, int nblk, const float* gk, bf16* WT, int mode, LAS float* scr, int item, int lane) {
    const int kb = item / nblk, nb = item % nblk, k0 = 64 * kb, n0 = 64 * nb, kr = lane >> 4, n4 = (lane & 15) * 4;
    const bool valid = (n0 + n4) < N;
    f32x4 v[16];
#pragma unroll
    for (int i = 0; i < 16; ++i) v[i] = valid ? *(const f32x4*)(W + (size_t)(k0 + 4 * i + kr) * N + n0 + n4) : (f32x4){0.f, 0.f, 0.f, 0.f};
    if (gk) {
#pragma unroll
        for (int i = 0; i < 16; ++i) v[i] = v[i] * gk[k0 + 4 * i + kr]; }
    const int rowbase = (mode == 0) ? n0 : ((n0 >> 7) * 256 + (mode == 2 ? 128 : 0) + (n0 & 127));
    const int c = lane & 3;
#pragma unroll
    for (int half = 0; half < 2; ++half) {
#pragma unroll
        for (int i = 0; i < 8; ++i) { LAS float* d = scr + (4 * i + kr) * 65 + n4; const f32x4 x = v[half * 8 + i]; d[0] = x[0]; d[1] = x[1]; d[2] = x[2]; d[3] = x[3]; }
        LDS_WAIT(); asm volatile("" ::: "memory");
#pragma unroll
        for (int j = 0; j < 4; ++j) { const int nn = (lane >> 2) + 16 * j; const LAS float* s = scr + (8 * c) * 65 + nn;
            u32x4 o; o.x = pk2(s[0 * 65], s[1 * 65]); o.y = pk2(s[2 * 65], s[3 * 65]); o.z = pk2(s[4 * 65], s[5 * 65]); o.w = pk2(s[6 * 65], s[7 * 65]);
            *(u32x4*)(WT + (size_t)(rowbase + nn) * K + k0 + half * 32 + 8 * c) = o; }
        LDS_WAIT(); asm volatile("" ::: "memory"); }
}
__device__ __forceinline__ void p0_prologue(Frame& F, const int part) {
    const int tid = mytid(F), lane = tid & 63, wave = __builtin_amdgcn_readfirstlane(tid >> 6); (void)lane; (void)wave;
    LAS float* scr = (LAS float*)(F.lds + wave * 16384);
    const int gw = F.blk * NWAVES + wave, NGW = F.G * NWAVES;
    constexpr int I_IN = 16 * 48, I_OUT = 16 * 16, I_GU = 16 * 44, I_D = 44 * 16, I_SET = 2 * I_GU + I_D;
    constexpr int NITEMS = 2 * I_IN + 2 * I_OUT + 9 * I_SET;
    unsigned char* ws = F.ws;
    constexpr int NPART0 = 2 * I_IN + 2 * I_OUT + I_SET;
    for (int it = (part == 0 ? 0 : NPART0) + gw; it < (part == 0 ? NPART0 : NITEMS); it += NGW) {
        int r = it;
        if (r < 2 * I_IN) { const int l = r / I_IN; r -= l * I_IN;
            p0_transpose_item(inptr(F, IN_WIN) + (size_t)l * DM * INW, DM, INW, 48, inptr(F, IN_MIXG) + l * DM, (bf16*)(ws + WS_WIN) + (size_t)l * NPADW * DM, 0, scr, r, lane); continue; }
        r -= 2 * I_IN;
        if (r < 2 * I_OUT) { const int l = r / I_OUT; r -= l * I_OUT;
            p0_transpose_item(inptr(F, IN_WOUT) + (size_t)l * DM * DM, DM, DM, 16, nullptr, (bf16*)(ws + WS_WOUT) + (size_t)l * DM * DM, 0, scr, r, lane); continue; }
        r -= 2 * I_OUT;
        const int set = r / I_SET; r -= set * I_SET;
        const float* wg = set == 0 ? inptr(F, IN_FWG) : inptr(F, IN_MWG) + (size_t)(set - 1) * DM * DFF;
        const float* wu = set == 0 ? inptr(F, IN_FWU) : inptr(F, IN_MWU) + (size_t)(set - 1) * DM * DFF;
        const float* wd = set == 0 ? inptr(F, IN_FWD) : inptr(F, IN_MWD) + (size_t)(set - 1) * DFF * DM;
        const float* gk = inptr(F, IN_FFNG) + (set == 0 ? 0 : DM);
        bf16* dgu = set == 0 ? (bf16*)(ws + WS_WGU) : (bf16*)(ws + WS_MOEW + (size_t)(set - 1) * MOEW_E_BYTES);
        bf16* dd = set == 0 ? (bf16*)(ws + WS_WD) : (bf16*)(ws + WS_MOEW + (size_t)(set - 1) * MOEW_E_BYTES + MOEW_GU_BYTES);
        if (r < I_GU) { p0_transpose_item(wg, DM, DFF, 44, gk, dgu, 1, scr, r, lane); continue; } r -= I_GU;
        if (r < I_GU) { p0_transpose_item(wu, DM, DFF, 44, gk, dgu, 2, scr, r, lane); continue; } r -= I_GU;
        p0_transpose_item(wd, DFF, DM, 16, nullptr, dd, 0, scr, r, lane);
    }
    if (part != 0) return;
    const float* x = inptr(F, IN_X); bf16* hb = (bf16*)(ws + WS_HB); float* ssq = (float*)(ws + WS_SSQ);
    for (int m = gw; m < NTOK; m += NGW) {
        const f32x4* xr = (const f32x4*)(x + (size_t)m * DM) + lane; f32x4 v[4]; float s = 0.f;
#pragma unroll
        for (int j = 0; j < 4; ++j) { v[j] = xr[64 * j]; s += (v[j][0] * v[j][0] + v[j][1] * v[j][1]) + (v[j][2] * v[j][2] + v[j][3] * v[j][3]); }
        s = wave_sum(s);
        u32x2* o8 = (u32x2*)(hb + (size_t)m * DM) + lane;
#pragma unroll
        for (int j = 0; j < 4; ++j) { u32x2 w; w.x = pk2(v[j][0], v[j][1]); w.y = pk2(v[j][2], v[j][3]); o8[64 * j] = w; }
        if (lane < 16) ssq[(size_t)m * 16 + lane] = (lane == 0) ? s : 0.f;
    }
}

__device__ const unsigned char T5B[3][132] = {
 {0,1,2,3,4,5,6,7,8,9,10,11,12,13,14,15,16,16,16,16,16,16,17,17,17,17,17,17,17,17,18,18,18,18,18,18,18,18,18,18,19,19,19,19,19,19,19,19,19,19,19,19,19,19,20,20,20,20,20,20,20,20,20,20,20,20,20,20,20,20,20,20,20,21,21,21,21,21,21,21,21,21,21,21,21,21,21,21,21,21,21,21,21,21,21,21,21,21,21,22,22,22,22,22,22,22,22,22,22,22,22,22,22,22,22,22,22,22,22,22,22,22,22,22,22,22,22,22,22,0,0,0},
 {0,4,8,12,16,16,17,17,18,18,19,19,19,19,20,20,20,20,20,21,21,21,21,21,21,22,22,22,22,22,22,22,22,22,23,23,23,23,23,23,23,23,23,23,23,23,24,24,24,24,24,24,24,24,24,24,24,24,24,24,24,24,25,25,25,25,25,25,25,25,25,25,25,25,25,25,25,25,25,25,25,25,25,26,26,26,26,26,26,26,26,26,26,26,26,26,26,26,26,26,26,26,26,26,26,26,26,26,26,26,26,26,26,27,27,27,27,27,27,27,27,27,27,27,27,27,27,27,27,0,0,0},
 {0,16,18,19,20,21,21,22,22,23,23,23,24,24,24,24,25,25,25,25,25,26,26,26,26,26,26,26,26,27,27,27,27,27,27,27,27,27,27,28,28,28,28,28,28,28,28,28,28,28,28,28,29,29,29,29,29,29,29,29,29,29,29,29,29,29,29,29,29,29,30,30,30,30,30,30,30,30,30,30,30,30,30,30,30,30,30,30,30,30,30,30,30,30,30,31,31,31,31,31,31,31,31,31,31,31,31,31,31,31,31,31,31,31,31,31,31,31,31,31,31,31,31,31,31,31,31,31,31,0,0,0}};

__device__ __forceinline__ void attn_tile(LAS unsigned char* lds, const bf16* Z, bf16* OP, float* LSE, const float* rel_bias, const float* qg, const float* kg, int tile, int tid) {
    const int lane = tid & 63, w = __builtin_amdgcn_readfirstlane(tid >> 6), fr = lane & 15, g = lane >> 4;
    const int br = tile >> 10, rem = tile & 1023, b = rem >> 7, h = (rem >> 5) & 3, sub = rem & 31;
    const int dsh = 2 * br, nbl = 32 >> dsh, r = sub >> (5 - dsh), n = sub & (nbl - 1);
    LAS unsigned char* Qs = lds;
    LAS unsigned char* Ks = lds + 16384;
    LAS unsigned char* Vt = lds + 49152;
    LAS float* BT = (LAS float*)(lds + 49152 + 33792);
    const size_t zrow0 = (size_t)b * SEQ;
    if (tid < 129) BT[tid] = rel_bias[(int)T5B[br][tid] * 4 + h];
    {
        const int j = tid >> 1, half = tid & 1;
        {
            const int lk = 128 * (n - 1) + j; u32x4 p[4];
            if (lk >= 0) { const u32x4* src = (const u32x4*)(Z + (zrow0 + ((size_t)lk << dsh) + r) * INW + ZA + 256 + h * 64 + half * 32);
#pragma unroll
                for (int c = 0; c < 4; ++c) p[c] = src[c]; }
            else {
#pragma unroll
                for (int c = 0; c < 4; ++c) p[c] = (u32x4){0u, 0u, 0u, 0u}; }
            float f[4][8]; float ss = 0.f;
#pragma unroll
            for (int c = 0; c < 4; ++c) { unpack8(p[c], f[c]);
#pragma unroll
                for (int e = 0; e < 8; ++e) ss += f[c][e] * f[c][e]; }
            ss += __shfl_xor(ss, 1);
            const float rs = __builtin_amdgcn_rsqf(ss * (1.0f / 64.0f) + NORM_EPS);
#pragma unroll
            for (int c = 0; c < 4; ++c) { const float* gp = kg + half * 32 + c * 8; u32x4 o;
                o.x = pk2(f[c][0] * rs * gp[0], f[c][1] * rs * gp[1]); o.y = pk2(f[c][2] * rs * gp[2], f[c][3] * rs * gp[3]);
                o.z = pk2(f[c][4] * rs * gp[4], f[c][5] * rs * gp[5]); o.w = pk2(f[c][6] * rs * gp[6], f[c][7] * rs * gp[7]);
                *(LAS u32x4*)(Ks + j * 128 + (((half * 4 + c) ^ (j & 7)) << 4)) = o; }
        }
        if (tid < 256) {
            const int lq = 128 * n + j; u32x4 p[4];
            const u32x4* src = (const u32x4*)(Z + (zrow0 + ((size_t)lq << dsh) + r) * INW + ZA + h * 64 + half * 32);
#pragma unroll
            for (int c = 0; c < 4; ++c) p[c] = src[c];
            float f[4][8]; float ss = 0.f;
#pragma unroll
            for (int c = 0; c < 4; ++c) { unpack8(p[c], f[c]);
#pragma unroll
                for (int e = 0; e < 8; ++e) ss += f[c][e] * f[c][e]; }
            ss += __shfl_xor(ss, 1);
            const float rs = __builtin_amdgcn_rsqf(ss * (1.0f / 64.0f) + NORM_EPS) * 0.125f;
#pragma unroll
            for (int c = 0; c < 4; ++c) { const float* gp = qg + half * 32 + c * 8; u32x4 o;
                o.x = pk2(f[c][0] * rs * gp[0], f[c][1] * rs * gp[1]); o.y = pk2(f[c][2] * rs * gp[2], f[c][3] * rs * gp[3]);
                o.z = pk2(f[c][4] * rs * gp[4], f[c][5] * rs * gp[5]); o.w = pk2(f[c][6] * rs * gp[6], f[c][7] * rs * gp[7]);
                *(LAS u32x4*)(Qs + j * 128 + (((half * 4 + c) ^ (j & 7)) << 4)) = o; }
        }
    }
#pragma unroll
    for (int it = 0; it < 4; ++it) { const int idx = tid + 512 * it, chunk = idx >> 8, key = idx & 255, lk = 128 * (n - 1) + key; u32x4 p = (u32x4){0u, 0u, 0u, 0u};
        if (lk >= 0) p = *(const u32x4*)(Z + (zrow0 + ((size_t)lk << dsh) + r) * INW + ZA + 512 + h * 64 + chunk * 8);
        LAS unsigned short* vp = (LAS unsigned short*)(Vt + (chunk * 8) * 528 + key * 2);
        vp[0 * 264] = (unsigned short)(p.x & 0xffffu); vp[1 * 264] = (unsigned short)(p.x >> 16); vp[2 * 264] = (unsigned short)(p.y & 0xffffu); vp[3 * 264] = (unsigned short)(p.y >> 16);
        vp[4 * 264] = (unsigned short)(p.z & 0xffffu); vp[5 * 264] = (unsigned short)(p.z >> 16); vp[6 * 264] = (unsigned short)(p.w & 0xffffu); vp[7 * 264] = (unsigned short)(p.w >> 16); }
    BAR();
    bf16x8 qf[2];
#pragma unroll
    for (int ks = 0; ks < 2; ++ks) qf[ks] = *(const LAS bf16x8*)(Qs + (16 * w + fr) * 128 + (((ks * 4 + g) ^ (fr & 7)) << 4));
    f32x4 s[16];
#pragma unroll
    for (int kb = 0; kb < 16; ++kb) { s[kb] = (f32x4){0.f, 0.f, 0.f, 0.f};
#pragma unroll
        for (int ks = 0; ks < 2; ++ks) { const bf16x8 kf = *(const LAS bf16x8*)(Ks + (16 * kb + fr) * 128 + (((ks * 4 + g) ^ (fr & 7)) << 4));
            s[kb] = __builtin_amdgcn_mfma_f32_16x16x32_bf16(kf, qf[ks], s[kb], 0, 0, 0); } }
    const int q = 16 * w + fr; float mx = -3.0e38f;
#pragma unroll
    for (int kb = 0; kb < 16; ++kb)
#pragma unroll
        for (int rg = 0; rg < 4; ++rg) { const int key = 16 * kb + 4 * g + rg, delta = q + 128 - key; const bool valid = (delta >= 0) && (delta <= 128) && (n > 0 || key >= 128);
            const int di = delta < 0 ? 0 : (delta > 128 ? 128 : delta);
            const float v = valid ? s[kb][rg] + BT[di] : -3.0e38f; s[kb][rg] = v; mx = fmaxf(mx, v); }
    mx = fmaxf(mx, __shfl_xor(mx, 16)); mx = fmaxf(mx, __shfl_xor(mx, 32));
    float den = 0.f;
#pragma unroll
    for (int kb = 0; kb < 16; ++kb)
#pragma unroll
        for (int rg = 0; rg < 4; ++rg) { const float v = s[kb][rg]; const float p = (v > -1.0e38f) ? __expf(v - mx) : 0.f; s[kb][rg] = p; den += p; }
    den += __shfl_xor(den, 16); den += __shfl_xor(den, 32);
    f32x4 o[4];
#pragma unroll
    for (int eb = 0; eb < 4; ++eb) o[eb] = (f32x4){0.f, 0.f, 0.f, 0.f};
#pragma unroll
    for (int s8 = 0; s8 < 8; ++s8) {
        u32x4 pw; pw.x = pk2(s[2 * s8][0], s[2 * s8][1]); pw.y = pk2(s[2 * s8][2], s[2 * s8][3]); pw.z = pk2(s[2 * s8 + 1][0], s[2 * s8 + 1][1]); pw.w = pk2(s[2 * s8 + 1][2], s[2 * s8 + 1][3]);
        const bf16x8 pb = __builtin_bit_cast(bf16x8, pw);
#pragma unroll
        for (int eb = 0; eb < 4; ++eb) { const LAS unsigned char* vp = Vt + (16 * eb + fr) * 528 + (32 * s8 + 4 * g) * 2;
            const u32x2 lo = *(const LAS u32x2*)vp, hi = *(const LAS u32x2*)(vp + 32); u32x4 aw; aw.x = lo.x; aw.y = lo.y; aw.z = hi.x; aw.w = hi.y;
            o[eb] = __builtin_amdgcn_mfma_f32_16x16x32_bf16(__builtin_bit_cast(bf16x8, aw), pb, o[eb], 0, 0, 0); } }
    const float inv = 1.0f / den; const size_t tokq = zrow0 + ((size_t)(128 * n + q) << dsh) + r;
    bf16* op = OP + ((size_t)br * NTOK + tokq) * 256 + h * 64 + 4 * g;
#pragma unroll
    for (int eb = 0; eb < 4; ++eb) { u32x2 wv; wv.x = pk2(o[eb][0] * inv, o[eb][1] * inv); wv.y = pk2(o[eb][2] * inv, o[eb][3] * inv); *(u32x2*)(op + 16 * eb) = wv; }
    if (g == 0) LSE[((size_t)br * NTOK + tokq) * 4 + h] = mx + __logf(den);
    BAR();
}

__device__ __forceinline__ void attn_merge(Frame& F, const bf16* OP, const float* LSE, bf16* Y) {
    const int tid = mytid(F), lane = tid & 63, wave = __builtin_amdgcn_readfirstlane(tid >> 6); (void)lane; (void)wave;
    const int gt = (F.blk - 32) * NTHREADS + tid, NGT = (F.G - 32) * NTHREADS;
    for (int idx = gt; idx < NTOK * 32; idx += NGT) { const int tok = idx >> 5, c8 = idx & 31, h = c8 >> 3;
        const float l0 = LSE[((size_t)0 * NTOK + tok) * 4 + h], l1 = LSE[((size_t)1 * NTOK + tok) * 4 + h], l2 = LSE[((size_t)2 * NTOK + tok) * 4 + h];
        const float m = fmaxf(l0, fmaxf(l1, l2)); float w0 = __expf(l0 - m), w1 = __expf(l1 - m), w2 = __expf(l2 - m); const float inv = 1.0f / (w0 + w1 + w2); w0 *= inv; w1 *= inv; w2 *= inv;
        const u32x4 a = *(const u32x4*)(OP + ((size_t)0 * NTOK + tok) * 256 + c8 * 8), bq = *(const u32x4*)(OP + ((size_t)1 * NTOK + tok) * 256 + c8 * 8), c = *(const u32x4*)(OP + ((size_t)2 * NTOK + tok) * 256 + c8 * 8);
        float fa[8], fb[8], fc[8]; unpack8(a, fa); unpack8(bq, fb); unpack8(c, fc); float r[8];
#pragma unroll
        for (int e = 0; e < 8; ++e) r[e] = w0 * fa[e] + w1 * fb[e] + w2 * fc[e];
        u32x4 o; o.x = pk2(r[0], r[1]); o.y = pk2(r[2], r[3]); o.z = pk2(r[4], r[5]); o.w = pk2(r[6], r[7]);
        *(u32x4*)(Y + (size_t)tok * DM + c8 * 8) = o; }
}

__device__ __forceinline__ void conv_item(Frame& F, const bf16* Z, bf16* Y, const float* cw, const float* cb, const float* lg, const float* lb, int item) {
    const int tid = mytid(F), b = item >> 6, t0 = (item & 63) * 64;
    LAS float* HG = (LAS float*)F.lds;
    LAS float* WL = (LAS float*)(F.lds + 96256);
    for (int i = tid; i < 31 * 256; i += NTHREADS) WL[i] = cw[i];
    for (int p = tid; p < 94 * 32; p += NTHREADS) { const int row = p >> 5, c8 = p & 31, t = t0 - 30 + row; float hv[8];
        if (t >= 0) { const bf16* zr = Z + ((size_t)b * SEQ + t) * INW + ZB + c8 * 8; const u32x4 uu = *(const u32x4*)zr, gg = *(const u32x4*)(zr + 256); float fu[8], fg[8]; unpack8(uu, fu); unpack8(gg, fg);
#pragma unroll
            for (int e = 0; e < 8; ++e) hv[e] = fu[e] * sigmoidf_(fg[e]); }
        else {
#pragma unroll
            for (int e = 0; e < 8; ++e) hv[e] = 0.f; }
        LAS f32x4* d = (LAS f32x4*)(HG + row * 256 + c8 * 8); d[0] = (f32x4){hv[0], hv[1], hv[2], hv[3]}; d[1] = (f32x4){hv[4], hv[5], hv[6], hv[7]}; }
    BAR();
    const int tt = tid >> 3, cs = tid & 7;
    f32x4 acc[8];
#pragma unroll
    for (int i = 0; i < 8; ++i) acc[i] = *(const f32x4*)(cb + 4 * (cs + 8 * i));
    for (int j = 0; j < 31; ++j) {
#pragma unroll
        for (int i = 0; i < 8; ++i) { const int qd = cs + 8 * i; acc[i] += *(const LAS f32x4*)(HG + (tt + j) * 256 + 4 * qd) * *(const LAS f32x4*)(WL + j * 256 + 4 * qd); } }
    bf16* yr = Y + ((size_t)b * SEQ + t0 + tt) * DM + 256;
#pragma unroll
    for (int gi = 0; gi < 4; ++gi) {
        const f32x4 x0 = acc[2 * gi], x1 = acc[2 * gi + 1];
        float s = ((x0[0] + x0[1]) + (x0[2] + x0[3])) + ((x1[0] + x1[1]) + (x1[2] + x1[3])); s = red8(s);
        const float mean = s * (1.0f / 64.0f); const f32x4 d0 = x0 - mean, d1 = x1 - mean;
        float ss = ((d0[0] * d0[0] + d0[1] * d0[1]) + (d0[2] * d0[2] + d0[3] * d0[3])) + ((d1[0] * d1[0] + d1[1] * d1[1]) + (d1[2] * d1[2] + d1[3] * d1[3])); ss = red8(ss);
        const float rstd = __builtin_amdgcn_rsqf(ss * (1.0f / 64.0f) + 1e-5f);
#pragma unroll
        for (int k = 0; k < 2; ++k) { const int qd = cs + 8 * (2 * gi + k); const f32x4 dd = k ? d1 : d0; const f32x4 gv = *(const f32x4*)(lg + 4 * qd), bv = *(const f32x4*)(lb + 4 * qd); float y[4];
#pragma unroll
            for (int e = 0; e < 4; ++e) y[e] = siluf_(dd[e] * rstd * gv[e] + bv[e]);
            u32x2 wv; wv.x = pk2(y[0], y[1]); wv.y = pk2(y[2], y[3]); *(u32x2*)(yr + 4 * qd) = wv; } }
    BAR();
}

__device__ __forceinline__ bf16x8 ldfrag(const LAS unsigned char* base, int stride, int row0, int kb0, int fr, int g) {
    return *(const LAS bf16x8*)(base + (row0 + fr) * stride + kb0 + 16 * g);
}
#define MFMA16(a, b, c) __builtin_amdgcn_mfma_f32_16x16x32_bf16((a), (b), (c), 0, 0, 0)

constexpr int GL_G2 = 0, GL_Q = 2048, GL_K = 6144, GL_GK = 10240, GL_GD = 14336, GL_OG = 16384, GL_QT = 24576, GL_KB = 27136, GL_KHT = 29696, GL_VT = 32256, GL_ATT = 37376, GL_ST = 39936, GL_EC = 45056,
              GL_OB = 45184, GL_GB = 53376, GL_END = 53504;
struct GlaRaw { u32x4 p[2]; u32x4 s; };
__device__ __forceinline__ void gla_decode(int tid, int h, int it, int& tt, int& col, int& kind, int& off, bool& ok) {
    const int p = tid + 512 * it; ok = p < 832; tt = p / 26; const int qd = p % 26;
    if (qd < 4) { col = ZD + h * 32 + 8 * qd; kind = 0; off = tt * 32 + 8 * qd; }
    else if (qd < 8) { col = ZD + 128 + h * 32 + 8 * (qd - 4); kind = 1; off = tt * 32 + 8 * (qd - 4); }
    else if (qd < 16) { col = ZD + 256 + h * 64 + 8 * (qd - 8); kind = 2; off = 8 * (qd - 8); }
    else if (qd < 18) { col = ZD + 512 + 8 * (qd - 16); kind = 3; off = tt * 16 + 8 * (qd - 16); }
    else { col = ZD + 528 + h * 64 + 8 * (qd - 18); kind = 4; off = tt * 64 + 8 * (qd - 18); }
}
template <int STEP> __device__ __forceinline__ void gla_load(const bf16* Z, const unsigned char* sst, int b, int h, int ch, int tid, GlaRaw& r) {
#pragma unroll
    for (int it = 0; it < 2; ++it) { int tt, col, kind, off; bool ok; gla_decode(tid, h, it, tt, col, kind, off, ok);
        r.p[it] = ok ? *(const u32x4*)(Z + ((size_t)b * SEQ + ch * 32 + tt) * INW + col) : (u32x4){0u, 0u, 0u, 0u}; }
    if (STEP == 1) r.s = (tid < 256) ? *(const u32x4*)(sst + (size_t)((b * 4 + h) * (SEQ / 32) + ch) * 4096 + 16 * tid) : (u32x4){0u, 0u, 0u, 0u};
}
template <int STEP> __device__ __forceinline__ void gla_item(Frame& F, const GlaRaw& raw, unsigned char* con, float* ecg, bf16* Y, const float* ng, int b, int h, int ch) {
    const int tid = mytid(F), lane = tid & 63, w = __builtin_amdgcn_readfirstlane(tid >> 6), fr = lane & 15, g = lane >> 4;
    LAS unsigned char* L = F.lds;
    LAS float *G2 = (LAS float*)(L + GL_G2), *QF = (LAS float*)(L + GL_Q), *KF = (LAS float*)(L + GL_K), *GK = (LAS float*)(L + GL_GK), *GD = (LAS float*)(L + GL_GD), *OG = (LAS float*)(L + GL_OG),
              *OB = (LAS float*)(L + GL_OB), *GB = (LAS float*)(L + GL_GB);
    LAS unsigned char *QT = L + GL_QT, *KB = L + GL_KB, *KHT = L + GL_KHT, *VT = L + GL_VT, *ATT = L + GL_ATT, *ST = L + GL_ST;
    const size_t item = (size_t)((b * 4 + h) * (SEQ / 32) + ch);
#pragma unroll
    for (int it = 0; it < 2; ++it) { int tt, col, kind, off; bool ok; gla_decode(tid, h, it, tt, col, kind, off, ok);
        if (ok) { float f[8]; unpack8(raw.p[it], f);
            if (kind == 2) { LAS unsigned short* vp = (LAS unsigned short*)(VT + off * 80 + tt * 2); const u32x4 pr = raw.p[it];
                vp[0 * 40] = (unsigned short)(pr.x & 0xffffu); vp[1 * 40] = (unsigned short)(pr.x >> 16); vp[2 * 40] = (unsigned short)(pr.y & 0xffffu); vp[3 * 40] = (unsigned short)(pr.y >> 16);
                vp[4 * 40] = (unsigned short)(pr.z & 0xffffu); vp[5 * 40] = (unsigned short)(pr.z >> 16); vp[6 * 40] = (unsigned short)(pr.w & 0xffffu); vp[7 * 40] = (unsigned short)(pr.w >> 16); }
            else if (kind != 4 || STEP == 1) { LAS float* dst = (kind == 0 ? QF : kind == 1 ? KF : kind == 3 ? GD : OG) + off; const float sc = kind == 0 ? 0.17677669529663687f : 1.0f;
                ((LAS f32x4*)dst)[0] = (f32x4){f[0] * sc, f[1] * sc, f[2] * sc, f[3] * sc}; ((LAS f32x4*)dst)[1] = (f32x4){f[4] * sc, f[5] * sc, f[6] * sc, f[7] * sc}; } } }
    if (STEP == 1 && tid < 256) *(LAS u32x4*)(ST + (tid >> 2) * 80 + (tid & 3) * 16) = raw.s;
    BAR();
#pragma unroll
    for (int it = 0; it < 2; ++it) { const int o = tid + 512 * it, tt = o >> 5, kk = o & 31; float x = GB[kk];
#pragma unroll
        for (int j = 0; j < 16; ++j) x += GD[tt * 16 + j] * G2[j * 32 + kk];
        GK[tt * 32 + kk] = -softplusf_(-x) * (1.0f / 16.0f); }
    BAR();
    { const int t = tid >> 4, k2 = (tid & 15) * 2; float c0 = 0.f, c1 = 0.f, b0 = 0.f, b1 = 0.f;
#pragma unroll 8
        for (int s = 0; s < 32; ++s) { const f32x2 gk = *(const LAS f32x2*)(GK + s * 32 + k2); c0 += gk[0]; c1 += gk[1]; if (s == t) { b0 = c0; b1 = c1; } }
        const f32x2 q = *(const LAS f32x2*)(QF + t * 32 + k2), k = *(const LAS f32x2*)(KF + t * 32 + k2);
        if (STEP == 1) { *(LAS unsigned*)(QT + t * 80 + k2 * 2) = pk2(q[0] * __expf(b0), q[1] * __expf(b1)); *(LAS unsigned*)(KB + t * 80 + k2 * 2) = pk2(k[0] * __expf(-b0), k[1] * __expf(-b1)); }
        else { *(LAS unsigned short*)(KHT + k2 * 80 + t * 2) = (unsigned short)f2bf(k[0] * __expf(c0 - b0)); *(LAS unsigned short*)(KHT + (k2 + 1) * 80 + t * 2) = (unsigned short)f2bf(k[1] * __expf(c1 - b1));
            if (t == 0) { ecg[item * 32 + k2] = __expf(c0); ecg[item * 32 + k2 + 1] = __expf(c1); } } }
    BAR();
    if (STEP == 0) {
        const int kb = w >> 2, vb = w & 3; f32x4 d = (f32x4){0.f, 0.f, 0.f, 0.f};
        d = MFMA16(ldfrag(KHT, 80, 16 * kb, 0, fr, g), ldfrag(VT, 80, 16 * vb, 0, fr, g), d);
        u32x2 so; so.x = pk2(d[0], d[1]); so.y = pk2(d[2], d[3]); *(u32x2*)(con + item * 4096 + (16 * vb + fr) * 64 + (16 * kb + 4 * g) * 2) = so;
        BAR();
    } else {
        if (w < 3) { const int atb = w == 0 ? 0 : 1, asb = w == 2 ? 1 : 0;
            f32x4 d = (f32x4){0.f, 0.f, 0.f, 0.f}; d = MFMA16(ldfrag(KB, 80, 16 * asb, 0, fr, g), ldfrag(QT, 80, 16 * atb, 0, fr, g), d);
            const int t = 16 * atb + fr; float v[4];
#pragma unroll
            for (int r = 0; r < 4; ++r) { const int s = 16 * asb + 4 * g + r; v[r] = (s <= t) ? d[r] : 0.f; }
            u32x2 o; o.x = pk2(v[0], v[1]); o.y = pk2(v[2], v[3]); *(LAS u32x2*)(ATT + t * 80 + (16 * asb + 4 * g) * 2) = o; }
        else if (w == 3) { *(LAS u32x2*)(ATT + fr * 80 + (16 + 4 * g) * 2) = (u32x2){0u, 0u}; }
        BAR();
        { const int tb = w >> 2, vb = w & 3; f32x4 o = (f32x4){0.f, 0.f, 0.f, 0.f};
            o = MFMA16(ldfrag(ATT, 80, 16 * tb, 0, fr, g), ldfrag(VT, 80, 16 * vb, 0, fr, g), o);
            o = MFMA16(ldfrag(QT, 80, 16 * tb, 0, fr, g), ldfrag(ST, 80, 16 * vb, 0, fr, g), o);
#pragma unroll
            for (int r = 0; r < 4; ++r) OB[(16 * tb + 4 * g + r) * 64 + 16 * vb + fr] = o[r]; }
        BAR();
        { const int tt = tid >> 4, v4 = (tid & 15) * 4; const f32x4 o = *(const LAS f32x4*)(OB + tt * 64 + v4);
            float ss = (o[0] * o[0] + o[1] * o[1]) + (o[2] * o[2] + o[3] * o[3]); ss = red16(ss);
            const float rs = __builtin_amdgcn_rsqf(ss * (1.0f / 64.0f) + NORM_EPS); const f32x4 gv = *(const f32x4*)(ng + v4), og = *(const LAS f32x4*)(OG + tt * 64 + v4); float y[4];
#pragma unroll
            for (int e = 0; e < 4; ++e) y[e] = o[e] * rs * gv[e] * og[e] * __builtin_amdgcn_rcpf(1.0f + __expf(-og[e]));
            u32x2 wv; wv.x = pk2(y[0], y[1]); wv.y = pk2(y[2], y[3]); *(u32x2*)(Y + ((size_t)b * SEQ + ch * 32 + tt) * DM + 768 + h * 64 + v4) = wv; }
        BAR();
    }
}
template <int STEP> __device__ __forceinline__ void gla_items(Frame& F, const bf16* Z, unsigned char* con, float* ecg, bf16* Y, const float* g2, const float* gb, const float* ng, int wi, int nw) {
    const int tid = mytid(F);
#pragma unroll 1
    for (int h = 0; h < 4; ++h) {
        ((LAS float*)(F.lds + GL_G2))[tid] = g2[(tid >> 5) * 128 + h * 32 + (tid & 31)]; if (tid < 32) ((LAS float*)(F.lds + GL_GB))[tid] = gb[h * 32 + tid];
        BAR();
        GlaRaw cur, nxt; cur.p[0] = (u32x4){0u, 0u, 0u, 0u}; cur.p[1] = cur.p[0]; cur.s = cur.p[0]; nxt = cur;
        if (wi < 1024) gla_load<STEP>(Z, con, wi >> 7, h, wi & 127, tid, cur);
#pragma unroll 1
        for (int it = wi; it < 1024; it += nw) { const int nx = it + nw;
            if (nx < 1024) gla_load<STEP>(Z, con, nx >> 7, h, nx & 127, tid, nxt);
            gla_item<STEP>(F, cur, con, ecg, Y, ng, it >> 7, h, it & 127);
            cur = nxt; }
        BAR(); }
}
__device__ __forceinline__ void gla_scan(Frame& F, unsigned char* con, const float* ecg, int b, int h) {
    const int tid = mytid(F); const int k4 = (tid & 7) * 4;
    unsigned char* base = con + (size_t)((b * 4 + h) * (SEQ / 32)) * 4096 + 8 * tid; const float* eb = ecg + (size_t)((b * 4 + h) * (SEQ / 32)) * 32 + k4;
    float s[4] = {0.f, 0.f, 0.f, 0.f};
    u32x2 cn[4]; f32x4 ec[4];
#pragma unroll
    for (int j = 0; j < 4; ++j) { cn[j] = *(const u32x2*)(base + (size_t)j * 4096); ec[j] = *(const f32x4*)(eb + j * 32); }
#pragma unroll 1
    for (int c0 = 0; c0 < SEQ / 32; c0 += 4) {
        u32x2 cc[4]; f32x4 ee[4];
#pragma unroll
        for (int j = 0; j < 4; ++j) { cc[j] = cn[j]; ee[j] = ec[j]; }
        if (c0 + 4 < SEQ / 32) {
#pragma unroll
            for (int j = 0; j < 4; ++j) { cn[j] = *(const u32x2*)(base + (size_t)(c0 + 4 + j) * 4096); ec[j] = *(const f32x4*)(eb + (c0 + 4 + j) * 32); } }
#pragma unroll
        for (int j = 0; j < 4; ++j) { u32x2 o; o.x = pk2(s[0], s[1]); o.y = pk2(s[2], s[3]); *(u32x2*)(base + (size_t)(c0 + j) * 4096) = o;
            s[0] = ee[j][0] * s[0] + bflo(cc[j].x); s[1] = ee[j][1] * s[1] + bfhi(cc[j].x); s[2] = ee[j][2] * s[2] + bflo(cc[j].y); s[3] = ee[j][3] * s[3] + bfhi(cc[j].y); } }
}

struct RwkvP { const float *mu, *w0, *w2, *a0, *a2, *g2, *kk, *ka, *rk, *lg, *lb; };
constexpr int RC_AT = 0  , RC_RT = 2048  , RC_ZT = 4096, RC_RBK = 5120, RC_BKT = 6144  , RC_VT4 = 10240  ,
              RC_GC = 12288  , RC_G = 12544  , RC_BON = 14592  , RC_BYTES = 14656, RC_STRIDE = 14848;
constexpr int RC_CHUNKS16 = RC_BYTES / 16;
static_assert((size_t)NB * 4 * (SEQ / 16) * RC_STRIDE <= NEXP * MOEW_E_BYTES, "RWKV records overlay the (not yet converted) MoE weight region");
constexpr int RW_W2T = 0, RW_A2T = 5120, RW_G2T = 10240, RW_MU = 19456  , RW_TW = 23040, RW_AD = 24320, RW_SG = 25600, RW_R = 27904, RW_K = 32000, RW_V = 36096, RW_WL = 40192, RW_AL = 44288,
              RW_G = 48384, RW_KK = 52480, RW_KP = 56576, RW_BON = 60672, RW_GC = 60736, RW_AR = 60992, RW_BK = 65600, RW_BKT = 70208, RW_ZAK = 75328, RW_RBK = 76608, RW_AAB = 77888, RW_TT = 78912  , RW_END = 80192;

__device__ __forceinline__ void rwkv_prep_init(Frame& F, const RwkvP P, int h) {
    const int tid = mytid(F); LAS unsigned char* L = F.lds;
    for (int i = tid; i < 64 * 32; i += NTHREADS) { const int c = i >> 5, j = i & 31;
        *(LAS unsigned short*)(L + RW_W2T + c * 80 + j * 2) = (unsigned short)f2bf(P.w2[j * 256 + h * 64 + c]); *(LAS unsigned short*)(L + RW_A2T + c * 80 + j * 2) = (unsigned short)f2bf(P.a2[j * 256 + h * 64 + c]); }
    for (int i = tid; i < 64 * 64; i += NTHREADS) { const int c = i >> 6, j = i & 63; *(LAS unsigned short*)(L + RW_G2T + c * 144 + j * 2) = (unsigned short)f2bf(P.g2[j * 256 + h * 64 + c]); }
    for (int i = tid; i < 896; i += NTHREADS) ((LAS float*)(L + RW_MU))[i] = P.mu[i];
}
__device__ __forceinline__ void rwkv_prep_load(const bf16* Z, int b, int h, int ch, int w, int lane, u32x4 (&cur)[2], u32x4 (&prv)[2]) {
    const int kind = w & 3, p = (w >> 2) * 64 + lane, tt = p >> 3, j = p & 7;
    const int col = (kind < 3 ? ZC + kind * 256 + h * 64 : ZC + 832) + 8 * j;
    const int t = ch * 16 + tt; const bf16* zr = Z + ((size_t)b * SEQ + t) * INW + col;
    cur[0] = *(const u32x4*)zr; prv[0] = (t > 0) ? *(const u32x4*)(zr - INW) : (u32x4){0u, 0u, 0u, 0u};
    if (w < 2) { const int t2 = ch * 16 + (lane >> 2); const bf16* z2 = Z + ((size_t)b * SEQ + t2) * INW + ZC + 768 + w * 32 + 8 * (lane & 3);
        cur[1] = *(const u32x4*)z2; prv[1] = (t2 > 0) ? *(const u32x4*)(z2 - INW) : (u32x4){0u, 0u, 0u, 0u}; }
    else { cur[1] = (u32x4){0u, 0u, 0u, 0u}; prv[1] = cur[1]; }
}
__device__ __forceinline__ void rwkv_prep_item(Frame& F, unsigned char* rec, const RwkvP P, int h, const u32x4 (&cur)[2], const u32x4 (&prv)[2]) {
    const int tid = mytid(F), lane = tid & 63, w = __builtin_amdgcn_readfirstlane(tid >> 6), fr = lane & 15, g = lane >> 4;
    LAS unsigned char* L = F.lds;
    LAS float *R = (LAS float*)(L + RW_R), *KR = (LAS float*)(L + RW_K), *V = (LAS float*)(L + RW_V), *WL = (LAS float*)(L + RW_WL), *AL = (LAS float*)(L + RW_AL), *G = (LAS float*)(L + RW_G),
              *KK = (LAS float*)(L + RW_KK), *KP = (LAS float*)(L + RW_KP), *BON = (LAS float*)(L + RW_BON), *GC = (LAS float*)(L + RW_GC), *AAB = (LAS float*)(L + RW_AAB), *MU = (LAS float*)(L + RW_MU);
    { const int kind = w & 3, p = (w >> 2) * 64 + lane, tt = p >> 3, j = p & 7; float fc[8], fp[8], x[8]; unpack8(cur[0], fc); unpack8(prv[0], fp);
        const LAS float* mu = MU + (kind < 3 ? kind * 256 + h * 64 : 832) + 8 * j;
#pragma unroll
        for (int e = 0; e < 8; ++e) x[e] = fc[e] + (fp[e] - fc[e]) * mu[e];
        if (kind < 3) { LAS f32x4* d = (LAS f32x4*)((kind == 0 ? R : kind == 1 ? KR : V) + tt * 64 + 8 * j); d[0] = (f32x4){x[0], x[1], x[2], x[3]}; d[1] = (f32x4){x[4], x[5], x[6], x[7]}; }
        else {
#pragma unroll
            for (int e = 0; e < 8; ++e) x[e] = __builtin_amdgcn_rcpf(1.0f + __expf(-x[e]));
            u32x4 o; o.x = pk2(x[0], x[1]); o.y = pk2(x[2], x[3]); o.z = pk2(x[4], x[5]); o.w = pk2(x[6], x[7]); *(LAS u32x4*)(L + RW_SG + tt * 144 + 16 * j) = o; }
        if (w < 2) { const int t2 = lane >> 2, j2 = lane & 3; unpack8(cur[1], fc); unpack8(prv[1], fp); const LAS float* mu2 = MU + 768 + w * 32 + 8 * j2;
#pragma unroll
            for (int e = 0; e < 8; ++e) { x[e] = fc[e] + (fp[e] - fc[e]) * mu2[e]; if (w == 0) x[e] = 2.0f * __builtin_amdgcn_rcpf(1.0f + __expf(-2.0f * x[e])) - 1.0f; }
            u32x4 o; o.x = pk2(x[0], x[1]); o.y = pk2(x[2], x[3]); o.z = pk2(x[4], x[5]); o.w = pk2(x[6], x[7]); *(LAS u32x4*)(L + (w == 0 ? RW_TW : RW_AD) + t2 * 80 + 16 * j2) = o; } }
    BAR();
    if (w < 4) { f32x4 dw = (f32x4){0.f, 0.f, 0.f, 0.f}, da = dw;
        dw = MFMA16(ldfrag(L + RW_W2T, 80, 16 * w, 0, fr, g), ldfrag(L + RW_TW, 80, 0, 0, fr, g), dw);
        da = MFMA16(ldfrag(L + RW_A2T, 80, 16 * w, 0, fr, g), ldfrag(L + RW_AD, 80, 0, 0, fr, g), da);
        *(LAS f32x4*)(WL + fr * 64 + 16 * w + 4 * g) = dw; *(LAS f32x4*)(AL + fr * 64 + 16 * w + 4 * g) = da; }
    else { const int cb = w - 4; f32x4 dg = (f32x4){0.f, 0.f, 0.f, 0.f};
        dg = MFMA16(ldfrag(L + RW_G2T, 144, 16 * cb, 0, fr, g), ldfrag(L + RW_SG, 144, 0, 0, fr, g), dg);
        dg = MFMA16(ldfrag(L + RW_G2T, 144, 16 * cb, 64, fr, g), ldfrag(L + RW_SG, 144, 0, 64, fr, g), dg);
        *(LAS f32x4*)(G + fr * 64 + 16 * cb + 4 * g) = dg; }
    BAR();
    { const int t = tid >> 5, c2 = (tid & 31) * 2, hc = h * 64 + c2;
        const f32x2 wl = *(const LAS f32x2*)(WL + t * 64 + c2) + *(const f32x2*)(P.w0 + hc), al = *(const LAS f32x2*)(AL + t * 64 + c2) + *(const f32x2*)(P.a0 + hc);
        const f32x2 kr = *(const LAS f32x2*)(KR + t * 64 + c2), rr = *(const LAS f32x2*)(R + t * 64 + c2);
        const f32x2 kkw = *(const f32x2*)(P.kk + hc), kaw = *(const f32x2*)(P.ka + hc), rkw = *(const f32x2*)(P.rk + hc);
        f32x2 lw, a, kk, kp; float ss = 0.f, bon = 0.f;
#pragma unroll
        for (int e = 0; e < 2; ++e) { const float wlog = -softplusf_(-wl[e]) - 0.5f; lw[e] = -__expf(wlog); a[e] = __builtin_amdgcn_rcpf(1.0f + __expf(-al[e])); kk[e] = kr[e] * kkw[e]; ss += kk[e] * kk[e];
            kp[e] = kr[e] * (1.0f + (a[e] - 1.0f) * kaw[e]); bon += rr[e] * kp[e] * rkw[e]; }
        ss = red16(ss); bon = red16(bon); ss += __shfl_xor(ss, 16); bon += __shfl_xor(bon, 16);
        const float inv = 1.0f / fmaxf(sqrtf(ss), 1e-12f); kk = kk * inv;
        *(LAS f32x2*)(WL + t * 64 + c2) = lw; *(LAS f32x2*)(AL + t * 64 + c2) = a; *(LAS f32x2*)(KK + t * 64 + c2) = kk; *(LAS f32x2*)(KP + t * 64 + c2) = kp;
        if ((tid & 31) == 0) BON[t] = bon; }
    BAR();
    { const int t = tid >> 5, c2 = (tid & 31) * 2;
        f32x2 cs = (f32x2){0.f, 0.f}, ct = cs;
#pragma unroll
        for (int s = 0; s < 16; ++s) { cs += *(const LAS f32x2*)(WL + s * 64 + c2); if (s == t) ct = cs; }
        const f32x2 lwt = *(const LAS f32x2*)(WL + t * 64 + c2), a = *(const LAS f32x2*)(AL + t * 64 + c2), kk = *(const LAS f32x2*)(KK + t * 64 + c2), kp = *(const LAS f32x2*)(KP + t * 64 + c2), rr = *(const LAS f32x2*)(R + t * 64 + c2);
        float at[2], rt[2], bb[2], kb[2], bh[2], kh[2];
#pragma unroll
        for (int e = 0; e < 2; ++e) { const float eP = __expf(ct[e] - lwt[e]), eT = __expf(ct[e]), eI = __expf(-ct[e]), eC = __expf(cs[e] - ct[e]); const float bv = kk[e] * a[e];
            at[e] = -kk[e] * eP; rt[e] = rr[e] * eT; bb[e] = bv * eI; kb[e] = kp[e] * eI; bh[e] = bv * eC; kh[e] = kp[e] * eC; }
        *(LAS unsigned*)(L + RW_AR + t * 144 + c2 * 2) = pk2(at[0], at[1]); *(LAS unsigned*)(L + RW_AR + (16 + t) * 144 + c2 * 2) = pk2(rt[0], rt[1]);
        *(LAS unsigned*)(L + RW_BK + t * 144 + c2 * 2) = pk2(bb[0], bb[1]); *(LAS unsigned*)(L + RW_BK + (16 + t) * 144 + c2 * 2) = pk2(kb[0], kb[1]);
#pragma unroll
        for (int e = 0; e < 2; ++e) { *(LAS unsigned short*)(L + RW_BKT + (c2 + e) * 80 + t * 2) = (unsigned short)f2bf(bh[e]); *(LAS unsigned short*)(L + RW_BKT + (c2 + e) * 80 + (16 + t) * 2) = (unsigned short)f2bf(kh[e]); }
        if (t == 0) { GC[c2] = __expf(cs[0]); GC[c2 + 1] = __expf(cs[1]); } }
    BAR();
    if (w < 4) { const int arow = (w & 1) ? 16 : 0  , brow = (w & 2) ? 16 : 0  ;
        f32x4 d = (f32x4){0.f, 0.f, 0.f, 0.f};
        d = MFMA16(ldfrag(L + RW_BK, 144, arow, 0, fr, g), ldfrag(L + RW_AR, 144, brow, 0, fr, g), d);
        d = MFMA16(ldfrag(L + RW_BK, 144, arow, 64, fr, g), ldfrag(L + RW_AR, 144, brow, 64, fr, g), d);
        const int t = fr; float v[4];
#pragma unroll
        for (int r = 0; r < 4; ++r) { const int s = 4 * g + r; const bool keep = (w < 2) ? (s < t) : (s <= t); v[r] = keep ? d[r] : 0.f; }
        if (w == 0) *(LAS f32x4*)(AAB + t * 16 + 4 * g) = (f32x4){v[0], v[1], v[2], v[3]};
        else { u32x2 o; o.x = pk2(v[0], v[1]); o.y = pk2(v[2], v[3]);
            LAS unsigned char* dst = (w == 1) ? (L + RW_ZAK + t * 80 + (16 + 4 * g) * 2) : (w == 2) ? (L + RW_RBK + t * 80 + (4 * g) * 2) : (L + RW_RBK + t * 80 + (16 + 4 * g) * 2);
            *(LAS u32x2*)dst = o; } }
    BAR();
    if (w == 7) { if (lane < 16) { float col[16];
#pragma unroll
            for (int t = 0; t < 16; ++t) { float acc = (t == lane) ? 1.0f : 0.f;
#pragma unroll
                for (int s = 0; s < t; ++s) acc += AAB[t * 16 + s] * col[s];
                col[t] = acc; }
#pragma unroll
            for (int t = 0; t < 16; ++t) *(LAS unsigned short*)(L + RW_TT + t * 80 + lane * 2) = (unsigned short)f2bf(col[t]); }
        LDS_WAIT();
        { const u32x2 lo = *(const LAS u32x2*)(L + RW_TT + fr * 80 + 8 * g), hi = *(const LAS u32x2*)(L + RW_ZAK + fr * 80 + 32 + 8 * g); u32x4 o; o.x = lo.x; o.y = lo.y; o.z = hi.x; o.w = hi.y;
            *(u32x4*)(rec + RC_ZT + fr * 64 + 16 * g) = o; } }
    else {
#pragma unroll 1
        for (int job = w; job < 16; job += 7) {
            if (job < 9) { int src, stride, row0, ka, kb2, dst;
                if (job < 4) { src = RW_AR; stride = 144; row0 = (job >> 1) * 16; ka = 32 * (job & 1); kb2 = ka + 16; dst = (job >> 1 ? RC_RT : RC_AT) + (job & 1) * 1024; }
                else if (job == 4) { src = RW_RBK; stride = 80; row0 = 0; ka = 0; kb2 = 16; dst = RC_RBK; }
                else { src = RW_BKT; stride = 80; row0 = 16 * (job - 5); ka = 0; kb2 = 16; dst = RC_BKT + (job - 5) * 1024; }
                const LAS unsigned char* rp = L + src + (row0 + fr) * stride + 8 * g; const u32x2 lo = *(const LAS u32x2*)(rp + ka * 2), hi = *(const LAS u32x2*)(rp + kb2 * 2);
                u32x4 o; o.x = lo.x; o.y = lo.y; o.z = hi.x; o.w = hi.y; *(u32x4*)(rec + dst + fr * 64 + 16 * g) = o; }
            else if (job < 13) { const int vb = job - 9; const LAS float* vp = V + (4 * g) * 64 + 16 * vb + fr; u32x2 o; o.x = pk2(vp[0], vp[64]); o.y = pk2(vp[128], vp[192]); *(u32x2*)(rec + RC_VT4 + vb * 512 + lane * 8) = o; }
            else { const int p = (job - 13) * 64 + lane;
                if (p < 16) *(f32x4*)(rec + RC_GC + 16 * p) = *(const LAS f32x4*)(GC + 4 * p);
                else if (p < 144) { const int q = p - 16; const f32x4 a = *(const LAS f32x4*)(G + q * 8), c = *(const LAS f32x4*)(G + q * 8 + 4); u32x4 o; o.x = pk2(a[0], a[1]); o.y = pk2(a[2], a[3]); o.z = pk2(c[0], c[1]); o.w = pk2(c[2], c[3]); *(u32x4*)(rec + RC_G + 16 * q) = o; }
                else if (p < 148) { const int q = p - 144; *(f32x4*)(rec + RC_BON + 16 * q) = *(const LAS f32x4*)(BON + 4 * q); } } } }
    BAR();
}

constexpr int SB_STRIDE = 14720, SB_NBUF = 4, ST_OB = SB_NBUF * SB_STRIDE  , ST_END = ST_OB + 8192;
static_assert(ST_END <= RING_BYTES && SB_STRIDE >= RC_BYTES && SB_STRIDE % 64 == 0, "state pass LDS");
__device__ __forceinline__ void rwkv_state(Frame& F, const unsigned char* recs, bf16* Y, const RwkvP P, int b, int h) {
    const int tid = mytid(F), lane = tid & 63, w = __builtin_amdgcn_readfirstlane(tid >> 6), fr = lane & 15, g = lane >> 4;
    LAS unsigned char* L = F.lds;
    const unsigned char* rbase = recs + (size_t)(b * 4 + h) * (SEQ / 16) * RC_STRIDE;
    const int lt = tid - 256;
    const int ld = tid - 384;
    const f32x4 plg = *(const f32x4*)(P.lg + h * 64 + (tid & 15) * 4), plb = *(const f32x4*)(P.lb + h * 64 + (tid & 15) * 4);
    u32x4 preA[8], preB[8];
#pragma unroll
    for (int i = 0; i < 8; ++i) { const int p = ld + 128 * i; const bool ok = ld >= 0 && p < RC_CHUNKS16;
        preA[i] = ok ? *(const u32x4*)(rbase + 16 * p) : (u32x4){0u, 0u, 0u, 0u}; preB[i] = ok ? *(const u32x4*)(rbase + RC_STRIDE + 16 * p) : (u32x4){0u, 0u, 0u, 0u}; }
    f32x4 accS[4];
#pragma unroll
    for (int i = 0; i < 4; ++i) accS[i] = (f32x4){0.f, 0.f, 0.f, 0.f};
    constexpr int NCH = SEQ / 16;
#define RW_INTERVAL(PRE) { \
        if (w >= 6) { \
            if (c + 2 < NCH) { LAS unsigned char* B = L + ((c + 2) & 3) * SB_STRIDE; \
                _Pragma("unroll") for (int i = 0; i < 8; ++i) { const int p = ld + 128 * i; if (p < RC_CHUNKS16) *(LAS u32x4*)(B + 16 * p) = PRE[i]; } } \
            if (c + 4 < NCH) { const unsigned char* rp = rbase + (size_t)(c + 4) * RC_STRIDE; \
                _Pragma("unroll") for (int i = 0; i < 8; ++i) { const int p = ld + 128 * i; if (p < RC_CHUNKS16) PRE[i] = *(const u32x4*)(rp + 16 * p); } } \
        } else if (w >= 4) { \
            if (c >= 1) { _Pragma("unroll") for (int hh = 0; hh < 2; ++hh) { const int ce = c - 1; const LAS unsigned char* B = L + (ce & 3) * SB_STRIDE; const LAS float* OB = (const LAS float*)(L + ST_OB + (ce & 1) * 4096); \
                const int tt = (lt >> 4) + 8 * hh, c4 = (lt & 15) * 4; const f32x4 o = *(const LAS f32x4*)(OB + tt * 64 + c4); \
                float s = (o[0] + o[1]) + (o[2] + o[3]); s = red16(s); const float mean = s * (1.0f / 64.0f); const f32x4 d = o - mean; \
                float ss = (d[0] * d[0] + d[1] * d[1]) + (d[2] * d[2] + d[3] * d[3]); ss = red16(ss); const float rstd = __builtin_amdgcn_rsqf(ss * (1.0f / 64.0f) + 64e-5f); \
                const u32x2 gw = *(const LAS u32x2*)(B + RC_G + tt * 128 + c4 * 2); const float bon = ((const LAS float*)(B + RC_BON))[tt]; \
                const LAS unsigned short* vq = (const LAS unsigned short*)(B + RC_VT4 + (c4 >> 4) * 512 + ((tt >> 2) * 16 + (c4 & 15)) * 8 + (tt & 3) * 2); \
                const float vv[4] = {bf1(vq[0]), bf1(vq[4]), bf1(vq[8]), bf1(vq[12])}, gg[4] = {bflo(gw.x), bfhi(gw.x), bflo(gw.y), bfhi(gw.y)}; float y[4]; \
                _Pragma("unroll") for (int e = 0; e < 4; ++e) y[e] = (d[e] * rstd * plg[e] + plb[e] + bon * vv[e]) * gg[e]; \
                u32x2 wv; wv.x = pk2(y[0], y[1]); wv.y = pk2(y[2], y[3]); *(u32x2*)(Y + ((size_t)b * SEQ + ce * 16 + tt) * DM + 512 + h * 64 + c4) = wv; } } \
        } else if (c >= 0 && c < NCH) { const int vb = w; const LAS unsigned char* B = L + (c & 3) * SB_STRIDE; LAS float* OB = (LAS float*)(L + ST_OB + (c & 1) * 4096); const int fo = fr * 64 + 16 * g; \
            const bf16x8 at0 = *(const LAS bf16x8*)(B + RC_AT + fo), at1 = *(const LAS bf16x8*)(B + RC_AT + 1024 + fo), rt0 = *(const LAS bf16x8*)(B + RC_RT + fo), rt1 = *(const LAS bf16x8*)(B + RC_RT + 1024 + fo); \
            const bf16x8 zt = *(const LAS bf16x8*)(B + RC_ZT + fo), rbk = *(const LAS bf16x8*)(B + RC_RBK + fo); const u32x2 v4 = *(const LAS u32x2*)(B + RC_VT4 + vb * 512 + lane * 8); \
            u32x4 sw0, sw1; sw0.x = pk2(accS[0][0], accS[0][1]); sw0.y = pk2(accS[0][2], accS[0][3]); sw0.z = pk2(accS[1][0], accS[1][1]); sw0.w = pk2(accS[1][2], accS[1][3]); \
            sw1.x = pk2(accS[2][0], accS[2][1]); sw1.y = pk2(accS[2][2], accS[2][3]); sw1.z = pk2(accS[3][0], accS[3][1]); sw1.w = pk2(accS[3][2], accS[3][3]); \
            const bf16x8 s0 = __builtin_bit_cast(bf16x8, sw0), s1 = __builtin_bit_cast(bf16x8, sw1); \
            f32x4 y = (f32x4){0.f, 0.f, 0.f, 0.f}, accO = y; \
            y = MFMA16(at0, s0, y); y = MFMA16(at1, s1, y); accO = MFMA16(rt0, s0, accO); accO = MFMA16(rt1, s1, accO); \
            u32x4 bw; bw.x = 0u; bw.y = 0u; bw.z = v4.x; bw.w = v4.y; y = MFMA16(zt, __builtin_bit_cast(bf16x8, bw), y); \
            bw.x = pk2(y[0], y[1]); bw.y = pk2(y[2], y[3]); bw.z = 0u; bw.w = 0u; f32x4 u = (f32x4){0.f, 0.f, 0.f, 0.f}; u = MFMA16(zt, __builtin_bit_cast(bf16x8, bw), u); \
            bw.x = pk2(u[0], u[1]); bw.y = pk2(u[2], u[3]); bw.z = v4.x; bw.w = v4.y; const bf16x8 uv = __builtin_bit_cast(bf16x8, bw); \
            accO = MFMA16(rbk, uv, accO); \
            _Pragma("unroll") for (int r = 0; r < 4; ++r) OB[(4 * g + r) * 64 + 16 * vb + fr] = accO[r]; \
            _Pragma("unroll") for (int kb = 0; kb < 4; ++kb) { const f32x4 gc = *(const LAS f32x4*)(B + RC_GC + (16 * kb + 4 * g) * 4); accS[kb] = accS[kb] * gc; accS[kb] = MFMA16(*(const LAS bf16x8*)(B + RC_BKT + kb * 1024 + fo), uv, accS[kb]); } \
        } \
        BAR(); }
    BAR();
    for (int c = -2; c <= NCH; c += 2) {
        RW_INTERVAL(preA)
        ++c; if (c <= NCH) RW_INTERVAL(preB)
        --c;
    }
#undef RW_INTERVAL
}

__device__ __forceinline__ void moe_route(Frame& F, const float* hres, const float* gffn, const float* router) {
    const int tid = mytid(F), lane = tid & 63, wave = __builtin_amdgcn_readfirstlane(tid >> 6); (void)lane; (void)wave;
    unsigned char* rt = F.ws + WS_RT;
    int* tope = (int*)(rt + RT_TOPE); float* gate = (float*)(rt + RT_GATE); int* rank = (int*)(rt + RT_RANK); float* rstd = (float*)(rt + RT_RSTD); int* hist = (int*)(rt + RT_HIST); int* rowtok = (int*)(rt + RT_ROWTOK);
    LAS float* RW = (LAS float*)F.lds;
    LAS int* LH = (LAS int*)(F.lds + 32768);
    for (int i = tid; i < 8192; i += NTHREADS) RW[i] = router[i];
    if (tid < 16) LH[tid] = 0;
    for (int i = F.blk * NTHREADS + tid; i < 2 * MOE_ROWS; i += F.G * NTHREADS) rowtok[i] = -1;
    __syncthreads();
    const int tpb = NTOK / F.G;
    for (int i = wave; i < tpb; i += NWAVES) { const int t = F.blk * tpb + i;
        const f32x4* hr = (const f32x4*)(hres + (size_t)t * DM) + lane; f32x4 v[4]; float ss = 0.f;
#pragma unroll
        for (int j = 0; j < 4; ++j) { v[j] = hr[64 * j]; ss += (v[j][0] * v[j][0] + v[j][1] * v[j][1]) + (v[j][2] * v[j][2] + v[j][3] * v[j][3]); }
        ss = wave_sum(ss); const float rs = __builtin_amdgcn_rsqf(ss * (1.0f / DM) + NORM_EPS);
        float lg[8];
#pragma unroll
        for (int e = 0; e < 8; ++e) lg[e] = 0.f;
#pragma unroll
        for (int j = 0; j < 4; ++j) { const f32x4 gv = *((const f32x4*)gffn + 64 * j + lane);
#pragma unroll
            for (int c = 0; c < 4; ++c) { const int k = 256 * j + 4 * lane + c; const float xn = v[j][c] * rs * gv[c]; const f32x4 r0 = *(const LAS f32x4*)(RW + k * 8), r1 = *(const LAS f32x4*)(RW + k * 8 + 4);
                lg[0] += xn * r0[0]; lg[1] += xn * r0[1]; lg[2] += xn * r0[2]; lg[3] += xn * r0[3]; lg[4] += xn * r1[0]; lg[5] += xn * r1[1]; lg[6] += xn * r1[2]; lg[7] += xn * r1[3]; } }
#pragma unroll
        for (int e = 0; e < 8; ++e) lg[e] = wave_sum(lg[e]);
        int i1 = 0; float m1 = lg[0];
#pragma unroll
        for (int e = 1; e < 8; ++e) if (lg[e] > m1) { m1 = lg[e]; i1 = e; }
        int i2 = -1; float m2 = -3.0e38f;
#pragma unroll
        for (int e = 0; e < 8; ++e) if (e != i1 && lg[e] > m2) { m2 = lg[e]; i2 = e; }
        if (lane == 0) { const float g1 = 1.0f / (1.0f + __expf(m2 - m1));
            const int r1 = atomicAdd((int*)&LH[i1], 1), r2 = atomicAdd((int*)&LH[8 + i2], 1);
            tope[2 * t] = i1; tope[2 * t + 1] = i2; gate[2 * t] = g1; gate[2 * t + 1] = 1.0f - g1; rank[2 * t] = r1; rank[2 * t + 1] = r2; rstd[t] = rs; }
    }
    __syncthreads();
    if (tid < 16) hist[F.blk * 16 + tid] = LH[tid];
}
__device__ __forceinline__ void moe_gather(Frame& F, int slot, const bf16* hb, bf16* asort) {
    const int tid = mytid(F), lane = tid & 63, wave = __builtin_amdgcn_readfirstlane(tid >> 6); (void)lane; (void)wave;
    unsigned char* rt = F.ws + WS_RT;
    const int* tope = (const int*)(rt + RT_TOPE); const float* gate = (const float*)(rt + RT_GATE); const int* rank = (const int*)(rt + RT_RANK); const float* rstd = (const float*)(rt + RT_RSTD); const int* hist = (const int*)(rt + RT_HIST);
    int* rowtok = (int*)(rt + RT_ROWTOK) + slot * MOE_ROWS; float* rowgate = (float*)(rt + RT_ROWGATE) + slot * MOE_ROWS; float* rowrstd = (float*)(rt + RT_ROWRSTD) + slot * MOE_ROWS;
    int* tilee = (int*)(rt + RT_TILEE) + slot * 256; int* ntiles = (int*)(rt + RT_NTILES);
    LAS int* BASE = (LAS int*)(F.lds + 40960);
    LAS int* TOT = BASE + 8;
    __syncthreads();
    LAS int* HL = (LAS int*)(F.lds + 49152);
    for (int i = tid; i < F.G * 8; i += NTHREADS) HL[i] = hist[(i >> 3) * 16 + slot * 8 + (i & 7)];
    __syncthreads();
    { const int e = tid & 7, part = tid >> 3;
        const int per = (F.G + 63) / 64; int sb = 0, st = 0;
        for (int j = 0; j < per; ++j) { const int bb = part * per + j; if (bb < F.G) { const int c = HL[bb * 8 + e]; st += c; if (bb < F.blk) sb += c; } }
        LAS int* PB = (LAS int*)(F.lds + 49152 + 16384); PB[tid] = sb; PB[512 + tid] = st; }
    __syncthreads();
    if (tid < 8) { const LAS int* PB = (const LAS int*)(F.lds + 49152 + 16384); int before = 0, tot = 0;
        for (int p = 0; p < 64; ++p) { before += PB[p * 8 + tid]; tot += PB[512 + p * 8 + tid]; }
        BASE[tid] = before; TOT[tid] = tot; }
    __syncthreads();
    if (tid == 0) { int ps = 0, nt = 0;
        for (int e = 0; e < 8; ++e) { const int tl = (TOT[e] + 255) >> 8; BASE[e] += ps; if (F.blk == 0) for (int i = 0; i < tl; ++i) tilee[nt + i] = e; ps += tl * 256; nt += tl; }
        if (F.blk == 0) ntiles[slot] = nt; }
    __syncthreads();
    const int tpb = NTOK / F.G;
    for (int i = wave; i < tpb; i += NWAVES) { const int t = F.blk * tpb + i; const int e = tope[2 * t + slot]; const int dest = BASE[e] + rank[2 * t + slot];
        if (lane == 0) { rowtok[dest] = t; rowgate[dest] = gate[2 * t + slot]; rowrstd[dest] = rstd[t]; }
        const u32x4* s = (const u32x4*)(hb + (size_t)t * DM) + lane; u32x4* d = (u32x4*)(asort + (size_t)dest * DM) + lane;
        const u32x4 a = s[0], c = s[64]; d[0] = a; d[64] = c; }
}

#ifndef MK_PER_PHASE
#define MK_PER_PHASE 0
#endif
constexpr int N_PHASES = 19;
__global__ void __launch_bounds__(NTHREADS, 2) mk_fwd(Params prm) {
    extern __shared__ __attribute__((aligned(16))) unsigned char lds_raw[];
    Frame F;
    F.lds = (LAS unsigned char*)lds_raw;
    F.blk = blockIdx.x; F.G = gridDim.x; F.out = prm.out; F.ws = prm.ws; F.wv = __builtin_amdgcn_readfirstlane(threadIdx.x >> 6);
    volatile LAS unsigned* MISC = (volatile LAS unsigned*)(F.lds + MISC_OFF);
    for (int u = threadIdx.x; u < (LDS_BYTES - LDSCTL_OFF) / 4; u += NTHREADS) ((LAS unsigned*)(F.lds + LDSCTL_OFF))[u] = 0u;
    __syncthreads();
    if (threadIdx.x == 0) { LAS unsigned long long* tab = (LAS unsigned long long*)(F.lds + PTAB_OFF);
#pragma unroll
        for (int i_ = 0; i_ < 33; ++i_) tab[i_] = (unsigned long long)prm.in[i_]; }
    __syncthreads();
    const int lo = prm.ph_lo, hi = prm.ph_hi;
    unsigned* ctl = (unsigned*)(F.ws + WS_CTL);
    XcdBarrier bar; bar.bar = ctl + CW_BAR; bar.x = 0; bar.st = nullptr;
    if (hi - lo > 1) bar = xcd_barrier_post(ctl + CW_BAR, MISC + 8);
    unsigned char* ws = F.ws;
    bf16* hb = (bf16*)(ws + WS_HB); bf16* z = (bf16*)(ws + WS_Z); bf16* act = (bf16*)(ws + WS_Z); bf16* y = (bf16*)(ws + WS_Y); bf16* asort = (bf16*)(ws + WS_Y);
    float* ssq = (float*)(ws + WS_SSQ); bf16* opart = (bf16*)(ws + WS_OP); float* lse = (float*)(ws + WS_LSE);
    unsigned char* rt = ws + WS_RT;
#define IN(k) (lo <= (k) && (k) < hi)
#ifndef PROBE_MASK
#define PROBE_MASK 0
#endif
#if PROBE_MASK
#define STAMP(k) do { if (blockIdx.x == 0 && threadIdx.x == 0) ((volatile LAS unsigned long long*)(F.lds + LDSCTL_OFF + 2048))[k] = __builtin_amdgcn_s_memrealtime(); } while (0)
#else
#define STAMP(k) do { } while (0)
#endif
#define SEAM(k) do { if (IN(k) && IN((k) + 1)) xcd_barrier(bar); STAMP((k) + 1); } while (0)

    STAMP(0);
    if (IN(0)) p0_prologue(F, 0);
    SEAM(0);
#pragma unroll 1
    for (int layer = 0; layer < 2; ++layer) {
        const int pb = layer == 0 ? 1 : 8;
        if (IN(pb)) {
            pg8::Gemm g{hb, (const bf16*)(ws + WS_WIN) + (size_t)layer * NPADW * DM, NTOK, NPADW, DM, F.wv}; pg8::StaticOrder S; S.init(NTOK / 256, NPADW / 256, F.G, F.blk);
            pg8::EpiZ E{z, INW, INW, ssq};
            pg8::gemm_phase<pg8::EpiZ, pg8::StaticOrder, true, true>(F.lds, g, S, E);
        }
        SEAM(pb);
#if defined(PROBE_SUB)
        const unsigned long long tsub0 = __builtin_amdgcn_s_memrealtime();
#define PSUB(cls) do { if (threadIdx.x == 0 && (F.blk == 0 || F.blk == 32)) ((unsigned long long*)(F.ws + 32768))[layer * 4 + (cls)] = __builtin_amdgcn_s_memrealtime() - tsub0; } while (0)
#else
#define PSUB(cls) do { } while (0)
#endif
        if (IN(pb + 1)) {
            {
                const int wi = F.blk, nw = F.G;
                const RwkvP RP{inptr(F, IN_MU) + layer * 896, inptr(F, IN_W0) + layer * 256, inptr(F, IN_W2) + layer * 32 * 256, inptr(F, IN_A0) + layer * 256, inptr(F, IN_A2) + layer * 32 * 256, inptr(F, IN_G2) + layer * 64 * 256,
                               inptr(F, IN_KK) + layer * 256, inptr(F, IN_KA) + layer * 256, inptr(F, IN_RK) + layer * 256, inptr(F, IN_RLG) + layer * 256, inptr(F, IN_RLB) + layer * 256};
                unsigned char* recs = ws + WS_MOEW;
                for (int tile = wi; tile < 3072; tile += nw) attn_tile(F.lds, z, opart, lse, inptr(F, IN_RELB), inptr(F, IN_QG) + layer * 64, inptr(F, IN_KG) + layer * 64, tile, mytid(F));
                PSUB(2);
                for (int item = wi; item < 512; item += nw) conv_item(F, z, y, inptr(F, IN_CW) + layer * 31 * 256, inptr(F, IN_CB) + layer * 256, inptr(F, IN_CLG) + layer * 256, inptr(F, IN_CLB) + layer * 256, item);
                { const int tid_ = mytid(F), lane_ = tid_ & 63, w_ = __builtin_amdgcn_readfirstlane(tid_ >> 6);
#pragma unroll 1
                    for (int h = 0; h < 4; ++h) {
                        rwkv_prep_init(F, RP, h); BAR();
                        u32x4 cur[2], prv[2], ncur[2], nprv[2];
#pragma unroll
                        for (int q = 0; q < 2; ++q) { cur[q] = (u32x4){0u, 0u, 0u, 0u}; prv[q] = cur[q]; ncur[q] = cur[q]; nprv[q] = cur[q]; }
                        if (wi < 2048) rwkv_prep_load(z, wi >> 8, h, wi & 255, w_, lane_, cur, prv);
#pragma unroll 1
                        for (int it = wi; it < 2048; it += nw) { const int nx = it + nw;
                            if (nx < 2048) rwkv_prep_load(z, nx >> 8, h, nx & 255, w_, lane_, ncur, nprv);
                            rwkv_prep_item(F, recs + (size_t)(((it >> 8) * 4 + h) * 256 + (it & 255)) * RC_STRIDE, RP, h, cur, prv);
#pragma unroll
                            for (int q = 0; q < 2; ++q) { cur[q] = ncur[q]; prv[q] = nprv[q]; } }
                        BAR(); } }
                PSUB(3);
                gla_items<0>(F, z, ws + WS_MOEW + (size_t)NB * 4 * (SEQ / 16) * RC_STRIDE, (float*)(ws + WS_GLAEC), y, inptr(F, IN_GG2) + layer * 16 * 128, inptr(F, IN_GGB) + layer * 128, inptr(F, IN_GNG) + layer * 64, wi, nw);
                PSUB(1);
            }
        }
        SEAM(pb + 1);
        if (IN(pb + 2)) {
            if (F.blk < 32) {
                const RwkvP RP{inptr(F, IN_MU) + layer * 896, inptr(F, IN_W0) + layer * 256, inptr(F, IN_W2) + layer * 32 * 256, inptr(F, IN_A0) + layer * 256, inptr(F, IN_A2) + layer * 32 * 256, inptr(F, IN_G2) + layer * 64 * 256,
                               inptr(F, IN_KK) + layer * 256, inptr(F, IN_KA) + layer * 256, inptr(F, IN_RK) + layer * 256, inptr(F, IN_RLG) + layer * 256, inptr(F, IN_RLB) + layer * 256};
                unsigned char* recs = ws + WS_MOEW;
                rwkv_state(F, recs, y, RP, F.blk >> 2, F.blk & 3); }
            else { if (F.blk < 64) gla_scan(F, ws + WS_MOEW + (size_t)NB * 4 * (SEQ / 16) * RC_STRIDE, (const float*)(ws + WS_GLAEC), (F.blk - 32) >> 2, (F.blk - 32) & 3);
                attn_merge(F, opart, lse, y); }
        }
        SEAM(pb + 2);
        if (IN(pb + 3)) gla_items<1>(F, z, ws + WS_MOEW + (size_t)NB * 4 * (SEQ / 16) * RC_STRIDE, (float*)(ws + WS_GLAEC), y, inptr(F, IN_GG2) + layer * 16 * 128, inptr(F, IN_GGB) + layer * 128, inptr(F, IN_GNG) + layer * 64, F.blk, F.G);
        SEAM(pb + 3);
        if (IN(pb + 4)) {
            pg8::Gemm g{y, (const bf16*)(ws + WS_WOUT) + (size_t)layer * DM * DM, NTOK, DM, DM, F.wv}; pg8::StaticOrder S; S.init(NTOK / 256, DM / 256, F.G, F.blk);
            pg8::EpiRes E{layer == 0 ? inptr(F, IN_X) : (const float*)F.out, F.out, hb, ssq};
            pg8::gemm_phase<pg8::EpiRes, pg8::StaticOrder, true, true>(F.lds, g, S, E);
        }
        SEAM(pb + 4);
        if (layer == 0) {
            if (IN(6)) {
                pg8::Gemm g{hb, (const bf16*)(ws + WS_WGU), NTOK, 2 * DFF, DM, F.wv}; pg8::StaticOrder S; S.init(NTOK / 256, 2 * DFF / 256, F.G, F.blk);
                pg8::EpiSwiGLU<false> E{act, ssq, nullptr};
                pg8::gemm_phase<pg8::EpiSwiGLU<false>, pg8::StaticOrder, true, true>(F.lds, g, S, E);
            }
            SEAM(6);
            if (IN(7)) {
                pg8::Gemm g{act, (const bf16*)(ws + WS_WD), NTOK, DM, DFF, F.wv}; pg8::StaticOrder S; S.init(NTOK / 256, DM / 256, F.G, F.blk);
                pg8::EpiRes E{F.out, F.out, hb, ssq};
                pg8::gemm_phase<pg8::EpiRes, pg8::StaticOrder, true, true>(F.lds, g, S, E);
            }
            SEAM(7);
        }
    }
    if (IN(13)) { moe_route(F, F.out, inptr(F, IN_FFNG) + DM, inptr(F, IN_ROUTER)); __syncthreads(); p0_prologue(F, 1); }
    SEAM(13);
    if (IN(14)) moe_gather(F, 0, hb, asort);
    SEAM(14);
#pragma unroll 1
    for (int slot = 0; slot < 2; ++slot) {
        const int pg = 15 + 2 * slot;
        const int* tilee = (const int*)(rt + RT_TILEE) + slot * 256;
        if (IN(pg)) {
            const int nt = __builtin_amdgcn_readfirstlane(((const int*)(rt + RT_NTILES))[slot]);
            pg8::Gemm g{asort, (const bf16*)(ws + WS_MOEW), nt * 256, 2 * DFF, DM, F.wv}; pg8::StaticOrder S; S.init(nt, 2 * DFF / 256, F.G, F.blk, tilee, MOEW_E_BYTES);
            pg8::EpiSwiGLU<true> E{act, nullptr, (const float*)(rt + RT_ROWRSTD) + slot * MOE_ROWS};
            pg8::gemm_phase<pg8::EpiSwiGLU<true>, pg8::StaticOrder, true, true>(F.lds, g, S, E);
        }
        SEAM(pg);
        if (IN(pg + 1)) {
            const int nt = __builtin_amdgcn_readfirstlane(((const int*)(rt + RT_NTILES))[slot]);
            pg8::Gemm g{act, (const bf16*)(ws + WS_MOEW + MOEW_GU_BYTES), nt * 256, DM, DFF, F.wv}; pg8::StaticOrder S; S.init(nt, DM / 256, F.G, F.blk, tilee, MOEW_E_BYTES);
            pg8::EpiMoeDown E{F.out, (const int*)(rt + RT_ROWTOK) + slot * MOE_ROWS, (const float*)(rt + RT_ROWGATE) + slot * MOE_ROWS};
            pg8::gemm_phase<pg8::EpiMoeDown, pg8::StaticOrder, true, true>(F.lds, g, S, E);
            if (slot == 0) moe_gather(F, 1, hb, asort);
        }
        if (slot == 0) SEAM(pg + 1);
    }
#if PROBE_MASK
    __syncthreads();
    if (blockIdx.x == 0 && threadIdx.x == 0) { STAMP(N_PHASES); volatile LAS unsigned long long* ts = (volatile LAS unsigned long long*)(F.lds + LDSCTL_OFF + 2048); unsigned long long tot = 0;
        for (int k = 0; k < N_PHASES; ++k) if ((PROBE_MASK >> k) & 1) tot += ts[k + 1] - ts[k];
#if defined(PROBE_SUB)
        tot = (PROBE_SUB == 0) ? ((volatile unsigned long long*)(F.ws + 32768))[0] : ((volatile unsigned long long*)(F.ws + 32768))[PROBE_SUB] + ((volatile unsigned long long*)(F.ws + 32768))[4 + PROBE_SUB];
#endif
        const unsigned long long t0 = __builtin_amdgcn_s_memrealtime(); while (__builtin_amdgcn_s_memrealtime() - t0 < tot) __builtin_amdgcn_s_sleep(8); }
#endif
#undef IN
#undef SEAM
}

extern "C" void kernel_launch(void* const* d_in, const int* in_sizes, int n_in, void* d_out, int out_size, void* d_ws, size_t ws_size, hipStream_t stream) {
    static int grid = 0;
    if (grid == 0) {
        if (n_in != 33 || out_size != NTOK * DM || ws_size < WS_TOTAL) { fprintf(stderr, "kernel_launch: unexpected problem (n_in %d out %d ws %zu)\n", n_in, out_size, ws_size); grid = -1; return; }
        int dev = 0, cus = 0;
        if (hipGetDevice(&dev) != hipSuccess || hipDeviceGetAttribute(&cus, hipDeviceAttributeMultiprocessorCount, dev) != hipSuccess) { grid = -1; return; }
        if (hipFuncSetAttribute((const void*)mk_fwd, hipFuncAttributeMaxDynamicSharedMemorySize, LDS_BYTES) != hipSuccess) { fprintf(stderr, "kernel_launch: hipFuncSetAttribute failed\n"); grid = -1; return; }
        (void)hipGetLastError();
        grid = cus;
        if (grid != 256) fprintf(stderr, "kernel_launch: %d CUs (built for 256)\n", grid);
    }
    if (grid < 0) return;
    (void)hipMemsetAsync((char*)d_ws + WS_CTL, 0, CTL_ZERO_BYTES, stream);
    Params p{};
    for (int i = 0; i < 33; ++i) p.in[i] = (const float*)d_in[i];
    p.out = (float*)d_out; p.ws = (unsigned char*)d_ws;
#if MK_PER_PHASE
    for (int k = 0; k < N_PHASES; ++k) { p.ph_lo = k; p.ph_hi = k + 1; hipLaunchKernelGGL(mk_fwd, dim3(grid), dim3(NTHREADS), LDS_BYTES, stream, p); }
#else
    p.ph_lo = 0; p.ph_hi = N_PHASES;
    hipLaunchKernelGGL(mk_fwd, dim3(grid), dim3(NTHREADS), LDS_BYTES, stream, p);
#endif
}
```

```cpp
#include <hip/hip_runtime.h>
#include <cstdio>
#include <cstdint>

#define LAS __attribute__((address_space(3)))
#define GAS __attribute__((address_space(1)))
typedef unsigned short bf16;
typedef short bf16x8 __attribute__((ext_vector_type(8)));
typedef short s16x4 __attribute__((ext_vector_type(4)));
typedef float f32x4 __attribute__((ext_vector_type(4)));
typedef float f32x2 __attribute__((ext_vector_type(2)));
typedef unsigned u32x4 __attribute__((ext_vector_type(4)));
typedef unsigned u32x2 __attribute__((ext_vector_type(2)));

constexpr int DM = 1024, NB = 8, SEQ = 4096, NTOK = NB * SEQ, INW = 2960, NPADW = 3072, DFF = 2816, NEXP = 8;
constexpr int ZA = 0, ZB = 768, ZC = 1280, ZD = 2176;
constexpr float NORM_EPS = 1e-6f;
constexpr int MOE_ROWS = NTOK + NEXP * 256;

constexpr size_t MiB = 1u << 20;
constexpr size_t WS_CTL = 0, CTL_ZERO_BYTES = 64 * 1024;
constexpr size_t WS_WIN = 1 * MiB;
constexpr size_t WS_WOUT = 13 * MiB;
constexpr size_t WS_WGU = 17 * MiB;
constexpr size_t WS_WD = 28 * MiB;
constexpr size_t WS_SSQ = 34 * MiB;
constexpr size_t WS_RT = 36 * MiB;
constexpr size_t WS_HB = 40 * MiB;
constexpr size_t WS_Z = 104 * MiB;
constexpr size_t WS_Y = 297 * MiB;
constexpr size_t WS_MOEW = 367 * MiB;
constexpr size_t WS_END = 499 * MiB;
constexpr size_t WS_GLAEC = 499 * MiB;
constexpr size_t WS_TOTAL = 500 * MiB;
constexpr size_t MOEW_GU_BYTES = (size_t)2 * DFF * DM * 2, MOEW_D_BYTES = (size_t)DM * DFF * 2, MOEW_E_BYTES = MOEW_GU_BYTES + MOEW_D_BYTES;
static_assert(WS_Z + (size_t)MOE_ROWS * DFF * 2 <= WS_Y && WS_Y + (size_t)MOE_ROWS * DM * 2 <= WS_MOEW && WS_MOEW + NEXP * MOEW_E_BYTES <= WS_END, "ws map");
constexpr size_t WS_OP = WS_HB;
constexpr size_t WS_LSE = WS_HB + 48 * MiB;
constexpr size_t RT_TOPE = 0;
constexpr size_t RT_GATE = RT_TOPE + (size_t)NTOK * 8;
constexpr size_t RT_RANK = RT_GATE + (size_t)NTOK * 8;
constexpr size_t RT_RSTD = RT_RANK + (size_t)NTOK * 8;
constexpr size_t RT_HIST = RT_RSTD + (size_t)NTOK * 4;
constexpr size_t RT_ROWTOK = RT_HIST + 256 * 16 * 4;
constexpr size_t RT_ROWGATE = RT_ROWTOK + (size_t)2 * MOE_ROWS * 4;
constexpr size_t RT_ROWRSTD = RT_ROWGATE + (size_t)2 * MOE_ROWS * 4;
constexpr size_t RT_TILEE = RT_ROWRSTD + (size_t)2 * MOE_ROWS * 4;
constexpr size_t RT_NTILES = RT_TILEE + 2 * 256 * 4;
static_assert(RT_NTILES + 64 <= 4 * MiB, "routing arrays");

constexpr int CW_BAR = 1024;

constexpr int RING_BYTES = 131072, LDSCTL_OFF = RING_BYTES, MISC_OFF = LDSCTL_OFF + 320, LDS_BYTES = 147456;
constexpr int NWAVES = 8, NTHREADS = 512;

#define LDS_WAIT() asm volatile("s_waitcnt lgkmcnt(0)" ::: "memory")
#define VM_WAIT() asm volatile("s_waitcnt vmcnt(0)" ::: "memory")
#define BAR() do { asm volatile("s_waitcnt lgkmcnt(0)" ::: "memory"); __builtin_amdgcn_s_barrier(); asm volatile("" ::: "memory"); } while (0)
__device__ __forceinline__ unsigned f2bf(float f) { unsigned u = __builtin_bit_cast(unsigned, f); return (u + 0x7fffu + ((u >> 16) & 1u)) >> 16; }
typedef __bf16 bf16x2_hw __attribute__((ext_vector_type(2)));
__device__ __forceinline__ unsigned pk2(float lo, float hi) { const f32x2 v = {lo, hi}; const bf16x2_hw b = __builtin_convertvector(v, bf16x2_hw); return __builtin_bit_cast(unsigned, b); }
__device__ __forceinline__ float bflo(unsigned w) { return __builtin_bit_cast(float, w << 16); }
__device__ __forceinline__ float bfhi(unsigned w) { return __builtin_bit_cast(float, w & 0xffff0000u); }
__device__ __forceinline__ float bf1(bf16 b) { return __builtin_bit_cast(float, (unsigned)b << 16); }
__device__ __forceinline__ float wave_sum(float v) {
#pragma unroll
    for (int o = 1; o < 64; o <<= 1) v += __shfl_xor(v, o);
    return v;
}
#define DPP_ADD(v, ctrl) ((v) + __builtin_bit_cast(float, __builtin_amdgcn_update_dpp(0, __builtin_bit_cast(int, (v)), (ctrl), 0xf, 0xf, true)))
__device__ __forceinline__ float red8(float v) { v = DPP_ADD(v, 0xB1); v = DPP_ADD(v, 0x4E); v = DPP_ADD(v, 0x141); return v; }
__device__ __forceinline__ float red16(float v) { v = DPP_ADD(v, 0xB1); v = DPP_ADD(v, 0x4E); v = DPP_ADD(v, 0x141); v = DPP_ADD(v, 0x140); return v; }
__device__ __forceinline__ float sigmoidf_(float x) { return 1.0f / (1.0f + __expf(-x)); }
__device__ __forceinline__ float siluf_(float x) { return x / (1.0f + __expf(-x)); }
__device__ __forceinline__ float softplusf_(float x) { return fmaxf(x, 0.f) + __logf(1.0f + __expf(-fabsf(x))); }
__device__ __forceinline__ float tanhf_(float x) { const float e = __expf(2.0f * x); return 1.0f - 2.0f / (e + 1.0f); }
__device__ __forceinline__ void unpack8(const u32x4 w, float (&f)[8]) {
    f[0] = bflo(w.x); f[1] = bfhi(w.x); f[2] = bflo(w.y); f[3] = bfhi(w.y); f[4] = bflo(w.z); f[5] = bfhi(w.z); f[6] = bflo(w.w); f[7] = bfhi(w.w);
}

namespace pg8 {
#define PG8_LAS __attribute__((address_space(3)))
typedef unsigned short bf16_t;
constexpr int BM = 256, BK = 64, HALF = 128, HTB = HALF * BK * 2  , STAGE_BYTES = 8 * HTB, NXCD = 8, WGM = 8;

__host__ __device__ __forceinline__ int lds_byte(int r, int c) { const int st = (r >> 4) * 2 + (c >> 5), rr = r & 15, cc = c & 31, ob = rr * 64 + cc * 2; return st * 1024 + (ob ^ (((ob >> 9) & 1) << 5)); }
__host__ __device__ __forceinline__ void stage_rc(int b, int& R, int& C) { const int st = b / 1024, sb = b % 1024, swz = sb ^ (((sb >> 9) & 1) << 5); R = (st >> 1) * 16 + swz / 64; C = (st & 1) * 32 + (swz % 64) / 2; }
__host__ __device__ __forceinline__ int perm32(int rho) { const int n = rho >> 4, i = rho & 15; return 8 * (i >> 2) + 4 * n + (i & 3); }

struct Unit { int pm, pn; };
struct Gemm { const bf16_t* A; const bf16_t* Bt; int M, N, K, wv; };

struct StaticOrder {
    int nM, nN, nwg, G, c; const int* tile_e; size_t estride;
    __device__ void init(int nM_, int nN_, int G_, int c_, const int* te = nullptr, size_t es = 0) { nM = nM_; nN = nN_; nwg = nM * nN; G = G_; c = c_; tile_e = te; estride = es; }
    __device__ bool next(int i, Unit& u) const {
        const long L = (long)i * G + c; if (L >= nwg) return false;
        int wgid = (int)L; { const int q = nwg / NXCD, r = nwg % NXCD, xcd = wgid % NXCD, off = wgid / NXCD; wgid = (xcd < r ? xcd * (q + 1) : r * (q + 1) + (xcd - r) * q) + off; }
        const int nig = WGM * nN, gid = wgid / nig, fm = gid * WGM, gsz = (nM - fm) < WGM ? (nM - fm) : WGM;
        u.pm = fm + ((wgid % nig) % gsz); u.pn = (wgid % nig) / gsz; return true;
    }
    __device__ __forceinline__ size_t bofs(const Unit& u, size_t tstep) const { return (size_t)u.pn * tstep + (tile_e ? (size_t)__builtin_amdgcn_readfirstlane(tile_e[u.pm]) * estride : (size_t)0); }
    __device__ __forceinline__ void a_ready(const Unit&) const {}
    __device__ __forceinline__ void done(const Unit&) const {}
};

__device__ __forceinline__ unsigned cvt_pk_bf16(float lo, float hi) { unsigned r; asm volatile("v_cvt_pk_bf16_f32 %0, %1, %2" : "=v"(r) : "v"(lo), "v"(hi)); return r; }

__device__ __forceinline__ float row_rstd16(const float* ssq, int r, int fq) {
    const f32x4 p = *(const f32x4*)(ssq + (size_t)r * 16 + 4 * fq);
    float s = (p[0] + p[1]) + (p[2] + p[3]); s += __shfl_xor(s, 16); s += __shfl_xor(s, 32);
    return __builtin_amdgcn_rsqf(s * (1.0f / DM) + NORM_EPS);
}

struct EpiZ {
    static constexpr bool PERM = true, AFTER_DRAIN = false;
    bf16_t* Z; int ldc, ncols; const float* ssq;
    __device__ __forceinline__ void operator()(const f32x4 (&acc)[2][2][4][2], const Unit& u, int wr, int wc, int fr, int fq) const {
        const int row0 = u.pm * BM + wr * 64 + fr, col0 = u.pn * BM + wc * 32 + 8 * fq;
#pragma unroll
        for (int ai = 0; ai < 2; ++ai)
#pragma unroll
            for (int m = 0; m < 4; ++m) { const int r = row0 + ai * HALF + m * 16; const float rs = row_rstd16(ssq, r, fq); bf16_t* rowp = Z + (size_t)r * ldc + col0;
#pragma unroll
                for (int bj = 0; bj < 2; ++bj) { const f32x4 v0 = acc[ai][bj][m][0] * rs, v1 = acc[ai][bj][m][1] * rs;
                    u32x4 w; w.x = cvt_pk_bf16(v0[0], v0[1]); w.y = cvt_pk_bf16(v0[2], v0[3]); w.z = cvt_pk_bf16(v1[0], v1[1]); w.w = cvt_pk_bf16(v1[2], v1[3]);
                    if (col0 + bj * HALF < ncols) *(u32x4*)(rowp + bj * HALF) = w; } }
    }
};
template <bool MOE> struct EpiSwiGLU {
    static constexpr bool PERM = true, AFTER_DRAIN = false;
    bf16_t* O; const float* ssq; const float* row_rstd;
    __device__ __forceinline__ void operator()(const f32x4 (&acc)[2][2][4][2], const Unit& u, int wr, int wc, int fr, int fq) const {
        const int row0 = u.pm * BM + wr * 64 + fr, col0 = u.pn * HALF + wc * 32 + 8 * fq;
#pragma unroll
        for (int ai = 0; ai < 2; ++ai)
#pragma unroll
            for (int m = 0; m < 4; ++m) { const int r = row0 + ai * HALF + m * 16; float rs; if (MOE) rs = row_rstd[r]; else rs = row_rstd16(ssq, r, fq);
                const f32x4 g0 = acc[ai][0][m][0] * rs, g1 = acc[ai][0][m][1] * rs, u0 = acc[ai][1][m][0] * rs, u1 = acc[ai][1][m][1] * rs; f32x4 a0, a1;
#pragma unroll
                for (int j = 0; j < 4; ++j) { a0[j] = g0[j] * __builtin_amdgcn_rcpf(1.0f + __expf(-g0[j])) * u0[j]; a1[j] = g1[j] * __builtin_amdgcn_rcpf(1.0f + __expf(-g1[j])) * u1[j]; }
                u32x4 w; w.x = cvt_pk_bf16(a0[0], a0[1]); w.y = cvt_pk_bf16(a0[2], a0[3]); w.z = cvt_pk_bf16(a1[0], a1[1]); w.w = cvt_pk_bf16(a1[2], a1[3]);
                *(u32x4*)(O + (size_t)r * DFF + col0) = w; }
    }
};
struct EpiRes {
    static constexpr bool PERM = false, AFTER_DRAIN = false;
    const float* base; float* out; bf16_t* hb; float* ssq;
    __device__ __forceinline__ void operator()(const f32x4 (&acc)[2][2][4][2], const Unit& u, int wr, int wc, int fr, int fq) const {
        const int col0 = u.pn * BM + wc * 32 + 4 * fq;
#pragma unroll
        for (int ai = 0; ai < 2; ++ai)
#pragma unroll
            for (int m = 0; m < 4; ++m) { const int r = u.pm * BM + ai * HALF + wr * 64 + m * 16 + fr; const size_t off = (size_t)r * DM + col0; float ss = 0.f;
#pragma unroll
                for (int bj = 0; bj < 2; ++bj)
#pragma unroll
                    for (int n = 0; n < 2; ++n) { const f32x4 v = *(const f32x4*)(base + off + bj * HALF + n * 16) + acc[ai][bj][m][n];
                        *(f32x4*)(out + off + bj * HALF + n * 16) = v; ss += (v[0] * v[0] + v[1] * v[1]) + (v[2] * v[2] + v[3] * v[3]);
                        if (hb) { u32x2 w; w.x = cvt_pk_bf16(v[0], v[1]); w.y = cvt_pk_bf16(v[2], v[3]); *(u32x2*)(hb + off + bj * HALF + n * 16) = w; } }
                ss += __shfl_xor(ss, 16); ss += __shfl_xor(ss, 32);
                if (ssq && fq == 0) ssq[(size_t)r * 16 + u.pn * 4 + wc] = ss;
                if (m & 1) asm volatile("" ::: "memory"); }
    }
};
struct EpiMoeDown {
    static constexpr bool PERM = false, AFTER_DRAIN = false;
    float* out; const int* row_tok; const float* row_gate;
    __device__ __forceinline__ void operator()(const f32x4 (&acc)[2][2][4][2], const Unit& u, int wr, int wc, int fr, int fq) const {
        const int col0 = u.pn * BM + wc * 32 + 4 * fq;
#pragma unroll
        for (int ai = 0; ai < 2; ++ai)
#pragma unroll
            for (int m = 0; m < 4; ++m) { const int r = u.pm * BM + ai * HALF + wr * 64 + m * 16 + fr; const int tok = row_tok[r]; const float gt = row_gate[r];
                if (tok >= 0) { float* op = out + (size_t)tok * DM + col0;
#pragma unroll
                    for (int bj = 0; bj < 2; ++bj)
#pragma unroll
                        for (int n = 0; n < 2; ++n) { float* p = op + bj * HALF + n * 16; *(f32x4*)p = *(const f32x4*)p + acc[ai][bj][m][n] * gt; } }
                if (m & 1) asm volatile("" ::: "memory"); }
    }
};

template <class Epi, class Sched, bool ALIGN_EPI = false, bool SP2 = false>
__device__ __forceinline__ void gemm_phase(PG8_LAS unsigned char* lds, const Gemm g, const Sched& S, const Epi& E) {
    int lid_; asm volatile("v_mbcnt_lo_u32_b32 %0, -1, 0\n\tv_mbcnt_hi_u32_b32 %0, -1, %0" : "=v"(lid_)); int tid_ = g.wv * 64 + lid_; asm volatile("" : "+v"(tid_));
    const int tid = tid_, wid = __builtin_amdgcn_readfirstlane(tid >> 6), lane = tid & 63, wr = wid >> 2, wc = wid & 3, fr = lane & 15, fq = lane >> 4;
    const int K = g.K, nt = K / BK;
    unsigned voffA[2], voffB[2];
#pragma unroll
    for (int i = 0; i < 2; ++i) { int R, C; stage_rc(tid * 16 + i * 8192, R, C); const int Rb = Epi::PERM ? ((R & ~31) + perm32(R & 31)) : R;
        voffA[i] = (unsigned)(R * K + C) * 2u; voffB[i] = (unsigned)(Rb * K + C) * 2u; }
    const size_t kstep = (size_t)(BK * 2);
    const size_t hstep = (size_t)HALF * K * 2;
    const size_t tstep = 2 * hstep;
    const unsigned ldsw = (unsigned)wid * 1024u;
    const int aoff = lds_byte(wr * 64 + fr, fq * 8), boff = lds_byte(wc * 32 + fr, fq * 8);
#define PG8_SA(b, h) (((b) * 2 + (h)) * HTB)
#define PG8_SB(b, h) ((4 + (b) * 2 + (h)) * HTB)
#define PG8_STAGE(bufoff, gbase, voff) do { _Pragma("unroll") for (int _i = 0; _i < 2; ++_i) \
        __builtin_amdgcn_global_load_lds((const unsigned*)((const char*)(gbase) + (voff)[_i]), (PG8_LAS unsigned*)(lds + (bufoff) + ldsw + _i * 8192), 16, 0, 0); } while (0)
#define PG8_LDA(dst, b, h) do { _Pragma("unroll") for (int m = 0; m < 4; ++m) _Pragma("unroll") for (int k = 0; k < 2; ++k) dst[m][k] = *(const PG8_LAS bf16x8*)(lds + PG8_SA(b, h) + aoff + m * 2048 + k * 1024); } while (0)
#define PG8_LDB(dst, b, h) do { _Pragma("unroll") for (int n = 0; n < 2; ++n) _Pragma("unroll") for (int k = 0; k < 2; ++k) dst[n][k] = *(const PG8_LAS bf16x8*)(lds + PG8_SB(b, h) + boff + n * 2048 + k * 1024); } while (0)
#define PG8_MMA(ai, bj, At, Bt) do { __builtin_amdgcn_s_setprio(1); _Pragma("unroll") for (int m = 0; m < 4; ++m) _Pragma("unroll") for (int n = 0; n < 2; ++n) _Pragma("unroll") for (int k = 0; k < 2; ++k) \
        acc[ai][bj][m][n] = __builtin_amdgcn_mfma_f32_16x16x32_bf16(Bt[n][k], At[m][k], acc[ai][bj][m][n], 0, 0, 0); __builtin_amdgcn_s_setprio(0); } while (0)
#define PG8_WAIT_V(n) asm volatile("s_waitcnt vmcnt(" #n ")" ::: "memory")
#define PG8_WAIT_L(n) asm volatile("s_waitcnt lgkmcnt(" #n ")" ::: "memory")
#define PG8_BAR __builtin_amdgcn_s_barrier()
#define PG8_SCHED __builtin_amdgcn_sched_barrier(0)
    Unit cur, nxt; int ui = 0;
    if (!S.next(0, cur)) return;
    f32x4 acc[2][2][4][2];
#pragma unroll
    for (int a = 0; a < 2; ++a)
#pragma unroll
        for (int b = 0; b < 2; ++b)
#pragma unroll
            for (int m = 0; m < 4; ++m)
#pragma unroll
                for (int n = 0; n < 2; ++n) acc[a][b][m][n] = (f32x4){0.f, 0.f, 0.f, 0.f};
    bf16x8 At[4][2], B0[2][2], B1[2][2];
    const char* cA = (const char*)g.A + (size_t)cur.pm * tstep; const char* cB = (const char*)g.Bt + S.bofs(cur, tstep);
    S.a_ready(cur);
    if constexpr (SP2) {
        PG8_STAGE(PG8_SB(0, 0), cB, voffB); PG8_STAGE(PG8_SB(0, 1), cB + hstep, voffB); PG8_STAGE(PG8_SA(0, 0), cA, voffA); PG8_STAGE(PG8_SA(0, 1), cA + hstep, voffA);
        if (wr == 1) PG8_BAR;
        PG8_WAIT_V(2); PG8_BAR;
        PG8_STAGE(PG8_SB(1, 0), cB + kstep, voffB); PG8_STAGE(PG8_SA(1, 0), cA + kstep, voffA); PG8_STAGE(PG8_SB(1, 1), cB + hstep + kstep, voffB);
        PG8_WAIT_V(6); PG8_BAR;
    } else {
        PG8_STAGE(PG8_SB(0, 0), cB, voffB); PG8_STAGE(PG8_SA(0, 0), cA, voffA); PG8_STAGE(PG8_SB(0, 1), cB + hstep, voffB); PG8_STAGE(PG8_SA(0, 1), cA + hstep, voffA);
        if (wr == 1) PG8_BAR;
        PG8_WAIT_V(4); PG8_BAR;
        PG8_STAGE(PG8_SB(1, 0), cB + kstep, voffB); PG8_STAGE(PG8_SA(1, 0), cA + kstep, voffA); PG8_STAGE(PG8_SB(1, 1), cB + hstep + kstep, voffB);
        PG8_WAIT_V(6); PG8_BAR;
    }
    for (;;) {
        const bool has_next = S.next(ui + 1, nxt);
        const char* nA = has_next ? (const char*)g.A + (size_t)nxt.pm * tstep : cA; const char* nB = has_next ? (const char*)g.Bt + S.bofs(nxt, tstep) : cB;
        for (int t = 0; t < nt; t += 2) {
            const bool last = (t == nt - 2);
            const char* a1 = cA + (size_t)(t + 1) * kstep;
            const char* a2 = last ? nA : cA + (size_t)(t + 2) * kstep; const char* b2 = last ? nB : cB + (size_t)(t + 2) * kstep;
            const char* a3 = a2 + kstep; const char* b3 = b2 + kstep;
            if (last && has_next) S.a_ready(nxt);
            if constexpr (SP2) {
            PG8_LDB(B0, 0, 0); PG8_LDB(B1, 0, 1); PG8_SCHED; PG8_LDA(At, 0, 0); PG8_STAGE(PG8_SA(1, 1), a1 + hstep, voffA);
            PG8_WAIT_V(8); PG8_WAIT_L(0); PG8_BAR; PG8_MMA(0, 0, At, B0); PG8_MMA(0, 1, At, B1); PG8_BAR; PG8_SCHED;
            PG8_LDA(At, 0, 1); PG8_STAGE(PG8_SB(0, 0), b2, voffB); PG8_STAGE(PG8_SB(0, 1), b2 + hstep, voffB); PG8_STAGE(PG8_SA(0, 0), a2, voffA);
            PG8_WAIT_V(8); PG8_WAIT_L(0); PG8_BAR; PG8_MMA(1, 0, At, B0); PG8_MMA(1, 1, At, B1); PG8_BAR; PG8_SCHED;
            PG8_LDB(B0, 1, 0); PG8_LDB(B1, 1, 1); PG8_SCHED; PG8_LDA(At, 1, 0); PG8_STAGE(PG8_SA(0, 1), a2 + hstep, voffA);
            PG8_WAIT_V(8); PG8_WAIT_L(0); PG8_BAR; PG8_MMA(0, 0, At, B0); PG8_MMA(0, 1, At, B1); PG8_BAR; PG8_SCHED;
            PG8_LDA(At, 1, 1); PG8_STAGE(PG8_SB(1, 0), b3, voffB); PG8_STAGE(PG8_SB(1, 1), b3 + hstep, voffB); PG8_STAGE(PG8_SA(1, 0), a3, voffA);
            PG8_WAIT_V(8); PG8_WAIT_L(0); PG8_BAR; PG8_MMA(1, 0, At, B0); PG8_MMA(1, 1, At, B1); PG8_BAR; PG8_SCHED;
            } else {
            PG8_LDB(B0, 0, 0); PG8_SCHED; PG8_LDA(At, 0, 0); PG8_STAGE(PG8_SA(1, 1), a1 + hstep, voffA);
            PG8_WAIT_L(8); PG8_BAR; PG8_WAIT_L(0); PG8_MMA(0, 0, At, B0); PG8_BAR; PG8_SCHED;
            PG8_LDB(B1, 0, 1); PG8_STAGE(PG8_SB(0, 0), b2, voffB);
            PG8_BAR; PG8_WAIT_L(0); PG8_MMA(0, 1, At, B1); PG8_BAR;
            PG8_LDA(At, 0, 1); PG8_STAGE(PG8_SA(0, 0), a2, voffA);
            PG8_BAR; PG8_WAIT_L(0); PG8_MMA(1, 0, At, B0); PG8_BAR; PG8_SCHED;
            PG8_STAGE(PG8_SB(0, 1), b2 + hstep, voffB);
            PG8_WAIT_V(6); PG8_BAR; PG8_MMA(1, 1, At, B1); PG8_BAR;
            PG8_LDB(B0, 1, 0); PG8_SCHED; PG8_LDA(At, 1, 0); PG8_STAGE(PG8_SA(0, 1), a2 + hstep, voffA);
            PG8_WAIT_L(8); PG8_BAR; PG8_WAIT_L(0); PG8_MMA(0, 0, At, B0); PG8_BAR; PG8_SCHED;
            PG8_LDB(B1, 1, 1); PG8_STAGE(PG8_SB(1, 0), b3, voffB);
            PG8_BAR; PG8_WAIT_L(0); PG8_MMA(0, 1, At, B1); PG8_BAR;
            PG8_LDA(At, 1, 1); PG8_STAGE(PG8_SA(1, 0), a3, voffA);
            PG8_BAR; PG8_WAIT_L(0); PG8_MMA(1, 0, At, B0); PG8_BAR; PG8_SCHED;
            PG8_STAGE(PG8_SB(1, 1), b3 + hstep, voffB);
            PG8_WAIT_V(6); PG8_BAR; PG8_MMA(1, 1, At, B1); PG8_BAR;
            }
        }
        if constexpr (ALIGN_EPI) { if (wr == 0) PG8_BAR; }
        if constexpr (!Epi::AFTER_DRAIN) { E(acc, cur, wr, wc, fr, fq); S.done(cur); }
        if (!has_next) break;
#pragma unroll
        for (int a = 0; a < 2; ++a)
#pragma unroll
            for (int b = 0; b < 2; ++b)
#pragma unroll
                for (int m = 0; m < 4; ++m)
#pragma unroll
                    for (int n = 0; n < 2; ++n) acc[a][b][m][n] = (f32x4){0.f, 0.f, 0.f, 0.f};
        cur = nxt; cA = nA; cB = nB; ++ui;
        if constexpr (ALIGN_EPI) { if (wr == 1) PG8_BAR; }
    }
    PG8_WAIT_V(0);
    if constexpr (!ALIGN_EPI) { if (wr == 0) PG8_BAR; }
    PG8_BAR;
    if constexpr (Epi::AFTER_DRAIN) { E.fused(acc, cur, wr, wc, fr, fq, lds, wid, lane); S.done(cur); }
#undef PG8_SA
#undef PG8_SB
#undef PG8_STAGE
#undef PG8_LDA
#undef PG8_LDB
#undef PG8_MMA
#undef PG8_WAIT_V
#undef PG8_WAIT_L
#undef PG8_BAR
#undef PG8_SCHED
}
}
#define XB_TMO      128
#define XB_XCNT(j)  (256  + 64 * (j))
#define XB_XSUB(j)  (1280 + 64 * (j))
#define XB_XGEN(j)  (2304 + 64 * (j))
#define XB_TOP      3328
#define XB_TOPGEN   3392
#define XCD_BAR_WORDS 3456
#define XB_SPIN_CAP (1u << 18)

__device__ __forceinline__ unsigned xb_ld(unsigned* p)              { return __hip_atomic_load(p, __ATOMIC_RELAXED, __HIP_MEMORY_SCOPE_AGENT); }
__device__ __forceinline__ unsigned xb_add(unsigned* p, unsigned v) { return __hip_atomic_fetch_add(p, v, __ATOMIC_RELAXED, __HIP_MEMORY_SCOPE_AGENT); }
__device__ __forceinline__ unsigned xb_xcc_id() { return (unsigned)__builtin_amdgcn_s_getreg((3 << 11) | 20) & 0xFu; }
#define XB_SPIN(cond, bar) do { unsigned _sp = 0; while (cond) { __builtin_amdgcn_s_sleep(1); \
    if ((++_sp & 255u) == 0u) { if (xb_ld(&(bar)[XB_TMO])) break; if (_sp > XB_SPIN_CAP) { atomicAdd(&(bar)[XB_TMO], 1u); break; } } } } while (0)

struct XcdBarrier {
    unsigned* bar; unsigned x;
    volatile LAS unsigned* st;
};

__device__ __forceinline__ XcdBarrier xcd_barrier_post(unsigned* bar, volatile LAS unsigned* st) {
    XcdBarrier b; b.bar = bar; b.x = xb_xcc_id(); b.st = st;
    if (threadIdx.x == 0) (void)xb_add(&bar[XB_XCNT(b.x)], 1u);
    return b;
}
__device__ __forceinline__ void xcd_barrier_complete(unsigned* bar, unsigned x, unsigned& nloc, unsigned& nx) {
    const unsigned G = gridDim.x * gridDim.y * gridDim.z;
    unsigned sum, cnt, mine, sp = 0u;
    for (;;) {
        sum = 0u; cnt = 0u; mine = 0u;
#pragma unroll
        for (unsigned j = 0; j < 16; ++j) { const unsigned c = xb_ld(&bar[XB_XCNT(j)]); sum += c; cnt += (c > 0u) ? 1u : 0u; mine = (j == x) ? c : mine; }
        if (sum == G) break;
        __builtin_amdgcn_s_sleep(1);
        if ((++sp & 255u) == 0u) { if (xb_ld(&bar[XB_TMO])) break; if (sp > XB_SPIN_CAP) { atomicAdd(&bar[XB_TMO], 1u); break; } }
    }
    nloc = mine > 0u ? mine : 1u; nx = cnt > 0u ? cnt : 1u;
}

__device__ __forceinline__ void xcd_barrier(const XcdBarrier& b) {
    asm volatile("s_waitcnt vmcnt(0)" ::: "memory");
    __syncthreads();
    if (threadIdx.x == 0) {
        unsigned* bar = b.bar;
        __builtin_amdgcn_s_waitcnt(0);
        unsigned nloc = b.st[0], nx = b.st[1];
        if (nloc == 0u) { xcd_barrier_complete(bar, b.x, nloc, nx); b.st[0] = nloc; b.st[1] = nx; }
        const unsigned old = xb_add(&bar[XB_XSUB(b.x)], 1u);
        const unsigned gen = old / nloc;
        if (old + 1u == (gen + 1u) * nloc) {
            __builtin_amdgcn_fence(__ATOMIC_RELEASE, "agent");
            asm volatile("s_waitcnt vmcnt(0)" ::: "memory");
            const unsigned og = xb_add(&bar[XB_TOP], 1u);
            const unsigned tg = og / nx;
            if (og + 1u == (tg + 1u) * nx) xb_add(&bar[XB_TOPGEN], 1u);
            else XB_SPIN(xb_ld(&bar[XB_TOPGEN]) == tg, bar);
            __builtin_amdgcn_fence(__ATOMIC_ACQUIRE, "agent");
            xb_add(&bar[XB_XGEN(b.x)], 1u);
            asm volatile("s_waitcnt vmcnt(0)" ::: "memory");
        } else {
            XB_SPIN(xb_ld(&bar[XB_XGEN(b.x)]) == gen, bar);
            __builtin_amdgcn_fence(__ATOMIC_ACQUIRE, "agent");
            asm volatile("s_waitcnt vmcnt(0)" ::: "memory");
        }
    }
    __syncthreads();
}

struct Params {
    const float* in[33];
    float* out; unsigned char* ws;
    int ph_lo, ph_hi;
};
struct Frame {
    LAS unsigned char* lds;
    int blk, G, wv;
    float* out; unsigned char* ws;
};
constexpr int PTAB_OFF = LDSCTL_OFF + 1024;
__device__ __forceinline__ int lane_id() { int l; asm volatile("v_mbcnt_lo_u32_b32 %0, -1, 0\n\tv_mbcnt_hi_u32_b32 %0, -1, %0" : "=v"(l)); return l; }
__device__ __forceinline__ int mytid(const Frame& F) { int t = F.wv * 64 + lane_id(); asm volatile("" : "+v"(t)); return t; }
__device__ __forceinline__ const float* inptr(const Frame& F, int k) {
    volatile LAS unsigned* t = (volatile LAS unsigned*)(F.lds + PTAB_OFF) + 2 * k;
    const unsigned lo = __builtin_amdgcn_readfirstlane(t[0]), hi = __builtin_amdgcn_readfirstlane(t[1]);
    const GAS float* gp = (const GAS float*)(((unsigned long long)hi << 32) | (unsigned long long)lo);
    return (const float*)gp;
}
#define IN_X 0
#define IN_RELB 1
#define IN_MIXG 2
#define IN_WIN 3
#define IN_WOUT 4
#define IN_FFNG 5
#define IN_QG 6
#define IN_KG 7
#define IN_CW 8
#define IN_CB 9
#define IN_CLG 10
#define IN_CLB 11
#define IN_MU 12
#define IN_W0 13
#define IN_W2 14
#define IN_A0 15
#define IN_A2 16
#define IN_G2 17
#define IN_KK 18
#define IN_KA 19
#define IN_RK 20
#define IN_RLG 21
#define IN_RLB 22
#define IN_GG2 23
#define IN_GGB 24
#define IN_GNG 25
#define IN_FWG 26
#define IN_FWU 27
#define IN_FWD 28
#define IN_ROUTER 29
#define IN_MWG 30
#define IN_MWU 31
#define IN_MWD 32

__device__ __forceinline__ void p0_transpose_item(const float* W, int K, int N, int nblk, const float* gk, bf16* WT, int mode, LAS float* scr, int item, int lane) {
    const int kb = item / nblk, nb = item % nblk, k0 = 64 * kb, n0 = 64 * nb, kr = lane >> 4, n4 = (lane & 15) * 4;
    const bool valid = (n0 + n4) < N;
    f32x4 v[16];
#pragma unroll
    for (int i = 0; i < 16; ++i) v[i] = valid ? *(const f32x4*)(W + (size_t)(k0 + 4 * i + kr) * N + n0 + n4) : (f32x4){0.f, 0.f, 0.f, 0.f};
    if (gk) {
#pragma unroll
        for (int i = 0; i < 16; ++i) v[i] = v[i] * gk[k0 + 4 * i + kr]; }
    const int rowbase = (mode == 0) ? n0 : ((n0 >> 7) * 256 + (mode == 2 ? 128 : 0) + (n0 & 127));
    const int c = lane & 3;
#pragma unroll
    for (int half = 0; half < 2; ++half) {
#pragma unroll
        for (int i = 0; i < 8; ++i) { LAS float* d = scr + (4 * i + kr) * 65 + n4; const f32x4 x = v[half * 8 + i]; d[0] = x[0]; d[1] = x[1]; d[2] = x[2]; d[3] = x[3]; }
        LDS_WAIT(); asm volatile("" ::: "memory");
#pragma unroll
        for (int j = 0; j < 4; ++j) { const int nn = (lane >> 2) + 16 * j; const LAS float* s = scr + (8 * c) * 65 + nn;
            u32x4 o; o.x = pk2(s[0 * 65], s[1 * 65]); o.y = pk2(s[2 * 65], s[3 * 65]); o.z = pk2(s[4 * 65], s[5 * 65]); o.w = pk2(s[6 * 65], s[7 * 65]);
            *(u32x4*)(WT + (size_t)(rowbase + nn) * K + k0 + half * 32 + 8 * c) = o; }
        LDS_WAIT(); asm volatile("" ::: "memory"); }
}
__device__ __forceinline__ void p0_prologue(Frame& F, const int part) {
    const int tid = mytid(F), lane = tid & 63, wave = __builtin_amdgcn_readfirstlane(tid >> 6); (void)lane; (void)wave;
    LAS float* scr = (LAS float*)(F.lds + wave * 16384);
    const int gw = F.blk * NWAVES + wave, NGW = F.G * NWAVES;
    constexpr int I_IN = 16 * 48, I_OUT = 16 * 16, I_GU = 16 * 44, I_D = 44 * 16, I_SET = 2 * I_GU + I_D;
    constexpr int NITEMS = 2 * I_IN + 2 * I_OUT + 9 * I_SET;
    unsigned char* ws = F.ws;
    constexpr int NPART0 = 2 * I_IN + 2 * I_OUT + I_SET;
    for (int it = (part == 0 ? 0 : NPART0) + gw; it < (part == 0 ? NPART0 : NITEMS); it += NGW) {
        int r = it;
        if (r < 2 * I_IN) { const int l = r / I_IN; r -= l * I_IN;
            p0_transpose_item(inptr(F, IN_WIN) + (size_t)l * DM * INW, DM, INW, 48, inptr(F, IN_MIXG) + l * DM, (bf16*)(ws + WS_WIN) + (size_t)l * NPADW * DM, 0, scr, r, lane); continue; }
        r -= 2 * I_IN;
        if (r < 2 * I_OUT) { const int l = r / I_OUT; r -= l * I_OUT;
            p0_transpose_item(inptr(F, IN_WOUT) + (size_t)l * DM * DM, DM, DM, 16, nullptr, (bf16*)(ws + WS_WOUT) + (size_t)l * DM * DM, 0, scr, r, lane); continue; }
        r -= 2 * I_OUT;
        const int set = r / I_SET; r -= set * I_SET;
        const float* wg = set == 0 ? inptr(F, IN_FWG) : inptr(F, IN_MWG) + (size_t)(set - 1) * DM * DFF;
        const float* wu = set == 0 ? inptr(F, IN_FWU) : inptr(F, IN_MWU) + (size_t)(set - 1) * DM * DFF;
        const float* wd = set == 0 ? inptr(F, IN_FWD) : inptr(F, IN_MWD) + (size_t)(set - 1) * DFF * DM;
        const float* gk = inptr(F, IN_FFNG) + (set == 0 ? 0 : DM);
        bf16* dgu = set == 0 ? (bf16*)(ws + WS_WGU) : (bf16*)(ws + WS_MOEW + (size_t)(set - 1) * MOEW_E_BYTES);
        bf16* dd = set == 0 ? (bf16*)(ws + WS_WD) : (bf16*)(ws + WS_MOEW + (size_t)(set - 1) * MOEW_E_BYTES + MOEW_GU_BYTES);
        if (r < I_GU) { p0_transpose_item(wg, DM, DFF, 44, gk, dgu, 1, scr, r, lane); continue; } r -= I_GU;
        if (r < I_GU) { p0_transpose_item(wu, DM, DFF, 44, gk, dgu, 2, scr, r, lane); continue; } r -= I_GU;
        p0_transpose_item(wd, DFF, DM, 16, nullptr, dd, 0, scr, r, lane);
    }
    if (part != 0) return;
    const float* x = inptr(F, IN_X); bf16* hb = (bf16*)(ws + WS_HB); float* ssq = (float*)(ws + WS_SSQ);
    for (int m = gw; m < NTOK; m += NGW) {
        const f32x4* xr = (const f32x4*)(x + (size_t)m * DM) + lane; f32x4 v[4]; float s = 0.f;
#pragma unroll
        for (int j = 0; j < 4; ++j) { v[j] = xr[64 * j]; s += (v[j][0] * v[j][0] + v[j][1] * v[j][1]) + (v[j][2] * v[j][2] + v[j][3] * v[j][3]); }
        s = wave_sum(s);
        u32x2* o8 = (u32x2*)(hb + (size_t)m * DM) + lane;
#pragma unroll
        for (int j = 0; j < 4; ++j) { u32x2 w; w.x = pk2(v[j][0], v[j][1]); w.y = pk2(v[j][2], v[j][3]); o8[64 * j] = w; }
        if (lane < 16) ssq[(size_t)m * 16 + lane] = (lane == 0) ? s : 0.f;
    }
}

__device__ const unsigned char T5B[3][132] = {
 {0,1,2,3,4,5,6,7,8,9,10,11,12,13,14,15,16,16,16,16,16,16,17,17,17,17,17,17,17,17,18,18,18,18,18,18,18,18,18,18,19,19,19,19,19,19,19,19,19,19,19,19,19,19,20,20,20,20,20,20,20,20,20,20,20,20,20,20,20,20,20,20,20,21,21,21,21,21,21,21,21,21,21,21,21,21,21,21,21,21,21,21,21,21,21,21,21,21,21,22,22,22,22,22,22,22,22,22,22,22,22,22,22,22,22,22,22,22,22,22,22,22,22,22,22,22,22,22,22,0,0,0},
 {0,4,8,12,16,16,17,17,18,18,19,19,19,19,20,20,20,20,20,21,21,21,21,21,21,22,22,22,22,22,22,22,22,22,23,23,23,23,23,23,23,23,23,23,23,23,24,24,24,24,24,24,24,24,24,24,24,24,24,24,24,24,25,25,25,25,25,25,25,25,25,25,25,25,25,25,25,25,25,25,25,25,25,26,26,26,26,26,26,26,26,26,26,26,26,26,26,26,26,26,26,26,26,26,26,26,26,26,26,26,26,26,26,27,27,27,27,27,27,27,27,27,27,27,27,27,27,27,27,0,0,0},
 {0,16,18,19,20,21,21,22,22,23,23,23,24,24,24,24,25,25,25,25,25,26,26,26,26,26,26,26,26,27,27,27,27,27,27,27,27,27,27,28,28,28,28,28,28,28,28,28,28,28,28,28,29,29,29,29,29,29,29,29,29,29,29,29,29,29,29,29,29,29,30,30,30,30,30,30,30,30,30,30,30,30,30,30,30,30,30,30,30,30,30,30,30,30,30,31,31,31,31,31,31,31,31,31,31,31,31,31,31,31,31,31,31,31,31,31,31,31,31,31,31,31,31,31,31,31,31,31,31,0,0,0}};

__device__ __forceinline__ void attn_qknorm(Frame& F, bf16* Z, const float* qg, const float* kg) {
    const int tid = mytid(F); const int gt = F.blk * NTHREADS + tid, NGT = F.G * NTHREADS;
    for (int idx = gt; idx < NTOK * 64; idx += NGT) { const int tok = idx >> 6, seg = (idx >> 3) & 7, c8 = idx & 7;
        u32x4* ptr = (u32x4*)(Z + (size_t)tok * INW + (seg >> 2) * 256 + (seg & 3) * 64 + c8 * 8); const u32x4 p = *ptr; float f[8]; unpack8(p, f);
        float ss = 0.f;
#pragma unroll
        for (int e2 = 0; e2 < 8; ++e2) ss += f[e2] * f[e2];
        ss = red8(ss);
        const float rs = __builtin_amdgcn_rsqf(ss * (1.0f / 64.0f) + NORM_EPS) * (seg < 4 ? 0.125f : 1.0f); const float* gp = (seg < 4 ? qg : kg) + c8 * 8;
        u32x4 o; o.x = pk2(f[0] * rs * gp[0], f[1] * rs * gp[1]); o.y = pk2(f[2] * rs * gp[2], f[3] * rs * gp[3]); o.z = pk2(f[4] * rs * gp[4], f[5] * rs * gp[5]); o.w = pk2(f[6] * rs * gp[6], f[7] * rs * gp[7]);
        *ptr = o; }
}
typedef short v4i16 __attribute__((ext_vector_type(4)));
__device__ __forceinline__ void attn_tile(LAS unsigned char* lds, const bf16* Z, bf16* OP, float* LSE, const float* rel_bias, int tile, int tid) {
    const int lane = tid & 63, w = __builtin_amdgcn_readfirstlane(tid >> 6), fr = lane & 15, g = lane >> 4;
    const int br = tile >> 10, rem = tile & 1023, b = rem >> 7, h = (rem >> 5) & 3, sub = rem & 31;
    const int dsh = 2 * br, nbl = 32 >> dsh, r = sub >> (5 - dsh), n = sub & (nbl - 1);
    LAS unsigned char* Qs = lds;
    LAS unsigned char* Ks = lds + 16384;
    LAS unsigned char* Vs = lds + 49152;
    LAS float* BT = (LAS float*)(lds + 81920);
    const size_t zrow0 = (size_t)b * SEQ;
    if (tid < 129) BT[tid] = rel_bias[(int)T5B[br][tid] * 4 + h];
    { const int rl = lane >> 3, cp = lane & 7;
#pragma unroll
        for (int i = 0; i < 4; ++i) { const int R0 = (w * 4 + i) * 8, row = R0 + rl; int lk = 128 * (n - 1) + row; lk = lk < 0 ? 0 : lk;
            const bf16* zr = Z + (zrow0 + ((size_t)lk << dsh) + r) * INW + h * 64;
            __builtin_amdgcn_global_load_lds((const unsigned*)(zr + 256 + ((cp ^ (row & 7)) * 8)), (LAS unsigned*)(Ks + R0 * 128), 16, 0, 0);
            __builtin_amdgcn_global_load_lds((const unsigned*)(zr + 512 + ((2 * ((cp >> 1) ^ ((row >> 1) & 3)) + (cp & 1)) * 8)), (LAS unsigned*)(Vs + R0 * 128), 16, 0, 0); }
#pragma unroll
        for (int i = 0; i < 2; ++i) { const int R0 = (w * 2 + i) * 8, row = R0 + rl; const int lq = 128 * n + row;
            const bf16* zr = Z + (zrow0 + ((size_t)lq << dsh) + r) * INW + h * 64;
            __builtin_amdgcn_global_load_lds((const unsigned*)(zr + ((cp ^ (row & 7)) * 8)), (LAS unsigned*)(Qs + R0 * 128), 16, 0, 0); } }
    asm volatile("s_waitcnt vmcnt(0)" ::: "memory");
    BAR();
    bf16x8 qf[2];
#pragma unroll
    for (int ks = 0; ks < 2; ++ks) qf[ks] = *(const LAS bf16x8*)(Qs + (16 * w + fr) * 128 + (((ks * 4 + g) ^ (fr & 7)) << 4));
    f32x4 s[16];
#pragma unroll
    for (int kb = 0; kb < 16; ++kb) { s[kb] = (f32x4){0.f, 0.f, 0.f, 0.f};
#pragma unroll
        for (int ks = 0; ks < 2; ++ks) { const bf16x8 kf = *(const LAS bf16x8*)(Ks + (16 * kb + fr) * 128 + (((ks * 4 + g) ^ (fr & 7)) << 4));
            s[kb] = __builtin_amdgcn_mfma_f32_16x16x32_bf16(kf, qf[ks], s[kb], 0, 0, 0); } }
    const int q = 16 * w + fr; float mx = -3.0e38f;
#pragma unroll
    for (int kb = 0; kb < 16; ++kb)
#pragma unroll
        for (int rg = 0; rg < 4; ++rg) { const int key = 16 * kb + 4 * g + rg, delta = q + 128 - key; const bool valid = (delta >= 0) && (delta <= 128) && (n > 0 || key >= 128);
            const int di = delta < 0 ? 0 : (delta > 128 ? 128 : delta);
            const float v = valid ? s[kb][rg] + BT[di] : -3.0e38f; s[kb][rg] = v; mx = fmaxf(mx, v); }
    mx = fmaxf(mx, __shfl_xor(mx, 16)); mx = fmaxf(mx, __shfl_xor(mx, 32));
    float den = 0.f;
#pragma unroll
    for (int kb = 0; kb < 16; ++kb)
#pragma unroll
        for (int rg = 0; rg < 4; ++rg) { const float v = s[kb][rg]; const float p = (v > -1.0e38f) ? __expf(v - mx) : 0.f; s[kb][rg] = p; den += p; }
    den += __shfl_xor(den, 16); den += __shfl_xor(den, 32);
    f32x4 o[4];
#pragma unroll
    for (int eb = 0; eb < 4; ++eb) o[eb] = (f32x4){0.f, 0.f, 0.f, 0.f};
    const int trq = fr >> 2, trp = fr & 3;
#pragma unroll
    for (int s8 = 0; s8 < 8; ++s8) {
        u32x4 pw; pw.x = pk2(s[2 * s8][0], s[2 * s8][1]); pw.y = pk2(s[2 * s8][2], s[2 * s8][3]); pw.z = pk2(s[2 * s8 + 1][0], s[2 * s8 + 1][1]); pw.w = pk2(s[2 * s8 + 1][2], s[2 * s8 + 1][3]);
        const bf16x8 pb = __builtin_bit_cast(bf16x8, pw);
        const int rowA = 32 * s8 + 4 * g + trq, swz = (rowA >> 1) & 3;
#pragma unroll
        for (int eb = 0; eb < 4; ++eb) { const LAS unsigned char* vp = Vs + rowA * 128 + ((eb ^ swz) * 32) + 8 * trp;
            const v4i16 lo = __builtin_amdgcn_ds_read_tr16_b64_v4i16((LAS v4i16*)vp), hi = __builtin_amdgcn_ds_read_tr16_b64_v4i16((LAS v4i16*)(vp + 16 * 128));
            bf16x8 af; af[0] = lo[0]; af[1] = lo[1]; af[2] = lo[2]; af[3] = lo[3]; af[4] = hi[0]; af[5] = hi[1]; af[6] = hi[2]; af[7] = hi[3];
            o[eb] = __builtin_amdgcn_mfma_f32_16x16x32_bf16(af, pb, o[eb], 0, 0, 0); } }
    const float inv = 1.0f / den; const size_t tokq = zrow0 + ((size_t)(128 * n + q) << dsh) + r;
    bf16* op = OP + ((size_t)br * NTOK + tokq) * 256 + h * 64 + 4 * g;
#pragma unroll
    for (int eb = 0; eb < 4; ++eb) { u32x2 wv; wv.x = pk2(o[eb][0] * inv, o[eb][1] * inv); wv.y = pk2(o[eb][2] * inv, o[eb][3] * inv); *(u32x2*)(op + 16 * eb) = wv; }
    if (g == 0) LSE[((size_t)br * NTOK + tokq) * 4 + h] = mx + __logf(den);
    BAR();
}

__device__ __forceinline__ void attn_merge(Frame& F, const bf16* OP, const float* LSE, bf16* Y) {
    const int tid = mytid(F), lane = tid & 63, wave = __builtin_amdgcn_readfirstlane(tid >> 6); (void)lane; (void)wave;
    const int gt = F.blk * NTHREADS + tid, NGT = F.G * NTHREADS;
    for (int idx = gt; idx < NTOK * 32; idx += NGT) { const int tok = idx >> 5, c8 = idx & 31, h = c8 >> 3;
        const float l0 = LSE[((size_t)0 * NTOK + tok) * 4 + h], l1 = LSE[((size_t)1 * NTOK + tok) * 4 + h], l2 = LSE[((size_t)2 * NTOK + tok) * 4 + h];
        const float m = fmaxf(l0, fmaxf(l1, l2)); float w0 = __expf(l0 - m), w1 = __expf(l1 - m), w2 = __expf(l2 - m); const float inv = 1.0f / (w0 + w1 + w2); w0 *= inv; w1 *= inv; w2 *= inv;
        const u32x4 a = *(const u32x4*)(OP + ((size_t)0 * NTOK + tok) * 256 + c8 * 8), bq = *(const u32x4*)(OP + ((size_t)1 * NTOK + tok) * 256 + c8 * 8), c = *(const u32x4*)(OP + ((size_t)2 * NTOK + tok) * 256 + c8 * 8);
        float fa[8], fb[8], fc[8]; unpack8(a, fa); unpack8(bq, fb); unpack8(c, fc); float r[8];
#pragma unroll
        for (int e = 0; e < 8; ++e) r[e] = w0 * fa[e] + w1 * fb[e] + w2 * fc[e];
        u32x4 o; o.x = pk2(r[0], r[1]); o.y = pk2(r[2], r[3]); o.z = pk2(r[4], r[5]); o.w = pk2(r[6], r[7]);
        *(u32x4*)(Y + (size_t)tok * DM + c8 * 8) = o; }
}

__device__ __forceinline__ void conv_item(Frame& F, const bf16* Z, bf16* Y, const float* cw, const float* cb, const float* lg, const float* lb, int item) {
    const int tid = mytid(F), b = item >> 6, t0 = (item & 63) * 64;
    LAS float* HG = (LAS float*)F.lds;
    LAS float* WL = (LAS float*)(F.lds + 96256);
    for (int i = tid; i < 31 * 256; i += NTHREADS) WL[i] = cw[i];
    for (int p = tid; p < 94 * 32; p += NTHREADS) { const int row = p >> 5, c8 = p & 31, t = t0 - 30 + row; float hv[8];
        if (t >= 0) { const bf16* zr = Z + ((size_t)b * SEQ + t) * INW + ZB + c8 * 8; const u32x4 uu = *(const u32x4*)zr, gg = *(const u32x4*)(zr + 256); float fu[8], fg[8]; unpack8(uu, fu); unpack8(gg, fg);
#pragma unroll
            for (int e = 0; e < 8; ++e) hv[e] = fu[e] * sigmoidf_(fg[e]); }
        else {
#pragma unroll
            for (int e = 0; e < 8; ++e) hv[e] = 0.f; }
        LAS f32x4* d = (LAS f32x4*)(HG + row * 256 + c8 * 8); d[0] = (f32x4){hv[0], hv[1], hv[2], hv[3]}; d[1] = (f32x4){hv[4], hv[5], hv[6], hv[7]}; }
    BAR();
    const int tt = tid >> 3, cs = tid & 7;
    f32x4 acc[8];
#pragma unroll
    for (int i = 0; i < 8; ++i) acc[i] = *(const f32x4*)(cb + 4 * (cs + 8 * i));
    for (int j = 0; j < 31; ++j) {
#pragma unroll
        for (int i = 0; i < 8; ++i) { const int qd = cs + 8 * i; acc[i] += *(const LAS f32x4*)(HG + (tt + j) * 256 + 4 * qd) * *(const LAS f32x4*)(WL + j * 256 + 4 * qd); } }
    bf16* yr = Y + ((size_t)b * SEQ + t0 + tt) * DM + 256;
#pragma unroll
    for (int gi = 0; gi < 4; ++gi) {
        const f32x4 x0 = acc[2 * gi], x1 = acc[2 * gi + 1];
        float s = ((x0[0] + x0[1]) + (x0[2] + x0[3])) + ((x1[0] + x1[1]) + (x1[2] + x1[3])); s = red8(s);
        const float mean = s * (1.0f / 64.0f); const f32x4 d0 = x0 - mean, d1 = x1 - mean;
        float ss = ((d0[0] * d0[0] + d0[1] * d0[1]) + (d0[2] * d0[2] + d0[3] * d0[3])) + ((d1[0] * d1[0] + d1[1] * d1[1]) + (d1[2] * d1[2] + d1[3] * d1[3])); ss = red8(ss);
        const float rstd = __builtin_amdgcn_rsqf(ss * (1.0f / 64.0f) + 1e-5f);
#pragma unroll
        for (int k = 0; k < 2; ++k) { const int qd = cs + 8 * (2 * gi + k); const f32x4 dd = k ? d1 : d0; const f32x4 gv = *(const f32x4*)(lg + 4 * qd), bv = *(const f32x4*)(lb + 4 * qd); float y[4];
#pragma unroll
            for (int e = 0; e < 4; ++e) y[e] = siluf_(dd[e] * rstd * gv[e] + bv[e]);
            u32x2 wv; wv.x = pk2(y[0], y[1]); wv.y = pk2(y[2], y[3]); *(u32x2*)(yr + 4 * qd) = wv; } }
    BAR();
}

__device__ __forceinline__ bf16x8 ldfrag(const LAS unsigned char* base, int stride, int row0, int kb0, int fr, int g) {
    return *(const LAS bf16x8*)(base + (row0 + fr) * stride + kb0 + 16 * g);
}
#define MFMA16(a, b, c) __builtin_amdgcn_mfma_f32_16x16x32_bf16((a), (b), (c), 0, 0, 0)

constexpr int GL_G2 = 0, GL_Q = 2048, GL_K = 6144, GL_GK = 10240, GL_GD = 14336, GL_OG = 16384, GL_QT = 24576, GL_KB = 27136, GL_KHT = 29696, GL_VT = 32256, GL_ATT = 37376, GL_ST = 39936, GL_EC = 45056,
              GL_OB = 45184, GL_GB = 53376, GL_END = 53504;
struct GlaRaw { u32x4 p[2]; u32x4 s; };
__device__ __forceinline__ void gla_decode(int tid, int h, int it, int& tt, int& col, int& kind, int& off, bool& ok) {
    const int p = tid + 512 * it; ok = p < 832; tt = p / 26; const int qd = p % 26;
    if (qd < 4) { col = ZD + h * 32 + 8 * qd; kind = 0; off = tt * 32 + 8 * qd; }
    else if (qd < 8) { col = ZD + 128 + h * 32 + 8 * (qd - 4); kind = 1; off = tt * 32 + 8 * (qd - 4); }
    else if (qd < 16) { col = ZD + 256 + h * 64 + 8 * (qd - 8); kind = 2; off = 8 * (qd - 8); }
    else if (qd < 18) { col = ZD + 512 + 8 * (qd - 16); kind = 3; off = tt * 16 + 8 * (qd - 16); }
    else { col = ZD + 528 + h * 64 + 8 * (qd - 18); kind = 4; off = tt * 64 + 8 * (qd - 18); }
}
template <int STEP> __device__ __forceinline__ void gla_load(const bf16* Z, const unsigned char* sst, int b, int h, int ch, int tid, GlaRaw& r) {
#pragma unroll
    for (int it = 0; it < 2; ++it) { int tt, col, kind, off; bool ok; gla_decode(tid, h, it, tt, col, kind, off, ok);
        r.p[it] = ok ? *(const u32x4*)(Z + ((size_t)b * SEQ + ch * 32 + tt) * INW + col) : (u32x4){0u, 0u, 0u, 0u}; }
    if (STEP == 1) r.s = (tid < 256) ? *(const u32x4*)(sst + (size_t)((b * 4 + h) * (SEQ / 32) + ch) * 4096 + 16 * tid) : (u32x4){0u, 0u, 0u, 0u};
}
template <int STEP> __device__ __forceinline__ void gla_item(Frame& F, const GlaRaw& raw, unsigned char* con, float* ecg, bf16* Y, const float* ng, int b, int h, int ch) {
    const int tid = mytid(F), lane = tid & 63, w = __builtin_amdgcn_readfirstlane(tid >> 6), fr = lane & 15, g = lane >> 4;
    LAS unsigned char* L = F.lds;
    LAS float *G2 = (LAS float*)(L + GL_G2), *QF = (LAS float*)(L + GL_Q), *KF = (LAS float*)(L + GL_K), *GK = (LAS float*)(L + GL_GK), *GD = (LAS float*)(L + GL_GD), *OG = (LAS float*)(L + GL_OG),
              *OB = (LAS float*)(L + GL_OB), *GB = (LAS float*)(L + GL_GB);
    LAS unsigned char *QT = L + GL_QT, *KB = L + GL_KB, *KHT = L + GL_KHT, *VT = L + GL_VT, *ATT = L + GL_ATT, *ST = L + GL_ST;
    const size_t item = (size_t)((b * 4 + h) * (SEQ / 32) + ch);
#pragma unroll
    for (int it = 0; it < 2; ++it) { int tt, col, kind, off; bool ok; gla_decode(tid, h, it, tt, col, kind, off, ok);
        if (ok) { float f[8]; unpack8(raw.p[it], f);
            if (kind == 2) { LAS unsigned short* vp = (LAS unsigned short*)(VT + off * 80 + tt * 2); const u32x4 pr = raw.p[it];
                vp[0 * 40] = (unsigned short)(pr.x & 0xffffu); vp[1 * 40] = (unsigned short)(pr.x >> 16); vp[2 * 40] = (unsigned short)(pr.y & 0xffffu); vp[3 * 40] = (unsigned short)(pr.y >> 16);
                vp[4 * 40] = (unsigned short)(pr.z & 0xffffu); vp[5 * 40] = (unsigned short)(pr.z >> 16); vp[6 * 40] = (unsigned short)(pr.w & 0xffffu); vp[7 * 40] = (unsigned short)(pr.w >> 16); }
            else if (kind != 4 || STEP == 1) { LAS float* dst = (kind == 0 ? QF : kind == 1 ? KF : kind == 3 ? GD : OG) + off; const float sc = kind == 0 ? 0.17677669529663687f : 1.0f;
                ((LAS f32x4*)dst)[0] = (f32x4){f[0] * sc, f[1] * sc, f[2] * sc, f[3] * sc}; ((LAS f32x4*)dst)[1] = (f32x4){f[4] * sc, f[5] * sc, f[6] * sc, f[7] * sc}; } } }
    if (STEP == 1 && tid < 256) *(LAS u32x4*)(ST + (tid >> 2) * 80 + (tid & 3) * 16) = raw.s;
    BAR();
#pragma unroll
    for (int it = 0; it < 2; ++it) { const int o = tid + 512 * it, tt = o >> 5, kk = o & 31; float x = GB[kk];
#pragma unroll
        for (int j = 0; j < 16; ++j) x += GD[tt * 16 + j] * G2[j * 32 + kk];
        GK[tt * 32 + kk] = -softplusf_(-x) * (1.0f / 16.0f); }
    BAR();
    { const int t = tid >> 4, k2 = (tid & 15) * 2; float c0 = 0.f, c1 = 0.f, b0 = 0.f, b1 = 0.f;
#pragma unroll 8
        for (int s = 0; s < 32; ++s) { const f32x2 gk = *(const LAS f32x2*)(GK + s * 32 + k2); c0 += gk[0]; c1 += gk[1]; if (s == t) { b0 = c0; b1 = c1; } }
        const f32x2 q = *(const LAS f32x2*)(QF + t * 32 + k2), k = *(const LAS f32x2*)(KF + t * 32 + k2);
        if (STEP == 1) { *(LAS unsigned*)(QT + t * 80 + k2 * 2) = pk2(q[0] * __expf(b0), q[1] * __expf(b1)); *(LAS unsigned*)(KB + t * 80 + k2 * 2) = pk2(k[0] * __expf(-b0), k[1] * __expf(-b1)); }
        else { *(LAS unsigned short*)(KHT + k2 * 80 + t * 2) = (unsigned short)f2bf(k[0] * __expf(c0 - b0)); *(LAS unsigned short*)(KHT + (k2 + 1) * 80 + t * 2) = (unsigned short)f2bf(k[1] * __expf(c1 - b1));
            if (t == 0) { ecg[item * 32 + k2] = __expf(c0); ecg[item * 32 + k2 + 1] = __expf(c1); } } }
    BAR();
    if (STEP == 0) {
        const int kb = w >> 2, vb = w & 3; f32x4 d = (f32x4){0.f, 0.f, 0.f, 0.f};
        d = MFMA16(ldfrag(KHT, 80, 16 * kb, 0, fr, g), ldfrag(VT, 80, 16 * vb, 0, fr, g), d);
        u32x2 so; so.x = pk2(d[0], d[1]); so.y = pk2(d[2], d[3]); *(u32x2*)(con + item * 4096 + (16 * vb + fr) * 64 + (16 * kb + 4 * g) * 2) = so;
        BAR();
    } else {
        if (w < 3) { const int atb = w == 0 ? 0 : 1, asb = w == 2 ? 1 : 0;
            f32x4 d = (f32x4){0.f, 0.f, 0.f, 0.f}; d = MFMA16(ldfrag(KB, 80, 16 * asb, 0, fr, g), ldfrag(QT, 80, 16 * atb, 0, fr, g), d);
            const int t = 16 * atb + fr; float v[4];
#pragma unroll
            for (int r = 0; r < 4; ++r) { const int s = 16 * asb + 4 * g + r; v[r] = (s <= t) ? d[r] : 0.f; }
            u32x2 o; o.x = pk2(v[0], v[1]); o.y = pk2(v[2], v[3]); *(LAS u32x2*)(ATT + t * 80 + (16 * asb + 4 * g) * 2) = o; }
        else if (w == 3) { *(LAS u32x2*)(ATT + fr * 80 + (16 + 4 * g) * 2) = (u32x2){0u, 0u}; }
        BAR();
        { const int tb = w >> 2, vb = w & 3; f32x4 o = (f32x4){0.f, 0.f, 0.f, 0.f};
            o = MFMA16(ldfrag(ATT, 80, 16 * tb, 0, fr, g), ldfrag(VT, 80, 16 * vb, 0, fr, g), o);
            o = MFMA16(ldfrag(QT, 80, 16 * tb, 0, fr, g), ldfrag(ST, 80, 16 * vb, 0, fr, g), o);
#pragma unroll
            for (int r = 0; r < 4; ++r) OB[(16 * tb + 4 * g + r) * 64 + 16 * vb + fr] = o[r]; }
        BAR();
        { const int tt = tid >> 4, v4 = (tid & 15) * 4; const f32x4 o = *(const LAS f32x4*)(OB + tt * 64 + v4);
            float ss = (o[0] * o[0] + o[1] * o[1]) + (o[2] * o[2] + o[3] * o[3]); ss = red16(ss);
            const float rs = __builtin_amdgcn_rsqf(ss * (1.0f / 64.0f) + NORM_EPS); const f32x4 gv = *(const f32x4*)(ng + v4), og = *(const LAS f32x4*)(OG + tt * 64 + v4); float y[4];
#pragma unroll
            for (int e = 0; e < 4; ++e) y[e] = o[e] * rs * gv[e] * og[e] * __builtin_amdgcn_rcpf(1.0f + __expf(-og[e]));
            u32x2 wv; wv.x = pk2(y[0], y[1]); wv.y = pk2(y[2], y[3]); *(u32x2*)(Y + ((size_t)b * SEQ + ch * 32 + tt) * DM + 768 + h * 64 + v4) = wv; }
        BAR();
    }
}
template <int STEP> __device__ __forceinline__ void gla_items(Frame& F, const bf16* Z, unsigned char* con, float* ecg, bf16* Y, const float* g2, const float* gb, const float* ng, int wi, int nw) {
    const int tid = mytid(F);
#pragma unroll 1
    for (int h = 0; h < 4; ++h) {
        ((LAS float*)(F.lds + GL_G2))[tid] = g2[(tid >> 5) * 128 + h * 32 + (tid & 31)]; if (tid < 32) ((LAS float*)(F.lds + GL_GB))[tid] = gb[h * 32 + tid];
        BAR();
        GlaRaw cur, nxt; cur.p[0] = (u32x4){0u, 0u, 0u, 0u}; cur.p[1] = cur.p[0]; cur.s = cur.p[0]; nxt = cur;
        if (wi < 1024) gla_load<STEP>(Z, con, wi >> 7, h, wi & 127, tid, cur);
#pragma unroll 1
        for (int it = wi; it < 1024; it += nw) { const int nx = it + nw;
            if (nx < 1024) gla_load<STEP>(Z, con, nx >> 7, h, nx & 127, tid, nxt);
            gla_item<STEP>(F, cur, con, ecg, Y, ng, it >> 7, h, it & 127);
            cur = nxt; }
        BAR(); }
}
__device__ __forceinline__ void gla_scan(Frame& F, unsigned char* con, const float* ecg, int b, int h) {
    const int tid = mytid(F); const int k4 = (tid & 7) * 4;
    unsigned char* base = con + (size_t)((b * 4 + h) * (SEQ / 32)) * 4096 + 8 * tid; const float* eb = ecg + (size_t)((b * 4 + h) * (SEQ / 32)) * 32 + k4;
    float s[4] = {0.f, 0.f, 0.f, 0.f};
    u32x2 cn[4]; f32x4 ec[4];
#pragma unroll
    for (int j = 0; j < 4; ++j) { cn[j] = *(const u32x2*)(base + (size_t)j * 4096); ec[j] = *(const f32x4*)(eb + j * 32); }
#pragma unroll 1
    for (int c0 = 0; c0 < SEQ / 32; c0 += 4) {
        u32x2 cc[4]; f32x4 ee[4];
#pragma unroll
        for (int j = 0; j < 4; ++j) { cc[j] = cn[j]; ee[j] = ec[j]; }
        if (c0 + 4 < SEQ / 32) {
#pragma unroll
            for (int j = 0; j < 4; ++j) { cn[j] = *(const u32x2*)(base + (size_t)(c0 + 4 + j) * 4096); ec[j] = *(const f32x4*)(eb + (c0 + 4 + j) * 32); } }
#pragma unroll
        for (int j = 0; j < 4; ++j) { u32x2 o; o.x = pk2(s[0], s[1]); o.y = pk2(s[2], s[3]); *(u32x2*)(base + (size_t)(c0 + j) * 4096) = o;
            s[0] = ee[j][0] * s[0] + bflo(cc[j].x); s[1] = ee[j][1] * s[1] + bfhi(cc[j].x); s[2] = ee[j][2] * s[2] + bflo(cc[j].y); s[3] = ee[j][3] * s[3] + bfhi(cc[j].y); } }
}

struct RwkvP { const float *mu, *w0, *w2, *a0, *a2, *g2, *kk, *ka, *rk, *lg, *lb; };
constexpr int RC_AT = 0  , RC_RT = 2048  , RC_ZT = 4096, RC_RBK = 5120, RC_BKT = 6144  , RC_VT4 = 10240  ,
              RC_GC = 12288  , RC_G = 12544  , RC_BON = 14592  , RC_BYTES = 14656, RC_STRIDE = 14848;
constexpr int RC_CHUNKS16 = RC_BYTES / 16;
static_assert((size_t)NB * 4 * (SEQ / 16) * RC_STRIDE <= NEXP * MOEW_E_BYTES, "RWKV records overlay the (not yet converted) MoE weight region");
constexpr int RW_W2T = 0, RW_A2T = 5120, RW_G2T = 10240, RW_MU = 19456  , RW_TW = 23040, RW_AD = 24320, RW_SG = 25600, RW_R = 27904, RW_K = 32000, RW_V = 36096, RW_WL = 40192, RW_AL = 44288,
              RW_G = 48384, RW_KK = 52480, RW_KP = 56576, RW_BON = 60672, RW_GC = 60736, RW_AR = 60992, RW_BK = 65600, RW_BKT = 70208, RW_ZAK = 75328, RW_RBK = 76608, RW_AAB = 77888, RW_TT = 78912  , RW_PAR = 80192  , RW_END = 81472;

__device__ __forceinline__ void rwkv_prep_init(Frame& F, const RwkvP P, int h) {
    const int tid = mytid(F); LAS unsigned char* L = F.lds;
    for (int i = tid; i < 64 * 32; i += NTHREADS) { const int c = i >> 5, j = i & 31;
        *(LAS unsigned short*)(L + RW_W2T + c * 80 + j * 2) = (unsigned short)f2bf(P.w2[j * 256 + h * 64 + c]); *(LAS unsigned short*)(L + RW_A2T + c * 80 + j * 2) = (unsigned short)f2bf(P.a2[j * 256 + h * 64 + c]); }
    for (int i = tid; i < 64 * 64; i += NTHREADS) { const int c = i >> 6, j = i & 63; *(LAS unsigned short*)(L + RW_G2T + c * 144 + j * 2) = (unsigned short)f2bf(P.g2[j * 256 + h * 64 + c]); }
    for (int i = tid; i < 896; i += NTHREADS) ((LAS float*)(L + RW_MU))[i] = P.mu[i];
    if (tid < 320) { const int q = tid >> 6, c = tid & 63; const float* src = q == 0 ? P.w0 : q == 1 ? P.a0 : q == 2 ? P.kk : q == 3 ? P.ka : P.rk; ((LAS float*)(L + RW_PAR))[tid] = src[h * 64 + c]; }
}
__device__ __forceinline__ void rwkv_prep_load(const bf16* Z, int b, int h, int ch, int w, int lane, u32x4 (&cur)[2], u32x4 (&prv)[2]) {
    const int kind = w & 3, p = (w >> 2) * 64 + lane, tt = p >> 3, j = p & 7;
    const int col = (kind < 3 ? ZC + kind * 256 + h * 64 : ZC + 832) + 8 * j;
    const int t = ch * 16 + tt; const bf16* zr = Z + ((size_t)b * SEQ + t) * INW + col;
    cur[0] = *(const u32x4*)zr; prv[0] = (t > 0) ? *(const u32x4*)(zr - INW) : (u32x4){0u, 0u, 0u, 0u};
    if (w < 2) { const int t2 = ch * 16 + (lane >> 2); const bf16* z2 = Z + ((size_t)b * SEQ + t2) * INW + ZC + 768 + w * 32 + 8 * (lane & 3);
        cur[1] = *(const u32x4*)z2; prv[1] = (t2 > 0) ? *(const u32x4*)(z2 - INW) : (u32x4){0u, 0u, 0u, 0u}; }
    else { cur[1] = (u32x4){0u, 0u, 0u, 0u}; prv[1] = cur[1]; }
}
__device__ __forceinline__ void rwkv_prep_item(Frame& F, unsigned char* rec, const RwkvP P, int h, const u32x4 (&cur)[2], const u32x4 (&prv)[2]) {
    const int tid = mytid(F), lane = tid & 63, w = __builtin_amdgcn_readfirstlane(tid >> 6), fr = lane & 15, g = lane >> 4;
    LAS unsigned char* L = F.lds;
#if defined(PROBE_PI)
    unsigned long long tl_ = __builtin_amdgcn_s_memrealtime(), ta_ = 0;
#define PIT(k) do { const unsigned long long tn_ = __builtin_amdgcn_s_memrealtime(); if ((k) == PROBE_PI) ta_ += tn_ - tl_; tl_ = tn_; } while (0)
#else
#define PIT(k) do { } while (0)
#endif
    LAS float *R = (LAS float*)(L + RW_R), *KR = (LAS float*)(L + RW_K), *V = (LAS float*)(L + RW_V), *WL = (LAS float*)(L + RW_WL), *AL = (LAS float*)(L + RW_AL), *G = (LAS float*)(L + RW_G),
              *KK = (LAS float*)(L + RW_KK), *KP = (LAS float*)(L + RW_KP), *BON = (LAS float*)(L + RW_BON), *GC = (LAS float*)(L + RW_GC), *AAB = (LAS float*)(L + RW_AAB), *MU = (LAS float*)(L + RW_MU);
    { const int kind = w & 3, p = (w >> 2) * 64 + lane, tt = p >> 3, j = p & 7; float fc[8], fp[8], x[8]; unpack8(cur[0], fc); unpack8(prv[0], fp);
        const LAS float* mu = MU + (kind < 3 ? kind * 256 + h * 64 : 832) + 8 * j;
#pragma unroll
        for (int e = 0; e < 8; ++e) x[e] = fc[e] + (fp[e] - fc[e]) * mu[e];
        if (kind < 3) { LAS f32x4* d = (LAS f32x4*)((kind == 0 ? R : kind == 1 ? KR : V) + tt * 64 + 8 * j); d[0] = (f32x4){x[0], x[1], x[2], x[3]}; d[1] = (f32x4){x[4], x[5], x[6], x[7]}; }
        else {
#pragma unroll
            for (int e = 0; e < 8; ++e) x[e] = __builtin_amdgcn_rcpf(1.0f + __expf(-x[e]));
            u32x4 o; o.x = pk2(x[0], x[1]); o.y = pk2(x[2], x[3]); o.z = pk2(x[4], x[5]); o.w = pk2(x[6], x[7]); *(LAS u32x4*)(L + RW_SG + tt * 144 + 16 * j) = o; }
        if (w < 2) { const int t2 = lane >> 2, j2 = lane & 3; unpack8(cur[1], fc); unpack8(prv[1], fp); const LAS float* mu2 = MU + 768 + w * 32 + 8 * j2;
#pragma unroll
            for (int e = 0; e < 8; ++e) { x[e] = fc[e] + (fp[e] - fc[e]) * mu2[e]; if (w == 0) x[e] = 2.0f * __builtin_amdgcn_rcpf(1.0f + __expf(-2.0f * x[e])) - 1.0f; }
            u32x4 o; o.x = pk2(x[0], x[1]); o.y = pk2(x[2], x[3]); o.z = pk2(x[4], x[5]); o.w = pk2(x[6], x[7]); *(LAS u32x4*)(L + (w == 0 ? RW_TW : RW_AD) + t2 * 80 + 16 * j2) = o; } }
    BAR(); PIT(0);
    if (w < 4) { f32x4 dw = (f32x4){0.f, 0.f, 0.f, 0.f}, da = dw;
        dw = MFMA16(ldfrag(L + RW_W2T, 80, 16 * w, 0, fr, g), ldfrag(L + RW_TW, 80, 0, 0, fr, g), dw);
        da = MFMA16(ldfrag(L + RW_A2T, 80, 16 * w, 0, fr, g), ldfrag(L + RW_AD, 80, 0, 0, fr, g), da);
        *(LAS f32x4*)(WL + fr * 64 + 16 * w + 4 * g) = dw; *(LAS f32x4*)(AL + fr * 64 + 16 * w + 4 * g) = da; }
    else { const int cb = w - 4; f32x4 dg = (f32x4){0.f, 0.f, 0.f, 0.f};
        dg = MFMA16(ldfrag(L + RW_G2T, 144, 16 * cb, 0, fr, g), ldfrag(L + RW_SG, 144, 0, 0, fr, g), dg);
        dg = MFMA16(ldfrag(L + RW_G2T, 144, 16 * cb, 64, fr, g), ldfrag(L + RW_SG, 144, 0, 64, fr, g), dg);
        *(LAS f32x4*)(G + fr * 64 + 16 * cb + 4 * g) = dg; }
    BAR(); PIT(1);
    { const int t = tid >> 5, c2 = (tid & 31) * 2; const LAS float* PAR = (const LAS float*)(L + RW_PAR) + c2;
        const f32x2 wl = *(const LAS f32x2*)(WL + t * 64 + c2) + *(const LAS f32x2*)(PAR), al = *(const LAS f32x2*)(AL + t * 64 + c2) + *(const LAS f32x2*)(PAR + 64);
        const f32x2 kr = *(const LAS f32x2*)(KR + t * 64 + c2), rr = *(const LAS f32x2*)(R + t * 64 + c2);
        const f32x2 kkw = *(const LAS f32x2*)(PAR + 128), kaw = *(const LAS f32x2*)(PAR + 192), rkw = *(const LAS f32x2*)(PAR + 256);
        f32x2 lw, a, kk, kp; float ss = 0.f, bon = 0.f;
#pragma unroll
        for (int e = 0; e < 2; ++e) { const float wlog = -softplusf_(-wl[e]) - 0.5f; lw[e] = -__expf(wlog); a[e] = __builtin_amdgcn_rcpf(1.0f + __expf(-al[e])); kk[e] = kr[e] * kkw[e]; ss += kk[e] * kk[e];
            kp[e] = kr[e] * (1.0f + (a[e] - 1.0f) * kaw[e]); bon += rr[e] * kp[e] * rkw[e]; }
        ss = red16(ss); bon = red16(bon); ss += __shfl_xor(ss, 16); bon += __shfl_xor(bon, 16);
        const float inv = 1.0f / fmaxf(sqrtf(ss), 1e-12f); kk = kk * inv;
        *(LAS f32x2*)(WL + t * 64 + c2) = lw; *(LAS f32x2*)(AL + t * 64 + c2) = a; *(LAS f32x2*)(KK + t * 64 + c2) = kk; *(LAS f32x2*)(KP + t * 64 + c2) = kp;
        if ((tid & 31) == 0) BON[t] = bon; }
    BAR(); PIT(2);
    { const int t = tid >> 5, c2 = (tid & 31) * 2;
        f32x2 cs = (f32x2){0.f, 0.f}, ct = cs;
#pragma unroll
        for (int s = 0; s < 16; ++s) { cs += *(const LAS f32x2*)(WL + s * 64 + c2); if (s == t) ct = cs; }
        const f32x2 lwt = *(const LAS f32x2*)(WL + t * 64 + c2), a = *(const LAS f32x2*)(AL + t * 64 + c2), kk = *(const LAS f32x2*)(KK + t * 64 + c2), kp = *(const LAS f32x2*)(KP + t * 64 + c2), rr = *(const LAS f32x2*)(R + t * 64 + c2);
        float at[2], rt[2], bb[2], kb[2], bh[2], kh[2];
#pragma unroll
        for (int e = 0; e < 2; ++e) { const float eP = __expf(ct[e] - lwt[e]), eT = __expf(ct[e]), eI = __expf(-ct[e]), eC = __expf(cs[e] - ct[e]); const float bv = kk[e] * a[e];
            at[e] = -kk[e] * eP; rt[e] = rr[e] * eT; bb[e] = bv * eI; kb[e] = kp[e] * eI; bh[e] = bv * eC; kh[e] = kp[e] * eC; }
        *(LAS unsigned*)(L + RW_AR + t * 144 + c2 * 2) = pk2(at[0], at[1]); *(LAS unsigned*)(L + RW_AR + (16 + t) * 144 + c2 * 2) = pk2(rt[0], rt[1]);
        *(LAS unsigned*)(L + RW_BK + t * 144 + c2 * 2) = pk2(bb[0], bb[1]); *(LAS unsigned*)(L + RW_BK + (16 + t) * 144 + c2 * 2) = pk2(kb[0], kb[1]);
#pragma unroll
        for (int e = 0; e < 2; ++e) { *(LAS unsigned short*)(L + RW_BKT + (c2 + e) * 80 + t * 2) = (unsigned short)f2bf(bh[e]); *(LAS unsigned short*)(L + RW_BKT + (c2 + e) * 80 + (16 + t) * 2) = (unsigned short)f2bf(kh[e]); }
        if (t == 0) { GC[c2] = __expf(cs[0]); GC[c2 + 1] = __expf(cs[1]); } }
    BAR(); PIT(3);
    if (w < 4) { const int arow = (w & 1) ? 16 : 0  , brow = (w & 2) ? 16 : 0  ;
        f32x4 d = (f32x4){0.f, 0.f, 0.f, 0.f};
        d = MFMA16(ldfrag(L + RW_BK, 144, arow, 0, fr, g), ldfrag(L + RW_AR, 144, brow, 0, fr, g), d);
        d = MFMA16(ldfrag(L + RW_BK, 144, arow, 64, fr, g), ldfrag(L + RW_AR, 144, brow, 64, fr, g), d);
        const int t = fr; float v[4];
#pragma unroll
        for (int r = 0; r < 4; ++r) { const int s = 4 * g + r; const bool keep = (w < 2) ? (s < t) : (s <= t); v[r] = keep ? d[r] : 0.f; }
        if (w == 0) { AAB[(4 * g + 0) * 16 + t] = v[0]; AAB[(4 * g + 1) * 16 + t] = v[1]; AAB[(4 * g + 2) * 16 + t] = v[2]; AAB[(4 * g + 3) * 16 + t] = v[3]; }
        else { u32x2 o; o.x = pk2(v[0], v[1]); o.y = pk2(v[2], v[3]);
            LAS unsigned char* dst = (w == 1) ? (L + RW_ZAK + t * 80 + (16 + 4 * g) * 2) : (w == 2) ? (L + RW_RBK + t * 80 + (4 * g) * 2) : (L + RW_RBK + t * 80 + (16 + 4 * g) * 2);
            *(LAS u32x2*)dst = o; } }
    BAR(); PIT(4);
    if (w == 7) { if (lane < 16) { float col[16];
#pragma unroll
            for (int t = 0; t < 16; ++t) col[t] = (t == lane) ? 1.0f : 0.f;
#pragma unroll
            for (int s = 0; s < 15; ++s) { const f32x4 a0 = *(const LAS f32x4*)(AAB + s * 16), a1 = *(const LAS f32x4*)(AAB + s * 16 + 4), a2 = *(const LAS f32x4*)(AAB + s * 16 + 8), a3 = *(const LAS f32x4*)(AAB + s * 16 + 12);
                const float as[16] = {a0[0], a0[1], a0[2], a0[3], a1[0], a1[1], a1[2], a1[3], a2[0], a2[1], a2[2], a2[3], a3[0], a3[1], a3[2], a3[3]};
#pragma unroll
                for (int t = s + 1; t < 16; ++t) col[t] += as[t] * col[s]; }
#pragma unroll
            for (int t = 0; t < 16; ++t) *(LAS unsigned short*)(L + RW_TT + t * 80 + lane * 2) = (unsigned short)f2bf(col[t]); }
        LDS_WAIT();
        { const u32x2 lo = *(const LAS u32x2*)(L + RW_TT + fr * 80 + 8 * g), hi = *(const LAS u32x2*)(L + RW_ZAK + fr * 80 + 32 + 8 * g); u32x4 o; o.x = lo.x; o.y = lo.y; o.z = hi.x; o.w = hi.y;
            *(u32x4*)(rec + RC_ZT + fr * 64 + 16 * g) = o; } }
    else {
#pragma unroll 1
        for (int job = w; job < 16; job += 7) {
            if (job < 9) { int src, stride, row0, ka, kb2, dst;
                if (job < 4) { src = RW_AR; stride = 144; row0 = (job >> 1) * 16; ka = 32 * (job & 1); kb2 = ka + 16; dst = (job >> 1 ? RC_RT : RC_AT) + (job & 1) * 1024; }
                else if (job == 4) { src = RW_RBK; stride = 80; row0 = 0; ka = 0; kb2 = 16; dst = RC_RBK; }
                else { src = RW_BKT; stride = 80; row0 = 16 * (job - 5); ka = 0; kb2 = 16; dst = RC_BKT + (job - 5) * 1024; }
                const LAS unsigned char* rp = L + src + (row0 + fr) * stride + 8 * g; const u32x2 lo = *(const LAS u32x2*)(rp + ka * 2), hi = *(const LAS u32x2*)(rp + kb2 * 2);
                u32x4 o; o.x = lo.x; o.y = lo.y; o.z = hi.x; o.w = hi.y; *(u32x4*)(rec + dst + fr * 64 + 16 * g) = o; }
            else if (job < 13) { const int vb = job - 9; const LAS float* vp = V + (4 * g) * 64 + 16 * vb + fr; u32x2 o; o.x = pk2(vp[0], vp[64]); o.y = pk2(vp[128], vp[192]); *(u32x2*)(rec + RC_VT4 + vb * 512 + lane * 8) = o; }
            else { const int p = (job - 13) * 64 + lane;
                if (p < 16) *(f32x4*)(rec + RC_GC + 16 * p) = *(const LAS f32x4*)(GC + 4 * p);
                else if (p < 144) { const int q = p - 16; const f32x4 a = *(const LAS f32x4*)(G + q * 8), c = *(const LAS f32x4*)(G + q * 8 + 4); u32x4 o; o.x = pk2(a[0], a[1]); o.y = pk2(a[2], a[3]); o.z = pk2(c[0], c[1]); o.w = pk2(c[2], c[3]); *(u32x4*)(rec + RC_G + 16 * q) = o; }
                else if (p < 148) { const int q = p - 144; *(f32x4*)(rec + RC_BON + 16 * q) = *(const LAS f32x4*)(BON + 4 * q); } } } }
    BAR(); PIT(5);
#if defined(PROBE_PI)
    if (blockIdx.x == 0 && threadIdx.x == 0) ((unsigned long long*)(F.ws + 32768))[0] += ta_;
#endif
}

constexpr int SB_STRIDE = 16384, SB_NBUF = 7, SB_AHEAD = 5, ST_OB = SB_NBUF * SB_STRIDE  , ST_END = ST_OB + 8192;
static_assert(ST_END <= RING_BYTES && RC_BYTES <= SB_STRIDE, "state pass LDS");
__device__ __forceinline__ void rwkv_state(Frame& F, const unsigned char* recs, bf16* Y, const RwkvP P, int b, int h) {
    const int tid = mytid(F), lane = tid & 63, w = __builtin_amdgcn_readfirstlane(tid >> 6), fr = lane & 15, g = lane >> 4;
    LAS unsigned char* L = F.lds;
    const unsigned char* rbase = recs + (size_t)(b * 4 + h) * (SEQ / 16) * RC_STRIDE;
    const int lt = tid - 256;
    const f32x4 plg = *(const f32x4*)(P.lg + h * 64 + (tid & 15) * 4), plb = *(const f32x4*)(P.lb + h * 64 + (tid & 15) * 4);
    asm volatile("s_waitcnt vmcnt(0)" ::: "memory");
    f32x4 accS[4];
#pragma unroll
    for (int i = 0; i < 4; ++i) accS[i] = (f32x4){0.f, 0.f, 0.f, 0.f};
    constexpr int NCH = SEQ / 16;
#define RW_ISSUE(r) do { const unsigned char* gp_ = rbase + (size_t)(r) * RC_STRIDE + (w * 256 + lane) * 16; LAS unsigned char* lp_ = L + ((r) % SB_NBUF) * SB_STRIDE + w * 4096; \
        _Pragma("unroll") for (int i_ = 0; i_ < 4; ++i_) __builtin_amdgcn_global_load_lds((const unsigned*)(gp_ + i_ * 1024), (LAS unsigned*)(lp_ + i_ * 1024), 16, 0, 0); } while (0)
    if (w < 4) {
#pragma unroll 1
        for (int r = 0; r < SB_AHEAD; ++r) RW_ISSUE(r);
        asm volatile("s_waitcnt vmcnt(16)" ::: "memory"); }
    BAR();
#pragma unroll 1
    for (int c = 0; c <= NCH; ++c) {
        if (w >= 4) {
            if (c >= 1) { const int ce = c - 1; const LAS unsigned char* B = L + (ce % SB_NBUF) * SB_STRIDE; const LAS float* OB = (const LAS float*)(L + ST_OB + (ce & 1) * 4096);
                const int tt = lt >> 4, c4 = (lt & 15) * 4; const f32x4 o = *(const LAS f32x4*)(OB + tt * 64 + c4);
                float s = (o[0] + o[1]) + (o[2] + o[3]); s = red16(s); const float mean = s * (1.0f / 64.0f); const f32x4 d = o - mean;
                float ss = (d[0] * d[0] + d[1] * d[1]) + (d[2] * d[2] + d[3] * d[3]); ss = red16(ss); const float rstd = __builtin_amdgcn_rsqf(ss * (1.0f / 64.0f) + 64e-5f);
                const u32x2 gw = *(const LAS u32x2*)(B + RC_G + tt * 128 + c4 * 2); const float bon = ((const LAS float*)(B + RC_BON))[tt];
                const LAS unsigned short* vq = (const LAS unsigned short*)(B + RC_VT4 + (c4 >> 4) * 512 + ((tt >> 2) * 16 + (c4 & 15)) * 8 + (tt & 3) * 2);
                const float vv[4] = {bf1(vq[0]), bf1(vq[4]), bf1(vq[8]), bf1(vq[12])}, gg[4] = {bflo(gw.x), bfhi(gw.x), bflo(gw.y), bfhi(gw.y)}; float y[4];
#pragma unroll
                for (int e = 0; e < 4; ++e) y[e] = (d[e] * rstd * plg[e] + plb[e] + bon * vv[e]) * gg[e];
                u32x2 wv; wv.x = pk2(y[0], y[1]); wv.y = pk2(y[2], y[3]); *(u32x2*)(Y + ((size_t)b * SEQ + ce * 16 + tt) * DM + 512 + h * 64 + c4) = wv; }
        } else {
            if (c + SB_AHEAD < NCH) RW_ISSUE(c + SB_AHEAD);
            if (c < NCH) { const int vb = w; const LAS unsigned char* B = L + (c % SB_NBUF) * SB_STRIDE; LAS float* OB = (LAS float*)(L + ST_OB + (c & 1) * 4096); const int fo = fr * 64 + 16 * g;
                const bf16x8 at0 = *(const LAS bf16x8*)(B + RC_AT + fo), at1 = *(const LAS bf16x8*)(B + RC_AT + 1024 + fo), rt0 = *(const LAS bf16x8*)(B + RC_RT + fo), rt1 = *(const LAS bf16x8*)(B + RC_RT + 1024 + fo);
                const bf16x8 zt = *(const LAS bf16x8*)(B + RC_ZT + fo), rbk = *(const LAS bf16x8*)(B + RC_RBK + fo); const u32x2 v4 = *(const LAS u32x2*)(B + RC_VT4 + vb * 512 + lane * 8);
                u32x4 sw0, sw1; sw0.x = pk2(accS[0][0], accS[0][1]); sw0.y = pk2(accS[0][2], accS[0][3]); sw0.z = pk2(accS[1][0], accS[1][1]); sw0.w = pk2(accS[1][2], accS[1][3]);
                sw1.x = pk2(accS[2][0], accS[2][1]); sw1.y = pk2(accS[2][2], accS[2][3]); sw1.z = pk2(accS[3][0], accS[3][1]); sw1.w = pk2(accS[3][2], accS[3][3]);
                const bf16x8 s0 = __builtin_bit_cast(bf16x8, sw0), s1 = __builtin_bit_cast(bf16x8, sw1);
                f32x4 y = (f32x4){0.f, 0.f, 0.f, 0.f}, accO = y;
                y = MFMA16(at0, s0, y); y = MFMA16(at1, s1, y); accO = MFMA16(rt0, s0, accO); accO = MFMA16(rt1, s1, accO);
                u32x4 bw; bw.x = 0u; bw.y = 0u; bw.z = v4.x; bw.w = v4.y; y = MFMA16(zt, __builtin_bit_cast(bf16x8, bw), y);
                bw.x = pk2(y[0], y[1]); bw.y = pk2(y[2], y[3]); bw.z = 0u; bw.w = 0u; f32x4 u = (f32x4){0.f, 0.f, 0.f, 0.f}; u = MFMA16(zt, __builtin_bit_cast(bf16x8, bw), u);
                bw.x = pk2(u[0], u[1]); bw.y = pk2(u[2], u[3]); bw.z = v4.x; bw.w = v4.y; const bf16x8 uv = __builtin_bit_cast(bf16x8, bw);
                accO = MFMA16(rbk, uv, accO);
#pragma unroll
                for (int r = 0; r < 4; ++r) OB[(4 * g + r) * 64 + 16 * vb + fr] = accO[r];
#pragma unroll
                for (int kb = 0; kb < 4; ++kb) { const f32x4 gc = *(const LAS f32x4*)(B + RC_GC + (16 * kb + 4 * g) * 4); accS[kb] = accS[kb] * gc; accS[kb] = MFMA16(*(const LAS bf16x8*)(B + RC_BKT + kb * 1024 + fo), uv, accS[kb]); } }
            if (c + SB_AHEAD < NCH) asm volatile("s_waitcnt vmcnt(16)" ::: "memory"); else asm volatile("s_waitcnt vmcnt(0)" ::: "memory");
        }
        BAR();
    }
#undef RW_ISSUE
}

__device__ __forceinline__ void moe_route(Frame& F, const float* hres, const float* gffn, const float* router) {
    const int tid = mytid(F), lane = tid & 63, wave = __builtin_amdgcn_readfirstlane(tid >> 6); (void)lane; (void)wave;
    unsigned char* rt = F.ws + WS_RT;
    int* tope = (int*)(rt + RT_TOPE); float* gate = (float*)(rt + RT_GATE); int* rank = (int*)(rt + RT_RANK); float* rstd = (float*)(rt + RT_RSTD); int* hist = (int*)(rt + RT_HIST); int* rowtok = (int*)(rt + RT_ROWTOK);
    LAS float* RW = (LAS float*)F.lds;
    LAS int* LH = (LAS int*)(F.lds + 32768);
    for (int i = tid; i < 8192; i += NTHREADS) RW[i] = router[i];
    if (tid < 16) LH[tid] = 0;
    for (int i = F.blk * NTHREADS + tid; i < 2 * MOE_ROWS; i += F.G * NTHREADS) rowtok[i] = -1;
    __syncthreads();
    const int tpb = NTOK / F.G;
    for (int i = wave; i < tpb; i += NWAVES) { const int t = F.blk * tpb + i;
        const f32x4* hr = (const f32x4*)(hres + (size_t)t * DM) + lane; f32x4 v[4]; float ss = 0.f;
#pragma unroll
        for (int j = 0; j < 4; ++j) { v[j] = hr[64 * j]; ss += (v[j][0] * v[j][0] + v[j][1] * v[j][1]) + (v[j][2] * v[j][2] + v[j][3] * v[j][3]); }
        ss = wave_sum(ss); const float rs = __builtin_amdgcn_rsqf(ss * (1.0f / DM) + NORM_EPS);
        float lg[8];
#pragma unroll
        for (int e = 0; e < 8; ++e) lg[e] = 0.f;
#pragma unroll
        for (int j = 0; j < 4; ++j) { const f32x4 gv = *((const f32x4*)gffn + 64 * j + lane);
#pragma unroll
            for (int c = 0; c < 4; ++c) { const int k = 256 * j + 4 * lane + c; const float xn = v[j][c] * rs * gv[c]; const f32x4 r0 = *(const LAS f32x4*)(RW + k * 8), r1 = *(const LAS f32x4*)(RW + k * 8 + 4);
                lg[0] += xn * r0[0]; lg[1] += xn * r0[1]; lg[2] += xn * r0[2]; lg[3] += xn * r0[3]; lg[4] += xn * r1[0]; lg[5] += xn * r1[1]; lg[6] += xn * r1[2]; lg[7] += xn * r1[3]; } }
#pragma unroll
        for (int e = 0; e < 8; ++e) lg[e] = wave_sum(lg[e]);
        int i1 = 0; float m1 = lg[0];
#pragma unroll
        for (int e = 1; e < 8; ++e) if (lg[e] > m1) { m1 = lg[e]; i1 = e; }
        int i2 = -1; float m2 = -3.0e38f;
#pragma unroll
        for (int e = 0; e < 8; ++e) if (e != i1 && lg[e] > m2) { m2 = lg[e]; i2 = e; }
        if (lane == 0) { const float g1 = 1.0f / (1.0f + __expf(m2 - m1));
            const int r1 = atomicAdd((int*)&LH[i1], 1), r2 = atomicAdd((int*)&LH[8 + i2], 1);
            tope[2 * t] = i1; tope[2 * t + 1] = i2; gate[2 * t] = g1; gate[2 * t + 1] = 1.0f - g1; rank[2 * t] = r1; rank[2 * t + 1] = r2; rstd[t] = rs; }
    }
    __syncthreads();
    if (tid < 16) hist[F.blk * 16 + tid] = LH[tid];
}
__device__ __forceinline__ void moe_gather(Frame& F, int slot, const bf16* hb, bf16* asort) {
    const int tid = mytid(F), lane = tid & 63, wave = __builtin_amdgcn_readfirstlane(tid >> 6); (void)lane; (void)wave;
    unsigned char* rt = F.ws + WS_RT;
    const int* tope = (const int*)(rt + RT_TOPE); const float* gate = (const float*)(rt + RT_GATE); const int* rank = (const int*)(rt + RT_RANK); const float* rstd = (const float*)(rt + RT_RSTD); const int* hist = (const int*)(rt + RT_HIST);
    int* rowtok = (int*)(rt + RT_ROWTOK) + slot * MOE_ROWS; float* rowgate = (float*)(rt + RT_ROWGATE) + slot * MOE_ROWS; float* rowrstd = (float*)(rt + RT_ROWRSTD) + slot * MOE_ROWS;
    int* tilee = (int*)(rt + RT_TILEE) + slot * 256; int* ntiles = (int*)(rt + RT_NTILES);
    LAS int* BASE = (LAS int*)(F.lds + 40960);
    LAS int* TOT = BASE + 8;
    __syncthreads();
    LAS int* HL = (LAS int*)(F.lds + 49152);
    for (int i = tid; i < F.G * 8; i += NTHREADS) HL[i] = hist[(i >> 3) * 16 + slot * 8 + (i & 7)];
    __syncthreads();
    { const int e = tid & 7, part = tid >> 3;
        const int per = (F.G + 63) / 64; int sb = 0, st = 0;
        for (int j = 0; j < per; ++j) { const int bb = part * per + j; if (bb < F.G) { const int c = HL[bb * 8 + e]; st += c; if (bb < F.blk) sb += c; } }
        LAS int* PB = (LAS int*)(F.lds + 49152 + 16384); PB[tid] = sb; PB[512 + tid] = st; }
    __syncthreads();
    if (tid < 8) { const LAS int* PB = (const LAS int*)(F.lds + 49152 + 16384); int before = 0, tot = 0;
        for (int p = 0; p < 64; ++p) { before += PB[p * 8 + tid]; tot += PB[512 + p * 8 + tid]; }
        BASE[tid] = before; TOT[tid] = tot; }
    __syncthreads();
    if (tid == 0) { int ps = 0, nt = 0;
        for (int e = 0; e < 8; ++e) { const int tl = (TOT[e] + 255) >> 8; BASE[e] += ps; if (F.blk == 0) for (int i = 0; i < tl; ++i) tilee[nt + i] = e; ps += tl * 256; nt += tl; }
        if (F.blk == 0) ntiles[slot] = nt; }
    __syncthreads();
    const int tpb = NTOK / F.G;
    for (int i = wave; i < tpb; i += NWAVES) { const int t = F.blk * tpb + i; const int e = tope[2 * t + slot]; const int dest = BASE[e] + rank[2 * t + slot];
        if (lane == 0) { rowtok[dest] = t; rowgate[dest] = gate[2 * t + slot]; rowrstd[dest] = rstd[t]; }
        const u32x4* s = (const u32x4*)(hb + (size_t)t * DM) + lane; u32x4* d = (u32x4*)(asort + (size_t)dest * DM) + lane;
        const u32x4 a = s[0], c = s[64]; d[0] = a; d[64] = c; }
}

#ifndef MK_PER_PHASE
#define MK_PER_PHASE 0
#endif
constexpr int N_PHASES = 19;
__global__ void __launch_bounds__(NTHREADS, 2) mk_fwd(Params prm) {
    extern __shared__ __attribute__((aligned(16))) unsigned char lds_raw[];
    Frame F;
    F.lds = (LAS unsigned char*)lds_raw;
    F.blk = blockIdx.x; F.G = gridDim.x; F.out = prm.out; F.ws = prm.ws; F.wv = __builtin_amdgcn_readfirstlane(threadIdx.x >> 6);
    volatile LAS unsigned* MISC = (volatile LAS unsigned*)(F.lds + MISC_OFF);
    for (int u = threadIdx.x; u < (LDS_BYTES - LDSCTL_OFF) / 4; u += NTHREADS) ((LAS unsigned*)(F.lds + LDSCTL_OFF))[u] = 0u;
    __syncthreads();
    if (threadIdx.x == 0) { LAS unsigned long long* tab = (LAS unsigned long long*)(F.lds + PTAB_OFF);
#pragma unroll
        for (int i_ = 0; i_ < 33; ++i_) tab[i_] = (unsigned long long)prm.in[i_]; }
    __syncthreads();
    const int lo = prm.ph_lo, hi = prm.ph_hi;
    unsigned* ctl = (unsigned*)(F.ws + WS_CTL);
    XcdBarrier bar; bar.bar = ctl + CW_BAR; bar.x = 0; bar.st = nullptr;
    if (hi - lo > 1) bar = xcd_barrier_post(ctl + CW_BAR, MISC + 8);
    unsigned char* ws = F.ws;
    bf16* hb = (bf16*)(ws + WS_HB); bf16* z = (bf16*)(ws + WS_Z); bf16* act = (bf16*)(ws + WS_Z); bf16* y = (bf16*)(ws + WS_Y); bf16* asort = (bf16*)(ws + WS_Y);
    float* ssq = (float*)(ws + WS_SSQ); bf16* opart = (bf16*)(ws + WS_OP); float* lse = (float*)(ws + WS_LSE);
    unsigned char* rt = ws + WS_RT;
#define IN(k) (lo <= (k) && (k) < hi)
#ifndef PROBE_MASK
#define PROBE_MASK 0
#endif
#if PROBE_MASK
#define STAMP(k) do { if (blockIdx.x == 0 && threadIdx.x == 0) ((volatile LAS unsigned long long*)(F.lds + LDSCTL_OFF + 2048))[k] = __builtin_amdgcn_s_memrealtime(); } while (0)
#else
#define STAMP(k) do { } while (0)
#endif
#define SEAM(k) do { if (IN(k) && IN((k) + 1)) xcd_barrier(bar); STAMP((k) + 1); } while (0)

    STAMP(0);
    if (IN(0)) p0_prologue(F, 0);
    SEAM(0);
#pragma unroll 1
    for (int layer = 0; layer < 2; ++layer) {
        const int pb = layer == 0 ? 1 : 8;
        if (IN(pb)) {
            pg8::Gemm g{hb, (const bf16*)(ws + WS_WIN) + (size_t)layer * NPADW * DM, NTOK, NPADW, DM, F.wv}; pg8::StaticOrder S; S.init(NTOK / 256, NPADW / 256, F.G, F.blk);
            pg8::EpiZ E{z, INW, INW, ssq};
            pg8::gemm_phase<pg8::EpiZ, pg8::StaticOrder, true, true>(F.lds, g, S, E);
        }
        SEAM(pb);
#if defined(PROBE_SUB)
        const unsigned long long tsub0 = __builtin_amdgcn_s_memrealtime();
#define PSUB(cls, t0) do { if (threadIdx.x == 0) ((unsigned long long*)(F.ws + 32768))[layer * 4 + (cls)] = __builtin_amdgcn_s_memrealtime() - (t0); } while (0)
#else
#define PSUB(cls, t0) do { } while (0)
#endif
        unsigned char* recs = ws + WS_MOEW;
        unsigned char* gcon = ws + WS_MOEW + (size_t)NB * 4 * (SEQ / 16) * RC_STRIDE;
        if (IN(pb + 1)) {
            const int wi = F.blk, nw = F.G;
            { const RwkvP RP{inptr(F, IN_MU) + layer * 896, inptr(F, IN_W0) + layer * 256, inptr(F, IN_W2) + layer * 32 * 256, inptr(F, IN_A0) + layer * 256, inptr(F, IN_A2) + layer * 32 * 256, inptr(F, IN_G2) + layer * 64 * 256,
                             inptr(F, IN_KK) + layer * 256, inptr(F, IN_KA) + layer * 256, inptr(F, IN_RK) + layer * 256, inptr(F, IN_RLG) + layer * 256, inptr(F, IN_RLB) + layer * 256};
                const int tid_ = mytid(F), lane_ = tid_ & 63, w_ = __builtin_amdgcn_readfirstlane(tid_ >> 6);
#pragma unroll 1
                for (int h = 0; h < 4; ++h) {
                    rwkv_prep_init(F, RP, h); BAR();
                    u32x4 cur[2], prv[2], ncur[2], nprv[2];
#pragma unroll
                    for (int q = 0; q < 2; ++q) { cur[q] = (u32x4){0u, 0u, 0u, 0u}; prv[q] = cur[q]; ncur[q] = cur[q]; nprv[q] = cur[q]; }
                    if (wi < 2048) rwkv_prep_load(z, wi >> 8, h, wi & 255, w_, lane_, cur, prv);
#pragma unroll 1
                    for (int it = wi; it < 2048; it += nw) { const int nx = it + nw;
                        if (nx < 2048) rwkv_prep_load(z, nx >> 8, h, nx & 255, w_, lane_, ncur, nprv);
                        rwkv_prep_item(F, recs + (size_t)(((it >> 8) * 4 + h) * 256 + (it & 255)) * RC_STRIDE, RP, h, cur, prv);
#pragma unroll
                        for (int q = 0; q < 2; ++q) { cur[q] = ncur[q]; prv[q] = nprv[q]; } }
                    BAR(); } }
            attn_qknorm(F, z, inptr(F, IN_QG) + layer * 64, inptr(F, IN_KG) + layer * 64);
            gla_items<0>(F, z, gcon, (float*)(ws + WS_GLAEC), y, inptr(F, IN_GG2) + layer * 16 * 128, inptr(F, IN_GGB) + layer * 128, inptr(F, IN_GNG) + layer * 64, wi, nw);
        }
        SEAM(pb + 1);
        if (IN(pb + 2)) {
#if defined(PROBE_SUB)
            const unsigned long long tm2 = __builtin_amdgcn_s_memrealtime();
#endif
            if (F.blk < 32) {
                const RwkvP RP{inptr(F, IN_MU) + layer * 896, inptr(F, IN_W0) + layer * 256, inptr(F, IN_W2) + layer * 32 * 256, inptr(F, IN_A0) + layer * 256, inptr(F, IN_A2) + layer * 32 * 256, inptr(F, IN_G2) + layer * 64 * 256,
                               inptr(F, IN_KK) + layer * 256, inptr(F, IN_KA) + layer * 256, inptr(F, IN_RK) + layer * 256, inptr(F, IN_RLG) + layer * 256, inptr(F, IN_RLB) + layer * 256};
                rwkv_state(F, recs, y, RP, F.blk >> 2, F.blk & 3);
#if defined(PROBE_SUB)
                if (F.blk == 0) PSUB(1, tm2);
#endif
            } else {
                const int wi = F.blk - 32, nw = F.G - 32;
                if (F.blk < 64) { gla_scan(F, gcon, (const float*)(ws + WS_GLAEC), (F.blk - 32) >> 2, (F.blk - 32) & 3); BAR(); }
                { const int full = 3072 / nw, rem = 3072 - full * nw;
                    for (int rd = 0; rd < full; ++rd) attn_tile(F.lds, z, opart, lse, inptr(F, IN_RELB), rd * nw + wi, mytid(F));
                    if (wi >= 32 && wi - 32 < rem) attn_tile(F.lds, z, opart, lse, inptr(F, IN_RELB), full * nw + wi - 32, mytid(F)); }
                for (int item = wi; item < 512; item += nw) conv_item(F, z, y, inptr(F, IN_CW) + layer * 31 * 256, inptr(F, IN_CB) + layer * 256, inptr(F, IN_CLG) + layer * 256, inptr(F, IN_CLB) + layer * 256, item);
#if defined(PROBE_SUB)
                if (F.blk == 32) PSUB(2, tm2); if (F.blk == 64) PSUB(3, tm2);
#endif
            }
        }
        SEAM(pb + 2);
        if (IN(pb + 3)) {
            gla_items<1>(F, z, gcon, (float*)(ws + WS_GLAEC), y, inptr(F, IN_GG2) + layer * 16 * 128, inptr(F, IN_GGB) + layer * 128, inptr(F, IN_GNG) + layer * 64, F.blk, F.G);
            attn_merge(F, opart, lse, y);
        }
        SEAM(pb + 3);
        if (IN(pb + 4)) {
            pg8::Gemm g{y, (const bf16*)(ws + WS_WOUT) + (size_t)layer * DM * DM, NTOK, DM, DM, F.wv}; pg8::StaticOrder S; S.init(NTOK / 256, DM / 256, F.G, F.blk);
            pg8::EpiRes E{layer == 0 ? inptr(F, IN_X) : (const float*)F.out, F.out, hb, ssq};
            pg8::gemm_phase<pg8::EpiRes, pg8::StaticOrder, true, true>(F.lds, g, S, E);
        }
        SEAM(pb + 4);
        if (layer == 0) {
            if (IN(6)) {
                pg8::Gemm g{hb, (const bf16*)(ws + WS_WGU), NTOK, 2 * DFF, DM, F.wv}; pg8::StaticOrder S; S.init(NTOK / 256, 2 * DFF / 256, F.G, F.blk);
                pg8::EpiSwiGLU<false> E{act, ssq, nullptr};
                pg8::gemm_phase<pg8::EpiSwiGLU<false>, pg8::StaticOrder, true, true>(F.lds, g, S, E);
            }
            SEAM(6);
            if (IN(7)) {
                pg8::Gemm g{act, (const bf16*)(ws + WS_WD), NTOK, DM, DFF, F.wv}; pg8::StaticOrder S; S.init(NTOK / 256, DM / 256, F.G, F.blk);
                pg8::EpiRes E{F.out, F.out, hb, ssq};
                pg8::gemm_phase<pg8::EpiRes, pg8::StaticOrder, true, true>(F.lds, g, S, E);
            }
            SEAM(7);
        }
    }
    if (IN(13)) { moe_route(F, F.out, inptr(F, IN_FFNG) + DM, inptr(F, IN_ROUTER)); __syncthreads(); p0_prologue(F, 1); }
    SEAM(13);
    if (IN(14)) moe_gather(F, 0, hb, asort);
    SEAM(14);
#pragma unroll 1
    for (int slot = 0; slot < 2; ++slot) {
        const int pg = 15 + 2 * slot;
        const int* tilee = (const int*)(rt + RT_TILEE) + slot * 256;
        if (IN(pg)) {
            const int nt = __builtin_amdgcn_readfirstlane(((const int*)(rt + RT_NTILES))[slot]);
            pg8::Gemm g{asort, (const bf16*)(ws + WS_MOEW), nt * 256, 2 * DFF, DM, F.wv}; pg8::StaticOrder S; S.init(nt, 2 * DFF / 256, F.G, F.blk, tilee, MOEW_E_BYTES);
            pg8::EpiSwiGLU<true> E{act, nullptr, (const float*)(rt + RT_ROWRSTD) + slot * MOE_ROWS};
            pg8::gemm_phase<pg8::EpiSwiGLU<true>, pg8::StaticOrder, true, true>(F.lds, g, S, E);
        }
        SEAM(pg);
        if (IN(pg + 1)) {
            const int nt = __builtin_amdgcn_readfirstlane(((const int*)(rt + RT_NTILES))[slot]);
            pg8::Gemm g{act, (const bf16*)(ws + WS_MOEW + MOEW_GU_BYTES), nt * 256, DM, DFF, F.wv}; pg8::StaticOrder S; S.init(nt, DM / 256, F.G, F.blk, tilee, MOEW_E_BYTES);
            pg8::EpiMoeDown E{F.out, (const int*)(rt + RT_ROWTOK) + slot * MOE_ROWS, (const float*)(rt + RT_ROWGATE) + slot * MOE_ROWS};
            pg8::gemm_phase<pg8::EpiMoeDown, pg8::StaticOrder, true, true>(F.lds, g, S, E);
            if (slot == 0) moe_gather(F, 1, hb, asort);
        }
        if (slot == 0) SEAM(pg + 1);
    }
#if PROBE_MASK
    __syncthreads();
    if (blockIdx.x == 0 && threadIdx.x == 0) { STAMP(N_PHASES); volatile LAS unsigned long long* ts = (volatile LAS unsigned long long*)(F.lds + LDSCTL_OFF + 2048); unsigned long long tot = 0;
        for (int k = 0; k < N_PHASES; ++k) if ((PROBE_MASK >> k) & 1) tot += ts[k + 1] - ts[k];
#if defined(PROBE_SUB)
        tot = (PROBE_SUB == 0) ? ((volatile unsigned long long*)(F.ws + 32768))[0] : ((volatile unsigned long long*)(F.ws + 32768))[PROBE_SUB] + ((volatile unsigned long long*)(F.ws + 32768))[4 + PROBE_SUB];
#endif
        const unsigned long long t0 = __builtin_amdgcn_s_memrealtime(); while (__builtin_amdgcn_s_memrealtime() - t0 < tot) __builtin_amdgcn_s_sleep(8); }
#endif
#undef IN
#undef SEAM
}

extern "C" void kernel_launch(void* const* d_in, const int* in_sizes, int n_in, void* d_out, int out_size, void* d_ws, size_t ws_size, hipStream_t stream) {
    static int grid = 0;
    if (grid == 0) {
        if (n_in != 33 || out_size != NTOK * DM || ws_size < WS_TOTAL) { fprintf(stderr, "kernel_launch: unexpected problem (n_in %d out %d ws %zu)\n", n_in, out_size, ws_size); grid = -1; return; }
        int dev = 0, cus = 0;
        if (hipGetDevice(&dev) != hipSuccess || hipDeviceGetAttribute(&cus, hipDeviceAttributeMultiprocessorCount, dev) != hipSuccess) { grid = -1; return; }
        if (hipFuncSetAttribute((const void*)mk_fwd, hipFuncAttributeMaxDynamicSharedMemorySize, LDS_BYTES) != hipSuccess) { fprintf(stderr, "kernel_launch: hipFuncSetAttribute failed\n"); grid = -1; return; }
        (void)hipGetLastError();
        grid = cus;
        if (grid != 256) fprintf(stderr, "kernel_launch: %d CUs (built for 256)\n", grid);
    }
    if (grid < 0) return;
    (void)hipMemsetAsync((char*)d_ws + WS_CTL, 0, CTL_ZERO_BYTES, stream);
    Params p{};
    for (int i = 0; i < 33; ++i) p.in[i] = (const float*)d_in[i];
    p.out = (float*)d_out; p.ws = (unsigned char*)d_ws;
#if MK_PER_PHASE
    for (int k = 0; k < N_PHASES; ++k) { p.ph_lo = k; p.ph_hi = k + 1; hipLaunchKernelGGL(mk_fwd, dim3(grid), dim3(NTHREADS), LDS_BYTES, stream, p); }
#else
    p.ph_lo = 0; p.ph_hi = N_PHASES;
    hipLaunchKernelGGL(mk_fwd, dim3(grid), dim3(NTHREADS), LDS_BYTES, stream, p);
#endif
}
```

```cpp
#include <hip/hip_runtime.h>
#include <cstdio>
#include <cstdint>

#define LAS __attribute__((address_space(3)))
#define GAS __attribute__((address_space(1)))
typedef unsigned short bf16;
typedef short bf16x8 __attribute__((ext_vector_type(8)));
typedef short s16x4 __attribute__((ext_vector_type(4)));
typedef float f32x4 __attribute__((ext_vector_type(4)));
typedef float f32x2 __attribute__((ext_vector_type(2)));
typedef unsigned u32x4 __attribute__((ext_vector_type(4)));
typedef unsigned u32x2 __attribute__((ext_vector_type(2)));

constexpr int DM = 1024, NB = 8, SEQ = 4096, NTOK = NB * SEQ, INW = 2960, NPADW = 3072, DFF = 2816, NEXP = 8;
constexpr int ZA = 0, ZB = 768, ZC = 1280, ZD = 2176;
constexpr float NORM_EPS = 1e-6f;
constexpr int MOE_ROWS = NTOK + NEXP * 256;

constexpr size_t MiB = 1u << 20;
constexpr size_t WS_CTL = 0, CTL_ZERO_BYTES = 64 * 1024;
constexpr size_t WS_WIN = 1 * MiB;
constexpr size_t WS_WOUT = 13 * MiB;
constexpr size_t WS_WGU = 17 * MiB;
constexpr size_t WS_WD = 28 * MiB;
constexpr size_t WS_SSQ = 34 * MiB;
constexpr size_t WS_RT = 36 * MiB;
constexpr size_t WS_HB = 40 * MiB;
constexpr size_t WS_Z = 104 * MiB;
constexpr size_t WS_Y = 297 * MiB;
constexpr size_t WS_MOEW = 367 * MiB;
constexpr size_t WS_END = 499 * MiB;
constexpr size_t WS_GLAEC = 499 * MiB;
constexpr size_t WS_TOTAL = 500 * MiB;
constexpr size_t MOEW_GU_BYTES = (size_t)2 * DFF * DM * 2, MOEW_D_BYTES = (size_t)DM * DFF * 2, MOEW_E_BYTES = MOEW_GU_BYTES + MOEW_D_BYTES;
static_assert(WS_Z + (size_t)MOE_ROWS * DFF * 2 <= WS_Y && WS_Y + (size_t)MOE_ROWS * DM * 2 <= WS_MOEW && WS_MOEW + NEXP * MOEW_E_BYTES <= WS_END, "ws map");
constexpr size_t WS_OP = WS_HB;
constexpr size_t WS_LSE = WS_HB + 48 * MiB;
constexpr size_t RT_TOPE = 0;
constexpr size_t RT_GATE = RT_TOPE + (size_t)NTOK * 8;
constexpr size_t RT_RANK = RT_GATE + (size_t)NTOK * 8;
constexpr size_t RT_RSTD = RT_RANK + (size_t)NTOK * 8;
constexpr size_t RT_HIST = RT_RSTD + (size_t)NTOK * 4;
constexpr size_t RT_ROWTOK = RT_HIST + 256 * 16 * 4;
constexpr size_t RT_ROWGATE = RT_ROWTOK + (size_t)2 * MOE_ROWS * 4;
constexpr size_t RT_ROWRSTD = RT_ROWGATE + (size_t)2 * MOE_ROWS * 4;
constexpr size_t RT_TILEE = RT_ROWRSTD + (size_t)2 * MOE_ROWS * 4;
constexpr size_t RT_NTILES = RT_TILEE + 2 * 256 * 4;
static_assert(RT_NTILES + 64 <= 4 * MiB, "routing arrays");

constexpr int CW_BAR = 1024;

constexpr int RING_BYTES = 131072, LDSCTL_OFF = RING_BYTES, MISC_OFF = LDSCTL_OFF + 320, LDS_BYTES = 147456;
constexpr int NWAVES = 8, NTHREADS = 512;

#define LDS_WAIT() asm volatile("s_waitcnt lgkmcnt(0)" ::: "memory")
#define VM_WAIT() asm volatile("s_waitcnt vmcnt(0)" ::: "memory")
#define BAR() do { asm volatile("s_waitcnt lgkmcnt(0)" ::: "memory"); __builtin_amdgcn_s_barrier(); asm volatile("" ::: "memory"); } while (0)
__device__ __forceinline__ unsigned f2bf(float f) { unsigned u = __builtin_bit_cast(unsigned, f); return (u + 0x7fffu + ((u >> 16) & 1u)) >> 16; }
typedef __bf16 bf16x2_hw __attribute__((ext_vector_type(2)));
__device__ __forceinline__ unsigned pk2(float lo, float hi) { const f32x2 v = {lo, hi}; const bf16x2_hw b = __builtin_convertvector(v, bf16x2_hw); return __builtin_bit_cast(unsigned, b); }
__device__ __forceinline__ float bflo(unsigned w) { return __builtin_bit_cast(float, w << 16); }
__device__ __forceinline__ float bfhi(unsigned w) { return __builtin_bit_cast(float, w & 0xffff0000u); }
__device__ __forceinline__ float bf1(bf16 b) { return __builtin_bit_cast(float, (unsigned)b << 16); }
__device__ __forceinline__ float wave_sum(float v) {
#pragma unroll
    for (int o = 1; o < 64; o <<= 1) v += __shfl_xor(v, o);
    return v;
}
#define DPP_ADD(v, ctrl) ((v) + __builtin_bit_cast(float, __builtin_amdgcn_update_dpp(0, __builtin_bit_cast(int, (v)), (ctrl), 0xf, 0xf, true)))
__device__ __forceinline__ float red8(float v) { v = DPP_ADD(v, 0xB1); v = DPP_ADD(v, 0x4E); v = DPP_ADD(v, 0x141); return v; }
__device__ __forceinline__ float red16(float v) { v = DPP_ADD(v, 0xB1); v = DPP_ADD(v, 0x4E); v = DPP_ADD(v, 0x141); v = DPP_ADD(v, 0x140); return v; }
__device__ __forceinline__ float sigmoidf_(float x) { return 1.0f / (1.0f + __expf(-x)); }
__device__ __forceinline__ float siluf_(float x) { return x / (1.0f + __expf(-x)); }
__device__ __forceinline__ float softplusf_(float x) { return fmaxf(x, 0.f) + __logf(1.0f + __expf(-fabsf(x))); }
__device__ __forceinline__ float tanhf_(float x) { const float e = __expf(2.0f * x); return 1.0f - 2.0f / (e + 1.0f); }
__device__ __forceinline__ void unpack8(const u32x4 w, float (&f)[8]) {
    f[0] = bflo(w.x); f[1] = bfhi(w.x); f[2] = bflo(w.y); f[3] = bfhi(w.y); f[4] = bflo(w.z); f[5] = bfhi(w.z); f[6] = bflo(w.w); f[7] = bfhi(w.w);
}

namespace pg8 {
#define PG8_LAS __attribute__((address_space(3)))
typedef unsigned short bf16_t;
constexpr int BM = 256, BK = 64, HALF = 128, HTB = HALF * BK * 2  , STAGE_BYTES = 8 * HTB, NXCD = 8, WGM = 8;

__host__ __device__ __forceinline__ int lds_byte(int r, int c) { const int st = (r >> 4) * 2 + (c >> 5), rr = r & 15, cc = c & 31, ob = rr * 64 + cc * 2; return st * 1024 + (ob ^ (((ob >> 9) & 1) << 5)); }
__host__ __device__ __forceinline__ void stage_rc(int b, int& R, int& C) { const int st = b / 1024, sb = b % 1024, swz = sb ^ (((sb >> 9) & 1) << 5); R = (st >> 1) * 16 + swz / 64; C = (st & 1) * 32 + (swz % 64) / 2; }
__host__ __device__ __forceinline__ int perm32(int rho) { const int n = rho >> 4, i = rho & 15; return 8 * (i >> 2) + 4 * n + (i & 3); }

struct Unit { int pm, pn; };
struct Gemm { const bf16_t* A; const bf16_t* Bt; int M, N, K, wv; };

struct StaticOrder {
    int nM, nN, nwg, G, c; const int* tile_e; size_t estride;
    __device__ void init(int nM_, int nN_, int G_, int c_, const int* te = nullptr, size_t es = 0) { nM = nM_; nN = nN_; nwg = nM * nN; G = G_; c = c_; tile_e = te; estride = es; }
    __device__ bool next(int i, Unit& u) const {
        const long L = (long)i * G + c; if (L >= nwg) return false;
        int wgid = (int)L; { const int q = nwg / NXCD, r = nwg % NXCD, xcd = wgid % NXCD, off = wgid / NXCD; wgid = (xcd < r ? xcd * (q + 1) : r * (q + 1) + (xcd - r) * q) + off; }
        const int nig = WGM * nN, gid = wgid / nig, fm = gid * WGM, gsz = (nM - fm) < WGM ? (nM - fm) : WGM;
        u.pm = fm + ((wgid % nig) % gsz); u.pn = (wgid % nig) / gsz; return true;
    }
    __device__ __forceinline__ size_t bofs(const Unit& u, size_t tstep) const { return (size_t)u.pn * tstep + (tile_e ? (size_t)__builtin_amdgcn_readfirstlane(tile_e[u.pm]) * estride : (size_t)0); }
    __device__ __forceinline__ void a_ready(const Unit&) const {}
    __device__ __forceinline__ void done(const Unit&) const {}
};

__device__ __forceinline__ unsigned cvt_pk_bf16(float lo, float hi) { unsigned r; asm volatile("v_cvt_pk_bf16_f32 %0, %1, %2" : "=v"(r) : "v"(lo), "v"(hi)); return r; }

__device__ __forceinline__ float row_rstd16(const float* ssq, int r, int fq) {
    const f32x4 p = *(const f32x4*)(ssq + (size_t)r * 16 + 4 * fq);
    float s = (p[0] + p[1]) + (p[2] + p[3]); s += __shfl_xor(s, 16); s += __shfl_xor(s, 32);
    return __builtin_amdgcn_rsqf(s * (1.0f / DM) + NORM_EPS);
}

struct EpiZ {
    static constexpr bool PERM = true, AFTER_DRAIN = false;
    bf16_t* Z; int ldc, ncols; const float* ssq;
    __device__ __forceinline__ void operator()(const f32x4 (&acc)[2][2][4][2], const Unit& u, int wr, int wc, int fr, int fq) const {
        const int row0 = u.pm * BM + wr * 64 + fr, col0 = u.pn * BM + wc * 32 + 8 * fq;
#pragma unroll
        for (int ai = 0; ai < 2; ++ai)
#pragma unroll
            for (int m = 0; m < 4; ++m) { const int r = row0 + ai * HALF + m * 16; const float rs = row_rstd16(ssq, r, fq); bf16_t* rowp = Z + (size_t)r * ldc + col0;
#pragma unroll
                for (int bj = 0; bj < 2; ++bj) { const f32x4 v0 = acc[ai][bj][m][0] * rs, v1 = acc[ai][bj][m][1] * rs;
                    u32x4 w; w.x = cvt_pk_bf16(v0[0], v0[1]); w.y = cvt_pk_bf16(v0[2], v0[3]); w.z = cvt_pk_bf16(v1[0], v1[1]); w.w = cvt_pk_bf16(v1[2], v1[3]);
                    if (col0 + bj * HALF < ncols) *(u32x4*)(rowp + bj * HALF) = w; } }
    }
};
template <bool MOE> struct EpiSwiGLU {
    static constexpr bool PERM = true, AFTER_DRAIN = false;
    bf16_t* O; const float* ssq; const float* row_rstd;
    __device__ __forceinline__ void operator()(const f32x4 (&acc)[2][2][4][2], const Unit& u, int wr, int wc, int fr, int fq) const {
        const int row0 = u.pm * BM + wr * 64 + fr, col0 = u.pn * HALF + wc * 32 + 8 * fq;
#pragma unroll
        for (int ai = 0; ai < 2; ++ai)
#pragma unroll
            for (int m = 0; m < 4; ++m) { const int r = row0 + ai * HALF + m * 16; float rs; if (MOE) rs = row_rstd[r]; else rs = row_rstd16(ssq, r, fq);
                const f32x4 g0 = acc[ai][0][m][0] * rs, g1 = acc[ai][0][m][1] * rs, u0 = acc[ai][1][m][0] * rs, u1 = acc[ai][1][m][1] * rs; f32x4 a0, a1;
#pragma unroll
                for (int j = 0; j < 4; ++j) { a0[j] = g0[j] * __builtin_amdgcn_rcpf(1.0f + __expf(-g0[j])) * u0[j]; a1[j] = g1[j] * __builtin_amdgcn_rcpf(1.0f + __expf(-g1[j])) * u1[j]; }
                u32x4 w; w.x = cvt_pk_bf16(a0[0], a0[1]); w.y = cvt_pk_bf16(a0[2], a0[3]); w.z = cvt_pk_bf16(a1[0], a1[1]); w.w = cvt_pk_bf16(a1[2], a1[3]);
                *(u32x4*)(O + (size_t)r * DFF + col0) = w; }
    }
};
struct EpiRes {
    static constexpr bool PERM = false, AFTER_DRAIN = false;
    const float* base; const bf16_t* baseb; float* out; bf16_t* hb; float* ssq;
    __device__ __forceinline__ void operator()(const f32x4 (&acc)[2][2][4][2], const Unit& u, int wr, int wc, int fr, int fq) const {
        const int col0 = u.pn * BM + wc * 32 + 4 * fq;
#pragma unroll
        for (int ai = 0; ai < 2; ++ai)
#pragma unroll
            for (int m = 0; m < 4; ++m) { const int r = u.pm * BM + ai * HALF + wr * 64 + m * 16 + fr; const size_t off = (size_t)r * DM + col0; float ss = 0.f;
#pragma unroll
                for (int bj = 0; bj < 2; ++bj)
#pragma unroll
                    for (int n = 0; n < 2; ++n) { f32x4 bv;
                        if (base) bv = *(const f32x4*)(base + off + bj * HALF + n * 16);
                        else { const u32x2 bw = *(const u32x2*)(baseb + off + bj * HALF + n * 16); bv = (f32x4){bflo(bw.x), bfhi(bw.x), bflo(bw.y), bfhi(bw.y)}; }
                        const f32x4 v = bv + acc[ai][bj][m][n];
                        if (out) *(f32x4*)(out + off + bj * HALF + n * 16) = v;
                        ss += (v[0] * v[0] + v[1] * v[1]) + (v[2] * v[2] + v[3] * v[3]);
                        { u32x2 w; w.x = cvt_pk_bf16(v[0], v[1]); w.y = cvt_pk_bf16(v[2], v[3]); *(u32x2*)(hb + off + bj * HALF + n * 16) = w; } }
                ss += __shfl_xor(ss, 16); ss += __shfl_xor(ss, 32);
                if (fq == 0) ssq[(size_t)r * 16 + u.pn * 4 + wc] = ss;
                if (m & 1) asm volatile("" ::: "memory"); }
    }
};
struct EpiMoeDown {
    static constexpr bool PERM = false, AFTER_DRAIN = false;
    float* out; const int* row_tok; const float* row_gate;
    __device__ __forceinline__ void operator()(const f32x4 (&acc)[2][2][4][2], const Unit& u, int wr, int wc, int fr, int fq) const {
        const int col0 = u.pn * BM + wc * 32 + 4 * fq;
#pragma unroll
        for (int ai = 0; ai < 2; ++ai)
#pragma unroll
            for (int m = 0; m < 4; ++m) { const int r = u.pm * BM + ai * HALF + wr * 64 + m * 16 + fr; const int tok = row_tok[r]; const float gt = row_gate[r];
                if (tok >= 0) { float* op = out + (size_t)tok * DM + col0;
#pragma unroll
                    for (int bj = 0; bj < 2; ++bj)
#pragma unroll
                        for (int n = 0; n < 2; ++n) { float* p = op + bj * HALF + n * 16; *(f32x4*)p = *(const f32x4*)p + acc[ai][bj][m][n] * gt; } }
                if (m & 1) asm volatile("" ::: "memory"); }
    }
};

template <class Epi, class Sched, bool ALIGN_EPI = false, bool SP2 = false>
__device__ __forceinline__ void gemm_phase(PG8_LAS unsigned char* lds, const Gemm g, const Sched& S, const Epi& E) {
    int lid_; asm volatile("v_mbcnt_lo_u32_b32 %0, -1, 0\n\tv_mbcnt_hi_u32_b32 %0, -1, %0" : "=v"(lid_)); int tid_ = g.wv * 64 + lid_; asm volatile("" : "+v"(tid_));
    const int tid = tid_, wid = __builtin_amdgcn_readfirstlane(tid >> 6), lane = tid & 63, wr = wid >> 2, wc = wid & 3, fr = lane & 15, fq = lane >> 4;
    const int K = g.K, nt = K / BK;
    unsigned voffA[2], voffB[2];
#pragma unroll
    for (int i = 0; i < 2; ++i) { int R, C; stage_rc(tid * 16 + i * 8192, R, C); const int Rb = Epi::PERM ? ((R & ~31) + perm32(R & 31)) : R;
        voffA[i] = (unsigned)(R * K + C) * 2u; voffB[i] = (unsigned)(Rb * K + C) * 2u; }
    const size_t kstep = (size_t)(BK * 2);
    const size_t hstep = (size_t)HALF * K * 2;
    const size_t tstep = 2 * hstep;
    const unsigned ldsw = (unsigned)wid * 1024u;
    const int aoff = lds_byte(wr * 64 + fr, fq * 8), boff = lds_byte(wc * 32 + fr, fq * 8);
#define PG8_SA(b, h) (((b) * 2 + (h)) * HTB)
#define PG8_SB(b, h) ((4 + (b) * 2 + (h)) * HTB)
#define PG8_STAGE(bufoff, gbase, voff) do { _Pragma("unroll") for (int _i = 0; _i < 2; ++_i) \
        __builtin_amdgcn_global_load_lds((const unsigned*)((const char*)(gbase) + (voff)[_i]), (PG8_LAS unsigned*)(lds + (bufoff) + ldsw + _i * 8192), 16, 0, 0); } while (0)
#define PG8_LDA(dst, b, h) do { _Pragma("unroll") for (int m = 0; m < 4; ++m) _Pragma("unroll") for (int k = 0; k < 2; ++k) dst[m][k] = *(const PG8_LAS bf16x8*)(lds + PG8_SA(b, h) + aoff + m * 2048 + k * 1024); } while (0)
#define PG8_LDB(dst, b, h) do { _Pragma("unroll") for (int n = 0; n < 2; ++n) _Pragma("unroll") for (int k = 0; k < 2; ++k) dst[n][k] = *(const PG8_LAS bf16x8*)(lds + PG8_SB(b, h) + boff + n * 2048 + k * 1024); } while (0)
#define PG8_MMA(ai, bj, At, Bt) do { __builtin_amdgcn_s_setprio(1); _Pragma("unroll") for (int m = 0; m < 4; ++m) _Pragma("unroll") for (int n = 0; n < 2; ++n) _Pragma("unroll") for (int k = 0; k < 2; ++k) \
        acc[ai][bj][m][n] = __builtin_amdgcn_mfma_f32_16x16x32_bf16(Bt[n][k], At[m][k], acc[ai][bj][m][n], 0, 0, 0); __builtin_amdgcn_s_setprio(0); } while (0)
#define PG8_WAIT_V(n) asm volatile("s_waitcnt vmcnt(" #n ")" ::: "memory")
#define PG8_WAIT_L(n) asm volatile("s_waitcnt lgkmcnt(" #n ")" ::: "memory")
#define PG8_BAR __builtin_amdgcn_s_barrier()
#define PG8_SCHED __builtin_amdgcn_sched_barrier(0)
    Unit cur, nxt; int ui = 0;
    if (!S.next(0, cur)) return;
    f32x4 acc[2][2][4][2];
#pragma unroll
    for (int a = 0; a < 2; ++a)
#pragma unroll
        for (int b = 0; b < 2; ++b)
#pragma unroll
            for (int m = 0; m < 4; ++m)
#pragma unroll
                for (int n = 0; n < 2; ++n) acc[a][b][m][n] = (f32x4){0.f, 0.f, 0.f, 0.f};
    bf16x8 At[4][2], B0[2][2], B1[2][2];
    const char* cA = (const char*)g.A + (size_t)cur.pm * tstep; const char* cB = (const char*)g.Bt + S.bofs(cur, tstep);
    S.a_ready(cur);
    if constexpr (SP2) {
        PG8_STAGE(PG8_SB(0, 0), cB, voffB); PG8_STAGE(PG8_SB(0, 1), cB + hstep, voffB); PG8_STAGE(PG8_SA(0, 0), cA, voffA); PG8_STAGE(PG8_SA(0, 1), cA + hstep, voffA);
        if (wr == 1) PG8_BAR;
        PG8_WAIT_V(2); PG8_BAR;
        PG8_STAGE(PG8_SB(1, 0), cB + kstep, voffB); PG8_STAGE(PG8_SA(1, 0), cA + kstep, voffA); PG8_STAGE(PG8_SB(1, 1), cB + hstep + kstep, voffB);
        PG8_WAIT_V(6); PG8_BAR;
    } else {
        PG8_STAGE(PG8_SB(0, 0), cB, voffB); PG8_STAGE(PG8_SA(0, 0), cA, voffA); PG8_STAGE(PG8_SB(0, 1), cB + hstep, voffB); PG8_STAGE(PG8_SA(0, 1), cA + hstep, voffA);
        if (wr == 1) PG8_BAR;
        PG8_WAIT_V(4); PG8_BAR;
        PG8_STAGE(PG8_SB(1, 0), cB + kstep, voffB); PG8_STAGE(PG8_SA(1, 0), cA + kstep, voffA); PG8_STAGE(PG8_SB(1, 1), cB + hstep + kstep, voffB);
        PG8_WAIT_V(6); PG8_BAR;
    }
    for (;;) {
        const bool has_next = S.next(ui + 1, nxt);
        const char* nA = has_next ? (const char*)g.A + (size_t)nxt.pm * tstep : cA; const char* nB = has_next ? (const char*)g.Bt + S.bofs(nxt, tstep) : cB;
        for (int t = 0; t < nt; t += 2) {
            const bool last = (t == nt - 2);
            const char* a1 = cA + (size_t)(t + 1) * kstep;
            const char* a2 = last ? nA : cA + (size_t)(t + 2) * kstep; const char* b2 = last ? nB : cB + (size_t)(t + 2) * kstep;
            const char* a3 = a2 + kstep; const char* b3 = b2 + kstep;
            if (last && has_next) S.a_ready(nxt);
            if constexpr (SP2) {
            PG8_LDB(B0, 0, 0); PG8_LDB(B1, 0, 1); PG8_SCHED; PG8_LDA(At, 0, 0); PG8_STAGE(PG8_SA(1, 1), a1 + hstep, voffA);
            PG8_WAIT_V(8); PG8_WAIT_L(0); PG8_BAR; PG8_MMA(0, 0, At, B0); PG8_MMA(0, 1, At, B1); PG8_BAR; PG8_SCHED;
            PG8_LDA(At, 0, 1); PG8_STAGE(PG8_SB(0, 0), b2, voffB); PG8_STAGE(PG8_SB(0, 1), b2 + hstep, voffB); PG8_STAGE(PG8_SA(0, 0), a2, voffA);
            PG8_WAIT_V(8); PG8_WAIT_L(0); PG8_BAR; PG8_MMA(1, 0, At, B0); PG8_MMA(1, 1, At, B1); PG8_BAR; PG8_SCHED;
            PG8_LDB(B0, 1, 0); PG8_LDB(B1, 1, 1); PG8_SCHED; PG8_LDA(At, 1, 0); PG8_STAGE(PG8_SA(0, 1), a2 + hstep, voffA);
            PG8_WAIT_V(8); PG8_WAIT_L(0); PG8_BAR; PG8_MMA(0, 0, At, B0); PG8_MMA(0, 1, At, B1); PG8_BAR; PG8_SCHED;
            PG8_LDA(At, 1, 1); PG8_STAGE(PG8_SB(1, 0), b3, voffB); PG8_STAGE(PG8_SB(1, 1), b3 + hstep, voffB); PG8_STAGE(PG8_SA(1, 0), a3, voffA);
            PG8_WAIT_V(8); PG8_WAIT_L(0); PG8_BAR; PG8_MMA(1, 0, At, B0); PG8_MMA(1, 1, At, B1); PG8_BAR; PG8_SCHED;
            } else {
            PG8_LDB(B0, 0, 0); PG8_SCHED; PG8_LDA(At, 0, 0); PG8_STAGE(PG8_SA(1, 1), a1 + hstep, voffA);
            PG8_WAIT_L(8); PG8_BAR; PG8_WAIT_L(0); PG8_MMA(0, 0, At, B0); PG8_BAR; PG8_SCHED;
            PG8_LDB(B1, 0, 1); PG8_STAGE(PG8_SB(0, 0), b2, voffB);
            PG8_BAR; PG8_WAIT_L(0); PG8_MMA(0, 1, At, B1); PG8_BAR;
            PG8_LDA(At, 0, 1); PG8_STAGE(PG8_SA(0, 0), a2, voffA);
            PG8_BAR; PG8_WAIT_L(0); PG8_MMA(1, 0, At, B0); PG8_BAR; PG8_SCHED;
            PG8_STAGE(PG8_SB(0, 1), b2 + hstep, voffB);
            PG8_WAIT_V(6); PG8_BAR; PG8_MMA(1, 1, At, B1); PG8_BAR;
            PG8_LDB(B0, 1, 0); PG8_SCHED; PG8_LDA(At, 1, 0); PG8_STAGE(PG8_SA(0, 1), a2 + hstep, voffA);
            PG8_WAIT_L(8); PG8_BAR; PG8_WAIT_L(0); PG8_MMA(0, 0, At, B0); PG8_BAR; PG8_SCHED;
            PG8_LDB(B1, 1, 1); PG8_STAGE(PG8_SB(1, 0), b3, voffB);
            PG8_BAR; PG8_WAIT_L(0); PG8_MMA(0, 1, At, B1); PG8_BAR;
            PG8_LDA(At, 1, 1); PG8_STAGE(PG8_SA(1, 0), a3, voffA);
            PG8_BAR; PG8_WAIT_L(0); PG8_MMA(1, 0, At, B0); PG8_BAR; PG8_SCHED;
            PG8_STAGE(PG8_SB(1, 1), b3 + hstep, voffB);
            PG8_WAIT_V(6); PG8_BAR; PG8_MMA(1, 1, At, B1); PG8_BAR;
            }
        }
        if constexpr (ALIGN_EPI) { if (wr == 0) PG8_BAR; }
        if constexpr (!Epi::AFTER_DRAIN) { E(acc, cur, wr, wc, fr, fq); S.done(cur); }
        if (!has_next) break;
#pragma unroll
        for (int a = 0; a < 2; ++a)
#pragma unroll
            for (int b = 0; b < 2; ++b)
#pragma unroll
                for (int m = 0; m < 4; ++m)
#pragma unroll
                    for (int n = 0; n < 2; ++n) acc[a][b][m][n] = (f32x4){0.f, 0.f, 0.f, 0.f};
        cur = nxt; cA = nA; cB = nB; ++ui;
        if constexpr (ALIGN_EPI) { if (wr == 1) PG8_BAR; }
    }
    PG8_WAIT_V(0);
    if constexpr (!ALIGN_EPI) { if (wr == 0) PG8_BAR; }
    PG8_BAR;
    if constexpr (Epi::AFTER_DRAIN) { E.fused(acc, cur, wr, wc, fr, fq, lds, wid, lane); S.done(cur); }
#undef PG8_SA
#undef PG8_SB
#undef PG8_STAGE
#undef PG8_LDA
#undef PG8_LDB
#undef PG8_MMA
#undef PG8_WAIT_V
#undef PG8_WAIT_L
#undef PG8_BAR
#undef PG8_SCHED
}
}
#define XB_TMO      128
#define XB_XCNT(j)  (256  + 64 * (j))
#define XB_XSUB(j)  (1280 + 64 * (j))
#define XB_XGEN(j)  (2304 + 64 * (j))
#define XB_TOP      3328
#define XB_TOPGEN   3392
#define XCD_BAR_WORDS 3456
#define XB_SPIN_CAP (1u << 18)

__device__ __forceinline__ unsigned xb_ld(unsigned* p)              { return __hip_atomic_load(p, __ATOMIC_RELAXED, __HIP_MEMORY_SCOPE_AGENT); }
__device__ __forceinline__ unsigned xb_add(unsigned* p, unsigned v) { return __hip_atomic_fetch_add(p, v, __ATOMIC_RELAXED, __HIP_MEMORY_SCOPE_AGENT); }
__device__ __forceinline__ unsigned xb_xcc_id() { return (unsigned)__builtin_amdgcn_s_getreg((3 << 11) | 20) & 0xFu; }
#define XB_SPIN(cond, bar) do { unsigned _sp = 0; while (cond) { __builtin_amdgcn_s_sleep(1); \
    if ((++_sp & 255u) == 0u) { if (xb_ld(&(bar)[XB_TMO])) break; if (_sp > XB_SPIN_CAP) { atomicAdd(&(bar)[XB_TMO], 1u); break; } } } } while (0)

struct XcdBarrier {
    unsigned* bar; unsigned x;
    volatile LAS unsigned* st;
};

__device__ __forceinline__ XcdBarrier xcd_barrier_post(unsigned* bar, volatile LAS unsigned* st) {
    XcdBarrier b; b.bar = bar; b.x = xb_xcc_id(); b.st = st;
    if (threadIdx.x == 0) (void)xb_add(&bar[XB_XCNT(b.x)], 1u);
    return b;
}
__device__ __forceinline__ void xcd_barrier_complete(unsigned* bar, unsigned x, unsigned& nloc, unsigned& nx) {
    const unsigned G = gridDim.x * gridDim.y * gridDim.z;
    unsigned sum, cnt, mine, sp = 0u;
    for (;;) {
        sum = 0u; cnt = 0u; mine = 0u;
#pragma unroll
        for (unsigned j = 0; j < 16; ++j) { const unsigned c = xb_ld(&bar[XB_XCNT(j)]); sum += c; cnt += (c > 0u) ? 1u : 0u; mine = (j == x) ? c : mine; }
        if (sum == G) break;
        __builtin_amdgcn_s_sleep(1);
        if ((++sp & 255u) == 0u) { if (xb_ld(&bar[XB_TMO])) break; if (sp > XB_SPIN_CAP) { atomicAdd(&bar[XB_TMO], 1u); break; } }
    }
    nloc = mine > 0u ? mine : 1u; nx = cnt > 0u ? cnt : 1u;
}

__device__ __forceinline__ void xcd_barrier(const XcdBarrier& b) {
    asm volatile("s_waitcnt vmcnt(0)" ::: "memory");
    __syncthreads();
    if (threadIdx.x == 0) {
        unsigned* bar = b.bar;
        __builtin_amdgcn_s_waitcnt(0);
        unsigned nloc = b.st[0], nx = b.st[1];
        if (nloc == 0u) { xcd_barrier_complete(bar, b.x, nloc, nx); b.st[0] = nloc; b.st[1] = nx; }
        const unsigned old = xb_add(&bar[XB_XSUB(b.x)], 1u);
        const unsigned gen = old / nloc;
        if (old + 1u == (gen + 1u) * nloc) {
            __builtin_amdgcn_fence(__ATOMIC_RELEASE, "agent");
            asm volatile("s_waitcnt vmcnt(0)" ::: "memory");
            const unsigned og = xb_add(&bar[XB_TOP], 1u);
            const unsigned tg = og / nx;
            if (og + 1u == (tg + 1u) * nx) xb_add(&bar[XB_TOPGEN], 1u);
            else XB_SPIN(xb_ld(&bar[XB_TOPGEN]) == tg, bar);
            __builtin_amdgcn_fence(__ATOMIC_ACQUIRE, "agent");
            xb_add(&bar[XB_XGEN(b.x)], 1u);
            asm volatile("s_waitcnt vmcnt(0)" ::: "memory");
        } else {
            XB_SPIN(xb_ld(&bar[XB_XGEN(b.x)]) == gen, bar);
            __builtin_amdgcn_fence(__ATOMIC_ACQUIRE, "agent");
            asm volatile("s_waitcnt vmcnt(0)" ::: "memory");
        }
    }
    __syncthreads();
}

struct Params {
    const float* in[33];
    float* out; unsigned char* ws;
    int ph_lo, ph_hi;
};
struct Frame {
    LAS unsigned char* lds;
    int blk, G, wv;
    float* out; unsigned char* ws;
};
constexpr int PTAB_OFF = LDSCTL_OFF + 1024;
__device__ __forceinline__ int lane_id() { int l; asm volatile("v_mbcnt_lo_u32_b32 %0, -1, 0\n\tv_mbcnt_hi_u32_b32 %0, -1, %0" : "=v"(l)); return l; }
__device__ __forceinline__ int mytid(const Frame& F) { int t = F.wv * 64 + lane_id(); asm volatile("" : "+v"(t)); return t; }
__device__ __forceinline__ const float* inptr(const Frame& F, int k) {
    volatile LAS unsigned* t = (volatile LAS unsigned*)(F.lds + PTAB_OFF) + 2 * k;
    const unsigned lo = __builtin_amdgcn_readfirstlane(t[0]), hi = __builtin_amdgcn_readfirstlane(t[1]);
    const GAS float* gp = (const GAS float*)(((unsigned long long)hi << 32) | (unsigned long long)lo);
    return (const float*)gp;
}
#define IN_X 0
#define IN_RELB 1
#define IN_MIXG 2
#define IN_WIN 3
#define IN_WOUT 4
#define IN_FFNG 5
#define IN_QG 6
#define IN_KG 7
#define IN_CW 8
#define IN_CB 9
#define IN_CLG 10
#define IN_CLB 11
#define IN_MU 12
#define IN_W0 13
#define IN_W2 14
#define IN_A0 15
#define IN_A2 16
#define IN_G2 17
#define IN_KK 18
#define IN_KA 19
#define IN_RK 20
#define IN_RLG 21
#define IN_RLB 22
#define IN_GG2 23
#define IN_GGB 24
#define IN_GNG 25
#define IN_FWG 26
#define IN_FWU 27
#define IN_FWD 28
#define IN_ROUTER 29
#define IN_MWG 30
#define IN_MWU 31
#define IN_MWD 32

__device__ __forceinline__ void p0_transpose_item(const float* W, int K, int N, int nblk, const float* gk, bf16* WT, int mode, LAS float* scr, int item, int lane) {
    const int kb = item / nblk, nb = item % nblk, k0 = 64 * kb, n0 = 64 * nb, kr = lane >> 4, n4 = (lane & 15) * 4;
    const bool valid = (n0 + n4) < N;
    f32x4 v[16];
#pragma unroll
    for (int i = 0; i < 16; ++i) v[i] = valid ? *(const f32x4*)(W + (size_t)(k0 + 4 * i + kr) * N + n0 + n4) : (f32x4){0.f, 0.f, 0.f, 0.f};
    if (gk) {
#pragma unroll
        for (int i = 0; i < 16; ++i) v[i] = v[i] * gk[k0 + 4 * i + kr]; }
    const int rowbase = (mode == 0) ? n0 : ((n0 >> 7) * 256 + (mode == 2 ? 128 : 0) + (n0 & 127));
    const int c = lane & 3;
#pragma unroll
    for (int half = 0; half < 2; ++half) {
#pragma unroll
        for (int i = 0; i < 8; ++i) { LAS float* d = scr + (4 * i + kr) * 65 + n4; const f32x4 x = v[half * 8 + i]; d[0] = x[0]; d[1] = x[1]; d[2] = x[2]; d[3] = x[3]; }
        LDS_WAIT(); asm volatile("" ::: "memory");
#pragma unroll
        for (int j = 0; j < 4; ++j) { const int nn = (lane >> 2) + 16 * j; const LAS float* s = scr + (8 * c) * 65 + nn;
            u32x4 o; o.x = pk2(s[0 * 65], s[1 * 65]); o.y = pk2(s[2 * 65], s[3 * 65]); o.z = pk2(s[4 * 65], s[5 * 65]); o.w = pk2(s[6 * 65], s[7 * 65]);
            *(u32x4*)(WT + (size_t)(rowbase + nn) * K + k0 + half * 32 + 8 * c) = o; }
        LDS_WAIT(); asm volatile("" ::: "memory"); }
}
__device__ __forceinline__ void p0_prologue(Frame& F, const int part) {
    const int tid = mytid(F), lane = tid & 63, wave = __builtin_amdgcn_readfirstlane(tid >> 6); (void)lane; (void)wave;
    LAS float* scr = (LAS float*)(F.lds + wave * 16384);
    const int gw = F.blk * NWAVES + wave, NGW = F.G * NWAVES;
    constexpr int I_IN = 16 * 48, I_OUT = 16 * 16, I_GU = 16 * 44, I_D = 44 * 16, I_SET = 2 * I_GU + I_D;
    constexpr int NITEMS = 2 * I_IN + 2 * I_OUT + 9 * I_SET;
    unsigned char* ws = F.ws;
    constexpr int NPART0 = 2 * I_IN + 2 * I_OUT + I_SET;
    for (int it = (part == 0 ? 0 : NPART0) + gw; it < (part == 0 ? NPART0 : NITEMS); it += NGW) {
        int r = it;
        if (r < 2 * I_IN) { const int l = r / I_IN; r -= l * I_IN;
            p0_transpose_item(inptr(F, IN_WIN) + (size_t)l * DM * INW, DM, INW, 48, inptr(F, IN_MIXG) + l * DM, (bf16*)(ws + WS_WIN) + (size_t)l * NPADW * DM, 0, scr, r, lane); continue; }
        r -= 2 * I_IN;
        if (r < 2 * I_OUT) { const int l = r / I_OUT; r -= l * I_OUT;
            p0_transpose_item(inptr(F, IN_WOUT) + (size_t)l * DM * DM, DM, DM, 16, nullptr, (bf16*)(ws + WS_WOUT) + (size_t)l * DM * DM, 0, scr, r, lane); continue; }
        r -= 2 * I_OUT;
        const int set = r / I_SET; r -= set * I_SET;
        const float* wg = set == 0 ? inptr(F, IN_FWG) : inptr(F, IN_MWG) + (size_t)(set - 1) * DM * DFF;
        const float* wu = set == 0 ? inptr(F, IN_FWU) : inptr(F, IN_MWU) + (size_t)(set - 1) * DM * DFF;
        const float* wd = set == 0 ? inptr(F, IN_FWD) : inptr(F, IN_MWD) + (size_t)(set - 1) * DFF * DM;
        const float* gk = inptr(F, IN_FFNG) + (set == 0 ? 0 : DM);
        bf16* dgu = set == 0 ? (bf16*)(ws + WS_WGU) : (bf16*)(ws + WS_MOEW + (size_t)(set - 1) * MOEW_E_BYTES);
        bf16* dd = set == 0 ? (bf16*)(ws + WS_WD) : (bf16*)(ws + WS_MOEW + (size_t)(set - 1) * MOEW_E_BYTES + MOEW_GU_BYTES);
        if (r < I_GU) { p0_transpose_item(wg, DM, DFF, 44, gk, dgu, 1, scr, r, lane); continue; } r -= I_GU;
        if (r < I_GU) { p0_transpose_item(wu, DM, DFF, 44, gk, dgu, 2, scr, r, lane); continue; } r -= I_GU;
        p0_transpose_item(wd, DFF, DM, 16, nullptr, dd, 0, scr, r, lane);
    }
    if (part != 0) return;
    const float* x = inptr(F, IN_X); bf16* hb = (bf16*)(ws + WS_HB); float* ssq = (float*)(ws + WS_SSQ);
    for (int m = gw; m < NTOK; m += NGW) {
        const f32x4* xr = (const f32x4*)(x + (size_t)m * DM) + lane; f32x4 v[4]; float s = 0.f;
#pragma unroll
        for (int j = 0; j < 4; ++j) { v[j] = xr[64 * j]; s += (v[j][0] * v[j][0] + v[j][1] * v[j][1]) + (v[j][2] * v[j][2] + v[j][3] * v[j][3]); }
        s = wave_sum(s);
        u32x2* o8 = (u32x2*)(hb + (size_t)m * DM) + lane;
#pragma unroll
        for (int j = 0; j < 4; ++j) { u32x2 w; w.x = pk2(v[j][0], v[j][1]); w.y = pk2(v[j][2], v[j][3]); o8[64 * j] = w; }
        if (lane < 16) ssq[(size_t)m * 16 + lane] = (lane == 0) ? s : 0.f;
    }
}

__device__ const unsigned char T5B[3][132] = {
 {0,1,2,3,4,5,6,7,8,9,10,11,12,13,14,15,16,16,16,16,16,16,17,17,17,17,17,17,17,17,18,18,18,18,18,18,18,18,18,18,19,19,19,19,19,19,19,19,19,19,19,19,19,19,20,20,20,20,20,20,20,20,20,20,20,20,20,20,20,20,20,20,20,21,21,21,21,21,21,21,21,21,21,21,21,21,21,21,21,21,21,21,21,21,21,21,21,21,21,22,22,22,22,22,22,22,22,22,22,22,22,22,22,22,22,22,22,22,22,22,22,22,22,22,22,22,22,22,22,0,0,0},
 {0,4,8,12,16,16,17,17,18,18,19,19,19,19,20,20,20,20,20,21,21,21,21,21,21,22,22,22,22,22,22,22,22,22,23,23,23,23,23,23,23,23,23,23,23,23,24,24,24,24,24,24,24,24,24,24,24,24,24,24,24,24,25,25,25,25,25,25,25,25,25,25,25,25,25,25,25,25,25,25,25,25,25,26,26,26,26,26,26,26,26,26,26,26,26,26,26,26,26,26,26,26,26,26,26,26,26,26,26,26,26,26,26,27,27,27,27,27,27,27,27,27,27,27,27,27,27,27,27,0,0,0},
 {0,16,18,19,20,21,21,22,22,23,23,23,24,24,24,24,25,25,25,25,25,26,26,26,26,26,26,26,26,27,27,27,27,27,27,27,27,27,27,28,28,28,28,28,28,28,28,28,28,28,28,28,29,29,29,29,29,29,29,29,29,29,29,29,29,29,29,29,29,29,30,30,30,30,30,30,30,30,30,30,30,30,30,30,30,30,30,30,30,30,30,30,30,30,30,31,31,31,31,31,31,31,31,31,31,31,31,31,31,31,31,31,31,31,31,31,31,31,31,31,31,31,31,31,31,31,31,31,31,0,0,0}};

__device__ __forceinline__ void attn_qknorm(Frame& F, bf16* Z, const float* qg, const float* kg) {
    const int tid = mytid(F); const int gt = F.blk * NTHREADS + tid, NGT = F.G * NTHREADS;
    for (int idx = gt; idx < NTOK * 64; idx += NGT) { const int tok = idx >> 6, seg = (idx >> 3) & 7, c8 = idx & 7;
        u32x4* ptr = (u32x4*)(Z + (size_t)tok * INW + (seg >> 2) * 256 + (seg & 3) * 64 + c8 * 8); const u32x4 p = *ptr; float f[8]; unpack8(p, f);
        float ss = 0.f;
#pragma unroll
        for (int e2 = 0; e2 < 8; ++e2) ss += f[e2] * f[e2];
        ss = red8(ss);
        const float rs = __builtin_amdgcn_rsqf(ss * (1.0f / 64.0f) + NORM_EPS) * (seg < 4 ? 0.125f : 1.0f); const float* gp = (seg < 4 ? qg : kg) + c8 * 8;
        u32x4 o; o.x = pk2(f[0] * rs * gp[0], f[1] * rs * gp[1]); o.y = pk2(f[2] * rs * gp[2], f[3] * rs * gp[3]); o.z = pk2(f[4] * rs * gp[4], f[5] * rs * gp[5]); o.w = pk2(f[6] * rs * gp[6], f[7] * rs * gp[7]);
        *ptr = o; }
}
typedef short v4i16 __attribute__((ext_vector_type(4)));
__device__ __forceinline__ void attn_tile(LAS unsigned char* lds, const bf16* Z, bf16* OP, float* LSE, const float* rel_bias, int tile, int tid) {
    const int lane = tid & 63, w = __builtin_amdgcn_readfirstlane(tid >> 6), fr = lane & 15, g = lane >> 4;
    const int br = tile >> 10, rem = tile & 1023, b = rem >> 7, h = (rem >> 5) & 3, sub = rem & 31;
    const int dsh = 2 * br, nbl = 32 >> dsh, r = sub >> (5 - dsh), n = sub & (nbl - 1);
    LAS unsigned char* Qs = lds;
    LAS unsigned char* Ks = lds + 16384;
    LAS unsigned char* Vs = lds + 49152;
    LAS float* BT = (LAS float*)(lds + 81920);
    const size_t zrow0 = (size_t)b * SEQ;
    if (tid < 129) BT[tid] = rel_bias[(int)T5B[br][tid] * 4 + h];
    { const int rl = lane >> 3, cp = lane & 7;
#pragma unroll
        for (int i = 0; i < 4; ++i) { const int R0 = (w * 4 + i) * 8, row = R0 + rl; int lk = 128 * (n - 1) + row; lk = lk < 0 ? 0 : lk;
            const bf16* zr = Z + (zrow0 + ((size_t)lk << dsh) + r) * INW + h * 64;
            __builtin_amdgcn_global_load_lds((const unsigned*)(zr + 256 + ((cp ^ (row & 7)) * 8)), (LAS unsigned*)(Ks + R0 * 128), 16, 0, 0);
            __builtin_amdgcn_global_load_lds((const unsigned*)(zr + 512 + ((2 * ((cp >> 1) ^ ((row >> 1) & 3)) + (cp & 1)) * 8)), (LAS unsigned*)(Vs + R0 * 128), 16, 0, 0); }
#pragma unroll
        for (int i = 0; i < 2; ++i) { const int R0 = (w * 2 + i) * 8, row = R0 + rl; const int lq = 128 * n + row;
            const bf16* zr = Z + (zrow0 + ((size_t)lq << dsh) + r) * INW + h * 64;
            __builtin_amdgcn_global_load_lds((const unsigned*)(zr + ((cp ^ (row & 7)) * 8)), (LAS unsigned*)(Qs + R0 * 128), 16, 0, 0); } }
    asm volatile("s_waitcnt vmcnt(0)" ::: "memory");
    BAR();
    bf16x8 qf[2];
#pragma unroll
    for (int ks = 0; ks < 2; ++ks) qf[ks] = *(const LAS bf16x8*)(Qs + (16 * w + fr) * 128 + (((ks * 4 + g) ^ (fr & 7)) << 4));
    f32x4 s[16];
#pragma unroll
    for (int kb = 0; kb < 16; ++kb) { s[kb] = (f32x4){0.f, 0.f, 0.f, 0.f};
#pragma unroll
        for (int ks = 0; ks < 2; ++ks) { const bf16x8 kf = *(const LAS bf16x8*)(Ks + (16 * kb + fr) * 128 + (((ks * 4 + g) ^ (fr & 7)) << 4));
            s[kb] = __builtin_amdgcn_mfma_f32_16x16x32_bf16(kf, qf[ks], s[kb], 0, 0, 0); } }
    const int q = 16 * w + fr; float mx = -3.0e38f;
#pragma unroll
    for (int kb = 0; kb < 16; ++kb)
#pragma unroll
        for (int rg = 0; rg < 4; ++rg) { const int key = 16 * kb + 4 * g + rg, delta = q + 128 - key; const bool valid = (delta >= 0) && (delta <= 128) && (n > 0 || key >= 128);
            const int di = delta < 0 ? 0 : (delta > 128 ? 128 : delta);
            const float v = valid ? s[kb][rg] + BT[di] : -3.0e38f; s[kb][rg] = v; mx = fmaxf(mx, v); }
    mx = fmaxf(mx, __shfl_xor(mx, 16)); mx = fmaxf(mx, __shfl_xor(mx, 32));
    float den = 0.f;
#pragma unroll
    for (int kb = 0; kb < 16; ++kb)
#pragma unroll
        for (int rg = 0; rg < 4; ++rg) { const float v = s[kb][rg]; const float p = (v > -1.0e38f) ? __expf(v - mx) : 0.f; s[kb][rg] = p; den += p; }
    den += __shfl_xor(den, 16); den += __shfl_xor(den, 32);
    f32x4 o[4];
#pragma unroll
    for (int eb = 0; eb < 4; ++eb) o[eb] = (f32x4){0.f, 0.f, 0.f, 0.f};
    const int trq = fr >> 2, trp = fr & 3;
#pragma unroll
    for (int s8 = 0; s8 < 8; ++s8) {
        u32x4 pw; pw.x = pk2(s[2 * s8][0], s[2 * s8][1]); pw.y = pk2(s[2 * s8][2], s[2 * s8][3]); pw.z = pk2(s[2 * s8 + 1][0], s[2 * s8 + 1][1]); pw.w = pk2(s[2 * s8 + 1][2], s[2 * s8 + 1][3]);
        const bf16x8 pb = __builtin_bit_cast(bf16x8, pw);
        const int rowA = 32 * s8 + 4 * g + trq, swz = (rowA >> 1) & 3;
#pragma unroll
        for (int eb = 0; eb < 4; ++eb) { const LAS unsigned char* vp = Vs + rowA * 128 + ((eb ^ swz) * 32) + 8 * trp;
            const v4i16 lo = __builtin_amdgcn_ds_read_tr16_b64_v4i16((LAS v4i16*)vp), hi = __builtin_amdgcn_ds_read_tr16_b64_v4i16((LAS v4i16*)(vp + 16 * 128));
            bf16x8 af; af[0] = lo[0]; af[1] = lo[1]; af[2] = lo[2]; af[3] = lo[3]; af[4] = hi[0]; af[5] = hi[1]; af[6] = hi[2]; af[7] = hi[3];
            o[eb] = __builtin_amdgcn_mfma_f32_16x16x32_bf16(af, pb, o[eb], 0, 0, 0); } }
    const float inv = 1.0f / den; const size_t tokq = zrow0 + ((size_t)(128 * n + q) << dsh) + r;
    bf16* op = OP + ((size_t)br * NTOK + tokq) * 256 + h * 64 + 4 * g;
#pragma unroll
    for (int eb = 0; eb < 4; ++eb) { u32x2 wv; wv.x = pk2(o[eb][0] * inv, o[eb][1] * inv); wv.y = pk2(o[eb][2] * inv, o[eb][3] * inv); *(u32x2*)(op + 16 * eb) = wv; }
    if (g == 0) LSE[((size_t)br * NTOK + tokq) * 4 + h] = mx + __logf(den);
    BAR();
}

__device__ __forceinline__ void attn_merge(Frame& F, const bf16* OP, const float* LSE, bf16* Y, int wi, int nw) {
    const int tid = mytid(F), lane = tid & 63, wave = __builtin_amdgcn_readfirstlane(tid >> 6); (void)lane; (void)wave;
    const int gt = wi * NTHREADS + tid, NGT = nw * NTHREADS;
    for (int idx = gt; idx < NTOK * 32; idx += NGT) { const int tok = idx >> 5, c8 = idx & 31, h = c8 >> 3;
        const float l0 = LSE[((size_t)0 * NTOK + tok) * 4 + h], l1 = LSE[((size_t)1 * NTOK + tok) * 4 + h], l2 = LSE[((size_t)2 * NTOK + tok) * 4 + h];
        const float m = fmaxf(l0, fmaxf(l1, l2)); float w0 = __expf(l0 - m), w1 = __expf(l1 - m), w2 = __expf(l2 - m); const float inv = 1.0f / (w0 + w1 + w2); w0 *= inv; w1 *= inv; w2 *= inv;
        const u32x4 a = *(const u32x4*)(OP + ((size_t)0 * NTOK + tok) * 256 + c8 * 8), bq = *(const u32x4*)(OP + ((size_t)1 * NTOK + tok) * 256 + c8 * 8), c = *(const u32x4*)(OP + ((size_t)2 * NTOK + tok) * 256 + c8 * 8);
        float fa[8], fb[8], fc[8]; unpack8(a, fa); unpack8(bq, fb); unpack8(c, fc); float r[8];
#pragma unroll
        for (int e = 0; e < 8; ++e) r[e] = w0 * fa[e] + w1 * fb[e] + w2 * fc[e];
        u32x4 o; o.x = pk2(r[0], r[1]); o.y = pk2(r[2], r[3]); o.z = pk2(r[4], r[5]); o.w = pk2(r[6], r[7]);
        *(u32x4*)(Y + (size_t)tok * DM + c8 * 8) = o; }
}

__device__ __forceinline__ void conv_item(Frame& F, const bf16* Z, bf16* Y, const float* cw, const float* cb, const float* lg, const float* lb, int item) {
    const int tid = mytid(F), b = item >> 6, t0 = (item & 63) * 64;
    LAS float* HG = (LAS float*)F.lds;
    LAS float* WL = (LAS float*)(F.lds + 96256);
    f32x4 wq[4]; u32x4 uu[6], gg[6];
#pragma unroll
    for (int i = 0; i < 4; ++i) { const int q = tid + NTHREADS * i; wq[i] = (q < 31 * 64) ? *(const f32x4*)(cw + 4 * q) : (f32x4){0.f, 0.f, 0.f, 0.f}; }
#pragma unroll
    for (int i = 0; i < 6; ++i) { const int p = tid + NTHREADS * i, row = p >> 5, c8 = p & 31, t = t0 - 30 + row; uu[i] = (u32x4){0u, 0u, 0u, 0u}; gg[i] = uu[i];
        if (p < 94 * 32 && t >= 0) { const bf16* zr = Z + ((size_t)b * SEQ + t) * INW + ZB + c8 * 8; uu[i] = *(const u32x4*)zr; gg[i] = *(const u32x4*)(zr + 256); } }
#pragma unroll
    for (int i = 0; i < 4; ++i) { const int q = tid + NTHREADS * i; if (q < 31 * 64) *(LAS f32x4*)(WL + 4 * q) = wq[i]; }
#pragma unroll
    for (int i = 0; i < 6; ++i) { const int p = tid + NTHREADS * i, row = p >> 5, c8 = p & 31;
        if (p < 94 * 32) { float fu[8], fg[8], hv[8]; unpack8(uu[i], fu); unpack8(gg[i], fg);
#pragma unroll
            for (int e = 0; e < 8; ++e) hv[e] = fu[e] * __builtin_amdgcn_rcpf(1.0f + __expf(-fg[e]));
            LAS f32x4* d = (LAS f32x4*)(HG + row * 256 + c8 * 8); d[0] = (f32x4){hv[0], hv[1], hv[2], hv[3]}; d[1] = (f32x4){hv[4], hv[5], hv[6], hv[7]}; } }
    BAR();
    const int tt = tid >> 3, cs = tid & 7;
    f32x4 acc[8];
#pragma unroll
    for (int i = 0; i < 8; ++i) acc[i] = *(const f32x4*)(cb + 4 * (cs + 8 * i));
    for (int j = 0; j < 31; ++j) {
#pragma unroll
        for (int i = 0; i < 8; ++i) { const int qd = cs + 8 * i; acc[i] += *(const LAS f32x4*)(HG + (tt + j) * 256 + 4 * qd) * *(const LAS f32x4*)(WL + j * 256 + 4 * qd); } }
    bf16* yr = Y + ((size_t)b * SEQ + t0 + tt) * DM + 256;
#pragma unroll
    for (int gi = 0; gi < 4; ++gi) {
        const f32x4 x0 = acc[2 * gi], x1 = acc[2 * gi + 1];
        float s = ((x0[0] + x0[1]) + (x0[2] + x0[3])) + ((x1[0] + x1[1]) + (x1[2] + x1[3])); s = red8(s);
        const float mean = s * (1.0f / 64.0f); const f32x4 d0 = x0 - mean, d1 = x1 - mean;
        float ss = ((d0[0] * d0[0] + d0[1] * d0[1]) + (d0[2] * d0[2] + d0[3] * d0[3])) + ((d1[0] * d1[0] + d1[1] * d1[1]) + (d1[2] * d1[2] + d1[3] * d1[3])); ss = red8(ss);
        const float rstd = __builtin_amdgcn_rsqf(ss * (1.0f / 64.0f) + 1e-5f);
#pragma unroll
        for (int k = 0; k < 2; ++k) { const int qd = cs + 8 * (2 * gi + k); const f32x4 dd = k ? d1 : d0; const f32x4 gv = *(const f32x4*)(lg + 4 * qd), bv = *(const f32x4*)(lb + 4 * qd); float y[4];
#pragma unroll
            for (int e = 0; e < 4; ++e) y[e] = siluf_(dd[e] * rstd * gv[e] + bv[e]);
            u32x2 wv; wv.x = pk2(y[0], y[1]); wv.y = pk2(y[2], y[3]); *(u32x2*)(yr + 4 * qd) = wv; } }
    BAR();
}

__device__ __forceinline__ bf16x8 ldfrag(const LAS unsigned char* base, int stride, int row0, int kb0, int fr, int g) {
    return *(const LAS bf16x8*)(base + (row0 + fr) * stride + kb0 + 16 * g);
}
#define MFMA16(a, b, c) __builtin_amdgcn_mfma_f32_16x16x32_bf16((a), (b), (c), 0, 0, 0)

constexpr int GL_G2 = 0, GL_Q = 2048, GL_K = 6144, GL_GK = 10240, GL_GD = 14336, GL_OG = 16384, GL_QT = 24576, GL_KB = 27136, GL_KHT = 29696, GL_VT = 32256, GL_ATT = 37376, GL_ST = 39936, GL_EC = 45056,
              GL_OB = 45184, GL_GB = 53376, GL_END = 53504;
struct GlaRaw { u32x4 p[2]; u32x4 s; };
__device__ __forceinline__ void gla_decode(int tid, int h, int it, int& tt, int& col, int& kind, int& off, bool& ok) {
    const int p = tid + 512 * it; ok = p < 832; tt = p / 26; const int qd = p % 26;
    if (qd < 4) { col = ZD + h * 32 + 8 * qd; kind = 0; off = tt * 32 + 8 * qd; }
    else if (qd < 8) { col = ZD + 128 + h * 32 + 8 * (qd - 4); kind = 1; off = tt * 32 + 8 * (qd - 4); }
    else if (qd < 16) { col = ZD + 256 + h * 64 + 8 * (qd - 8); kind = 2; off = 8 * (qd - 8); }
    else if (qd < 18) { col = ZD + 512 + 8 * (qd - 16); kind = 3; off = tt * 16 + 8 * (qd - 16); }
    else { col = ZD + 528 + h * 64 + 8 * (qd - 18); kind = 4; off = tt * 64 + 8 * (qd - 18); }
}
template <int STEP> __device__ __forceinline__ void gla_load(const bf16* Z, const unsigned char* sst, int b, int h, int ch, int tid, GlaRaw& r) {
#pragma unroll
    for (int it = 0; it < 2; ++it) { int tt, col, kind, off; bool ok; gla_decode(tid, h, it, tt, col, kind, off, ok);
        r.p[it] = ok ? *(const u32x4*)(Z + ((size_t)b * SEQ + ch * 32 + tt) * INW + col) : (u32x4){0u, 0u, 0u, 0u}; }
    if (STEP == 1) r.s = (tid < 256) ? *(const u32x4*)(sst + (size_t)((b * 4 + h) * (SEQ / 32) + ch) * 4096 + 16 * tid) : (u32x4){0u, 0u, 0u, 0u};
}
template <int STEP> __device__ __forceinline__ void gla_item(Frame& F, const GlaRaw& raw, unsigned char* con, float* ecg, bf16* Y, const float* ng, int b, int h, int ch) {
    const int tid = mytid(F), lane = tid & 63, w = __builtin_amdgcn_readfirstlane(tid >> 6), fr = lane & 15, g = lane >> 4;
    LAS unsigned char* L = F.lds;
    LAS float *G2 = (LAS float*)(L + GL_G2), *QF = (LAS float*)(L + GL_Q), *KF = (LAS float*)(L + GL_K), *GK = (LAS float*)(L + GL_GK), *GD = (LAS float*)(L + GL_GD), *OG = (LAS float*)(L + GL_OG),
              *OB = (LAS float*)(L + GL_OB), *GB = (LAS float*)(L + GL_GB);
    LAS unsigned char *QT = L + GL_QT, *KB = L + GL_KB, *KHT = L + GL_KHT, *VT = L + GL_VT, *ATT = L + GL_ATT, *ST = L + GL_ST;
    const size_t item = (size_t)((b * 4 + h) * (SEQ / 32) + ch);
#pragma unroll
    for (int it = 0; it < 2; ++it) { int tt, col, kind, off; bool ok; gla_decode(tid, h, it, tt, col, kind, off, ok);
        if (ok) { float f[8]; unpack8(raw.p[it], f);
            if (kind == 2) { LAS unsigned short* vp = (LAS unsigned short*)(VT + off * 80 + tt * 2); const u32x4 pr = raw.p[it];
                vp[0 * 40] = (unsigned short)(pr.x & 0xffffu); vp[1 * 40] = (unsigned short)(pr.x >> 16); vp[2 * 40] = (unsigned short)(pr.y & 0xffffu); vp[3 * 40] = (unsigned short)(pr.y >> 16);
                vp[4 * 40] = (unsigned short)(pr.z & 0xffffu); vp[5 * 40] = (unsigned short)(pr.z >> 16); vp[6 * 40] = (unsigned short)(pr.w & 0xffffu); vp[7 * 40] = (unsigned short)(pr.w >> 16); }
            else if (kind != 4 || STEP == 1) { LAS float* dst = (kind == 0 ? QF : kind == 1 ? KF : kind == 3 ? GD : OG) + off; const float sc = kind == 0 ? 0.17677669529663687f : 1.0f;
                ((LAS f32x4*)dst)[0] = (f32x4){f[0] * sc, f[1] * sc, f[2] * sc, f[3] * sc}; ((LAS f32x4*)dst)[1] = (f32x4){f[4] * sc, f[5] * sc, f[6] * sc, f[7] * sc}; } } }
    if (STEP == 1 && tid < 256) *(LAS u32x4*)(ST + (tid >> 2) * 80 + (tid & 3) * 16) = raw.s;
    BAR();
#pragma unroll
    for (int it = 0; it < 2; ++it) { const int o = tid + 512 * it, tt = o >> 5, kk = o & 31; float x = GB[kk];
#pragma unroll
        for (int j = 0; j < 16; ++j) x += GD[tt * 16 + j] * G2[j * 32 + kk];
        GK[tt * 32 + kk] = -softplusf_(-x) * (1.0f / 16.0f); }
    BAR();
    { const int t = tid >> 4, k2 = (tid & 15) * 2; float c0 = 0.f, c1 = 0.f, b0 = 0.f, b1 = 0.f;
#pragma unroll 8
        for (int s = 0; s < 32; ++s) { const f32x2 gk = *(const LAS f32x2*)(GK + s * 32 + k2); c0 += gk[0]; c1 += gk[1]; if (s == t) { b0 = c0; b1 = c1; } }
        const f32x2 q = *(const LAS f32x2*)(QF + t * 32 + k2), k = *(const LAS f32x2*)(KF + t * 32 + k2);
        if (STEP == 1) { *(LAS unsigned*)(QT + t * 80 + k2 * 2) = pk2(q[0] * __expf(b0), q[1] * __expf(b1)); *(LAS unsigned*)(KB + t * 80 + k2 * 2) = pk2(k[0] * __expf(-b0), k[1] * __expf(-b1)); }
        else { *(LAS unsigned short*)(KHT + k2 * 80 + t * 2) = (unsigned short)f2bf(k[0] * __expf(c0 - b0)); *(LAS unsigned short*)(KHT + (k2 + 1) * 80 + t * 2) = (unsigned short)f2bf(k[1] * __expf(c1 - b1));
            if (t == 0) { ecg[item * 32 + k2] = __expf(c0); ecg[item * 32 + k2 + 1] = __expf(c1); } } }
    BAR();
    if (STEP == 0) {
        const int kb = w >> 2, vb = w & 3; f32x4 d = (f32x4){0.f, 0.f, 0.f, 0.f};
        d = MFMA16(ldfrag(KHT, 80, 16 * kb, 0, fr, g), ldfrag(VT, 80, 16 * vb, 0, fr, g), d);
        u32x2 so; so.x = pk2(d[0], d[1]); so.y = pk2(d[2], d[3]); *(u32x2*)(con + item * 4096 + (16 * vb + fr) * 64 + (16 * kb + 4 * g) * 2) = so;
        BAR();
    } else {
        if (w < 3) { const int atb = w == 0 ? 0 : 1, asb = w == 2 ? 1 : 0;
            f32x4 d = (f32x4){0.f, 0.f, 0.f, 0.f}; d = MFMA16(ldfrag(KB, 80, 16 * asb, 0, fr, g), ldfrag(QT, 80, 16 * atb, 0, fr, g), d);
            const int t = 16 * atb + fr; float v[4];
#pragma unroll
            for (int r = 0; r < 4; ++r) { const int s = 16 * asb + 4 * g + r; v[r] = (s <= t) ? d[r] : 0.f; }
            u32x2 o; o.x = pk2(v[0], v[1]); o.y = pk2(v[2], v[3]); *(LAS u32x2*)(ATT + t * 80 + (16 * asb + 4 * g) * 2) = o; }
        else if (w == 3) { *(LAS u32x2*)(ATT + fr * 80 + (16 + 4 * g) * 2) = (u32x2){0u, 0u}; }
        BAR();
        { const int tb = w >> 2, vb = w & 3; f32x4 o = (f32x4){0.f, 0.f, 0.f, 0.f};
            o = MFMA16(ldfrag(ATT, 80, 16 * tb, 0, fr, g), ldfrag(VT, 80, 16 * vb, 0, fr, g), o);
            o = MFMA16(ldfrag(QT, 80, 16 * tb, 0, fr, g), ldfrag(ST, 80, 16 * vb, 0, fr, g), o);
#pragma unroll
            for (int r = 0; r < 4; ++r) OB[(16 * tb + 4 * g + r) * 64 + 16 * vb + fr] = o[r]; }
        BAR();
        { const int tt = tid >> 4, v4 = (tid & 15) * 4; const f32x4 o = *(const LAS f32x4*)(OB + tt * 64 + v4);
            float ss = (o[0] * o[0] + o[1] * o[1]) + (o[2] * o[2] + o[3] * o[3]); ss = red16(ss);
            const float rs = __builtin_amdgcn_rsqf(ss * (1.0f / 64.0f) + NORM_EPS); const f32x4 gv = *(const f32x4*)(ng + v4), og = *(const LAS f32x4*)(OG + tt * 64 + v4); float y[4];
#pragma unroll
            for (int e = 0; e < 4; ++e) y[e] = o[e] * rs * gv[e] * og[e] * __builtin_amdgcn_rcpf(1.0f + __expf(-og[e]));
            u32x2 wv; wv.x = pk2(y[0], y[1]); wv.y = pk2(y[2], y[3]); *(u32x2*)(Y + ((size_t)b * SEQ + ch * 32 + tt) * DM + 768 + h * 64 + v4) = wv; }
        BAR();
    }
}
template <int STEP> __device__ __forceinline__ void gla_items(Frame& F, const bf16* Z, unsigned char* con, float* ecg, bf16* Y, const float* g2, const float* gb, const float* ng, int wi, int nw) {
    const int tid = mytid(F);
#pragma unroll 1
    for (int h = 0; h < 4; ++h) {
        ((LAS float*)(F.lds + GL_G2))[tid] = g2[(tid >> 5) * 128 + h * 32 + (tid & 31)]; if (tid < 32) ((LAS float*)(F.lds + GL_GB))[tid] = gb[h * 32 + tid];
        BAR();
        GlaRaw cur, nxt; cur.p[0] = (u32x4){0u, 0u, 0u, 0u}; cur.p[1] = cur.p[0]; cur.s = cur.p[0]; nxt = cur;
        if (wi < 1024) gla_load<STEP>(Z, con, wi >> 7, h, wi & 127, tid, cur);
#pragma unroll 1
        for (int it = wi; it < 1024; it += nw) { const int nx = it + nw;
            if (nx < 1024) gla_load<STEP>(Z, con, nx >> 7, h, nx & 127, tid, nxt);
            gla_item<STEP>(F, cur, con, ecg, Y, ng, it >> 7, h, it & 127);
            cur = nxt; }
        BAR(); }
}
__device__ __forceinline__ void gla_scan(Frame& F, unsigned char* con, const float* ecg, int b, int h) {
    const int tid = mytid(F); const int k4 = (tid & 7) * 4;
    unsigned char* base = con + (size_t)((b * 4 + h) * (SEQ / 32)) * 4096 + 8 * tid; const float* eb = ecg + (size_t)((b * 4 + h) * (SEQ / 32)) * 32 + k4;
    float s[4] = {0.f, 0.f, 0.f, 0.f};
    u32x2 cn[4]; f32x4 ec[4];
#pragma unroll
    for (int j = 0; j < 4; ++j) { cn[j] = *(const u32x2*)(base + (size_t)j * 4096); ec[j] = *(const f32x4*)(eb + j * 32); }
#pragma unroll 1
    for (int c0 = 0; c0 < SEQ / 32; c0 += 4) {
        u32x2 cc[4]; f32x4 ee[4];
#pragma unroll
        for (int j = 0; j < 4; ++j) { cc[j] = cn[j]; ee[j] = ec[j]; }
        if (c0 + 4 < SEQ / 32) {
#pragma unroll
            for (int j = 0; j < 4; ++j) { cn[j] = *(const u32x2*)(base + (size_t)(c0 + 4 + j) * 4096); ec[j] = *(const f32x4*)(eb + (c0 + 4 + j) * 32); } }
#pragma unroll
        for (int j = 0; j < 4; ++j) { u32x2 o; o.x = pk2(s[0], s[1]); o.y = pk2(s[2], s[3]); *(u32x2*)(base + (size_t)(c0 + j) * 4096) = o;
            s[0] = ee[j][0] * s[0] + bflo(cc[j].x); s[1] = ee[j][1] * s[1] + bfhi(cc[j].x); s[2] = ee[j][2] * s[2] + bflo(cc[j].y); s[3] = ee[j][3] * s[3] + bfhi(cc[j].y); } }
}

struct RwkvP { const float *mu, *w0, *w2, *a0, *a2, *g2, *kk, *ka, *rk, *lg, *lb; };
constexpr int RC_AT = 0  , RC_RT = 2048  , RC_ZT = 4096, RC_RBK = 5120, RC_BKT = 6144  , RC_VT4 = 10240  ,
              RC_GC = 12288  , RC_G = 12544  , RC_BON = 14592  , RC_BYTES = 14656, RC_STRIDE = 14848;
constexpr int RC_CHUNKS16 = RC_BYTES / 16;
static_assert((size_t)NB * 4 * (SEQ / 16) * RC_STRIDE <= NEXP * MOEW_E_BYTES, "RWKV records overlay the (not yet converted) MoE weight region");
constexpr int RW_W2T = 0, RW_A2T = 5120, RW_G2T = 10240, RW_MU = 19456  , RW_TW = 23040, RW_AD = 24320, RW_SG = 25600, RW_R = 27904, RW_K = 32000, RW_V = 36096, RW_WL = 40192, RW_AL = 44288,
              RW_G = 48384, RW_KK = 52480, RW_KP = 56576, RW_BON = 60672, RW_GC = 60736, RW_AR = 60992, RW_BK = 65600, RW_BKT = 70208, RW_ZAK = 75328, RW_RBK = 76608, RW_AAB = 77888, RW_TT = 78912  , RW_PAR = 80192  , RW_END = 81472;

__device__ __forceinline__ void rwkv_prep_init(Frame& F, const RwkvP P, int h) {
    const int tid = mytid(F); LAS unsigned char* L = F.lds;
    for (int i = tid; i < 64 * 32; i += NTHREADS) { const int c = i >> 5, j = i & 31;
        *(LAS unsigned short*)(L + RW_W2T + c * 80 + j * 2) = (unsigned short)f2bf(P.w2[j * 256 + h * 64 + c]); *(LAS unsigned short*)(L + RW_A2T + c * 80 + j * 2) = (unsigned short)f2bf(P.a2[j * 256 + h * 64 + c]); }
    for (int i = tid; i < 64 * 64; i += NTHREADS) { const int c = i >> 6, j = i & 63; *(LAS unsigned short*)(L + RW_G2T + c * 144 + j * 2) = (unsigned short)f2bf(P.g2[j * 256 + h * 64 + c]); }
    for (int i = tid; i < 896; i += NTHREADS) ((LAS float*)(L + RW_MU))[i] = P.mu[i];
    if (tid < 320) { const int q = tid >> 6, c = tid & 63; const float* src = q == 0 ? P.w0 : q == 1 ? P.a0 : q == 2 ? P.kk : q == 3 ? P.ka : P.rk; ((LAS float*)(L + RW_PAR))[tid] = src[h * 64 + c]; }
}
__device__ __forceinline__ void rwkv_prep_load(const bf16* Z, int b, int h, int ch, int w, int lane, u32x4 (&cur)[2], u32x4 (&prv)[2]) {
    const int kind = w & 3, p = (w >> 2) * 64 + lane, tt = p >> 3, j = p & 7;
    const int col = (kind < 3 ? ZC + kind * 256 + h * 64 : ZC + 832) + 8 * j;
    const int t = ch * 16 + tt; const bf16* zr = Z + ((size_t)b * SEQ + t) * INW + col;
    cur[0] = *(const u32x4*)zr; prv[0] = (t > 0) ? *(const u32x4*)(zr - INW) : (u32x4){0u, 0u, 0u, 0u};
    if (w < 2) { const int t2 = ch * 16 + (lane >> 2); const bf16* z2 = Z + ((size_t)b * SEQ + t2) * INW + ZC + 768 + w * 32 + 8 * (lane & 3);
        cur[1] = *(const u32x4*)z2; prv[1] = (t2 > 0) ? *(const u32x4*)(z2 - INW) : (u32x4){0u, 0u, 0u, 0u}; }
    else { cur[1] = (u32x4){0u, 0u, 0u, 0u}; prv[1] = cur[1]; }
}
__device__ __forceinline__ void rwkv_prep_item(Frame& F, unsigned char* rec, const RwkvP P, int h, const u32x4 (&cur)[2], const u32x4 (&prv)[2]) {
    const int tid = mytid(F), lane = tid & 63, w = __builtin_amdgcn_readfirstlane(tid >> 6), fr = lane & 15, g = lane >> 4;
    LAS unsigned char* L = F.lds;
#if defined(PROBE_PI)
    unsigned long long tl_ = __builtin_amdgcn_s_memrealtime(), ta_ = 0;
#define PIT(k) do { const unsigned long long tn_ = __builtin_amdgcn_s_memrealtime(); if ((k) == PROBE_PI) ta_ += tn_ - tl_; tl_ = tn_; } while (0)
#else
#define PIT(k) do { } while (0)
#endif
    LAS float *R = (LAS float*)(L + RW_R), *KR = (LAS float*)(L + RW_K), *V = (LAS float*)(L + RW_V), *WL = (LAS float*)(L + RW_WL), *AL = (LAS float*)(L + RW_AL), *G = (LAS float*)(L + RW_G),
              *KK = (LAS float*)(L + RW_KK), *KP = (LAS float*)(L + RW_KP), *BON = (LAS float*)(L + RW_BON), *GC = (LAS float*)(L + RW_GC), *AAB = (LAS float*)(L + RW_AAB), *MU = (LAS float*)(L + RW_MU);
    { const int kind = w & 3, p = (w >> 2) * 64 + lane, tt = p >> 3, j = p & 7; float fc[8], fp[8], x[8]; unpack8(cur[0], fc); unpack8(prv[0], fp);
        const LAS float* mu = MU + (kind < 3 ? kind * 256 + h * 64 : 832) + 8 * j;
#pragma unroll
        for (int e = 0; e < 8; ++e) x[e] = fc[e] + (fp[e] - fc[e]) * mu[e];
        if (kind < 3) { LAS f32x4* d = (LAS f32x4*)((kind == 0 ? R : kind == 1 ? KR : V) + tt * 64 + 8 * j); d[0] = (f32x4){x[0], x[1], x[2], x[3]}; d[1] = (f32x4){x[4], x[5], x[6], x[7]}; }
        else {
#pragma unroll
            for (int e = 0; e < 8; ++e) x[e] = __builtin_amdgcn_rcpf(1.0f + __expf(-x[e]));
            u32x4 o; o.x = pk2(x[0], x[1]); o.y = pk2(x[2], x[3]); o.z = pk2(x[4], x[5]); o.w = pk2(x[6], x[7]); *(LAS u32x4*)(L + RW_SG + tt * 144 + 16 * j) = o; }
        if (w < 2) { const int t2 = lane >> 2, j2 = lane & 3; unpack8(cur[1], fc); unpack8(prv[1], fp); const LAS float* mu2 = MU + 768 + w * 32 + 8 * j2;
#pragma unroll
            for (int e = 0; e < 8; ++e) { x[e] = fc[e] + (fp[e] - fc[e]) * mu2[e]; if (w == 0) x[e] = 2.0f * __builtin_amdgcn_rcpf(1.0f + __expf(-2.0f * x[e])) - 1.0f; }
            u32x4 o; o.x = pk2(x[0], x[1]); o.y = pk2(x[2], x[3]); o.z = pk2(x[4], x[5]); o.w = pk2(x[6], x[7]); *(LAS u32x4*)(L + (w == 0 ? RW_TW : RW_AD) + t2 * 80 + 16 * j2) = o; } }
    BAR(); PIT(0);
    if (w < 4) { f32x4 dw = (f32x4){0.f, 0.f, 0.f, 0.f}, da = dw;
        dw = MFMA16(ldfrag(L + RW_W2T, 80, 16 * w, 0, fr, g), ldfrag(L + RW_TW, 80, 0, 0, fr, g), dw);
        da = MFMA16(ldfrag(L + RW_A2T, 80, 16 * w, 0, fr, g), ldfrag(L + RW_AD, 80, 0, 0, fr, g), da);
        *(LAS f32x4*)(WL + fr * 64 + 16 * w + 4 * g) = dw; *(LAS f32x4*)(AL + fr * 64 + 16 * w + 4 * g) = da; }
    else { const int cb = w - 4; f32x4 dg = (f32x4){0.f, 0.f, 0.f, 0.f};
        dg = MFMA16(ldfrag(L + RW_G2T, 144, 16 * cb, 0, fr, g), ldfrag(L + RW_SG, 144, 0, 0, fr, g), dg);
        dg = MFMA16(ldfrag(L + RW_G2T, 144, 16 * cb, 64, fr, g), ldfrag(L + RW_SG, 144, 0, 64, fr, g), dg);
        *(LAS f32x4*)(G + fr * 64 + 16 * cb + 4 * g) = dg; }
    BAR(); PIT(1);
    { const int t = tid >> 5, c2 = (tid & 31) * 2; const LAS float* PAR = (const LAS float*)(L + RW_PAR) + c2;
        const f32x2 wl = *(const LAS f32x2*)(WL + t * 64 + c2) + *(const LAS f32x2*)(PAR), al = *(const LAS f32x2*)(AL + t * 64 + c2) + *(const LAS f32x2*)(PAR + 64);
        const f32x2 kr = *(const LAS f32x2*)(KR + t * 64 + c2), rr = *(const LAS f32x2*)(R + t * 64 + c2);
        const f32x2 kkw = *(const LAS f32x2*)(PAR + 128), kaw = *(const LAS f32x2*)(PAR + 192), rkw = *(const LAS f32x2*)(PAR + 256);
        f32x2 lw, a, kk, kp; float ss = 0.f, bon = 0.f;
#pragma unroll
        for (int e = 0; e < 2; ++e) { const float wlog = -softplusf_(-wl[e]) - 0.5f; lw[e] = -__expf(wlog); a[e] = __builtin_amdgcn_rcpf(1.0f + __expf(-al[e])); kk[e] = kr[e] * kkw[e]; ss += kk[e] * kk[e];
            kp[e] = kr[e] * (1.0f + (a[e] - 1.0f) * kaw[e]); bon += rr[e] * kp[e] * rkw[e]; }
        ss = red16(ss); bon = red16(bon); ss += __shfl_xor(ss, 16); bon += __shfl_xor(bon, 16);
        const float inv = 1.0f / fmaxf(sqrtf(ss), 1e-12f); kk = kk * inv;
        *(LAS f32x2*)(WL + t * 64 + c2) = lw; *(LAS f32x2*)(AL + t * 64 + c2) = a; *(LAS f32x2*)(KK + t * 64 + c2) = kk; *(LAS f32x2*)(KP + t * 64 + c2) = kp;
        if ((tid & 31) == 0) BON[t] = bon; }
    BAR(); PIT(2);
    { const int t = tid >> 5, c2 = (tid & 31) * 2;
        f32x2 cs = (f32x2){0.f, 0.f}, ct = cs;
#pragma unroll
        for (int s = 0; s < 16; ++s) { cs += *(const LAS f32x2*)(WL + s * 64 + c2); if (s == t) ct = cs; }
        const f32x2 lwt = *(const LAS f32x2*)(WL + t * 64 + c2), a = *(const LAS f32x2*)(AL + t * 64 + c2), kk = *(const LAS f32x2*)(KK + t * 64 + c2), kp = *(const LAS f32x2*)(KP + t * 64 + c2), rr = *(const LAS f32x2*)(R + t * 64 + c2);
        float at[2], rt[2], bb[2], kb[2], bh[2], kh[2];
#pragma unroll
        for (int e = 0; e < 2; ++e) { const float eP = __expf(ct[e] - lwt[e]), eT = __expf(ct[e]), eI = __expf(-ct[e]), eC = __expf(cs[e] - ct[e]); const float bv = kk[e] * a[e];
            at[e] = -kk[e] * eP; rt[e] = rr[e] * eT; bb[e] = bv * eI; kb[e] = kp[e] * eI; bh[e] = bv * eC; kh[e] = kp[e] * eC; }
        *(LAS unsigned*)(L + RW_AR + t * 144 + c2 * 2) = pk2(at[0], at[1]); *(LAS unsigned*)(L + RW_AR + (16 + t) * 144 + c2 * 2) = pk2(rt[0], rt[1]);
        *(LAS unsigned*)(L + RW_BK + t * 144 + c2 * 2) = pk2(bb[0], bb[1]); *(LAS unsigned*)(L + RW_BK + (16 + t) * 144 + c2 * 2) = pk2(kb[0], kb[1]);
#pragma unroll
        for (int e = 0; e < 2; ++e) { *(LAS unsigned short*)(L + RW_BKT + (c2 + e) * 80 + t * 2) = (unsigned short)f2bf(bh[e]); *(LAS unsigned short*)(L + RW_BKT + (c2 + e) * 80 + (16 + t) * 2) = (unsigned short)f2bf(kh[e]); }
        if (t == 0) { GC[c2] = __expf(cs[0]); GC[c2 + 1] = __expf(cs[1]); } }
    BAR(); PIT(3);
    if (w < 4) { const int arow = (w & 1) ? 16 : 0  , brow = (w & 2) ? 16 : 0  ;
        f32x4 d = (f32x4){0.f, 0.f, 0.f, 0.f};
        d = MFMA16(ldfrag(L + RW_BK, 144, arow, 0, fr, g), ldfrag(L + RW_AR, 144, brow, 0, fr, g), d);
        d = MFMA16(ldfrag(L + RW_BK, 144, arow, 64, fr, g), ldfrag(L + RW_AR, 144, brow, 64, fr, g), d);
        const int t = fr; float v[4];
#pragma unroll
        for (int r = 0; r < 4; ++r) { const int s = 4 * g + r; const bool keep = (w < 2) ? (s < t) : (s <= t); v[r] = keep ? d[r] : 0.f; }
        if (w == 0) { AAB[(4 * g + 0) * 16 + t] = v[0]; AAB[(4 * g + 1) * 16 + t] = v[1]; AAB[(4 * g + 2) * 16 + t] = v[2]; AAB[(4 * g + 3) * 16 + t] = v[3]; }
        else { u32x2 o; o.x = pk2(v[0], v[1]); o.y = pk2(v[2], v[3]);
            LAS unsigned char* dst = (w == 1) ? (L + RW_ZAK + t * 80 + (16 + 4 * g) * 2) : (w == 2) ? (L + RW_RBK + t * 80 + (4 * g) * 2) : (L + RW_RBK + t * 80 + (16 + 4 * g) * 2);
            *(LAS u32x2*)dst = o; } }
    BAR(); PIT(4);
    if (w == 7) { if (lane < 16) { float col[16];
#pragma unroll
            for (int t = 0; t < 16; ++t) col[t] = (t == lane) ? 1.0f : 0.f;
#pragma unroll
            for (int s = 0; s < 15; ++s) { const f32x4 a0 = *(const LAS f32x4*)(AAB + s * 16), a1 = *(const LAS f32x4*)(AAB + s * 16 + 4), a2 = *(const LAS f32x4*)(AAB + s * 16 + 8), a3 = *(const LAS f32x4*)(AAB + s * 16 + 12);
                const float as[16] = {a0[0], a0[1], a0[2], a0[3], a1[0], a1[1], a1[2], a1[3], a2[0], a2[1], a2[2], a2[3], a3[0], a3[1], a3[2], a3[3]};
#pragma unroll
                for (int t = s + 1; t < 16; ++t) col[t] += as[t] * col[s]; }
#pragma unroll
            for (int t = 0; t < 16; ++t) *(LAS unsigned short*)(L + RW_TT + t * 80 + lane * 2) = (unsigned short)f2bf(col[t]); }
        LDS_WAIT();
        { const u32x2 lo = *(const LAS u32x2*)(L + RW_TT + fr * 80 + 8 * g), hi = *(const LAS u32x2*)(L + RW_ZAK + fr * 80 + 32 + 8 * g); u32x4 o; o.x = lo.x; o.y = lo.y; o.z = hi.x; o.w = hi.y;
            *(u32x4*)(rec + RC_ZT + fr * 64 + 16 * g) = o; } }
    else {
#pragma unroll 1
        for (int job = w; job < 16; job += 7) {
            if (job < 9) { int src, stride, row0, ka, kb2, dst;
                if (job < 4) { src = RW_AR; stride = 144; row0 = (job >> 1) * 16; ka = 32 * (job & 1); kb2 = ka + 16; dst = (job >> 1 ? RC_RT : RC_AT) + (job & 1) * 1024; }
                else if (job == 4) { src = RW_RBK; stride = 80; row0 = 0; ka = 0; kb2 = 16; dst = RC_RBK; }
                else { src = RW_BKT; stride = 80; row0 = 16 * (job - 5); ka = 0; kb2 = 16; dst = RC_BKT + (job - 5) * 1024; }
                const LAS unsigned char* rp = L + src + (row0 + fr) * stride + 8 * g; const u32x2 lo = *(const LAS u32x2*)(rp + ka * 2), hi = *(const LAS u32x2*)(rp + kb2 * 2);
                u32x4 o; o.x = lo.x; o.y = lo.y; o.z = hi.x; o.w = hi.y; *(u32x4*)(rec + dst + fr * 64 + 16 * g) = o; }
            else if (job < 13) { const int vb = job - 9; const LAS float* vp = V + (4 * g) * 64 + 16 * vb + fr; u32x2 o; o.x = pk2(vp[0], vp[64]); o.y = pk2(vp[128], vp[192]); *(u32x2*)(rec + RC_VT4 + vb * 512 + lane * 8) = o; }
            else { const int p = (job - 13) * 64 + lane;
                if (p < 16) *(f32x4*)(rec + RC_GC + 16 * p) = *(const LAS f32x4*)(GC + 4 * p);
                else if (p < 144) { const int q = p - 16; const f32x4 a = *(const LAS f32x4*)(G + q * 8), c = *(const LAS f32x4*)(G + q * 8 + 4); u32x4 o; o.x = pk2(a[0], a[1]); o.y = pk2(a[2], a[3]); o.z = pk2(c[0], c[1]); o.w = pk2(c[2], c[3]); *(u32x4*)(rec + RC_G + 16 * q) = o; }
                else if (p < 148) { const int q = p - 144; *(f32x4*)(rec + RC_BON + 16 * q) = *(const LAS f32x4*)(BON + 4 * q); } } } }
    BAR(); PIT(5);
#if defined(PROBE_PI)
    if (blockIdx.x == 0 && threadIdx.x == 0) ((unsigned long long*)(F.ws + 32768))[0] += ta_;
#endif
}

constexpr int SB_STRIDE = 16384, SB_NBUF = 7, SB_AHEAD = 5, ST_OB = SB_NBUF * SB_STRIDE  , ST_END = ST_OB + 8192;
static_assert(ST_END <= RING_BYTES && RC_BYTES <= SB_STRIDE, "state pass LDS");
__device__ __forceinline__ void rwkv_state(Frame& F, const unsigned char* recs, bf16* Y, const RwkvP P, int b, int h) {
    const int tid = mytid(F), lane = tid & 63, w = __builtin_amdgcn_readfirstlane(tid >> 6), fr = lane & 15, g = lane >> 4;
    LAS unsigned char* L = F.lds;
    const unsigned char* rbase = recs + (size_t)(b * 4 + h) * (SEQ / 16) * RC_STRIDE;
    const int lt = tid - 256;
    const f32x4 plg = *(const f32x4*)(P.lg + h * 64 + (tid & 15) * 4), plb = *(const f32x4*)(P.lb + h * 64 + (tid & 15) * 4);
    asm volatile("s_waitcnt vmcnt(0)" ::: "memory");
    f32x4 accS[4];
#pragma unroll
    for (int i = 0; i < 4; ++i) accS[i] = (f32x4){0.f, 0.f, 0.f, 0.f};
    constexpr int NCH = SEQ / 16;
#define RW_ISSUE(r) do { const unsigned char* gp_ = rbase + (size_t)(r) * RC_STRIDE + (w * 256 + lane) * 16; LAS unsigned char* lp_ = L + ((r) % SB_NBUF) * SB_STRIDE + w * 4096; \
        _Pragma("unroll") for (int i_ = 0; i_ < 4; ++i_) __builtin_amdgcn_global_load_lds((const unsigned*)(gp_ + i_ * 1024), (LAS unsigned*)(lp_ + i_ * 1024), 16, 0, 0); } while (0)
    if (w < 4) {
#pragma unroll 1
        for (int r = 0; r < SB_AHEAD; ++r) RW_ISSUE(r);
        asm volatile("s_waitcnt vmcnt(16)" ::: "memory"); }
    BAR();
#pragma unroll 1
    for (int c = 0; c <= NCH; ++c) {
        if (w >= 4) {
            if (c >= 1) { const int ce = c - 1; const LAS unsigned char* B = L + (ce % SB_NBUF) * SB_STRIDE; const LAS float* OB = (const LAS float*)(L + ST_OB + (ce & 1) * 4096);
                const int tt = lt >> 4, c4 = (lt & 15) * 4; const f32x4 o = *(const LAS f32x4*)(OB + tt * 64 + c4);
                float s = (o[0] + o[1]) + (o[2] + o[3]); s = red16(s); const float mean = s * (1.0f / 64.0f); const f32x4 d = o - mean;
                float ss = (d[0] * d[0] + d[1] * d[1]) + (d[2] * d[2] + d[3] * d[3]); ss = red16(ss); const float rstd = __builtin_amdgcn_rsqf(ss * (1.0f / 64.0f) + 64e-5f);
                const u32x2 gw = *(const LAS u32x2*)(B + RC_G + tt * 128 + c4 * 2); const float bon = ((const LAS float*)(B + RC_BON))[tt];
                const LAS unsigned short* vq = (const LAS unsigned short*)(B + RC_VT4 + (c4 >> 4) * 512 + ((tt >> 2) * 16 + (c4 & 15)) * 8 + (tt & 3) * 2);
                const float vv[4] = {bf1(vq[0]), bf1(vq[4]), bf1(vq[8]), bf1(vq[12])}, gg[4] = {bflo(gw.x), bfhi(gw.x), bflo(gw.y), bfhi(gw.y)}; float y[4];
#pragma unroll
                for (int e = 0; e < 4; ++e) y[e] = (d[e] * rstd * plg[e] + plb[e] + bon * vv[e]) * gg[e];
                u32x2 wv; wv.x = pk2(y[0], y[1]); wv.y = pk2(y[2], y[3]); *(u32x2*)(Y + ((size_t)b * SEQ + ce * 16 + tt) * DM + 512 + h * 64 + c4) = wv; }
        } else {
            if (c + SB_AHEAD < NCH) RW_ISSUE(c + SB_AHEAD);
            if (c < NCH) { const int vb = w; const LAS unsigned char* B = L + (c % SB_NBUF) * SB_STRIDE; LAS float* OB = (LAS float*)(L + ST_OB + (c & 1) * 4096); const int fo = fr * 64 + 16 * g;
                const bf16x8 at0 = *(const LAS bf16x8*)(B + RC_AT + fo), at1 = *(const LAS bf16x8*)(B + RC_AT + 1024 + fo), rt0 = *(const LAS bf16x8*)(B + RC_RT + fo), rt1 = *(const LAS bf16x8*)(B + RC_RT + 1024 + fo);
                const bf16x8 zt = *(const LAS bf16x8*)(B + RC_ZT + fo), rbk = *(const LAS bf16x8*)(B + RC_RBK + fo); const u32x2 v4 = *(const LAS u32x2*)(B + RC_VT4 + vb * 512 + lane * 8);
                u32x4 sw0, sw1; sw0.x = pk2(accS[0][0], accS[0][1]); sw0.y = pk2(accS[0][2], accS[0][3]); sw0.z = pk2(accS[1][0], accS[1][1]); sw0.w = pk2(accS[1][2], accS[1][3]);
                sw1.x = pk2(accS[2][0], accS[2][1]); sw1.y = pk2(accS[2][2], accS[2][3]); sw1.z = pk2(accS[3][0], accS[3][1]); sw1.w = pk2(accS[3][2], accS[3][3]);
                const bf16x8 s0 = __builtin_bit_cast(bf16x8, sw0), s1 = __builtin_bit_cast(bf16x8, sw1);
                f32x4 y = (f32x4){0.f, 0.f, 0.f, 0.f}, accO = y;
                y = MFMA16(at0, s0, y); y = MFMA16(at1, s1, y); accO = MFMA16(rt0, s0, accO); accO = MFMA16(rt1, s1, accO);
                u32x4 bw; bw.x = 0u; bw.y = 0u; bw.z = v4.x; bw.w = v4.y; y = MFMA16(zt, __builtin_bit_cast(bf16x8, bw), y);
                bw.x = pk2(y[0], y[1]); bw.y = pk2(y[2], y[3]); bw.z = 0u; bw.w = 0u; f32x4 u = (f32x4){0.f, 0.f, 0.f, 0.f}; u = MFMA16(zt, __builtin_bit_cast(bf16x8, bw), u);
                bw.x = pk2(u[0], u[1]); bw.y = pk2(u[2], u[3]); bw.z = v4.x; bw.w = v4.y; const bf16x8 uv = __builtin_bit_cast(bf16x8, bw);
                accO = MFMA16(rbk, uv, accO);
#pragma unroll
                for (int r = 0; r < 4; ++r) OB[(4 * g + r) * 64 + 16 * vb + fr] = accO[r];
#pragma unroll
                for (int kb = 0; kb < 4; ++kb) { const f32x4 gc = *(const LAS f32x4*)(B + RC_GC + (16 * kb + 4 * g) * 4); accS[kb] = accS[kb] * gc; accS[kb] = MFMA16(*(const LAS bf16x8*)(B + RC_BKT + kb * 1024 + fo), uv, accS[kb]); } }
            if (c + SB_AHEAD < NCH) asm volatile("s_waitcnt vmcnt(16)" ::: "memory"); else asm volatile("s_waitcnt vmcnt(0)" ::: "memory");
        }
        BAR();
    }
#undef RW_ISSUE
}

__device__ __forceinline__ void moe_route(Frame& F, const float* hres, const float* gffn, const float* router) {
    const int tid = mytid(F), lane = tid & 63, wave = __builtin_amdgcn_readfirstlane(tid >> 6); (void)lane; (void)wave;
    unsigned char* rt = F.ws + WS_RT;
    int* tope = (int*)(rt + RT_TOPE); float* gate = (float*)(rt + RT_GATE); int* rank = (int*)(rt + RT_RANK); float* rstd = (float*)(rt + RT_RSTD); int* hist = (int*)(rt + RT_HIST); int* rowtok = (int*)(rt + RT_ROWTOK);
    LAS float* RW = (LAS float*)F.lds;
    LAS int* LH = (LAS int*)(F.lds + 32768);
    for (int i = tid; i < 8192; i += NTHREADS) RW[i] = router[i];
    if (tid < 16) LH[tid] = 0;
    for (int i = F.blk * NTHREADS + tid; i < 2 * MOE_ROWS; i += F.G * NTHREADS) rowtok[i] = -1;
    __syncthreads();
    const int tpb = NTOK / F.G;
    for (int i = wave; i < tpb; i += NWAVES) { const int t = F.blk * tpb + i;
        const f32x4* hr = (const f32x4*)(hres + (size_t)t * DM) + lane; f32x4 v[4]; float ss = 0.f;
#pragma unroll
        for (int j = 0; j < 4; ++j) { v[j] = hr[64 * j]; ss += (v[j][0] * v[j][0] + v[j][1] * v[j][1]) + (v[j][2] * v[j][2] + v[j][3] * v[j][3]); }
        ss = wave_sum(ss); const float rs = __builtin_amdgcn_rsqf(ss * (1.0f / DM) + NORM_EPS);
        float lg[8];
#pragma unroll
        for (int e = 0; e < 8; ++e) lg[e] = 0.f;
#pragma unroll
        for (int j = 0; j < 4; ++j) { const f32x4 gv = *((const f32x4*)gffn + 64 * j + lane);
#pragma unroll
            for (int c = 0; c < 4; ++c) { const int k = 256 * j + 4 * lane + c; const float xn = v[j][c] * rs * gv[c]; const f32x4 r0 = *(const LAS f32x4*)(RW + k * 8), r1 = *(const LAS f32x4*)(RW + k * 8 + 4);
                lg[0] += xn * r0[0]; lg[1] += xn * r0[1]; lg[2] += xn * r0[2]; lg[3] += xn * r0[3]; lg[4] += xn * r1[0]; lg[5] += xn * r1[1]; lg[6] += xn * r1[2]; lg[7] += xn * r1[3]; } }
#pragma unroll
        for (int e = 0; e < 8; ++e) lg[e] = wave_sum(lg[e]);
        int i1 = 0; float m1 = lg[0];
#pragma unroll
        for (int e = 1; e < 8; ++e) if (lg[e] > m1) { m1 = lg[e]; i1 = e; }
        int i2 = -1; float m2 = -3.0e38f;
#pragma unroll
        for (int e = 0; e < 8; ++e) if (e != i1 && lg[e] > m2) { m2 = lg[e]; i2 = e; }
        if (lane == 0) { const float g1 = 1.0f / (1.0f + __expf(m2 - m1));
            const int r1 = atomicAdd((int*)&LH[i1], 1), r2 = atomicAdd((int*)&LH[8 + i2], 1);
            tope[2 * t] = i1; tope[2 * t + 1] = i2; gate[2 * t] = g1; gate[2 * t + 1] = 1.0f - g1; rank[2 * t] = r1; rank[2 * t + 1] = r2; rstd[t] = rs; }
    }
    __syncthreads();
    if (tid < 16) hist[F.blk * 16 + tid] = LH[tid];
}
__device__ __forceinline__ void moe_gather(Frame& F, int slot, const bf16* hb, bf16* asort) {
    const int tid = mytid(F), lane = tid & 63, wave = __builtin_amdgcn_readfirstlane(tid >> 6); (void)lane; (void)wave;
    unsigned char* rt = F.ws + WS_RT;
    const int* tope = (const int*)(rt + RT_TOPE); const float* gate = (const float*)(rt + RT_GATE); const int* rank = (const int*)(rt + RT_RANK); const float* rstd = (const float*)(rt + RT_RSTD); const int* hist = (const int*)(rt + RT_HIST);
    int* rowtok = (int*)(rt + RT_ROWTOK) + slot * MOE_ROWS; float* rowgate = (float*)(rt + RT_ROWGATE) + slot * MOE_ROWS; float* rowrstd = (float*)(rt + RT_ROWRSTD) + slot * MOE_ROWS;
    int* tilee = (int*)(rt + RT_TILEE) + slot * 256; int* ntiles = (int*)(rt + RT_NTILES);
    LAS int* BASE = (LAS int*)(F.lds + 40960);
    LAS int* TOT = BASE + 8;
    __syncthreads();
    LAS int* HL = (LAS int*)(F.lds + 49152);
    for (int i = tid; i < F.G * 8; i += NTHREADS) HL[i] = hist[(i >> 3) * 16 + slot * 8 + (i & 7)];
    __syncthreads();
    { const int e = tid & 7, part = tid >> 3;
        const int per = (F.G + 63) / 64; int sb = 0, st = 0;
        for (int j = 0; j < per; ++j) { const int bb = part * per + j; if (bb < F.G) { const int c = HL[bb * 8 + e]; st += c; if (bb < F.blk) sb += c; } }
        LAS int* PB = (LAS int*)(F.lds + 49152 + 16384); PB[tid] = sb; PB[512 + tid] = st; }
    __syncthreads();
    if (tid < 8) { const LAS int* PB = (const LAS int*)(F.lds + 49152 + 16384); int before = 0, tot = 0;
        for (int p = 0; p < 64; ++p) { before += PB[p * 8 + tid]; tot += PB[512 + p * 8 + tid]; }
        BASE[tid] = before; TOT[tid] = tot; }
    __syncthreads();
    if (tid == 0) { int ps = 0, nt = 0;
        for (int e = 0; e < 8; ++e) { const int tl = (TOT[e] + 255) >> 8; BASE[e] += ps; if (F.blk == 0) for (int i = 0; i < tl; ++i) tilee[nt + i] = e; ps += tl * 256; nt += tl; }
        if (F.blk == 0) ntiles[slot] = nt; }
    __syncthreads();
    const int tpb = NTOK / F.G;
    for (int i = wave; i < tpb; i += NWAVES) { const int t = F.blk * tpb + i; const int e = tope[2 * t + slot]; const int dest = BASE[e] + rank[2 * t + slot];
        if (lane == 0) { rowtok[dest] = t; rowgate[dest] = gate[2 * t + slot]; rowrstd[dest] = rstd[t]; }
        const u32x4* s = (const u32x4*)(hb + (size_t)t * DM) + lane; u32x4* d = (u32x4*)(asort + (size_t)dest * DM) + lane;
        const u32x4 a = s[0], c = s[64]; d[0] = a; d[64] = c; }
}


__device__ __forceinline__ void mk_publish(unsigned* ctr) {
    asm volatile("s_waitcnt vmcnt(0)" ::: "memory");
    __syncthreads();
    if (threadIdx.x == 0) { __builtin_amdgcn_fence(__ATOMIC_RELEASE, "agent"); asm volatile("s_waitcnt vmcnt(0)" ::: "memory"); (void)__hip_atomic_fetch_add(ctr, 1u, __ATOMIC_RELAXED, __HIP_MEMORY_SCOPE_AGENT); }
}
__device__ __forceinline__ void mk_wait(unsigned* ctr, unsigned need) {
    if (threadIdx.x == 0) { unsigned sp = 0;
        while (__hip_atomic_load(ctr, __ATOMIC_RELAXED, __HIP_MEMORY_SCOPE_AGENT) < need) { __builtin_amdgcn_s_sleep(4); if (++sp > (1u << 24)) break; }
        __builtin_amdgcn_fence(__ATOMIC_ACQUIRE, "agent"); asm volatile("s_waitcnt vmcnt(0)" ::: "memory"); }
    __syncthreads();
}

#ifndef MK_PER_PHASE
#define MK_PER_PHASE 0
#endif
constexpr int N_PHASES = 17;
__global__ void __launch_bounds__(NTHREADS, 2) mk_fwd(Params prm) {
    extern __shared__ __attribute__((aligned(16))) unsigned char lds_raw[];
    Frame F;
    F.lds = (LAS unsigned char*)lds_raw;
    F.blk = blockIdx.x; F.G = gridDim.x; F.out = prm.out; F.ws = prm.ws; F.wv = __builtin_amdgcn_readfirstlane(threadIdx.x >> 6);
    volatile LAS unsigned* MISC = (volatile LAS unsigned*)(F.lds + MISC_OFF);
    for (int u = threadIdx.x; u < (LDS_BYTES - LDSCTL_OFF) / 4; u += NTHREADS) ((LAS unsigned*)(F.lds + LDSCTL_OFF))[u] = 0u;
    __syncthreads();
    if (threadIdx.x == 0) { LAS unsigned long long* tab = (LAS unsigned long long*)(F.lds + PTAB_OFF);
#pragma unroll
        for (int i_ = 0; i_ < 33; ++i_) tab[i_] = (unsigned long long)prm.in[i_]; }
    __syncthreads();
    const int lo = prm.ph_lo, hi = prm.ph_hi;
    unsigned* ctl = (unsigned*)(F.ws + WS_CTL);
    XcdBarrier bar; bar.bar = ctl + CW_BAR; bar.x = 0; bar.st = nullptr;
    if (hi - lo > 1) bar = xcd_barrier_post(ctl + CW_BAR, MISC + 8);
    unsigned char* ws = F.ws;
    bf16* hb = (bf16*)(ws + WS_HB); bf16* z = (bf16*)(ws + WS_Z); bf16* act = (bf16*)(ws + WS_Z); bf16* y = (bf16*)(ws + WS_Y); bf16* asort = (bf16*)(ws + WS_Y);
    float* ssq = (float*)(ws + WS_SSQ);
    bf16* opart = (bf16*)F.out; float* lse = (float*)((unsigned char*)F.out + 48 * MiB);
    unsigned char* rt = ws + WS_RT;
#define IN(k) (lo <= (k) && (k) < hi)
#ifndef PROBE_MASK
#define PROBE_MASK 0
#endif
#if PROBE_MASK
#define STAMP(k) do { if (blockIdx.x == 0 && threadIdx.x == 0) ((volatile LAS unsigned long long*)(F.lds + LDSCTL_OFF + 2048))[k] = __builtin_amdgcn_s_memrealtime(); } while (0)
#else
#define STAMP(k) do { } while (0)
#endif
#define SEAM(k) do { if (IN(k) && IN((k) + 1)) xcd_barrier(bar); STAMP((k) + 1); } while (0)

    STAMP(0);
    if (IN(0)) p0_prologue(F, 0);
    SEAM(0);
#pragma unroll 1
    for (int layer = 0; layer < 2; ++layer) {
        const int pb = layer == 0 ? 1 : 7;
        if (IN(pb)) {
            pg8::Gemm g{hb, (const bf16*)(ws + WS_WIN) + (size_t)layer * NPADW * DM, NTOK, NPADW, DM, F.wv}; pg8::StaticOrder S; S.init(NTOK / 256, NPADW / 256, F.G, F.blk);
            pg8::EpiZ E{z, INW, INW, ssq};
            pg8::gemm_phase<pg8::EpiZ, pg8::StaticOrder, true, true>(F.lds, g, S, E);
        }
        SEAM(pb);
#if defined(PROBE_SUB)
        const unsigned long long tsub0 = __builtin_amdgcn_s_memrealtime();
#define PSUB(cls, t0) do { if (threadIdx.x == 0) ((unsigned long long*)(F.ws + 32768))[layer * 4 + (cls)] = __builtin_amdgcn_s_memrealtime() - (t0); } while (0)
#else
#define PSUB(cls, t0) do { } while (0)
#endif
        unsigned char* recs = ws + WS_MOEW;
        unsigned char* gcon = ws + WS_MOEW + (size_t)NB * 4 * (SEQ / 16) * RC_STRIDE;
        if (IN(pb + 1)) {
            const int wi = F.blk, nw = F.G;
            { const RwkvP RP{inptr(F, IN_MU) + layer * 896, inptr(F, IN_W0) + layer * 256, inptr(F, IN_W2) + layer * 32 * 256, inptr(F, IN_A0) + layer * 256, inptr(F, IN_A2) + layer * 32 * 256, inptr(F, IN_G2) + layer * 64 * 256,
                             inptr(F, IN_KK) + layer * 256, inptr(F, IN_KA) + layer * 256, inptr(F, IN_RK) + layer * 256, inptr(F, IN_RLG) + layer * 256, inptr(F, IN_RLB) + layer * 256};
                const int tid_ = mytid(F), lane_ = tid_ & 63, w_ = __builtin_amdgcn_readfirstlane(tid_ >> 6);
#pragma unroll 1
                for (int h = 0; h < 4; ++h) {
                    rwkv_prep_init(F, RP, h); BAR();
                    u32x4 cur[2], prv[2], ncur[2], nprv[2];
#pragma unroll
                    for (int q = 0; q < 2; ++q) { cur[q] = (u32x4){0u, 0u, 0u, 0u}; prv[q] = cur[q]; ncur[q] = cur[q]; nprv[q] = cur[q]; }
                    if (wi < 2048) rwkv_prep_load(z, wi >> 8, h, wi & 255, w_, lane_, cur, prv);
#pragma unroll 1
                    for (int it = wi; it < 2048; it += nw) { const int nx = it + nw;
                        if (nx < 2048) rwkv_prep_load(z, nx >> 8, h, nx & 255, w_, lane_, ncur, nprv);
                        rwkv_prep_item(F, recs + (size_t)(((it >> 8) * 4 + h) * 256 + (it & 255)) * RC_STRIDE, RP, h, cur, prv);
#pragma unroll
                        for (int q = 0; q < 2; ++q) { cur[q] = ncur[q]; prv[q] = nprv[q]; } }
                    BAR(); } }
            attn_qknorm(F, z, inptr(F, IN_QG) + layer * 64, inptr(F, IN_KG) + layer * 64);
            for (int item = wi; item < 512; item += nw) conv_item(F, z, y, inptr(F, IN_CW) + layer * 31 * 256, inptr(F, IN_CB) + layer * 256, inptr(F, IN_CLG) + layer * 256, inptr(F, IN_CLB) + layer * 256, item);
            gla_items<0>(F, z, gcon, (float*)(ws + WS_GLAEC), y, inptr(F, IN_GG2) + layer * 16 * 128, inptr(F, IN_GGB) + layer * 128, inptr(F, IN_GNG) + layer * 64, wi, nw);
        }
        SEAM(pb + 1);
        if (IN(pb + 2)) {
            unsigned* cA = ctl + 12288 + layer * 128;
            unsigned* cB = ctl + 12288 + layer * 128 + 64;
            if (F.blk < 32) {
                const RwkvP RP{inptr(F, IN_MU) + layer * 896, inptr(F, IN_W0) + layer * 256, inptr(F, IN_W2) + layer * 32 * 256, inptr(F, IN_A0) + layer * 256, inptr(F, IN_A2) + layer * 32 * 256, inptr(F, IN_G2) + layer * 64 * 256,
                               inptr(F, IN_KK) + layer * 256, inptr(F, IN_KA) + layer * 256, inptr(F, IN_RK) + layer * 256, inptr(F, IN_RLG) + layer * 256, inptr(F, IN_RLB) + layer * 256};
                rwkv_state(F, recs, y, RP, F.blk >> 2, F.blk & 3);
            } else {
                const int wi = F.blk - 32, nw = F.G - 32;
                if (F.blk < 64) { gla_scan(F, gcon, (const float*)(ws + WS_GLAEC), (F.blk - 32) >> 2, (F.blk - 32) & 3); mk_publish(cA); }
                { const int full = 3072 / nw, rem = 3072 - full * nw;
                    for (int rd = 0; rd < full; ++rd) attn_tile(F.lds, z, opart, lse, inptr(F, IN_RELB), rd * nw + wi, mytid(F));
                    if (wi >= 32 && wi - 32 < rem) attn_tile(F.lds, z, opart, lse, inptr(F, IN_RELB), full * nw + wi - 32, mytid(F)); }
                mk_publish(cB);
                mk_wait(cA, 32u);
                gla_items<1>(F, z, gcon, (float*)(ws + WS_GLAEC), y, inptr(F, IN_GG2) + layer * 16 * 128, inptr(F, IN_GGB) + layer * 128, inptr(F, IN_GNG) + layer * 64, wi, nw);
                mk_wait(cB, (unsigned)nw);
                attn_merge(F, opart, lse, y, wi, nw);
            }
        }
        SEAM(pb + 2);
        if (IN(pb + 3)) {
            pg8::Gemm g{y, (const bf16*)(ws + WS_WOUT) + (size_t)layer * DM * DM, NTOK, DM, DM, F.wv}; pg8::StaticOrder S; S.init(NTOK / 256, DM / 256, F.G, F.blk);
            pg8::EpiRes E{layer == 0 ? inptr(F, IN_X) : (const float*)nullptr, hb, layer == 0 ? (float*)nullptr : F.out, hb, ssq};
            pg8::gemm_phase<pg8::EpiRes, pg8::StaticOrder, true, true>(F.lds, g, S, E);
        }
        SEAM(pb + 3);
        if (layer == 0) {
            if (IN(5)) {
                pg8::Gemm g{hb, (const bf16*)(ws + WS_WGU), NTOK, 2 * DFF, DM, F.wv}; pg8::StaticOrder S; S.init(NTOK / 256, 2 * DFF / 256, F.G, F.blk);
                pg8::EpiSwiGLU<false> E{act, ssq, nullptr};
                pg8::gemm_phase<pg8::EpiSwiGLU<false>, pg8::StaticOrder, true, true>(F.lds, g, S, E);
            }
            SEAM(5);
            if (IN(6)) {
                pg8::Gemm g{act, (const bf16*)(ws + WS_WD), NTOK, DM, DFF, F.wv}; pg8::StaticOrder S; S.init(NTOK / 256, DM / 256, F.G, F.blk);
                pg8::EpiRes E{nullptr, hb, nullptr, hb, ssq};
                pg8::gemm_phase<pg8::EpiRes, pg8::StaticOrder, true, true>(F.lds, g, S, E);
            }
            SEAM(6);
        }
    }
    if (IN(11)) { moe_route(F, F.out, inptr(F, IN_FFNG) + DM, inptr(F, IN_ROUTER)); __syncthreads(); p0_prologue(F, 1); }
    SEAM(11);
    if (IN(12)) moe_gather(F, 0, hb, asort);
    SEAM(12);
#pragma unroll 1
    for (int slot = 0; slot < 2; ++slot) {
        const int pg = 13 + 2 * slot;
        const int* tilee = (const int*)(rt + RT_TILEE) + slot * 256;
        if (IN(pg)) {
            const int nt = __builtin_amdgcn_readfirstlane(((const int*)(rt + RT_NTILES))[slot]);
            pg8::Gemm g{asort, (const bf16*)(ws + WS_MOEW), nt * 256, 2 * DFF, DM, F.wv}; pg8::StaticOrder S; S.init(nt, 2 * DFF / 256, F.G, F.blk, tilee, MOEW_E_BYTES);
            pg8::EpiSwiGLU<true> E{act, nullptr, (const float*)(rt + RT_ROWRSTD) + slot * MOE_ROWS};
            pg8::gemm_phase<pg8::EpiSwiGLU<true>, pg8::StaticOrder, true, true>(F.lds, g, S, E);
        }
        SEAM(pg);
        if (IN(pg + 1)) {
            const int nt = __builtin_amdgcn_readfirstlane(((const int*)(rt + RT_NTILES))[slot]);
            pg8::Gemm g{act, (const bf16*)(ws + WS_MOEW + MOEW_GU_BYTES), nt * 256, DM, DFF, F.wv}; pg8::StaticOrder S; S.init(nt, DM / 256, F.G, F.blk, tilee, MOEW_E_BYTES);
            pg8::EpiMoeDown E{F.out, (const int*)(rt + RT_ROWTOK) + slot * MOE_ROWS, (const float*)(rt + RT_ROWGATE) + slot * MOE_ROWS};
            pg8::gemm_phase<pg8::EpiMoeDown, pg8::StaticOrder, true, true>(F.lds, g, S, E);
            if (slot == 0) moe_gather(F, 1, hb, asort);
        }
        if (slot == 0) SEAM(pg + 1);
    }
#if PROBE_MASK
    __syncthreads();
    if (blockIdx.x == 0 && threadIdx.x == 0) { STAMP(N_PHASES); volatile LAS unsigned long long* ts = (volatile LAS unsigned long long*)(F.lds + LDSCTL_OFF + 2048); unsigned long long tot = 0;
        for (int k = 0; k < N_PHASES; ++k) if ((PROBE_MASK >> k) & 1) tot += ts[k + 1] - ts[k];
#if defined(PROBE_SUB)
        tot = (PROBE_SUB == 0) ? ((volatile unsigned long long*)(F.ws + 32768))[0] : ((volatile unsigned long long*)(F.ws + 32768))[PROBE_SUB] + ((volatile unsigned long long*)(F.ws + 32768))[4 + PROBE_SUB];
#endif
        const unsigned long long t0 = __builtin_amdgcn_s_memrealtime(); while (__builtin_amdgcn_s_memrealtime() - t0 < tot) __builtin_amdgcn_s_sleep(8); }
#endif
#undef IN
#undef SEAM
}

extern "C" void kernel_launch(void* const* d_in, const int* in_sizes, int n_in, void* d_out, int out_size, void* d_ws, size_t ws_size, hipStream_t stream) {
    static int grid = 0;
    if (grid == 0) {
        if (n_in != 33 || out_size != NTOK * DM || ws_size < WS_TOTAL) { fprintf(stderr, "kernel_launch: unexpected problem (n_in %d out %d ws %zu)\n", n_in, out_size, ws_size); grid = -1; return; }
        int dev = 0, cus = 0;
        if (hipGetDevice(&dev) != hipSuccess || hipDeviceGetAttribute(&cus, hipDeviceAttributeMultiprocessorCount, dev) != hipSuccess) { grid = -1; return; }
        if (hipFuncSetAttribute((const void*)mk_fwd, hipFuncAttributeMaxDynamicSharedMemorySize, LDS_BYTES) != hipSuccess) { fprintf(stderr, "kernel_launch: hipFuncSetAttribute failed\n"); grid = -1; return; }
        (void)hipGetLastError();
        grid = cus;
        if (grid != 256) fprintf(stderr, "kernel_launch: %d CUs (built for 256)\n", grid);
    }
    if (grid < 0) return;
    (void)hipMemsetAsync((char*)d_ws + WS_CTL, 0, CTL_ZERO_BYTES, stream);
    Params p{};
    for (int i = 0; i < 33; ++i) p.in[i] = (const float*)d_in[i];
    p.out = (float*)d_out; p.ws = (unsigned char*)d_ws;
#if MK_PER_PHASE
    for (int k = 0; k < N_PHASES; ++k) { p.ph_lo = k; p.ph_hi = k + 1; hipLaunchKernelGGL(mk_fwd, dim3(grid), dim3(NTHREADS), LDS_BYTES, stream, p); }
#else
    p.ph_lo = 0; p.ph_hi = N_PHASES;
    hipLaunchKernelGGL(mk_fwd, dim3(grid), dim3(NTHREADS), LDS_BYTES, stream, p);
#endif
}
```

```cpp
#include <hip/hip_runtime.h>
#include <cstdio>
#include <cstdint>

#define LAS __attribute__((address_space(3)))
#define GAS __attribute__((address_space(1)))
typedef unsigned short bf16;
typedef short bf16x8 __attribute__((ext_vector_type(8)));
typedef short s16x4 __attribute__((ext_vector_type(4)));
typedef float f32x4 __attribute__((ext_vector_type(4)));
typedef float f32x2 __attribute__((ext_vector_type(2)));
typedef unsigned u32x4 __attribute__((ext_vector_type(4)));
typedef unsigned u32x2 __attribute__((ext_vector_type(2)));

constexpr int DM = 1024, NB = 8, SEQ = 4096, NTOK = NB * SEQ, INW = 2960, NPADW = 3072, DFF = 2816, NEXP = 8;
constexpr int ZA = 0, ZB = 768, ZC = 1280, ZD = 2176;
constexpr float NORM_EPS = 1e-6f;
constexpr int MOE_ROWS = NTOK + NEXP * 256;

constexpr size_t MiB = 1u << 20;
constexpr size_t WS_CTL = 0, CTL_ZERO_BYTES = 64 * 1024;
constexpr size_t WS_WIN = 1 * MiB;
constexpr size_t WS_WOUT = 13 * MiB;
constexpr size_t WS_WGU = 17 * MiB;
constexpr size_t WS_WD = 28 * MiB;
constexpr size_t WS_SSQ = 34 * MiB;
constexpr size_t WS_RT = 36 * MiB;
constexpr size_t WS_HB = 40 * MiB;
constexpr size_t WS_Z = 104 * MiB;
constexpr size_t WS_Y = 297 * MiB;
constexpr size_t WS_MOEW = 367 * MiB;
constexpr size_t WS_END = 499 * MiB;
constexpr size_t WS_GLAEC = 499 * MiB;
constexpr size_t WS_TOTAL = 500 * MiB;
constexpr size_t MOEW_GU_BYTES = (size_t)2 * DFF * DM * 2, MOEW_D_BYTES = (size_t)DM * DFF * 2, MOEW_E_BYTES = MOEW_GU_BYTES + MOEW_D_BYTES;
static_assert(WS_Z + (size_t)MOE_ROWS * DFF * 2 <= WS_Y && WS_Y + (size_t)MOE_ROWS * DM * 2 <= WS_MOEW && WS_MOEW + NEXP * MOEW_E_BYTES <= WS_END, "ws map");
constexpr size_t WS_OP = WS_HB;
constexpr size_t WS_LSE = WS_HB + 48 * MiB;
constexpr size_t RT_TOPE = 0;
constexpr size_t RT_GATE = RT_TOPE + (size_t)NTOK * 8;
constexpr size_t RT_RANK = RT_GATE + (size_t)NTOK * 8;
constexpr size_t RT_RSTD = RT_RANK + (size_t)NTOK * 8;
constexpr size_t RT_HIST = RT_RSTD + (size_t)NTOK * 4;
constexpr size_t RT_ROWTOK = RT_HIST + 256 * 16 * 4;
constexpr size_t RT_ROWGATE = RT_ROWTOK + (size_t)2 * MOE_ROWS * 4;
constexpr size_t RT_ROWRSTD = RT_ROWGATE + (size_t)2 * MOE_ROWS * 4;
constexpr size_t RT_TILEE = RT_ROWRSTD + (size_t)2 * MOE_ROWS * 4;
constexpr size_t RT_NTILES = RT_TILEE + 2 * 256 * 4;
static_assert(RT_NTILES + 64 <= 4 * MiB, "routing arrays");

constexpr int CW_BAR = 1024;

constexpr int RING_BYTES = 131072, LDSCTL_OFF = RING_BYTES, MISC_OFF = LDSCTL_OFF + 320, LDS_BYTES = 147456;
constexpr int NWAVES = 8, NTHREADS = 512;

#define LDS_WAIT() asm volatile("s_waitcnt lgkmcnt(0)" ::: "memory")
#define VM_WAIT() asm volatile("s_waitcnt vmcnt(0)" ::: "memory")
#define BAR() do { asm volatile("s_waitcnt lgkmcnt(0)" ::: "memory"); __builtin_amdgcn_s_barrier(); asm volatile("" ::: "memory"); } while (0)
__device__ __forceinline__ unsigned f2bf(float f) { unsigned u = __builtin_bit_cast(unsigned, f); return (u + 0x7fffu + ((u >> 16) & 1u)) >> 16; }
typedef __bf16 bf16x2_hw __attribute__((ext_vector_type(2)));
__device__ __forceinline__ unsigned pk2(float lo, float hi) { const f32x2 v = {lo, hi}; const bf16x2_hw b = __builtin_convertvector(v, bf16x2_hw); return __builtin_bit_cast(unsigned, b); }
__device__ __forceinline__ float bflo(unsigned w) { return __builtin_bit_cast(float, w << 16); }
__device__ __forceinline__ float bfhi(unsigned w) { return __builtin_bit_cast(float, w & 0xffff0000u); }
__device__ __forceinline__ float bf1(bf16 b) { return __builtin_bit_cast(float, (unsigned)b << 16); }
__device__ __forceinline__ float wave_sum(float v) {
#pragma unroll
    for (int o = 1; o < 64; o <<= 1) v += __shfl_xor(v, o);
    return v;
}
#define DPP_ADD(v, ctrl) ((v) + __builtin_bit_cast(float, __builtin_amdgcn_update_dpp(0, __builtin_bit_cast(int, (v)), (ctrl), 0xf, 0xf, true)))
__device__ __forceinline__ float red8(float v) { v = DPP_ADD(v, 0xB1); v = DPP_ADD(v, 0x4E); v = DPP_ADD(v, 0x141); return v; }
__device__ __forceinline__ float red16(float v) { v = DPP_ADD(v, 0xB1); v = DPP_ADD(v, 0x4E); v = DPP_ADD(v, 0x141); v = DPP_ADD(v, 0x140); return v; }
__device__ __forceinline__ float sigmoidf_(float x) { return 1.0f / (1.0f + __expf(-x)); }
__device__ __forceinline__ float siluf_(float x) { return x / (1.0f + __expf(-x)); }
__device__ __forceinline__ float softplusf_(float x) { return fmaxf(x, 0.f) + __logf(1.0f + __expf(-fabsf(x))); }
__device__ __forceinline__ float tanhf_(float x) { const float e = __expf(2.0f * x); return 1.0f - 2.0f / (e + 1.0f); }
__device__ __forceinline__ void unpack8(const u32x4 w, float (&f)[8]) {
    f[0] = bflo(w.x); f[1] = bfhi(w.x); f[2] = bflo(w.y); f[3] = bfhi(w.y); f[4] = bflo(w.z); f[5] = bfhi(w.z); f[6] = bflo(w.w); f[7] = bfhi(w.w);
}

namespace pg8 {
#define PG8_LAS __attribute__((address_space(3)))
typedef unsigned short bf16_t;
constexpr int BM = 256, BK = 64, HALF = 128, HTB = HALF * BK * 2  , STAGE_BYTES = 8 * HTB, NXCD = 8, WGM = 8;

__host__ __device__ __forceinline__ int lds_byte(int r, int c) { const int st = (r >> 4) * 2 + (c >> 5), rr = r & 15, cc = c & 31, ob = rr * 64 + cc * 2; return st * 1024 + (ob ^ (((ob >> 9) & 1) << 5)); }
__host__ __device__ __forceinline__ void stage_rc(int b, int& R, int& C) { const int st = b / 1024, sb = b % 1024, swz = sb ^ (((sb >> 9) & 1) << 5); R = (st >> 1) * 16 + swz / 64; C = (st & 1) * 32 + (swz % 64) / 2; }
__host__ __device__ __forceinline__ int perm32(int rho) { const int n = rho >> 4, i = rho & 15; return 8 * (i >> 2) + 4 * n + (i & 3); }

struct Unit { int pm, pn; };
struct Gemm { const bf16_t* A; const bf16_t* Bt; int M, N, K, wv; };

struct StaticOrder {
    int nM, nN, nwg, G, c; const int* tile_e; size_t estride;
    __device__ void init(int nM_, int nN_, int G_, int c_, const int* te = nullptr, size_t es = 0) { nM = nM_; nN = nN_; nwg = nM * nN; G = G_; c = c_; tile_e = te; estride = es; }
    __device__ bool next(int i, Unit& u) const {
        const long L = (long)i * G + c; if (L >= nwg) return false;
        int wgid = (int)L; { const int q = nwg / NXCD, r = nwg % NXCD, xcd = wgid % NXCD, off = wgid / NXCD; wgid = (xcd < r ? xcd * (q + 1) : r * (q + 1) + (xcd - r) * q) + off; }
        const int nig = WGM * nN, gid = wgid / nig, fm = gid * WGM, gsz = (nM - fm) < WGM ? (nM - fm) : WGM;
        u.pm = fm + ((wgid % nig) % gsz); u.pn = (wgid % nig) / gsz; return true;
    }
    __device__ __forceinline__ size_t bofs(const Unit& u, size_t tstep) const { return (size_t)u.pn * tstep + (tile_e ? (size_t)__builtin_amdgcn_readfirstlane(tile_e[u.pm]) * estride : (size_t)0); }
    __device__ __forceinline__ void a_ready(const Unit&) const {}
    __device__ __forceinline__ void done(const Unit&) const {}
};

__device__ __forceinline__ unsigned cvt_pk_bf16(float lo, float hi) { unsigned r; asm volatile("v_cvt_pk_bf16_f32 %0, %1, %2" : "=v"(r) : "v"(lo), "v"(hi)); return r; }

__device__ __forceinline__ float row_rstd16(const float* ssq, int r, int fq) {
    const f32x4 p = *(const f32x4*)(ssq + (size_t)r * 16 + 4 * fq);
    float s = (p[0] + p[1]) + (p[2] + p[3]); s += __shfl_xor(s, 16); s += __shfl_xor(s, 32);
    return __builtin_amdgcn_rsqf(s * (1.0f / DM) + NORM_EPS);
}

struct EpiZ {
    static constexpr bool PERM = true, AFTER_DRAIN = false;
    bf16_t* Z; int ldc, ncols; const float* ssq;
    __device__ __forceinline__ void operator()(const f32x4 (&acc)[2][2][4][2], const Unit& u, int wr, int wc, int fr, int fq) const {
        const int row0 = u.pm * BM + wr * 64 + fr, col0 = u.pn * BM + wc * 32 + 8 * fq;
#pragma unroll
        for (int ai = 0; ai < 2; ++ai)
#pragma unroll
            for (int m = 0; m < 4; ++m) { const int r = row0 + ai * HALF + m * 16; const float rs = row_rstd16(ssq, r, fq); bf16_t* rowp = Z + (size_t)r * ldc + col0;
#pragma unroll
                for (int bj = 0; bj < 2; ++bj) { const f32x4 v0 = acc[ai][bj][m][0] * rs, v1 = acc[ai][bj][m][1] * rs;
                    u32x4 w; w.x = cvt_pk_bf16(v0[0], v0[1]); w.y = cvt_pk_bf16(v0[2], v0[3]); w.z = cvt_pk_bf16(v1[0], v1[1]); w.w = cvt_pk_bf16(v1[2], v1[3]);
                    if (col0 + bj * HALF < ncols) *(u32x4*)(rowp + bj * HALF) = w; } }
    }
};
template <bool MOE> struct EpiSwiGLU {
    static constexpr bool PERM = true, AFTER_DRAIN = false;
    bf16_t* O; const float* ssq; const float* row_rstd;
    __device__ __forceinline__ void operator()(const f32x4 (&acc)[2][2][4][2], const Unit& u, int wr, int wc, int fr, int fq) const {
        const int row0 = u.pm * BM + wr * 64 + fr, col0 = u.pn * HALF + wc * 32 + 8 * fq;
#pragma unroll
        for (int ai = 0; ai < 2; ++ai)
#pragma unroll
            for (int m = 0; m < 4; ++m) { const int r = row0 + ai * HALF + m * 16; float rs; if (MOE) rs = row_rstd[r]; else rs = row_rstd16(ssq, r, fq);
                const f32x4 g0 = acc[ai][0][m][0] * rs, g1 = acc[ai][0][m][1] * rs, u0 = acc[ai][1][m][0] * rs, u1 = acc[ai][1][m][1] * rs; f32x4 a0, a1;
#pragma unroll
                for (int j = 0; j < 4; ++j) { a0[j] = g0[j] * __builtin_amdgcn_rcpf(1.0f + __expf(-g0[j])) * u0[j]; a1[j] = g1[j] * __builtin_amdgcn_rcpf(1.0f + __expf(-g1[j])) * u1[j]; }
                u32x4 w; w.x = cvt_pk_bf16(a0[0], a0[1]); w.y = cvt_pk_bf16(a0[2], a0[3]); w.z = cvt_pk_bf16(a1[0], a1[1]); w.w = cvt_pk_bf16(a1[2], a1[3]);
                *(u32x4*)(O + (size_t)r * DFF + col0) = w; }
    }
};
struct EpiRes {
    static constexpr bool PERM = false, AFTER_DRAIN = false;
    const float* base; const bf16_t* baseb; float* out; bf16_t* hb; float* ssq;
    __device__ __forceinline__ void operator()(const f32x4 (&acc)[2][2][4][2], const Unit& u, int wr, int wc, int fr, int fq) const {
        const int col0 = u.pn * BM + wc * 32 + 4 * fq;
#pragma unroll
        for (int ai = 0; ai < 2; ++ai)
#pragma unroll
            for (int m = 0; m < 4; ++m) { const int r = u.pm * BM + ai * HALF + wr * 64 + m * 16 + fr; const size_t off = (size_t)r * DM + col0; float ss = 0.f;
#pragma unroll
                for (int bj = 0; bj < 2; ++bj)
#pragma unroll
                    for (int n = 0; n < 2; ++n) { f32x4 bv;
                        if (base) bv = *(const f32x4*)(base + off + bj * HALF + n * 16);
                        else { const u32x2 bw = *(const u32x2*)(baseb + off + bj * HALF + n * 16); bv = (f32x4){bflo(bw.x), bfhi(bw.x), bflo(bw.y), bfhi(bw.y)}; }
                        const f32x4 v = bv + acc[ai][bj][m][n];
                        if (out) *(f32x4*)(out + off + bj * HALF + n * 16) = v;
                        ss += (v[0] * v[0] + v[1] * v[1]) + (v[2] * v[2] + v[3] * v[3]);
                        { u32x2 w; w.x = cvt_pk_bf16(v[0], v[1]); w.y = cvt_pk_bf16(v[2], v[3]); *(u32x2*)(hb + off + bj * HALF + n * 16) = w; } }
                ss += __shfl_xor(ss, 16); ss += __shfl_xor(ss, 32);
                if (fq == 0) ssq[(size_t)r * 16 + u.pn * 4 + wc] = ss;
                if (m & 1) asm volatile("" ::: "memory"); }
    }
};
struct EpiMoeDown {
    static constexpr bool PERM = false, AFTER_DRAIN = false;
    float* out; const int* row_tok; const float* row_gate;
    __device__ __forceinline__ void operator()(const f32x4 (&acc)[2][2][4][2], const Unit& u, int wr, int wc, int fr, int fq) const {
        const int col0 = u.pn * BM + wc * 32 + 4 * fq;
#pragma unroll
        for (int ai = 0; ai < 2; ++ai)
#pragma unroll
            for (int m = 0; m < 4; ++m) { const int r = u.pm * BM + ai * HALF + wr * 64 + m * 16 + fr; const int tok = row_tok[r]; const float gt = row_gate[r];
                if (tok >= 0) { float* op = out + (size_t)tok * DM + col0;
#pragma unroll
                    for (int bj = 0; bj < 2; ++bj)
#pragma unroll
                        for (int n = 0; n < 2; ++n) { float* p = op + bj * HALF + n * 16; *(f32x4*)p = *(const f32x4*)p + acc[ai][bj][m][n] * gt; } }
                if (m & 1) asm volatile("" ::: "memory"); }
    }
};

template <class Epi, class Sched, bool ALIGN_EPI = false, bool SP2 = false>
__device__ __forceinline__ void gemm_phase(PG8_LAS unsigned char* lds, const Gemm g, const Sched& S, const Epi& E) {
    int lid_; asm volatile("v_mbcnt_lo_u32_b32 %0, -1, 0\n\tv_mbcnt_hi_u32_b32 %0, -1, %0" : "=v"(lid_)); int tid_ = g.wv * 64 + lid_; asm volatile("" : "+v"(tid_));
    const int tid = tid_, wid = __builtin_amdgcn_readfirstlane(tid >> 6), lane = tid & 63, wr = wid >> 2, wc = wid & 3, fr = lane & 15, fq = lane >> 4;
    const int K = g.K, nt = K / BK;
    unsigned voffA[2], voffB[2];
#pragma unroll
    for (int i = 0; i < 2; ++i) { int R, C; stage_rc(tid * 16 + i * 8192, R, C); const int Rb = Epi::PERM ? ((R & ~31) + perm32(R & 31)) : R;
        voffA[i] = (unsigned)(R * K + C) * 2u; voffB[i] = (unsigned)(Rb * K + C) * 2u; }
    const size_t kstep = (size_t)(BK * 2);
    const size_t hstep = (size_t)HALF * K * 2;
    const size_t tstep = 2 * hstep;
    const unsigned ldsw = (unsigned)wid * 1024u;
    const int aoff = lds_byte(wr * 64 + fr, fq * 8), boff = lds_byte(wc * 32 + fr, fq * 8);
#define PG8_SA(b, h) (((b) * 2 + (h)) * HTB)
#define PG8_SB(b, h) ((4 + (b) * 2 + (h)) * HTB)
#define PG8_STAGE(bufoff, gbase, voff) do { _Pragma("unroll") for (int _i = 0; _i < 2; ++_i) \
        __builtin_amdgcn_global_load_lds((const unsigned*)((const char*)(gbase) + (voff)[_i]), (PG8_LAS unsigned*)(lds + (bufoff) + ldsw + _i * 8192), 16, 0, 0); } while (0)
#define PG8_LDA(dst, b, h) do { _Pragma("unroll") for (int m = 0; m < 4; ++m) _Pragma("unroll") for (int k = 0; k < 2; ++k) dst[m][k] = *(const PG8_LAS bf16x8*)(lds + PG8_SA(b, h) + aoff + m * 2048 + k * 1024); } while (0)
#define PG8_LDB(dst, b, h) do { _Pragma("unroll") for (int n = 0; n < 2; ++n) _Pragma("unroll") for (int k = 0; k < 2; ++k) dst[n][k] = *(const PG8_LAS bf16x8*)(lds + PG8_SB(b, h) + boff + n * 2048 + k * 1024); } while (0)
#define PG8_MMA(ai, bj, At, Bt) do { __builtin_amdgcn_s_setprio(1); _Pragma("unroll") for (int m = 0; m < 4; ++m) _Pragma("unroll") for (int n = 0; n < 2; ++n) _Pragma("unroll") for (int k = 0; k < 2; ++k) \
        acc[ai][bj][m][n] = __builtin_amdgcn_mfma_f32_16x16x32_bf16(Bt[n][k], At[m][k], acc[ai][bj][m][n], 0, 0, 0); __builtin_amdgcn_s_setprio(0); } while (0)
#define PG8_WAIT_V(n) asm volatile("s_waitcnt vmcnt(" #n ")" ::: "memory")
#define PG8_WAIT_L(n) asm volatile("s_waitcnt lgkmcnt(" #n ")" ::: "memory")
#define PG8_BAR __builtin_amdgcn_s_barrier()
#define PG8_SCHED __builtin_amdgcn_sched_barrier(0)
    Unit cur, nxt; int ui = 0;
    if (!S.next(0, cur)) return;
    f32x4 acc[2][2][4][2];
#pragma unroll
    for (int a = 0; a < 2; ++a)
#pragma unroll
        for (int b = 0; b < 2; ++b)
#pragma unroll
            for (int m = 0; m < 4; ++m)
#pragma unroll
                for (int n = 0; n < 2; ++n) acc[a][b][m][n] = (f32x4){0.f, 0.f, 0.f, 0.f};
    bf16x8 At[4][2], B0[2][2], B1[2][2];
    const char* cA = (const char*)g.A + (size_t)cur.pm * tstep; const char* cB = (const char*)g.Bt + S.bofs(cur, tstep);
    S.a_ready(cur);
    if constexpr (SP2) {
        PG8_STAGE(PG8_SB(0, 0), cB, voffB); PG8_STAGE(PG8_SB(0, 1), cB + hstep, voffB); PG8_STAGE(PG8_SA(0, 0), cA, voffA); PG8_STAGE(PG8_SA(0, 1), cA + hstep, voffA);
        if (wr == 1) PG8_BAR;
        PG8_WAIT_V(2); PG8_BAR;
        PG8_STAGE(PG8_SB(1, 0), cB + kstep, voffB); PG8_STAGE(PG8_SA(1, 0), cA + kstep, voffA); PG8_STAGE(PG8_SB(1, 1), cB + hstep + kstep, voffB);
        PG8_WAIT_V(6); PG8_BAR;
    } else {
        PG8_STAGE(PG8_SB(0, 0), cB, voffB); PG8_STAGE(PG8_SA(0, 0), cA, voffA); PG8_STAGE(PG8_SB(0, 1), cB + hstep, voffB); PG8_STAGE(PG8_SA(0, 1), cA + hstep, voffA);
        if (wr == 1) PG8_BAR;
        PG8_WAIT_V(4); PG8_BAR;
        PG8_STAGE(PG8_SB(1, 0), cB + kstep, voffB); PG8_STAGE(PG8_SA(1, 0), cA + kstep, voffA); PG8_STAGE(PG8_SB(1, 1), cB + hstep + kstep, voffB);
        PG8_WAIT_V(6); PG8_BAR;
    }
    for (;;) {
        const bool has_next = S.next(ui + 1, nxt);
        const char* nA = has_next ? (const char*)g.A + (size_t)nxt.pm * tstep : cA; const char* nB = has_next ? (const char*)g.Bt + S.bofs(nxt, tstep) : cB;
        for (int t = 0; t < nt; t += 2) {
            const bool last = (t == nt - 2);
            const char* a1 = cA + (size_t)(t + 1) * kstep;
            const char* a2 = last ? nA : cA + (size_t)(t + 2) * kstep; const char* b2 = last ? nB : cB + (size_t)(t + 2) * kstep;
            const char* a3 = a2 + kstep; const char* b3 = b2 + kstep;
            if (last && has_next) S.a_ready(nxt);
            if constexpr (SP2) {
            PG8_LDB(B0, 0, 0); PG8_LDB(B1, 0, 1); PG8_SCHED; PG8_LDA(At, 0, 0); PG8_STAGE(PG8_SA(1, 1), a1 + hstep, voffA);
            PG8_WAIT_V(8); PG8_WAIT_L(0); PG8_BAR; PG8_MMA(0, 0, At, B0); PG8_MMA(0, 1, At, B1); PG8_BAR; PG8_SCHED;
            PG8_LDA(At, 0, 1); PG8_STAGE(PG8_SB(0, 0), b2, voffB); PG8_STAGE(PG8_SB(0, 1), b2 + hstep, voffB); PG8_STAGE(PG8_SA(0, 0), a2, voffA);
            PG8_WAIT_V(8); PG8_WAIT_L(0); PG8_BAR; PG8_MMA(1, 0, At, B0); PG8_MMA(1, 1, At, B1); PG8_BAR; PG8_SCHED;
            PG8_LDB(B0, 1, 0); PG8_LDB(B1, 1, 1); PG8_SCHED; PG8_LDA(At, 1, 0); PG8_STAGE(PG8_SA(0, 1), a2 + hstep, voffA);
            PG8_WAIT_V(8); PG8_WAIT_L(0); PG8_BAR; PG8_MMA(0, 0, At, B0); PG8_MMA(0, 1, At, B1); PG8_BAR; PG8_SCHED;
            PG8_LDA(At, 1, 1); PG8_STAGE(PG8_SB(1, 0), b3, voffB); PG8_STAGE(PG8_SB(1, 1), b3 + hstep, voffB); PG8_STAGE(PG8_SA(1, 0), a3, voffA);
            PG8_WAIT_V(8); PG8_WAIT_L(0); PG8_BAR; PG8_MMA(1, 0, At, B0); PG8_MMA(1, 1, At, B1); PG8_BAR; PG8_SCHED;
            } else {
            PG8_LDB(B0, 0, 0); PG8_SCHED; PG8_LDA(At, 0, 0); PG8_STAGE(PG8_SA(1, 1), a1 + hstep, voffA);
            PG8_WAIT_L(8); PG8_BAR; PG8_WAIT_L(0); PG8_MMA(0, 0, At, B0); PG8_BAR; PG8_SCHED;
            PG8_LDB(B1, 0, 1); PG8_STAGE(PG8_SB(0, 0), b2, voffB);
            PG8_BAR; PG8_WAIT_L(0); PG8_MMA(0, 1, At, B1); PG8_BAR;
            PG8_LDA(At, 0, 1); PG8_STAGE(PG8_SA(0, 0), a2, voffA);
            PG8_BAR; PG8_WAIT_L(0); PG8_MMA(1, 0, At, B0); PG8_BAR; PG8_SCHED;
            PG8_STAGE(PG8_SB(0, 1), b2 + hstep, voffB);
            PG8_WAIT_V(6); PG8_BAR; PG8_MMA(1, 1, At, B1); PG8_BAR;
            PG8_LDB(B0, 1, 0); PG8_SCHED; PG8_LDA(At, 1, 0); PG8_STAGE(PG8_SA(0, 1), a2 + hstep, voffA);
            PG8_WAIT_L(8); PG8_BAR; PG8_WAIT_L(0); PG8_MMA(0, 0, At, B0); PG8_BAR; PG8_SCHED;
            PG8_LDB(B1, 1, 1); PG8_STAGE(PG8_SB(1, 0), b3, voffB);
            PG8_BAR; PG8_WAIT_L(0); PG8_MMA(0, 1, At, B1); PG8_BAR;
            PG8_LDA(At, 1, 1); PG8_STAGE(PG8_SA(1, 0), a3, voffA);
            PG8_BAR; PG8_WAIT_L(0); PG8_MMA(1, 0, At, B0); PG8_BAR; PG8_SCHED;
            PG8_STAGE(PG8_SB(1, 1), b3 + hstep, voffB);
            PG8_WAIT_V(6); PG8_BAR; PG8_MMA(1, 1, At, B1); PG8_BAR;
            }
        }
        if constexpr (ALIGN_EPI) { if (wr == 0) PG8_BAR; }
        if constexpr (!Epi::AFTER_DRAIN) { E(acc, cur, wr, wc, fr, fq); S.done(cur); }
        if (!has_next) break;
#pragma unroll
        for (int a = 0; a < 2; ++a)
#pragma unroll
            for (int b = 0; b < 2; ++b)
#pragma unroll
                for (int m = 0; m < 4; ++m)
#pragma unroll
                    for (int n = 0; n < 2; ++n) acc[a][b][m][n] = (f32x4){0.f, 0.f, 0.f, 0.f};
        cur = nxt; cA = nA; cB = nB; ++ui;
        if constexpr (ALIGN_EPI) { if (wr == 1) PG8_BAR; }
    }
    PG8_WAIT_V(0);
    if constexpr (!ALIGN_EPI) { if (wr == 0) PG8_BAR; }
    PG8_BAR;
    if constexpr (Epi::AFTER_DRAIN) { E.fused(acc, cur, wr, wc, fr, fq, lds, wid, lane); S.done(cur); }
#undef PG8_SA
#undef PG8_SB
#undef PG8_STAGE
#undef PG8_LDA
#undef PG8_LDB
#undef PG8_MMA
#undef PG8_WAIT_V
#undef PG8_WAIT_L
#undef PG8_BAR
#undef PG8_SCHED
}
template <class Epi, class Sched, bool ALIGN_EPI = false, bool SP2 = false>
__device__ __forceinline__ void gemm_phase_g(PG8_LAS unsigned char* lds, const Gemm g, const Sched& S, const Epi& E, const int* rowtok) {
    int lid_; asm volatile("v_mbcnt_lo_u32_b32 %0, -1, 0\n\tv_mbcnt_hi_u32_b32 %0, -1, %0" : "=v"(lid_)); int tid_ = g.wv * 64 + lid_; asm volatile("" : "+v"(tid_));
    const int tid = tid_, wid = __builtin_amdgcn_readfirstlane(tid >> 6), lane = tid & 63, wr = wid >> 2, wc = wid & 3, fr = lane & 15, fq = lane >> 4;
    const int K = g.K, nt = K / BK;
    unsigned voffA[2], voffB[2];
#pragma unroll
    for (int i = 0; i < 2; ++i) { int R, C; stage_rc(tid * 16 + i * 8192, R, C); const int Rb = Epi::PERM ? ((R & ~31) + perm32(R & 31)) : R;
        voffA[i] = (unsigned)(R * K + C) * 2u; voffB[i] = (unsigned)(Rb * K + C) * 2u; }
    const size_t kstep = (size_t)(BK * 2);
    const size_t hstep = (size_t)HALF * K * 2;
    const size_t tstep = 2 * hstep;
    const unsigned ldsw = (unsigned)wid * 1024u;
    const int aoff = lds_byte(wr * 64 + fr, fq * 8), boff = lds_byte(wc * 32 + fr, fq * 8);
#define PG8_SA(b, h) (((b) * 2 + (h)) * HTB)
#define PG8_SB(b, h) ((4 + (b) * 2 + (h)) * HTB)
#define PG8_STAGE(bufoff, gbase, voff) do { _Pragma("unroll") for (int _i = 0; _i < 2; ++_i) \
        __builtin_amdgcn_global_load_lds((const unsigned*)((const char*)(gbase) + (voff)[_i]), (PG8_LAS unsigned*)(lds + (bufoff) + ldsw + _i * 8192), 16, 0, 0); } while (0)
#define PG8_LDA(dst, b, h) do { _Pragma("unroll") for (int m = 0; m < 4; ++m) _Pragma("unroll") for (int k = 0; k < 2; ++k) dst[m][k] = *(const PG8_LAS bf16x8*)(lds + PG8_SA(b, h) + aoff + m * 2048 + k * 1024); } while (0)
#define PG8_LDB(dst, b, h) do { _Pragma("unroll") for (int n = 0; n < 2; ++n) _Pragma("unroll") for (int k = 0; k < 2; ++k) dst[n][k] = *(const PG8_LAS bf16x8*)(lds + PG8_SB(b, h) + boff + n * 2048 + k * 1024); } while (0)
#define PG8_MMA(ai, bj, At, Bt) do { __builtin_amdgcn_s_setprio(1); _Pragma("unroll") for (int m = 0; m < 4; ++m) _Pragma("unroll") for (int n = 0; n < 2; ++n) _Pragma("unroll") for (int k = 0; k < 2; ++k) \
        acc[ai][bj][m][n] = __builtin_amdgcn_mfma_f32_16x16x32_bf16(Bt[n][k], At[m][k], acc[ai][bj][m][n], 0, 0, 0); __builtin_amdgcn_s_setprio(0); } while (0)
#define PG8_WAIT_V(n) asm volatile("s_waitcnt vmcnt(" #n ")" ::: "memory")
#define PG8_WAIT_L(n) asm volatile("s_waitcnt lgkmcnt(" #n ")" ::: "memory")
#define PG8_BAR __builtin_amdgcn_s_barrier()
#define PG8_SCHED __builtin_amdgcn_sched_barrier(0)
    unsigned gAc[2][2], gAn[2][2];
#define PG8_GATHER(dst, un) do { _Pragma("unroll") for (int hh_ = 0; hh_ < 2; ++hh_) _Pragma("unroll") for (int i_ = 0; i_ < 2; ++i_) { \
        const int tok_ = rowtok[(un).pm * BM + hh_ * HALF + (int)(voffA[i_] >> 11)]; dst[hh_][i_] = (unsigned)(tok_ < 0 ? 0 : tok_) * 2048u + (voffA[i_] & 2047u); } } while (0)
#define PG8_STAGE_GA(bufoff, kptr, hh, NX) do { _Pragma("unroll") for (int _i = 0; _i < 2; ++_i) \
        __builtin_amdgcn_global_load_lds((const unsigned*)((const char*)(kptr) + ((NX) ? gAn[hh][_i] : gAc[hh][_i])), (PG8_LAS unsigned*)(lds + (bufoff) + ldsw + _i * 8192), 16, 0, 0); } while (0)
    Unit cur, nxt; int ui = 0;
    if (!S.next(0, cur)) return;
    PG8_GATHER(gAc, cur);
    f32x4 acc[2][2][4][2];
#pragma unroll
    for (int a = 0; a < 2; ++a)
#pragma unroll
        for (int b = 0; b < 2; ++b)
#pragma unroll
            for (int m = 0; m < 4; ++m)
#pragma unroll
                for (int n = 0; n < 2; ++n) acc[a][b][m][n] = (f32x4){0.f, 0.f, 0.f, 0.f};
    bf16x8 At[4][2], B0[2][2], B1[2][2];
    const char* cA = (const char*)g.A; const char* cB = (const char*)g.Bt + S.bofs(cur, tstep);
    S.a_ready(cur);
    if constexpr (SP2) {
        PG8_STAGE(PG8_SB(0, 0), cB, voffB); PG8_STAGE(PG8_SB(0, 1), cB + hstep, voffB); PG8_STAGE_GA(PG8_SA(0, 0), cA, 0, false); PG8_STAGE_GA(PG8_SA(0, 1), cA, 1, false);
        if (wr == 1) PG8_BAR;
        PG8_WAIT_V(2); PG8_BAR;
        PG8_STAGE(PG8_SB(1, 0), cB + kstep, voffB); PG8_STAGE_GA(PG8_SA(1, 0), cA + kstep, 0, false); PG8_STAGE(PG8_SB(1, 1), cB + hstep + kstep, voffB);
        PG8_WAIT_V(6); PG8_BAR;
    } else {
        PG8_STAGE(PG8_SB(0, 0), cB, voffB); PG8_STAGE_GA(PG8_SA(0, 0), cA, 0, false); PG8_STAGE(PG8_SB(0, 1), cB + hstep, voffB); PG8_STAGE_GA(PG8_SA(0, 1), cA, 1, false);
        if (wr == 1) PG8_BAR;
        PG8_WAIT_V(4); PG8_BAR;
        PG8_STAGE(PG8_SB(1, 0), cB + kstep, voffB); PG8_STAGE_GA(PG8_SA(1, 0), cA + kstep, 0, false); PG8_STAGE(PG8_SB(1, 1), cB + hstep + kstep, voffB);
        PG8_WAIT_V(6); PG8_BAR;
    }
    for (;;) {
        const bool has_next = S.next(ui + 1, nxt);
        if (has_next) PG8_GATHER(gAn, nxt); else { _Pragma("unroll") for (int hh_ = 0; hh_ < 2; ++hh_) _Pragma("unroll") for (int i_ = 0; i_ < 2; ++i_) gAn[hh_][i_] = gAc[hh_][i_]; }
        const char* nA = (const char*)g.A; const char* nB = has_next ? (const char*)g.Bt + S.bofs(nxt, tstep) : cB;
        for (int t = 0; t < nt; t += 2) {
            const bool last = (t == nt - 2);
            const char* a1 = cA + (size_t)(t + 1) * kstep;
            const char* a2 = last ? nA : cA + (size_t)(t + 2) * kstep; const char* b2 = last ? nB : cB + (size_t)(t + 2) * kstep;
            const char* a3 = a2 + kstep; const char* b3 = b2 + kstep;
            if (last && has_next) S.a_ready(nxt);
            if constexpr (SP2) {
            PG8_LDB(B0, 0, 0); PG8_LDB(B1, 0, 1); PG8_SCHED; PG8_LDA(At, 0, 0); PG8_STAGE_GA(PG8_SA(1, 1), a1, 1, false);
            PG8_WAIT_V(8); PG8_WAIT_L(0); PG8_BAR; PG8_MMA(0, 0, At, B0); PG8_MMA(0, 1, At, B1); PG8_BAR; PG8_SCHED;
            PG8_LDA(At, 0, 1); PG8_STAGE(PG8_SB(0, 0), b2, voffB); PG8_STAGE(PG8_SB(0, 1), b2 + hstep, voffB); PG8_STAGE_GA(PG8_SA(0, 0), a2, 0, last);
            PG8_WAIT_V(8); PG8_WAIT_L(0); PG8_BAR; PG8_MMA(1, 0, At, B0); PG8_MMA(1, 1, At, B1); PG8_BAR; PG8_SCHED;
            PG8_LDB(B0, 1, 0); PG8_LDB(B1, 1, 1); PG8_SCHED; PG8_LDA(At, 1, 0); PG8_STAGE_GA(PG8_SA(0, 1), a2, 1, last);
            PG8_WAIT_V(8); PG8_WAIT_L(0); PG8_BAR; PG8_MMA(0, 0, At, B0); PG8_MMA(0, 1, At, B1); PG8_BAR; PG8_SCHED;
            PG8_LDA(At, 1, 1); PG8_STAGE(PG8_SB(1, 0), b3, voffB); PG8_STAGE(PG8_SB(1, 1), b3 + hstep, voffB); PG8_STAGE_GA(PG8_SA(1, 0), a3, 0, last);
            PG8_WAIT_V(8); PG8_WAIT_L(0); PG8_BAR; PG8_MMA(1, 0, At, B0); PG8_MMA(1, 1, At, B1); PG8_BAR; PG8_SCHED;
            } else {
            PG8_LDB(B0, 0, 0); PG8_SCHED; PG8_LDA(At, 0, 0); PG8_STAGE_GA(PG8_SA(1, 1), a1, 1, false);
            PG8_WAIT_L(8); PG8_BAR; PG8_WAIT_L(0); PG8_MMA(0, 0, At, B0); PG8_BAR; PG8_SCHED;
            PG8_LDB(B1, 0, 1); PG8_STAGE(PG8_SB(0, 0), b2, voffB);
            PG8_BAR; PG8_WAIT_L(0); PG8_MMA(0, 1, At, B1); PG8_BAR;
            PG8_LDA(At, 0, 1); PG8_STAGE_GA(PG8_SA(0, 0), a2, 0, last);
            PG8_BAR; PG8_WAIT_L(0); PG8_MMA(1, 0, At, B0); PG8_BAR; PG8_SCHED;
            PG8_STAGE(PG8_SB(0, 1), b2 + hstep, voffB);
            PG8_WAIT_V(6); PG8_BAR; PG8_MMA(1, 1, At, B1); PG8_BAR;
            PG8_LDB(B0, 1, 0); PG8_SCHED; PG8_LDA(At, 1, 0); PG8_STAGE_GA(PG8_SA(0, 1), a2, 1, last);
            PG8_WAIT_L(8); PG8_BAR; PG8_WAIT_L(0); PG8_MMA(0, 0, At, B0); PG8_BAR; PG8_SCHED;
            PG8_LDB(B1, 1, 1); PG8_STAGE(PG8_SB(1, 0), b3, voffB);
            PG8_BAR; PG8_WAIT_L(0); PG8_MMA(0, 1, At, B1); PG8_BAR;
            PG8_LDA(At, 1, 1); PG8_STAGE_GA(PG8_SA(1, 0), a3, 0, last);
            PG8_BAR; PG8_WAIT_L(0); PG8_MMA(1, 0, At, B0); PG8_BAR; PG8_SCHED;
            PG8_STAGE(PG8_SB(1, 1), b3 + hstep, voffB);
            PG8_WAIT_V(6); PG8_BAR; PG8_MMA(1, 1, At, B1); PG8_BAR;
            }
        }
        if constexpr (ALIGN_EPI) { if (wr == 0) PG8_BAR; }
        if constexpr (!Epi::AFTER_DRAIN) { E(acc, cur, wr, wc, fr, fq); S.done(cur); }
        if (!has_next) break;
#pragma unroll
        for (int a = 0; a < 2; ++a)
#pragma unroll
            for (int b = 0; b < 2; ++b)
#pragma unroll
                for (int m = 0; m < 4; ++m)
#pragma unroll
                    for (int n = 0; n < 2; ++n) acc[a][b][m][n] = (f32x4){0.f, 0.f, 0.f, 0.f};
        cur = nxt; cA = nA; cB = nB; ++ui;
        _Pragma("unroll") for (int hh_ = 0; hh_ < 2; ++hh_) _Pragma("unroll") for (int i_ = 0; i_ < 2; ++i_) gAc[hh_][i_] = gAn[hh_][i_];
        if constexpr (ALIGN_EPI) { if (wr == 1) PG8_BAR; }
    }
    PG8_WAIT_V(0);
    if constexpr (!ALIGN_EPI) { if (wr == 0) PG8_BAR; }
    PG8_BAR;
    if constexpr (Epi::AFTER_DRAIN) { E.fused(acc, cur, wr, wc, fr, fq, lds, wid, lane); S.done(cur); }
#undef PG8_GATHER
#undef PG8_STAGE_GA
#undef PG8_SA
#undef PG8_SB
#undef PG8_STAGE
#undef PG8_LDA
#undef PG8_LDB
#undef PG8_MMA
#undef PG8_WAIT_V
#undef PG8_WAIT_L
#undef PG8_BAR
#undef PG8_SCHED
}
}
#define XB_TMO      128
#define XB_XCNT(j)  (256  + 64 * (j))
#define XB_XSUB(j)  (1280 + 64 * (j))
#define XB_XGEN(j)  (2304 + 64 * (j))
#define XB_TOP      3328
#define XB_TOPGEN   3392
#define XCD_BAR_WORDS 3456
#define XB_SPIN_CAP (1u << 18)

__device__ __forceinline__ unsigned xb_ld(unsigned* p)              { return __hip_atomic_load(p, __ATOMIC_RELAXED, __HIP_MEMORY_SCOPE_AGENT); }
__device__ __forceinline__ unsigned xb_add(unsigned* p, unsigned v) { return __hip_atomic_fetch_add(p, v, __ATOMIC_RELAXED, __HIP_MEMORY_SCOPE_AGENT); }
__device__ __forceinline__ unsigned xb_xcc_id() { return (unsigned)__builtin_amdgcn_s_getreg((3 << 11) | 20) & 0xFu; }
#define XB_SPIN(cond, bar) do { unsigned _sp = 0; while (cond) { __builtin_amdgcn_s_sleep(1); \
    if ((++_sp & 255u) == 0u) { if (xb_ld(&(bar)[XB_TMO])) break; if (_sp > XB_SPIN_CAP) { atomicAdd(&(bar)[XB_TMO], 1u); break; } } } } while (0)

struct XcdBarrier {
    unsigned* bar; unsigned x;
    volatile LAS unsigned* st;
};

__device__ __forceinline__ XcdBarrier xcd_barrier_post(unsigned* bar, volatile LAS unsigned* st) {
    XcdBarrier b; b.bar = bar; b.x = xb_xcc_id(); b.st = st;
    if (threadIdx.x == 0) (void)xb_add(&bar[XB_XCNT(b.x)], 1u);
    return b;
}
__device__ __forceinline__ void xcd_barrier_complete(unsigned* bar, unsigned x, unsigned& nloc, unsigned& nx) {
    const unsigned G = gridDim.x * gridDim.y * gridDim.z;
    unsigned sum, cnt, mine, sp = 0u;
    for (;;) {
        sum = 0u; cnt = 0u; mine = 0u;
#pragma unroll
        for (unsigned j = 0; j < 16; ++j) { const unsigned c = xb_ld(&bar[XB_XCNT(j)]); sum += c; cnt += (c > 0u) ? 1u : 0u; mine = (j == x) ? c : mine; }
        if (sum == G) break;
        __builtin_amdgcn_s_sleep(1);
        if ((++sp & 255u) == 0u) { if (xb_ld(&bar[XB_TMO])) break; if (sp > XB_SPIN_CAP) { atomicAdd(&bar[XB_TMO], 1u); break; } }
    }
    nloc = mine > 0u ? mine : 1u; nx = cnt > 0u ? cnt : 1u;
}

__device__ __forceinline__ void xcd_barrier(const XcdBarrier& b) {
    asm volatile("s_waitcnt vmcnt(0)" ::: "memory");
    __syncthreads();
    if (threadIdx.x == 0) {
        unsigned* bar = b.bar;
        __builtin_amdgcn_s_waitcnt(0);
        unsigned nloc = b.st[0], nx = b.st[1];
        if (nloc == 0u) { xcd_barrier_complete(bar, b.x, nloc, nx); b.st[0] = nloc; b.st[1] = nx; }
        const unsigned old = xb_add(&bar[XB_XSUB(b.x)], 1u);
        const unsigned gen = old / nloc;
        if (old + 1u == (gen + 1u) * nloc) {
            __builtin_amdgcn_fence(__ATOMIC_RELEASE, "agent");
            asm volatile("s_waitcnt vmcnt(0)" ::: "memory");
            const unsigned og = xb_add(&bar[XB_TOP], 1u);
            const unsigned tg = og / nx;
            if (og + 1u == (tg + 1u) * nx) xb_add(&bar[XB_TOPGEN], 1u);
            else XB_SPIN(xb_ld(&bar[XB_TOPGEN]) == tg, bar);
            __builtin_amdgcn_fence(__ATOMIC_ACQUIRE, "agent");
            xb_add(&bar[XB_XGEN(b.x)], 1u);
            asm volatile("s_waitcnt vmcnt(0)" ::: "memory");
        } else {
            XB_SPIN(xb_ld(&bar[XB_XGEN(b.x)]) == gen, bar);
            __builtin_amdgcn_fence(__ATOMIC_ACQUIRE, "agent");
            asm volatile("s_waitcnt vmcnt(0)" ::: "memory");
        }
    }
    __syncthreads();
}

struct Params {
    const float* in[33];
    float* out; unsigned char* ws;
    int ph_lo, ph_hi;
};
struct Frame {
    LAS unsigned char* lds;
    int blk, G, wv;
    float* out; unsigned char* ws;
};
constexpr int PTAB_OFF = LDSCTL_OFF + 1024;
__device__ __forceinline__ int lane_id() { int l; asm volatile("v_mbcnt_lo_u32_b32 %0, -1, 0\n\tv_mbcnt_hi_u32_b32 %0, -1, %0" : "=v"(l)); return l; }
__device__ __forceinline__ int mytid(const Frame& F) { int t = F.wv * 64 + lane_id(); asm volatile("" : "+v"(t)); return t; }
__device__ __forceinline__ const float* inptr(const Frame& F, int k) {
    volatile LAS unsigned* t = (volatile LAS unsigned*)(F.lds + PTAB_OFF) + 2 * k;
    const unsigned lo = __builtin_amdgcn_readfirstlane(t[0]), hi = __builtin_amdgcn_readfirstlane(t[1]);
    const GAS float* gp = (const GAS float*)(((unsigned long long)hi << 32) | (unsigned long long)lo);
    return (const float*)gp;
}
#define IN_X 0
#define IN_RELB 1
#define IN_MIXG 2
#define IN_WIN 3
#define IN_WOUT 4
#define IN_FFNG 5
#define IN_QG 6
#define IN_KG 7
#define IN_CW 8
#define IN_CB 9
#define IN_CLG 10
#define IN_CLB 11
#define IN_MU 12
#define IN_W0 13
#define IN_W2 14
#define IN_A0 15
#define IN_A2 16
#define IN_G2 17
#define IN_KK 18
#define IN_KA 19
#define IN_RK 20
#define IN_RLG 21
#define IN_RLB 22
#define IN_GG2 23
#define IN_GGB 24
#define IN_GNG 25
#define IN_FWG 26
#define IN_FWU 27
#define IN_FWD 28
#define IN_ROUTER 29
#define IN_MWG 30
#define IN_MWU 31
#define IN_MWD 32

__device__ __forceinline__ void p0_transpose_item(const float* W, int K, int N, int nblk, const float* gk, bf16* WT, int mode, LAS float* scr, int item, int lane) {
    const int kb = item / nblk, nb = item % nblk, k0 = 64 * kb, n0 = 64 * nb, kr = lane >> 4, n4 = (lane & 15) * 4;
    const bool valid = (n0 + n4) < N;
    f32x4 v[16];
#pragma unroll
    for (int i = 0; i < 16; ++i) v[i] = valid ? *(const f32x4*)(W + (size_t)(k0 + 4 * i + kr) * N + n0 + n4) : (f32x4){0.f, 0.f, 0.f, 0.f};
    if (gk) {
#pragma unroll
        for (int i = 0; i < 16; ++i) v[i] = v[i] * gk[k0 + 4 * i + kr]; }
    const int rowbase = (mode == 0) ? n0 : ((n0 >> 7) * 256 + (mode == 2 ? 128 : 0) + (n0 & 127));
    const int c = lane & 3;
#pragma unroll
    for (int half = 0; half < 2; ++half) {
#pragma unroll
        for (int i = 0; i < 8; ++i) { LAS float* d = scr + (4 * i + kr) * 65 + n4; const f32x4 x = v[half * 8 + i]; d[0] = x[0]; d[1] = x[1]; d[2] = x[2]; d[3] = x[3]; }
        LDS_WAIT(); asm volatile("" ::: "memory");
#pragma unroll
        for (int j = 0; j < 4; ++j) { const int nn = (lane >> 2) + 16 * j; const LAS float* s = scr + (8 * c) * 65 + nn;
            u32x4 o; o.x = pk2(s[0 * 65], s[1 * 65]); o.y = pk2(s[2 * 65], s[3 * 65]); o.z = pk2(s[4 * 65], s[5 * 65]); o.w = pk2(s[6 * 65], s[7 * 65]);
            *(u32x4*)(WT + (size_t)(rowbase + nn) * K + k0 + half * 32 + 8 * c) = o; }
        LDS_WAIT(); asm volatile("" ::: "memory"); }
}
__device__ __forceinline__ void p0_prologue(Frame& F, const int part) {
    const int tid = mytid(F), lane = tid & 63, wave = __builtin_amdgcn_readfirstlane(tid >> 6); (void)lane; (void)wave;
    LAS float* scr = (LAS float*)(F.lds + wave * 16384);
    const int gw = F.blk * NWAVES + wave, NGW = F.G * NWAVES;
    constexpr int I_IN = 16 * 48, I_OUT = 16 * 16, I_GU = 16 * 44, I_D = 44 * 16, I_SET = 2 * I_GU + I_D;
    constexpr int NITEMS = 2 * I_IN + 2 * I_OUT + 9 * I_SET;
    unsigned char* ws = F.ws;
    constexpr int NPART0 = 2 * I_IN + 2 * I_OUT + I_SET;
    for (int it = (part == 0 ? 0 : NPART0) + gw; it < (part == 0 ? NPART0 : NITEMS); it += NGW) {
        int r = it;
        if (r < 2 * I_IN) { const int l = r / I_IN; r -= l * I_IN;
            p0_transpose_item(inptr(F, IN_WIN) + (size_t)l * DM * INW, DM, INW, 48, inptr(F, IN_MIXG) + l * DM, (bf16*)(ws + WS_WIN) + (size_t)l * NPADW * DM, 0, scr, r, lane); continue; }
        r -= 2 * I_IN;
        if (r < 2 * I_OUT) { const int l = r / I_OUT; r -= l * I_OUT;
            p0_transpose_item(inptr(F, IN_WOUT) + (size_t)l * DM * DM, DM, DM, 16, nullptr, (bf16*)(ws + WS_WOUT) + (size_t)l * DM * DM, 0, scr, r, lane); continue; }
        r -= 2 * I_OUT;
        const int set = r / I_SET; r -= set * I_SET;
        const float* wg = set == 0 ? inptr(F, IN_FWG) : inptr(F, IN_MWG) + (size_t)(set - 1) * DM * DFF;
        const float* wu = set == 0 ? inptr(F, IN_FWU) : inptr(F, IN_MWU) + (size_t)(set - 1) * DM * DFF;
        const float* wd = set == 0 ? inptr(F, IN_FWD) : inptr(F, IN_MWD) + (size_t)(set - 1) * DFF * DM;
        const float* gk = inptr(F, IN_FFNG) + (set == 0 ? 0 : DM);
        bf16* dgu = set == 0 ? (bf16*)(ws + WS_WGU) : (bf16*)(ws + WS_MOEW + (size_t)(set - 1) * MOEW_E_BYTES);
        bf16* dd = set == 0 ? (bf16*)(ws + WS_WD) : (bf16*)(ws + WS_MOEW + (size_t)(set - 1) * MOEW_E_BYTES + MOEW_GU_BYTES);
        if (r < I_GU) { p0_transpose_item(wg, DM, DFF, 44, gk, dgu, 1, scr, r, lane); continue; } r -= I_GU;
        if (r < I_GU) { p0_transpose_item(wu, DM, DFF, 44, gk, dgu, 2, scr, r, lane); continue; } r -= I_GU;
        p0_transpose_item(wd, DFF, DM, 16, nullptr, dd, 0, scr, r, lane);
    }
    if (part != 0) return;
    const float* x = inptr(F, IN_X); bf16* hb = (bf16*)(ws + WS_HB); float* ssq = (float*)(ws + WS_SSQ);
    for (int m = gw; m < NTOK; m += NGW) {
        const f32x4* xr = (const f32x4*)(x + (size_t)m * DM) + lane; f32x4 v[4]; float s = 0.f;
#pragma unroll
        for (int j = 0; j < 4; ++j) { v[j] = xr[64 * j]; s += (v[j][0] * v[j][0] + v[j][1] * v[j][1]) + (v[j][2] * v[j][2] + v[j][3] * v[j][3]); }
        s = wave_sum(s);
        u32x2* o8 = (u32x2*)(hb + (size_t)m * DM) + lane;
#pragma unroll
        for (int j = 0; j < 4; ++j) { u32x2 w; w.x = pk2(v[j][0], v[j][1]); w.y = pk2(v[j][2], v[j][3]); o8[64 * j] = w; }
        if (lane < 16) ssq[(size_t)m * 16 + lane] = (lane == 0) ? s : 0.f;
    }
}

__device__ const unsigned char T5B[3][132] = {
 {0,1,2,3,4,5,6,7,8,9,10,11,12,13,14,15,16,16,16,16,16,16,17,17,17,17,17,17,17,17,18,18,18,18,18,18,18,18,18,18,19,19,19,19,19,19,19,19,19,19,19,19,19,19,20,20,20,20,20,20,20,20,20,20,20,20,20,20,20,20,20,20,20,21,21,21,21,21,21,21,21,21,21,21,21,21,21,21,21,21,21,21,21,21,21,21,21,21,21,22,22,22,22,22,22,22,22,22,22,22,22,22,22,22,22,22,22,22,22,22,22,22,22,22,22,22,22,22,22,0,0,0},
 {0,4,8,12,16,16,17,17,18,18,19,19,19,19,20,20,20,20,20,21,21,21,21,21,21,22,22,22,22,22,22,22,22,22,23,23,23,23,23,23,23,23,23,23,23,23,24,24,24,24,24,24,24,24,24,24,24,24,24,24,24,24,25,25,25,25,25,25,25,25,25,25,25,25,25,25,25,25,25,25,25,25,25,26,26,26,26,26,26,26,26,26,26,26,26,26,26,26,26,26,26,26,26,26,26,26,26,26,26,26,26,26,26,27,27,27,27,27,27,27,27,27,27,27,27,27,27,27,27,0,0,0},
 {0,16,18,19,20,21,21,22,22,23,23,23,24,24,24,24,25,25,25,25,25,26,26,26,26,26,26,26,26,27,27,27,27,27,27,27,27,27,27,28,28,28,28,28,28,28,28,28,28,28,28,28,29,29,29,29,29,29,29,29,29,29,29,29,29,29,29,29,29,29,30,30,30,30,30,30,30,30,30,30,30,30,30,30,30,30,30,30,30,30,30,30,30,30,30,31,31,31,31,31,31,31,31,31,31,31,31,31,31,31,31,31,31,31,31,31,31,31,31,31,31,31,31,31,31,31,31,31,31,0,0,0}};

__device__ __forceinline__ void attn_qknorm(Frame& F, bf16* Z, const float* qg, const float* kg) {
    const int tid = mytid(F); const int gt = F.blk * NTHREADS + tid, NGT = F.G * NTHREADS;
    for (int idx = gt; idx < NTOK * 64; idx += NGT) { const int tok = idx >> 6, seg = (idx >> 3) & 7, c8 = idx & 7;
        u32x4* ptr = (u32x4*)(Z + (size_t)tok * INW + (seg >> 2) * 256 + (seg & 3) * 64 + c8 * 8); const u32x4 p = *ptr; float f[8]; unpack8(p, f);
        float ss = 0.f;
#pragma unroll
        for (int e2 = 0; e2 < 8; ++e2) ss += f[e2] * f[e2];
        ss = red8(ss);
        const float rs = __builtin_amdgcn_rsqf(ss * (1.0f / 64.0f) + NORM_EPS) * (seg < 4 ? 0.125f : 1.0f); const float* gp = (seg < 4 ? qg : kg) + c8 * 8;
        u32x4 o; o.x = pk2(f[0] * rs * gp[0], f[1] * rs * gp[1]); o.y = pk2(f[2] * rs * gp[2], f[3] * rs * gp[3]); o.z = pk2(f[4] * rs * gp[4], f[5] * rs * gp[5]); o.w = pk2(f[6] * rs * gp[6], f[7] * rs * gp[7]);
        *ptr = o; }
}
typedef short v4i16 __attribute__((ext_vector_type(4)));
__device__ __forceinline__ void attn_tile(LAS unsigned char* lds, const bf16* Z, bf16* OP, float* LSE, const float* rel_bias, int tile, int tid) {
    const int lane = tid & 63, w = __builtin_amdgcn_readfirstlane(tid >> 6), fr = lane & 15, g = lane >> 4;
    const int br = tile >> 10, rem = tile & 1023, b = rem >> 7, h = (rem >> 5) & 3, sub = rem & 31;
    const int dsh = 2 * br, nbl = 32 >> dsh, r = sub >> (5 - dsh), n = sub & (nbl - 1);
    LAS unsigned char* Qs = lds;
    LAS unsigned char* Ks = lds + 16384;
    LAS unsigned char* Vs = lds + 49152;
    LAS float* BT = (LAS float*)(lds + 81920);
    const size_t zrow0 = (size_t)b * SEQ;
    if (tid < 129) BT[tid] = rel_bias[(int)T5B[br][tid] * 4 + h];
    { const int rl = lane >> 3, cp = lane & 7;
#pragma unroll
        for (int i = 0; i < 4; ++i) { const int R0 = (w * 4 + i) * 8, row = R0 + rl; int lk = 128 * (n - 1) + row; lk = lk < 0 ? 0 : lk;
            const bf16* zr = Z + (zrow0 + ((size_t)lk << dsh) + r) * INW + h * 64;
            __builtin_amdgcn_global_load_lds((const unsigned*)(zr + 256 + ((cp ^ (row & 7)) * 8)), (LAS unsigned*)(Ks + R0 * 128), 16, 0, 0);
            __builtin_amdgcn_global_load_lds((const unsigned*)(zr + 512 + ((2 * ((cp >> 1) ^ ((row >> 1) & 3)) + (cp & 1)) * 8)), (LAS unsigned*)(Vs + R0 * 128), 16, 0, 0); }
#pragma unroll
        for (int i = 0; i < 2; ++i) { const int R0 = (w * 2 + i) * 8, row = R0 + rl; const int lq = 128 * n + row;
            const bf16* zr = Z + (zrow0 + ((size_t)lq << dsh) + r) * INW + h * 64;
            __builtin_amdgcn_global_load_lds((const unsigned*)(zr + ((cp ^ (row & 7)) * 8)), (LAS unsigned*)(Qs + R0 * 128), 16, 0, 0); } }
    asm volatile("s_waitcnt vmcnt(0)" ::: "memory");
    BAR();
    bf16x8 qf[2];
#pragma unroll
    for (int ks = 0; ks < 2; ++ks) qf[ks] = *(const LAS bf16x8*)(Qs + (16 * w + fr) * 128 + (((ks * 4 + g) ^ (fr & 7)) << 4));
    f32x4 s[16];
#pragma unroll
    for (int kb = 0; kb < 16; ++kb) { s[kb] = (f32x4){0.f, 0.f, 0.f, 0.f};
#pragma unroll
        for (int ks = 0; ks < 2; ++ks) { const bf16x8 kf = *(const LAS bf16x8*)(Ks + (16 * kb + fr) * 128 + (((ks * 4 + g) ^ (fr & 7)) << 4));
            s[kb] = __builtin_amdgcn_mfma_f32_16x16x32_bf16(kf, qf[ks], s[kb], 0, 0, 0); } }
    const int q = 16 * w + fr; float mx = -3.0e38f;
#pragma unroll
    for (int kb = 0; kb < 16; ++kb)
#pragma unroll
        for (int rg = 0; rg < 4; ++rg) { const int key = 16 * kb + 4 * g + rg, delta = q + 128 - key; const bool valid = (delta >= 0) && (delta <= 128) && (n > 0 || key >= 128);
            const int di = delta < 0 ? 0 : (delta > 128 ? 128 : delta);
            const float v = valid ? s[kb][rg] + BT[di] : -3.0e38f; s[kb][rg] = v; mx = fmaxf(mx, v); }
    mx = fmaxf(mx, __shfl_xor(mx, 16)); mx = fmaxf(mx, __shfl_xor(mx, 32));
    float den = 0.f;
#pragma unroll
    for (int kb = 0; kb < 16; ++kb)
#pragma unroll
        for (int rg = 0; rg < 4; ++rg) { const float v = s[kb][rg]; const float p = (v > -1.0e38f) ? __expf(v - mx) : 0.f; s[kb][rg] = p; den += p; }
    den += __shfl_xor(den, 16); den += __shfl_xor(den, 32);
    f32x4 o[4];
#pragma unroll
    for (int eb = 0; eb < 4; ++eb) o[eb] = (f32x4){0.f, 0.f, 0.f, 0.f};
    const int trq = fr >> 2, trp = fr & 3;
#pragma unroll
    for (int s8 = 0; s8 < 8; ++s8) {
        u32x4 pw; pw.x = pk2(s[2 * s8][0], s[2 * s8][1]); pw.y = pk2(s[2 * s8][2], s[2 * s8][3]); pw.z = pk2(s[2 * s8 + 1][0], s[2 * s8 + 1][1]); pw.w = pk2(s[2 * s8 + 1][2], s[2 * s8 + 1][3]);
        const bf16x8 pb = __builtin_bit_cast(bf16x8, pw);
        const int rowA = 32 * s8 + 4 * g + trq, swz = (rowA >> 1) & 3;
#pragma unroll
        for (int eb = 0; eb < 4; ++eb) { const LAS unsigned char* vp = Vs + rowA * 128 + ((eb ^ swz) * 32) + 8 * trp;
            const v4i16 lo = __builtin_amdgcn_ds_read_tr16_b64_v4i16((LAS v4i16*)vp), hi = __builtin_amdgcn_ds_read_tr16_b64_v4i16((LAS v4i16*)(vp + 16 * 128));
            bf16x8 af; af[0] = lo[0]; af[1] = lo[1]; af[2] = lo[2]; af[3] = lo[3]; af[4] = hi[0]; af[5] = hi[1]; af[6] = hi[2]; af[7] = hi[3];
            o[eb] = __builtin_amdgcn_mfma_f32_16x16x32_bf16(af, pb, o[eb], 0, 0, 0); } }
    const float inv = 1.0f / den; const size_t tokq = zrow0 + ((size_t)(128 * n + q) << dsh) + r;
    bf16* op = OP + ((size_t)br * NTOK + tokq) * 256 + h * 64 + 4 * g;
#pragma unroll
    for (int eb = 0; eb < 4; ++eb) { u32x2 wv; wv.x = pk2(o[eb][0] * inv, o[eb][1] * inv); wv.y = pk2(o[eb][2] * inv, o[eb][3] * inv); *(u32x2*)(op + 16 * eb) = wv; }
    if (g == 0) LSE[((size_t)br * NTOK + tokq) * 4 + h] = mx + __logf(den);
    BAR();
}

__device__ __forceinline__ void attn_merge(Frame& F, const bf16* OP, const float* LSE, bf16* Y, int wi, int nw) {
    const int tid = mytid(F), lane = tid & 63, wave = __builtin_amdgcn_readfirstlane(tid >> 6); (void)lane; (void)wave;
    const int gt = wi * NTHREADS + tid, NGT = nw * NTHREADS;
    for (int idx = gt; idx < NTOK * 32; idx += NGT) { const int tok = idx >> 5, c8 = idx & 31, h = c8 >> 3;
        const float l0 = LSE[((size_t)0 * NTOK + tok) * 4 + h], l1 = LSE[((size_t)1 * NTOK + tok) * 4 + h], l2 = LSE[((size_t)2 * NTOK + tok) * 4 + h];
        const float m = fmaxf(l0, fmaxf(l1, l2)); float w0 = __expf(l0 - m), w1 = __expf(l1 - m), w2 = __expf(l2 - m); const float inv = 1.0f / (w0 + w1 + w2); w0 *= inv; w1 *= inv; w2 *= inv;
        const u32x4 a = *(const u32x4*)(OP + ((size_t)0 * NTOK + tok) * 256 + c8 * 8), bq = *(const u32x4*)(OP + ((size_t)1 * NTOK + tok) * 256 + c8 * 8), c = *(const u32x4*)(OP + ((size_t)2 * NTOK + tok) * 256 + c8 * 8);
        float fa[8], fb[8], fc[8]; unpack8(a, fa); unpack8(bq, fb); unpack8(c, fc); float r[8];
#pragma unroll
        for (int e = 0; e < 8; ++e) r[e] = w0 * fa[e] + w1 * fb[e] + w2 * fc[e];
        u32x4 o; o.x = pk2(r[0], r[1]); o.y = pk2(r[2], r[3]); o.z = pk2(r[4], r[5]); o.w = pk2(r[6], r[7]);
        *(u32x4*)(Y + (size_t)tok * DM + c8 * 8) = o; }
}

__device__ __forceinline__ void conv_item(Frame& F, const bf16* Z, bf16* Y, const float* cw, const float* cb, const float* lg, const float* lb, int item) {
    const int tid = mytid(F), b = item >> 6, t0 = (item & 63) * 64;
    LAS float* HG = (LAS float*)F.lds;
    LAS float* WL = (LAS float*)(F.lds + 96256);
    f32x4 wq[4]; u32x4 uu[6], gg[6];
#pragma unroll
    for (int i = 0; i < 4; ++i) { const int q = tid + NTHREADS * i; wq[i] = (q < 31 * 64) ? *(const f32x4*)(cw + 4 * q) : (f32x4){0.f, 0.f, 0.f, 0.f}; }
#pragma unroll
    for (int i = 0; i < 6; ++i) { const int p = tid + NTHREADS * i, row = p >> 5, c8 = p & 31, t = t0 - 30 + row; uu[i] = (u32x4){0u, 0u, 0u, 0u}; gg[i] = uu[i];
        if (p < 94 * 32 && t >= 0) { const bf16* zr = Z + ((size_t)b * SEQ + t) * INW + ZB + c8 * 8; uu[i] = *(const u32x4*)zr; gg[i] = *(const u32x4*)(zr + 256); } }
#pragma unroll
    for (int i = 0; i < 4; ++i) { const int q = tid + NTHREADS * i; if (q < 31 * 64) *(LAS f32x4*)(WL + 4 * q) = wq[i]; }
#pragma unroll
    for (int i = 0; i < 6; ++i) { const int p = tid + NTHREADS * i, row = p >> 5, c8 = p & 31;
        if (p < 94 * 32) { float fu[8], fg[8], hv[8]; unpack8(uu[i], fu); unpack8(gg[i], fg);
#pragma unroll
            for (int e = 0; e < 8; ++e) hv[e] = fu[e] * __builtin_amdgcn_rcpf(1.0f + __expf(-fg[e]));
            LAS f32x4* d = (LAS f32x4*)(HG + row * 256 + c8 * 8); d[0] = (f32x4){hv[0], hv[1], hv[2], hv[3]}; d[1] = (f32x4){hv[4], hv[5], hv[6], hv[7]}; } }
    BAR();
    const int tt = tid >> 3, cs = tid & 7;
    f32x4 acc[8];
#pragma unroll
    for (int i = 0; i < 8; ++i) acc[i] = *(const f32x4*)(cb + 4 * (cs + 8 * i));
    for (int j = 0; j < 31; ++j) {
#pragma unroll
        for (int i = 0; i < 8; ++i) { const int qd = cs + 8 * i; acc[i] += *(const LAS f32x4*)(HG + (tt + j) * 256 + 4 * qd) * *(const LAS f32x4*)(WL + j * 256 + 4 * qd); } }
    bf16* yr = Y + ((size_t)b * SEQ + t0 + tt) * DM + 256;
#pragma unroll
    for (int gi = 0; gi < 4; ++gi) {
        const f32x4 x0 = acc[2 * gi], x1 = acc[2 * gi + 1];
        float s = ((x0[0] + x0[1]) + (x0[2] + x0[3])) + ((x1[0] + x1[1]) + (x1[2] + x1[3])); s = red8(s);
        const float mean = s * (1.0f / 64.0f); const f32x4 d0 = x0 - mean, d1 = x1 - mean;
        float ss = ((d0[0] * d0[0] + d0[1] * d0[1]) + (d0[2] * d0[2] + d0[3] * d0[3])) + ((d1[0] * d1[0] + d1[1] * d1[1]) + (d1[2] * d1[2] + d1[3] * d1[3])); ss = red8(ss);
        const float rstd = __builtin_amdgcn_rsqf(ss * (1.0f / 64.0f) + 1e-5f);
#pragma unroll
        for (int k = 0; k < 2; ++k) { const int qd = cs + 8 * (2 * gi + k); const f32x4 dd = k ? d1 : d0; const f32x4 gv = *(const f32x4*)(lg + 4 * qd), bv = *(const f32x4*)(lb + 4 * qd); float y[4];
#pragma unroll
            for (int e = 0; e < 4; ++e) y[e] = siluf_(dd[e] * rstd * gv[e] + bv[e]);
            u32x2 wv; wv.x = pk2(y[0], y[1]); wv.y = pk2(y[2], y[3]); *(u32x2*)(yr + 4 * qd) = wv; } }
    BAR();
}

__device__ __forceinline__ bf16x8 ldfrag(const LAS unsigned char* base, int stride, int row0, int kb0, int fr, int g) {
    return *(const LAS bf16x8*)(base + (row0 + fr) * stride + kb0 + 16 * g);
}
#define MFMA16(a, b, c) __builtin_amdgcn_mfma_f32_16x16x32_bf16((a), (b), (c), 0, 0, 0)

constexpr int GL_G2 = 0, GL_Q = 2048, GL_K = 6144, GL_GK = 10240, GL_GD = 14336, GL_OG = 16384, GL_QT = 24576, GL_KB = 27136, GL_KHT = 29696, GL_VT = 32256, GL_ATT = 37376, GL_ST = 39936, GL_EC = 45056,
              GL_OB = 45184, GL_GB = 53376, GL_END = 53504;
struct GlaRaw { u32x4 p[2]; u32x4 s; };
__device__ __forceinline__ void gla_decode(int tid, int h, int it, int& tt, int& col, int& kind, int& off, bool& ok) {
    const int p = tid + 512 * it; ok = p < 832; tt = p / 26; const int qd = p % 26;
    if (qd < 4) { col = ZD + h * 32 + 8 * qd; kind = 0; off = tt * 32 + 8 * qd; }
    else if (qd < 8) { col = ZD + 128 + h * 32 + 8 * (qd - 4); kind = 1; off = tt * 32 + 8 * (qd - 4); }
    else if (qd < 16) { col = ZD + 256 + h * 64 + 8 * (qd - 8); kind = 2; off = 8 * (qd - 8); }
    else if (qd < 18) { col = ZD + 512 + 8 * (qd - 16); kind = 3; off = tt * 16 + 8 * (qd - 16); }
    else { col = ZD + 528 + h * 64 + 8 * (qd - 18); kind = 4; off = tt * 64 + 8 * (qd - 18); }
}
template <int STEP> __device__ __forceinline__ void gla_load(const bf16* Z, const unsigned char* sst, int b, int h, int ch, int tid, GlaRaw& r) {
#pragma unroll
    for (int it = 0; it < 2; ++it) { int tt, col, kind, off; bool ok; gla_decode(tid, h, it, tt, col, kind, off, ok);
        r.p[it] = ok ? *(const u32x4*)(Z + ((size_t)b * SEQ + ch * 32 + tt) * INW + col) : (u32x4){0u, 0u, 0u, 0u}; }
    if (STEP == 1) r.s = (tid < 256) ? *(const u32x4*)(sst + (size_t)((b * 4 + h) * (SEQ / 32) + ch) * 4096 + 16 * tid) : (u32x4){0u, 0u, 0u, 0u};
}
template <int STEP> __device__ __forceinline__ void gla_item(Frame& F, const GlaRaw& raw, unsigned char* con, float* ecg, bf16* Y, const float* ng, int b, int h, int ch) {
    const int tid = mytid(F), lane = tid & 63, w = __builtin_amdgcn_readfirstlane(tid >> 6), fr = lane & 15, g = lane >> 4;
    LAS unsigned char* L = F.lds;
    LAS float *G2 = (LAS float*)(L + GL_G2), *QF = (LAS float*)(L + GL_Q), *KF = (LAS float*)(L + GL_K), *GK = (LAS float*)(L + GL_GK), *GD = (LAS float*)(L + GL_GD), *OG = (LAS float*)(L + GL_OG),
              *OB = (LAS float*)(L + GL_OB), *GB = (LAS float*)(L + GL_GB);
    LAS unsigned char *QT = L + GL_QT, *KB = L + GL_KB, *KHT = L + GL_KHT, *VT = L + GL_VT, *ATT = L + GL_ATT, *ST = L + GL_ST;
    const size_t item = (size_t)((b * 4 + h) * (SEQ / 32) + ch);
#pragma unroll
    for (int it = 0; it < 2; ++it) { int tt, col, kind, off; bool ok; gla_decode(tid, h, it, tt, col, kind, off, ok);
        if (ok) { float f[8]; unpack8(raw.p[it], f);
            if (kind == 2) { LAS unsigned short* vp = (LAS unsigned short*)(VT + off * 80 + tt * 2); const u32x4 pr = raw.p[it];
                vp[0 * 40] = (unsigned short)(pr.x & 0xffffu); vp[1 * 40] = (unsigned short)(pr.x >> 16); vp[2 * 40] = (unsigned short)(pr.y & 0xffffu); vp[3 * 40] = (unsigned short)(pr.y >> 16);
                vp[4 * 40] = (unsigned short)(pr.z & 0xffffu); vp[5 * 40] = (unsigned short)(pr.z >> 16); vp[6 * 40] = (unsigned short)(pr.w & 0xffffu); vp[7 * 40] = (unsigned short)(pr.w >> 16); }
            else if (kind != 4 || STEP == 1) { LAS float* dst = (kind == 0 ? QF : kind == 1 ? KF : kind == 3 ? GD : OG) + off; const float sc = kind == 0 ? 0.17677669529663687f : 1.0f;
                ((LAS f32x4*)dst)[0] = (f32x4){f[0] * sc, f[1] * sc, f[2] * sc, f[3] * sc}; ((LAS f32x4*)dst)[1] = (f32x4){f[4] * sc, f[5] * sc, f[6] * sc, f[7] * sc}; } } }
    if (STEP == 1 && tid < 256) *(LAS u32x4*)(ST + (tid >> 2) * 80 + (tid & 3) * 16) = raw.s;
    BAR();
#pragma unroll
    for (int it = 0; it < 2; ++it) { const int o = tid + 512 * it, tt = o >> 5, kk = o & 31; float x = GB[kk];
#pragma unroll
        for (int j = 0; j < 16; ++j) x += GD[tt * 16 + j] * G2[j * 32 + kk];
        GK[tt * 32 + kk] = -softplusf_(-x) * (1.0f / 16.0f); }
    BAR();
    { const int t = tid >> 4, k2 = (tid & 15) * 2; float c0 = 0.f, c1 = 0.f, b0 = 0.f, b1 = 0.f;
#pragma unroll 8
        for (int s = 0; s < 32; ++s) { const f32x2 gk = *(const LAS f32x2*)(GK + s * 32 + k2); c0 += gk[0]; c1 += gk[1]; if (s == t) { b0 = c0; b1 = c1; } }
        const f32x2 q = *(const LAS f32x2*)(QF + t * 32 + k2), k = *(const LAS f32x2*)(KF + t * 32 + k2);
        if (STEP == 1) { *(LAS unsigned*)(QT + t * 80 + k2 * 2) = pk2(q[0] * __expf(b0), q[1] * __expf(b1)); *(LAS unsigned*)(KB + t * 80 + k2 * 2) = pk2(k[0] * __expf(-b0), k[1] * __expf(-b1)); }
        else { *(LAS unsigned short*)(KHT + k2 * 80 + t * 2) = (unsigned short)f2bf(k[0] * __expf(c0 - b0)); *(LAS unsigned short*)(KHT + (k2 + 1) * 80 + t * 2) = (unsigned short)f2bf(k[1] * __expf(c1 - b1));
            if (t == 0) { ecg[item * 32 + k2] = __expf(c0); ecg[item * 32 + k2 + 1] = __expf(c1); } } }
    BAR();
    if (STEP == 0) {
        const int kb = w >> 2, vb = w & 3; f32x4 d = (f32x4){0.f, 0.f, 0.f, 0.f};
        d = MFMA16(ldfrag(KHT, 80, 16 * kb, 0, fr, g), ldfrag(VT, 80, 16 * vb, 0, fr, g), d);
        u32x2 so; so.x = pk2(d[0], d[1]); so.y = pk2(d[2], d[3]); *(u32x2*)(con + item * 4096 + (16 * vb + fr) * 64 + (16 * kb + 4 * g) * 2) = so;
        BAR();
    } else {
        if (w < 3) { const int atb = w == 0 ? 0 : 1, asb = w == 2 ? 1 : 0;
            f32x4 d = (f32x4){0.f, 0.f, 0.f, 0.f}; d = MFMA16(ldfrag(KB, 80, 16 * asb, 0, fr, g), ldfrag(QT, 80, 16 * atb, 0, fr, g), d);
            const int t = 16 * atb + fr; float v[4];
#pragma unroll
            for (int r = 0; r < 4; ++r) { const int s = 16 * asb + 4 * g + r; v[r] = (s <= t) ? d[r] : 0.f; }
            u32x2 o; o.x = pk2(v[0], v[1]); o.y = pk2(v[2], v[3]); *(LAS u32x2*)(ATT + t * 80 + (16 * asb + 4 * g) * 2) = o; }
        else if (w == 3) { *(LAS u32x2*)(ATT + fr * 80 + (16 + 4 * g) * 2) = (u32x2){0u, 0u}; }
        BAR();
        { const int tb = w >> 2, vb = w & 3; f32x4 o = (f32x4){0.f, 0.f, 0.f, 0.f};
            o = MFMA16(ldfrag(ATT, 80, 16 * tb, 0, fr, g), ldfrag(VT, 80, 16 * vb, 0, fr, g), o);
            o = MFMA16(ldfrag(QT, 80, 16 * tb, 0, fr, g), ldfrag(ST, 80, 16 * vb, 0, fr, g), o);
#pragma unroll
            for (int r = 0; r < 4; ++r) OB[(16 * tb + 4 * g + r) * 64 + 16 * vb + fr] = o[r]; }
        BAR();
        { const int tt = tid >> 4, v4 = (tid & 15) * 4; const f32x4 o = *(const LAS f32x4*)(OB + tt * 64 + v4);
            float ss = (o[0] * o[0] + o[1] * o[1]) + (o[2] * o[2] + o[3] * o[3]); ss = red16(ss);
            const float rs = __builtin_amdgcn_rsqf(ss * (1.0f / 64.0f) + NORM_EPS); const f32x4 gv = *(const f32x4*)(ng + v4), og = *(const LAS f32x4*)(OG + tt * 64 + v4); float y[4];
#pragma unroll
            for (int e = 0; e < 4; ++e) y[e] = o[e] * rs * gv[e] * og[e] * __builtin_amdgcn_rcpf(1.0f + __expf(-og[e]));
            u32x2 wv; wv.x = pk2(y[0], y[1]); wv.y = pk2(y[2], y[3]); *(u32x2*)(Y + ((size_t)b * SEQ + ch * 32 + tt) * DM + 768 + h * 64 + v4) = wv; }
        BAR();
    }
}
template <int STEP> __device__ __forceinline__ void gla_items(Frame& F, const bf16* Z, unsigned char* con, float* ecg, bf16* Y, const float* g2, const float* gb, const float* ng, int wi, int nw) {
    const int tid = mytid(F);
#pragma unroll 1
    for (int h = 0; h < 4; ++h) {
        ((LAS float*)(F.lds + GL_G2))[tid] = g2[(tid >> 5) * 128 + h * 32 + (tid & 31)]; if (tid < 32) ((LAS float*)(F.lds + GL_GB))[tid] = gb[h * 32 + tid];
        BAR();
        GlaRaw cur, nxt; cur.p[0] = (u32x4){0u, 0u, 0u, 0u}; cur.p[1] = cur.p[0]; cur.s = cur.p[0]; nxt = cur;
        if (wi < 1024) gla_load<STEP>(Z, con, wi >> 7, h, wi & 127, tid, cur);
#pragma unroll 1
        for (int it = wi; it < 1024; it += nw) { const int nx = it + nw;
            if (nx < 1024) gla_load<STEP>(Z, con, nx >> 7, h, nx & 127, tid, nxt);
            gla_item<STEP>(F, cur, con, ecg, Y, ng, it >> 7, h, it & 127);
            cur = nxt; }
        BAR(); }
}
__device__ __forceinline__ void gla_scan(Frame& F, unsigned char* con, const float* ecg, int b, int h) {
    const int tid = mytid(F); const int k4 = (tid & 7) * 4;
    unsigned char* base = con + (size_t)((b * 4 + h) * (SEQ / 32)) * 4096 + 8 * tid; const float* eb = ecg + (size_t)((b * 4 + h) * (SEQ / 32)) * 32 + k4;
    float s[4] = {0.f, 0.f, 0.f, 0.f};
    u32x2 cn[4]; f32x4 ec[4];
#pragma unroll
    for (int j = 0; j < 4; ++j) { cn[j] = *(const u32x2*)(base + (size_t)j * 4096); ec[j] = *(const f32x4*)(eb + j * 32); }
#pragma unroll 1
    for (int c0 = 0; c0 < SEQ / 32; c0 += 4) {
        u32x2 cc[4]; f32x4 ee[4];
#pragma unroll
        for (int j = 0; j < 4; ++j) { cc[j] = cn[j]; ee[j] = ec[j]; }
        if (c0 + 4 < SEQ / 32) {
#pragma unroll
            for (int j = 0; j < 4; ++j) { cn[j] = *(const u32x2*)(base + (size_t)(c0 + 4 + j) * 4096); ec[j] = *(const f32x4*)(eb + (c0 + 4 + j) * 32); } }
#pragma unroll
        for (int j = 0; j < 4; ++j) { u32x2 o; o.x = pk2(s[0], s[1]); o.y = pk2(s[2], s[3]); *(u32x2*)(base + (size_t)(c0 + j) * 4096) = o;
            s[0] = ee[j][0] * s[0] + bflo(cc[j].x); s[1] = ee[j][1] * s[1] + bfhi(cc[j].x); s[2] = ee[j][2] * s[2] + bflo(cc[j].y); s[3] = ee[j][3] * s[3] + bfhi(cc[j].y); } }
}

struct RwkvP { const float *mu, *w0, *w2, *a0, *a2, *g2, *kk, *ka, *rk, *lg, *lb; };
constexpr int RC_AT = 0  , RC_RT = 2048  , RC_ZT = 4096, RC_RBK = 5120, RC_BKT = 6144  , RC_VT4 = 10240  ,
              RC_GC = 12288  , RC_G = 12544  , RC_BON = 14592  , RC_BYTES = 14656, RC_STRIDE = 14848;
constexpr int RC_CHUNKS16 = RC_BYTES / 16;
static_assert((size_t)NB * 4 * (SEQ / 16) * RC_STRIDE <= NEXP * MOEW_E_BYTES, "RWKV records overlay the (not yet converted) MoE weight region");
constexpr int RW_W2T = 0, RW_A2T = 5120, RW_G2T = 10240, RW_MU = 19456  , RW_TW = 23040, RW_AD = 24320, RW_SG = 25600, RW_R = 27904, RW_K = 32000, RW_V = 36096, RW_WL = 40192, RW_AL = 44288,
              RW_G = 48384, RW_KK = 52480, RW_KP = 56576, RW_BON = 60672, RW_GC = 60736, RW_AR = 60992, RW_BK = 65600, RW_BKT = 70208, RW_ZAK = 75328, RW_RBK = 76608, RW_AAB = 77888, RW_TT = 78912  , RW_PAR = 80192  , RW_END = 81472;

__device__ __forceinline__ void rwkv_prep_init(Frame& F, const RwkvP P, int h) {
    const int tid = mytid(F); LAS unsigned char* L = F.lds;
    for (int i = tid; i < 64 * 32; i += NTHREADS) { const int c = i >> 5, j = i & 31;
        *(LAS unsigned short*)(L + RW_W2T + c * 80 + j * 2) = (unsigned short)f2bf(P.w2[j * 256 + h * 64 + c]); *(LAS unsigned short*)(L + RW_A2T + c * 80 + j * 2) = (unsigned short)f2bf(P.a2[j * 256 + h * 64 + c]); }
    for (int i = tid; i < 64 * 64; i += NTHREADS) { const int c = i >> 6, j = i & 63; *(LAS unsigned short*)(L + RW_G2T + c * 144 + j * 2) = (unsigned short)f2bf(P.g2[j * 256 + h * 64 + c]); }
    for (int i = tid; i < 896; i += NTHREADS) ((LAS float*)(L + RW_MU))[i] = P.mu[i];
    if (tid < 320) { const int q = tid >> 6, c = tid & 63; const float* src = q == 0 ? P.w0 : q == 1 ? P.a0 : q == 2 ? P.kk : q == 3 ? P.ka : P.rk; ((LAS float*)(L + RW_PAR))[tid] = src[h * 64 + c]; }
}
__device__ __forceinline__ void rwkv_prep_load(const bf16* Z, int b, int h, int ch, int w, int lane, u32x4 (&cur)[2], u32x4 (&prv)[2]) {
    const int kind = w & 3, p = (w >> 2) * 64 + lane, tt = p >> 3, j = p & 7;
    const int col = (kind < 3 ? ZC + kind * 256 + h * 64 : ZC + 832) + 8 * j;
    const int t = ch * 16 + tt; const bf16* zr = Z + ((size_t)b * SEQ + t) * INW + col;
    cur[0] = *(const u32x4*)zr; prv[0] = (t > 0) ? *(const u32x4*)(zr - INW) : (u32x4){0u, 0u, 0u, 0u};
    if (w < 2) { const int t2 = ch * 16 + (lane >> 2); const bf16* z2 = Z + ((size_t)b * SEQ + t2) * INW + ZC + 768 + w * 32 + 8 * (lane & 3);
        cur[1] = *(const u32x4*)z2; prv[1] = (t2 > 0) ? *(const u32x4*)(z2 - INW) : (u32x4){0u, 0u, 0u, 0u}; }
    else { cur[1] = (u32x4){0u, 0u, 0u, 0u}; prv[1] = cur[1]; }
}
__device__ __forceinline__ void rwkv_prep_item(Frame& F, unsigned char* rec, const RwkvP P, int h, const u32x4 (&cur)[2], const u32x4 (&prv)[2]) {
    const int tid = mytid(F), lane = tid & 63, w = __builtin_amdgcn_readfirstlane(tid >> 6), fr = lane & 15, g = lane >> 4;
    LAS unsigned char* L = F.lds;
#if defined(PROBE_PI)
    unsigned long long tl_ = __builtin_amdgcn_s_memrealtime(), ta_ = 0;
#define PIT(k) do { const unsigned long long tn_ = __builtin_amdgcn_s_memrealtime(); if ((k) == PROBE_PI) ta_ += tn_ - tl_; tl_ = tn_; } while (0)
#else
#define PIT(k) do { } while (0)
#endif
    LAS float *R = (LAS float*)(L + RW_R), *KR = (LAS float*)(L + RW_K), *V = (LAS float*)(L + RW_V), *WL = (LAS float*)(L + RW_WL), *AL = (LAS float*)(L + RW_AL), *G = (LAS float*)(L + RW_G),
              *KK = (LAS float*)(L + RW_KK), *KP = (LAS float*)(L + RW_KP), *BON = (LAS float*)(L + RW_BON), *GC = (LAS float*)(L + RW_GC), *AAB = (LAS float*)(L + RW_AAB), *MU = (LAS float*)(L + RW_MU);
    { const int kind = w & 3, p = (w >> 2) * 64 + lane, tt = p >> 3, j = p & 7; float fc[8], fp[8], x[8]; unpack8(cur[0], fc); unpack8(prv[0], fp);
        const LAS float* mu = MU + (kind < 3 ? kind * 256 + h * 64 : 832) + 8 * j;
#pragma unroll
        for (int e = 0; e < 8; ++e) x[e] = fc[e] + (fp[e] - fc[e]) * mu[e];
        if (kind < 3) { LAS f32x4* d = (LAS f32x4*)((kind == 0 ? R : kind == 1 ? KR : V) + tt * 64 + 8 * j); d[0] = (f32x4){x[0], x[1], x[2], x[3]}; d[1] = (f32x4){x[4], x[5], x[6], x[7]}; }
        else {
#pragma unroll
            for (int e = 0; e < 8; ++e) x[e] = __builtin_amdgcn_rcpf(1.0f + __expf(-x[e]));
            u32x4 o; o.x = pk2(x[0], x[1]); o.y = pk2(x[2], x[3]); o.z = pk2(x[4], x[5]); o.w = pk2(x[6], x[7]); *(LAS u32x4*)(L + RW_SG + tt * 144 + 16 * j) = o; }
        if (w < 2) { const int t2 = lane >> 2, j2 = lane & 3; unpack8(cur[1], fc); unpack8(prv[1], fp); const LAS float* mu2 = MU + 768 + w * 32 + 8 * j2;
#pragma unroll
            for (int e = 0; e < 8; ++e) { x[e] = fc[e] + (fp[e] - fc[e]) * mu2[e]; if (w == 0) x[e] = 2.0f * __builtin_amdgcn_rcpf(1.0f + __expf(-2.0f * x[e])) - 1.0f; }
            u32x4 o; o.x = pk2(x[0], x[1]); o.y = pk2(x[2], x[3]); o.z = pk2(x[4], x[5]); o.w = pk2(x[6], x[7]); *(LAS u32x4*)(L + (w == 0 ? RW_TW : RW_AD) + t2 * 80 + 16 * j2) = o; } }
    BAR(); PIT(0);
    if (w < 4) { f32x4 dw = (f32x4){0.f, 0.f, 0.f, 0.f}, da = dw;
        dw = MFMA16(ldfrag(L + RW_W2T, 80, 16 * w, 0, fr, g), ldfrag(L + RW_TW, 80, 0, 0, fr, g), dw);
        da = MFMA16(ldfrag(L + RW_A2T, 80, 16 * w, 0, fr, g), ldfrag(L + RW_AD, 80, 0, 0, fr, g), da);
        *(LAS f32x4*)(WL + fr * 64 + 16 * w + 4 * g) = dw; *(LAS f32x4*)(AL + fr * 64 + 16 * w + 4 * g) = da; }
    else { const int cb = w - 4; f32x4 dg = (f32x4){0.f, 0.f, 0.f, 0.f};
        dg = MFMA16(ldfrag(L + RW_G2T, 144, 16 * cb, 0, fr, g), ldfrag(L + RW_SG, 144, 0, 0, fr, g), dg);
        dg = MFMA16(ldfrag(L + RW_G2T, 144, 16 * cb, 64, fr, g), ldfrag(L + RW_SG, 144, 0, 64, fr, g), dg);
        *(LAS f32x4*)(G + fr * 64 + 16 * cb + 4 * g) = dg; }
    BAR(); PIT(1);
    { const int t = tid >> 5, c2 = (tid & 31) * 2; const LAS float* PAR = (const LAS float*)(L + RW_PAR) + c2;
        const f32x2 wl = *(const LAS f32x2*)(WL + t * 64 + c2) + *(const LAS f32x2*)(PAR), al = *(const LAS f32x2*)(AL + t * 64 + c2) + *(const LAS f32x2*)(PAR + 64);
        const f32x2 kr = *(const LAS f32x2*)(KR + t * 64 + c2), rr = *(const LAS f32x2*)(R + t * 64 + c2);
        const f32x2 kkw = *(const LAS f32x2*)(PAR + 128), kaw = *(const LAS f32x2*)(PAR + 192), rkw = *(const LAS f32x2*)(PAR + 256);
        f32x2 lw, a, kk, kp; float ss = 0.f, bon = 0.f;
#pragma unroll
        for (int e = 0; e < 2; ++e) { const float wlog = -softplusf_(-wl[e]) - 0.5f; lw[e] = -__expf(wlog); a[e] = __builtin_amdgcn_rcpf(1.0f + __expf(-al[e])); kk[e] = kr[e] * kkw[e]; ss += kk[e] * kk[e];
            kp[e] = kr[e] * (1.0f + (a[e] - 1.0f) * kaw[e]); bon += rr[e] * kp[e] * rkw[e]; }
        ss = red16(ss); bon = red16(bon); ss += __shfl_xor(ss, 16); bon += __shfl_xor(bon, 16);
        const float inv = 1.0f / fmaxf(sqrtf(ss), 1e-12f); kk = kk * inv;
        *(LAS f32x2*)(WL + t * 64 + c2) = lw; *(LAS f32x2*)(AL + t * 64 + c2) = a; *(LAS f32x2*)(KK + t * 64 + c2) = kk; *(LAS f32x2*)(KP + t * 64 + c2) = kp;
        if ((tid & 31) == 0) BON[t] = bon; }
    BAR(); PIT(2);
    { const int t = tid >> 5, c2 = (tid & 31) * 2;
        f32x2 cs = (f32x2){0.f, 0.f}, ct = cs;
#pragma unroll
        for (int s = 0; s < 16; ++s) { cs += *(const LAS f32x2*)(WL + s * 64 + c2); if (s == t) ct = cs; }
        const f32x2 lwt = *(const LAS f32x2*)(WL + t * 64 + c2), a = *(const LAS f32x2*)(AL + t * 64 + c2), kk = *(const LAS f32x2*)(KK + t * 64 + c2), kp = *(const LAS f32x2*)(KP + t * 64 + c2), rr = *(const LAS f32x2*)(R + t * 64 + c2);
        float at[2], rt[2], bb[2], kb[2], bh[2], kh[2];
#pragma unroll
        for (int e = 0; e < 2; ++e) { const float eP = __expf(ct[e] - lwt[e]), eT = __expf(ct[e]), eI = __expf(-ct[e]), eC = __expf(cs[e] - ct[e]); const float bv = kk[e] * a[e];
            at[e] = -kk[e] * eP; rt[e] = rr[e] * eT; bb[e] = bv * eI; kb[e] = kp[e] * eI; bh[e] = bv * eC; kh[e] = kp[e] * eC; }
        *(LAS unsigned*)(L + RW_AR + t * 144 + c2 * 2) = pk2(at[0], at[1]); *(LAS unsigned*)(L + RW_AR + (16 + t) * 144 + c2 * 2) = pk2(rt[0], rt[1]);
        *(LAS unsigned*)(L + RW_BK + t * 144 + c2 * 2) = pk2(bb[0], bb[1]); *(LAS unsigned*)(L + RW_BK + (16 + t) * 144 + c2 * 2) = pk2(kb[0], kb[1]);
#pragma unroll
        for (int e = 0; e < 2; ++e) { *(LAS unsigned short*)(L + RW_BKT + (c2 + e) * 80 + t * 2) = (unsigned short)f2bf(bh[e]); *(LAS unsigned short*)(L + RW_BKT + (c2 + e) * 80 + (16 + t) * 2) = (unsigned short)f2bf(kh[e]); }
        if (t == 0) { GC[c2] = __expf(cs[0]); GC[c2 + 1] = __expf(cs[1]); } }
    BAR(); PIT(3);
    if (w < 4) { const int arow = (w & 1) ? 16 : 0  , brow = (w & 2) ? 16 : 0  ;
        f32x4 d = (f32x4){0.f, 0.f, 0.f, 0.f};
        d = MFMA16(ldfrag(L + RW_BK, 144, arow, 0, fr, g), ldfrag(L + RW_AR, 144, brow, 0, fr, g), d);
        d = MFMA16(ldfrag(L + RW_BK, 144, arow, 64, fr, g), ldfrag(L + RW_AR, 144, brow, 64, fr, g), d);
        const int t = fr; float v[4];
#pragma unroll
        for (int r = 0; r < 4; ++r) { const int s = 4 * g + r; const bool keep = (w < 2) ? (s < t) : (s <= t); v[r] = keep ? d[r] : 0.f; }
        if (w == 0) { AAB[(4 * g + 0) * 16 + t] = v[0]; AAB[(4 * g + 1) * 16 + t] = v[1]; AAB[(4 * g + 2) * 16 + t] = v[2]; AAB[(4 * g + 3) * 16 + t] = v[3]; }
        else { u32x2 o; o.x = pk2(v[0], v[1]); o.y = pk2(v[2], v[3]);
            LAS unsigned char* dst = (w == 1) ? (L + RW_ZAK + t * 80 + (16 + 4 * g) * 2) : (w == 2) ? (L + RW_RBK + t * 80 + (4 * g) * 2) : (L + RW_RBK + t * 80 + (16 + 4 * g) * 2);
            *(LAS u32x2*)dst = o; } }
    BAR(); PIT(4);
    if (w == 7) { if (lane < 16) { float col[16];
#pragma unroll
            for (int t = 0; t < 16; ++t) col[t] = (t == lane) ? 1.0f : 0.f;
#pragma unroll
            for (int s = 0; s < 15; ++s) { const f32x4 a0 = *(const LAS f32x4*)(AAB + s * 16), a1 = *(const LAS f32x4*)(AAB + s * 16 + 4), a2 = *(const LAS f32x4*)(AAB + s * 16 + 8), a3 = *(const LAS f32x4*)(AAB + s * 16 + 12);
                const float as[16] = {a0[0], a0[1], a0[2], a0[3], a1[0], a1[1], a1[2], a1[3], a2[0], a2[1], a2[2], a2[3], a3[0], a3[1], a3[2], a3[3]};
#pragma unroll
                for (int t = s + 1; t < 16; ++t) col[t] += as[t] * col[s]; }
#pragma unroll
            for (int t = 0; t < 16; ++t) *(LAS unsigned short*)(L + RW_TT + t * 80 + lane * 2) = (unsigned short)f2bf(col[t]); }
        LDS_WAIT();
        { const u32x2 lo = *(const LAS u32x2*)(L + RW_TT + fr * 80 + 8 * g), hi = *(const LAS u32x2*)(L + RW_ZAK + fr * 80 + 32 + 8 * g); u32x4 o; o.x = lo.x; o.y = lo.y; o.z = hi.x; o.w = hi.y;
            *(u32x4*)(rec + RC_ZT + fr * 64 + 16 * g) = o; } }
    else {
#pragma unroll 1
        for (int job = w; job < 16; job += 7) {
            if (job < 9) { int src, stride, row0, ka, kb2, dst;
                if (job < 4) { src = RW_AR; stride = 144; row0 = (job >> 1) * 16; ka = 32 * (job & 1); kb2 = ka + 16; dst = (job >> 1 ? RC_RT : RC_AT) + (job & 1) * 1024; }
                else if (job == 4) { src = RW_RBK; stride = 80; row0 = 0; ka = 0; kb2 = 16; dst = RC_RBK; }
                else { src = RW_BKT; stride = 80; row0 = 16 * (job - 5); ka = 0; kb2 = 16; dst = RC_BKT + (job - 5) * 1024; }
                const LAS unsigned char* rp = L + src + (row0 + fr) * stride + 8 * g; const u32x2 lo = *(const LAS u32x2*)(rp + ka * 2), hi = *(const LAS u32x2*)(rp + kb2 * 2);
                u32x4 o; o.x = lo.x; o.y = lo.y; o.z = hi.x; o.w = hi.y; *(u32x4*)(rec + dst + fr * 64 + 16 * g) = o; }
            else if (job < 13) { const int vb = job - 9; const LAS float* vp = V + (4 * g) * 64 + 16 * vb + fr; u32x2 o; o.x = pk2(vp[0], vp[64]); o.y = pk2(vp[128], vp[192]); *(u32x2*)(rec + RC_VT4 + vb * 512 + lane * 8) = o; }
            else { const int p = (job - 13) * 64 + lane;
                if (p < 16) *(f32x4*)(rec + RC_GC + 16 * p) = *(const LAS f32x4*)(GC + 4 * p);
                else if (p < 144) { const int q = p - 16; const f32x4 a = *(const LAS f32x4*)(G + q * 8), c = *(const LAS f32x4*)(G + q * 8 + 4); u32x4 o; o.x = pk2(a[0], a[1]); o.y = pk2(a[2], a[3]); o.z = pk2(c[0], c[1]); o.w = pk2(c[2], c[3]); *(u32x4*)(rec + RC_G + 16 * q) = o; }
                else if (p < 148) { const int q = p - 144; *(f32x4*)(rec + RC_BON + 16 * q) = *(const LAS f32x4*)(BON + 4 * q); } } } }
    BAR(); PIT(5);
#if defined(PROBE_PI)
    if (blockIdx.x == 0 && threadIdx.x == 0) ((unsigned long long*)(F.ws + 32768))[0] += ta_;
#endif
}

constexpr int SB_STRIDE = 16384, SB_NBUF = 7, SB_AHEAD = 5, ST_OB = SB_NBUF * SB_STRIDE  , ST_END = ST_OB + 8192;
static_assert(ST_END <= RING_BYTES && RC_BYTES <= SB_STRIDE, "state pass LDS");
__device__ __forceinline__ void rwkv_state(Frame& F, const unsigned char* recs, bf16* Y, const RwkvP P, int b, int h) {
    const int tid = mytid(F), lane = tid & 63, w = __builtin_amdgcn_readfirstlane(tid >> 6), fr = lane & 15, g = lane >> 4;
    LAS unsigned char* L = F.lds;
    const unsigned char* rbase = recs + (size_t)(b * 4 + h) * (SEQ / 16) * RC_STRIDE;
    const int lt = tid - 256;
    const f32x4 plg = *(const f32x4*)(P.lg + h * 64 + (tid & 15) * 4), plb = *(const f32x4*)(P.lb + h * 64 + (tid & 15) * 4);
    asm volatile("s_waitcnt vmcnt(0)" ::: "memory");
    f32x4 accS[4];
#pragma unroll
    for (int i = 0; i < 4; ++i) accS[i] = (f32x4){0.f, 0.f, 0.f, 0.f};
    constexpr int NCH = SEQ / 16;
#define RW_ISSUE(r) do { const unsigned char* gp_ = rbase + (size_t)(r) * RC_STRIDE + (w * 256 + lane) * 16; LAS unsigned char* lp_ = L + ((r) % SB_NBUF) * SB_STRIDE + w * 4096; \
        _Pragma("unroll") for (int i_ = 0; i_ < 4; ++i_) __builtin_amdgcn_global_load_lds((const unsigned*)(gp_ + i_ * 1024), (LAS unsigned*)(lp_ + i_ * 1024), 16, 0, 0); } while (0)
    if (w < 4) {
#pragma unroll 1
        for (int r = 0; r < SB_AHEAD; ++r) RW_ISSUE(r);
        asm volatile("s_waitcnt vmcnt(16)" ::: "memory"); }
    BAR();
#pragma unroll 1
    for (int c = 0; c <= NCH; ++c) {
        if (w >= 4) {
            if (c >= 1) { const int ce = c - 1; const LAS unsigned char* B = L + (ce % SB_NBUF) * SB_STRIDE; const LAS float* OB = (const LAS float*)(L + ST_OB + (ce & 1) * 4096);
                const int tt = lt >> 4, c4 = (lt & 15) * 4; const f32x4 o = *(const LAS f32x4*)(OB + tt * 64 + c4);
                float s = (o[0] + o[1]) + (o[2] + o[3]); s = red16(s); const float mean = s * (1.0f / 64.0f); const f32x4 d = o - mean;
                float ss = (d[0] * d[0] + d[1] * d[1]) + (d[2] * d[2] + d[3] * d[3]); ss = red16(ss); const float rstd = __builtin_amdgcn_rsqf(ss * (1.0f / 64.0f) + 64e-5f);
                const u32x2 gw = *(const LAS u32x2*)(B + RC_G + tt * 128 + c4 * 2); const float bon = ((const LAS float*)(B + RC_BON))[tt];
                const LAS unsigned short* vq = (const LAS unsigned short*)(B + RC_VT4 + (c4 >> 4) * 512 + ((tt >> 2) * 16 + (c4 & 15)) * 8 + (tt & 3) * 2);
                const float vv[4] = {bf1(vq[0]), bf1(vq[4]), bf1(vq[8]), bf1(vq[12])}, gg[4] = {bflo(gw.x), bfhi(gw.x), bflo(gw.y), bfhi(gw.y)}; float y[4];
#pragma unroll
                for (int e = 0; e < 4; ++e) y[e] = (d[e] * rstd * plg[e] + plb[e] + bon * vv[e]) * gg[e];
                u32x2 wv; wv.x = pk2(y[0], y[1]); wv.y = pk2(y[2], y[3]); *(u32x2*)(Y + ((size_t)b * SEQ + ce * 16 + tt) * DM + 512 + h * 64 + c4) = wv; }
        } else {
            if (c + SB_AHEAD < NCH) RW_ISSUE(c + SB_AHEAD);
            if (c < NCH) { const int vb = w; const LAS unsigned char* B = L + (c % SB_NBUF) * SB_STRIDE; LAS float* OB = (LAS float*)(L + ST_OB + (c & 1) * 4096); const int fo = fr * 64 + 16 * g;
                const bf16x8 at0 = *(const LAS bf16x8*)(B + RC_AT + fo), at1 = *(const LAS bf16x8*)(B + RC_AT + 1024 + fo), rt0 = *(const LAS bf16x8*)(B + RC_RT + fo), rt1 = *(const LAS bf16x8*)(B + RC_RT + 1024 + fo);
                const bf16x8 zt = *(const LAS bf16x8*)(B + RC_ZT + fo), rbk = *(const LAS bf16x8*)(B + RC_RBK + fo); const u32x2 v4 = *(const LAS u32x2*)(B + RC_VT4 + vb * 512 + lane * 8);
                u32x4 sw0, sw1; sw0.x = pk2(accS[0][0], accS[0][1]); sw0.y = pk2(accS[0][2], accS[0][3]); sw0.z = pk2(accS[1][0], accS[1][1]); sw0.w = pk2(accS[1][2], accS[1][3]);
                sw1.x = pk2(accS[2][0], accS[2][1]); sw1.y = pk2(accS[2][2], accS[2][3]); sw1.z = pk2(accS[3][0], accS[3][1]); sw1.w = pk2(accS[3][2], accS[3][3]);
                const bf16x8 s0 = __builtin_bit_cast(bf16x8, sw0), s1 = __builtin_bit_cast(bf16x8, sw1);
                f32x4 y = (f32x4){0.f, 0.f, 0.f, 0.f}, accO = y;
                y = MFMA16(at0, s0, y); y = MFMA16(at1, s1, y); accO = MFMA16(rt0, s0, accO); accO = MFMA16(rt1, s1, accO);
                u32x4 bw; bw.x = 0u; bw.y = 0u; bw.z = v4.x; bw.w = v4.y; y = MFMA16(zt, __builtin_bit_cast(bf16x8, bw), y);
                bw.x = pk2(y[0], y[1]); bw.y = pk2(y[2], y[3]); bw.z = 0u; bw.w = 0u; f32x4 u = (f32x4){0.f, 0.f, 0.f, 0.f}; u = MFMA16(zt, __builtin_bit_cast(bf16x8, bw), u);
                bw.x = pk2(u[0], u[1]); bw.y = pk2(u[2], u[3]); bw.z = v4.x; bw.w = v4.y; const bf16x8 uv = __builtin_bit_cast(bf16x8, bw);
                accO = MFMA16(rbk, uv, accO);
#pragma unroll
                for (int r = 0; r < 4; ++r) OB[(4 * g + r) * 64 + 16 * vb + fr] = accO[r];
#pragma unroll
                for (int kb = 0; kb < 4; ++kb) { const f32x4 gc = *(const LAS f32x4*)(B + RC_GC + (16 * kb + 4 * g) * 4); accS[kb] = accS[kb] * gc; accS[kb] = MFMA16(*(const LAS bf16x8*)(B + RC_BKT + kb * 1024 + fo), uv, accS[kb]); } }
            if (c + SB_AHEAD < NCH) asm volatile("s_waitcnt vmcnt(16)" ::: "memory"); else asm volatile("s_waitcnt vmcnt(0)" ::: "memory");
        }
        BAR();
    }
#undef RW_ISSUE
}

__device__ __forceinline__ void moe_route(Frame& F, const float* hres, const float* gffn, const float* router) {
    const int tid = mytid(F), lane = tid & 63, wave = __builtin_amdgcn_readfirstlane(tid >> 6); (void)lane; (void)wave;
    unsigned char* rt = F.ws + WS_RT;
    int* tope = (int*)(rt + RT_TOPE); float* gate = (float*)(rt + RT_GATE); int* rank = (int*)(rt + RT_RANK); float* rstd = (float*)(rt + RT_RSTD); int* hist = (int*)(rt + RT_HIST); int* rowtok = (int*)(rt + RT_ROWTOK);
    LAS float* RW = (LAS float*)F.lds;
    LAS int* LH = (LAS int*)(F.lds + 32768);
    for (int i = tid; i < 8192; i += NTHREADS) RW[i] = router[i];
    if (tid < 16) LH[tid] = 0;
    for (int i = F.blk * NTHREADS + tid; i < 2 * MOE_ROWS; i += F.G * NTHREADS) rowtok[i] = -1;
    __syncthreads();
    const int tpb = NTOK / F.G;
    for (int i = wave; i < tpb; i += NWAVES) { const int t = F.blk * tpb + i;
        const f32x4* hr = (const f32x4*)(hres + (size_t)t * DM) + lane; f32x4 v[4]; float ss = 0.f;
#pragma unroll
        for (int j = 0; j < 4; ++j) { v[j] = hr[64 * j]; ss += (v[j][0] * v[j][0] + v[j][1] * v[j][1]) + (v[j][2] * v[j][2] + v[j][3] * v[j][3]); }
        ss = wave_sum(ss); const float rs = __builtin_amdgcn_rsqf(ss * (1.0f / DM) + NORM_EPS);
        float lg[8];
#pragma unroll
        for (int e = 0; e < 8; ++e) lg[e] = 0.f;
#pragma unroll
        for (int j = 0; j < 4; ++j) { const f32x4 gv = *((const f32x4*)gffn + 64 * j + lane);
#pragma unroll
            for (int c = 0; c < 4; ++c) { const int k = 256 * j + 4 * lane + c; const float xn = v[j][c] * rs * gv[c]; const f32x4 r0 = *(const LAS f32x4*)(RW + k * 8), r1 = *(const LAS f32x4*)(RW + k * 8 + 4);
                lg[0] += xn * r0[0]; lg[1] += xn * r0[1]; lg[2] += xn * r0[2]; lg[3] += xn * r0[3]; lg[4] += xn * r1[0]; lg[5] += xn * r1[1]; lg[6] += xn * r1[2]; lg[7] += xn * r1[3]; } }
#pragma unroll
        for (int e = 0; e < 8; ++e) lg[e] = wave_sum(lg[e]);
        int i1 = 0; float m1 = lg[0];
#pragma unroll
        for (int e = 1; e < 8; ++e) if (lg[e] > m1) { m1 = lg[e]; i1 = e; }
        int i2 = -1; float m2 = -3.0e38f;
#pragma unroll
        for (int e = 0; e < 8; ++e) if (e != i1 && lg[e] > m2) { m2 = lg[e]; i2 = e; }
        if (lane == 0) { const float g1 = 1.0f / (1.0f + __expf(m2 - m1));
            const int r1 = atomicAdd((int*)&LH[i1], 1), r2 = atomicAdd((int*)&LH[8 + i2], 1);
            tope[2 * t] = i1; tope[2 * t + 1] = i2; gate[2 * t] = g1; gate[2 * t + 1] = 1.0f - g1; rank[2 * t] = r1; rank[2 * t + 1] = r2; rstd[t] = rs; }
    }
    __syncthreads();
    if (tid < 16) hist[F.blk * 16 + tid] = LH[tid];
}
__device__ __forceinline__ void moe_gather(Frame& F, int slot, const bf16* hb, bf16* asort) {
    const int tid = mytid(F), lane = tid & 63, wave = __builtin_amdgcn_readfirstlane(tid >> 6); (void)lane; (void)wave;
    unsigned char* rt = F.ws + WS_RT;
    const int* tope = (const int*)(rt + RT_TOPE); const float* gate = (const float*)(rt + RT_GATE); const int* rank = (const int*)(rt + RT_RANK); const float* rstd = (const float*)(rt + RT_RSTD); const int* hist = (const int*)(rt + RT_HIST);
    int* rowtok = (int*)(rt + RT_ROWTOK) + slot * MOE_ROWS; float* rowgate = (float*)(rt + RT_ROWGATE) + slot * MOE_ROWS; float* rowrstd = (float*)(rt + RT_ROWRSTD) + slot * MOE_ROWS;
    int* tilee = (int*)(rt + RT_TILEE) + slot * 256; int* ntiles = (int*)(rt + RT_NTILES);
    LAS int* BASE = (LAS int*)(F.lds + 40960);
    LAS int* TOT = BASE + 8;
    __syncthreads();
    LAS int* HL = (LAS int*)(F.lds + 49152);
    for (int i = tid; i < F.G * 8; i += NTHREADS) HL[i] = hist[(i >> 3) * 16 + slot * 8 + (i & 7)];
    __syncthreads();
    { const int e = tid & 7, part = tid >> 3;
        const int per = (F.G + 63) / 64; int sb = 0, st = 0;
        for (int j = 0; j < per; ++j) { const int bb = part * per + j; if (bb < F.G) { const int c = HL[bb * 8 + e]; st += c; if (bb < F.blk) sb += c; } }
        LAS int* PB = (LAS int*)(F.lds + 49152 + 16384); PB[tid] = sb; PB[512 + tid] = st; }
    __syncthreads();
    if (tid < 8) { const LAS int* PB = (const LAS int*)(F.lds + 49152 + 16384); int before = 0, tot = 0;
        for (int p = 0; p < 64; ++p) { before += PB[p * 8 + tid]; tot += PB[512 + p * 8 + tid]; }
        BASE[tid] = before; TOT[tid] = tot; }
    __syncthreads();
    if (tid == 0) { int ps = 0, nt = 0;
        for (int e = 0; e < 8; ++e) { const int tl = (TOT[e] + 255) >> 8; BASE[e] += ps; if (F.blk == 0) for (int i = 0; i < tl; ++i) tilee[nt + i] = e; ps += tl * 256; nt += tl; }
        if (F.blk == 0) ntiles[slot] = nt; }
    __syncthreads();
    const int tpb = NTOK / F.G;
    for (int i = wave; i < tpb; i += NWAVES) { const int t = F.blk * tpb + i; const int e = tope[2 * t + slot]; const int dest = BASE[e] + rank[2 * t + slot];
        if (lane == 0) { rowtok[dest] = t; rowgate[dest] = gate[2 * t + slot]; rowrstd[dest] = rstd[t]; }
        (void)hb; (void)asort; }
}


__device__ __forceinline__ void mk_publish(unsigned* ctr) {
    asm volatile("s_waitcnt vmcnt(0)" ::: "memory");
    __syncthreads();
    if (threadIdx.x == 0) { __builtin_amdgcn_fence(__ATOMIC_RELEASE, "agent"); asm volatile("s_waitcnt vmcnt(0)" ::: "memory"); (void)__hip_atomic_fetch_add(ctr, 1u, __ATOMIC_RELAXED, __HIP_MEMORY_SCOPE_AGENT); }
}
__device__ __forceinline__ void mk_wait(unsigned* ctr, unsigned need) {
    if (threadIdx.x == 0) { unsigned sp = 0;
        while (__hip_atomic_load(ctr, __ATOMIC_RELAXED, __HIP_MEMORY_SCOPE_AGENT) < need) { __builtin_amdgcn_s_sleep(4); if (++sp > (1u << 24)) break; }
        __builtin_amdgcn_fence(__ATOMIC_ACQUIRE, "agent"); asm volatile("s_waitcnt vmcnt(0)" ::: "memory"); }
    __syncthreads();
}

#ifndef MK_PER_PHASE
#define MK_PER_PHASE 0
#endif
constexpr int N_PHASES = 17;
__global__ void __launch_bounds__(NTHREADS, 2) mk_fwd(Params prm) {
    extern __shared__ __attribute__((aligned(16))) unsigned char lds_raw[];
    Frame F;
    F.lds = (LAS unsigned char*)lds_raw;
    F.blk = blockIdx.x; F.G = gridDim.x; F.out = prm.out; F.ws = prm.ws; F.wv = __builtin_amdgcn_readfirstlane(threadIdx.x >> 6);
    volatile LAS unsigned* MISC = (volatile LAS unsigned*)(F.lds + MISC_OFF);
    for (int u = threadIdx.x; u < (LDS_BYTES - LDSCTL_OFF) / 4; u += NTHREADS) ((LAS unsigned*)(F.lds + LDSCTL_OFF))[u] = 0u;
    __syncthreads();
    if (threadIdx.x == 0) { LAS unsigned long long* tab = (LAS unsigned long long*)(F.lds + PTAB_OFF);
#pragma unroll
        for (int i_ = 0; i_ < 33; ++i_) tab[i_] = (unsigned long long)prm.in[i_]; }
    __syncthreads();
    const int lo = prm.ph_lo, hi = prm.ph_hi;
    unsigned* ctl = (unsigned*)(F.ws + WS_CTL);
    XcdBarrier bar; bar.bar = ctl + CW_BAR; bar.x = 0; bar.st = nullptr;
    if (hi - lo > 1) bar = xcd_barrier_post(ctl + CW_BAR, MISC + 8);
    unsigned char* ws = F.ws;
    bf16* hb = (bf16*)(ws + WS_HB); bf16* z = (bf16*)(ws + WS_Z); bf16* act = (bf16*)(ws + WS_Z); bf16* y = (bf16*)(ws + WS_Y); bf16* asort = (bf16*)(ws + WS_Y);
    float* ssq = (float*)(ws + WS_SSQ);
    bf16* opart = (bf16*)F.out; float* lse = (float*)((unsigned char*)F.out + 48 * MiB);
    unsigned char* rt = ws + WS_RT;
#define IN(k) (lo <= (k) && (k) < hi)
#ifndef PROBE_MASK
#define PROBE_MASK 0
#endif
#if PROBE_MASK
#define STAMP(k) do { if (blockIdx.x == 0 && threadIdx.x == 0) ((volatile LAS unsigned long long*)(F.lds + LDSCTL_OFF + 2048))[k] = __builtin_amdgcn_s_memrealtime(); } while (0)
#else
#define STAMP(k) do { } while (0)
#endif
#define SEAM(k) do { if (IN(k) && IN((k) + 1)) xcd_barrier(bar); STAMP((k) + 1); } while (0)

    STAMP(0);
    if (IN(0)) p0_prologue(F, 0);
    SEAM(0);
#pragma unroll 1
    for (int layer = 0; layer < 2; ++layer) {
        const int pb = layer == 0 ? 1 : 7;
        if (IN(pb)) {
            pg8::Gemm g{hb, (const bf16*)(ws + WS_WIN) + (size_t)layer * NPADW * DM, NTOK, NPADW, DM, F.wv}; pg8::StaticOrder S; S.init(NTOK / 256, NPADW / 256, F.G, F.blk);
            pg8::EpiZ E{z, INW, INW, ssq};
            pg8::gemm_phase<pg8::EpiZ, pg8::StaticOrder, true, true>(F.lds, g, S, E);
        }
        SEAM(pb);
#if defined(PROBE_SUB)
        const unsigned long long tsub0 = __builtin_amdgcn_s_memrealtime();
#define PSUB(cls, t0) do { if (threadIdx.x == 0) ((unsigned long long*)(F.ws + 32768))[layer * 4 + (cls)] = __builtin_amdgcn_s_memrealtime() - (t0); } while (0)
#else
#define PSUB(cls, t0) do { } while (0)
#endif
        unsigned char* recs = ws + WS_MOEW;
        unsigned char* gcon = ws + WS_MOEW + (size_t)NB * 4 * (SEQ / 16) * RC_STRIDE;
        if (IN(pb + 1)) {
            const int wi = F.blk, nw = F.G;
            { const RwkvP RP{inptr(F, IN_MU) + layer * 896, inptr(F, IN_W0) + layer * 256, inptr(F, IN_W2) + layer * 32 * 256, inptr(F, IN_A0) + layer * 256, inptr(F, IN_A2) + layer * 32 * 256, inptr(F, IN_G2) + layer * 64 * 256,
                             inptr(F, IN_KK) + layer * 256, inptr(F, IN_KA) + layer * 256, inptr(F, IN_RK) + layer * 256, inptr(F, IN_RLG) + layer * 256, inptr(F, IN_RLB) + layer * 256};
                const int tid_ = mytid(F), lane_ = tid_ & 63, w_ = __builtin_amdgcn_readfirstlane(tid_ >> 6);
#pragma unroll 1
                for (int h = 0; h < 4; ++h) {
                    rwkv_prep_init(F, RP, h); BAR();
                    u32x4 cur[2], prv[2], ncur[2], nprv[2];
#pragma unroll
                    for (int q = 0; q < 2; ++q) { cur[q] = (u32x4){0u, 0u, 0u, 0u}; prv[q] = cur[q]; ncur[q] = cur[q]; nprv[q] = cur[q]; }
                    if (wi < 2048) rwkv_prep_load(z, wi >> 8, h, wi & 255, w_, lane_, cur, prv);
#pragma unroll 1
                    for (int it = wi; it < 2048; it += nw) { const int nx = it + nw;
                        if (nx < 2048) rwkv_prep_load(z, nx >> 8, h, nx & 255, w_, lane_, ncur, nprv);
                        rwkv_prep_item(F, recs + (size_t)(((it >> 8) * 4 + h) * 256 + (it & 255)) * RC_STRIDE, RP, h, cur, prv);
#pragma unroll
                        for (int q = 0; q < 2; ++q) { cur[q] = ncur[q]; prv[q] = nprv[q]; } }
                    BAR(); } }
            attn_qknorm(F, z, inptr(F, IN_QG) + layer * 64, inptr(F, IN_KG) + layer * 64);
            for (int item = wi; item < 512; item += nw) conv_item(F, z, y, inptr(F, IN_CW) + layer * 31 * 256, inptr(F, IN_CB) + layer * 256, inptr(F, IN_CLG) + layer * 256, inptr(F, IN_CLB) + layer * 256, item);
            gla_items<0>(F, z, gcon, (float*)(ws + WS_GLAEC), y, inptr(F, IN_GG2) + layer * 16 * 128, inptr(F, IN_GGB) + layer * 128, inptr(F, IN_GNG) + layer * 64, wi, nw);
        }
        SEAM(pb + 1);
        if (IN(pb + 2)) {
            unsigned* cA = ctl + 12288 + layer * 128;
            unsigned* cB = ctl + 12288 + layer * 128 + 64;
            if (F.blk < 32) {
                const RwkvP RP{inptr(F, IN_MU) + layer * 896, inptr(F, IN_W0) + layer * 256, inptr(F, IN_W2) + layer * 32 * 256, inptr(F, IN_A0) + layer * 256, inptr(F, IN_A2) + layer * 32 * 256, inptr(F, IN_G2) + layer * 64 * 256,
                               inptr(F, IN_KK) + layer * 256, inptr(F, IN_KA) + layer * 256, inptr(F, IN_RK) + layer * 256, inptr(F, IN_RLG) + layer * 256, inptr(F, IN_RLB) + layer * 256};
                rwkv_state(F, recs, y, RP, F.blk >> 2, F.blk & 3);
            } else {
                const int wi = F.blk - 32, nw = F.G - 32;
                if (F.blk < 64) { gla_scan(F, gcon, (const float*)(ws + WS_GLAEC), (F.blk - 32) >> 2, (F.blk - 32) & 3); mk_publish(cA); }
                { const int full = 3072 / nw, rem = 3072 - full * nw;
                    for (int rd = 0; rd < full; ++rd) attn_tile(F.lds, z, opart, lse, inptr(F, IN_RELB), rd * nw + wi, mytid(F));
                    if (wi >= 32 && wi - 32 < rem) attn_tile(F.lds, z, opart, lse, inptr(F, IN_RELB), full * nw + wi - 32, mytid(F)); }
                mk_publish(cB);
                mk_wait(cA, 32u);
                gla_items<1>(F, z, gcon, (float*)(ws + WS_GLAEC), y, inptr(F, IN_GG2) + layer * 16 * 128, inptr(F, IN_GGB) + layer * 128, inptr(F, IN_GNG) + layer * 64, wi, nw);
                mk_wait(cB, (unsigned)nw);
                attn_merge(F, opart, lse, y, wi, nw);
            }
        }
        SEAM(pb + 2);
        if (IN(pb + 3)) {
            pg8::Gemm g{y, (const bf16*)(ws + WS_WOUT) + (size_t)layer * DM * DM, NTOK, DM, DM, F.wv}; pg8::StaticOrder S; S.init(NTOK / 256, DM / 256, F.G, F.blk);
            pg8::EpiRes E{layer == 0 ? inptr(F, IN_X) : (const float*)nullptr, hb, layer == 0 ? (float*)nullptr : F.out, hb, ssq};
            pg8::gemm_phase<pg8::EpiRes, pg8::StaticOrder, true, true>(F.lds, g, S, E);
        }
        SEAM(pb + 3);
        if (layer == 0) {
            if (IN(5)) {
                pg8::Gemm g{hb, (const bf16*)(ws + WS_WGU), NTOK, 2 * DFF, DM, F.wv}; pg8::StaticOrder S; S.init(NTOK / 256, 2 * DFF / 256, F.G, F.blk);
                pg8::EpiSwiGLU<false> E{act, ssq, nullptr};
                pg8::gemm_phase<pg8::EpiSwiGLU<false>, pg8::StaticOrder, true, true>(F.lds, g, S, E);
            }
            SEAM(5);
            if (IN(6)) {
                pg8::Gemm g{act, (const bf16*)(ws + WS_WD), NTOK, DM, DFF, F.wv}; pg8::StaticOrder S; S.init(NTOK / 256, DM / 256, F.G, F.blk);
                pg8::EpiRes E{nullptr, hb, nullptr, hb, ssq};
                pg8::gemm_phase<pg8::EpiRes, pg8::StaticOrder, true, true>(F.lds, g, S, E);
            }
            SEAM(6);
        }
    }
    if (IN(11)) { moe_route(F, F.out, inptr(F, IN_FFNG) + DM, inptr(F, IN_ROUTER)); __syncthreads(); p0_prologue(F, 1); }
    SEAM(11);
    if (IN(12)) moe_gather(F, 0, hb, asort);
    SEAM(12);
#pragma unroll 1
    for (int slot = 0; slot < 2; ++slot) {
        const int pg = 13 + 2 * slot;
        const int* tilee = (const int*)(rt + RT_TILEE) + slot * 256;
        if (IN(pg)) {
            const int nt = __builtin_amdgcn_readfirstlane(((const int*)(rt + RT_NTILES))[slot]);
            pg8::Gemm g{hb, (const bf16*)(ws + WS_MOEW), nt * 256, 2 * DFF, DM, F.wv}; pg8::StaticOrder S; S.init(nt, 2 * DFF / 256, F.G, F.blk, tilee, MOEW_E_BYTES);
            pg8::EpiSwiGLU<true> E{act, nullptr, (const float*)(rt + RT_ROWRSTD) + slot * MOE_ROWS};
            pg8::gemm_phase_g<pg8::EpiSwiGLU<true>, pg8::StaticOrder, true, true>(F.lds, g, S, E, (const int*)(rt + RT_ROWTOK) + slot * MOE_ROWS);
        }
        SEAM(pg);
        if (IN(pg + 1)) {
            const int nt = __builtin_amdgcn_readfirstlane(((const int*)(rt + RT_NTILES))[slot]);
            pg8::Gemm g{act, (const bf16*)(ws + WS_MOEW + MOEW_GU_BYTES), nt * 256, DM, DFF, F.wv}; pg8::StaticOrder S; S.init(nt, DM / 256, F.G, F.blk, tilee, MOEW_E_BYTES);
            pg8::EpiMoeDown E{F.out, (const int*)(rt + RT_ROWTOK) + slot * MOE_ROWS, (const float*)(rt + RT_ROWGATE) + slot * MOE_ROWS};
            pg8::gemm_phase<pg8::EpiMoeDown, pg8::StaticOrder, true, true>(F.lds, g, S, E);
            if (slot == 0) moe_gather(F, 1, hb, asort);
        }
        if (slot == 0) SEAM(pg + 1);
    }
#if PROBE_MASK
    __syncthreads();
    if (blockIdx.x == 0 && threadIdx.x == 0) { STAMP(N_PHASES); volatile LAS unsigned long long* ts = (volatile LAS unsigned long long*)(F.lds + LDSCTL_OFF + 2048); unsigned long long tot = 0;
        for (int k = 0; k < N_PHASES; ++k) if ((PROBE_MASK >> k) & 1) tot += ts[k + 1] - ts[k];
#if defined(PROBE_SUB)
        tot = (PROBE_SUB == 0) ? ((volatile unsigned long long*)(F.ws + 32768))[0] : ((volatile unsigned long long*)(F.ws + 32768))[PROBE_SUB] + ((volatile unsigned long long*)(F.ws + 32768))[4 + PROBE_SUB];
#endif
        const unsigned long long t0 = __builtin_amdgcn_s_memrealtime(); while (__builtin_amdgcn_s_memrealtime() - t0 < tot) __builtin_amdgcn_s_sleep(8); }
#endif
#undef IN
#undef SEAM
}

extern "C" void kernel_launch(void* const* d_in, const int* in_sizes, int n_in, void* d_out, int out_size, void* d_ws, size_t ws_size, hipStream_t stream) {
    static int grid = 0;
    if (grid == 0) {
        if (n_in != 33 || out_size != NTOK * DM || ws_size < WS_TOTAL) { fprintf(stderr, "kernel_launch: unexpected problem (n_in %d out %d ws %zu)\n", n_in, out_size, ws_size); grid = -1; return; }
        int dev = 0, cus = 0;
        if (hipGetDevice(&dev) != hipSuccess || hipDeviceGetAttribute(&cus, hipDeviceAttributeMultiprocessorCount, dev) != hipSuccess) { grid = -1; return; }
        if (hipFuncSetAttribute((const void*)mk_fwd, hipFuncAttributeMaxDynamicSharedMemorySize, LDS_BYTES) != hipSuccess) { fprintf(stderr, "kernel_launch: hipFuncSetAttribute failed\n"); grid = -1; return; }
        (void)hipGetLastError();
        grid = cus;
        if (grid != 256) fprintf(stderr, "kernel_launch: %d CUs (built for 256)\n", grid);
    }
    if (grid < 0) return;
    (void)hipMemsetAsync((char*)d_ws + WS_CTL, 0, CTL_ZERO_BYTES, stream);
    Params p{};
    for (int i = 0; i < 33; ++i) p.in[i] = (const float*)d_in[i];
    p.out = (float*)d_out; p.ws = (unsigned char*)d_ws;
#if MK_PER_PHASE
    for (int k = 0; k < N_PHASES; ++k) { p.ph_lo = k; p.ph_hi = k + 1; hipLaunchKernelGGL(mk_fwd, dim3(grid), dim3(NTHREADS), LDS_BYTES, stream, p); }
#else
    p.ph_lo = 0; p.ph_hi = N_PHASES;
    hipLaunchKernelGGL(mk_fwd, dim3(grid), dim3(NTHREADS), LDS_BYTES, stream, p);
#endif
}
```

```cpp
#include <hip/hip_runtime.h>
#include <cstdio>
#include <cstdint>

#define LAS __attribute__((address_space(3)))
#define GAS __attribute__((address_space(1)))
typedef unsigned short bf16;
typedef short bf16x8 __attribute__((ext_vector_type(8)));
typedef short s16x4 __attribute__((ext_vector_type(4)));
typedef float f32x4 __attribute__((ext_vector_type(4)));
typedef float f32x2 __attribute__((ext_vector_type(2)));
typedef unsigned u32x4 __attribute__((ext_vector_type(4)));
typedef unsigned u32x2 __attribute__((ext_vector_type(2)));

constexpr int DM = 1024, NB = 8, SEQ = 4096, NTOK = NB * SEQ, INW = 2960, NPADW = 3072, DFF = 2816, NEXP = 8;
constexpr int ZA = 0, ZB = 768, ZC = 1280, ZD = 2176;
constexpr float NORM_EPS = 1e-6f;
constexpr int MOE_ROWS = NTOK + NEXP * 256;

constexpr size_t MiB = 1u << 20;
constexpr size_t WS_CTL = 0, CTL_ZERO_BYTES = 64 * 1024;
constexpr size_t WS_WIN = 1 * MiB;
constexpr size_t WS_WOUT = 13 * MiB;
constexpr size_t WS_WGU = 17 * MiB;
constexpr size_t WS_WD = 28 * MiB;
constexpr size_t WS_SSQ = 34 * MiB;
constexpr size_t WS_RT = 36 * MiB;
constexpr size_t WS_HB = 40 * MiB;
constexpr size_t WS_Z = 104 * MiB;
constexpr size_t WS_Y = 297 * MiB;
constexpr size_t WS_MOEW = 367 * MiB;
constexpr size_t WS_END = 499 * MiB;
constexpr size_t WS_GLAEC = 499 * MiB;
constexpr size_t WS_TOTAL = 500 * MiB;
constexpr size_t MOEW_GU_BYTES = (size_t)2 * DFF * DM * 2, MOEW_D_BYTES = (size_t)DM * DFF * 2, MOEW_E_BYTES = MOEW_GU_BYTES + MOEW_D_BYTES;
static_assert(WS_Z + (size_t)MOE_ROWS * DFF * 2 <= WS_Y && WS_Y + (size_t)MOE_ROWS * DM * 2 <= WS_MOEW && WS_MOEW + NEXP * MOEW_E_BYTES <= WS_END, "ws map");
constexpr size_t WS_OP = WS_HB;
constexpr size_t WS_LSE = WS_HB + 48 * MiB;
constexpr size_t RT_TOPE = 0;
constexpr size_t RT_GATE = RT_TOPE + (size_t)NTOK * 8;
constexpr size_t RT_RANK = RT_GATE + (size_t)NTOK * 8;
constexpr size_t RT_RSTD = RT_RANK + (size_t)NTOK * 8;
constexpr size_t RT_HIST = RT_RSTD + (size_t)NTOK * 4;
constexpr size_t RT_ROWTOK = RT_HIST + 256 * 16 * 4;
constexpr size_t RT_ROWGATE = RT_ROWTOK + (size_t)2 * MOE_ROWS * 4;
constexpr size_t RT_ROWRSTD = RT_ROWGATE + (size_t)2 * MOE_ROWS * 4;
constexpr size_t RT_TILEE = RT_ROWRSTD + (size_t)2 * MOE_ROWS * 4;
constexpr size_t RT_NTILES = RT_TILEE + 2 * 256 * 4;
static_assert(RT_NTILES + 64 <= 4 * MiB, "routing arrays");

constexpr int CW_BAR = 1024;

constexpr int RING_BYTES = 131072, LDSCTL_OFF = RING_BYTES, MISC_OFF = LDSCTL_OFF + 320, LDS_BYTES = 147456;
constexpr int NWAVES = 8, NTHREADS = 512;

#define LDS_WAIT() asm volatile("s_waitcnt lgkmcnt(0)" ::: "memory")
#define VM_WAIT() asm volatile("s_waitcnt vmcnt(0)" ::: "memory")
#define BAR() do { asm volatile("s_waitcnt lgkmcnt(0)" ::: "memory"); __builtin_amdgcn_s_barrier(); asm volatile("" ::: "memory"); } while (0)
__device__ __forceinline__ unsigned f2bf(float f) { unsigned u = __builtin_bit_cast(unsigned, f); return (u + 0x7fffu + ((u >> 16) & 1u)) >> 16; }
typedef __bf16 bf16x2_hw __attribute__((ext_vector_type(2)));
__device__ __forceinline__ unsigned pk2(float lo, float hi) { const f32x2 v = {lo, hi}; const bf16x2_hw b = __builtin_convertvector(v, bf16x2_hw); return __builtin_bit_cast(unsigned, b); }
__device__ __forceinline__ float bflo(unsigned w) { return __builtin_bit_cast(float, w << 16); }
__device__ __forceinline__ float bfhi(unsigned w) { return __builtin_bit_cast(float, w & 0xffff0000u); }
__device__ __forceinline__ float bf1(bf16 b) { return __builtin_bit_cast(float, (unsigned)b << 16); }
__device__ __forceinline__ float wave_sum(float v) {
#pragma unroll
    for (int o = 1; o < 64; o <<= 1) v += __shfl_xor(v, o);
    return v;
}
#define DPP_ADD(v, ctrl) ((v) + __builtin_bit_cast(float, __builtin_amdgcn_update_dpp(0, __builtin_bit_cast(int, (v)), (ctrl), 0xf, 0xf, true)))
__device__ __forceinline__ float red8(float v) { v = DPP_ADD(v, 0xB1); v = DPP_ADD(v, 0x4E); v = DPP_ADD(v, 0x141); return v; }
__device__ __forceinline__ float red16(float v) { v = DPP_ADD(v, 0xB1); v = DPP_ADD(v, 0x4E); v = DPP_ADD(v, 0x141); v = DPP_ADD(v, 0x140); return v; }
__device__ __forceinline__ float sigmoidf_(float x) { return 1.0f / (1.0f + __expf(-x)); }
__device__ __forceinline__ float siluf_(float x) { return x / (1.0f + __expf(-x)); }
__device__ __forceinline__ float softplusf_(float x) { return fmaxf(x, 0.f) + __logf(1.0f + __expf(-fabsf(x))); }
__device__ __forceinline__ float tanhf_(float x) { const float e = __expf(2.0f * x); return 1.0f - 2.0f / (e + 1.0f); }
__device__ __forceinline__ void unpack8(const u32x4 w, float (&f)[8]) {
    f[0] = bflo(w.x); f[1] = bfhi(w.x); f[2] = bflo(w.y); f[3] = bfhi(w.y); f[4] = bflo(w.z); f[5] = bfhi(w.z); f[6] = bflo(w.w); f[7] = bfhi(w.w);
}

namespace pg8 {
#define PG8_LAS __attribute__((address_space(3)))
typedef unsigned short bf16_t;
constexpr int BM = 256, BK = 64, HALF = 128, HTB = HALF * BK * 2  , STAGE_BYTES = 8 * HTB, NXCD = 8, WGM = 8;

__host__ __device__ __forceinline__ int lds_byte(int r, int c) { const int st = (r >> 4) * 2 + (c >> 5), rr = r & 15, cc = c & 31, ob = rr * 64 + cc * 2; return st * 1024 + (ob ^ (((ob >> 9) & 1) << 5)); }
__host__ __device__ __forceinline__ void stage_rc(int b, int& R, int& C) { const int st = b / 1024, sb = b % 1024, swz = sb ^ (((sb >> 9) & 1) << 5); R = (st >> 1) * 16 + swz / 64; C = (st & 1) * 32 + (swz % 64) / 2; }
__host__ __device__ __forceinline__ int perm32(int rho) { const int n = rho >> 4, i = rho & 15; return 8 * (i >> 2) + 4 * n + (i & 3); }

struct Unit { int pm, pn; };
struct Gemm { const bf16_t* A; const bf16_t* Bt; int M, N, K, wv; };

struct StaticOrder {
    int nM, nN, nwg, G, c; const int* tile_e; size_t estride;
    __device__ void init(int nM_, int nN_, int G_, int c_, const int* te = nullptr, size_t es = 0) { nM = nM_; nN = nN_; nwg = nM * nN; G = G_; c = c_; tile_e = te; estride = es; }
    __device__ bool next(int i, Unit& u) const {
        const long L = (long)i * G + c; if (L >= nwg) return false;
        int wgid = (int)L; { const int q = nwg / NXCD, r = nwg % NXCD, xcd = wgid % NXCD, off = wgid / NXCD; wgid = (xcd < r ? xcd * (q + 1) : r * (q + 1) + (xcd - r) * q) + off; }
        const int nig = WGM * nN, gid = wgid / nig, fm = gid * WGM, gsz = (nM - fm) < WGM ? (nM - fm) : WGM;
        u.pm = fm + ((wgid % nig) % gsz); u.pn = (wgid % nig) / gsz; return true;
    }
    __device__ __forceinline__ size_t bofs(const Unit& u, size_t tstep) const { return (size_t)u.pn * tstep + (tile_e ? (size_t)__builtin_amdgcn_readfirstlane(tile_e[u.pm]) * estride : (size_t)0); }
    __device__ __forceinline__ void a_ready(const Unit&) const {}
    __device__ __forceinline__ void done(const Unit&) const {}
};

__device__ __forceinline__ unsigned cvt_pk_bf16(float lo, float hi) { unsigned r; asm volatile("v_cvt_pk_bf16_f32 %0, %1, %2" : "=v"(r) : "v"(lo), "v"(hi)); return r; }

__device__ __forceinline__ float row_rstd16(const float* ssq, int r, int fq) {
    const f32x4 p = *(const f32x4*)(ssq + (size_t)r * 16 + 4 * fq);
    float s = (p[0] + p[1]) + (p[2] + p[3]); s += __shfl_xor(s, 16); s += __shfl_xor(s, 32);
    return __builtin_amdgcn_rsqf(s * (1.0f / DM) + NORM_EPS);
}

struct EpiZ {
    static constexpr bool PERM = true, AFTER_DRAIN = false;
    bf16_t* Z; int ldc, ncols; const float* ssq;
    __device__ __forceinline__ void operator()(const f32x4 (&acc)[2][2][4][2], const Unit& u, int wr, int wc, int fr, int fq) const {
        const int row0 = u.pm * BM + wr * 64 + fr, col0 = u.pn * BM + wc * 32 + 8 * fq;
#pragma unroll
        for (int ai = 0; ai < 2; ++ai)
#pragma unroll
            for (int m = 0; m < 4; ++m) { const int r = row0 + ai * HALF + m * 16; const float rs = row_rstd16(ssq, r, fq); bf16_t* rowp = Z + (size_t)r * ldc + col0;
#pragma unroll
                for (int bj = 0; bj < 2; ++bj) { const f32x4 v0 = acc[ai][bj][m][0] * rs, v1 = acc[ai][bj][m][1] * rs;
                    u32x4 w; w.x = cvt_pk_bf16(v0[0], v0[1]); w.y = cvt_pk_bf16(v0[2], v0[3]); w.z = cvt_pk_bf16(v1[0], v1[1]); w.w = cvt_pk_bf16(v1[2], v1[3]);
                    if (col0 + bj * HALF < ncols) *(u32x4*)(rowp + bj * HALF) = w; } }
    }
};
template <bool MOE> struct EpiSwiGLU {
    static constexpr bool PERM = true, AFTER_DRAIN = false;
    bf16_t* O; const float* ssq; const float* row_rstd;
    __device__ __forceinline__ void operator()(const f32x4 (&acc)[2][2][4][2], const Unit& u, int wr, int wc, int fr, int fq) const {
        const int row0 = u.pm * BM + wr * 64 + fr, col0 = u.pn * HALF + wc * 32 + 8 * fq;
#pragma unroll
        for (int ai = 0; ai < 2; ++ai)
#pragma unroll
            for (int m = 0; m < 4; ++m) { const int r = row0 + ai * HALF + m * 16; float rs; if (MOE) rs = row_rstd[r]; else rs = row_rstd16(ssq, r, fq);
                const f32x4 g0 = acc[ai][0][m][0] * rs, g1 = acc[ai][0][m][1] * rs, u0 = acc[ai][1][m][0] * rs, u1 = acc[ai][1][m][1] * rs; f32x4 a0, a1;
#pragma unroll
                for (int j = 0; j < 4; ++j) { a0[j] = g0[j] * __builtin_amdgcn_rcpf(1.0f + __expf(-g0[j])) * u0[j]; a1[j] = g1[j] * __builtin_amdgcn_rcpf(1.0f + __expf(-g1[j])) * u1[j]; }
                u32x4 w; w.x = cvt_pk_bf16(a0[0], a0[1]); w.y = cvt_pk_bf16(a0[2], a0[3]); w.z = cvt_pk_bf16(a1[0], a1[1]); w.w = cvt_pk_bf16(a1[2], a1[3]);
                *(u32x4*)(O + (size_t)r * DFF + col0) = w; }
    }
};
struct EpiRes {
    static constexpr bool PERM = false, AFTER_DRAIN = false;
    const float* base; const bf16_t* baseb; float* out; bf16_t* hb; float* ssq;
    __device__ __forceinline__ void operator()(const f32x4 (&acc)[2][2][4][2], const Unit& u, int wr, int wc, int fr, int fq) const {
        const int col0 = u.pn * BM + wc * 32 + 4 * fq;
#pragma unroll
        for (int ai = 0; ai < 2; ++ai)
#pragma unroll
            for (int m = 0; m < 4; ++m) { const int r = u.pm * BM + ai * HALF + wr * 64 + m * 16 + fr; const size_t off = (size_t)r * DM + col0; float ss = 0.f;
#pragma unroll
                for (int bj = 0; bj < 2; ++bj)
#pragma unroll
                    for (int n = 0; n < 2; ++n) { f32x4 bv;
                        if (base) bv = *(const f32x4*)(base + off + bj * HALF + n * 16);
                        else { const u32x2 bw = *(const u32x2*)(baseb + off + bj * HALF + n * 16); bv = (f32x4){bflo(bw.x), bfhi(bw.x), bflo(bw.y), bfhi(bw.y)}; }
                        const f32x4 v = bv + acc[ai][bj][m][n];
                        if (out) *(f32x4*)(out + off + bj * HALF + n * 16) = v;
                        ss += (v[0] * v[0] + v[1] * v[1]) + (v[2] * v[2] + v[3] * v[3]);
                        { u32x2 w; w.x = cvt_pk_bf16(v[0], v[1]); w.y = cvt_pk_bf16(v[2], v[3]); *(u32x2*)(hb + off + bj * HALF + n * 16) = w; } }
                ss += __shfl_xor(ss, 16); ss += __shfl_xor(ss, 32);
                if (fq == 0) ssq[(size_t)r * 16 + u.pn * 4 + wc] = ss;
                if (m & 1) asm volatile("" ::: "memory"); }
    }
};
struct EpiMoeDown {
    static constexpr bool PERM = false, AFTER_DRAIN = false;
    float* out; const int* row_tok; const float* row_gate;
    __device__ __forceinline__ void operator()(const f32x4 (&acc)[2][2][4][2], const Unit& u, int wr, int wc, int fr, int fq) const {
        const int col0 = u.pn * BM + wc * 32 + 4 * fq;
#pragma unroll
        for (int ai = 0; ai < 2; ++ai)
#pragma unroll
            for (int m = 0; m < 4; ++m) { const int r = u.pm * BM + ai * HALF + wr * 64 + m * 16 + fr; const int tok = row_tok[r]; const float gt = row_gate[r];
                if (tok >= 0) { float* op = out + (size_t)tok * DM + col0;
#pragma unroll
                    for (int bj = 0; bj < 2; ++bj)
#pragma unroll
                        for (int n = 0; n < 2; ++n) { float* p = op + bj * HALF + n * 16; *(f32x4*)p = *(const f32x4*)p + acc[ai][bj][m][n] * gt; } }
                if (m & 1) asm volatile("" ::: "memory"); }
    }
};

template <class Epi, class Sched, bool ALIGN_EPI = false, bool SP2 = false>
__device__ __forceinline__ void gemm_phase(PG8_LAS unsigned char* lds, const Gemm g, const Sched& S, const Epi& E) {
    int lid_; asm volatile("v_mbcnt_lo_u32_b32 %0, -1, 0\n\tv_mbcnt_hi_u32_b32 %0, -1, %0" : "=v"(lid_)); int tid_ = g.wv * 64 + lid_; asm volatile("" : "+v"(tid_));
    const int tid = tid_, wid = __builtin_amdgcn_readfirstlane(tid >> 6), lane = tid & 63, wr = wid >> 2, wc = wid & 3, fr = lane & 15, fq = lane >> 4;
    const int K = g.K, nt = K / BK;
    unsigned voffA[2], voffB[2];
#pragma unroll
    for (int i = 0; i < 2; ++i) { int R, C; stage_rc(tid * 16 + i * 8192, R, C); const int Rb = Epi::PERM ? ((R & ~31) + perm32(R & 31)) : R;
        voffA[i] = (unsigned)(R * K + C) * 2u; voffB[i] = (unsigned)(Rb * K + C) * 2u; }
    const size_t kstep = (size_t)(BK * 2);
    const size_t hstep = (size_t)HALF * K * 2;
    const size_t tstep = 2 * hstep;
    const unsigned ldsw = (unsigned)wid * 1024u;
    const int aoff = lds_byte(wr * 64 + fr, fq * 8), boff = lds_byte(wc * 32 + fr, fq * 8);
#define PG8_SA(b, h) (((b) * 2 + (h)) * HTB)
#define PG8_SB(b, h) ((4 + (b) * 2 + (h)) * HTB)
#define PG8_STAGE(bufoff, gbase, voff) do { _Pragma("unroll") for (int _i = 0; _i < 2; ++_i) \
        __builtin_amdgcn_global_load_lds((const unsigned*)((const char*)(gbase) + (voff)[_i]), (PG8_LAS unsigned*)(lds + (bufoff) + ldsw + _i * 8192), 16, 0, 0); } while (0)
#define PG8_LDA(dst, b, h) do { _Pragma("unroll") for (int m = 0; m < 4; ++m) _Pragma("unroll") for (int k = 0; k < 2; ++k) dst[m][k] = *(const PG8_LAS bf16x8*)(lds + PG8_SA(b, h) + aoff + m * 2048 + k * 1024); } while (0)
#define PG8_LDB(dst, b, h) do { _Pragma("unroll") for (int n = 0; n < 2; ++n) _Pragma("unroll") for (int k = 0; k < 2; ++k) dst[n][k] = *(const PG8_LAS bf16x8*)(lds + PG8_SB(b, h) + boff + n * 2048 + k * 1024); } while (0)
#define PG8_MMA(ai, bj, At, Bt) do { __builtin_amdgcn_s_setprio(1); _Pragma("unroll") for (int m = 0; m < 4; ++m) _Pragma("unroll") for (int n = 0; n < 2; ++n) _Pragma("unroll") for (int k = 0; k < 2; ++k) \
        acc[ai][bj][m][n] = __builtin_amdgcn_mfma_f32_16x16x32_bf16(Bt[n][k], At[m][k], acc[ai][bj][m][n], 0, 0, 0); __builtin_amdgcn_s_setprio(0); } while (0)
#define PG8_WAIT_V(n) asm volatile("s_waitcnt vmcnt(" #n ")" ::: "memory")
#define PG8_WAIT_L(n) asm volatile("s_waitcnt lgkmcnt(" #n ")" ::: "memory")
#define PG8_BAR __builtin_amdgcn_s_barrier()
#define PG8_SCHED __builtin_amdgcn_sched_barrier(0)
    Unit cur, nxt; int ui = 0;
    if (!S.next(0, cur)) return;
    f32x4 acc[2][2][4][2];
#pragma unroll
    for (int a = 0; a < 2; ++a)
#pragma unroll
        for (int b = 0; b < 2; ++b)
#pragma unroll
            for (int m = 0; m < 4; ++m)
#pragma unroll
                for (int n = 0; n < 2; ++n) acc[a][b][m][n] = (f32x4){0.f, 0.f, 0.f, 0.f};
    bf16x8 At[4][2], B0[2][2], B1[2][2];
    const char* cA = (const char*)g.A + (size_t)cur.pm * tstep; const char* cB = (const char*)g.Bt + S.bofs(cur, tstep);
    S.a_ready(cur);
    if constexpr (SP2) {
        PG8_STAGE(PG8_SB(0, 0), cB, voffB); PG8_STAGE(PG8_SB(0, 1), cB + hstep, voffB); PG8_STAGE(PG8_SA(0, 0), cA, voffA); PG8_STAGE(PG8_SA(0, 1), cA + hstep, voffA);
        if (wr == 1) PG8_BAR;
        PG8_WAIT_V(2); PG8_BAR;
        PG8_STAGE(PG8_SB(1, 0), cB + kstep, voffB); PG8_STAGE(PG8_SA(1, 0), cA + kstep, voffA); PG8_STAGE(PG8_SB(1, 1), cB + hstep + kstep, voffB);
        PG8_WAIT_V(6); PG8_BAR;
    } else {
        PG8_STAGE(PG8_SB(0, 0), cB, voffB); PG8_STAGE(PG8_SA(0, 0), cA, voffA); PG8_STAGE(PG8_SB(0, 1), cB + hstep, voffB); PG8_STAGE(PG8_SA(0, 1), cA + hstep, voffA);
        if (wr == 1) PG8_BAR;
        PG8_WAIT_V(4); PG8_BAR;
        PG8_STAGE(PG8_SB(1, 0), cB + kstep, voffB); PG8_STAGE(PG8_SA(1, 0), cA + kstep, voffA); PG8_STAGE(PG8_SB(1, 1), cB + hstep + kstep, voffB);
        PG8_WAIT_V(6); PG8_BAR;
    }
    for (;;) {
        const bool has_next = S.next(ui + 1, nxt);
        const char* nA = has_next ? (const char*)g.A + (size_t)nxt.pm * tstep : cA; const char* nB = has_next ? (const char*)g.Bt + S.bofs(nxt, tstep) : cB;
        for (int t = 0; t < nt; t += 2) {
            const bool last = (t == nt - 2);
            const char* a1 = cA + (size_t)(t + 1) * kstep;
            const char* a2 = last ? nA : cA + (size_t)(t + 2) * kstep; const char* b2 = last ? nB : cB + (size_t)(t + 2) * kstep;
            const char* a3 = a2 + kstep; const char* b3 = b2 + kstep;
            if (last && has_next) S.a_ready(nxt);
            if constexpr (SP2) {
            PG8_LDB(B0, 0, 0); PG8_LDB(B1, 0, 1); PG8_SCHED; PG8_LDA(At, 0, 0); PG8_STAGE(PG8_SA(1, 1), a1 + hstep, voffA);
            PG8_WAIT_V(8); PG8_WAIT_L(0); PG8_BAR; PG8_MMA(0, 0, At, B0); PG8_MMA(0, 1, At, B1); PG8_BAR; PG8_SCHED;
            PG8_LDA(At, 0, 1); PG8_STAGE(PG8_SB(0, 0), b2, voffB); PG8_STAGE(PG8_SB(0, 1), b2 + hstep, voffB); PG8_STAGE(PG8_SA(0, 0), a2, voffA);
            PG8_WAIT_V(8); PG8_WAIT_L(0); PG8_BAR; PG8_MMA(1, 0, At, B0); PG8_MMA(1, 1, At, B1); PG8_BAR; PG8_SCHED;
            PG8_LDB(B0, 1, 0); PG8_LDB(B1, 1, 1); PG8_SCHED; PG8_LDA(At, 1, 0); PG8_STAGE(PG8_SA(0, 1), a2 + hstep, voffA);
            PG8_WAIT_V(8); PG8_WAIT_L(0); PG8_BAR; PG8_MMA(0, 0, At, B0); PG8_MMA(0, 1, At, B1); PG8_BAR; PG8_SCHED;
            PG8_LDA(At, 1, 1); PG8_STAGE(PG8_SB(1, 0), b3, voffB); PG8_STAGE(PG8_SB(1, 1), b3 + hstep, voffB); PG8_STAGE(PG8_SA(1, 0), a3, voffA);
            PG8_WAIT_V(8); PG8_WAIT_L(0); PG8_BAR; PG8_MMA(1, 0, At, B0); PG8_MMA(1, 1, At, B1); PG8_BAR; PG8_SCHED;
            } else {
            PG8_LDB(B0, 0, 0); PG8_SCHED; PG8_LDA(At, 0, 0); PG8_STAGE(PG8_SA(1, 1), a1 + hstep, voffA);
            PG8_WAIT_L(8); PG8_BAR; PG8_WAIT_L(0); PG8_MMA(0, 0, At, B0); PG8_BAR; PG8_SCHED;
            PG8_LDB(B1, 0, 1); PG8_STAGE(PG8_SB(0, 0), b2, voffB);
            PG8_BAR; PG8_WAIT_L(0); PG8_MMA(0, 1, At, B1); PG8_BAR;
            PG8_LDA(At, 0, 1); PG8_STAGE(PG8_SA(0, 0), a2, voffA);
            PG8_BAR; PG8_WAIT_L(0); PG8_MMA(1, 0, At, B0); PG8_BAR; PG8_SCHED;
            PG8_STAGE(PG8_SB(0, 1), b2 + hstep, voffB);
            PG8_WAIT_V(6); PG8_BAR; PG8_MMA(1, 1, At, B1); PG8_BAR;
            PG8_LDB(B0, 1, 0); PG8_SCHED; PG8_LDA(At, 1, 0); PG8_STAGE(PG8_SA(0, 1), a2 + hstep, voffA);
            PG8_WAIT_L(8); PG8_BAR; PG8_WAIT_L(0); PG8_MMA(0, 0, At, B0); PG8_BAR; PG8_SCHED;
            PG8_LDB(B1, 1, 1); PG8_STAGE(PG8_SB(1, 0), b3, voffB);
            PG8_BAR; PG8_WAIT_L(0); PG8_MMA(0, 1, At, B1); PG8_BAR;
            PG8_LDA(At, 1, 1); PG8_STAGE(PG8_SA(1, 0), a3, voffA);
            PG8_BAR; PG8_WAIT_L(0); PG8_MMA(1, 0, At, B0); PG8_BAR; PG8_SCHED;
            PG8_STAGE(PG8_SB(1, 1), b3 + hstep, voffB);
            PG8_WAIT_V(6); PG8_BAR; PG8_MMA(1, 1, At, B1); PG8_BAR;
            }
        }
        if constexpr (ALIGN_EPI) { if (wr == 0) PG8_BAR; }
        if constexpr (!Epi::AFTER_DRAIN) { E(acc, cur, wr, wc, fr, fq); S.done(cur); }
        if (!has_next) break;
#pragma unroll
        for (int a = 0; a < 2; ++a)
#pragma unroll
            for (int b = 0; b < 2; ++b)
#pragma unroll
                for (int m = 0; m < 4; ++m)
#pragma unroll
                    for (int n = 0; n < 2; ++n) acc[a][b][m][n] = (f32x4){0.f, 0.f, 0.f, 0.f};
        cur = nxt; cA = nA; cB = nB; ++ui;
        if constexpr (ALIGN_EPI) { if (wr == 1) PG8_BAR; }
    }
    PG8_WAIT_V(0);
    if constexpr (!ALIGN_EPI) { if (wr == 0) PG8_BAR; }
    PG8_BAR;
    if constexpr (Epi::AFTER_DRAIN) { E.fused(acc, cur, wr, wc, fr, fq, lds, wid, lane); S.done(cur); }
#undef PG8_SA
#undef PG8_SB
#undef PG8_STAGE
#undef PG8_LDA
#undef PG8_LDB
#undef PG8_MMA
#undef PG8_WAIT_V
#undef PG8_WAIT_L
#undef PG8_BAR
#undef PG8_SCHED
}
template <class Epi, class Sched, bool ALIGN_EPI = false, bool SP2 = false>
__device__ __forceinline__ void gemm_phase_g(PG8_LAS unsigned char* lds, const Gemm g, const Sched& S, const Epi& E, const int* rowtok) {
    int lid_; asm volatile("v_mbcnt_lo_u32_b32 %0, -1, 0\n\tv_mbcnt_hi_u32_b32 %0, -1, %0" : "=v"(lid_)); int tid_ = g.wv * 64 + lid_; asm volatile("" : "+v"(tid_));
    const int tid = tid_, wid = __builtin_amdgcn_readfirstlane(tid >> 6), lane = tid & 63, wr = wid >> 2, wc = wid & 3, fr = lane & 15, fq = lane >> 4;
    const int K = g.K, nt = K / BK;
    unsigned voffA[2], voffB[2];
#pragma unroll
    for (int i = 0; i < 2; ++i) { int R, C; stage_rc(tid * 16 + i * 8192, R, C); const int Rb = Epi::PERM ? ((R & ~31) + perm32(R & 31)) : R;
        voffA[i] = (unsigned)(R * K + C) * 2u; voffB[i] = (unsigned)(Rb * K + C) * 2u; }
    const size_t kstep = (size_t)(BK * 2);
    const size_t hstep = (size_t)HALF * K * 2;
    const size_t tstep = 2 * hstep;
    const unsigned ldsw = (unsigned)wid * 1024u;
    const int aoff = lds_byte(wr * 64 + fr, fq * 8), boff = lds_byte(wc * 32 + fr, fq * 8);
#define PG8_SA(b, h) (((b) * 2 + (h)) * HTB)
#define PG8_SB(b, h) ((4 + (b) * 2 + (h)) * HTB)
#define PG8_STAGE(bufoff, gbase, voff) do { _Pragma("unroll") for (int _i = 0; _i < 2; ++_i) \
        __builtin_amdgcn_global_load_lds((const unsigned*)((const char*)(gbase) + (voff)[_i]), (PG8_LAS unsigned*)(lds + (bufoff) + ldsw + _i * 8192), 16, 0, 0); } while (0)
#define PG8_LDA(dst, b, h) do { _Pragma("unroll") for (int m = 0; m < 4; ++m) _Pragma("unroll") for (int k = 0; k < 2; ++k) dst[m][k] = *(const PG8_LAS bf16x8*)(lds + PG8_SA(b, h) + aoff + m * 2048 + k * 1024); } while (0)
#define PG8_LDB(dst, b, h) do { _Pragma("unroll") for (int n = 0; n < 2; ++n) _Pragma("unroll") for (int k = 0; k < 2; ++k) dst[n][k] = *(const PG8_LAS bf16x8*)(lds + PG8_SB(b, h) + boff + n * 2048 + k * 1024); } while (0)
#define PG8_MMA(ai, bj, At, Bt) do { __builtin_amdgcn_s_setprio(1); _Pragma("unroll") for (int m = 0; m < 4; ++m) _Pragma("unroll") for (int n = 0; n < 2; ++n) _Pragma("unroll") for (int k = 0; k < 2; ++k) \
        acc[ai][bj][m][n] = __builtin_amdgcn_mfma_f32_16x16x32_bf16(Bt[n][k], At[m][k], acc[ai][bj][m][n], 0, 0, 0); __builtin_amdgcn_s_setprio(0); } while (0)
#define PG8_WAIT_V(n) asm volatile("s_waitcnt vmcnt(" #n ")" ::: "memory")
#define PG8_WAIT_L(n) asm volatile("s_waitcnt lgkmcnt(" #n ")" ::: "memory")
#define PG8_BAR __builtin_amdgcn_s_barrier()
#define PG8_SCHED __builtin_amdgcn_sched_barrier(0)
    unsigned gAc[2][2], gAn[2][2];
#define PG8_GATHER(dst, un) do { _Pragma("unroll") for (int hh_ = 0; hh_ < 2; ++hh_) _Pragma("unroll") for (int i_ = 0; i_ < 2; ++i_) { \
        const int tok_ = rowtok[(un).pm * BM + hh_ * HALF + (int)(voffA[i_] >> 11)]; dst[hh_][i_] = (unsigned)(tok_ < 0 ? 0 : tok_) * 2048u + (voffA[i_] & 2047u); } } while (0)
#define PG8_STAGE_GA(bufoff, kptr, hh, NX) do { _Pragma("unroll") for (int _i = 0; _i < 2; ++_i) \
        __builtin_amdgcn_global_load_lds((const unsigned*)((const char*)(kptr) + ((NX) ? gAn[hh][_i] : gAc[hh][_i])), (PG8_LAS unsigned*)(lds + (bufoff) + ldsw + _i * 8192), 16, 0, 0); } while (0)
    Unit cur, nxt; int ui = 0;
    if (!S.next(0, cur)) return;
    PG8_GATHER(gAc, cur);
    f32x4 acc[2][2][4][2];
#pragma unroll
    for (int a = 0; a < 2; ++a)
#pragma unroll
        for (int b = 0; b < 2; ++b)
#pragma unroll
            for (int m = 0; m < 4; ++m)
#pragma unroll
                for (int n = 0; n < 2; ++n) acc[a][b][m][n] = (f32x4){0.f, 0.f, 0.f, 0.f};
    bf16x8 At[4][2], B0[2][2], B1[2][2];
    const char* cA = (const char*)g.A; const char* cB = (const char*)g.Bt + S.bofs(cur, tstep);
    S.a_ready(cur);
    if constexpr (SP2) {
        PG8_STAGE(PG8_SB(0, 0), cB, voffB); PG8_STAGE(PG8_SB(0, 1), cB + hstep, voffB); PG8_STAGE_GA(PG8_SA(0, 0), cA, 0, false); PG8_STAGE_GA(PG8_SA(0, 1), cA, 1, false);
        if (wr == 1) PG8_BAR;
        PG8_WAIT_V(2); PG8_BAR;
        PG8_STAGE(PG8_SB(1, 0), cB + kstep, voffB); PG8_STAGE_GA(PG8_SA(1, 0), cA + kstep, 0, false); PG8_STAGE(PG8_SB(1, 1), cB + hstep + kstep, voffB);
        PG8_WAIT_V(6); PG8_BAR;
    } else {
        PG8_STAGE(PG8_SB(0, 0), cB, voffB); PG8_STAGE_GA(PG8_SA(0, 0), cA, 0, false); PG8_STAGE(PG8_SB(0, 1), cB + hstep, voffB); PG8_STAGE_GA(PG8_SA(0, 1), cA, 1, false);
        if (wr == 1) PG8_BAR;
        PG8_WAIT_V(4); PG8_BAR;
        PG8_STAGE(PG8_SB(1, 0), cB + kstep, voffB); PG8_STAGE_GA(PG8_SA(1, 0), cA + kstep, 0, false); PG8_STAGE(PG8_SB(1, 1), cB + hstep + kstep, voffB);
        PG8_WAIT_V(6); PG8_BAR;
    }
    for (;;) {
        const bool has_next = S.next(ui + 1, nxt);
        if (has_next) PG8_GATHER(gAn, nxt); else { _Pragma("unroll") for (int hh_ = 0; hh_ < 2; ++hh_) _Pragma("unroll") for (int i_ = 0; i_ < 2; ++i_) gAn[hh_][i_] = gAc[hh_][i_]; }
        const char* nA = (const char*)g.A; const char* nB = has_next ? (const char*)g.Bt + S.bofs(nxt, tstep) : cB;
        for (int t = 0; t < nt; t += 2) {
            const bool last = (t == nt - 2);
            const char* a1 = cA + (size_t)(t + 1) * kstep;
            const char* a2 = last ? nA : cA + (size_t)(t + 2) * kstep; const char* b2 = last ? nB : cB + (size_t)(t + 2) * kstep;
            const char* a3 = a2 + kstep; const char* b3 = b2 + kstep;
            if (last && has_next) S.a_ready(nxt);
            if constexpr (SP2) {
            PG8_LDB(B0, 0, 0); PG8_LDB(B1, 0, 1); PG8_SCHED; PG8_LDA(At, 0, 0); PG8_STAGE_GA(PG8_SA(1, 1), a1, 1, false);
            PG8_WAIT_V(8); PG8_WAIT_L(0); PG8_BAR; PG8_MMA(0, 0, At, B0); PG8_MMA(0, 1, At, B1); PG8_BAR; PG8_SCHED;
            PG8_LDA(At, 0, 1); PG8_STAGE(PG8_SB(0, 0), b2, voffB); PG8_STAGE(PG8_SB(0, 1), b2 + hstep, voffB); PG8_STAGE_GA(PG8_SA(0, 0), a2, 0, last);
            PG8_WAIT_V(8); PG8_WAIT_L(0); PG8_BAR; PG8_MMA(1, 0, At, B0); PG8_MMA(1, 1, At, B1); PG8_BAR; PG8_SCHED;
            PG8_LDB(B0, 1, 0); PG8_LDB(B1, 1, 1); PG8_SCHED; PG8_LDA(At, 1, 0); PG8_STAGE_GA(PG8_SA(0, 1), a2, 1, last);
            PG8_WAIT_V(8); PG8_WAIT_L(0); PG8_BAR; PG8_MMA(0, 0, At, B0); PG8_MMA(0, 1, At, B1); PG8_BAR; PG8_SCHED;
            PG8_LDA(At, 1, 1); PG8_STAGE(PG8_SB(1, 0), b3, voffB); PG8_STAGE(PG8_SB(1, 1), b3 + hstep, voffB); PG8_STAGE_GA(PG8_SA(1, 0), a3, 0, last);
            PG8_WAIT_V(8); PG8_WAIT_L(0); PG8_BAR; PG8_MMA(1, 0, At, B0); PG8_MMA(1, 1, At, B1); PG8_BAR; PG8_SCHED;
            } else {
            PG8_LDB(B0, 0, 0); PG8_SCHED; PG8_LDA(At, 0, 0); PG8_STAGE_GA(PG8_SA(1, 1), a1, 1, false);
            PG8_WAIT_L(8); PG8_BAR; PG8_WAIT_L(0); PG8_MMA(0, 0, At, B0); PG8_BAR; PG8_SCHED;
            PG8_LDB(B1, 0, 1); PG8_STAGE(PG8_SB(0, 0), b2, voffB);
            PG8_BAR; PG8_WAIT_L(0); PG8_MMA(0, 1, At, B1); PG8_BAR;
            PG8_LDA(At, 0, 1); PG8_STAGE_GA(PG8_SA(0, 0), a2, 0, last);
            PG8_BAR; PG8_WAIT_L(0); PG8_MMA(1, 0, At, B0); PG8_BAR; PG8_SCHED;
            PG8_STAGE(PG8_SB(0, 1), b2 + hstep, voffB);
            PG8_WAIT_V(6); PG8_BAR; PG8_MMA(1, 1, At, B1); PG8_BAR;
            PG8_LDB(B0, 1, 0); PG8_SCHED; PG8_LDA(At, 1, 0); PG8_STAGE_GA(PG8_SA(0, 1), a2, 1, last);
            PG8_WAIT_L(8); PG8_BAR; PG8_WAIT_L(0); PG8_MMA(0, 0, At, B0); PG8_BAR; PG8_SCHED;
            PG8_LDB(B1, 1, 1); PG8_STAGE(PG8_SB(1, 0), b3, voffB);
            PG8_BAR; PG8_WAIT_L(0); PG8_MMA(0, 1, At, B1); PG8_BAR;
            PG8_LDA(At, 1, 1); PG8_STAGE_GA(PG8_SA(1, 0), a3, 0, last);
            PG8_BAR; PG8_WAIT_L(0); PG8_MMA(1, 0, At, B0); PG8_BAR; PG8_SCHED;
            PG8_STAGE(PG8_SB(1, 1), b3 + hstep, voffB);
            PG8_WAIT_V(6); PG8_BAR; PG8_MMA(1, 1, At, B1); PG8_BAR;
            }
        }
        if constexpr (ALIGN_EPI) { if (wr == 0) PG8_BAR; }
        if constexpr (!Epi::AFTER_DRAIN) { E(acc, cur, wr, wc, fr, fq); S.done(cur); }
        if (!has_next) break;
#pragma unroll
        for (int a = 0; a < 2; ++a)
#pragma unroll
            for (int b = 0; b < 2; ++b)
#pragma unroll
                for (int m = 0; m < 4; ++m)
#pragma unroll
                    for (int n = 0; n < 2; ++n) acc[a][b][m][n] = (f32x4){0.f, 0.f, 0.f, 0.f};
        cur = nxt; cA = nA; cB = nB; ++ui;
        _Pragma("unroll") for (int hh_ = 0; hh_ < 2; ++hh_) _Pragma("unroll") for (int i_ = 0; i_ < 2; ++i_) gAc[hh_][i_] = gAn[hh_][i_];
        if constexpr (ALIGN_EPI) { if (wr == 1) PG8_BAR; }
    }
    PG8_WAIT_V(0);
    if constexpr (!ALIGN_EPI) { if (wr == 0) PG8_BAR; }
    PG8_BAR;
    if constexpr (Epi::AFTER_DRAIN) { E.fused(acc, cur, wr, wc, fr, fq, lds, wid, lane); S.done(cur); }
#undef PG8_GATHER
#undef PG8_STAGE_GA
#undef PG8_SA
#undef PG8_SB
#undef PG8_STAGE
#undef PG8_LDA
#undef PG8_LDB
#undef PG8_MMA
#undef PG8_WAIT_V
#undef PG8_WAIT_L
#undef PG8_BAR
#undef PG8_SCHED
}
}
#define XB_TMO      128
#define XB_XCNT(j)  (256  + 64 * (j))
#define XB_XSUB(j)  (1280 + 64 * (j))
#define XB_XGEN(j)  (2304 + 64 * (j))
#define XB_TOP      3328
#define XB_TOPGEN   3392
#define XCD_BAR_WORDS 3456
#define XB_SPIN_CAP (1u << 18)

__device__ __forceinline__ unsigned xb_ld(unsigned* p)              { return __hip_atomic_load(p, __ATOMIC_RELAXED, __HIP_MEMORY_SCOPE_AGENT); }
__device__ __forceinline__ unsigned xb_add(unsigned* p, unsigned v) { return __hip_atomic_fetch_add(p, v, __ATOMIC_RELAXED, __HIP_MEMORY_SCOPE_AGENT); }
__device__ __forceinline__ unsigned xb_xcc_id() { return (unsigned)__builtin_amdgcn_s_getreg((3 << 11) | 20) & 0xFu; }
#define XB_SPIN(cond, bar) do { unsigned _sp = 0; while (cond) { __builtin_amdgcn_s_sleep(1); \
    if ((++_sp & 255u) == 0u) { if (xb_ld(&(bar)[XB_TMO])) break; if (_sp > XB_SPIN_CAP) { atomicAdd(&(bar)[XB_TMO], 1u); break; } } } } while (0)

struct XcdBarrier {
    unsigned* bar; unsigned x;
    volatile LAS unsigned* st;
};

__device__ __forceinline__ XcdBarrier xcd_barrier_post(unsigned* bar, volatile LAS unsigned* st) {
    XcdBarrier b; b.bar = bar; b.x = xb_xcc_id(); b.st = st;
    if (threadIdx.x == 0) (void)xb_add(&bar[XB_XCNT(b.x)], 1u);
    return b;
}
__device__ __forceinline__ void xcd_barrier_complete(unsigned* bar, unsigned x, unsigned& nloc, unsigned& nx) {
    const unsigned G = gridDim.x * gridDim.y * gridDim.z;
    unsigned sum, cnt, mine, sp = 0u;
    for (;;) {
        sum = 0u; cnt = 0u; mine = 0u;
#pragma unroll
        for (unsigned j = 0; j < 16; ++j) { const unsigned c = xb_ld(&bar[XB_XCNT(j)]); sum += c; cnt += (c > 0u) ? 1u : 0u; mine = (j == x) ? c : mine; }
        if (sum == G) break;
        __builtin_amdgcn_s_sleep(1);
        if ((++sp & 255u) == 0u) { if (xb_ld(&bar[XB_TMO])) break; if (sp > XB_SPIN_CAP) { atomicAdd(&bar[XB_TMO], 1u); break; } }
    }
    nloc = mine > 0u ? mine : 1u; nx = cnt > 0u ? cnt : 1u;
}

__device__ __forceinline__ void xcd_barrier(const XcdBarrier& b) {
    asm volatile("s_waitcnt vmcnt(0)" ::: "memory");
    __syncthreads();
    if (threadIdx.x == 0) {
        unsigned* bar = b.bar;
        __builtin_amdgcn_s_waitcnt(0);
        unsigned nloc = b.st[0], nx = b.st[1];
        if (nloc == 0u) { xcd_barrier_complete(bar, b.x, nloc, nx); b.st[0] = nloc; b.st[1] = nx; }
        const unsigned old = xb_add(&bar[XB_XSUB(b.x)], 1u);
        const unsigned gen = old / nloc;
        if (old + 1u == (gen + 1u) * nloc) {
            __builtin_amdgcn_fence(__ATOMIC_RELEASE, "agent");
            asm volatile("s_waitcnt vmcnt(0)" ::: "memory");
            const unsigned og = xb_add(&bar[XB_TOP], 1u);
            const unsigned tg = og / nx;
            if (og + 1u == (tg + 1u) * nx) xb_add(&bar[XB_TOPGEN], 1u);
            else XB_SPIN(xb_ld(&bar[XB_TOPGEN]) == tg, bar);
            __builtin_amdgcn_fence(__ATOMIC_ACQUIRE, "agent");
            xb_add(&bar[XB_XGEN(b.x)], 1u);
            asm volatile("s_waitcnt vmcnt(0)" ::: "memory");
        } else {
            XB_SPIN(xb_ld(&bar[XB_XGEN(b.x)]) == gen, bar);
            __builtin_amdgcn_fence(__ATOMIC_ACQUIRE, "agent");
            asm volatile("s_waitcnt vmcnt(0)" ::: "memory");
        }
    }
    __syncthreads();
}

struct Params {
    const float* in[33];
    float* out; unsigned char* ws;
    int ph_lo, ph_hi;
};
struct Frame {
    LAS unsigned char* lds;
    int blk, G, wv;
    float* out; unsigned char* ws;
};
constexpr int PTAB_OFF = LDSCTL_OFF + 1024;
__device__ __forceinline__ int lane_id() { int l; asm volatile("v_mbcnt_lo_u32_b32 %0, -1, 0\n\tv_mbcnt_hi_u32_b32 %0, -1, %0" : "=v"(l)); return l; }
__device__ __forceinline__ int mytid(const Frame& F) { int t = F.wv * 64 + lane_id(); asm volatile("" : "+v"(t)); return t; }
__device__ __forceinline__ const float* inptr(const Frame& F, int k) {
    volatile LAS unsigned* t = (volatile LAS unsigned*)(F.lds + PTAB_OFF) + 2 * k;
    const unsigned lo = __builtin_amdgcn_readfirstlane(t[0]), hi = __builtin_amdgcn_readfirstlane(t[1]);
    const GAS float* gp = (const GAS float*)(((unsigned long long)hi << 32) | (unsigned long long)lo);
    return (const float*)gp;
}
#define IN_X 0
#define IN_RELB 1
#define IN_MIXG 2
#define IN_WIN 3
#define IN_WOUT 4
#define IN_FFNG 5
#define IN_QG 6
#define IN_KG 7
#define IN_CW 8
#define IN_CB 9
#define IN_CLG 10
#define IN_CLB 11
#define IN_MU 12
#define IN_W0 13
#define IN_W2 14
#define IN_A0 15
#define IN_A2 16
#define IN_G2 17
#define IN_KK 18
#define IN_KA 19
#define IN_RK 20
#define IN_RLG 21
#define IN_RLB 22
#define IN_GG2 23
#define IN_GGB 24
#define IN_GNG 25
#define IN_FWG 26
#define IN_FWU 27
#define IN_FWD 28
#define IN_ROUTER 29
#define IN_MWG 30
#define IN_MWU 31
#define IN_MWD 32

__device__ __forceinline__ void p0_transpose_item(const float* W, int K, int N, int nblk, const float* gk, bf16* WT, int mode, LAS float* scr, int item, int lane) {
    const int kb = item / nblk, nb = item % nblk, k0 = 64 * kb, n0 = 64 * nb, kr = lane >> 4, n4 = (lane & 15) * 4;
    const bool valid = (n0 + n4) < N;
    f32x4 v[16];
#pragma unroll
    for (int i = 0; i < 16; ++i) v[i] = valid ? *(const f32x4*)(W + (size_t)(k0 + 4 * i + kr) * N + n0 + n4) : (f32x4){0.f, 0.f, 0.f, 0.f};
    if (gk) {
#pragma unroll
        for (int i = 0; i < 16; ++i) v[i] = v[i] * gk[k0 + 4 * i + kr]; }
    const int rowbase = (mode == 0) ? n0 : ((n0 >> 7) * 256 + (mode == 2 ? 128 : 0) + (n0 & 127));
    const int c = lane & 3;
#pragma unroll
    for (int half = 0; half < 2; ++half) {
#pragma unroll
        for (int i = 0; i < 8; ++i) { LAS float* d = scr + (4 * i + kr) * 65 + n4; const f32x4 x = v[half * 8 + i]; d[0] = x[0]; d[1] = x[1]; d[2] = x[2]; d[3] = x[3]; }
        LDS_WAIT(); asm volatile("" ::: "memory");
#pragma unroll
        for (int j = 0; j < 4; ++j) { const int nn = (lane >> 2) + 16 * j; const LAS float* s = scr + (8 * c) * 65 + nn;
            u32x4 o; o.x = pk2(s[0 * 65], s[1 * 65]); o.y = pk2(s[2 * 65], s[3 * 65]); o.z = pk2(s[4 * 65], s[5 * 65]); o.w = pk2(s[6 * 65], s[7 * 65]);
            *(u32x4*)(WT + (size_t)(rowbase + nn) * K + k0 + half * 32 + 8 * c) = o; }
        LDS_WAIT(); asm volatile("" ::: "memory"); }
}
__device__ __forceinline__ void p0_prologue(Frame& F, const int part) {
    const int tid = mytid(F), lane = tid & 63, wave = __builtin_amdgcn_readfirstlane(tid >> 6); (void)lane; (void)wave;
    LAS float* scr = (LAS float*)(F.lds + wave * 16384);
    const int gw = F.blk * NWAVES + wave, NGW = F.G * NWAVES;
    constexpr int I_IN = 16 * 48, I_OUT = 16 * 16, I_GU = 16 * 44, I_D = 44 * 16, I_SET = 2 * I_GU + I_D;
    constexpr int NITEMS = 2 * I_IN + 2 * I_OUT + 9 * I_SET;
    unsigned char* ws = F.ws;
    constexpr int NPART0 = 2 * I_IN + 2 * I_OUT + I_SET;
    for (int it = (part == 0 ? 0 : NPART0) + gw; it < (part == 0 ? NPART0 : NITEMS); it += NGW) {
        int r = it;
        if (r < 2 * I_IN) { const int l = r / I_IN; r -= l * I_IN;
            p0_transpose_item(inptr(F, IN_WIN) + (size_t)l * DM * INW, DM, INW, 48, inptr(F, IN_MIXG) + l * DM, (bf16*)(ws + WS_WIN) + (size_t)l * NPADW * DM, 0, scr, r, lane); continue; }
        r -= 2 * I_IN;
        if (r < 2 * I_OUT) { const int l = r / I_OUT; r -= l * I_OUT;
            p0_transpose_item(inptr(F, IN_WOUT) + (size_t)l * DM * DM, DM, DM, 16, nullptr, (bf16*)(ws + WS_WOUT) + (size_t)l * DM * DM, 0, scr, r, lane); continue; }
        r -= 2 * I_OUT;
        const int set = r / I_SET; r -= set * I_SET;
        const float* wg = set == 0 ? inptr(F, IN_FWG) : inptr(F, IN_MWG) + (size_t)(set - 1) * DM * DFF;
        const float* wu = set == 0 ? inptr(F, IN_FWU) : inptr(F, IN_MWU) + (size_t)(set - 1) * DM * DFF;
        const float* wd = set == 0 ? inptr(F, IN_FWD) : inptr(F, IN_MWD) + (size_t)(set - 1) * DFF * DM;
        const float* gk = inptr(F, IN_FFNG) + (set == 0 ? 0 : DM);
        bf16* dgu = set == 0 ? (bf16*)(ws + WS_WGU) : (bf16*)(ws + WS_MOEW + (size_t)(set - 1) * MOEW_E_BYTES);
        bf16* dd = set == 0 ? (bf16*)(ws + WS_WD) : (bf16*)(ws + WS_MOEW + (size_t)(set - 1) * MOEW_E_BYTES + MOEW_GU_BYTES);
        if (r < I_GU) { p0_transpose_item(wg, DM, DFF, 44, gk, dgu, 1, scr, r, lane); continue; } r -= I_GU;
        if (r < I_GU) { p0_transpose_item(wu, DM, DFF, 44, gk, dgu, 2, scr, r, lane); continue; } r -= I_GU;
        p0_transpose_item(wd, DFF, DM, 16, nullptr, dd, 0, scr, r, lane);
    }
    if (part != 0) return;
    const float* x = inptr(F, IN_X); bf16* hb = (bf16*)(ws + WS_HB); float* ssq = (float*)(ws + WS_SSQ);
    for (int m = gw; m < NTOK; m += NGW) {
        const f32x4* xr = (const f32x4*)(x + (size_t)m * DM) + lane; f32x4 v[4]; float s = 0.f;
#pragma unroll
        for (int j = 0; j < 4; ++j) { v[j] = xr[64 * j]; s += (v[j][0] * v[j][0] + v[j][1] * v[j][1]) + (v[j][2] * v[j][2] + v[j][3] * v[j][3]); }
        s = wave_sum(s);
        u32x2* o8 = (u32x2*)(hb + (size_t)m * DM) + lane;
#pragma unroll
        for (int j = 0; j < 4; ++j) { u32x2 w; w.x = pk2(v[j][0], v[j][1]); w.y = pk2(v[j][2], v[j][3]); o8[64 * j] = w; }
        if (lane < 16) ssq[(size_t)m * 16 + lane] = (lane == 0) ? s : 0.f;
    }
}

__device__ const unsigned char T5B[3][132] = {
 {0,1,2,3,4,5,6,7,8,9,10,11,12,13,14,15,16,16,16,16,16,16,17,17,17,17,17,17,17,17,18,18,18,18,18,18,18,18,18,18,19,19,19,19,19,19,19,19,19,19,19,19,19,19,20,20,20,20,20,20,20,20,20,20,20,20,20,20,20,20,20,20,20,21,21,21,21,21,21,21,21,21,21,21,21,21,21,21,21,21,21,21,21,21,21,21,21,21,21,22,22,22,22,22,22,22,22,22,22,22,22,22,22,22,22,22,22,22,22,22,22,22,22,22,22,22,22,22,22,0,0,0},
 {0,4,8,12,16,16,17,17,18,18,19,19,19,19,20,20,20,20,20,21,21,21,21,21,21,22,22,22,22,22,22,22,22,22,23,23,23,23,23,23,23,23,23,23,23,23,24,24,24,24,24,24,24,24,24,24,24,24,24,24,24,24,25,25,25,25,25,25,25,25,25,25,25,25,25,25,25,25,25,25,25,25,25,26,26,26,26,26,26,26,26,26,26,26,26,26,26,26,26,26,26,26,26,26,26,26,26,26,26,26,26,26,26,27,27,27,27,27,27,27,27,27,27,27,27,27,27,27,27,0,0,0},
 {0,16,18,19,20,21,21,22,22,23,23,23,24,24,24,24,25,25,25,25,25,26,26,26,26,26,26,26,26,27,27,27,27,27,27,27,27,27,27,28,28,28,28,28,28,28,28,28,28,28,28,28,29,29,29,29,29,29,29,29,29,29,29,29,29,29,29,29,29,29,30,30,30,30,30,30,30,30,30,30,30,30,30,30,30,30,30,30,30,30,30,30,30,30,30,31,31,31,31,31,31,31,31,31,31,31,31,31,31,31,31,31,31,31,31,31,31,31,31,31,31,31,31,31,31,31,31,31,31,0,0,0}};

__device__ __forceinline__ void attn_qknorm(Frame& F, bf16* Z, const float* qg, const float* kg) {
    const int tid = mytid(F); const int gt = F.blk * NTHREADS + tid, NGT = F.G * NTHREADS;
    for (int idx = gt; idx < NTOK * 64; idx += NGT) { const int tok = idx >> 6, seg = (idx >> 3) & 7, c8 = idx & 7;
        u32x4* ptr = (u32x4*)(Z + (size_t)tok * INW + (seg >> 2) * 256 + (seg & 3) * 64 + c8 * 8); const u32x4 p = *ptr; float f[8]; unpack8(p, f);
        float ss = 0.f;
#pragma unroll
        for (int e2 = 0; e2 < 8; ++e2) ss += f[e2] * f[e2];
        ss = red8(ss);
        const float rs = __builtin_amdgcn_rsqf(ss * (1.0f / 64.0f) + NORM_EPS) * (seg < 4 ? 0.125f : 1.0f); const float* gp = (seg < 4 ? qg : kg) + c8 * 8;
        u32x4 o; o.x = pk2(f[0] * rs * gp[0], f[1] * rs * gp[1]); o.y = pk2(f[2] * rs * gp[2], f[3] * rs * gp[3]); o.z = pk2(f[4] * rs * gp[4], f[5] * rs * gp[5]); o.w = pk2(f[6] * rs * gp[6], f[7] * rs * gp[7]);
        *ptr = o; }
}
typedef short v4i16 __attribute__((ext_vector_type(4)));
__device__ __forceinline__ void attn_tile(LAS unsigned char* lds, const bf16* Z, bf16* OP, float* LSE, const float* rel_bias, int tile, int tid) {
    const int lane = tid & 63, w = __builtin_amdgcn_readfirstlane(tid >> 6), fr = lane & 15, g = lane >> 4;
    const int br = tile >> 10, rem = tile & 1023, b = rem >> 7, h = (rem >> 5) & 3, sub = rem & 31;
    const int dsh = 2 * br, nbl = 32 >> dsh, r = sub >> (5 - dsh), n = sub & (nbl - 1);
    LAS unsigned char* Qs = lds;
    LAS unsigned char* Ks = lds + 16384;
    LAS unsigned char* Vs = lds + 49152;
    LAS float* BT = (LAS float*)(lds + 81920);
    const size_t zrow0 = (size_t)b * SEQ;
    if (tid < 383) { const int delta = tid - 127; BT[tid] = (delta >= 0 && delta <= 128) ? rel_bias[(int)T5B[br][delta] * 4 + h] : -3.0e38f; }
    { const int rl = lane >> 3, cp = lane & 7;
#pragma unroll
        for (int i = 0; i < 4; ++i) { const int R0 = (w * 4 + i) * 8, row = R0 + rl; int lk = 128 * (n - 1) + row; lk = lk < 0 ? 0 : lk;
            const bf16* zr = Z + (zrow0 + ((size_t)lk << dsh) + r) * INW + h * 64;
            __builtin_amdgcn_global_load_lds((const unsigned*)(zr + 256 + ((cp ^ (row & 7)) * 8)), (LAS unsigned*)(Ks + R0 * 128), 16, 0, 0);
            __builtin_amdgcn_global_load_lds((const unsigned*)(zr + 512 + ((2 * ((cp >> 1) ^ ((row >> 1) & 3)) + (cp & 1)) * 8)), (LAS unsigned*)(Vs + R0 * 128), 16, 0, 0); }
#pragma unroll
        for (int i = 0; i < 2; ++i) { const int R0 = (w * 2 + i) * 8, row = R0 + rl; const int lq = 128 * n + row;
            const bf16* zr = Z + (zrow0 + ((size_t)lq << dsh) + r) * INW + h * 64;
            __builtin_amdgcn_global_load_lds((const unsigned*)(zr + ((cp ^ (row & 7)) * 8)), (LAS unsigned*)(Qs + R0 * 128), 16, 0, 0); } }
    asm volatile("s_waitcnt vmcnt(0)" ::: "memory");
    BAR();
    bf16x8 qf[2];
#pragma unroll
    for (int ks = 0; ks < 2; ++ks) qf[ks] = *(const LAS bf16x8*)(Qs + (16 * w + fr) * 128 + (((ks * 4 + g) ^ (fr & 7)) << 4));
    f32x4 s[16];
#pragma unroll
    for (int kb = 0; kb < 16; ++kb) { s[kb] = (f32x4){0.f, 0.f, 0.f, 0.f};
#pragma unroll
        for (int ks = 0; ks < 2; ++ks) { const bf16x8 kf = *(const LAS bf16x8*)(Ks + (16 * kb + fr) * 128 + (((ks * 4 + g) ^ (fr & 7)) << 4));
            s[kb] = __builtin_amdgcn_mfma_f32_16x16x32_bf16(kf, qf[ks], s[kb], 0, 0, 0); } }
    const int q = 16 * w + fr; float mx = -3.0e38f;
    const LAS float* btq = BT + (q + 255 - 4 * g);
#pragma unroll
    for (int kb = 0; kb < 16; ++kb)
#pragma unroll
        for (int rg = 0; rg < 4; ++rg) { float v = s[kb][rg] + btq[-(16 * kb + rg)];
            if (kb < 8) v = (n > 0) ? v : -3.0e38f;
            s[kb][rg] = v; mx = fmaxf(mx, v); }
    mx = fmaxf(mx, __shfl_xor(mx, 16)); mx = fmaxf(mx, __shfl_xor(mx, 32));
    float den = 0.f;
#pragma unroll
    for (int kb = 0; kb < 16; ++kb)
#pragma unroll
        for (int rg = 0; rg < 4; ++rg) { const float p = __expf(s[kb][rg] - mx); s[kb][rg] = p; den += p; }
    den += __shfl_xor(den, 16); den += __shfl_xor(den, 32);
    f32x4 o[4];
#pragma unroll
    for (int eb = 0; eb < 4; ++eb) o[eb] = (f32x4){0.f, 0.f, 0.f, 0.f};
    const int trq = fr >> 2, trp = fr & 3;
#pragma unroll
    for (int s8 = 0; s8 < 8; ++s8) {
        u32x4 pw; pw.x = pk2(s[2 * s8][0], s[2 * s8][1]); pw.y = pk2(s[2 * s8][2], s[2 * s8][3]); pw.z = pk2(s[2 * s8 + 1][0], s[2 * s8 + 1][1]); pw.w = pk2(s[2 * s8 + 1][2], s[2 * s8 + 1][3]);
        const bf16x8 pb = __builtin_bit_cast(bf16x8, pw);
        const int rowA = 32 * s8 + 4 * g + trq, swz = (rowA >> 1) & 3;
#pragma unroll
        for (int eb = 0; eb < 4; ++eb) { const LAS unsigned char* vp = Vs + rowA * 128 + ((eb ^ swz) * 32) + 8 * trp;
            const v4i16 lo = __builtin_amdgcn_ds_read_tr16_b64_v4i16((LAS v4i16*)vp), hi = __builtin_amdgcn_ds_read_tr16_b64_v4i16((LAS v4i16*)(vp + 16 * 128));
            bf16x8 af; af[0] = lo[0]; af[1] = lo[1]; af[2] = lo[2]; af[3] = lo[3]; af[4] = hi[0]; af[5] = hi[1]; af[6] = hi[2]; af[7] = hi[3];
            o[eb] = __builtin_amdgcn_mfma_f32_16x16x32_bf16(af, pb, o[eb], 0, 0, 0); } }
    const float inv = 1.0f / den; const size_t tokq = zrow0 + ((size_t)(128 * n + q) << dsh) + r;
    bf16* op = OP + ((size_t)br * NTOK + tokq) * 256 + h * 64 + 4 * g;
#pragma unroll
    for (int eb = 0; eb < 4; ++eb) { u32x2 wv; wv.x = pk2(o[eb][0] * inv, o[eb][1] * inv); wv.y = pk2(o[eb][2] * inv, o[eb][3] * inv); *(u32x2*)(op + 16 * eb) = wv; }
    if (g == 0) LSE[((size_t)br * NTOK + tokq) * 4 + h] = mx + __logf(den);
    BAR();
}

__device__ __forceinline__ void attn_merge(Frame& F, const bf16* OP, const float* LSE, bf16* Y, int wi, int nw) {
    const int tid = mytid(F), lane = tid & 63, wave = __builtin_amdgcn_readfirstlane(tid >> 6); (void)lane; (void)wave;
    const int gt = wi * NTHREADS + tid, NGT = nw * NTHREADS;
    for (int idx = gt; idx < NTOK * 32; idx += NGT) { const int tok = idx >> 5, c8 = idx & 31, h = c8 >> 3;
        const float l0 = LSE[((size_t)0 * NTOK + tok) * 4 + h], l1 = LSE[((size_t)1 * NTOK + tok) * 4 + h], l2 = LSE[((size_t)2 * NTOK + tok) * 4 + h];
        const float m = fmaxf(l0, fmaxf(l1, l2)); float w0 = __expf(l0 - m), w1 = __expf(l1 - m), w2 = __expf(l2 - m); const float inv = 1.0f / (w0 + w1 + w2); w0 *= inv; w1 *= inv; w2 *= inv;
        const u32x4 a = *(const u32x4*)(OP + ((size_t)0 * NTOK + tok) * 256 + c8 * 8), bq = *(const u32x4*)(OP + ((size_t)1 * NTOK + tok) * 256 + c8 * 8), c = *(const u32x4*)(OP + ((size_t)2 * NTOK + tok) * 256 + c8 * 8);
        float fa[8], fb[8], fc[8]; unpack8(a, fa); unpack8(bq, fb); unpack8(c, fc); float r[8];
#pragma unroll
        for (int e = 0; e < 8; ++e) r[e] = w0 * fa[e] + w1 * fb[e] + w2 * fc[e];
        u32x4 o; o.x = pk2(r[0], r[1]); o.y = pk2(r[2], r[3]); o.z = pk2(r[4], r[5]); o.w = pk2(r[6], r[7]);
        *(u32x4*)(Y + (size_t)tok * DM + c8 * 8) = o; }
}

__device__ __forceinline__ void conv_item(Frame& F, const bf16* Z, bf16* Y, const float* cw, const float* cb, const float* lg, const float* lb, int item) {
    const int tid = mytid(F), b = item >> 6, t0 = (item & 63) * 64;
    LAS float* HG = (LAS float*)F.lds;
    LAS float* WL = (LAS float*)(F.lds + 96256);
    f32x4 wq[4]; u32x4 uu[6], gg[6];
#pragma unroll
    for (int i = 0; i < 4; ++i) { const int q = tid + NTHREADS * i; wq[i] = (q < 31 * 64) ? *(const f32x4*)(cw + 4 * q) : (f32x4){0.f, 0.f, 0.f, 0.f}; }
#pragma unroll
    for (int i = 0; i < 6; ++i) { const int p = tid + NTHREADS * i, row = p >> 5, c8 = p & 31, t = t0 - 30 + row; uu[i] = (u32x4){0u, 0u, 0u, 0u}; gg[i] = uu[i];
        if (p < 94 * 32 && t >= 0) { const bf16* zr = Z + ((size_t)b * SEQ + t) * INW + ZB + c8 * 8; uu[i] = *(const u32x4*)zr; gg[i] = *(const u32x4*)(zr + 256); } }
#pragma unroll
    for (int i = 0; i < 4; ++i) { const int q = tid + NTHREADS * i; if (q < 31 * 64) *(LAS f32x4*)(WL + 4 * q) = wq[i]; }
#pragma unroll
    for (int i = 0; i < 6; ++i) { const int p = tid + NTHREADS * i, row = p >> 5, c8 = p & 31;
        if (p < 94 * 32) { float fu[8], fg[8], hv[8]; unpack8(uu[i], fu); unpack8(gg[i], fg);
#pragma unroll
            for (int e = 0; e < 8; ++e) hv[e] = fu[e] * __builtin_amdgcn_rcpf(1.0f + __expf(-fg[e]));
            LAS f32x4* d = (LAS f32x4*)(HG + row * 256 + c8 * 8); d[0] = (f32x4){hv[0], hv[1], hv[2], hv[3]}; d[1] = (f32x4){hv[4], hv[5], hv[6], hv[7]}; } }
    BAR();
    const int tg = tid >> 5, co = tid & 31;
    f32x4 acc[4][2];
    { const f32x4 b0 = *(const f32x4*)(cb + 8 * co), b1 = *(const f32x4*)(cb + 8 * co + 4);
#pragma unroll
        for (int t = 0; t < 4; ++t) { acc[t][0] = b0; acc[t][1] = b1; } }
    f32x4 wv[4][2];
#pragma unroll
    for (int d = 0; d < 4; ++d) { wv[d][0] = (f32x4){0.f, 0.f, 0.f, 0.f}; wv[d][1] = wv[d][0]; }
#pragma unroll 2
    for (int r = 0; r < 34; ++r) {
        const LAS float* hp = HG + (4 * tg + r) * 256 + 8 * co; const f32x4 h0 = *(const LAS f32x4*)hp, h1 = *(const LAS f32x4*)(hp + 4);
#pragma unroll
        for (int d = 3; d > 0; --d) { wv[d][0] = wv[d - 1][0]; wv[d][1] = wv[d - 1][1]; }
        if (r < 31) { wv[0][0] = *(const LAS f32x4*)(WL + r * 256 + 8 * co); wv[0][1] = *(const LAS f32x4*)(WL + r * 256 + 8 * co + 4); } else { wv[0][0] = (f32x4){0.f, 0.f, 0.f, 0.f}; wv[0][1] = wv[0][0]; }
#pragma unroll
        for (int t = 0; t < 4; ++t) { acc[t][0] += h0 * wv[t][0]; acc[t][1] += h1 * wv[t][1]; } }
    const f32x4 g0 = *(const f32x4*)(lg + 8 * co), g1 = *(const f32x4*)(lg + 8 * co + 4), be0 = *(const f32x4*)(lb + 8 * co), be1 = *(const f32x4*)(lb + 8 * co + 4);
#pragma unroll
    for (int t = 0; t < 4; ++t) { const f32x4 x0 = acc[t][0], x1 = acc[t][1];
        float s = ((x0[0] + x0[1]) + (x0[2] + x0[3])) + ((x1[0] + x1[1]) + (x1[2] + x1[3])); s = red8(s);
        const float mean = s * (1.0f / 64.0f); const f32x4 d0 = x0 - mean, d1 = x1 - mean;
        float ss = ((d0[0] * d0[0] + d0[1] * d0[1]) + (d0[2] * d0[2] + d0[3] * d0[3])) + ((d1[0] * d1[0] + d1[1] * d1[1]) + (d1[2] * d1[2] + d1[3] * d1[3])); ss = red8(ss);
        const float rstd = __builtin_amdgcn_rsqf(ss * (1.0f / 64.0f) + 1e-5f); float y[8];
#pragma unroll
        for (int e2 = 0; e2 < 4; ++e2) { const float a = d0[e2] * rstd * g0[e2] + be0[e2], c = d1[e2] * rstd * g1[e2] + be1[e2]; y[e2] = a * __builtin_amdgcn_rcpf(1.0f + __expf(-a)); y[4 + e2] = c * __builtin_amdgcn_rcpf(1.0f + __expf(-c)); }
        u32x4 o; o.x = pk2(y[0], y[1]); o.y = pk2(y[2], y[3]); o.z = pk2(y[4], y[5]); o.w = pk2(y[6], y[7]);
        *(u32x4*)(Y + ((size_t)b * SEQ + t0 + 4 * tg + t) * DM + 256 + 8 * co) = o; }
    BAR();
}

__device__ __forceinline__ bf16x8 ldfrag(const LAS unsigned char* base, int stride, int row0, int kb0, int fr, int g) {
    return *(const LAS bf16x8*)(base + (row0 + fr) * stride + kb0 + 16 * g);
}
#define MFMA16(a, b, c) __builtin_amdgcn_mfma_f32_16x16x32_bf16((a), (b), (c), 0, 0, 0)

constexpr int GL_G2 = 0, GL_Q = 2048, GL_K = 6144, GL_GK = 10240, GL_GD = 14336, GL_OG = 16384, GL_QT = 24576, GL_KB = 27136, GL_KHT = 29696, GL_VT = 32256, GL_ATT = 37376, GL_ST = 39936, GL_EC = 45056,
              GL_OB = 45184, GL_GB = 53376, GL_END = 53504;
struct GlaRaw { u32x4 p[2]; u32x4 s; };
__device__ __forceinline__ void gla_decode(int tid, int h, int it, int& tt, int& col, int& kind, int& off, bool& ok) {
    const int p = tid + 512 * it; ok = p < 832; tt = p / 26; const int qd = p % 26;
    if (qd < 4) { col = ZD + h * 32 + 8 * qd; kind = 0; off = tt * 32 + 8 * qd; }
    else if (qd < 8) { col = ZD + 128 + h * 32 + 8 * (qd - 4); kind = 1; off = tt * 32 + 8 * (qd - 4); }
    else if (qd < 16) { col = ZD + 256 + h * 64 + 8 * (qd - 8); kind = 2; off = 8 * (qd - 8); }
    else if (qd < 18) { col = ZD + 512 + 8 * (qd - 16); kind = 3; off = tt * 16 + 8 * (qd - 16); }
    else { col = ZD + 528 + h * 64 + 8 * (qd - 18); kind = 4; off = tt * 64 + 8 * (qd - 18); }
}
template <int STEP> __device__ __forceinline__ void gla_load(const bf16* Z, const unsigned char* sst, int b, int h, int ch, int tid, GlaRaw& r) {
#pragma unroll
    for (int it = 0; it < 2; ++it) { int tt, col, kind, off; bool ok; gla_decode(tid, h, it, tt, col, kind, off, ok);
        r.p[it] = ok ? *(const u32x4*)(Z + ((size_t)b * SEQ + ch * 32 + tt) * INW + col) : (u32x4){0u, 0u, 0u, 0u}; }
    if (STEP == 1) r.s = (tid < 256) ? *(const u32x4*)(sst + (size_t)((b * 4 + h) * (SEQ / 32) + ch) * 4096 + 16 * tid) : (u32x4){0u, 0u, 0u, 0u};
}
template <int STEP> __device__ __forceinline__ void gla_item(Frame& F, const GlaRaw& raw, unsigned char* con, float* ecg, bf16* Y, const float* ng, int b, int h, int ch) {
    const int tid = mytid(F), lane = tid & 63, w = __builtin_amdgcn_readfirstlane(tid >> 6), fr = lane & 15, g = lane >> 4;
    LAS unsigned char* L = F.lds;
    LAS float *G2 = (LAS float*)(L + GL_G2), *QF = (LAS float*)(L + GL_Q), *KF = (LAS float*)(L + GL_K), *GK = (LAS float*)(L + GL_GK), *GD = (LAS float*)(L + GL_GD), *OG = (LAS float*)(L + GL_OG),
              *OB = (LAS float*)(L + GL_OB), *GB = (LAS float*)(L + GL_GB);
    LAS unsigned char *QT = L + GL_QT, *KB = L + GL_KB, *KHT = L + GL_KHT, *VT = L + GL_VT, *ATT = L + GL_ATT, *ST = L + GL_ST;
    const size_t item = (size_t)((b * 4 + h) * (SEQ / 32) + ch);
#pragma unroll
    for (int it = 0; it < 2; ++it) { int tt, col, kind, off; bool ok; gla_decode(tid, h, it, tt, col, kind, off, ok);
        if (ok) { float f[8]; unpack8(raw.p[it], f);
            if (kind == 2) { LAS unsigned short* vp = (LAS unsigned short*)(VT + off * 80 + tt * 2); const u32x4 pr = raw.p[it];
                vp[0 * 40] = (unsigned short)(pr.x & 0xffffu); vp[1 * 40] = (unsigned short)(pr.x >> 16); vp[2 * 40] = (unsigned short)(pr.y & 0xffffu); vp[3 * 40] = (unsigned short)(pr.y >> 16);
                vp[4 * 40] = (unsigned short)(pr.z & 0xffffu); vp[5 * 40] = (unsigned short)(pr.z >> 16); vp[6 * 40] = (unsigned short)(pr.w & 0xffffu); vp[7 * 40] = (unsigned short)(pr.w >> 16); }
            else if (kind != 4 || STEP == 1) { LAS float* dst = (kind == 0 ? QF : kind == 1 ? KF : kind == 3 ? GD : OG) + off; const float sc = kind == 0 ? 0.17677669529663687f : 1.0f;
                ((LAS f32x4*)dst)[0] = (f32x4){f[0] * sc, f[1] * sc, f[2] * sc, f[3] * sc}; ((LAS f32x4*)dst)[1] = (f32x4){f[4] * sc, f[5] * sc, f[6] * sc, f[7] * sc}; } } }
    if (STEP == 1 && tid < 256) *(LAS u32x4*)(ST + (tid >> 2) * 80 + (tid & 3) * 16) = raw.s;
    BAR();
#pragma unroll
    for (int it = 0; it < 2; ++it) { const int o = tid + 512 * it, tt = o >> 5, kk = o & 31; float x = GB[kk];
#pragma unroll
        for (int j = 0; j < 16; ++j) x += GD[tt * 16 + j] * G2[j * 32 + kk];
        GK[tt * 32 + kk] = -softplusf_(-x) * (1.0f / 16.0f); }
    BAR();
    { const int t = tid >> 4, k2 = (tid & 15) * 2; float c0 = 0.f, c1 = 0.f, b0 = 0.f, b1 = 0.f;
#pragma unroll 8
        for (int s = 0; s < 32; ++s) { const f32x2 gk = *(const LAS f32x2*)(GK + s * 32 + k2); c0 += gk[0]; c1 += gk[1]; if (s == t) { b0 = c0; b1 = c1; } }
        const f32x2 q = *(const LAS f32x2*)(QF + t * 32 + k2), k = *(const LAS f32x2*)(KF + t * 32 + k2);
        if (STEP == 1) { *(LAS unsigned*)(QT + t * 80 + k2 * 2) = pk2(q[0] * __expf(b0), q[1] * __expf(b1)); *(LAS unsigned*)(KB + t * 80 + k2 * 2) = pk2(k[0] * __expf(-b0), k[1] * __expf(-b1)); }
        else { *(LAS unsigned short*)(KHT + k2 * 80 + t * 2) = (unsigned short)f2bf(k[0] * __expf(c0 - b0)); *(LAS unsigned short*)(KHT + (k2 + 1) * 80 + t * 2) = (unsigned short)f2bf(k[1] * __expf(c1 - b1));
            if (t == 0) { ecg[item * 32 + k2] = __expf(c0); ecg[item * 32 + k2 + 1] = __expf(c1); } } }
    BAR();
    if (STEP == 0) {
        const int kb = w >> 2, vb = w & 3; f32x4 d = (f32x4){0.f, 0.f, 0.f, 0.f};
        d = MFMA16(ldfrag(KHT, 80, 16 * kb, 0, fr, g), ldfrag(VT, 80, 16 * vb, 0, fr, g), d);
        u32x2 so; so.x = pk2(d[0], d[1]); so.y = pk2(d[2], d[3]); *(u32x2*)(con + item * 4096 + (16 * vb + fr) * 64 + (16 * kb + 4 * g) * 2) = so;
        BAR();
    } else {
        if (w < 3) { const int atb = w == 0 ? 0 : 1, asb = w == 2 ? 1 : 0;
            f32x4 d = (f32x4){0.f, 0.f, 0.f, 0.f}; d = MFMA16(ldfrag(KB, 80, 16 * asb, 0, fr, g), ldfrag(QT, 80, 16 * atb, 0, fr, g), d);
            const int t = 16 * atb + fr; float v[4];
#pragma unroll
            for (int r = 0; r < 4; ++r) { const int s = 16 * asb + 4 * g + r; v[r] = (s <= t) ? d[r] : 0.f; }
            u32x2 o; o.x = pk2(v[0], v[1]); o.y = pk2(v[2], v[3]); *(LAS u32x2*)(ATT + t * 80 + (16 * asb + 4 * g) * 2) = o; }
        else if (w == 3) { *(LAS u32x2*)(ATT + fr * 80 + (16 + 4 * g) * 2) = (u32x2){0u, 0u}; }
        BAR();
        { const int tb = w >> 2, vb = w & 3; f32x4 o = (f32x4){0.f, 0.f, 0.f, 0.f};
            o = MFMA16(ldfrag(ATT, 80, 16 * tb, 0, fr, g), ldfrag(VT, 80, 16 * vb, 0, fr, g), o);
            o = MFMA16(ldfrag(QT, 80, 16 * tb, 0, fr, g), ldfrag(ST, 80, 16 * vb, 0, fr, g), o);
#pragma unroll
            for (int r = 0; r < 4; ++r) OB[(16 * tb + 4 * g + r) * 64 + 16 * vb + fr] = o[r]; }
        BAR();
        { const int tt = tid >> 4, v4 = (tid & 15) * 4; const f32x4 o = *(const LAS f32x4*)(OB + tt * 64 + v4);
            float ss = (o[0] * o[0] + o[1] * o[1]) + (o[2] * o[2] + o[3] * o[3]); ss = red16(ss);
            const float rs = __builtin_amdgcn_rsqf(ss * (1.0f / 64.0f) + NORM_EPS); const f32x4 gv = *(const f32x4*)(ng + v4), og = *(const LAS f32x4*)(OG + tt * 64 + v4); float y[4];
#pragma unroll
            for (int e = 0; e < 4; ++e) y[e] = o[e] * rs * gv[e] * og[e] * __builtin_amdgcn_rcpf(1.0f + __expf(-og[e]));
            u32x2 wv; wv.x = pk2(y[0], y[1]); wv.y = pk2(y[2], y[3]); *(u32x2*)(Y + ((size_t)b * SEQ + ch * 32 + tt) * DM + 768 + h * 64 + v4) = wv; }
        BAR();
    }
}
__device__ __forceinline__ int gla_sched(int k, int wi, int nw, int skip) { const int full = 1024 / nw, rem = 1024 - full * nw; if (k < full) return k * nw + wi; if (k == full && wi >= skip && wi - skip < rem) return full * nw + wi - skip; return -1; }
template <int STEP> __device__ __forceinline__ void gla_items(Frame& F, const bf16* Z, unsigned char* con, float* ecg, bf16* Y, const float* g2, const float* gb, const float* ng, int wi, int nw, int skip) {
    const int tid = mytid(F);
#pragma unroll 1
    for (int h = 0; h < 4; ++h) {
        ((LAS float*)(F.lds + GL_G2))[tid] = g2[(tid >> 5) * 128 + h * 32 + (tid & 31)]; if (tid < 32) ((LAS float*)(F.lds + GL_GB))[tid] = gb[h * 32 + tid];
        BAR();
        GlaRaw cur, nxt; cur.p[0] = (u32x4){0u, 0u, 0u, 0u}; cur.p[1] = cur.p[0]; cur.s = cur.p[0]; nxt = cur;
        int it = gla_sched(0, wi, nw, skip);
        if (it >= 0) gla_load<STEP>(Z, con, it >> 7, h, it & 127, tid, cur);
#pragma unroll 1
        for (int k = 0; it >= 0; ++k) { const int nx = gla_sched(k + 1, wi, nw, skip);
            if (nx >= 0) gla_load<STEP>(Z, con, nx >> 7, h, nx & 127, tid, nxt);
            gla_item<STEP>(F, cur, con, ecg, Y, ng, it >> 7, h, it & 127);
            cur = nxt; it = nx; }
        BAR(); }
}
__device__ __forceinline__ void gla_scan(Frame& F, unsigned char* con, const float* ecg, int b, int h) {
    const int tid = mytid(F); const int k4 = (tid & 7) * 4;
    unsigned char* base = con + (size_t)((b * 4 + h) * (SEQ / 32)) * 4096 + 8 * tid; const float* eb = ecg + (size_t)((b * 4 + h) * (SEQ / 32)) * 32 + k4;
    float s[4] = {0.f, 0.f, 0.f, 0.f};
    u32x2 cn[4]; f32x4 ec[4];
#pragma unroll
    for (int j = 0; j < 4; ++j) { cn[j] = *(const u32x2*)(base + (size_t)j * 4096); ec[j] = *(const f32x4*)(eb + j * 32); }
#pragma unroll 1
    for (int c0 = 0; c0 < SEQ / 32; c0 += 4) {
        u32x2 cc[4]; f32x4 ee[4];
#pragma unroll
        for (int j = 0; j < 4; ++j) { cc[j] = cn[j]; ee[j] = ec[j]; }
        if (c0 + 4 < SEQ / 32) {
#pragma unroll
            for (int j = 0; j < 4; ++j) { cn[j] = *(const u32x2*)(base + (size_t)(c0 + 4 + j) * 4096); ec[j] = *(const f32x4*)(eb + (c0 + 4 + j) * 32); } }
#pragma unroll
        for (int j = 0; j < 4; ++j) { u32x2 o; o.x = pk2(s[0], s[1]); o.y = pk2(s[2], s[3]); *(u32x2*)(base + (size_t)(c0 + j) * 4096) = o;
            s[0] = ee[j][0] * s[0] + bflo(cc[j].x); s[1] = ee[j][1] * s[1] + bfhi(cc[j].x); s[2] = ee[j][2] * s[2] + bflo(cc[j].y); s[3] = ee[j][3] * s[3] + bfhi(cc[j].y); } }
}

struct RwkvP { const float *mu, *w0, *w2, *a0, *a2, *g2, *kk, *ka, *rk, *lg, *lb; };
constexpr int RC_AT = 0  , RC_RT = 2048  , RC_ZT = 4096, RC_RBK = 5120, RC_BKT = 6144  , RC_VT4 = 10240  ,
              RC_GC = 12288  , RC_G = 12544  , RC_BON = 14592  , RC_BYTES = 14656, RC_STRIDE = 14848;
constexpr int RC_CHUNKS16 = RC_BYTES / 16;
static_assert((size_t)NB * 4 * (SEQ / 16) * RC_STRIDE <= NEXP * MOEW_E_BYTES, "RWKV records overlay the (not yet converted) MoE weight region");
constexpr int RW_W2T = 0, RW_A2T = 5120, RW_G2T = 10240, RW_MU = 19456  , RW_TW = 23040, RW_AD = 24320, RW_SG = 25600, RW_R = 27904, RW_K = 32000, RW_V = 36096, RW_WL = 40192, RW_AL = 44288,
              RW_G = 48384, RW_KK = 52480, RW_KP = 56576, RW_BON = 60672, RW_GC = 60736, RW_AR = 60992, RW_BK = 65600, RW_BKT = 70208, RW_ZAK = 75328, RW_RBK = 76608, RW_AAB = 77888, RW_TT = 78912  , RW_PAR = 80192  , RW_END = 81472;

__device__ __forceinline__ void rwkv_prep_init(Frame& F, const RwkvP P, int h) {
    const int tid = mytid(F); LAS unsigned char* L = F.lds;
    for (int i = tid; i < 64 * 32; i += NTHREADS) { const int c = i >> 5, j = i & 31;
        *(LAS unsigned short*)(L + RW_W2T + c * 80 + j * 2) = (unsigned short)f2bf(P.w2[j * 256 + h * 64 + c]); *(LAS unsigned short*)(L + RW_A2T + c * 80 + j * 2) = (unsigned short)f2bf(P.a2[j * 256 + h * 64 + c]); }
    for (int i = tid; i < 64 * 64; i += NTHREADS) { const int c = i >> 6, j = i & 63; *(LAS unsigned short*)(L + RW_G2T + c * 144 + j * 2) = (unsigned short)f2bf(P.g2[j * 256 + h * 64 + c]); }
    for (int i = tid; i < 896; i += NTHREADS) ((LAS float*)(L + RW_MU))[i] = P.mu[i];
    if (tid < 320) { const int q = tid >> 6, c = tid & 63; const float* src = q == 0 ? P.w0 : q == 1 ? P.a0 : q == 2 ? P.kk : q == 3 ? P.ka : P.rk; ((LAS float*)(L + RW_PAR))[tid] = src[h * 64 + c]; }
}
__device__ __forceinline__ void rwkv_prep_load(const bf16* Z, int b, int h, int ch, int w, int lane, u32x4 (&cur)[2], u32x4 (&prv)[2]) {
    const int kind = w & 3, p = (w >> 2) * 64 + lane, tt = p >> 3, j = p & 7;
    const int col = (kind < 3 ? ZC + kind * 256 + h * 64 : ZC + 832) + 8 * j;
    const int t = ch * 16 + tt; const bf16* zr = Z + ((size_t)b * SEQ + t) * INW + col;
    cur[0] = *(const u32x4*)zr; prv[0] = (t > 0) ? *(const u32x4*)(zr - INW) : (u32x4){0u, 0u, 0u, 0u};
    if (w < 2) { const int t2 = ch * 16 + (lane >> 2); const bf16* z2 = Z + ((size_t)b * SEQ + t2) * INW + ZC + 768 + w * 32 + 8 * (lane & 3);
        cur[1] = *(const u32x4*)z2; prv[1] = (t2 > 0) ? *(const u32x4*)(z2 - INW) : (u32x4){0u, 0u, 0u, 0u}; }
    else { cur[1] = (u32x4){0u, 0u, 0u, 0u}; prv[1] = cur[1]; }
}
__device__ __forceinline__ void rwkv_prep_item(Frame& F, unsigned char* rec, const RwkvP P, int h, const u32x4 (&cur)[2], const u32x4 (&prv)[2]) {
    const int tid = mytid(F), lane = tid & 63, w = __builtin_amdgcn_readfirstlane(tid >> 6), fr = lane & 15, g = lane >> 4;
    LAS unsigned char* L = F.lds;
#if defined(PROBE_PI)
    unsigned long long tl_ = __builtin_amdgcn_s_memrealtime(), ta_ = 0;
#define PIT(k) do { const unsigned long long tn_ = __builtin_amdgcn_s_memrealtime(); if ((k) == PROBE_PI) ta_ += tn_ - tl_; tl_ = tn_; } while (0)
#else
#define PIT(k) do { } while (0)
#endif
    LAS float *R = (LAS float*)(L + RW_R), *KR = (LAS float*)(L + RW_K), *V = (LAS float*)(L + RW_V), *WL = (LAS float*)(L + RW_WL), *AL = (LAS float*)(L + RW_AL), *G = (LAS float*)(L + RW_G),
              *KK = (LAS float*)(L + RW_KK), *KP = (LAS float*)(L + RW_KP), *BON = (LAS float*)(L + RW_BON), *GC = (LAS float*)(L + RW_GC), *AAB = (LAS float*)(L + RW_AAB), *MU = (LAS float*)(L + RW_MU);
    { const int kind = w & 3, p = (w >> 2) * 64 + lane, tt = p >> 3, j = p & 7; float fc[8], fp[8], x[8]; unpack8(cur[0], fc); unpack8(prv[0], fp);
        const LAS float* mu = MU + (kind < 3 ? kind * 256 + h * 64 : 832) + 8 * j;
#pragma unroll
        for (int e = 0; e < 8; ++e) x[e] = fc[e] + (fp[e] - fc[e]) * mu[e];
        if (kind < 3) { LAS f32x4* d = (LAS f32x4*)((kind == 0 ? R : kind == 1 ? KR : V) + tt * 64 + 8 * j); d[0] = (f32x4){x[0], x[1], x[2], x[3]}; d[1] = (f32x4){x[4], x[5], x[6], x[7]}; }
        else {
#pragma unroll
            for (int e = 0; e < 8; ++e) x[e] = __builtin_amdgcn_rcpf(1.0f + __expf(-x[e]));
            u32x4 o; o.x = pk2(x[0], x[1]); o.y = pk2(x[2], x[3]); o.z = pk2(x[4], x[5]); o.w = pk2(x[6], x[7]); *(LAS u32x4*)(L + RW_SG + tt * 144 + 16 * j) = o; }
        if (w < 2) { const int t2 = lane >> 2, j2 = lane & 3; unpack8(cur[1], fc); unpack8(prv[1], fp); const LAS float* mu2 = MU + 768 + w * 32 + 8 * j2;
#pragma unroll
            for (int e = 0; e < 8; ++e) { x[e] = fc[e] + (fp[e] - fc[e]) * mu2[e]; if (w == 0) x[e] = 2.0f * __builtin_amdgcn_rcpf(1.0f + __expf(-2.0f * x[e])) - 1.0f; }
            u32x4 o; o.x = pk2(x[0], x[1]); o.y = pk2(x[2], x[3]); o.z = pk2(x[4], x[5]); o.w = pk2(x[6], x[7]); *(LAS u32x4*)(L + (w == 0 ? RW_TW : RW_AD) + t2 * 80 + 16 * j2) = o; } }
    BAR(); PIT(0);
    if (w < 4) { f32x4 dw = (f32x4){0.f, 0.f, 0.f, 0.f}, da = dw;
        dw = MFMA16(ldfrag(L + RW_W2T, 80, 16 * w, 0, fr, g), ldfrag(L + RW_TW, 80, 0, 0, fr, g), dw);
        da = MFMA16(ldfrag(L + RW_A2T, 80, 16 * w, 0, fr, g), ldfrag(L + RW_AD, 80, 0, 0, fr, g), da);
        *(LAS f32x4*)(WL + fr * 64 + 16 * w + 4 * g) = dw; *(LAS f32x4*)(AL + fr * 64 + 16 * w + 4 * g) = da; }
    else { const int cb = w - 4; f32x4 dg = (f32x4){0.f, 0.f, 0.f, 0.f};
        dg = MFMA16(ldfrag(L + RW_G2T, 144, 16 * cb, 0, fr, g), ldfrag(L + RW_SG, 144, 0, 0, fr, g), dg);
        dg = MFMA16(ldfrag(L + RW_G2T, 144, 16 * cb, 64, fr, g), ldfrag(L + RW_SG, 144, 0, 64, fr, g), dg);
        *(LAS f32x4*)(G + fr * 64 + 16 * cb + 4 * g) = dg; }
    BAR(); PIT(1);
    { const int t = tid >> 5, c2 = (tid & 31) * 2; const LAS float* PAR = (const LAS float*)(L + RW_PAR) + c2;
        const f32x2 wl = *(const LAS f32x2*)(WL + t * 64 + c2) + *(const LAS f32x2*)(PAR), al = *(const LAS f32x2*)(AL + t * 64 + c2) + *(const LAS f32x2*)(PAR + 64);
        const f32x2 kr = *(const LAS f32x2*)(KR + t * 64 + c2), rr = *(const LAS f32x2*)(R + t * 64 + c2);
        const f32x2 kkw = *(const LAS f32x2*)(PAR + 128), kaw = *(const LAS f32x2*)(PAR + 192), rkw = *(const LAS f32x2*)(PAR + 256);
        f32x2 lw, a, kk, kp; float ss = 0.f, bon = 0.f;
#pragma unroll
        for (int e = 0; e < 2; ++e) { const float wlog = -softplusf_(-wl[e]) - 0.5f; lw[e] = -__expf(wlog); a[e] = __builtin_amdgcn_rcpf(1.0f + __expf(-al[e])); kk[e] = kr[e] * kkw[e]; ss += kk[e] * kk[e];
            kp[e] = kr[e] * (1.0f + (a[e] - 1.0f) * kaw[e]); bon += rr[e] * kp[e] * rkw[e]; }
        ss = red16(ss); bon = red16(bon); ss += __shfl_xor(ss, 16); bon += __shfl_xor(bon, 16);
        const float inv = 1.0f / fmaxf(sqrtf(ss), 1e-12f); kk = kk * inv;
        *(LAS f32x2*)(WL + t * 64 + c2) = lw; *(LAS f32x2*)(AL + t * 64 + c2) = a; *(LAS f32x2*)(KK + t * 64 + c2) = kk; *(LAS f32x2*)(KP + t * 64 + c2) = kp;
        if ((tid & 31) == 0) BON[t] = bon; }
    BAR(); PIT(2);
    { const int t = tid >> 5, c2 = (tid & 31) * 2;
        f32x2 cs = (f32x2){0.f, 0.f}, ct = cs;
#pragma unroll
        for (int s = 0; s < 16; ++s) { cs += *(const LAS f32x2*)(WL + s * 64 + c2); if (s == t) ct = cs; }
        const f32x2 lwt = *(const LAS f32x2*)(WL + t * 64 + c2), a = *(const LAS f32x2*)(AL + t * 64 + c2), kk = *(const LAS f32x2*)(KK + t * 64 + c2), kp = *(const LAS f32x2*)(KP + t * 64 + c2), rr = *(const LAS f32x2*)(R + t * 64 + c2);
        float at[2], rt[2], bb[2], kb[2], bh[2], kh[2];
#pragma unroll
        for (int e = 0; e < 2; ++e) { const float eP = __expf(ct[e] - lwt[e]), eT = __expf(ct[e]), eI = __expf(-ct[e]), eC = __expf(cs[e] - ct[e]); const float bv = kk[e] * a[e];
            at[e] = -kk[e] * eP; rt[e] = rr[e] * eT; bb[e] = bv * eI; kb[e] = kp[e] * eI; bh[e] = bv * eC; kh[e] = kp[e] * eC; }
        *(LAS unsigned*)(L + RW_AR + t * 144 + c2 * 2) = pk2(at[0], at[1]); *(LAS unsigned*)(L + RW_AR + (16 + t) * 144 + c2 * 2) = pk2(rt[0], rt[1]);
        *(LAS unsigned*)(L + RW_BK + t * 144 + c2 * 2) = pk2(bb[0], bb[1]); *(LAS unsigned*)(L + RW_BK + (16 + t) * 144 + c2 * 2) = pk2(kb[0], kb[1]);
#pragma unroll
        for (int e = 0; e < 2; ++e) { *(LAS unsigned short*)(L + RW_BKT + (c2 + e) * 80 + t * 2) = (unsigned short)f2bf(bh[e]); *(LAS unsigned short*)(L + RW_BKT + (c2 + e) * 80 + (16 + t) * 2) = (unsigned short)f2bf(kh[e]); }
        if (t == 0) { GC[c2] = __expf(cs[0]); GC[c2 + 1] = __expf(cs[1]); } }
    BAR(); PIT(3);
    if (w < 4) { const int arow = (w & 1) ? 16 : 0  , brow = (w & 2) ? 16 : 0  ;
        f32x4 d = (f32x4){0.f, 0.f, 0.f, 0.f};
        d = MFMA16(ldfrag(L + RW_BK, 144, arow, 0, fr, g), ldfrag(L + RW_AR, 144, brow, 0, fr, g), d);
        d = MFMA16(ldfrag(L + RW_BK, 144, arow, 64, fr, g), ldfrag(L + RW_AR, 144, brow, 64, fr, g), d);
        const int t = fr; float v[4];
#pragma unroll
        for (int r = 0; r < 4; ++r) { const int s = 4 * g + r; const bool keep = (w < 2) ? (s < t) : (s <= t); v[r] = keep ? d[r] : 0.f; }
        if (w == 0) { AAB[(4 * g + 0) * 16 + t] = v[0]; AAB[(4 * g + 1) * 16 + t] = v[1]; AAB[(4 * g + 2) * 16 + t] = v[2]; AAB[(4 * g + 3) * 16 + t] = v[3]; }
        else { u32x2 o; o.x = pk2(v[0], v[1]); o.y = pk2(v[2], v[3]);
            LAS unsigned char* dst = (w == 1) ? (L + RW_ZAK + t * 80 + (16 + 4 * g) * 2) : (w == 2) ? (L + RW_RBK + t * 80 + (4 * g) * 2) : (L + RW_RBK + t * 80 + (16 + 4 * g) * 2);
            *(LAS u32x2*)dst = o; } }
    BAR(); PIT(4);
    if (w == 7) { if (lane < 16) { float col[16];
#pragma unroll
            for (int t = 0; t < 16; ++t) col[t] = (t == lane) ? 1.0f : 0.f;
#pragma unroll
            for (int s = 0; s < 15; ++s) { const f32x4 a0 = *(const LAS f32x4*)(AAB + s * 16), a1 = *(const LAS f32x4*)(AAB + s * 16 + 4), a2 = *(const LAS f32x4*)(AAB + s * 16 + 8), a3 = *(const LAS f32x4*)(AAB + s * 16 + 12);
                const float as[16] = {a0[0], a0[1], a0[2], a0[3], a1[0], a1[1], a1[2], a1[3], a2[0], a2[1], a2[2], a2[3], a3[0], a3[1], a3[2], a3[3]};
#pragma unroll
                for (int t = s + 1; t < 16; ++t) col[t] += as[t] * col[s]; }
#pragma unroll
            for (int t = 0; t < 16; ++t) *(LAS unsigned short*)(L + RW_TT + t * 80 + lane * 2) = (unsigned short)f2bf(col[t]); }
        LDS_WAIT();
        { const u32x2 lo = *(const LAS u32x2*)(L + RW_TT + fr * 80 + 8 * g), hi = *(const LAS u32x2*)(L + RW_ZAK + fr * 80 + 32 + 8 * g); u32x4 o; o.x = lo.x; o.y = lo.y; o.z = hi.x; o.w = hi.y;
            *(u32x4*)(rec + RC_ZT + fr * 64 + 16 * g) = o; } }
    else {
#pragma unroll 1
        for (int job = w; job < 16; job += 7) {
            if (job < 9) { int src, stride, row0, ka, kb2, dst;
                if (job < 4) { src = RW_AR; stride = 144; row0 = (job >> 1) * 16; ka = 32 * (job & 1); kb2 = ka + 16; dst = (job >> 1 ? RC_RT : RC_AT) + (job & 1) * 1024; }
                else if (job == 4) { src = RW_RBK; stride = 80; row0 = 0; ka = 0; kb2 = 16; dst = RC_RBK; }
                else { src = RW_BKT; stride = 80; row0 = 16 * (job - 5); ka = 0; kb2 = 16; dst = RC_BKT + (job - 5) * 1024; }
                const LAS unsigned char* rp = L + src + (row0 + fr) * stride + 8 * g; const u32x2 lo = *(const LAS u32x2*)(rp + ka * 2), hi = *(const LAS u32x2*)(rp + kb2 * 2);
                u32x4 o; o.x = lo.x; o.y = lo.y; o.z = hi.x; o.w = hi.y; *(u32x4*)(rec + dst + fr * 64 + 16 * g) = o; }
            else if (job < 13) { const int vb = job - 9; const LAS float* vp = V + (4 * g) * 64 + 16 * vb + fr; u32x2 o; o.x = pk2(vp[0], vp[64]); o.y = pk2(vp[128], vp[192]); *(u32x2*)(rec + RC_VT4 + vb * 512 + lane * 8) = o; }
            else { const int p = (job - 13) * 64 + lane;
                if (p < 16) *(f32x4*)(rec + RC_GC + 16 * p) = *(const LAS f32x4*)(GC + 4 * p);
                else if (p < 144) { const int q = p - 16; const f32x4 a = *(const LAS f32x4*)(G + q * 8), c = *(const LAS f32x4*)(G + q * 8 + 4); u32x4 o; o.x = pk2(a[0], a[1]); o.y = pk2(a[2], a[3]); o.z = pk2(c[0], c[1]); o.w = pk2(c[2], c[3]); *(u32x4*)(rec + RC_G + 16 * q) = o; }
                else if (p < 148) { const int q = p - 144; *(f32x4*)(rec + RC_BON + 16 * q) = *(const LAS f32x4*)(BON + 4 * q); } } } }
    BAR(); PIT(5);
#if defined(PROBE_PI)
    if (blockIdx.x == 0 && threadIdx.x == 0) ((unsigned long long*)(F.ws + 32768))[0] += ta_;
#endif
}

constexpr int SB_STRIDE = 16384, SB_NBUF = 7, SB_AHEAD = 5, ST_OB = SB_NBUF * SB_STRIDE  , ST_END = ST_OB + 8192;
static_assert(ST_END <= RING_BYTES && RC_BYTES <= SB_STRIDE, "state pass LDS");
__device__ __forceinline__ void rwkv_state(Frame& F, const unsigned char* recs, bf16* Y, const RwkvP P, int b, int h) {
    const int tid = mytid(F), lane = tid & 63, w = __builtin_amdgcn_readfirstlane(tid >> 6), fr = lane & 15, g = lane >> 4;
    LAS unsigned char* L = F.lds;
    const unsigned char* rbase = recs + (size_t)(b * 4 + h) * (SEQ / 16) * RC_STRIDE;
    const int lt = tid - 256;
    const f32x4 plg = *(const f32x4*)(P.lg + h * 64 + (tid & 15) * 4), plb = *(const f32x4*)(P.lb + h * 64 + (tid & 15) * 4);
    asm volatile("s_waitcnt vmcnt(0)" ::: "memory");
    f32x4 accS[4];
#pragma unroll
    for (int i = 0; i < 4; ++i) accS[i] = (f32x4){0.f, 0.f, 0.f, 0.f};
    constexpr int NCH = SEQ / 16;
#define RW_ISSUE(r) do { const unsigned char* gp_ = rbase + (size_t)(r) * RC_STRIDE + (w * 256 + lane) * 16; LAS unsigned char* lp_ = L + ((r) % SB_NBUF) * SB_STRIDE + w * 4096; \
        _Pragma("unroll") for (int i_ = 0; i_ < 4; ++i_) __builtin_amdgcn_global_load_lds((const unsigned*)(gp_ + i_ * 1024), (LAS unsigned*)(lp_ + i_ * 1024), 16, 0, 0); } while (0)
    if (w < 4) {
#pragma unroll 1
        for (int r = 0; r < SB_AHEAD; ++r) RW_ISSUE(r);
        asm volatile("s_waitcnt vmcnt(16)" ::: "memory"); }
    BAR();
#pragma unroll 1
    for (int c = 0; c <= NCH; ++c) {
        if (w >= 4) {
            if (c >= 1) { const int ce = c - 1; const LAS unsigned char* B = L + (ce % SB_NBUF) * SB_STRIDE; const LAS float* OB = (const LAS float*)(L + ST_OB + (ce & 1) * 4096);
                const int tt = lt >> 4, c4 = (lt & 15) * 4; const f32x4 o = *(const LAS f32x4*)(OB + tt * 64 + c4);
                float s = (o[0] + o[1]) + (o[2] + o[3]); s = red16(s); const float mean = s * (1.0f / 64.0f); const f32x4 d = o - mean;
                float ss = (d[0] * d[0] + d[1] * d[1]) + (d[2] * d[2] + d[3] * d[3]); ss = red16(ss); const float rstd = __builtin_amdgcn_rsqf(ss * (1.0f / 64.0f) + 64e-5f);
                const u32x2 gw = *(const LAS u32x2*)(B + RC_G + tt * 128 + c4 * 2); const float bon = ((const LAS float*)(B + RC_BON))[tt];
                const LAS unsigned short* vq = (const LAS unsigned short*)(B + RC_VT4 + (c4 >> 4) * 512 + ((tt >> 2) * 16 + (c4 & 15)) * 8 + (tt & 3) * 2);
                const float vv[4] = {bf1(vq[0]), bf1(vq[4]), bf1(vq[8]), bf1(vq[12])}, gg[4] = {bflo(gw.x), bfhi(gw.x), bflo(gw.y), bfhi(gw.y)}; float y[4];
#pragma unroll
                for (int e = 0; e < 4; ++e) y[e] = (d[e] * rstd * plg[e] + plb[e] + bon * vv[e]) * gg[e];
                u32x2 wv; wv.x = pk2(y[0], y[1]); wv.y = pk2(y[2], y[3]); *(u32x2*)(Y + ((size_t)b * SEQ + ce * 16 + tt) * DM + 512 + h * 64 + c4) = wv; }
        } else {
            if (c + SB_AHEAD < NCH) RW_ISSUE(c + SB_AHEAD);
            if (c < NCH) { const int vb = w; const LAS unsigned char* B = L + (c % SB_NBUF) * SB_STRIDE; LAS float* OB = (LAS float*)(L + ST_OB + (c & 1) * 4096); const int fo = fr * 64 + 16 * g;
                const bf16x8 at0 = *(const LAS bf16x8*)(B + RC_AT + fo), at1 = *(const LAS bf16x8*)(B + RC_AT + 1024 + fo), rt0 = *(const LAS bf16x8*)(B + RC_RT + fo), rt1 = *(const LAS bf16x8*)(B + RC_RT + 1024 + fo);
                const bf16x8 zt = *(const LAS bf16x8*)(B + RC_ZT + fo), rbk = *(const LAS bf16x8*)(B + RC_RBK + fo); const u32x2 v4 = *(const LAS u32x2*)(B + RC_VT4 + vb * 512 + lane * 8);
                u32x4 sw0, sw1; sw0.x = pk2(accS[0][0], accS[0][1]); sw0.y = pk2(accS[0][2], accS[0][3]); sw0.z = pk2(accS[1][0], accS[1][1]); sw0.w = pk2(accS[1][2], accS[1][3]);
                sw1.x = pk2(accS[2][0], accS[2][1]); sw1.y = pk2(accS[2][2], accS[2][3]); sw1.z = pk2(accS[3][0], accS[3][1]); sw1.w = pk2(accS[3][2], accS[3][3]);
                const bf16x8 s0 = __builtin_bit_cast(bf16x8, sw0), s1 = __builtin_bit_cast(bf16x8, sw1);
                f32x4 y = (f32x4){0.f, 0.f, 0.f, 0.f}, accO = y;
                y = MFMA16(at0, s0, y); y = MFMA16(at1, s1, y); accO = MFMA16(rt0, s0, accO); accO = MFMA16(rt1, s1, accO);
                u32x4 bw; bw.x = 0u; bw.y = 0u; bw.z = v4.x; bw.w = v4.y; y = MFMA16(zt, __builtin_bit_cast(bf16x8, bw), y);
                bw.x = pk2(y[0], y[1]); bw.y = pk2(y[2], y[3]); bw.z = 0u; bw.w = 0u; f32x4 u = (f32x4){0.f, 0.f, 0.f, 0.f}; u = MFMA16(zt, __builtin_bit_cast(bf16x8, bw), u);
                bw.x = pk2(u[0], u[1]); bw.y = pk2(u[2], u[3]); bw.z = v4.x; bw.w = v4.y; const bf16x8 uv = __builtin_bit_cast(bf16x8, bw);
                accO = MFMA16(rbk, uv, accO);
#pragma unroll
                for (int r = 0; r < 4; ++r) OB[(4 * g + r) * 64 + 16 * vb + fr] = accO[r];
#pragma unroll
                for (int kb = 0; kb < 4; ++kb) { const f32x4 gc = *(const LAS f32x4*)(B + RC_GC + (16 * kb + 4 * g) * 4); accS[kb] = accS[kb] * gc; accS[kb] = MFMA16(*(const LAS bf16x8*)(B + RC_BKT + kb * 1024 + fo), uv, accS[kb]); } }
            if (c + SB_AHEAD < NCH) asm volatile("s_waitcnt vmcnt(16)" ::: "memory"); else asm volatile("s_waitcnt vmcnt(0)" ::: "memory");
        }
        BAR();
    }
#undef RW_ISSUE
}

__device__ __forceinline__ void moe_route(Frame& F, const float* hres, const float* gffn, const float* router) {
    const int tid = mytid(F), lane = tid & 63, wave = __builtin_amdgcn_readfirstlane(tid >> 6); (void)lane; (void)wave;
    unsigned char* rt = F.ws + WS_RT;
    int* tope = (int*)(rt + RT_TOPE); float* gate = (float*)(rt + RT_GATE); int* rank = (int*)(rt + RT_RANK); float* rstd = (float*)(rt + RT_RSTD); int* hist = (int*)(rt + RT_HIST); int* rowtok = (int*)(rt + RT_ROWTOK);
    LAS float* RW = (LAS float*)F.lds;
    LAS int* LH = (LAS int*)(F.lds + 32768);
    for (int i = tid; i < 8192; i += NTHREADS) RW[i] = router[i];
    if (tid < 16) LH[tid] = 0;
    for (int i = F.blk * NTHREADS + tid; i < 2 * MOE_ROWS; i += F.G * NTHREADS) rowtok[i] = -1;
    __syncthreads();
    const int tpb = NTOK / F.G;
    for (int i = wave; i < tpb; i += NWAVES) { const int t = F.blk * tpb + i;
        const f32x4* hr = (const f32x4*)(hres + (size_t)t * DM) + lane; f32x4 v[4]; float ss = 0.f;
#pragma unroll
        for (int j = 0; j < 4; ++j) { v[j] = hr[64 * j]; ss += (v[j][0] * v[j][0] + v[j][1] * v[j][1]) + (v[j][2] * v[j][2] + v[j][3] * v[j][3]); }
        ss = wave_sum(ss); const float rs = __builtin_amdgcn_rsqf(ss * (1.0f / DM) + NORM_EPS);
        float lg[8];
#pragma unroll
        for (int e = 0; e < 8; ++e) lg[e] = 0.f;
#pragma unroll
        for (int j = 0; j < 4; ++j) { const f32x4 gv = *((const f32x4*)gffn + 64 * j + lane);
#pragma unroll
            for (int c = 0; c < 4; ++c) { const int k = 256 * j + 4 * lane + c; const float xn = v[j][c] * rs * gv[c]; const f32x4 r0 = *(const LAS f32x4*)(RW + k * 8), r1 = *(const LAS f32x4*)(RW + k * 8 + 4);
                lg[0] += xn * r0[0]; lg[1] += xn * r0[1]; lg[2] += xn * r0[2]; lg[3] += xn * r0[3]; lg[4] += xn * r1[0]; lg[5] += xn * r1[1]; lg[6] += xn * r1[2]; lg[7] += xn * r1[3]; } }
#pragma unroll
        for (int e = 0; e < 8; ++e) lg[e] = wave_sum(lg[e]);
        int i1 = 0; float m1 = lg[0];
#pragma unroll
        for (int e = 1; e < 8; ++e) if (lg[e] > m1) { m1 = lg[e]; i1 = e; }
        int i2 = -1; float m2 = -3.0e38f;
#pragma unroll
        for (int e = 0; e < 8; ++e) if (e != i1 && lg[e] > m2) { m2 = lg[e]; i2 = e; }
        if (lane == 0) { const float g1 = 1.0f / (1.0f + __expf(m2 - m1));
            const int r1 = atomicAdd((int*)&LH[i1], 1), r2 = atomicAdd((int*)&LH[8 + i2], 1);
            tope[2 * t] = i1; tope[2 * t + 1] = i2; gate[2 * t] = g1; gate[2 * t + 1] = 1.0f - g1; rank[2 * t] = r1; rank[2 * t + 1] = r2; rstd[t] = rs; }
    }
    __syncthreads();
    if (tid < 16) hist[F.blk * 16 + tid] = LH[tid];
}
__device__ __forceinline__ void moe_gather(Frame& F, int slot, const bf16* hb, bf16* asort) {
    const int tid = mytid(F), lane = tid & 63, wave = __builtin_amdgcn_readfirstlane(tid >> 6); (void)lane; (void)wave;
    unsigned char* rt = F.ws + WS_RT;
    const int* tope = (const int*)(rt + RT_TOPE); const float* gate = (const float*)(rt + RT_GATE); const int* rank = (const int*)(rt + RT_RANK); const float* rstd = (const float*)(rt + RT_RSTD); const int* hist = (const int*)(rt + RT_HIST);
    int* rowtok = (int*)(rt + RT_ROWTOK) + slot * MOE_ROWS; float* rowgate = (float*)(rt + RT_ROWGATE) + slot * MOE_ROWS; float* rowrstd = (float*)(rt + RT_ROWRSTD) + slot * MOE_ROWS;
    int* tilee = (int*)(rt + RT_TILEE) + slot * 256; int* ntiles = (int*)(rt + RT_NTILES);
    LAS int* BASE = (LAS int*)(F.lds + 40960);
    LAS int* TOT = BASE + 8;
    __syncthreads();
    LAS int* HL = (LAS int*)(F.lds + 49152);
    for (int i = tid; i < F.G * 8; i += NTHREADS) HL[i] = hist[(i >> 3) * 16 + slot * 8 + (i & 7)];
    __syncthreads();
    { const int e = tid & 7, part = tid >> 3;
        const int per = (F.G + 63) / 64; int sb = 0, st = 0;
        for (int j = 0; j < per; ++j) { const int bb = part * per + j; if (bb < F.G) { const int c = HL[bb * 8 + e]; st += c; if (bb < F.blk) sb += c; } }
        LAS int* PB = (LAS int*)(F.lds + 49152 + 16384); PB[tid] = sb; PB[512 + tid] = st; }
    __syncthreads();
    if (tid < 8) { const LAS int* PB = (const LAS int*)(F.lds + 49152 + 16384); int before = 0, tot = 0;
        for (int p = 0; p < 64; ++p) { before += PB[p * 8 + tid]; tot += PB[512 + p * 8 + tid]; }
        BASE[tid] = before; TOT[tid] = tot; }
    __syncthreads();
    if (tid == 0) { int ps = 0, nt = 0;
        for (int e = 0; e < 8; ++e) { const int tl = (TOT[e] + 255) >> 8; BASE[e] += ps; if (F.blk == 0) for (int i = 0; i < tl; ++i) tilee[nt + i] = e; ps += tl * 256; nt += tl; }
        if (F.blk == 0) ntiles[slot] = nt; }
    __syncthreads();
    const int tpb = NTOK / F.G;
    for (int i = wave; i < tpb; i += NWAVES) { const int t = F.blk * tpb + i; const int e = tope[2 * t + slot]; const int dest = BASE[e] + rank[2 * t + slot];
        if (lane == 0) { rowtok[dest] = t; rowgate[dest] = gate[2 * t + slot]; rowrstd[dest] = rstd[t]; }
        (void)hb; (void)asort; }
}


__device__ __forceinline__ void mk_publish(unsigned* ctr) {
    asm volatile("s_waitcnt vmcnt(0)" ::: "memory");
    __syncthreads();
    if (threadIdx.x == 0) { __builtin_amdgcn_fence(__ATOMIC_RELEASE, "agent"); asm volatile("s_waitcnt vmcnt(0)" ::: "memory"); (void)__hip_atomic_fetch_add(ctr, 1u, __ATOMIC_RELAXED, __HIP_MEMORY_SCOPE_AGENT); }
}
__device__ __forceinline__ void mk_wait(unsigned* ctr, unsigned need) {
    if (threadIdx.x == 0) { unsigned sp = 0;
        while (__hip_atomic_load(ctr, __ATOMIC_RELAXED, __HIP_MEMORY_SCOPE_AGENT) < need) { __builtin_amdgcn_s_sleep(4); if (++sp > (1u << 24)) break; }
        __builtin_amdgcn_fence(__ATOMIC_ACQUIRE, "agent"); asm volatile("s_waitcnt vmcnt(0)" ::: "memory"); }
    __syncthreads();
}

#ifndef MK_PER_PHASE
#define MK_PER_PHASE 0
#endif
constexpr int N_PHASES = 17;
__global__ void __launch_bounds__(NTHREADS, 2) mk_fwd(Params prm) {
    extern __shared__ __attribute__((aligned(16))) unsigned char lds_raw[];
    Frame F;
    F.lds = (LAS unsigned char*)lds_raw;
    F.blk = blockIdx.x; F.G = gridDim.x; F.out = prm.out; F.ws = prm.ws; F.wv = __builtin_amdgcn_readfirstlane(threadIdx.x >> 6);
    volatile LAS unsigned* MISC = (volatile LAS unsigned*)(F.lds + MISC_OFF);
    for (int u = threadIdx.x; u < (LDS_BYTES - LDSCTL_OFF) / 4; u += NTHREADS) ((LAS unsigned*)(F.lds + LDSCTL_OFF))[u] = 0u;
    __syncthreads();
    if (threadIdx.x == 0) { LAS unsigned long long* tab = (LAS unsigned long long*)(F.lds + PTAB_OFF);
#pragma unroll
        for (int i_ = 0; i_ < 33; ++i_) tab[i_] = (unsigned long long)prm.in[i_]; }
    __syncthreads();
    const int lo = prm.ph_lo, hi = prm.ph_hi;
    unsigned* ctl = (unsigned*)(F.ws + WS_CTL);
    XcdBarrier bar; bar.bar = ctl + CW_BAR; bar.x = 0; bar.st = nullptr;
    if (hi - lo > 1) bar = xcd_barrier_post(ctl + CW_BAR, MISC + 8);
    unsigned char* ws = F.ws;
    bf16* hb = (bf16*)(ws + WS_HB); bf16* z = (bf16*)(ws + WS_Z); bf16* act = (bf16*)(ws + WS_Z); bf16* y = (bf16*)(ws + WS_Y); bf16* asort = (bf16*)(ws + WS_Y);
    float* ssq = (float*)(ws + WS_SSQ);
    bf16* opart = (bf16*)F.out; float* lse = (float*)((unsigned char*)F.out + 48 * MiB);
    unsigned char* rt = ws + WS_RT;
#define IN(k) (lo <= (k) && (k) < hi)
#ifndef PROBE_MASK
#define PROBE_MASK 0
#endif
#if PROBE_MASK
#define STAMP(k) do { if (blockIdx.x == 0 && threadIdx.x == 0) ((volatile LAS unsigned long long*)(F.lds + LDSCTL_OFF + 2048))[k] = __builtin_amdgcn_s_memrealtime(); } while (0)
#else
#define STAMP(k) do { } while (0)
#endif
#define SEAM(k) do { if (IN(k) && IN((k) + 1)) xcd_barrier(bar); STAMP((k) + 1); } while (0)

    STAMP(0);
    if (IN(0)) p0_prologue(F, 0);
    SEAM(0);
#pragma unroll 1
    for (int layer = 0; layer < 2; ++layer) {
        const int pb = layer == 0 ? 1 : 7;
        if (IN(pb)) {
            pg8::Gemm g{hb, (const bf16*)(ws + WS_WIN) + (size_t)layer * NPADW * DM, NTOK, NPADW, DM, F.wv}; pg8::StaticOrder S; S.init(NTOK / 256, NPADW / 256, F.G, F.blk);
            pg8::EpiZ E{z, INW, INW, ssq};
            pg8::gemm_phase<pg8::EpiZ, pg8::StaticOrder, true, true>(F.lds, g, S, E);
        }
        SEAM(pb);
#if defined(PROBE_SUB)
        const unsigned long long tsub0 = __builtin_amdgcn_s_memrealtime();
#define PSUB(cls, t0) do { if (threadIdx.x == 0) ((unsigned long long*)(F.ws + 32768))[layer * 4 + (cls)] = __builtin_amdgcn_s_memrealtime() - (t0); } while (0)
#else
#define PSUB(cls, t0) do { } while (0)
#endif
        unsigned char* recs = ws + WS_MOEW;
        unsigned char* gcon = ws + WS_MOEW + (size_t)NB * 4 * (SEQ / 16) * RC_STRIDE;
        if (IN(pb + 1)) {
            const int wi = F.blk, nw = F.G;
            { const RwkvP RP{inptr(F, IN_MU) + layer * 896, inptr(F, IN_W0) + layer * 256, inptr(F, IN_W2) + layer * 32 * 256, inptr(F, IN_A0) + layer * 256, inptr(F, IN_A2) + layer * 32 * 256, inptr(F, IN_G2) + layer * 64 * 256,
                             inptr(F, IN_KK) + layer * 256, inptr(F, IN_KA) + layer * 256, inptr(F, IN_RK) + layer * 256, inptr(F, IN_RLG) + layer * 256, inptr(F, IN_RLB) + layer * 256};
                const int tid_ = mytid(F), lane_ = tid_ & 63, w_ = __builtin_amdgcn_readfirstlane(tid_ >> 6);
#pragma unroll 1
                for (int h = 0; h < 4; ++h) {
                    rwkv_prep_init(F, RP, h); BAR();
                    u32x4 cur[2], prv[2], ncur[2], nprv[2];
#pragma unroll
                    for (int q = 0; q < 2; ++q) { cur[q] = (u32x4){0u, 0u, 0u, 0u}; prv[q] = cur[q]; ncur[q] = cur[q]; nprv[q] = cur[q]; }
                    if (wi < 2048) rwkv_prep_load(z, wi >> 8, h, wi & 255, w_, lane_, cur, prv);
#pragma unroll 1
                    for (int it = wi; it < 2048; it += nw) { const int nx = it + nw;
                        if (nx < 2048) rwkv_prep_load(z, nx >> 8, h, nx & 255, w_, lane_, ncur, nprv);
                        rwkv_prep_item(F, recs + (size_t)(((it >> 8) * 4 + h) * 256 + (it & 255)) * RC_STRIDE, RP, h, cur, prv);
#pragma unroll
                        for (int q = 0; q < 2; ++q) { cur[q] = ncur[q]; prv[q] = nprv[q]; } }
                    BAR(); } }
            attn_qknorm(F, z, inptr(F, IN_QG) + layer * 64, inptr(F, IN_KG) + layer * 64);
            for (int item = wi; item < 512; item += nw) conv_item(F, z, y, inptr(F, IN_CW) + layer * 31 * 256, inptr(F, IN_CB) + layer * 256, inptr(F, IN_CLG) + layer * 256, inptr(F, IN_CLB) + layer * 256, item);
            gla_items<0>(F, z, gcon, (float*)(ws + WS_GLAEC), y, inptr(F, IN_GG2) + layer * 16 * 128, inptr(F, IN_GGB) + layer * 128, inptr(F, IN_GNG) + layer * 64, wi, nw, 0);
        }
        SEAM(pb + 1);
        if (IN(pb + 2)) {
            unsigned* cA = ctl + 12288 + layer * 128;
            unsigned* cB = ctl + 12288 + layer * 128 + 64;
            if (F.blk < 32) {
                const RwkvP RP{inptr(F, IN_MU) + layer * 896, inptr(F, IN_W0) + layer * 256, inptr(F, IN_W2) + layer * 32 * 256, inptr(F, IN_A0) + layer * 256, inptr(F, IN_A2) + layer * 32 * 256, inptr(F, IN_G2) + layer * 64 * 256,
                               inptr(F, IN_KK) + layer * 256, inptr(F, IN_KA) + layer * 256, inptr(F, IN_RK) + layer * 256, inptr(F, IN_RLG) + layer * 256, inptr(F, IN_RLB) + layer * 256};
                rwkv_state(F, recs, y, RP, F.blk >> 2, F.blk & 3);
            } else {
                const int wi = F.blk - 32, nw = F.G - 32;
                if (F.blk < 64) { gla_scan(F, gcon, (const float*)(ws + WS_GLAEC), (F.blk - 32) >> 2, (F.blk - 32) & 3); mk_publish(cA); }
                { const int full = 3072 / nw, rem = 3072 - full * nw;
                    for (int rd = 0; rd < full; ++rd) attn_tile(F.lds, z, opart, lse, inptr(F, IN_RELB), rd * nw + wi, mytid(F));
                    if (wi >= 32 && wi - 32 < rem) attn_tile(F.lds, z, opart, lse, inptr(F, IN_RELB), full * nw + wi - 32, mytid(F)); }
                mk_publish(cB);
                mk_wait(cA, 32u);
                gla_items<1>(F, z, gcon, (float*)(ws + WS_GLAEC), y, inptr(F, IN_GG2) + layer * 16 * 128, inptr(F, IN_GGB) + layer * 128, inptr(F, IN_GNG) + layer * 64, wi, nw, 32);
                mk_wait(cB, (unsigned)nw);
                attn_merge(F, opart, lse, y, wi, nw);
            }
        }
        SEAM(pb + 2);
        if (IN(pb + 3)) {
            pg8::Gemm g{y, (const bf16*)(ws + WS_WOUT) + (size_t)layer * DM * DM, NTOK, DM, DM, F.wv}; pg8::StaticOrder S; S.init(NTOK / 256, DM / 256, F.G, F.blk);
            pg8::EpiRes E{layer == 0 ? inptr(F, IN_X) : (const float*)nullptr, hb, layer == 0 ? (float*)nullptr : F.out, hb, ssq};
            pg8::gemm_phase<pg8::EpiRes, pg8::StaticOrder, true, true>(F.lds, g, S, E);
        }
        SEAM(pb + 3);
        if (layer == 0) {
            if (IN(5)) {
                pg8::Gemm g{hb, (const bf16*)(ws + WS_WGU), NTOK, 2 * DFF, DM, F.wv}; pg8::StaticOrder S; S.init(NTOK / 256, 2 * DFF / 256, F.G, F.blk);
                pg8::EpiSwiGLU<false> E{act, ssq, nullptr};
                pg8::gemm_phase<pg8::EpiSwiGLU<false>, pg8::StaticOrder, true, true>(F.lds, g, S, E);
            }
            SEAM(5);
            if (IN(6)) {
                pg8::Gemm g{act, (const bf16*)(ws + WS_WD), NTOK, DM, DFF, F.wv}; pg8::StaticOrder S; S.init(NTOK / 256, DM / 256, F.G, F.blk);
                pg8::EpiRes E{nullptr, hb, nullptr, hb, ssq};
                pg8::gemm_phase<pg8::EpiRes, pg8::StaticOrder, true, true>(F.lds, g, S, E);
            }
            SEAM(6);
        }
    }
    if (IN(11)) { moe_route(F, F.out, inptr(F, IN_FFNG) + DM, inptr(F, IN_ROUTER)); __syncthreads(); p0_prologue(F, 1); }
    SEAM(11);
    if (IN(12)) moe_gather(F, 0, hb, asort);
    SEAM(12);
#pragma unroll 1
    for (int slot = 0; slot < 2; ++slot) {
        const int pg = 13 + 2 * slot;
        const int* tilee = (const int*)(rt + RT_TILEE) + slot * 256;
        if (IN(pg)) {
            const int nt = __builtin_amdgcn_readfirstlane(((const int*)(rt + RT_NTILES))[slot]);
            pg8::Gemm g{hb, (const bf16*)(ws + WS_MOEW), nt * 256, 2 * DFF, DM, F.wv}; pg8::StaticOrder S; S.init(nt, 2 * DFF / 256, F.G, F.blk, tilee, MOEW_E_BYTES);
            pg8::EpiSwiGLU<true> E{act, nullptr, (const float*)(rt + RT_ROWRSTD) + slot * MOE_ROWS};
            pg8::gemm_phase_g<pg8::EpiSwiGLU<true>, pg8::StaticOrder, true, true>(F.lds, g, S, E, (const int*)(rt + RT_ROWTOK) + slot * MOE_ROWS);
        }
        SEAM(pg);
        if (IN(pg + 1)) {
            const int nt = __builtin_amdgcn_readfirstlane(((const int*)(rt + RT_NTILES))[slot]);
            pg8::Gemm g{act, (const bf16*)(ws + WS_MOEW + MOEW_GU_BYTES), nt * 256, DM, DFF, F.wv}; pg8::StaticOrder S; S.init(nt, DM / 256, F.G, F.blk, tilee, MOEW_E_BYTES);
            pg8::EpiMoeDown E{F.out, (const int*)(rt + RT_ROWTOK) + slot * MOE_ROWS, (const float*)(rt + RT_ROWGATE) + slot * MOE_ROWS};
            pg8::gemm_phase<pg8::EpiMoeDown, pg8::StaticOrder, true, true>(F.lds, g, S, E);
            if (slot == 0) moe_gather(F, 1, hb, asort);
        }
        if (slot == 0) SEAM(pg + 1);
    }
#if PROBE_MASK
    __syncthreads();
    if (blockIdx.x == 0 && threadIdx.x == 0) { STAMP(N_PHASES); volatile LAS unsigned long long* ts = (volatile LAS unsigned long long*)(F.lds + LDSCTL_OFF + 2048); unsigned long long tot = 0;
        for (int k = 0; k < N_PHASES; ++k) if ((PROBE_MASK >> k) & 1) tot += ts[k + 1] - ts[k];
#if defined(PROBE_SUB)
        tot = (PROBE_SUB == 0) ? ((volatile unsigned long long*)(F.ws + 32768))[0] : ((volatile unsigned long long*)(F.ws + 32768))[PROBE_SUB] + ((volatile unsigned long long*)(F.ws + 32768))[4 + PROBE_SUB];
#endif
        const unsigned long long t0 = __builtin_amdgcn_s_memrealtime(); while (__builtin_amdgcn_s_memrealtime() - t0 < tot) __builtin_amdgcn_s_sleep(8); }
#endif
#undef IN
#undef SEAM
}

extern "C" void kernel_launch(void* const* d_in, const int* in_sizes, int n_in, void* d_out, int out_size, void* d_ws, size_t ws_size, hipStream_t stream) {
    static int grid = 0;
    if (grid == 0) {
        if (n_in != 33 || out_size != NTOK * DM || ws_size < WS_TOTAL) { fprintf(stderr, "kernel_launch: unexpected problem (n_in %d out %d ws %zu)\n", n_in, out_size, ws_size); grid = -1; return; }
        int dev = 0, cus = 0;
        if (hipGetDevice(&dev) != hipSuccess || hipDeviceGetAttribute(&cus, hipDeviceAttributeMultiprocessorCount, dev) != hipSuccess) { grid = -1; return; }
        if (hipFuncSetAttribute((const void*)mk_fwd, hipFuncAttributeMaxDynamicSharedMemorySize, LDS_BYTES) != hipSuccess) { fprintf(stderr, "kernel_launch: hipFuncSetAttribute failed\n"); grid = -1; return; }
        (void)hipGetLastError();
        grid = cus < 256 ? cus : 256;
        if (grid != 256) fprintf(stderr, "kernel_launch: %d CUs (built for 256)\n", cus);
    }
    if (grid < 0) return;
    (void)hipMemsetAsync((char*)d_ws + WS_CTL, 0, CTL_ZERO_BYTES, stream);
    Params p{};
    for (int i = 0; i < 33; ++i) p.in[i] = (const float*)d_in[i];
    p.out = (float*)d_out; p.ws = (unsigned char*)d_ws;
#if MK_PER_PHASE
    for (int k = 0; k < N_PHASES; ++k) { p.ph_lo = k; p.ph_hi = k + 1; hipLaunchKernelGGL(mk_fwd, dim3(grid), dim3(NTHREADS), LDS_BYTES, stream, p); }
#else
    p.ph_lo = 0; p.ph_hi = N_PHASES;
    hipLaunchKernelGGL(mk_fwd, dim3(grid), dim3(NTHREADS), LDS_BYTES, stream, p);
#endif
}
```

```cpp
#include <hip/hip_runtime.h>
#include <cstdio>
#include <cstdint>

#define LAS __attribute__((address_space(3)))
#define GAS __attribute__((address_space(1)))
typedef unsigned short bf16;
typedef short bf16x8 __attribute__((ext_vector_type(8)));
typedef short s16x4 __attribute__((ext_vector_type(4)));
typedef float f32x4 __attribute__((ext_vector_type(4)));
typedef float f32x2 __attribute__((ext_vector_type(2)));
typedef unsigned u32x4 __attribute__((ext_vector_type(4)));
typedef unsigned u32x2 __attribute__((ext_vector_type(2)));

constexpr int DM = 1024, NB = 8, SEQ = 4096, NTOK = NB * SEQ, INW = 2960, NPADW = 3072, DFF = 2816, NEXP = 8;
constexpr int ZA = 0, ZB = 768, ZC = 1280, ZD = 2176;
constexpr float NORM_EPS = 1e-6f;
constexpr int MOE_ROWS = NTOK + NEXP * 256;

constexpr size_t MiB = 1u << 20;
constexpr size_t WS_CTL = 0, CTL_ZERO_BYTES = 64 * 1024;
constexpr size_t WS_WIN = 1 * MiB;
constexpr size_t WS_WOUT = 13 * MiB;
constexpr size_t WS_WGU = 17 * MiB;
constexpr size_t WS_WD = 28 * MiB;
constexpr size_t WS_SSQ = 34 * MiB;
constexpr size_t WS_RT = 36 * MiB;
constexpr size_t WS_HB = 40 * MiB;
constexpr size_t WS_Z = 104 * MiB;
constexpr size_t WS_Y = 297 * MiB;
constexpr size_t WS_MOEW = 367 * MiB;
constexpr size_t WS_END = 499 * MiB;
constexpr size_t WS_GLAEC = 499 * MiB;
constexpr size_t WS_GLAQT = 500 * MiB;
constexpr size_t WS_GLAKB = 289 * MiB;
constexpr size_t WS_TOTAL = 508 * MiB;
constexpr size_t MOEW_GU_BYTES = (size_t)2 * DFF * DM * 2, MOEW_D_BYTES = (size_t)DM * DFF * 2, MOEW_E_BYTES = MOEW_GU_BYTES + MOEW_D_BYTES;
static_assert(WS_Z + (size_t)MOE_ROWS * DFF * 2 <= WS_Y && WS_Y + (size_t)MOE_ROWS * DM * 2 <= WS_MOEW && WS_MOEW + NEXP * MOEW_E_BYTES <= WS_END, "ws map");
constexpr size_t WS_OP = WS_HB;
constexpr size_t WS_LSE = WS_HB + 48 * MiB;
constexpr size_t RT_TOPE = 0;
constexpr size_t RT_GATE = RT_TOPE + (size_t)NTOK * 8;
constexpr size_t RT_RANK = RT_GATE + (size_t)NTOK * 8;
constexpr size_t RT_RSTD = RT_RANK + (size_t)NTOK * 8;
constexpr size_t RT_HIST = RT_RSTD + (size_t)NTOK * 4;
constexpr size_t RT_ROWTOK = RT_HIST + 256 * 16 * 4;
constexpr size_t RT_ROWGATE = RT_ROWTOK + (size_t)2 * MOE_ROWS * 4;
constexpr size_t RT_ROWRSTD = RT_ROWGATE + (size_t)2 * MOE_ROWS * 4;
constexpr size_t RT_TILEE = RT_ROWRSTD + (size_t)2 * MOE_ROWS * 4;
constexpr size_t RT_NTILES = RT_TILEE + 2 * 256 * 4;
static_assert(RT_NTILES + 64 <= 4 * MiB, "routing arrays");

constexpr int CW_BAR = 1024;

constexpr int RING_BYTES = 131072, LDSCTL_OFF = RING_BYTES, MISC_OFF = LDSCTL_OFF + 320, LDS_BYTES = 147456;
constexpr int NWAVES = 8, NTHREADS = 512;

#define LDS_WAIT() asm volatile("s_waitcnt lgkmcnt(0)" ::: "memory")
#define VM_WAIT() asm volatile("s_waitcnt vmcnt(0)" ::: "memory")
#define BAR() do { asm volatile("s_waitcnt lgkmcnt(0)" ::: "memory"); __builtin_amdgcn_s_barrier(); asm volatile("" ::: "memory"); } while (0)
__device__ __forceinline__ unsigned f2bf(float f) { unsigned u = __builtin_bit_cast(unsigned, f); return (u + 0x7fffu + ((u >> 16) & 1u)) >> 16; }
typedef __bf16 bf16x2_hw __attribute__((ext_vector_type(2)));
__device__ __forceinline__ unsigned pk2(float lo, float hi) { const f32x2 v = {lo, hi}; const bf16x2_hw b = __builtin_convertvector(v, bf16x2_hw); return __builtin_bit_cast(unsigned, b); }
__device__ __forceinline__ float bflo(unsigned w) { return __builtin_bit_cast(float, w << 16); }
__device__ __forceinline__ float bfhi(unsigned w) { return __builtin_bit_cast(float, w & 0xffff0000u); }
__device__ __forceinline__ float bf1(bf16 b) { return __builtin_bit_cast(float, (unsigned)b << 16); }
__device__ __forceinline__ float wave_sum(float v) {
#pragma unroll
    for (int o = 1; o < 64; o <<= 1) v += __shfl_xor(v, o);
    return v;
}
#define DPP_ADD(v, ctrl) ((v) + __builtin_bit_cast(float, __builtin_amdgcn_update_dpp(0, __builtin_bit_cast(int, (v)), (ctrl), 0xf, 0xf, true)))
__device__ __forceinline__ float red8(float v) { v = DPP_ADD(v, 0xB1); v = DPP_ADD(v, 0x4E); v = DPP_ADD(v, 0x141); return v; }
__device__ __forceinline__ float red16(float v) { v = DPP_ADD(v, 0xB1); v = DPP_ADD(v, 0x4E); v = DPP_ADD(v, 0x141); v = DPP_ADD(v, 0x140); return v; }
__device__ __forceinline__ float sigmoidf_(float x) { return 1.0f / (1.0f + __expf(-x)); }
__device__ __forceinline__ float siluf_(float x) { return x / (1.0f + __expf(-x)); }
__device__ __forceinline__ float softplusf_(float x) { return fmaxf(x, 0.f) + __logf(1.0f + __expf(-fabsf(x))); }
__device__ __forceinline__ float tanhf_(float x) { const float e = __expf(2.0f * x); return 1.0f - 2.0f / (e + 1.0f); }
__device__ __forceinline__ void unpack8(const u32x4 w, float (&f)[8]) {
    f[0] = bflo(w.x); f[1] = bfhi(w.x); f[2] = bflo(w.y); f[3] = bfhi(w.y); f[4] = bflo(w.z); f[5] = bfhi(w.z); f[6] = bflo(w.w); f[7] = bfhi(w.w);
}

namespace pg8 {
#define PG8_LAS __attribute__((address_space(3)))
typedef unsigned short bf16_t;
constexpr int BM = 256, BK = 64, HALF = 128, HTB = HALF * BK * 2  , STAGE_BYTES = 8 * HTB, NXCD = 8, WGM = 8;

__host__ __device__ __forceinline__ int lds_byte(int r, int c) { const int st = (r >> 4) * 2 + (c >> 5), rr = r & 15, cc = c & 31, ob = rr * 64 + cc * 2; return st * 1024 + (ob ^ (((ob >> 9) & 1) << 5)); }
__host__ __device__ __forceinline__ void stage_rc(int b, int& R, int& C) { const int st = b / 1024, sb = b % 1024, swz = sb ^ (((sb >> 9) & 1) << 5); R = (st >> 1) * 16 + swz / 64; C = (st & 1) * 32 + (swz % 64) / 2; }
__host__ __device__ __forceinline__ int perm32(int rho) { const int n = rho >> 4, i = rho & 15; return 8 * (i >> 2) + 4 * n + (i & 3); }

struct Unit { int pm, pn; };
struct Gemm { const bf16_t* A; const bf16_t* Bt; int M, N, K, wv; };

struct StaticOrder {
    int nM, nN, nwg, G, c; const int* tile_e; size_t estride;
    __device__ void init(int nM_, int nN_, int G_, int c_, const int* te = nullptr, size_t es = 0) { nM = nM_; nN = nN_; nwg = nM * nN; G = G_; c = c_; tile_e = te; estride = es; }
    __device__ bool next(int i, Unit& u) const {
        const long L = (long)i * G + c; if (L >= nwg) return false;
        int wgid = (int)L; { const int q = nwg / NXCD, r = nwg % NXCD, xcd = wgid % NXCD, off = wgid / NXCD; wgid = (xcd < r ? xcd * (q + 1) : r * (q + 1) + (xcd - r) * q) + off; }
        const int nig = WGM * nN, gid = wgid / nig, fm = gid * WGM, gsz = (nM - fm) < WGM ? (nM - fm) : WGM;
        u.pm = fm + ((wgid % nig) % gsz); u.pn = (wgid % nig) / gsz; return true;
    }
    __device__ __forceinline__ size_t bofs(const Unit& u, size_t tstep) const { return (size_t)u.pn * tstep + (tile_e ? (size_t)__builtin_amdgcn_readfirstlane(tile_e[u.pm]) * estride : (size_t)0); }
    __device__ __forceinline__ void a_ready(const Unit&) const {}
    __device__ __forceinline__ void done(const Unit&) const {}
};

__device__ __forceinline__ unsigned cvt_pk_bf16(float lo, float hi) { unsigned r; asm volatile("v_cvt_pk_bf16_f32 %0, %1, %2" : "=v"(r) : "v"(lo), "v"(hi)); return r; }

__device__ __forceinline__ float row_rstd16(const float* ssq, int r, int fq) {
    const f32x4 p = *(const f32x4*)(ssq + (size_t)r * 16 + 4 * fq);
    float s = (p[0] + p[1]) + (p[2] + p[3]); s += __shfl_xor(s, 16); s += __shfl_xor(s, 32);
    return __builtin_amdgcn_rsqf(s * (1.0f / DM) + NORM_EPS);
}

struct EpiZ {
    static constexpr bool PERM = true, AFTER_DRAIN = false;
    bf16_t* Z; int ldc, ncols; const float* ssq;
    __device__ __forceinline__ void operator()(const f32x4 (&acc)[2][2][4][2], const Unit& u, int wr, int wc, int fr, int fq) const {
        const int row0 = u.pm * BM + wr * 64 + fr, col0 = u.pn * BM + wc * 32 + 8 * fq;
#pragma unroll
        for (int ai = 0; ai < 2; ++ai)
#pragma unroll
            for (int m = 0; m < 4; ++m) { const int r = row0 + ai * HALF + m * 16; const float rs = row_rstd16(ssq, r, fq); bf16_t* rowp = Z + (size_t)r * ldc + col0;
#pragma unroll
                for (int bj = 0; bj < 2; ++bj) { const f32x4 v0 = acc[ai][bj][m][0] * rs, v1 = acc[ai][bj][m][1] * rs;
                    u32x4 w; w.x = cvt_pk_bf16(v0[0], v0[1]); w.y = cvt_pk_bf16(v0[2], v0[3]); w.z = cvt_pk_bf16(v1[0], v1[1]); w.w = cvt_pk_bf16(v1[2], v1[3]);
                    if (col0 + bj * HALF < ncols) *(u32x4*)(rowp + bj * HALF) = w; } }
    }
};
template <bool MOE> struct EpiSwiGLU {
    static constexpr bool PERM = true, AFTER_DRAIN = false;
    bf16_t* O; const float* ssq; const float* row_rstd;
    __device__ __forceinline__ void operator()(const f32x4 (&acc)[2][2][4][2], const Unit& u, int wr, int wc, int fr, int fq) const {
        const int row0 = u.pm * BM + wr * 64 + fr, col0 = u.pn * HALF + wc * 32 + 8 * fq;
#pragma unroll
        for (int ai = 0; ai < 2; ++ai)
#pragma unroll
            for (int m = 0; m < 4; ++m) { const int r = row0 + ai * HALF + m * 16; float rs; if (MOE) rs = row_rstd[r]; else rs = row_rstd16(ssq, r, fq);
                const f32x4 g0 = acc[ai][0][m][0] * rs, g1 = acc[ai][0][m][1] * rs, u0 = acc[ai][1][m][0] * rs, u1 = acc[ai][1][m][1] * rs; f32x4 a0, a1;
#pragma unroll
                for (int j = 0; j < 4; ++j) { a0[j] = g0[j] * __builtin_amdgcn_rcpf(1.0f + __expf(-g0[j])) * u0[j]; a1[j] = g1[j] * __builtin_amdgcn_rcpf(1.0f + __expf(-g1[j])) * u1[j]; }
                u32x4 w; w.x = cvt_pk_bf16(a0[0], a0[1]); w.y = cvt_pk_bf16(a0[2], a0[3]); w.z = cvt_pk_bf16(a1[0], a1[1]); w.w = cvt_pk_bf16(a1[2], a1[3]);
                *(u32x4*)(O + (size_t)r * DFF + col0) = w; }
    }
};
struct EpiRes {
    static constexpr bool PERM = false, AFTER_DRAIN = false;
    const float* base; const bf16_t* baseb; float* out; bf16_t* hb; float* ssq;
    __device__ __forceinline__ void operator()(const f32x4 (&acc)[2][2][4][2], const Unit& u, int wr, int wc, int fr, int fq) const {
        const int col0 = u.pn * BM + wc * 32 + 4 * fq;
#pragma unroll
        for (int ai = 0; ai < 2; ++ai)
#pragma unroll
            for (int m = 0; m < 4; ++m) { const int r = u.pm * BM + ai * HALF + wr * 64 + m * 16 + fr; const size_t off = (size_t)r * DM + col0; float ss = 0.f;
#pragma unroll
                for (int bj = 0; bj < 2; ++bj)
#pragma unroll
                    for (int n = 0; n < 2; ++n) { f32x4 bv;
                        if (base) bv = *(const f32x4*)(base + off + bj * HALF + n * 16);
                        else { const u32x2 bw = *(const u32x2*)(baseb + off + bj * HALF + n * 16); bv = (f32x4){bflo(bw.x), bfhi(bw.x), bflo(bw.y), bfhi(bw.y)}; }
                        const f32x4 v = bv + acc[ai][bj][m][n];
                        if (out) *(f32x4*)(out + off + bj * HALF + n * 16) = v;
                        ss += (v[0] * v[0] + v[1] * v[1]) + (v[2] * v[2] + v[3] * v[3]);
                        { u32x2 w; w.x = cvt_pk_bf16(v[0], v[1]); w.y = cvt_pk_bf16(v[2], v[3]); *(u32x2*)(hb + off + bj * HALF + n * 16) = w; } }
                ss += __shfl_xor(ss, 16); ss += __shfl_xor(ss, 32);
                if (fq == 0) ssq[(size_t)r * 16 + u.pn * 4 + wc] = ss;
                if (m & 1) asm volatile("" ::: "memory"); }
    }
};
struct EpiMoeDown {
    static constexpr bool PERM = false, AFTER_DRAIN = false;
    float* out; const int* row_tok; const float* row_gate;
    __device__ __forceinline__ void operator()(const f32x4 (&acc)[2][2][4][2], const Unit& u, int wr, int wc, int fr, int fq) const {
        const int col0 = u.pn * BM + wc * 32 + 4 * fq;
#pragma unroll
        for (int ai = 0; ai < 2; ++ai)
#pragma unroll
            for (int m = 0; m < 4; ++m) { const int r = u.pm * BM + ai * HALF + wr * 64 + m * 16 + fr; const int tok = row_tok[r]; const float gt = row_gate[r];
                if (tok >= 0) { float* op = out + (size_t)tok * DM + col0;
#pragma unroll
                    for (int bj = 0; bj < 2; ++bj)
#pragma unroll
                        for (int n = 0; n < 2; ++n) { float* p = op + bj * HALF + n * 16; *(f32x4*)p = *(const f32x4*)p + acc[ai][bj][m][n] * gt; } }
                if (m & 1) asm volatile("" ::: "memory"); }
    }
};

template <class Epi, class Sched, bool ALIGN_EPI = false, bool SP2 = false>
__device__ __forceinline__ void gemm_phase(PG8_LAS unsigned char* lds, const Gemm g, const Sched& S, const Epi& E) {
    int lid_; asm volatile("v_mbcnt_lo_u32_b32 %0, -1, 0\n\tv_mbcnt_hi_u32_b32 %0, -1, %0" : "=v"(lid_)); int tid_ = g.wv * 64 + lid_; asm volatile("" : "+v"(tid_));
    const int tid = tid_, wid = __builtin_amdgcn_readfirstlane(tid >> 6), lane = tid & 63, wr = wid >> 2, wc = wid & 3, fr = lane & 15, fq = lane >> 4;
    const int K = g.K, nt = K / BK;
    unsigned voffA[2], voffB[2];
#pragma unroll
    for (int i = 0; i < 2; ++i) { int R, C; stage_rc(tid * 16 + i * 8192, R, C); const int Rb = Epi::PERM ? ((R & ~31) + perm32(R & 31)) : R;
        voffA[i] = (unsigned)(R * K + C) * 2u; voffB[i] = (unsigned)(Rb * K + C) * 2u; }
    const size_t kstep = (size_t)(BK * 2);
    const size_t hstep = (size_t)HALF * K * 2;
    const size_t tstep = 2 * hstep;
    const unsigned ldsw = (unsigned)wid * 1024u;
    const int aoff = lds_byte(wr * 64 + fr, fq * 8), boff = lds_byte(wc * 32 + fr, fq * 8);
#define PG8_SA(b, h) (((b) * 2 + (h)) * HTB)
#define PG8_SB(b, h) ((4 + (b) * 2 + (h)) * HTB)
#define PG8_STAGE(bufoff, gbase, voff) do { _Pragma("unroll") for (int _i = 0; _i < 2; ++_i) \
        __builtin_amdgcn_global_load_lds((const unsigned*)((const char*)(gbase) + (voff)[_i]), (PG8_LAS unsigned*)(lds + (bufoff) + ldsw + _i * 8192), 16, 0, 0); } while (0)
#define PG8_LDA(dst, b, h) do { _Pragma("unroll") for (int m = 0; m < 4; ++m) _Pragma("unroll") for (int k = 0; k < 2; ++k) dst[m][k] = *(const PG8_LAS bf16x8*)(lds + PG8_SA(b, h) + aoff + m * 2048 + k * 1024); } while (0)
#define PG8_LDB(dst, b, h) do { _Pragma("unroll") for (int n = 0; n < 2; ++n) _Pragma("unroll") for (int k = 0; k < 2; ++k) dst[n][k] = *(const PG8_LAS bf16x8*)(lds + PG8_SB(b, h) + boff + n * 2048 + k * 1024); } while (0)
#define PG8_MMA(ai, bj, At, Bt) do { __builtin_amdgcn_s_setprio(1); _Pragma("unroll") for (int m = 0; m < 4; ++m) _Pragma("unroll") for (int n = 0; n < 2; ++n) _Pragma("unroll") for (int k = 0; k < 2; ++k) \
        acc[ai][bj][m][n] = __builtin_amdgcn_mfma_f32_16x16x32_bf16(Bt[n][k], At[m][k], acc[ai][bj][m][n], 0, 0, 0); __builtin_amdgcn_s_setprio(0); } while (0)
#define PG8_WAIT_V(n) asm volatile("s_waitcnt vmcnt(" #n ")" ::: "memory")
#define PG8_WAIT_L(n) asm volatile("s_waitcnt lgkmcnt(" #n ")" ::: "memory")
#define PG8_BAR __builtin_amdgcn_s_barrier()
#define PG8_SCHED __builtin_amdgcn_sched_barrier(0)
    Unit cur, nxt; int ui = 0;
    if (!S.next(0, cur)) return;
    f32x4 acc[2][2][4][2];
#pragma unroll
    for (int a = 0; a < 2; ++a)
#pragma unroll
        for (int b = 0; b < 2; ++b)
#pragma unroll
            for (int m = 0; m < 4; ++m)
#pragma unroll
                for (int n = 0; n < 2; ++n) acc[a][b][m][n] = (f32x4){0.f, 0.f, 0.f, 0.f};
    bf16x8 At[4][2], B0[2][2], B1[2][2];
    const char* cA = (const char*)g.A + (size_t)cur.pm * tstep; const char* cB = (const char*)g.Bt + S.bofs(cur, tstep);
    S.a_ready(cur);
    if constexpr (SP2) {
        PG8_STAGE(PG8_SB(0, 0), cB, voffB); PG8_STAGE(PG8_SB(0, 1), cB + hstep, voffB); PG8_STAGE(PG8_SA(0, 0), cA, voffA); PG8_STAGE(PG8_SA(0, 1), cA + hstep, voffA);
        if (wr == 1) PG8_BAR;
        PG8_WAIT_V(2); PG8_BAR;
        PG8_STAGE(PG8_SB(1, 0), cB + kstep, voffB); PG8_STAGE(PG8_SA(1, 0), cA + kstep, voffA); PG8_STAGE(PG8_SB(1, 1), cB + hstep + kstep, voffB);
        PG8_WAIT_V(6); PG8_BAR;
    } else {
        PG8_STAGE(PG8_SB(0, 0), cB, voffB); PG8_STAGE(PG8_SA(0, 0), cA, voffA); PG8_STAGE(PG8_SB(0, 1), cB + hstep, voffB); PG8_STAGE(PG8_SA(0, 1), cA + hstep, voffA);
        if (wr == 1) PG8_BAR;
        PG8_WAIT_V(4); PG8_BAR;
        PG8_STAGE(PG8_SB(1, 0), cB + kstep, voffB); PG8_STAGE(PG8_SA(1, 0), cA + kstep, voffA); PG8_STAGE(PG8_SB(1, 1), cB + hstep + kstep, voffB);
        PG8_WAIT_V(6); PG8_BAR;
    }
    for (;;) {
        const bool has_next = S.next(ui + 1, nxt);
        const char* nA = has_next ? (const char*)g.A + (size_t)nxt.pm * tstep : cA; const char* nB = has_next ? (const char*)g.Bt + S.bofs(nxt, tstep) : cB;
        for (int t = 0; t < nt; t += 2) {
            const bool last = (t == nt - 2);
            const char* a1 = cA + (size_t)(t + 1) * kstep;
            const char* a2 = last ? nA : cA + (size_t)(t + 2) * kstep; const char* b2 = last ? nB : cB + (size_t)(t + 2) * kstep;
            const char* a3 = a2 + kstep; const char* b3 = b2 + kstep;
            if (last && has_next) S.a_ready(nxt);
            if constexpr (SP2) {
            PG8_LDB(B0, 0, 0); PG8_LDB(B1, 0, 1); PG8_SCHED; PG8_LDA(At, 0, 0); PG8_STAGE(PG8_SA(1, 1), a1 + hstep, voffA);
            PG8_WAIT_V(8); PG8_WAIT_L(0); PG8_BAR; PG8_MMA(0, 0, At, B0); PG8_MMA(0, 1, At, B1); PG8_BAR; PG8_SCHED;
            PG8_LDA(At, 0, 1); PG8_STAGE(PG8_SB(0, 0), b2, voffB); PG8_STAGE(PG8_SB(0, 1), b2 + hstep, voffB); PG8_STAGE(PG8_SA(0, 0), a2, voffA);
            PG8_WAIT_V(8); PG8_WAIT_L(0); PG8_BAR; PG8_MMA(1, 0, At, B0); PG8_MMA(1, 1, At, B1); PG8_BAR; PG8_SCHED;
            PG8_LDB(B0, 1, 0); PG8_LDB(B1, 1, 1); PG8_SCHED; PG8_LDA(At, 1, 0); PG8_STAGE(PG8_SA(0, 1), a2 + hstep, voffA);
            PG8_WAIT_V(8); PG8_WAIT_L(0); PG8_BAR; PG8_MMA(0, 0, At, B0); PG8_MMA(0, 1, At, B1); PG8_BAR; PG8_SCHED;
            PG8_LDA(At, 1, 1); PG8_STAGE(PG8_SB(1, 0), b3, voffB); PG8_STAGE(PG8_SB(1, 1), b3 + hstep, voffB); PG8_STAGE(PG8_SA(1, 0), a3, voffA);
            PG8_WAIT_V(8); PG8_WAIT_L(0); PG8_BAR; PG8_MMA(1, 0, At, B0); PG8_MMA(1, 1, At, B1); PG8_BAR; PG8_SCHED;
            } else {
            PG8_LDB(B0, 0, 0); PG8_SCHED; PG8_LDA(At, 0, 0); PG8_STAGE(PG8_SA(1, 1), a1 + hstep, voffA);
            PG8_WAIT_L(8); PG8_BAR; PG8_WAIT_L(0); PG8_MMA(0, 0, At, B0); PG8_BAR; PG8_SCHED;
            PG8_LDB(B1, 0, 1); PG8_STAGE(PG8_SB(0, 0), b2, voffB);
            PG8_BAR; PG8_WAIT_L(0); PG8_MMA(0, 1, At, B1); PG8_BAR;
            PG8_LDA(At, 0, 1); PG8_STAGE(PG8_SA(0, 0), a2, voffA);
            PG8_BAR; PG8_WAIT_L(0); PG8_MMA(1, 0, At, B0); PG8_BAR; PG8_SCHED;
            PG8_STAGE(PG8_SB(0, 1), b2 + hstep, voffB);
            PG8_WAIT_V(6); PG8_BAR; PG8_MMA(1, 1, At, B1); PG8_BAR;
            PG8_LDB(B0, 1, 0); PG8_SCHED; PG8_LDA(At, 1, 0); PG8_STAGE(PG8_SA(0, 1), a2 + hstep, voffA);
            PG8_WAIT_L(8); PG8_BAR; PG8_WAIT_L(0); PG8_MMA(0, 0, At, B0); PG8_BAR; PG8_SCHED;
            PG8_LDB(B1, 1, 1); PG8_STAGE(PG8_SB(1, 0), b3, voffB);
            PG8_BAR; PG8_WAIT_L(0); PG8_MMA(0, 1, At, B1); PG8_BAR;
            PG8_LDA(At, 1, 1); PG8_STAGE(PG8_SA(1, 0), a3, voffA);
            PG8_BAR; PG8_WAIT_L(0); PG8_MMA(1, 0, At, B0); PG8_BAR; PG8_SCHED;
            PG8_STAGE(PG8_SB(1, 1), b3 + hstep, voffB);
            PG8_WAIT_V(6); PG8_BAR; PG8_MMA(1, 1, At, B1); PG8_BAR;
            }
        }
        if constexpr (ALIGN_EPI) { if (wr == 0) PG8_BAR; }
        if constexpr (!Epi::AFTER_DRAIN) { E(acc, cur, wr, wc, fr, fq); S.done(cur); }
        if (!has_next) break;
#pragma unroll
        for (int a = 0; a < 2; ++a)
#pragma unroll
            for (int b = 0; b < 2; ++b)
#pragma unroll
                for (int m = 0; m < 4; ++m)
#pragma unroll
                    for (int n = 0; n < 2; ++n) acc[a][b][m][n] = (f32x4){0.f, 0.f, 0.f, 0.f};
        cur = nxt; cA = nA; cB = nB; ++ui;
        if constexpr (ALIGN_EPI) { if (wr == 1) PG8_BAR; }
    }
    PG8_WAIT_V(0);
    if constexpr (!ALIGN_EPI) { if (wr == 0) PG8_BAR; }
    PG8_BAR;
    if constexpr (Epi::AFTER_DRAIN) { E.fused(acc, cur, wr, wc, fr, fq, lds, wid, lane); S.done(cur); }
#undef PG8_SA
#undef PG8_SB
#undef PG8_STAGE
#undef PG8_LDA
#undef PG8_LDB
#undef PG8_MMA
#undef PG8_WAIT_V
#undef PG8_WAIT_L
#undef PG8_BAR
#undef PG8_SCHED
}
template <class Epi, class Sched, bool ALIGN_EPI = false, bool SP2 = false>
__device__ __forceinline__ void gemm_phase_g(PG8_LAS unsigned char* lds, const Gemm g, const Sched& S, const Epi& E, const int* rowtok) {
    int lid_; asm volatile("v_mbcnt_lo_u32_b32 %0, -1, 0\n\tv_mbcnt_hi_u32_b32 %0, -1, %0" : "=v"(lid_)); int tid_ = g.wv * 64 + lid_; asm volatile("" : "+v"(tid_));
    const int tid = tid_, wid = __builtin_amdgcn_readfirstlane(tid >> 6), lane = tid & 63, wr = wid >> 2, wc = wid & 3, fr = lane & 15, fq = lane >> 4;
    const int K = g.K, nt = K / BK;
    unsigned voffA[2], voffB[2];
#pragma unroll
    for (int i = 0; i < 2; ++i) { int R, C; stage_rc(tid * 16 + i * 8192, R, C); const int Rb = Epi::PERM ? ((R & ~31) + perm32(R & 31)) : R;
        voffA[i] = (unsigned)(R * K + C) * 2u; voffB[i] = (unsigned)(Rb * K + C) * 2u; }
    const size_t kstep = (size_t)(BK * 2);
    const size_t hstep = (size_t)HALF * K * 2;
    const size_t tstep = 2 * hstep;
    const unsigned ldsw = (unsigned)wid * 1024u;
    const int aoff = lds_byte(wr * 64 + fr, fq * 8), boff = lds_byte(wc * 32 + fr, fq * 8);
#define PG8_SA(b, h) (((b) * 2 + (h)) * HTB)
#define PG8_SB(b, h) ((4 + (b) * 2 + (h)) * HTB)
#define PG8_STAGE(bufoff, gbase, voff) do { _Pragma("unroll") for (int _i = 0; _i < 2; ++_i) \
        __builtin_amdgcn_global_load_lds((const unsigned*)((const char*)(gbase) + (voff)[_i]), (PG8_LAS unsigned*)(lds + (bufoff) + ldsw + _i * 8192), 16, 0, 0); } while (0)
#define PG8_LDA(dst, b, h) do { _Pragma("unroll") for (int m = 0; m < 4; ++m) _Pragma("unroll") for (int k = 0; k < 2; ++k) dst[m][k] = *(const PG8_LAS bf16x8*)(lds + PG8_SA(b, h) + aoff + m * 2048 + k * 1024); } while (0)
#define PG8_LDB(dst, b, h) do { _Pragma("unroll") for (int n = 0; n < 2; ++n) _Pragma("unroll") for (int k = 0; k < 2; ++k) dst[n][k] = *(const PG8_LAS bf16x8*)(lds + PG8_SB(b, h) + boff + n * 2048 + k * 1024); } while (0)
#define PG8_MMA(ai, bj, At, Bt) do { __builtin_amdgcn_s_setprio(1); _Pragma("unroll") for (int m = 0; m < 4; ++m) _Pragma("unroll") for (int n = 0; n < 2; ++n) _Pragma("unroll") for (int k = 0; k < 2; ++k) \
        acc[ai][bj][m][n] = __builtin_amdgcn_mfma_f32_16x16x32_bf16(Bt[n][k], At[m][k], acc[ai][bj][m][n], 0, 0, 0); __builtin_amdgcn_s_setprio(0); } while (0)
#define PG8_WAIT_V(n) asm volatile("s_waitcnt vmcnt(" #n ")" ::: "memory")
#define PG8_WAIT_L(n) asm volatile("s_waitcnt lgkmcnt(" #n ")" ::: "memory")
#define PG8_BAR __builtin_amdgcn_s_barrier()
#define PG8_SCHED __builtin_amdgcn_sched_barrier(0)
    unsigned gAc[2][2], gAn[2][2];
#define PG8_GATHER(dst, un) do { _Pragma("unroll") for (int hh_ = 0; hh_ < 2; ++hh_) _Pragma("unroll") for (int i_ = 0; i_ < 2; ++i_) { \
        const int tok_ = rowtok[(un).pm * BM + hh_ * HALF + (int)(voffA[i_] >> 11)]; dst[hh_][i_] = (unsigned)(tok_ < 0 ? 0 : tok_) * 2048u + (voffA[i_] & 2047u); } } while (0)
#define PG8_STAGE_GA(bufoff, kptr, hh, NX) do { _Pragma("unroll") for (int _i = 0; _i < 2; ++_i) \
        __builtin_amdgcn_global_load_lds((const unsigned*)((const char*)(kptr) + ((NX) ? gAn[hh][_i] : gAc[hh][_i])), (PG8_LAS unsigned*)(lds + (bufoff) + ldsw + _i * 8192), 16, 0, 0); } while (0)
    Unit cur, nxt; int ui = 0;
    if (!S.next(0, cur)) return;
    PG8_GATHER(gAc, cur);
    f32x4 acc[2][2][4][2];
#pragma unroll
    for (int a = 0; a < 2; ++a)
#pragma unroll
        for (int b = 0; b < 2; ++b)
#pragma unroll
            for (int m = 0; m < 4; ++m)
#pragma unroll
                for (int n = 0; n < 2; ++n) acc[a][b][m][n] = (f32x4){0.f, 0.f, 0.f, 0.f};
    bf16x8 At[4][2], B0[2][2], B1[2][2];
    const char* cA = (const char*)g.A; const char* cB = (const char*)g.Bt + S.bofs(cur, tstep);
    S.a_ready(cur);
    if constexpr (SP2) {
        PG8_STAGE(PG8_SB(0, 0), cB, voffB); PG8_STAGE(PG8_SB(0, 1), cB + hstep, voffB); PG8_STAGE_GA(PG8_SA(0, 0), cA, 0, false); PG8_STAGE_GA(PG8_SA(0, 1), cA, 1, false);
        if (wr == 1) PG8_BAR;
        PG8_WAIT_V(2); PG8_BAR;
        PG8_STAGE(PG8_SB(1, 0), cB + kstep, voffB); PG8_STAGE_GA(PG8_SA(1, 0), cA + kstep, 0, false); PG8_STAGE(PG8_SB(1, 1), cB + hstep + kstep, voffB);
        PG8_WAIT_V(6); PG8_BAR;
    } else {
        PG8_STAGE(PG8_SB(0, 0), cB, voffB); PG8_STAGE_GA(PG8_SA(0, 0), cA, 0, false); PG8_STAGE(PG8_SB(0, 1), cB + hstep, voffB); PG8_STAGE_GA(PG8_SA(0, 1), cA, 1, false);
        if (wr == 1) PG8_BAR;
        PG8_WAIT_V(4); PG8_BAR;
        PG8_STAGE(PG8_SB(1, 0), cB + kstep, voffB); PG8_STAGE_GA(PG8_SA(1, 0), cA + kstep, 0, false); PG8_STAGE(PG8_SB(1, 1), cB + hstep + kstep, voffB);
        PG8_WAIT_V(6); PG8_BAR;
    }
    for (;;) {
        const bool has_next = S.next(ui + 1, nxt);
        if (has_next) PG8_GATHER(gAn, nxt); else { _Pragma("unroll") for (int hh_ = 0; hh_ < 2; ++hh_) _Pragma("unroll") for (int i_ = 0; i_ < 2; ++i_) gAn[hh_][i_] = gAc[hh_][i_]; }
        const char* nA = (const char*)g.A; const char* nB = has_next ? (const char*)g.Bt + S.bofs(nxt, tstep) : cB;
        for (int t = 0; t < nt; t += 2) {
            const bool last = (t == nt - 2);
            const char* a1 = cA + (size_t)(t + 1) * kstep;
            const char* a2 = last ? nA : cA + (size_t)(t + 2) * kstep; const char* b2 = last ? nB : cB + (size_t)(t + 2) * kstep;
            const char* a3 = a2 + kstep; const char* b3 = b2 + kstep;
            if (last && has_next) S.a_ready(nxt);
            if constexpr (SP2) {
            PG8_LDB(B0, 0, 0); PG8_LDB(B1, 0, 1); PG8_SCHED; PG8_LDA(At, 0, 0); PG8_STAGE_GA(PG8_SA(1, 1), a1, 1, false);
            PG8_WAIT_V(8); PG8_WAIT_L(0); PG8_BAR; PG8_MMA(0, 0, At, B0); PG8_MMA(0, 1, At, B1); PG8_BAR; PG8_SCHED;
            PG8_LDA(At, 0, 1); PG8_STAGE(PG8_SB(0, 0), b2, voffB); PG8_STAGE(PG8_SB(0, 1), b2 + hstep, voffB); PG8_STAGE_GA(PG8_SA(0, 0), a2, 0, last);
            PG8_WAIT_V(8); PG8_WAIT_L(0); PG8_BAR; PG8_MMA(1, 0, At, B0); PG8_MMA(1, 1, At, B1); PG8_BAR; PG8_SCHED;
            PG8_LDB(B0, 1, 0); PG8_LDB(B1, 1, 1); PG8_SCHED; PG8_LDA(At, 1, 0); PG8_STAGE_GA(PG8_SA(0, 1), a2, 1, last);
            PG8_WAIT_V(8); PG8_WAIT_L(0); PG8_BAR; PG8_MMA(0, 0, At, B0); PG8_MMA(0, 1, At, B1); PG8_BAR; PG8_SCHED;
            PG8_LDA(At, 1, 1); PG8_STAGE(PG8_SB(1, 0), b3, voffB); PG8_STAGE(PG8_SB(1, 1), b3 + hstep, voffB); PG8_STAGE_GA(PG8_SA(1, 0), a3, 0, last);
            PG8_WAIT_V(8); PG8_WAIT_L(0); PG8_BAR; PG8_MMA(1, 0, At, B0); PG8_MMA(1, 1, At, B1); PG8_BAR; PG8_SCHED;
            } else {
            PG8_LDB(B0, 0, 0); PG8_SCHED; PG8_LDA(At, 0, 0); PG8_STAGE_GA(PG8_SA(1, 1), a1, 1, false);
            PG8_WAIT_L(8); PG8_BAR; PG8_WAIT_L(0); PG8_MMA(0, 0, At, B0); PG8_BAR; PG8_SCHED;
            PG8_LDB(B1, 0, 1); PG8_STAGE(PG8_SB(0, 0), b2, voffB);
            PG8_BAR; PG8_WAIT_L(0); PG8_MMA(0, 1, At, B1); PG8_BAR;
            PG8_LDA(At, 0, 1); PG8_STAGE_GA(PG8_SA(0, 0), a2, 0, last);
            PG8_BAR; PG8_WAIT_L(0); PG8_MMA(1, 0, At, B0); PG8_BAR; PG8_SCHED;
            PG8_STAGE(PG8_SB(0, 1), b2 + hstep, voffB);
            PG8_WAIT_V(6); PG8_BAR; PG8_MMA(1, 1, At, B1); PG8_BAR;
            PG8_LDB(B0, 1, 0); PG8_SCHED; PG8_LDA(At, 1, 0); PG8_STAGE_GA(PG8_SA(0, 1), a2, 1, last);
            PG8_WAIT_L(8); PG8_BAR; PG8_WAIT_L(0); PG8_MMA(0, 0, At, B0); PG8_BAR; PG8_SCHED;
            PG8_LDB(B1, 1, 1); PG8_STAGE(PG8_SB(1, 0), b3, voffB);
            PG8_BAR; PG8_WAIT_L(0); PG8_MMA(0, 1, At, B1); PG8_BAR;
            PG8_LDA(At, 1, 1); PG8_STAGE_GA(PG8_SA(1, 0), a3, 0, last);
            PG8_BAR; PG8_WAIT_L(0); PG8_MMA(1, 0, At, B0); PG8_BAR; PG8_SCHED;
            PG8_STAGE(PG8_SB(1, 1), b3 + hstep, voffB);
            PG8_WAIT_V(6); PG8_BAR; PG8_MMA(1, 1, At, B1); PG8_BAR;
            }
        }
        if constexpr (ALIGN_EPI) { if (wr == 0) PG8_BAR; }
        if constexpr (!Epi::AFTER_DRAIN) { E(acc, cur, wr, wc, fr, fq); S.done(cur); }
        if (!has_next) break;
#pragma unroll
        for (int a = 0; a < 2; ++a)
#pragma unroll
            for (int b = 0; b < 2; ++b)
#pragma unroll
                for (int m = 0; m < 4; ++m)
#pragma unroll
                    for (int n = 0; n < 2; ++n) acc[a][b][m][n] = (f32x4){0.f, 0.f, 0.f, 0.f};
        cur = nxt; cA = nA; cB = nB; ++ui;
        _Pragma("unroll") for (int hh_ = 0; hh_ < 2; ++hh_) _Pragma("unroll") for (int i_ = 0; i_ < 2; ++i_) gAc[hh_][i_] = gAn[hh_][i_];
        if constexpr (ALIGN_EPI) { if (wr == 1) PG8_BAR; }
    }
    PG8_WAIT_V(0);
    if constexpr (!ALIGN_EPI) { if (wr == 0) PG8_BAR; }
    PG8_BAR;
    if constexpr (Epi::AFTER_DRAIN) { E.fused(acc, cur, wr, wc, fr, fq, lds, wid, lane); S.done(cur); }
#undef PG8_GATHER
#undef PG8_STAGE_GA
#undef PG8_SA
#undef PG8_SB
#undef PG8_STAGE
#undef PG8_LDA
#undef PG8_LDB
#undef PG8_MMA
#undef PG8_WAIT_V
#undef PG8_WAIT_L
#undef PG8_BAR
#undef PG8_SCHED
}
}
#define XB_TMO      128
#define XB_XCNT(j)  (256  + 64 * (j))
#define XB_XSUB(j)  (1280 + 64 * (j))
#define XB_XGEN(j)  (2304 + 64 * (j))
#define XB_TOP      3328
#define XB_TOPGEN   3392
#define XCD_BAR_WORDS 3456
#define XB_SPIN_CAP (1u << 18)

__device__ __forceinline__ unsigned xb_ld(unsigned* p)              { return __hip_atomic_load(p, __ATOMIC_RELAXED, __HIP_MEMORY_SCOPE_AGENT); }
__device__ __forceinline__ unsigned xb_add(unsigned* p, unsigned v) { return __hip_atomic_fetch_add(p, v, __ATOMIC_RELAXED, __HIP_MEMORY_SCOPE_AGENT); }
__device__ __forceinline__ unsigned xb_xcc_id() { return (unsigned)__builtin_amdgcn_s_getreg((3 << 11) | 20) & 0xFu; }
#define XB_SPIN(cond, bar) do { unsigned _sp = 0; while (cond) { __builtin_amdgcn_s_sleep(1); \
    if ((++_sp & 255u) == 0u) { if (xb_ld(&(bar)[XB_TMO])) break; if (_sp > XB_SPIN_CAP) { atomicAdd(&(bar)[XB_TMO], 1u); break; } } } } while (0)

struct XcdBarrier {
    unsigned* bar; unsigned x;
    volatile LAS unsigned* st;
};

__device__ __forceinline__ XcdBarrier xcd_barrier_post(unsigned* bar, volatile LAS unsigned* st) {
    XcdBarrier b; b.bar = bar; b.x = xb_xcc_id(); b.st = st;
    if (threadIdx.x == 0) (void)xb_add(&bar[XB_XCNT(b.x)], 1u);
    return b;
}
__device__ __forceinline__ void xcd_barrier_complete(unsigned* bar, unsigned x, unsigned& nloc, unsigned& nx) {
    const unsigned G = gridDim.x * gridDim.y * gridDim.z;
    unsigned sum, cnt, mine, sp = 0u;
    for (;;) {
        sum = 0u; cnt = 0u; mine = 0u;
#pragma unroll
        for (unsigned j = 0; j < 16; ++j) { const unsigned c = xb_ld(&bar[XB_XCNT(j)]); sum += c; cnt += (c > 0u) ? 1u : 0u; mine = (j == x) ? c : mine; }
        if (sum == G) break;
        __builtin_amdgcn_s_sleep(1);
        if ((++sp & 255u) == 0u) { if (xb_ld(&bar[XB_TMO])) break; if (sp > XB_SPIN_CAP) { atomicAdd(&bar[XB_TMO], 1u); break; } }
    }
    nloc = mine > 0u ? mine : 1u; nx = cnt > 0u ? cnt : 1u;
}

__device__ __forceinline__ void xcd_barrier(const XcdBarrier& b) {
    asm volatile("s_waitcnt vmcnt(0)" ::: "memory");
    __syncthreads();
    if (threadIdx.x == 0) {
        unsigned* bar = b.bar;
        __builtin_amdgcn_s_waitcnt(0);
        unsigned nloc = b.st[0], nx = b.st[1];
        if (nloc == 0u) { xcd_barrier_complete(bar, b.x, nloc, nx); b.st[0] = nloc; b.st[1] = nx; }
        const unsigned old = xb_add(&bar[XB_XSUB(b.x)], 1u);
        const unsigned gen = old / nloc;
        if (old + 1u == (gen + 1u) * nloc) {
            __builtin_amdgcn_fence(__ATOMIC_RELEASE, "agent");
            asm volatile("s_waitcnt vmcnt(0)" ::: "memory");
            const unsigned og = xb_add(&bar[XB_TOP], 1u);
            const unsigned tg = og / nx;
            if (og + 1u == (tg + 1u) * nx) xb_add(&bar[XB_TOPGEN], 1u);
            else XB_SPIN(xb_ld(&bar[XB_TOPGEN]) == tg, bar);
            __builtin_amdgcn_fence(__ATOMIC_ACQUIRE, "agent");
            xb_add(&bar[XB_XGEN(b.x)], 1u);
            asm volatile("s_waitcnt vmcnt(0)" ::: "memory");
        } else {
            XB_SPIN(xb_ld(&bar[XB_XGEN(b.x)]) == gen, bar);
            __builtin_amdgcn_fence(__ATOMIC_ACQUIRE, "agent");
            asm volatile("s_waitcnt vmcnt(0)" ::: "memory");
        }
    }
    __syncthreads();
}

struct Params {
    const float* in[33];
    float* out; unsigned char* ws;
    int ph_lo, ph_hi;
};
struct Frame {
    LAS unsigned char* lds;
    int blk, G, wv;
    float* out; unsigned char* ws;
};
constexpr int PTAB_OFF = LDSCTL_OFF + 1024;
__device__ __forceinline__ int lane_id() { int l; asm volatile("v_mbcnt_lo_u32_b32 %0, -1, 0\n\tv_mbcnt_hi_u32_b32 %0, -1, %0" : "=v"(l)); return l; }
__device__ __forceinline__ int mytid(const Frame& F) { int t = F.wv * 64 + lane_id(); asm volatile("" : "+v"(t)); return t; }
__device__ __forceinline__ const float* inptr(const Frame& F, int k) {
    volatile LAS unsigned* t = (volatile LAS unsigned*)(F.lds + PTAB_OFF) + 2 * k;
    const unsigned lo = __builtin_amdgcn_readfirstlane(t[0]), hi = __builtin_amdgcn_readfirstlane(t[1]);
    const GAS float* gp = (const GAS float*)(((unsigned long long)hi << 32) | (unsigned long long)lo);
    return (const float*)gp;
}
#define IN_X 0
#define IN_RELB 1
#define IN_MIXG 2
#define IN_WIN 3
#define IN_WOUT 4
#define IN_FFNG 5
#define IN_QG 6
#define IN_KG 7
#define IN_CW 8
#define IN_CB 9
#define IN_CLG 10
#define IN_CLB 11
#define IN_MU 12
#define IN_W0 13
#define IN_W2 14
#define IN_A0 15
#define IN_A2 16
#define IN_G2 17
#define IN_KK 18
#define IN_KA 19
#define IN_RK 20
#define IN_RLG 21
#define IN_RLB 22
#define IN_GG2 23
#define IN_GGB 24
#define IN_GNG 25
#define IN_FWG 26
#define IN_FWU 27
#define IN_FWD 28
#define IN_ROUTER 29
#define IN_MWG 30
#define IN_MWU 31
#define IN_MWD 32

__device__ __forceinline__ void p0_transpose_item(const float* W, int K, int N, int nblk, const float* gk, bf16* WT, int mode, LAS float* scr, int item, int lane) {
    const int kb = item / nblk, nb = item % nblk, k0 = 64 * kb, n0 = 64 * nb, kr = lane >> 4, n4 = (lane & 15) * 4;
    const bool valid = (n0 + n4) < N;
    f32x4 v[16];
#pragma unroll
    for (int i = 0; i < 16; ++i) v[i] = valid ? *(const f32x4*)(W + (size_t)(k0 + 4 * i + kr) * N + n0 + n4) : (f32x4){0.f, 0.f, 0.f, 0.f};
    if (gk) {
#pragma unroll
        for (int i = 0; i < 16; ++i) v[i] = v[i] * gk[k0 + 4 * i + kr]; }
    const int rowbase = (mode == 0) ? n0 : ((n0 >> 7) * 256 + (mode == 2 ? 128 : 0) + (n0 & 127));
    const int c = lane & 3;
#pragma unroll
    for (int half = 0; half < 2; ++half) {
#pragma unroll
        for (int i = 0; i < 8; ++i) { LAS float* d = scr + (4 * i + kr) * 65 + n4; const f32x4 x = v[half * 8 + i]; d[0] = x[0]; d[1] = x[1]; d[2] = x[2]; d[3] = x[3]; }
        LDS_WAIT(); asm volatile("" ::: "memory");
#pragma unroll
        for (int j = 0; j < 4; ++j) { const int nn = (lane >> 2) + 16 * j; const LAS float* s = scr + (8 * c) * 65 + nn;
            u32x4 o; o.x = pk2(s[0 * 65], s[1 * 65]); o.y = pk2(s[2 * 65], s[3 * 65]); o.z = pk2(s[4 * 65], s[5 * 65]); o.w = pk2(s[6 * 65], s[7 * 65]);
            *(u32x4*)(WT + (size_t)(rowbase + nn) * K + k0 + half * 32 + 8 * c) = o; }
        LDS_WAIT(); asm volatile("" ::: "memory"); }
}
__device__ __forceinline__ void p0_prologue(Frame& F, const int part) {
    const int tid = mytid(F), lane = tid & 63, wave = __builtin_amdgcn_readfirstlane(tid >> 6); (void)lane; (void)wave;
    LAS float* scr = (LAS float*)(F.lds + wave * 16384);
    const int gw = F.blk * NWAVES + wave, NGW = F.G * NWAVES;
    constexpr int I_IN = 16 * 48, I_OUT = 16 * 16, I_GU = 16 * 44, I_D = 44 * 16, I_SET = 2 * I_GU + I_D;
    constexpr int NITEMS = 2 * I_IN + 2 * I_OUT + 9 * I_SET;
    unsigned char* ws = F.ws;
    constexpr int NPART0 = 2 * I_IN + 2 * I_OUT + I_SET;
    for (int it = (part == 0 ? 0 : NPART0) + gw; it < (part == 0 ? NPART0 : NITEMS); it += NGW) {
        int r = it;
        if (r < 2 * I_IN) { const int l = r / I_IN; r -= l * I_IN;
            p0_transpose_item(inptr(F, IN_WIN) + (size_t)l * DM * INW, DM, INW, 48, inptr(F, IN_MIXG) + l * DM, (bf16*)(ws + WS_WIN) + (size_t)l * NPADW * DM, 0, scr, r, lane); continue; }
        r -= 2 * I_IN;
        if (r < 2 * I_OUT) { const int l = r / I_OUT; r -= l * I_OUT;
            p0_transpose_item(inptr(F, IN_WOUT) + (size_t)l * DM * DM, DM, DM, 16, nullptr, (bf16*)(ws + WS_WOUT) + (size_t)l * DM * DM, 0, scr, r, lane); continue; }
        r -= 2 * I_OUT;
        const int set = r / I_SET; r -= set * I_SET;
        const float* wg = set == 0 ? inptr(F, IN_FWG) : inptr(F, IN_MWG) + (size_t)(set - 1) * DM * DFF;
        const float* wu = set == 0 ? inptr(F, IN_FWU) : inptr(F, IN_MWU) + (size_t)(set - 1) * DM * DFF;
        const float* wd = set == 0 ? inptr(F, IN_FWD) : inptr(F, IN_MWD) + (size_t)(set - 1) * DFF * DM;
        const float* gk = inptr(F, IN_FFNG) + (set == 0 ? 0 : DM);
        bf16* dgu = set == 0 ? (bf16*)(ws + WS_WGU) : (bf16*)(ws + WS_MOEW + (size_t)(set - 1) * MOEW_E_BYTES);
        bf16* dd = set == 0 ? (bf16*)(ws + WS_WD) : (bf16*)(ws + WS_MOEW + (size_t)(set - 1) * MOEW_E_BYTES + MOEW_GU_BYTES);
        if (r < I_GU) { p0_transpose_item(wg, DM, DFF, 44, gk, dgu, 1, scr, r, lane); continue; } r -= I_GU;
        if (r < I_GU) { p0_transpose_item(wu, DM, DFF, 44, gk, dgu, 2, scr, r, lane); continue; } r -= I_GU;
        p0_transpose_item(wd, DFF, DM, 16, nullptr, dd, 0, scr, r, lane);
    }
    if (part != 0) return;
    const float* x = inptr(F, IN_X); bf16* hb = (bf16*)(ws + WS_HB); float* ssq = (float*)(ws + WS_SSQ);
    for (int m = gw; m < NTOK; m += NGW) {
        const f32x4* xr = (const f32x4*)(x + (size_t)m * DM) + lane; f32x4 v[4]; float s = 0.f;
#pragma unroll
        for (int j = 0; j < 4; ++j) { v[j] = xr[64 * j]; s += (v[j][0] * v[j][0] + v[j][1] * v[j][1]) + (v[j][2] * v[j][2] + v[j][3] * v[j][3]); }
        s = wave_sum(s);
        u32x2* o8 = (u32x2*)(hb + (size_t)m * DM) + lane;
#pragma unroll
        for (int j = 0; j < 4; ++j) { u32x2 w; w.x = pk2(v[j][0], v[j][1]); w.y = pk2(v[j][2], v[j][3]); o8[64 * j] = w; }
        if (lane < 16) ssq[(size_t)m * 16 + lane] = (lane == 0) ? s : 0.f;
    }
}

__device__ const unsigned char T5B[3][132] = {
 {0,1,2,3,4,5,6,7,8,9,10,11,12,13,14,15,16,16,16,16,16,16,17,17,17,17,17,17,17,17,18,18,18,18,18,18,18,18,18,18,19,19,19,19,19,19,19,19,19,19,19,19,19,19,20,20,20,20,20,20,20,20,20,20,20,20,20,20,20,20,20,20,20,21,21,21,21,21,21,21,21,21,21,21,21,21,21,21,21,21,21,21,21,21,21,21,21,21,21,22,22,22,22,22,22,22,22,22,22,22,22,22,22,22,22,22,22,22,22,22,22,22,22,22,22,22,22,22,22,0,0,0},
 {0,4,8,12,16,16,17,17,18,18,19,19,19,19,20,20,20,20,20,21,21,21,21,21,21,22,22,22,22,22,22,22,22,22,23,23,23,23,23,23,23,23,23,23,23,23,24,24,24,24,24,24,24,24,24,24,24,24,24,24,24,24,25,25,25,25,25,25,25,25,25,25,25,25,25,25,25,25,25,25,25,25,25,26,26,26,26,26,26,26,26,26,26,26,26,26,26,26,26,26,26,26,26,26,26,26,26,26,26,26,26,26,26,27,27,27,27,27,27,27,27,27,27,27,27,27,27,27,27,0,0,0},
 {0,16,18,19,20,21,21,22,22,23,23,23,24,24,24,24,25,25,25,25,25,26,26,26,26,26,26,26,26,27,27,27,27,27,27,27,27,27,27,28,28,28,28,28,28,28,28,28,28,28,28,28,29,29,29,29,29,29,29,29,29,29,29,29,29,29,29,29,29,29,30,30,30,30,30,30,30,30,30,30,30,30,30,30,30,30,30,30,30,30,30,30,30,30,30,31,31,31,31,31,31,31,31,31,31,31,31,31,31,31,31,31,31,31,31,31,31,31,31,31,31,31,31,31,31,31,31,31,31,0,0,0}};

__device__ __forceinline__ void attn_qknorm(Frame& F, bf16* Z, const float* qg, const float* kg) {
    const int tid = mytid(F); const int gt = F.blk * NTHREADS + tid, NGT = F.G * NTHREADS;
    for (int idx = gt; idx < NTOK * 64; idx += NGT) { const int tok = idx >> 6, seg = (idx >> 3) & 7, c8 = idx & 7;
        u32x4* ptr = (u32x4*)(Z + (size_t)tok * INW + (seg >> 2) * 256 + (seg & 3) * 64 + c8 * 8); const u32x4 p = *ptr; float f[8]; unpack8(p, f);
        float ss = 0.f;
#pragma unroll
        for (int e2 = 0; e2 < 8; ++e2) ss += f[e2] * f[e2];
        ss = red8(ss);
        const float rs = __builtin_amdgcn_rsqf(ss * (1.0f / 64.0f) + NORM_EPS) * (seg < 4 ? 0.125f : 1.0f); const float* gp = (seg < 4 ? qg : kg) + c8 * 8;
        u32x4 o; o.x = pk2(f[0] * rs * gp[0], f[1] * rs * gp[1]); o.y = pk2(f[2] * rs * gp[2], f[3] * rs * gp[3]); o.z = pk2(f[4] * rs * gp[4], f[5] * rs * gp[5]); o.w = pk2(f[6] * rs * gp[6], f[7] * rs * gp[7]);
        *ptr = o; }
}
typedef short v4i16 __attribute__((ext_vector_type(4)));
__device__ __forceinline__ void attn_tile(LAS unsigned char* lds, const bf16* Z, bf16* OP, float* LSE, const float* rel_bias, int tile, int tid) {
    const int lane = tid & 63, w = __builtin_amdgcn_readfirstlane(tid >> 6), fr = lane & 15, g = lane >> 4;
    const int br = tile >> 10, rem = tile & 1023, b = rem >> 7, h = (rem >> 5) & 3, sub = rem & 31;
    const int dsh = 2 * br, nbl = 32 >> dsh, r = sub >> (5 - dsh), n = sub & (nbl - 1);
    LAS unsigned char* Qs = lds;
    LAS unsigned char* Ks = lds + 16384;
    LAS unsigned char* Vs = lds + 49152;
    LAS float* BT = (LAS float*)(lds + 81920);
    const size_t zrow0 = (size_t)b * SEQ;
    if (tid < 383) { const int delta = tid - 127; BT[tid] = (delta >= 0 && delta <= 128) ? rel_bias[(int)T5B[br][delta] * 4 + h] : -3.0e38f; }
    { const int rl = lane >> 3, cp = lane & 7;
#pragma unroll
        for (int i = 0; i < 4; ++i) { const int R0 = (w * 4 + i) * 8, row = R0 + rl; int lk = 128 * (n - 1) + row; lk = lk < 0 ? 0 : lk;
            const bf16* zr = Z + (zrow0 + ((size_t)lk << dsh) + r) * INW + h * 64;
            __builtin_amdgcn_global_load_lds((const unsigned*)(zr + 256 + ((cp ^ (row & 7)) * 8)), (LAS unsigned*)(Ks + R0 * 128), 16, 0, 0);
            __builtin_amdgcn_global_load_lds((const unsigned*)(zr + 512 + ((2 * ((cp >> 1) ^ ((row >> 1) & 3)) + (cp & 1)) * 8)), (LAS unsigned*)(Vs + R0 * 128), 16, 0, 0); }
#pragma unroll
        for (int i = 0; i < 2; ++i) { const int R0 = (w * 2 + i) * 8, row = R0 + rl; const int lq = 128 * n + row;
            const bf16* zr = Z + (zrow0 + ((size_t)lq << dsh) + r) * INW + h * 64;
            __builtin_amdgcn_global_load_lds((const unsigned*)(zr + ((cp ^ (row & 7)) * 8)), (LAS unsigned*)(Qs + R0 * 128), 16, 0, 0); } }
    asm volatile("s_waitcnt vmcnt(0)" ::: "memory");
    BAR();
    bf16x8 qf[2];
#pragma unroll
    for (int ks = 0; ks < 2; ++ks) qf[ks] = *(const LAS bf16x8*)(Qs + (16 * w + fr) * 128 + (((ks * 4 + g) ^ (fr & 7)) << 4));
    f32x4 s[16];
#pragma unroll
    for (int kb = 0; kb < 16; ++kb) { s[kb] = (f32x4){0.f, 0.f, 0.f, 0.f};
#pragma unroll
        for (int ks = 0; ks < 2; ++ks) { const bf16x8 kf = *(const LAS bf16x8*)(Ks + (16 * kb + fr) * 128 + (((ks * 4 + g) ^ (fr & 7)) << 4));
            s[kb] = __builtin_amdgcn_mfma_f32_16x16x32_bf16(kf, qf[ks], s[kb], 0, 0, 0); } }
    const int q = 16 * w + fr; float mx = -3.0e38f;
    const LAS float* btq = BT + (q + 255 - 4 * g);
#pragma unroll
    for (int kb = 0; kb < 16; ++kb)
#pragma unroll
        for (int rg = 0; rg < 4; ++rg) { float v = s[kb][rg] + btq[-(16 * kb + rg)];
            if (kb < 8) v = (n > 0) ? v : -3.0e38f;
            s[kb][rg] = v; mx = fmaxf(mx, v); }
    mx = fmaxf(mx, __shfl_xor(mx, 16)); mx = fmaxf(mx, __shfl_xor(mx, 32));
    float den = 0.f;
#pragma unroll
    for (int kb = 0; kb < 16; ++kb)
#pragma unroll
        for (int rg = 0; rg < 4; ++rg) { const float p = __expf(s[kb][rg] - mx); s[kb][rg] = p; den += p; }
    den += __shfl_xor(den, 16); den += __shfl_xor(den, 32);
    f32x4 o[4];
#pragma unroll
    for (int eb = 0; eb < 4; ++eb) o[eb] = (f32x4){0.f, 0.f, 0.f, 0.f};
    const int trq = fr >> 2, trp = fr & 3;
#pragma unroll
    for (int s8 = 0; s8 < 8; ++s8) {
        u32x4 pw; pw.x = pk2(s[2 * s8][0], s[2 * s8][1]); pw.y = pk2(s[2 * s8][2], s[2 * s8][3]); pw.z = pk2(s[2 * s8 + 1][0], s[2 * s8 + 1][1]); pw.w = pk2(s[2 * s8 + 1][2], s[2 * s8 + 1][3]);
        const bf16x8 pb = __builtin_bit_cast(bf16x8, pw);
        const int rowA = 32 * s8 + 4 * g + trq, swz = (rowA >> 1) & 3;
#pragma unroll
        for (int eb = 0; eb < 4; ++eb) { const LAS unsigned char* vp = Vs + rowA * 128 + ((eb ^ swz) * 32) + 8 * trp;
            const v4i16 lo = __builtin_amdgcn_ds_read_tr16_b64_v4i16((LAS v4i16*)vp), hi = __builtin_amdgcn_ds_read_tr16_b64_v4i16((LAS v4i16*)(vp + 16 * 128));
            bf16x8 af; af[0] = lo[0]; af[1] = lo[1]; af[2] = lo[2]; af[3] = lo[3]; af[4] = hi[0]; af[5] = hi[1]; af[6] = hi[2]; af[7] = hi[3];
            o[eb] = __builtin_amdgcn_mfma_f32_16x16x32_bf16(af, pb, o[eb], 0, 0, 0); } }
    const float inv = 1.0f / den; const size_t tokq = zrow0 + ((size_t)(128 * n + q) << dsh) + r;
    bf16* op = OP + ((size_t)br * NTOK + tokq) * 256 + h * 64 + 4 * g;
#pragma unroll
    for (int eb = 0; eb < 4; ++eb) { u32x2 wv; wv.x = pk2(o[eb][0] * inv, o[eb][1] * inv); wv.y = pk2(o[eb][2] * inv, o[eb][3] * inv); *(u32x2*)(op + 16 * eb) = wv; }
    if (g == 0) LSE[((size_t)br * NTOK + tokq) * 4 + h] = mx + __logf(den);
    BAR();
}

__device__ __forceinline__ void attn_merge(Frame& F, const bf16* OP, const float* LSE, bf16* Y, int wi, int nw) {
    const int tid = mytid(F), lane = tid & 63, wave = __builtin_amdgcn_readfirstlane(tid >> 6); (void)lane; (void)wave;
    const int gt = wi * NTHREADS + tid, NGT = nw * NTHREADS;
    for (int idx = gt; idx < NTOK * 32; idx += NGT) { const int tok = idx >> 5, c8 = idx & 31, h = c8 >> 3;
        const float l0 = LSE[((size_t)0 * NTOK + tok) * 4 + h], l1 = LSE[((size_t)1 * NTOK + tok) * 4 + h], l2 = LSE[((size_t)2 * NTOK + tok) * 4 + h];
        const float m = fmaxf(l0, fmaxf(l1, l2)); float w0 = __expf(l0 - m), w1 = __expf(l1 - m), w2 = __expf(l2 - m); const float inv = 1.0f / (w0 + w1 + w2); w0 *= inv; w1 *= inv; w2 *= inv;
        const u32x4 a = *(const u32x4*)(OP + ((size_t)0 * NTOK + tok) * 256 + c8 * 8), bq = *(const u32x4*)(OP + ((size_t)1 * NTOK + tok) * 256 + c8 * 8), c = *(const u32x4*)(OP + ((size_t)2 * NTOK + tok) * 256 + c8 * 8);
        float fa[8], fb[8], fc[8]; unpack8(a, fa); unpack8(bq, fb); unpack8(c, fc); float r[8];
#pragma unroll
        for (int e = 0; e < 8; ++e) r[e] = w0 * fa[e] + w1 * fb[e] + w2 * fc[e];
        u32x4 o; o.x = pk2(r[0], r[1]); o.y = pk2(r[2], r[3]); o.z = pk2(r[4], r[5]); o.w = pk2(r[6], r[7]);
        *(u32x4*)(Y + (size_t)tok * DM + c8 * 8) = o; }
}

__device__ __forceinline__ void conv_item(Frame& F, const bf16* Z, bf16* Y, const float* cw, const float* cb, const float* lg, const float* lb, int item) {
    const int tid = mytid(F), b = item >> 6, t0 = (item & 63) * 64;
    LAS float* HG = (LAS float*)F.lds;
    LAS float* WL = (LAS float*)(F.lds + 96256);
    f32x4 wq[4]; u32x4 uu[6], gg[6];
#pragma unroll
    for (int i = 0; i < 4; ++i) { const int q = tid + NTHREADS * i; wq[i] = (q < 31 * 64) ? *(const f32x4*)(cw + 4 * q) : (f32x4){0.f, 0.f, 0.f, 0.f}; }
#pragma unroll
    for (int i = 0; i < 6; ++i) { const int p = tid + NTHREADS * i, row = p >> 5, c8 = p & 31, t = t0 - 30 + row; uu[i] = (u32x4){0u, 0u, 0u, 0u}; gg[i] = uu[i];
        if (p < 94 * 32 && t >= 0) { const bf16* zr = Z + ((size_t)b * SEQ + t) * INW + ZB + c8 * 8; uu[i] = *(const u32x4*)zr; gg[i] = *(const u32x4*)(zr + 256); } }
#pragma unroll
    for (int i = 0; i < 4; ++i) { const int q = tid + NTHREADS * i; if (q < 31 * 64) *(LAS f32x4*)(WL + 4 * q) = wq[i]; }
#pragma unroll
    for (int i = 0; i < 6; ++i) { const int p = tid + NTHREADS * i, row = p >> 5, c8 = p & 31;
        if (p < 94 * 32) { float fu[8], fg[8], hv[8]; unpack8(uu[i], fu); unpack8(gg[i], fg);
#pragma unroll
            for (int e = 0; e < 8; ++e) hv[e] = fu[e] * __builtin_amdgcn_rcpf(1.0f + __expf(-fg[e]));
            LAS f32x4* d = (LAS f32x4*)(HG + row * 256 + c8 * 8); d[0] = (f32x4){hv[0], hv[1], hv[2], hv[3]}; d[1] = (f32x4){hv[4], hv[5], hv[6], hv[7]}; } }
    BAR();
    const int tg = tid >> 5, co = tid & 31;
    f32x4 acc[4][2];
    { const f32x4 b0 = *(const f32x4*)(cb + 8 * co), b1 = *(const f32x4*)(cb + 8 * co + 4);
#pragma unroll
        for (int t = 0; t < 4; ++t) { acc[t][0] = b0; acc[t][1] = b1; } }
    f32x4 wv[4][2];
#pragma unroll
    for (int d = 0; d < 4; ++d) { wv[d][0] = (f32x4){0.f, 0.f, 0.f, 0.f}; wv[d][1] = wv[d][0]; }
#pragma unroll 2
    for (int r = 0; r < 34; ++r) {
        const LAS float* hp = HG + (4 * tg + r) * 256 + 8 * co; const f32x4 h0 = *(const LAS f32x4*)hp, h1 = *(const LAS f32x4*)(hp + 4);
#pragma unroll
        for (int d = 3; d > 0; --d) { wv[d][0] = wv[d - 1][0]; wv[d][1] = wv[d - 1][1]; }
        if (r < 31) { wv[0][0] = *(const LAS f32x4*)(WL + r * 256 + 8 * co); wv[0][1] = *(const LAS f32x4*)(WL + r * 256 + 8 * co + 4); } else { wv[0][0] = (f32x4){0.f, 0.f, 0.f, 0.f}; wv[0][1] = wv[0][0]; }
#pragma unroll
        for (int t = 0; t < 4; ++t) { acc[t][0] += h0 * wv[t][0]; acc[t][1] += h1 * wv[t][1]; } }
    const f32x4 g0 = *(const f32x4*)(lg + 8 * co), g1 = *(const f32x4*)(lg + 8 * co + 4), be0 = *(const f32x4*)(lb + 8 * co), be1 = *(const f32x4*)(lb + 8 * co + 4);
#pragma unroll
    for (int t = 0; t < 4; ++t) { const f32x4 x0 = acc[t][0], x1 = acc[t][1];
        float s = ((x0[0] + x0[1]) + (x0[2] + x0[3])) + ((x1[0] + x1[1]) + (x1[2] + x1[3])); s = red8(s);
        const float mean = s * (1.0f / 64.0f); const f32x4 d0 = x0 - mean, d1 = x1 - mean;
        float ss = ((d0[0] * d0[0] + d0[1] * d0[1]) + (d0[2] * d0[2] + d0[3] * d0[3])) + ((d1[0] * d1[0] + d1[1] * d1[1]) + (d1[2] * d1[2] + d1[3] * d1[3])); ss = red8(ss);
        const float rstd = __builtin_amdgcn_rsqf(ss * (1.0f / 64.0f) + 1e-5f); float y[8];
#pragma unroll
        for (int e2 = 0; e2 < 4; ++e2) { const float a = d0[e2] * rstd * g0[e2] + be0[e2], c = d1[e2] * rstd * g1[e2] + be1[e2]; y[e2] = a * __builtin_amdgcn_rcpf(1.0f + __expf(-a)); y[4 + e2] = c * __builtin_amdgcn_rcpf(1.0f + __expf(-c)); }
        u32x4 o; o.x = pk2(y[0], y[1]); o.y = pk2(y[2], y[3]); o.z = pk2(y[4], y[5]); o.w = pk2(y[6], y[7]);
        *(u32x4*)(Y + ((size_t)b * SEQ + t0 + 4 * tg + t) * DM + 256 + 8 * co) = o; }
    BAR();
}

__device__ __forceinline__ bf16x8 ldfrag(const LAS unsigned char* base, int stride, int row0, int kb0, int fr, int g) {
    return *(const LAS bf16x8*)(base + (row0 + fr) * stride + kb0 + 16 * g);
}
#define MFMA16(a, b, c) __builtin_amdgcn_mfma_f32_16x16x32_bf16((a), (b), (c), 0, 0, 0)

constexpr int GL_G2 = 0, GL_Q = 2048, GL_K = 6144, GL_GK = 10240, GL_GD = 14336, GL_OG = 16384, GL_QT = 24576, GL_KB = 27136, GL_KHT = 29696, GL_VT = 32256, GL_ATT = 37376, GL_ST = 39936, GL_EC = 45056,
              GL_OB = 45184, GL_GB = 53376, GL_END = 53504;
struct GlaRaw { u32x4 p[2]; u32x4 s; };
__device__ __forceinline__ void gla_decode(int tid, int h, int it, int& tt, int& col, int& kind, int& off, bool& ok) {
    const int p = tid + 512 * it; ok = p < 832; tt = p / 26; const int qd = p % 26;
    if (qd < 4) { col = ZD + h * 32 + 8 * qd; kind = 0; off = tt * 32 + 8 * qd; }
    else if (qd < 8) { col = ZD + 128 + h * 32 + 8 * (qd - 4); kind = 1; off = tt * 32 + 8 * (qd - 4); }
    else if (qd < 16) { col = ZD + 256 + h * 64 + 8 * (qd - 8); kind = 2; off = 8 * (qd - 8); }
    else if (qd < 18) { col = ZD + 512 + 8 * (qd - 16); kind = 3; off = tt * 16 + 8 * (qd - 16); }
    else { col = ZD + 528 + h * 64 + 8 * (qd - 18); kind = 4; off = tt * 64 + 8 * (qd - 18); }
}
struct GlaAux { const unsigned char* qt; const unsigned char* kb; };
template <int STEP> __device__ __forceinline__ void gla_load(const bf16* Z, const unsigned char* sst, const GlaAux ax, int b, int h, int ch, int tid, GlaRaw& r) {
    const size_t item = (size_t)((b * 4 + h) * (SEQ / 32) + ch);
    if (STEP == 0) {
#pragma unroll
        for (int it = 0; it < 2; ++it) { int tt, col, kind, off; bool ok; gla_decode(tid, h, it, tt, col, kind, off, ok);
            r.p[it] = ok ? *(const u32x4*)(Z + ((size_t)b * SEQ + ch * 32 + tt) * INW + col) : (u32x4){0u, 0u, 0u, 0u}; }
    } else {
#pragma unroll
        for (int it = 0; it < 2; ++it) { const int p = tid + 512 * it;
            if (p < 128) r.p[it] = *(const u32x4*)(ax.qt + item * 2048 + 16 * p);
            else if (p < 256) r.p[it] = *(const u32x4*)(ax.kb + item * 2048 + 16 * (p - 128));
            else if (p < 768) { const int q = (p - 256) & 255, tt = q >> 3, c8 = q & 7; r.p[it] = *(const u32x4*)(Z + ((size_t)b * SEQ + ch * 32 + tt) * INW + ZD + (p < 512 ? 256 : 528) + h * 64 + 8 * c8); }
            else r.p[it] = *(const u32x4*)(sst + item * 4096 + 16 * (p - 768)); }
    }
}
template <int STEP> __device__ __forceinline__ void gla_item(Frame& F, const GlaRaw& raw, unsigned char* con, float* ecg, const GlaAux ax, bf16* Y, const float* ng, int b, int h, int ch) {
    const int tid = mytid(F), lane = tid & 63, w = __builtin_amdgcn_readfirstlane(tid >> 6), fr = lane & 15, g = lane >> 4;
    LAS unsigned char* L = F.lds;
    LAS float *G2 = (LAS float*)(L + GL_G2), *QF = (LAS float*)(L + GL_Q), *KF = (LAS float*)(L + GL_K), *GK = (LAS float*)(L + GL_GK), *GD = (LAS float*)(L + GL_GD), *OG = (LAS float*)(L + GL_OG),
              *OB = (LAS float*)(L + GL_OB), *GB = (LAS float*)(L + GL_GB);
    LAS unsigned char *QT = L + GL_QT, *KB = L + GL_KB, *KHT = L + GL_KHT, *VT = L + GL_VT, *ATT = L + GL_ATT, *ST = L + GL_ST;
    const size_t item = (size_t)((b * 4 + h) * (SEQ / 32) + ch);
    if (STEP == 0) {
#pragma unroll
        for (int it = 0; it < 2; ++it) { int tt, col, kind, off; bool ok; gla_decode(tid, h, it, tt, col, kind, off, ok);
            if (ok) { float f[8]; unpack8(raw.p[it], f);
                if (kind == 2) { LAS unsigned short* vp = (LAS unsigned short*)(VT + off * 80 + tt * 2); const u32x4 pr = raw.p[it];
                    vp[0 * 40] = (unsigned short)(pr.x & 0xffffu); vp[1 * 40] = (unsigned short)(pr.x >> 16); vp[2 * 40] = (unsigned short)(pr.y & 0xffffu); vp[3 * 40] = (unsigned short)(pr.y >> 16);
                    vp[4 * 40] = (unsigned short)(pr.z & 0xffffu); vp[5 * 40] = (unsigned short)(pr.z >> 16); vp[6 * 40] = (unsigned short)(pr.w & 0xffffu); vp[7 * 40] = (unsigned short)(pr.w >> 16); }
                else if (kind != 4) { LAS float* dst = (kind == 0 ? QF : kind == 1 ? KF : GD) + off; const float sc = kind == 0 ? 0.17677669529663687f : 1.0f;
                    ((LAS f32x4*)dst)[0] = (f32x4){f[0] * sc, f[1] * sc, f[2] * sc, f[3] * sc}; ((LAS f32x4*)dst)[1] = (f32x4){f[4] * sc, f[5] * sc, f[6] * sc, f[7] * sc}; } } }
        BAR();
#pragma unroll
        for (int it = 0; it < 2; ++it) { const int o = tid + 512 * it, tt = o >> 5, kk = o & 31; float x = GB[kk];
#pragma unroll
            for (int j = 0; j < 16; ++j) x += GD[tt * 16 + j] * G2[j * 32 + kk];
            GK[tt * 32 + kk] = -softplusf_(-x) * (1.0f / 16.0f); }
        BAR();
        { const int t = tid >> 4, k2 = (tid & 15) * 2; float c0 = 0.f, c1 = 0.f, b0 = 0.f, b1 = 0.f;
#pragma unroll 8
            for (int s = 0; s < 32; ++s) { const f32x2 gk = *(const LAS f32x2*)(GK + s * 32 + k2); c0 += gk[0]; c1 += gk[1]; if (s == t) { b0 = c0; b1 = c1; } }
            const f32x2 q = *(const LAS f32x2*)(QF + t * 32 + k2), k = *(const LAS f32x2*)(KF + t * 32 + k2);
            *(unsigned*)(ax.qt + item * 2048 + t * 64 + k2 * 2) = pk2(q[0] * __expf(b0), q[1] * __expf(b1)); *(unsigned*)(ax.kb + item * 2048 + t * 64 + k2 * 2) = pk2(k[0] * __expf(-b0), k[1] * __expf(-b1));
            *(LAS unsigned short*)(KHT + k2 * 80 + t * 2) = (unsigned short)f2bf(k[0] * __expf(c0 - b0)); *(LAS unsigned short*)(KHT + (k2 + 1) * 80 + t * 2) = (unsigned short)f2bf(k[1] * __expf(c1 - b1));
            if (t == 0) { ecg[item * 32 + k2] = __expf(c0); ecg[item * 32 + k2 + 1] = __expf(c1); } }
        BAR();
        { const int kb = w >> 2, vb = w & 3; f32x4 d = (f32x4){0.f, 0.f, 0.f, 0.f};
            d = MFMA16(ldfrag(KHT, 80, 16 * kb, 0, fr, g), ldfrag(VT, 80, 16 * vb, 0, fr, g), d);
            u32x2 so; so.x = pk2(d[0], d[1]); so.y = pk2(d[2], d[3]); *(u32x2*)(con + item * 4096 + (16 * vb + fr) * 64 + (16 * kb + 4 * g) * 2) = so; }
        BAR();
    } else {
#pragma unroll
        for (int it = 0; it < 2; ++it) { const int p = tid + 512 * it; const u32x4 pr = raw.p[it];
            if (p < 128) *(LAS u32x4*)(QT + (p >> 2) * 80 + (p & 3) * 16) = pr;
            else if (p < 256) { const int q = p - 128; *(LAS u32x4*)(KB + (q >> 2) * 80 + (q & 3) * 16) = pr; }
            else if (p < 512) { const int q = p - 256, tt = q >> 3, c8 = q & 7; LAS unsigned short* vp = (LAS unsigned short*)(VT + (8 * c8) * 80 + tt * 2);
                vp[0 * 40] = (unsigned short)(pr.x & 0xffffu); vp[1 * 40] = (unsigned short)(pr.x >> 16); vp[2 * 40] = (unsigned short)(pr.y & 0xffffu); vp[3 * 40] = (unsigned short)(pr.y >> 16);
                vp[4 * 40] = (unsigned short)(pr.z & 0xffffu); vp[5 * 40] = (unsigned short)(pr.z >> 16); vp[6 * 40] = (unsigned short)(pr.w & 0xffffu); vp[7 * 40] = (unsigned short)(pr.w >> 16); }
            else if (p < 768) { const int q = p - 512; float f[8]; unpack8(pr, f); LAS f32x4* dst = (LAS f32x4*)(OG + q * 8); dst[0] = (f32x4){f[0], f[1], f[2], f[3]}; dst[1] = (f32x4){f[4], f[5], f[6], f[7]}; }
            else { const int q = p - 768; *(LAS u32x4*)(ST + (q >> 2) * 80 + (q & 3) * 16) = pr; } }
        BAR();
        if (w < 3) { const int atb = w == 0 ? 0 : 1, asb = w == 2 ? 1 : 0;
            f32x4 d = (f32x4){0.f, 0.f, 0.f, 0.f}; d = MFMA16(ldfrag(KB, 80, 16 * asb, 0, fr, g), ldfrag(QT, 80, 16 * atb, 0, fr, g), d);
            const int t = 16 * atb + fr; float v[4];
#pragma unroll
            for (int r = 0; r < 4; ++r) { const int s = 16 * asb + 4 * g + r; v[r] = (s <= t) ? d[r] : 0.f; }
            u32x2 o; o.x = pk2(v[0], v[1]); o.y = pk2(v[2], v[3]); *(LAS u32x2*)(ATT + t * 80 + (16 * asb + 4 * g) * 2) = o; }
        else if (w == 3) { *(LAS u32x2*)(ATT + fr * 80 + (16 + 4 * g) * 2) = (u32x2){0u, 0u}; }
        BAR();
        { const int tb = w >> 2, vb = w & 3; f32x4 o = (f32x4){0.f, 0.f, 0.f, 0.f};
            o = MFMA16(ldfrag(ATT, 80, 16 * tb, 0, fr, g), ldfrag(VT, 80, 16 * vb, 0, fr, g), o);
            o = MFMA16(ldfrag(QT, 80, 16 * tb, 0, fr, g), ldfrag(ST, 80, 16 * vb, 0, fr, g), o);
#pragma unroll
            for (int r = 0; r < 4; ++r) OB[(16 * tb + 4 * g + r) * 64 + 16 * vb + fr] = o[r]; }
        BAR();
        { const int tt = tid >> 4, v4 = (tid & 15) * 4; const f32x4 o = *(const LAS f32x4*)(OB + tt * 64 + v4);
            float ss = (o[0] * o[0] + o[1] * o[1]) + (o[2] * o[2] + o[3] * o[3]); ss = red16(ss);
            const float rs = __builtin_amdgcn_rsqf(ss * (1.0f / 64.0f) + NORM_EPS); const f32x4 gv = *(const f32x4*)(ng + v4), og = *(const LAS f32x4*)(OG + tt * 64 + v4); float y[4];
#pragma unroll
            for (int e = 0; e < 4; ++e) y[e] = o[e] * rs * gv[e] * og[e] * __builtin_amdgcn_rcpf(1.0f + __expf(-og[e]));
            u32x2 wv; wv.x = pk2(y[0], y[1]); wv.y = pk2(y[2], y[3]); *(u32x2*)(Y + ((size_t)b * SEQ + ch * 32 + tt) * DM + 768 + h * 64 + v4) = wv; }
        BAR();
    }
}
__device__ __forceinline__ int gla_sched(int k, int wi, int nw, int skip) { const int full = 1024 / nw, rem = 1024 - full * nw; if (k < full) return k * nw + wi; if (k == full && wi >= skip && wi - skip < rem) return full * nw + wi - skip; return -1; }
template <int STEP> __device__ __forceinline__ void gla_items(Frame& F, const bf16* Z, unsigned char* con, float* ecg, const GlaAux ax, bf16* Y, const float* g2, const float* gb, const float* ng, int wi, int nw, int skip) {
    const int tid = mytid(F);
#pragma unroll 1
    for (int h = 0; h < 4; ++h) {
        ((LAS float*)(F.lds + GL_G2))[tid] = g2[(tid >> 5) * 128 + h * 32 + (tid & 31)]; if (tid < 32) ((LAS float*)(F.lds + GL_GB))[tid] = gb[h * 32 + tid];
        BAR();
        GlaRaw cur, nxt; cur.p[0] = (u32x4){0u, 0u, 0u, 0u}; cur.p[1] = cur.p[0]; cur.s = cur.p[0]; nxt = cur;
        int it = gla_sched(0, wi, nw, skip);
        if (it >= 0) gla_load<STEP>(Z, con, ax, it >> 7, h, it & 127, tid, cur);
#pragma unroll 1
        for (int k = 0; it >= 0; ++k) { const int nx = gla_sched(k + 1, wi, nw, skip);
            if (nx >= 0) gla_load<STEP>(Z, con, ax, nx >> 7, h, nx & 127, tid, nxt);
            gla_item<STEP>(F, cur, con, ecg, ax, Y, ng, it >> 7, h, it & 127);
            cur = nxt; it = nx; }
        BAR(); }
}
__device__ __forceinline__ void gla_scan(Frame& F, unsigned char* con, const float* ecg, int b, int h) {
    const int tid = mytid(F); const int k4 = (tid & 7) * 4;
    unsigned char* base = con + (size_t)((b * 4 + h) * (SEQ / 32)) * 4096 + 8 * tid; const float* eb = ecg + (size_t)((b * 4 + h) * (SEQ / 32)) * 32 + k4;
    float s[4] = {0.f, 0.f, 0.f, 0.f};
    u32x2 cn[4]; f32x4 ec[4];
#pragma unroll
    for (int j = 0; j < 4; ++j) { cn[j] = *(const u32x2*)(base + (size_t)j * 4096); ec[j] = *(const f32x4*)(eb + j * 32); }
#pragma unroll 1
    for (int c0 = 0; c0 < SEQ / 32; c0 += 4) {
        u32x2 cc[4]; f32x4 ee[4];
#pragma unroll
        for (int j = 0; j < 4; ++j) { cc[j] = cn[j]; ee[j] = ec[j]; }
        if (c0 + 4 < SEQ / 32) {
#pragma unroll
            for (int j = 0; j < 4; ++j) { cn[j] = *(const u32x2*)(base + (size_t)(c0 + 4 + j) * 4096); ec[j] = *(const f32x4*)(eb + (c0 + 4 + j) * 32); } }
#pragma unroll
        for (int j = 0; j < 4; ++j) { u32x2 o; o.x = pk2(s[0], s[1]); o.y = pk2(s[2], s[3]); *(u32x2*)(base + (size_t)(c0 + j) * 4096) = o;
            s[0] = ee[j][0] * s[0] + bflo(cc[j].x); s[1] = ee[j][1] * s[1] + bfhi(cc[j].x); s[2] = ee[j][2] * s[2] + bflo(cc[j].y); s[3] = ee[j][3] * s[3] + bfhi(cc[j].y); } }
}

struct RwkvP { const float *mu, *w0, *w2, *a0, *a2, *g2, *kk, *ka, *rk, *lg, *lb; };
constexpr int RC_AT = 0  , RC_RT = 2048  , RC_ZT = 4096, RC_RBK = 5120, RC_BKT = 6144  , RC_VT4 = 10240  ,
              RC_GC = 12288  , RC_G = 12544  , RC_BON = 14592  , RC_BYTES = 14656, RC_STRIDE = 14848;
constexpr int RC_CHUNKS16 = RC_BYTES / 16;
static_assert((size_t)NB * 4 * (SEQ / 16) * RC_STRIDE <= NEXP * MOEW_E_BYTES, "RWKV records overlay the (not yet converted) MoE weight region");
constexpr int RW_W2T = 0, RW_A2T = 5120, RW_G2T = 10240, RW_MU = 19456  , RW_TW = 23040, RW_AD = 24320, RW_SG = 25600, RW_R = 27904, RW_K = 32000, RW_V = 36096, RW_WL = 40192, RW_AL = 44288,
              RW_G = 48384, RW_KK = 52480, RW_KP = 56576, RW_BON = 60672, RW_GC = 60736, RW_AR = 60992, RW_BK = 65600, RW_BKT = 70208, RW_ZAK = 75328, RW_RBK = 76608, RW_AAB = 77888, RW_TT = 78912  , RW_PAR = 80192  , RW_END = 81472;

__device__ __forceinline__ void rwkv_prep_init(Frame& F, const RwkvP P, int h) {
    const int tid = mytid(F); LAS unsigned char* L = F.lds;
    for (int i = tid; i < 64 * 32; i += NTHREADS) { const int c = i >> 5, j = i & 31;
        *(LAS unsigned short*)(L + RW_W2T + c * 80 + j * 2) = (unsigned short)f2bf(P.w2[j * 256 + h * 64 + c]); *(LAS unsigned short*)(L + RW_A2T + c * 80 + j * 2) = (unsigned short)f2bf(P.a2[j * 256 + h * 64 + c]); }
    for (int i = tid; i < 64 * 64; i += NTHREADS) { const int c = i >> 6, j = i & 63; *(LAS unsigned short*)(L + RW_G2T + c * 144 + j * 2) = (unsigned short)f2bf(P.g2[j * 256 + h * 64 + c]); }
    for (int i = tid; i < 896; i += NTHREADS) ((LAS float*)(L + RW_MU))[i] = P.mu[i];
    if (tid < 320) { const int q = tid >> 6, c = tid & 63; const float* src = q == 0 ? P.w0 : q == 1 ? P.a0 : q == 2 ? P.kk : q == 3 ? P.ka : P.rk; ((LAS float*)(L + RW_PAR))[tid] = src[h * 64 + c]; }
}
__device__ __forceinline__ void rwkv_prep_load(const bf16* Z, int b, int h, int ch, int w, int lane, u32x4 (&cur)[2], u32x4 (&prv)[2]) {
    const int kind = w & 3, p = (w >> 2) * 64 + lane, tt = p >> 3, j = p & 7;
    const int col = (kind < 3 ? ZC + kind * 256 + h * 64 : ZC + 832) + 8 * j;
    const int t = ch * 16 + tt; const bf16* zr = Z + ((size_t)b * SEQ + t) * INW + col;
    cur[0] = *(const u32x4*)zr; prv[0] = (t > 0) ? *(const u32x4*)(zr - INW) : (u32x4){0u, 0u, 0u, 0u};
    if (w < 2) { const int t2 = ch * 16 + (lane >> 2); const bf16* z2 = Z + ((size_t)b * SEQ + t2) * INW + ZC + 768 + w * 32 + 8 * (lane & 3);
        cur[1] = *(const u32x4*)z2; prv[1] = (t2 > 0) ? *(const u32x4*)(z2 - INW) : (u32x4){0u, 0u, 0u, 0u}; }
    else { cur[1] = (u32x4){0u, 0u, 0u, 0u}; prv[1] = cur[1]; }
}
__device__ __forceinline__ void rwkv_prep_item(Frame& F, unsigned char* rec, const RwkvP P, int h, const u32x4 (&cur)[2], const u32x4 (&prv)[2]) {
    const int tid = mytid(F), lane = tid & 63, w = __builtin_amdgcn_readfirstlane(tid >> 6), fr = lane & 15, g = lane >> 4;
    LAS unsigned char* L = F.lds;
#if defined(PROBE_PI)
    unsigned long long tl_ = __builtin_amdgcn_s_memrealtime(), ta_ = 0;
#define PIT(k) do { const unsigned long long tn_ = __builtin_amdgcn_s_memrealtime(); if ((k) == PROBE_PI) ta_ += tn_ - tl_; tl_ = tn_; } while (0)
#else
#define PIT(k) do { } while (0)
#endif
    LAS float *R = (LAS float*)(L + RW_R), *KR = (LAS float*)(L + RW_K), *V = (LAS float*)(L + RW_V), *WL = (LAS float*)(L + RW_WL), *AL = (LAS float*)(L + RW_AL), *G = (LAS float*)(L + RW_G),
              *KK = (LAS float*)(L + RW_KK), *KP = (LAS float*)(L + RW_KP), *BON = (LAS float*)(L + RW_BON), *GC = (LAS float*)(L + RW_GC), *AAB = (LAS float*)(L + RW_AAB), *MU = (LAS float*)(L + RW_MU);
    { const int kind = w & 3, p = (w >> 2) * 64 + lane, tt = p >> 3, j = p & 7; float fc[8], fp[8], x[8]; unpack8(cur[0], fc); unpack8(prv[0], fp);
        const LAS float* mu = MU + (kind < 3 ? kind * 256 + h * 64 : 832) + 8 * j;
#pragma unroll
        for (int e = 0; e < 8; ++e) x[e] = fc[e] + (fp[e] - fc[e]) * mu[e];
        if (kind < 3) { LAS f32x4* d = (LAS f32x4*)((kind == 0 ? R : kind == 1 ? KR : V) + tt * 64 + 8 * j); d[0] = (f32x4){x[0], x[1], x[2], x[3]}; d[1] = (f32x4){x[4], x[5], x[6], x[7]}; }
        else {
#pragma unroll
            for (int e = 0; e < 8; ++e) x[e] = __builtin_amdgcn_rcpf(1.0f + __expf(-x[e]));
            u32x4 o; o.x = pk2(x[0], x[1]); o.y = pk2(x[2], x[3]); o.z = pk2(x[4], x[5]); o.w = pk2(x[6], x[7]); *(LAS u32x4*)(L + RW_SG + tt * 144 + 16 * j) = o; }
        if (w < 2) { const int t2 = lane >> 2, j2 = lane & 3; unpack8(cur[1], fc); unpack8(prv[1], fp); const LAS float* mu2 = MU + 768 + w * 32 + 8 * j2;
#pragma unroll
            for (int e = 0; e < 8; ++e) { x[e] = fc[e] + (fp[e] - fc[e]) * mu2[e]; if (w == 0) x[e] = 2.0f * __builtin_amdgcn_rcpf(1.0f + __expf(-2.0f * x[e])) - 1.0f; }
            u32x4 o; o.x = pk2(x[0], x[1]); o.y = pk2(x[2], x[3]); o.z = pk2(x[4], x[5]); o.w = pk2(x[6], x[7]); *(LAS u32x4*)(L + (w == 0 ? RW_TW : RW_AD) + t2 * 80 + 16 * j2) = o; } }
    BAR(); PIT(0);
    if (w < 4) { f32x4 dw = (f32x4){0.f, 0.f, 0.f, 0.f}, da = dw;
        dw = MFMA16(ldfrag(L + RW_W2T, 80, 16 * w, 0, fr, g), ldfrag(L + RW_TW, 80, 0, 0, fr, g), dw);
        da = MFMA16(ldfrag(L + RW_A2T, 80, 16 * w, 0, fr, g), ldfrag(L + RW_AD, 80, 0, 0, fr, g), da);
        *(LAS f32x4*)(WL + fr * 64 + 16 * w + 4 * g) = dw; *(LAS f32x4*)(AL + fr * 64 + 16 * w + 4 * g) = da; }
    else { const int cb = w - 4; f32x4 dg = (f32x4){0.f, 0.f, 0.f, 0.f};
        dg = MFMA16(ldfrag(L + RW_G2T, 144, 16 * cb, 0, fr, g), ldfrag(L + RW_SG, 144, 0, 0, fr, g), dg);
        dg = MFMA16(ldfrag(L + RW_G2T, 144, 16 * cb, 64, fr, g), ldfrag(L + RW_SG, 144, 0, 64, fr, g), dg);
        *(LAS f32x4*)(G + fr * 64 + 16 * cb + 4 * g) = dg; }
    BAR(); PIT(1);
    { const int t = tid >> 5, c2 = (tid & 31) * 2; const LAS float* PAR = (const LAS float*)(L + RW_PAR) + c2;
        const f32x2 wl = *(const LAS f32x2*)(WL + t * 64 + c2) + *(const LAS f32x2*)(PAR), al = *(const LAS f32x2*)(AL + t * 64 + c2) + *(const LAS f32x2*)(PAR + 64);
        const f32x2 kr = *(const LAS f32x2*)(KR + t * 64 + c2), rr = *(const LAS f32x2*)(R + t * 64 + c2);
        const f32x2 kkw = *(const LAS f32x2*)(PAR + 128), kaw = *(const LAS f32x2*)(PAR + 192), rkw = *(const LAS f32x2*)(PAR + 256);
        f32x2 lw, a, kk, kp; float ss = 0.f, bon = 0.f;
#pragma unroll
        for (int e = 0; e < 2; ++e) { const float wlog = -softplusf_(-wl[e]) - 0.5f; lw[e] = -__expf(wlog); a[e] = __builtin_amdgcn_rcpf(1.0f + __expf(-al[e])); kk[e] = kr[e] * kkw[e]; ss += kk[e] * kk[e];
            kp[e] = kr[e] * (1.0f + (a[e] - 1.0f) * kaw[e]); bon += rr[e] * kp[e] * rkw[e]; }
        ss = red16(ss); bon = red16(bon); ss += __shfl_xor(ss, 16); bon += __shfl_xor(bon, 16);
        const float inv = 1.0f / fmaxf(sqrtf(ss), 1e-12f); kk = kk * inv;
        *(LAS f32x2*)(WL + t * 64 + c2) = lw; *(LAS f32x2*)(AL + t * 64 + c2) = a; *(LAS f32x2*)(KK + t * 64 + c2) = kk; *(LAS f32x2*)(KP + t * 64 + c2) = kp;
        if ((tid & 31) == 0) BON[t] = bon; }
    BAR(); PIT(2);
    { const int t = tid >> 5, c2 = (tid & 31) * 2;
        f32x2 cs = (f32x2){0.f, 0.f}, ct = cs;
#pragma unroll
        for (int s = 0; s < 16; ++s) { cs += *(const LAS f32x2*)(WL + s * 64 + c2); if (s == t) ct = cs; }
        const f32x2 lwt = *(const LAS f32x2*)(WL + t * 64 + c2), a = *(const LAS f32x2*)(AL + t * 64 + c2), kk = *(const LAS f32x2*)(KK + t * 64 + c2), kp = *(const LAS f32x2*)(KP + t * 64 + c2), rr = *(const LAS f32x2*)(R + t * 64 + c2);
        float at[2], rt[2], bb[2], kb[2], bh[2], kh[2];
#pragma unroll
        for (int e = 0; e < 2; ++e) { const float eP = __expf(ct[e] - lwt[e]), eT = __expf(ct[e]), eI = __expf(-ct[e]), eC = __expf(cs[e] - ct[e]); const float bv = kk[e] * a[e];
            at[e] = -kk[e] * eP; rt[e] = rr[e] * eT; bb[e] = bv * eI; kb[e] = kp[e] * eI; bh[e] = bv * eC; kh[e] = kp[e] * eC; }
        *(LAS unsigned*)(L + RW_AR + t * 144 + c2 * 2) = pk2(at[0], at[1]); *(LAS unsigned*)(L + RW_AR + (16 + t) * 144 + c2 * 2) = pk2(rt[0], rt[1]);
        *(LAS unsigned*)(L + RW_BK + t * 144 + c2 * 2) = pk2(bb[0], bb[1]); *(LAS unsigned*)(L + RW_BK + (16 + t) * 144 + c2 * 2) = pk2(kb[0], kb[1]);
#pragma unroll
        for (int e = 0; e < 2; ++e) { *(LAS unsigned short*)(L + RW_BKT + (c2 + e) * 80 + t * 2) = (unsigned short)f2bf(bh[e]); *(LAS unsigned short*)(L + RW_BKT + (c2 + e) * 80 + (16 + t) * 2) = (unsigned short)f2bf(kh[e]); }
        if (t == 0) { GC[c2] = __expf(cs[0]); GC[c2 + 1] = __expf(cs[1]); } }
    BAR(); PIT(3);
    if (w < 4) { const int arow = (w & 1) ? 16 : 0  , brow = (w & 2) ? 16 : 0  ;
        f32x4 d = (f32x4){0.f, 0.f, 0.f, 0.f};
        d = MFMA16(ldfrag(L + RW_BK, 144, arow, 0, fr, g), ldfrag(L + RW_AR, 144, brow, 0, fr, g), d);
        d = MFMA16(ldfrag(L + RW_BK, 144, arow, 64, fr, g), ldfrag(L + RW_AR, 144, brow, 64, fr, g), d);
        const int t = fr; float v[4];
#pragma unroll
        for (int r = 0; r < 4; ++r) { const int s = 4 * g + r; const bool keep = (w < 2) ? (s < t) : (s <= t); v[r] = keep ? d[r] : 0.f; }
        if (w == 0) { AAB[(4 * g + 0) * 16 + t] = v[0]; AAB[(4 * g + 1) * 16 + t] = v[1]; AAB[(4 * g + 2) * 16 + t] = v[2]; AAB[(4 * g + 3) * 16 + t] = v[3]; }
        else { u32x2 o; o.x = pk2(v[0], v[1]); o.y = pk2(v[2], v[3]);
            LAS unsigned char* dst = (w == 1) ? (L + RW_ZAK + t * 80 + (16 + 4 * g) * 2) : (w == 2) ? (L + RW_RBK + t * 80 + (4 * g) * 2) : (L + RW_RBK + t * 80 + (16 + 4 * g) * 2);
            *(LAS u32x2*)dst = o; } }
    BAR(); PIT(4);
    if (w == 7) { if (lane < 16) { float col[16];
#pragma unroll
            for (int t = 0; t < 16; ++t) col[t] = (t == lane) ? 1.0f : 0.f;
#pragma unroll
            for (int s = 0; s < 15; ++s) { const f32x4 a0 = *(const LAS f32x4*)(AAB + s * 16), a1 = *(const LAS f32x4*)(AAB + s * 16 + 4), a2 = *(const LAS f32x4*)(AAB + s * 16 + 8), a3 = *(const LAS f32x4*)(AAB + s * 16 + 12);
                const float as[16] = {a0[0], a0[1], a0[2], a0[3], a1[0], a1[1], a1[2], a1[3], a2[0], a2[1], a2[2], a2[3], a3[0], a3[1], a3[2], a3[3]};
#pragma unroll
                for (int t = s + 1; t < 16; ++t) col[t] += as[t] * col[s]; }
#pragma unroll
            for (int t = 0; t < 16; ++t) *(LAS unsigned short*)(L + RW_TT + t * 80 + lane * 2) = (unsigned short)f2bf(col[t]); }
        LDS_WAIT();
        { const u32x2 lo = *(const LAS u32x2*)(L + RW_TT + fr * 80 + 8 * g), hi = *(const LAS u32x2*)(L + RW_ZAK + fr * 80 + 32 + 8 * g); u32x4 o; o.x = lo.x; o.y = lo.y; o.z = hi.x; o.w = hi.y;
            *(u32x4*)(rec + RC_ZT + fr * 64 + 16 * g) = o; } }
    else {
#pragma unroll 1
        for (int job = w; job < 16; job += 7) {
            if (job < 9) { int src, stride, row0, ka, kb2, dst;
                if (job < 4) { src = RW_AR; stride = 144; row0 = (job >> 1) * 16; ka = 32 * (job & 1); kb2 = ka + 16; dst = (job >> 1 ? RC_RT : RC_AT) + (job & 1) * 1024; }
                else if (job == 4) { src = RW_RBK; stride = 80; row0 = 0; ka = 0; kb2 = 16; dst = RC_RBK; }
                else { src = RW_BKT; stride = 80; row0 = 16 * (job - 5); ka = 0; kb2 = 16; dst = RC_BKT + (job - 5) * 1024; }
                const LAS unsigned char* rp = L + src + (row0 + fr) * stride + 8 * g; const u32x2 lo = *(const LAS u32x2*)(rp + ka * 2), hi = *(const LAS u32x2*)(rp + kb2 * 2);
                u32x4 o; o.x = lo.x; o.y = lo.y; o.z = hi.x; o.w = hi.y; *(u32x4*)(rec + dst + fr * 64 + 16 * g) = o; }
            else if (job < 13) { const int vb = job - 9; const LAS float* vp = V + (4 * g) * 64 + 16 * vb + fr; u32x2 o; o.x = pk2(vp[0], vp[64]); o.y = pk2(vp[128], vp[192]); *(u32x2*)(rec + RC_VT4 + vb * 512 + lane * 8) = o; }
            else { const int p = (job - 13) * 64 + lane;
                if (p < 16) *(f32x4*)(rec + RC_GC + 16 * p) = *(const LAS f32x4*)(GC + 4 * p);
                else if (p < 144) { const int q = p - 16; const f32x4 a = *(const LAS f32x4*)(G + q * 8), c = *(const LAS f32x4*)(G + q * 8 + 4); u32x4 o; o.x = pk2(a[0], a[1]); o.y = pk2(a[2], a[3]); o.z = pk2(c[0], c[1]); o.w = pk2(c[2], c[3]); *(u32x4*)(rec + RC_G + 16 * q) = o; }
                else if (p < 148) { const int q = p - 144; *(f32x4*)(rec + RC_BON + 16 * q) = *(const LAS f32x4*)(BON + 4 * q); } } } }
    BAR(); PIT(5);
#if defined(PROBE_PI)
    if (blockIdx.x == 0 && threadIdx.x == 0) ((unsigned long long*)(F.ws + 32768))[0] += ta_;
#endif
}

constexpr int SB_STRIDE = 16384, SB_NBUF = 7, SB_AHEAD = 5, ST_OB = SB_NBUF * SB_STRIDE  , ST_END = ST_OB + 8192;
static_assert(ST_END <= RING_BYTES && RC_BYTES <= SB_STRIDE, "state pass LDS");
__device__ __forceinline__ void rwkv_state(Frame& F, const unsigned char* recs, bf16* Y, const RwkvP P, int b, int h) {
    const int tid = mytid(F), lane = tid & 63, w = __builtin_amdgcn_readfirstlane(tid >> 6), fr = lane & 15, g = lane >> 4;
    LAS unsigned char* L = F.lds;
    const unsigned char* rbase = recs + (size_t)(b * 4 + h) * (SEQ / 16) * RC_STRIDE;
    const int lt = tid - 256;
    const f32x4 plg = *(const f32x4*)(P.lg + h * 64 + (tid & 15) * 4), plb = *(const f32x4*)(P.lb + h * 64 + (tid & 15) * 4);
    asm volatile("s_waitcnt vmcnt(0)" ::: "memory");
    f32x4 accS[4];
#pragma unroll
    for (int i = 0; i < 4; ++i) accS[i] = (f32x4){0.f, 0.f, 0.f, 0.f};
    constexpr int NCH = SEQ / 16;
#define RW_ISSUE(r) do { const unsigned char* gp_ = rbase + (size_t)(r) * RC_STRIDE + (w * 256 + lane) * 16; LAS unsigned char* lp_ = L + ((r) % SB_NBUF) * SB_STRIDE + w * 4096; \
        _Pragma("unroll") for (int i_ = 0; i_ < 4; ++i_) __builtin_amdgcn_global_load_lds((const unsigned*)(gp_ + i_ * 1024), (LAS unsigned*)(lp_ + i_ * 1024), 16, 0, 0); } while (0)
    if (w < 4) {
#pragma unroll 1
        for (int r = 0; r < SB_AHEAD; ++r) RW_ISSUE(r);
        asm volatile("s_waitcnt vmcnt(16)" ::: "memory"); }
    BAR();
#pragma unroll 1
    for (int c = 0; c <= NCH; ++c) {
        if (w >= 4) {
            if (c >= 1) { const int ce = c - 1; const LAS unsigned char* B = L + (ce % SB_NBUF) * SB_STRIDE; const LAS float* OB = (const LAS float*)(L + ST_OB + (ce & 1) * 4096);
                const int tt = lt >> 4, c4 = (lt & 15) * 4; const f32x4 o = *(const LAS f32x4*)(OB + tt * 64 + c4);
                float s = (o[0] + o[1]) + (o[2] + o[3]); s = red16(s); const float mean = s * (1.0f / 64.0f); const f32x4 d = o - mean;
                float ss = (d[0] * d[0] + d[1] * d[1]) + (d[2] * d[2] + d[3] * d[3]); ss = red16(ss); const float rstd = __builtin_amdgcn_rsqf(ss * (1.0f / 64.0f) + 64e-5f);
                const u32x2 gw = *(const LAS u32x2*)(B + RC_G + tt * 128 + c4 * 2); const float bon = ((const LAS float*)(B + RC_BON))[tt];
                const LAS unsigned short* vq = (const LAS unsigned short*)(B + RC_VT4 + (c4 >> 4) * 512 + ((tt >> 2) * 16 + (c4 & 15)) * 8 + (tt & 3) * 2);
                const float vv[4] = {bf1(vq[0]), bf1(vq[4]), bf1(vq[8]), bf1(vq[12])}, gg[4] = {bflo(gw.x), bfhi(gw.x), bflo(gw.y), bfhi(gw.y)}; float y[4];
#pragma unroll
                for (int e = 0; e < 4; ++e) y[e] = (d[e] * rstd * plg[e] + plb[e] + bon * vv[e]) * gg[e];
                u32x2 wv; wv.x = pk2(y[0], y[1]); wv.y = pk2(y[2], y[3]); *(u32x2*)(Y + ((size_t)b * SEQ + ce * 16 + tt) * DM + 512 + h * 64 + c4) = wv; }
        } else {
            if (c + SB_AHEAD < NCH) RW_ISSUE(c + SB_AHEAD);
            if (c < NCH) { const int vb = w; const LAS unsigned char* B = L + (c % SB_NBUF) * SB_STRIDE; LAS float* OB = (LAS float*)(L + ST_OB + (c & 1) * 4096); const int fo = fr * 64 + 16 * g;
                const bf16x8 at0 = *(const LAS bf16x8*)(B + RC_AT + fo), at1 = *(const LAS bf16x8*)(B + RC_AT + 1024 + fo), rt0 = *(const LAS bf16x8*)(B + RC_RT + fo), rt1 = *(const LAS bf16x8*)(B + RC_RT + 1024 + fo);
                const bf16x8 zt = *(const LAS bf16x8*)(B + RC_ZT + fo), rbk = *(const LAS bf16x8*)(B + RC_RBK + fo); const u32x2 v4 = *(const LAS u32x2*)(B + RC_VT4 + vb * 512 + lane * 8);
                u32x4 sw0, sw1; sw0.x = pk2(accS[0][0], accS[0][1]); sw0.y = pk2(accS[0][2], accS[0][3]); sw0.z = pk2(accS[1][0], accS[1][1]); sw0.w = pk2(accS[1][2], accS[1][3]);
                sw1.x = pk2(accS[2][0], accS[2][1]); sw1.y = pk2(accS[2][2], accS[2][3]); sw1.z = pk2(accS[3][0], accS[3][1]); sw1.w = pk2(accS[3][2], accS[3][3]);
                const bf16x8 s0 = __builtin_bit_cast(bf16x8, sw0), s1 = __builtin_bit_cast(bf16x8, sw1);
                f32x4 y = (f32x4){0.f, 0.f, 0.f, 0.f}, accO = y;
                y = MFMA16(at0, s0, y); y = MFMA16(at1, s1, y); accO = MFMA16(rt0, s0, accO); accO = MFMA16(rt1, s1, accO);
                u32x4 bw; bw.x = 0u; bw.y = 0u; bw.z = v4.x; bw.w = v4.y; y = MFMA16(zt, __builtin_bit_cast(bf16x8, bw), y);
                bw.x = pk2(y[0], y[1]); bw.y = pk2(y[2], y[3]); bw.z = 0u; bw.w = 0u; f32x4 u = (f32x4){0.f, 0.f, 0.f, 0.f}; u = MFMA16(zt, __builtin_bit_cast(bf16x8, bw), u);
                bw.x = pk2(u[0], u[1]); bw.y = pk2(u[2], u[3]); bw.z = v4.x; bw.w = v4.y; const bf16x8 uv = __builtin_bit_cast(bf16x8, bw);
                accO = MFMA16(rbk, uv, accO);
#pragma unroll
                for (int r = 0; r < 4; ++r) OB[(4 * g + r) * 64 + 16 * vb + fr] = accO[r];
#pragma unroll
                for (int kb = 0; kb < 4; ++kb) { const f32x4 gc = *(const LAS f32x4*)(B + RC_GC + (16 * kb + 4 * g) * 4); accS[kb] = accS[kb] * gc; accS[kb] = MFMA16(*(const LAS bf16x8*)(B + RC_BKT + kb * 1024 + fo), uv, accS[kb]); } }
            if (c + SB_AHEAD < NCH) asm volatile("s_waitcnt vmcnt(16)" ::: "memory"); else asm volatile("s_waitcnt vmcnt(0)" ::: "memory");
        }
        BAR();
    }
#undef RW_ISSUE
}

__device__ __forceinline__ void moe_route(Frame& F, const float* hres, const float* gffn, const float* router) {
    const int tid = mytid(F), lane = tid & 63, wave = __builtin_amdgcn_readfirstlane(tid >> 6); (void)lane; (void)wave;
    unsigned char* rt = F.ws + WS_RT;
    int* tope = (int*)(rt + RT_TOPE); float* gate = (float*)(rt + RT_GATE); int* rank = (int*)(rt + RT_RANK); float* rstd = (float*)(rt + RT_RSTD); int* hist = (int*)(rt + RT_HIST); int* rowtok = (int*)(rt + RT_ROWTOK);
    LAS float* RW = (LAS float*)F.lds;
    LAS int* LH = (LAS int*)(F.lds + 32768);
    for (int i = tid; i < 8192; i += NTHREADS) RW[i] = router[i];
    if (tid < 16) LH[tid] = 0;
    for (int i = F.blk * NTHREADS + tid; i < 2 * MOE_ROWS; i += F.G * NTHREADS) rowtok[i] = -1;
    __syncthreads();
    const int tpb = NTOK / F.G;
    for (int i = wave; i < tpb; i += NWAVES) { const int t = F.blk * tpb + i;
        const f32x4* hr = (const f32x4*)(hres + (size_t)t * DM) + lane; f32x4 v[4]; float ss = 0.f;
#pragma unroll
        for (int j = 0; j < 4; ++j) { v[j] = hr[64 * j]; ss += (v[j][0] * v[j][0] + v[j][1] * v[j][1]) + (v[j][2] * v[j][2] + v[j][3] * v[j][3]); }
        ss = wave_sum(ss); const float rs = __builtin_amdgcn_rsqf(ss * (1.0f / DM) + NORM_EPS);
        float lg[8];
#pragma unroll
        for (int e = 0; e < 8; ++e) lg[e] = 0.f;
#pragma unroll
        for (int j = 0; j < 4; ++j) { const f32x4 gv = *((const f32x4*)gffn + 64 * j + lane);
#pragma unroll
            for (int c = 0; c < 4; ++c) { const int k = 256 * j + 4 * lane + c; const float xn = v[j][c] * rs * gv[c]; const f32x4 r0 = *(const LAS f32x4*)(RW + k * 8), r1 = *(const LAS f32x4*)(RW + k * 8 + 4);
                lg[0] += xn * r0[0]; lg[1] += xn * r0[1]; lg[2] += xn * r0[2]; lg[3] += xn * r0[3]; lg[4] += xn * r1[0]; lg[5] += xn * r1[1]; lg[6] += xn * r1[2]; lg[7] += xn * r1[3]; } }
#pragma unroll
        for (int e = 0; e < 8; ++e) lg[e] = wave_sum(lg[e]);
        int i1 = 0; float m1 = lg[0];
#pragma unroll
        for (int e = 1; e < 8; ++e) if (lg[e] > m1) { m1 = lg[e]; i1 = e; }
        int i2 = -1; float m2 = -3.0e38f;
#pragma unroll
        for (int e = 0; e < 8; ++e) if (e != i1 && lg[e] > m2) { m2 = lg[e]; i2 = e; }
        if (lane == 0) { const float g1 = 1.0f / (1.0f + __expf(m2 - m1));
            const int r1 = atomicAdd((int*)&LH[i1], 1), r2 = atomicAdd((int*)&LH[8 + i2], 1);
            tope[2 * t] = i1; tope[2 * t + 1] = i2; gate[2 * t] = g1; gate[2 * t + 1] = 1.0f - g1; rank[2 * t] = r1; rank[2 * t + 1] = r2; rstd[t] = rs; }
    }
    __syncthreads();
    if (tid < 16) hist[F.blk * 16 + tid] = LH[tid];
}
__device__ __forceinline__ void moe_gather(Frame& F, int slot, const bf16* hb, bf16* asort) {
    const int tid = mytid(F), lane = tid & 63, wave = __builtin_amdgcn_readfirstlane(tid >> 6); (void)lane; (void)wave;
    unsigned char* rt = F.ws + WS_RT;
    const int* tope = (const int*)(rt + RT_TOPE); const float* gate = (const float*)(rt + RT_GATE); const int* rank = (const int*)(rt + RT_RANK); const float* rstd = (const float*)(rt + RT_RSTD); const int* hist = (const int*)(rt + RT_HIST);
    int* rowtok = (int*)(rt + RT_ROWTOK) + slot * MOE_ROWS; float* rowgate = (float*)(rt + RT_ROWGATE) + slot * MOE_ROWS; float* rowrstd = (float*)(rt + RT_ROWRSTD) + slot * MOE_ROWS;
    int* tilee = (int*)(rt + RT_TILEE) + slot * 256; int* ntiles = (int*)(rt + RT_NTILES);
    LAS int* BASE = (LAS int*)(F.lds + 40960);
    LAS int* TOT = BASE + 8;
    __syncthreads();
    LAS int* HL = (LAS int*)(F.lds + 49152);
    for (int i = tid; i < F.G * 8; i += NTHREADS) HL[i] = hist[(i >> 3) * 16 + slot * 8 + (i & 7)];
    __syncthreads();
    { const int e = tid & 7, part = tid >> 3;
        const int per = (F.G + 63) / 64; int sb = 0, st = 0;
        for (int j = 0; j < per; ++j) { const int bb = part * per + j; if (bb < F.G) { const int c = HL[bb * 8 + e]; st += c; if (bb < F.blk) sb += c; } }
        LAS int* PB = (LAS int*)(F.lds + 49152 + 16384); PB[tid] = sb; PB[512 + tid] = st; }
    __syncthreads();
    if (tid < 8) { const LAS int* PB = (const LAS int*)(F.lds + 49152 + 16384); int before = 0, tot = 0;
        for (int p = 0; p < 64; ++p) { before += PB[p * 8 + tid]; tot += PB[512 + p * 8 + tid]; }
        BASE[tid] = before; TOT[tid] = tot; }
    __syncthreads();
    if (tid == 0) { int ps = 0, nt = 0;
        for (int e = 0; e < 8; ++e) { const int tl = (TOT[e] + 255) >> 8; BASE[e] += ps; if (F.blk == 0) for (int i = 0; i < tl; ++i) tilee[nt + i] = e; ps += tl * 256; nt += tl; }
        if (F.blk == 0) ntiles[slot] = nt; }
    __syncthreads();
    const int tpb = NTOK / F.G;
    for (int i = wave; i < tpb; i += NWAVES) { const int t = F.blk * tpb + i; const int e = tope[2 * t + slot]; const int dest = BASE[e] + rank[2 * t + slot];
        if (lane == 0) { rowtok[dest] = t; rowgate[dest] = gate[2 * t + slot]; rowrstd[dest] = rstd[t]; }
        (void)hb; (void)asort; }
}


__device__ __forceinline__ void mk_publish(unsigned* ctr) {
    asm volatile("s_waitcnt vmcnt(0)" ::: "memory");
    __syncthreads();
    if (threadIdx.x == 0) { __builtin_amdgcn_fence(__ATOMIC_RELEASE, "agent"); asm volatile("s_waitcnt vmcnt(0)" ::: "memory"); (void)__hip_atomic_fetch_add(ctr, 1u, __ATOMIC_RELAXED, __HIP_MEMORY_SCOPE_AGENT); }
}
__device__ __forceinline__ void mk_wait(unsigned* ctr, unsigned need) {
    if (threadIdx.x == 0) { unsigned sp = 0;
        while (__hip_atomic_load(ctr, __ATOMIC_RELAXED, __HIP_MEMORY_SCOPE_AGENT) < need) { __builtin_amdgcn_s_sleep(4); if (++sp > (1u << 24)) break; }
        __builtin_amdgcn_fence(__ATOMIC_ACQUIRE, "agent"); asm volatile("s_waitcnt vmcnt(0)" ::: "memory"); }
    __syncthreads();
}

#ifndef MK_PER_PHASE
#define MK_PER_PHASE 0
#endif
constexpr int N_PHASES = 17;
__global__ void __launch_bounds__(NTHREADS, 2) mk_fwd(Params prm) {
    extern __shared__ __attribute__((aligned(16))) unsigned char lds_raw[];
    Frame F;
    F.lds = (LAS unsigned char*)lds_raw;
    F.blk = blockIdx.x; F.G = gridDim.x; F.out = prm.out; F.ws = prm.ws; F.wv = __builtin_amdgcn_readfirstlane(threadIdx.x >> 6);
    volatile LAS unsigned* MISC = (volatile LAS unsigned*)(F.lds + MISC_OFF);
    for (int u = threadIdx.x; u < (LDS_BYTES - LDSCTL_OFF) / 4; u += NTHREADS) ((LAS unsigned*)(F.lds + LDSCTL_OFF))[u] = 0u;
    __syncthreads();
    if (threadIdx.x == 0) { LAS unsigned long long* tab = (LAS unsigned long long*)(F.lds + PTAB_OFF);
#pragma unroll
        for (int i_ = 0; i_ < 33; ++i_) tab[i_] = (unsigned long long)prm.in[i_]; }
    __syncthreads();
    const int lo = prm.ph_lo, hi = prm.ph_hi;
    unsigned* ctl = (unsigned*)(F.ws + WS_CTL);
    XcdBarrier bar; bar.bar = ctl + CW_BAR; bar.x = 0; bar.st = nullptr;
    if (hi - lo > 1) bar = xcd_barrier_post(ctl + CW_BAR, MISC + 8);
    unsigned char* ws = F.ws;
    bf16* hb = (bf16*)(ws + WS_HB); bf16* z = (bf16*)(ws + WS_Z); bf16* act = (bf16*)(ws + WS_Z); bf16* y = (bf16*)(ws + WS_Y); bf16* asort = (bf16*)(ws + WS_Y);
    float* ssq = (float*)(ws + WS_SSQ);
    bf16* opart = (bf16*)F.out; float* lse = (float*)((unsigned char*)F.out + 48 * MiB);
    unsigned char* rt = ws + WS_RT;
#define IN(k) (lo <= (k) && (k) < hi)
#ifndef PROBE_MASK
#define PROBE_MASK 0
#endif
#if PROBE_MASK
#define STAMP(k) do { if (blockIdx.x == 0 && threadIdx.x == 0) ((volatile LAS unsigned long long*)(F.lds + LDSCTL_OFF + 2048))[k] = __builtin_amdgcn_s_memrealtime(); } while (0)
#else
#define STAMP(k) do { } while (0)
#endif
#define SEAM(k) do { if (IN(k) && IN((k) + 1)) xcd_barrier(bar); STAMP((k) + 1); } while (0)

    STAMP(0);
    if (IN(0)) p0_prologue(F, 0);
    SEAM(0);
#pragma unroll 1
    for (int layer = 0; layer < 2; ++layer) {
        const int pb = layer == 0 ? 1 : 7;
        if (IN(pb)) {
            pg8::Gemm g{hb, (const bf16*)(ws + WS_WIN) + (size_t)layer * NPADW * DM, NTOK, NPADW, DM, F.wv}; pg8::StaticOrder S; S.init(NTOK / 256, NPADW / 256, F.G, F.blk);
            pg8::EpiZ E{z, INW, INW, ssq};
            pg8::gemm_phase<pg8::EpiZ, pg8::StaticOrder, true, true>(F.lds, g, S, E);
        }
        SEAM(pb);
#if defined(PROBE_SUB)
        const unsigned long long tsub0 = __builtin_amdgcn_s_memrealtime();
#define PSUB(cls, t0) do { if (threadIdx.x == 0) ((unsigned long long*)(F.ws + 32768))[layer * 4 + (cls)] = __builtin_amdgcn_s_memrealtime() - (t0); } while (0)
#else
#define PSUB(cls, t0) do { } while (0)
#endif
        unsigned char* recs = ws + WS_MOEW;
        unsigned char* gcon = ws + WS_MOEW + (size_t)NB * 4 * (SEQ / 16) * RC_STRIDE;
        const GlaAux gax{ws + WS_GLAQT, ws + WS_GLAKB};
        if (IN(pb + 1)) {
            const int wi = F.blk, nw = F.G;
            { const RwkvP RP{inptr(F, IN_MU) + layer * 896, inptr(F, IN_W0) + layer * 256, inptr(F, IN_W2) + layer * 32 * 256, inptr(F, IN_A0) + layer * 256, inptr(F, IN_A2) + layer * 32 * 256, inptr(F, IN_G2) + layer * 64 * 256,
                             inptr(F, IN_KK) + layer * 256, inptr(F, IN_KA) + layer * 256, inptr(F, IN_RK) + layer * 256, inptr(F, IN_RLG) + layer * 256, inptr(F, IN_RLB) + layer * 256};
                const int tid_ = mytid(F), lane_ = tid_ & 63, w_ = __builtin_amdgcn_readfirstlane(tid_ >> 6);
#pragma unroll 1
                for (int h = 0; h < 4; ++h) {
                    rwkv_prep_init(F, RP, h); BAR();
                    u32x4 cur[2], prv[2], ncur[2], nprv[2];
#pragma unroll
                    for (int q = 0; q < 2; ++q) { cur[q] = (u32x4){0u, 0u, 0u, 0u}; prv[q] = cur[q]; ncur[q] = cur[q]; nprv[q] = cur[q]; }
                    if (wi < 2048) rwkv_prep_load(z, wi >> 8, h, wi & 255, w_, lane_, cur, prv);
#pragma unroll 1
                    for (int it = wi; it < 2048; it += nw) { const int nx = it + nw;
                        if (nx < 2048) rwkv_prep_load(z, nx >> 8, h, nx & 255, w_, lane_, ncur, nprv);
                        rwkv_prep_item(F, recs + (size_t)(((it >> 8) * 4 + h) * 256 + (it & 255)) * RC_STRIDE, RP, h, cur, prv);
#pragma unroll
                        for (int q = 0; q < 2; ++q) { cur[q] = ncur[q]; prv[q] = nprv[q]; } }
                    BAR(); } }
            attn_qknorm(F, z, inptr(F, IN_QG) + layer * 64, inptr(F, IN_KG) + layer * 64);
            for (int item = wi; item < 512; item += nw) conv_item(F, z, y, inptr(F, IN_CW) + layer * 31 * 256, inptr(F, IN_CB) + layer * 256, inptr(F, IN_CLG) + layer * 256, inptr(F, IN_CLB) + layer * 256, item);
            gla_items<0>(F, z, gcon, (float*)(ws + WS_GLAEC), gax, y, inptr(F, IN_GG2) + layer * 16 * 128, inptr(F, IN_GGB) + layer * 128, inptr(F, IN_GNG) + layer * 64, wi, nw, 0);
        }
        SEAM(pb + 1);
        if (IN(pb + 2)) {
            unsigned* cA = ctl + 12288 + layer * 128;
            unsigned* cB = ctl + 12288 + layer * 128 + 64;
            if (F.blk < 32) {
                const RwkvP RP{inptr(F, IN_MU) + layer * 896, inptr(F, IN_W0) + layer * 256, inptr(F, IN_W2) + layer * 32 * 256, inptr(F, IN_A0) + layer * 256, inptr(F, IN_A2) + layer * 32 * 256, inptr(F, IN_G2) + layer * 64 * 256,
                               inptr(F, IN_KK) + layer * 256, inptr(F, IN_KA) + layer * 256, inptr(F, IN_RK) + layer * 256, inptr(F, IN_RLG) + layer * 256, inptr(F, IN_RLB) + layer * 256};
                rwkv_state(F, recs, y, RP, F.blk >> 2, F.blk & 3);
            } else {
                const int wi = F.blk - 32, nw = F.G - 32;
                if (F.blk < 64) { gla_scan(F, gcon, (const float*)(ws + WS_GLAEC), (F.blk - 32) >> 2, (F.blk - 32) & 3); mk_publish(cA); }
                { const int full = 3072 / nw, rem = 3072 - full * nw;
                    for (int rd = 0; rd < full; ++rd) attn_tile(F.lds, z, opart, lse, inptr(F, IN_RELB), rd * nw + wi, mytid(F));
                    if (wi >= 32 && wi - 32 < rem) attn_tile(F.lds, z, opart, lse, inptr(F, IN_RELB), full * nw + wi - 32, mytid(F)); }
                mk_publish(cB);
                mk_wait(cA, 32u);
                gla_items<1>(F, z, gcon, (float*)(ws + WS_GLAEC), gax, y, inptr(F, IN_GG2) + layer * 16 * 128, inptr(F, IN_GGB) + layer * 128, inptr(F, IN_GNG) + layer * 64, wi, nw, 32);
                mk_wait(cB, (unsigned)nw);
                attn_merge(F, opart, lse, y, wi, nw);
            }
        }
        SEAM(pb + 2);
        if (IN(pb + 3)) {
            pg8::Gemm g{y, (const bf16*)(ws + WS_WOUT) + (size_t)layer * DM * DM, NTOK, DM, DM, F.wv}; pg8::StaticOrder S; S.init(NTOK / 256, DM / 256, F.G, F.blk);
            pg8::EpiRes E{layer == 0 ? inptr(F, IN_X) : (const float*)nullptr, hb, layer == 0 ? (float*)nullptr : F.out, hb, ssq};
            pg8::gemm_phase<pg8::EpiRes, pg8::StaticOrder, true, true>(F.lds, g, S, E);
        }
        SEAM(pb + 3);
        if (layer == 0) {
            if (IN(5)) {
                pg8::Gemm g{hb, (const bf16*)(ws + WS_WGU), NTOK, 2 * DFF, DM, F.wv}; pg8::StaticOrder S; S.init(NTOK / 256, 2 * DFF / 256, F.G, F.blk);
                pg8::EpiSwiGLU<false> E{act, ssq, nullptr};
                pg8::gemm_phase<pg8::EpiSwiGLU<false>, pg8::StaticOrder, true, true>(F.lds, g, S, E);
            }
            SEAM(5);
            if (IN(6)) {
                pg8::Gemm g{act, (const bf16*)(ws + WS_WD), NTOK, DM, DFF, F.wv}; pg8::StaticOrder S; S.init(NTOK / 256, DM / 256, F.G, F.blk);
                pg8::EpiRes E{nullptr, hb, nullptr, hb, ssq};
                pg8::gemm_phase<pg8::EpiRes, pg8::StaticOrder, true, true>(F.lds, g, S, E);
            }
            SEAM(6);
        }
    }
    if (IN(11)) { moe_route(F, F.out, inptr(F, IN_FFNG) + DM, inptr(F, IN_ROUTER)); __syncthreads(); p0_prologue(F, 1); }
    SEAM(11);
    if (IN(12)) moe_gather(F, 0, hb, asort);
    SEAM(12);
#pragma unroll 1
    for (int slot = 0; slot < 2; ++slot) {
        const int pg = 13 + 2 * slot;
        const int* tilee = (const int*)(rt + RT_TILEE) + slot * 256;
        if (IN(pg)) {
            const int nt = __builtin_amdgcn_readfirstlane(((const int*)(rt + RT_NTILES))[slot]);
            pg8::Gemm g{hb, (const bf16*)(ws + WS_MOEW), nt * 256, 2 * DFF, DM, F.wv}; pg8::StaticOrder S; S.init(nt, 2 * DFF / 256, F.G, F.blk, tilee, MOEW_E_BYTES);
            pg8::EpiSwiGLU<true> E{act, nullptr, (const float*)(rt + RT_ROWRSTD) + slot * MOE_ROWS};
            pg8::gemm_phase_g<pg8::EpiSwiGLU<true>, pg8::StaticOrder, true, true>(F.lds, g, S, E, (const int*)(rt + RT_ROWTOK) + slot * MOE_ROWS);
        }
        SEAM(pg);
        if (IN(pg + 1)) {
            const int nt = __builtin_amdgcn_readfirstlane(((const int*)(rt + RT_NTILES))[slot]);
            pg8::Gemm g{act, (const bf16*)(ws + WS_MOEW + MOEW_GU_BYTES), nt * 256, DM, DFF, F.wv}; pg8::StaticOrder S; S.init(nt, DM / 256, F.G, F.blk, tilee, MOEW_E_BYTES);
            pg8::EpiMoeDown E{F.out, (const int*)(rt + RT_ROWTOK) + slot * MOE_ROWS, (const float*)(rt + RT_ROWGATE) + slot * MOE_ROWS};
            pg8::gemm_phase<pg8::EpiMoeDown, pg8::StaticOrder, true, true>(F.lds, g, S, E);
            if (slot == 0) moe_gather(F, 1, hb, asort);
        }
        if (slot == 0) SEAM(pg + 1);
    }
#if PROBE_MASK
    __syncthreads();
    if (blockIdx.x == 0 && threadIdx.x == 0) { STAMP(N_PHASES); volatile LAS unsigned long long* ts = (volatile LAS unsigned long long*)(F.lds + LDSCTL_OFF + 2048); unsigned long long tot = 0;
        for (int k = 0; k < N_PHASES; ++k) if ((PROBE_MASK >> k) & 1) tot += ts[k + 1] - ts[k];
#if defined(PROBE_SUB)
        tot = (PROBE_SUB == 0) ? ((volatile unsigned long long*)(F.ws + 32768))[0] : ((volatile unsigned long long*)(F.ws + 32768))[PROBE_SUB] + ((volatile unsigned long long*)(F.ws + 32768))[4 + PROBE_SUB];
#endif
        const unsigned long long t0 = __builtin_amdgcn_s_memrealtime(); while (__builtin_amdgcn_s_memrealtime() - t0 < tot) __builtin_amdgcn_s_sleep(8); }
#endif
#undef IN
#undef SEAM
}

extern "C" void kernel_launch(void* const* d_in, const int* in_sizes, int n_in, void* d_out, int out_size, void* d_ws, size_t ws_size, hipStream_t stream) {
    static int grid = 0;
    if (grid == 0) {
        if (n_in != 33 || out_size != NTOK * DM || ws_size < WS_TOTAL) { fprintf(stderr, "kernel_launch: unexpected problem (n_in %d out %d ws %zu)\n", n_in, out_size, ws_size); grid = -1; return; }
        int dev = 0, cus = 0;
        if (hipGetDevice(&dev) != hipSuccess || hipDeviceGetAttribute(&cus, hipDeviceAttributeMultiprocessorCount, dev) != hipSuccess) { grid = -1; return; }
        if (hipFuncSetAttribute((const void*)mk_fwd, hipFuncAttributeMaxDynamicSharedMemorySize, LDS_BYTES) != hipSuccess) { fprintf(stderr, "kernel_launch: hipFuncSetAttribute failed\n"); grid = -1; return; }
        (void)hipGetLastError();
        grid = cus < 256 ? cus : 256;
        if (grid != 256) fprintf(stderr, "kernel_launch: %d CUs (built for 256)\n", cus);
    }
    if (grid < 0) return;
    (void)hipMemsetAsync((char*)d_ws + WS_CTL, 0, CTL_ZERO_BYTES, stream);
    Params p{};
    for (int i = 0; i < 33; ++i) p.in[i] = (const float*)d_in[i];
    p.out = (float*)d_out; p.ws = (unsigned char*)d_ws;
#if MK_PER_PHASE
    for (int k = 0; k < N_PHASES; ++k) { p.ph_lo = k; p.ph_hi = k + 1; hipLaunchKernelGGL(mk_fwd, dim3(grid), dim3(NTHREADS), LDS_BYTES, stream, p); }
#else
    p.ph_lo = 0; p.ph_hi = N_PHASES;
    hipLaunchKernelGGL(mk_fwd, dim3(grid), dim3(NTHREADS), LDS_BYTES, stream, p);
#endif
}
```

```cpp
#include <hip/hip_runtime.h>
#include <cstdio>
#include <cstdint>

#define LAS __attribute__((address_space(3)))
#define GAS __attribute__((address_space(1)))
typedef unsigned short bf16;
typedef short bf16x8 __attribute__((ext_vector_type(8)));
typedef short s16x4 __attribute__((ext_vector_type(4)));
typedef float f32x4 __attribute__((ext_vector_type(4)));
typedef float f32x2 __attribute__((ext_vector_type(2)));
typedef unsigned u32x4 __attribute__((ext_vector_type(4)));
typedef unsigned u32x2 __attribute__((ext_vector_type(2)));

constexpr int DM = 1024, NB = 8, SEQ = 4096, NTOK = NB * SEQ, INW = 2960, NPADW = 3072, DFF = 2816, NEXP = 8;
constexpr int ZA = 0, ZB = 768, ZC = 1280, ZD = 2176;
constexpr float NORM_EPS = 1e-6f;
constexpr int MOE_ROWS = NTOK + NEXP * 256;

constexpr size_t MiB = 1u << 20;
constexpr size_t WS_CTL = 0, CTL_ZERO_BYTES = 64 * 1024;
constexpr size_t WS_WIN = 1 * MiB;
constexpr size_t WS_WOUT = 13 * MiB;
constexpr size_t WS_WGU = 17 * MiB;
constexpr size_t WS_WD = 28 * MiB;
constexpr size_t WS_SSQ = 34 * MiB;
constexpr size_t WS_RT = 36 * MiB;
constexpr size_t WS_HB = 40 * MiB;
constexpr size_t WS_Z = 104 * MiB;
constexpr size_t WS_Y = 297 * MiB;
constexpr size_t WS_MOEW = 367 * MiB;
constexpr size_t WS_END = 499 * MiB;
constexpr size_t WS_GLAEC = 499 * MiB;
constexpr size_t WS_GLAQT = 500 * MiB;
constexpr size_t WS_GLAKB = 289 * MiB;
constexpr size_t WS_TOTAL = 508 * MiB;
constexpr size_t MOEW_GU_BYTES = (size_t)2 * DFF * DM * 2, MOEW_D_BYTES = (size_t)DM * DFF * 2, MOEW_E_BYTES = MOEW_GU_BYTES + MOEW_D_BYTES;
static_assert(WS_Z + (size_t)MOE_ROWS * DFF * 2 <= WS_Y && WS_Y + (size_t)MOE_ROWS * DM * 2 <= WS_MOEW && WS_MOEW + NEXP * MOEW_E_BYTES <= WS_END, "ws map");
constexpr size_t WS_OP = WS_HB;
constexpr size_t WS_LSE = WS_HB + 48 * MiB;
constexpr size_t RT_TOPE = 0;
constexpr size_t RT_GATE = RT_TOPE + (size_t)NTOK * 8;
constexpr size_t RT_RANK = RT_GATE + (size_t)NTOK * 8;
constexpr size_t RT_RSTD = RT_RANK + (size_t)NTOK * 8;
constexpr size_t RT_HIST = RT_RSTD + (size_t)NTOK * 4;
constexpr size_t RT_ROWTOK = RT_HIST + 256 * 16 * 4;
constexpr size_t RT_ROWGATE = RT_ROWTOK + (size_t)2 * MOE_ROWS * 4;
constexpr size_t RT_ROWRSTD = RT_ROWGATE + (size_t)2 * MOE_ROWS * 4;
constexpr size_t RT_TILEE = RT_ROWRSTD + (size_t)2 * MOE_ROWS * 4;
constexpr size_t RT_NTILES = RT_TILEE + 2 * 256 * 4;
static_assert(RT_NTILES + 64 <= 4 * MiB, "routing arrays");

constexpr int CW_BAR = 1024;

constexpr int RING_BYTES = 131072, LDSCTL_OFF = RING_BYTES, MISC_OFF = LDSCTL_OFF + 320, LDS_BYTES = 147456;
constexpr int NWAVES = 8, NTHREADS = 512;

#define LDS_WAIT() asm volatile("s_waitcnt lgkmcnt(0)" ::: "memory")
#define VM_WAIT() asm volatile("s_waitcnt vmcnt(0)" ::: "memory")
#define BAR() do { asm volatile("s_waitcnt lgkmcnt(0)" ::: "memory"); __builtin_amdgcn_s_barrier(); asm volatile("" ::: "memory"); } while (0)
__device__ __forceinline__ unsigned f2bf(float f) { unsigned u = __builtin_bit_cast(unsigned, f); return (u + 0x7fffu + ((u >> 16) & 1u)) >> 16; }
typedef __bf16 bf16x2_hw __attribute__((ext_vector_type(2)));
__device__ __forceinline__ unsigned pk2(float lo, float hi) { const f32x2 v = {lo, hi}; const bf16x2_hw b = __builtin_convertvector(v, bf16x2_hw); return __builtin_bit_cast(unsigned, b); }
__device__ __forceinline__ float bflo(unsigned w) { return __builtin_bit_cast(float, w << 16); }
__device__ __forceinline__ float bfhi(unsigned w) { return __builtin_bit_cast(float, w & 0xffff0000u); }
__device__ __forceinline__ float bf1(bf16 b) { return __builtin_bit_cast(float, (unsigned)b << 16); }
__device__ __forceinline__ float wave_sum(float v) {
#pragma unroll
    for (int o = 1; o < 64; o <<= 1) v += __shfl_xor(v, o);
    return v;
}
#define DPP_ADD(v, ctrl) ((v) + __builtin_bit_cast(float, __builtin_amdgcn_update_dpp(0, __builtin_bit_cast(int, (v)), (ctrl), 0xf, 0xf, true)))
__device__ __forceinline__ float red8(float v) { v = DPP_ADD(v, 0xB1); v = DPP_ADD(v, 0x4E); v = DPP_ADD(v, 0x141); return v; }
__device__ __forceinline__ float red16(float v) { v = DPP_ADD(v, 0xB1); v = DPP_ADD(v, 0x4E); v = DPP_ADD(v, 0x141); v = DPP_ADD(v, 0x140); return v; }
__device__ __forceinline__ float sigmoidf_(float x) { return 1.0f / (1.0f + __expf(-x)); }
__device__ __forceinline__ float siluf_(float x) { return x / (1.0f + __expf(-x)); }
__device__ __forceinline__ float softplusf_(float x) { return fmaxf(x, 0.f) + __logf(1.0f + __expf(-fabsf(x))); }
__device__ __forceinline__ float tanhf_(float x) { const float e = __expf(2.0f * x); return 1.0f - 2.0f / (e + 1.0f); }
__device__ __forceinline__ void unpack8(const u32x4 w, float (&f)[8]) {
    f[0] = bflo(w.x); f[1] = bfhi(w.x); f[2] = bflo(w.y); f[3] = bfhi(w.y); f[4] = bflo(w.z); f[5] = bfhi(w.z); f[6] = bflo(w.w); f[7] = bfhi(w.w);
}

namespace pg8 {
#define PG8_LAS __attribute__((address_space(3)))
typedef unsigned short bf16_t;
constexpr int BM = 256, BK = 64, HALF = 128, HTB = HALF * BK * 2  , STAGE_BYTES = 8 * HTB, NXCD = 8, WGM = 8;

__host__ __device__ __forceinline__ int lds_byte(int r, int c) { const int st = (r >> 4) * 2 + (c >> 5), rr = r & 15, cc = c & 31, ob = rr * 64 + cc * 2; return st * 1024 + (ob ^ (((ob >> 9) & 1) << 5)); }
__host__ __device__ __forceinline__ void stage_rc(int b, int& R, int& C) { const int st = b / 1024, sb = b % 1024, swz = sb ^ (((sb >> 9) & 1) << 5); R = (st >> 1) * 16 + swz / 64; C = (st & 1) * 32 + (swz % 64) / 2; }
__host__ __device__ __forceinline__ int perm32(int rho) { const int n = rho >> 4, i = rho & 15; return 8 * (i >> 2) + 4 * n + (i & 3); }

struct Unit { int pm, pn; };
struct Gemm { const bf16_t* A; const bf16_t* Bt; int M, N, K, wv; };

struct StaticOrder {
    int nM, nN, nwg, G, c; const int* tile_e; size_t estride;
    __device__ void init(int nM_, int nN_, int G_, int c_, const int* te = nullptr, size_t es = 0) { nM = nM_; nN = nN_; nwg = nM * nN; G = G_; c = c_; tile_e = te; estride = es; }
    __device__ bool next(int i, Unit& u) const {
        const long L = (long)i * G + c; if (L >= nwg) return false;
        int wgid = (int)L; { const int q = nwg / NXCD, r = nwg % NXCD, xcd = wgid % NXCD, off = wgid / NXCD; wgid = (xcd < r ? xcd * (q + 1) : r * (q + 1) + (xcd - r) * q) + off; }
        const int nig = WGM * nN, gid = wgid / nig, fm = gid * WGM, gsz = (nM - fm) < WGM ? (nM - fm) : WGM;
        u.pm = fm + ((wgid % nig) % gsz); u.pn = (wgid % nig) / gsz; return true;
    }
    __device__ __forceinline__ size_t bofs(const Unit& u, size_t tstep) const { return (size_t)u.pn * tstep + (tile_e ? (size_t)__builtin_amdgcn_readfirstlane(tile_e[u.pm]) * estride : (size_t)0); }
    __device__ __forceinline__ void a_ready(const Unit&) const {}
    __device__ __forceinline__ void done(const Unit&) const {}
};

__device__ __forceinline__ unsigned cvt_pk_bf16(float lo, float hi) { unsigned r; asm volatile("v_cvt_pk_bf16_f32 %0, %1, %2" : "=v"(r) : "v"(lo), "v"(hi)); return r; }

__device__ __forceinline__ float row_rstd16(const float* ssq, int r, int fq) {
    const f32x4 p = *(const f32x4*)(ssq + (size_t)r * 16 + 4 * fq);
    float s = (p[0] + p[1]) + (p[2] + p[3]); s += __shfl_xor(s, 16); s += __shfl_xor(s, 32);
    return __builtin_amdgcn_rsqf(s * (1.0f / DM) + NORM_EPS);
}

struct EpiZ {
    static constexpr bool PERM = true, AFTER_DRAIN = false;
    bf16_t* Z; int ldc, ncols; const float* ssq;
    __device__ __forceinline__ void operator()(const f32x4 (&acc)[2][2][4][2], const Unit& u, int wr, int wc, int fr, int fq) const {
        const int row0 = u.pm * BM + wr * 64 + fr, col0 = u.pn * BM + wc * 32 + 8 * fq;
#pragma unroll
        for (int ai = 0; ai < 2; ++ai)
#pragma unroll
            for (int m = 0; m < 4; ++m) { const int r = row0 + ai * HALF + m * 16; const float rs = row_rstd16(ssq, r, fq); bf16_t* rowp = Z + (size_t)r * ldc + col0;
#pragma unroll
                for (int bj = 0; bj < 2; ++bj) { const f32x4 v0 = acc[ai][bj][m][0] * rs, v1 = acc[ai][bj][m][1] * rs;
                    u32x4 w; w.x = cvt_pk_bf16(v0[0], v0[1]); w.y = cvt_pk_bf16(v0[2], v0[3]); w.z = cvt_pk_bf16(v1[0], v1[1]); w.w = cvt_pk_bf16(v1[2], v1[3]);
                    if (col0 + bj * HALF < ncols) *(u32x4*)(rowp + bj * HALF) = w; } }
    }
};
template <bool MOE> struct EpiSwiGLU {
    static constexpr bool PERM = true, AFTER_DRAIN = false;
    bf16_t* O; const float* ssq; const float* row_rstd;
    __device__ __forceinline__ void operator()(const f32x4 (&acc)[2][2][4][2], const Unit& u, int wr, int wc, int fr, int fq) const {
        const int row0 = u.pm * BM + wr * 64 + fr, col0 = u.pn * HALF + wc * 32 + 8 * fq;
#pragma unroll
        for (int ai = 0; ai < 2; ++ai)
#pragma unroll
            for (int m = 0; m < 4; ++m) { const int r = row0 + ai * HALF + m * 16; float rs; if (MOE) rs = row_rstd[r]; else rs = row_rstd16(ssq, r, fq);
                const f32x4 g0 = acc[ai][0][m][0] * rs, g1 = acc[ai][0][m][1] * rs, u0 = acc[ai][1][m][0] * rs, u1 = acc[ai][1][m][1] * rs; f32x4 a0, a1;
#pragma unroll
                for (int j = 0; j < 4; ++j) { a0[j] = g0[j] * __builtin_amdgcn_rcpf(1.0f + __expf(-g0[j])) * u0[j]; a1[j] = g1[j] * __builtin_amdgcn_rcpf(1.0f + __expf(-g1[j])) * u1[j]; }
                u32x4 w; w.x = cvt_pk_bf16(a0[0], a0[1]); w.y = cvt_pk_bf16(a0[2], a0[3]); w.z = cvt_pk_bf16(a1[0], a1[1]); w.w = cvt_pk_bf16(a1[2], a1[3]);
                *(u32x4*)(O + (size_t)r * DFF + col0) = w; }
    }
};
struct EpiRes {
    static constexpr bool PERM = false, AFTER_DRAIN = false;
    const float* base; const bf16_t* baseb; float* out; bf16_t* hb; float* ssq;
    __device__ __forceinline__ void operator()(const f32x4 (&acc)[2][2][4][2], const Unit& u, int wr, int wc, int fr, int fq) const {
        const int col0 = u.pn * BM + wc * 32 + 4 * fq;
#pragma unroll
        for (int ai = 0; ai < 2; ++ai)
#pragma unroll
            for (int m = 0; m < 4; ++m) { const int r = u.pm * BM + ai * HALF + wr * 64 + m * 16 + fr; const size_t off = (size_t)r * DM + col0; float ss = 0.f;
#pragma unroll
                for (int bj = 0; bj < 2; ++bj)
#pragma unroll
                    for (int n = 0; n < 2; ++n) { f32x4 bv;
                        if (base) bv = *(const f32x4*)(base + off + bj * HALF + n * 16);
                        else { const u32x2 bw = *(const u32x2*)(baseb + off + bj * HALF + n * 16); bv = (f32x4){bflo(bw.x), bfhi(bw.x), bflo(bw.y), bfhi(bw.y)}; }
                        const f32x4 v = bv + acc[ai][bj][m][n];
                        if (out) *(f32x4*)(out + off + bj * HALF + n * 16) = v;
                        ss += (v[0] * v[0] + v[1] * v[1]) + (v[2] * v[2] + v[3] * v[3]);
                        { u32x2 w; w.x = cvt_pk_bf16(v[0], v[1]); w.y = cvt_pk_bf16(v[2], v[3]); *(u32x2*)(hb + off + bj * HALF + n * 16) = w; } }
                ss += __shfl_xor(ss, 16); ss += __shfl_xor(ss, 32);
                if (fq == 0) ssq[(size_t)r * 16 + u.pn * 4 + wc] = ss;
                if (m & 1) asm volatile("" ::: "memory"); }
    }
};
struct EpiMoeDown {
    static constexpr bool PERM = false, AFTER_DRAIN = false;
    float* out; const bf16_t* baseb; const int* row_tok; const float* row_gate;
    __device__ __forceinline__ void operator()(const f32x4 (&acc)[2][2][4][2], const Unit& u, int wr, int wc, int fr, int fq) const {
        const int col0 = u.pn * BM + wc * 32 + 4 * fq;
#pragma unroll
        for (int ai = 0; ai < 2; ++ai)
#pragma unroll
            for (int m = 0; m < 4; ++m) { const int r = u.pm * BM + ai * HALF + wr * 64 + m * 16 + fr; const int tok = row_tok[r]; const float gt = row_gate[r];
                if (tok >= 0) { float* op = out + (size_t)tok * DM + col0; const bf16_t* bp = baseb + (size_t)tok * DM + col0;
#pragma unroll
                    for (int bj = 0; bj < 2; ++bj)
#pragma unroll
                        for (int n = 0; n < 2; ++n) { float* p = op + bj * HALF + n * 16; f32x4 bv;
                            if (baseb) { const u32x2 bw = *(const u32x2*)(bp + bj * HALF + n * 16); bv = (f32x4){bflo(bw.x), bfhi(bw.x), bflo(bw.y), bfhi(bw.y)}; } else bv = *(const f32x4*)p;
                            *(f32x4*)p = bv + acc[ai][bj][m][n] * gt; } }
                if (m & 1) asm volatile("" ::: "memory"); }
    }
};

template <class Epi, class Sched, bool ALIGN_EPI = false, bool SP2 = false>
__device__ __forceinline__ void gemm_phase(PG8_LAS unsigned char* lds, const Gemm g, const Sched& S, const Epi& E) {
    int lid_; asm volatile("v_mbcnt_lo_u32_b32 %0, -1, 0\n\tv_mbcnt_hi_u32_b32 %0, -1, %0" : "=v"(lid_)); int tid_ = g.wv * 64 + lid_; asm volatile("" : "+v"(tid_));
    const int tid = tid_, wid = __builtin_amdgcn_readfirstlane(tid >> 6), lane = tid & 63, wr = wid >> 2, wc = wid & 3, fr = lane & 15, fq = lane >> 4;
    const int K = g.K, nt = K / BK;
    unsigned voffA[2], voffB[2];
#pragma unroll
    for (int i = 0; i < 2; ++i) { int R, C; stage_rc(tid * 16 + i * 8192, R, C); const int Rb = Epi::PERM ? ((R & ~31) + perm32(R & 31)) : R;
        voffA[i] = (unsigned)(R * K + C) * 2u; voffB[i] = (unsigned)(Rb * K + C) * 2u; }
    const size_t kstep = (size_t)(BK * 2);
    const size_t hstep = (size_t)HALF * K * 2;
    const size_t tstep = 2 * hstep;
    const unsigned ldsw = (unsigned)wid * 1024u;
    const int aoff = lds_byte(wr * 64 + fr, fq * 8), boff = lds_byte(wc * 32 + fr, fq * 8);
#define PG8_SA(b, h) (((b) * 2 + (h)) * HTB)
#define PG8_SB(b, h) ((4 + (b) * 2 + (h)) * HTB)
#define PG8_STAGE(bufoff, gbase, voff) do { _Pragma("unroll") for (int _i = 0; _i < 2; ++_i) \
        __builtin_amdgcn_global_load_lds((const unsigned*)((const char*)(gbase) + (voff)[_i]), (PG8_LAS unsigned*)(lds + (bufoff) + ldsw + _i * 8192), 16, 0, 0); } while (0)
#define PG8_LDA(dst, b, h) do { _Pragma("unroll") for (int m = 0; m < 4; ++m) _Pragma("unroll") for (int k = 0; k < 2; ++k) dst[m][k] = *(const PG8_LAS bf16x8*)(lds + PG8_SA(b, h) + aoff + m * 2048 + k * 1024); } while (0)
#define PG8_LDB(dst, b, h) do { _Pragma("unroll") for (int n = 0; n < 2; ++n) _Pragma("unroll") for (int k = 0; k < 2; ++k) dst[n][k] = *(const PG8_LAS bf16x8*)(lds + PG8_SB(b, h) + boff + n * 2048 + k * 1024); } while (0)
#define PG8_MMA(ai, bj, At, Bt) do { __builtin_amdgcn_s_setprio(1); _Pragma("unroll") for (int m = 0; m < 4; ++m) _Pragma("unroll") for (int n = 0; n < 2; ++n) _Pragma("unroll") for (int k = 0; k < 2; ++k) \
        acc[ai][bj][m][n] = __builtin_amdgcn_mfma_f32_16x16x32_bf16(Bt[n][k], At[m][k], acc[ai][bj][m][n], 0, 0, 0); __builtin_amdgcn_s_setprio(0); } while (0)
#define PG8_WAIT_V(n) asm volatile("s_waitcnt vmcnt(" #n ")" ::: "memory")
#define PG8_WAIT_L(n) asm volatile("s_waitcnt lgkmcnt(" #n ")" ::: "memory")
#define PG8_BAR __builtin_amdgcn_s_barrier()
#define PG8_SCHED __builtin_amdgcn_sched_barrier(0)
    Unit cur, nxt; int ui = 0;
    if (!S.next(0, cur)) return;
    f32x4 acc[2][2][4][2];
#pragma unroll
    for (int a = 0; a < 2; ++a)
#pragma unroll
        for (int b = 0; b < 2; ++b)
#pragma unroll
            for (int m = 0; m < 4; ++m)
#pragma unroll
                for (int n = 0; n < 2; ++n) acc[a][b][m][n] = (f32x4){0.f, 0.f, 0.f, 0.f};
    bf16x8 At[4][2], B0[2][2], B1[2][2];
    const char* cA = (const char*)g.A + (size_t)cur.pm * tstep; const char* cB = (const char*)g.Bt + S.bofs(cur, tstep);
    S.a_ready(cur);
    if constexpr (SP2) {
        PG8_STAGE(PG8_SB(0, 0), cB, voffB); PG8_STAGE(PG8_SB(0, 1), cB + hstep, voffB); PG8_STAGE(PG8_SA(0, 0), cA, voffA); PG8_STAGE(PG8_SA(0, 1), cA + hstep, voffA);
        if (wr == 1) PG8_BAR;
        PG8_WAIT_V(2); PG8_BAR;
        PG8_STAGE(PG8_SB(1, 0), cB + kstep, voffB); PG8_STAGE(PG8_SA(1, 0), cA + kstep, voffA); PG8_STAGE(PG8_SB(1, 1), cB + hstep + kstep, voffB);
        PG8_WAIT_V(6); PG8_BAR;
    } else {
        PG8_STAGE(PG8_SB(0, 0), cB, voffB); PG8_STAGE(PG8_SA(0, 0), cA, voffA); PG8_STAGE(PG8_SB(0, 1), cB + hstep, voffB); PG8_STAGE(PG8_SA(0, 1), cA + hstep, voffA);
        if (wr == 1) PG8_BAR;
        PG8_WAIT_V(4); PG8_BAR;
        PG8_STAGE(PG8_SB(1, 0), cB + kstep, voffB); PG8_STAGE(PG8_SA(1, 0), cA + kstep, voffA); PG8_STAGE(PG8_SB(1, 1), cB + hstep + kstep, voffB);
        PG8_WAIT_V(6); PG8_BAR;
    }
    for (;;) {
        const bool has_next = S.next(ui + 1, nxt);
        const char* nA = has_next ? (const char*)g.A + (size_t)nxt.pm * tstep : cA; const char* nB = has_next ? (const char*)g.Bt + S.bofs(nxt, tstep) : cB;
        for (int t = 0; t < nt; t += 2) {
            const bool last = (t == nt - 2);
            const char* a1 = cA + (size_t)(t + 1) * kstep;
            const char* a2 = last ? nA : cA + (size_t)(t + 2) * kstep; const char* b2 = last ? nB : cB + (size_t)(t + 2) * kstep;
            const char* a3 = a2 + kstep; const char* b3 = b2 + kstep;
            if (last && has_next) S.a_ready(nxt);
            if constexpr (SP2) {
            PG8_LDB(B0, 0, 0); PG8_LDB(B1, 0, 1); PG8_SCHED; PG8_LDA(At, 0, 0); PG8_STAGE(PG8_SA(1, 1), a1 + hstep, voffA);
            PG8_WAIT_V(8); PG8_WAIT_L(0); PG8_BAR; PG8_MMA(0, 0, At, B0); PG8_MMA(0, 1, At, B1); PG8_BAR; PG8_SCHED;
            PG8_LDA(At, 0, 1); PG8_STAGE(PG8_SB(0, 0), b2, voffB); PG8_STAGE(PG8_SB(0, 1), b2 + hstep, voffB); PG8_STAGE(PG8_SA(0, 0), a2, voffA);
            PG8_WAIT_V(8); PG8_WAIT_L(0); PG8_BAR; PG8_MMA(1, 0, At, B0); PG8_MMA(1, 1, At, B1); PG8_BAR; PG8_SCHED;
            PG8_LDB(B0, 1, 0); PG8_LDB(B1, 1, 1); PG8_SCHED; PG8_LDA(At, 1, 0); PG8_STAGE(PG8_SA(0, 1), a2 + hstep, voffA);
            PG8_WAIT_V(8); PG8_WAIT_L(0); PG8_BAR; PG8_MMA(0, 0, At, B0); PG8_MMA(0, 1, At, B1); PG8_BAR; PG8_SCHED;
            PG8_LDA(At, 1, 1); PG8_STAGE(PG8_SB(1, 0), b3, voffB); PG8_STAGE(PG8_SB(1, 1), b3 + hstep, voffB); PG8_STAGE(PG8_SA(1, 0), a3, voffA);
            PG8_WAIT_V(8); PG8_WAIT_L(0); PG8_BAR; PG8_MMA(1, 0, At, B0); PG8_MMA(1, 1, At, B1); PG8_BAR; PG8_SCHED;
            } else {
            PG8_LDB(B0, 0, 0); PG8_SCHED; PG8_LDA(At, 0, 0); PG8_STAGE(PG8_SA(1, 1), a1 + hstep, voffA);
            PG8_WAIT_L(8); PG8_BAR; PG8_WAIT_L(0); PG8_MMA(0, 0, At, B0); PG8_BAR; PG8_SCHED;
            PG8_LDB(B1, 0, 1); PG8_STAGE(PG8_SB(0, 0), b2, voffB);
            PG8_BAR; PG8_WAIT_L(0); PG8_MMA(0, 1, At, B1); PG8_BAR;
            PG8_LDA(At, 0, 1); PG8_STAGE(PG8_SA(0, 0), a2, voffA);
            PG8_BAR; PG8_WAIT_L(0); PG8_MMA(1, 0, At, B0); PG8_BAR; PG8_SCHED;
            PG8_STAGE(PG8_SB(0, 1), b2 + hstep, voffB);
            PG8_WAIT_V(6); PG8_BAR; PG8_MMA(1, 1, At, B1); PG8_BAR;
            PG8_LDB(B0, 1, 0); PG8_SCHED; PG8_LDA(At, 1, 0); PG8_STAGE(PG8_SA(0, 1), a2 + hstep, voffA);
            PG8_WAIT_L(8); PG8_BAR; PG8_WAIT_L(0); PG8_MMA(0, 0, At, B0); PG8_BAR; PG8_SCHED;
            PG8_LDB(B1, 1, 1); PG8_STAGE(PG8_SB(1, 0), b3, voffB);
            PG8_BAR; PG8_WAIT_L(0); PG8_MMA(0, 1, At, B1); PG8_BAR;
            PG8_LDA(At, 1, 1); PG8_STAGE(PG8_SA(1, 0), a3, voffA);
            PG8_BAR; PG8_WAIT_L(0); PG8_MMA(1, 0, At, B0); PG8_BAR; PG8_SCHED;
            PG8_STAGE(PG8_SB(1, 1), b3 + hstep, voffB);
            PG8_WAIT_V(6); PG8_BAR; PG8_MMA(1, 1, At, B1); PG8_BAR;
            }
        }
        if constexpr (ALIGN_EPI) { if (wr == 0) PG8_BAR; }
        if constexpr (!Epi::AFTER_DRAIN) { E(acc, cur, wr, wc, fr, fq); S.done(cur); }
        if (!has_next) break;
#pragma unroll
        for (int a = 0; a < 2; ++a)
#pragma unroll
            for (int b = 0; b < 2; ++b)
#pragma unroll
                for (int m = 0; m < 4; ++m)
#pragma unroll
                    for (int n = 0; n < 2; ++n) acc[a][b][m][n] = (f32x4){0.f, 0.f, 0.f, 0.f};
        cur = nxt; cA = nA; cB = nB; ++ui;
        if constexpr (ALIGN_EPI) { if (wr == 1) PG8_BAR; }
    }
    PG8_WAIT_V(0);
    if constexpr (!ALIGN_EPI) { if (wr == 0) PG8_BAR; }
    PG8_BAR;
    if constexpr (Epi::AFTER_DRAIN) { E.fused(acc, cur, wr, wc, fr, fq, lds, wid, lane); S.done(cur); }
#undef PG8_SA
#undef PG8_SB
#undef PG8_STAGE
#undef PG8_LDA
#undef PG8_LDB
#undef PG8_MMA
#undef PG8_WAIT_V
#undef PG8_WAIT_L
#undef PG8_BAR
#undef PG8_SCHED
}
template <class Epi, class Sched, bool ALIGN_EPI = false, bool SP2 = false>
__device__ __forceinline__ void gemm_phase_g(PG8_LAS unsigned char* lds, const Gemm g, const Sched& S, const Epi& E, const int* rowtok) {
    int lid_; asm volatile("v_mbcnt_lo_u32_b32 %0, -1, 0\n\tv_mbcnt_hi_u32_b32 %0, -1, %0" : "=v"(lid_)); int tid_ = g.wv * 64 + lid_; asm volatile("" : "+v"(tid_));
    const int tid = tid_, wid = __builtin_amdgcn_readfirstlane(tid >> 6), lane = tid & 63, wr = wid >> 2, wc = wid & 3, fr = lane & 15, fq = lane >> 4;
    const int K = g.K, nt = K / BK;
    unsigned voffA[2], voffB[2];
#pragma unroll
    for (int i = 0; i < 2; ++i) { int R, C; stage_rc(tid * 16 + i * 8192, R, C); const int Rb = Epi::PERM ? ((R & ~31) + perm32(R & 31)) : R;
        voffA[i] = (unsigned)(R * K + C) * 2u; voffB[i] = (unsigned)(Rb * K + C) * 2u; }
    const size_t kstep = (size_t)(BK * 2);
    const size_t hstep = (size_t)HALF * K * 2;
    const size_t tstep = 2 * hstep;
    const unsigned ldsw = (unsigned)wid * 1024u;
    const int aoff = lds_byte(wr * 64 + fr, fq * 8), boff = lds_byte(wc * 32 + fr, fq * 8);
#define PG8_SA(b, h) (((b) * 2 + (h)) * HTB)
#define PG8_SB(b, h) ((4 + (b) * 2 + (h)) * HTB)
#define PG8_STAGE(bufoff, gbase, voff) do { _Pragma("unroll") for (int _i = 0; _i < 2; ++_i) \
        __builtin_amdgcn_global_load_lds((const unsigned*)((const char*)(gbase) + (voff)[_i]), (PG8_LAS unsigned*)(lds + (bufoff) + ldsw + _i * 8192), 16, 0, 0); } while (0)
#define PG8_LDA(dst, b, h) do { _Pragma("unroll") for (int m = 0; m < 4; ++m) _Pragma("unroll") for (int k = 0; k < 2; ++k) dst[m][k] = *(const PG8_LAS bf16x8*)(lds + PG8_SA(b, h) + aoff + m * 2048 + k * 1024); } while (0)
#define PG8_LDB(dst, b, h) do { _Pragma("unroll") for (int n = 0; n < 2; ++n) _Pragma("unroll") for (int k = 0; k < 2; ++k) dst[n][k] = *(const PG8_LAS bf16x8*)(lds + PG8_SB(b, h) + boff + n * 2048 + k * 1024); } while (0)
#define PG8_MMA(ai, bj, At, Bt) do { __builtin_amdgcn_s_setprio(1); _Pragma("unroll") for (int m = 0; m < 4; ++m) _Pragma("unroll") for (int n = 0; n < 2; ++n) _Pragma("unroll") for (int k = 0; k < 2; ++k) \
        acc[ai][bj][m][n] = __builtin_amdgcn_mfma_f32_16x16x32_bf16(Bt[n][k], At[m][k], acc[ai][bj][m][n], 0, 0, 0); __builtin_amdgcn_s_setprio(0); } while (0)
#define PG8_WAIT_V(n) asm volatile("s_waitcnt vmcnt(" #n ")" ::: "memory")
#define PG8_WAIT_L(n) asm volatile("s_waitcnt lgkmcnt(" #n ")" ::: "memory")
#define PG8_BAR __builtin_amdgcn_s_barrier()
#define PG8_SCHED __builtin_amdgcn_sched_barrier(0)
    unsigned gAc[2][2], gAn[2][2];
#define PG8_GATHER(dst, un) do { _Pragma("unroll") for (int hh_ = 0; hh_ < 2; ++hh_) _Pragma("unroll") for (int i_ = 0; i_ < 2; ++i_) { \
        const int tok_ = rowtok[(un).pm * BM + hh_ * HALF + (int)(voffA[i_] >> 11)]; dst[hh_][i_] = (unsigned)(tok_ < 0 ? 0 : tok_) * 2048u + (voffA[i_] & 2047u); } } while (0)
#define PG8_STAGE_GA(bufoff, kptr, hh, NX) do { _Pragma("unroll") for (int _i = 0; _i < 2; ++_i) \
        __builtin_amdgcn_global_load_lds((const unsigned*)((const char*)(kptr) + ((NX) ? gAn[hh][_i] : gAc[hh][_i])), (PG8_LAS unsigned*)(lds + (bufoff) + ldsw + _i * 8192), 16, 0, 0); } while (0)
    Unit cur, nxt; int ui = 0;
    if (!S.next(0, cur)) return;
    PG8_GATHER(gAc, cur);
    f32x4 acc[2][2][4][2];
#pragma unroll
    for (int a = 0; a < 2; ++a)
#pragma unroll
        for (int b = 0; b < 2; ++b)
#pragma unroll
            for (int m = 0; m < 4; ++m)
#pragma unroll
                for (int n = 0; n < 2; ++n) acc[a][b][m][n] = (f32x4){0.f, 0.f, 0.f, 0.f};
    bf16x8 At[4][2], B0[2][2], B1[2][2];
    const char* cA = (const char*)g.A; const char* cB = (const char*)g.Bt + S.bofs(cur, tstep);
    S.a_ready(cur);
    if constexpr (SP2) {
        PG8_STAGE(PG8_SB(0, 0), cB, voffB); PG8_STAGE(PG8_SB(0, 1), cB + hstep, voffB); PG8_STAGE_GA(PG8_SA(0, 0), cA, 0, false); PG8_STAGE_GA(PG8_SA(0, 1), cA, 1, false);
        if (wr == 1) PG8_BAR;
        PG8_WAIT_V(2); PG8_BAR;
        PG8_STAGE(PG8_SB(1, 0), cB + kstep, voffB); PG8_STAGE_GA(PG8_SA(1, 0), cA + kstep, 0, false); PG8_STAGE(PG8_SB(1, 1), cB + hstep + kstep, voffB);
        PG8_WAIT_V(6); PG8_BAR;
    } else {
        PG8_STAGE(PG8_SB(0, 0), cB, voffB); PG8_STAGE_GA(PG8_SA(0, 0), cA, 0, false); PG8_STAGE(PG8_SB(0, 1), cB + hstep, voffB); PG8_STAGE_GA(PG8_SA(0, 1), cA, 1, false);
        if (wr == 1) PG8_BAR;
        PG8_WAIT_V(4); PG8_BAR;
        PG8_STAGE(PG8_SB(1, 0), cB + kstep, voffB); PG8_STAGE_GA(PG8_SA(1, 0), cA + kstep, 0, false); PG8_STAGE(PG8_SB(1, 1), cB + hstep + kstep, voffB);
        PG8_WAIT_V(6); PG8_BAR;
    }
    for (;;) {
        const bool has_next = S.next(ui + 1, nxt);
        if (has_next) PG8_GATHER(gAn, nxt); else { _Pragma("unroll") for (int hh_ = 0; hh_ < 2; ++hh_) _Pragma("unroll") for (int i_ = 0; i_ < 2; ++i_) gAn[hh_][i_] = gAc[hh_][i_]; }
        const char* nA = (const char*)g.A; const char* nB = has_next ? (const char*)g.Bt + S.bofs(nxt, tstep) : cB;
        for (int t = 0; t < nt; t += 2) {
            const bool last = (t == nt - 2);
            const char* a1 = cA + (size_t)(t + 1) * kstep;
            const char* a2 = last ? nA : cA + (size_t)(t + 2) * kstep; const char* b2 = last ? nB : cB + (size_t)(t + 2) * kstep;
            const char* a3 = a2 + kstep; const char* b3 = b2 + kstep;
            if (last && has_next) S.a_ready(nxt);
            if constexpr (SP2) {
            PG8_LDB(B0, 0, 0); PG8_LDB(B1, 0, 1); PG8_SCHED; PG8_LDA(At, 0, 0); PG8_STAGE_GA(PG8_SA(1, 1), a1, 1, false);
            PG8_WAIT_V(8); PG8_WAIT_L(0); PG8_BAR; PG8_MMA(0, 0, At, B0); PG8_MMA(0, 1, At, B1); PG8_BAR; PG8_SCHED;
            PG8_LDA(At, 0, 1); PG8_STAGE(PG8_SB(0, 0), b2, voffB); PG8_STAGE(PG8_SB(0, 1), b2 + hstep, voffB); PG8_STAGE_GA(PG8_SA(0, 0), a2, 0, last);
            PG8_WAIT_V(8); PG8_WAIT_L(0); PG8_BAR; PG8_MMA(1, 0, At, B0); PG8_MMA(1, 1, At, B1); PG8_BAR; PG8_SCHED;
            PG8_LDB(B0, 1, 0); PG8_LDB(B1, 1, 1); PG8_SCHED; PG8_LDA(At, 1, 0); PG8_STAGE_GA(PG8_SA(0, 1), a2, 1, last);
            PG8_WAIT_V(8); PG8_WAIT_L(0); PG8_BAR; PG8_MMA(0, 0, At, B0); PG8_MMA(0, 1, At, B1); PG8_BAR; PG8_SCHED;
            PG8_LDA(At, 1, 1); PG8_STAGE(PG8_SB(1, 0), b3, voffB); PG8_STAGE(PG8_SB(1, 1), b3 + hstep, voffB); PG8_STAGE_GA(PG8_SA(1, 0), a3, 0, last);
            PG8_WAIT_V(8); PG8_WAIT_L(0); PG8_BAR; PG8_MMA(1, 0, At, B0); PG8_MMA(1, 1, At, B1); PG8_BAR; PG8_SCHED;
            } else {
            PG8_LDB(B0, 0, 0); PG8_SCHED; PG8_LDA(At, 0, 0); PG8_STAGE_GA(PG8_SA(1, 1), a1, 1, false);
            PG8_WAIT_L(8); PG8_BAR; PG8_WAIT_L(0); PG8_MMA(0, 0, At, B0); PG8_BAR; PG8_SCHED;
            PG8_LDB(B1, 0, 1); PG8_STAGE(PG8_SB(0, 0), b2, voffB);
            PG8_BAR; PG8_WAIT_L(0); PG8_MMA(0, 1, At, B1); PG8_BAR;
            PG8_LDA(At, 0, 1); PG8_STAGE_GA(PG8_SA(0, 0), a2, 0, last);
            PG8_BAR; PG8_WAIT_L(0); PG8_MMA(1, 0, At, B0); PG8_BAR; PG8_SCHED;
            PG8_STAGE(PG8_SB(0, 1), b2 + hstep, voffB);
            PG8_WAIT_V(6); PG8_BAR; PG8_MMA(1, 1, At, B1); PG8_BAR;
            PG8_LDB(B0, 1, 0); PG8_SCHED; PG8_LDA(At, 1, 0); PG8_STAGE_GA(PG8_SA(0, 1), a2, 1, last);
            PG8_WAIT_L(8); PG8_BAR; PG8_WAIT_L(0); PG8_MMA(0, 0, At, B0); PG8_BAR; PG8_SCHED;
            PG8_LDB(B1, 1, 1); PG8_STAGE(PG8_SB(1, 0), b3, voffB);
            PG8_BAR; PG8_WAIT_L(0); PG8_MMA(0, 1, At, B1); PG8_BAR;
            PG8_LDA(At, 1, 1); PG8_STAGE_GA(PG8_SA(1, 0), a3, 0, last);
            PG8_BAR; PG8_WAIT_L(0); PG8_MMA(1, 0, At, B0); PG8_BAR; PG8_SCHED;
            PG8_STAGE(PG8_SB(1, 1), b3 + hstep, voffB);
            PG8_WAIT_V(6); PG8_BAR; PG8_MMA(1, 1, At, B1); PG8_BAR;
            }
        }
        if constexpr (ALIGN_EPI) { if (wr == 0) PG8_BAR; }
        if constexpr (!Epi::AFTER_DRAIN) { E(acc, cur, wr, wc, fr, fq); S.done(cur); }
        if (!has_next) break;
#pragma unroll
        for (int a = 0; a < 2; ++a)
#pragma unroll
            for (int b = 0; b < 2; ++b)
#pragma unroll
                for (int m = 0; m < 4; ++m)
#pragma unroll
                    for (int n = 0; n < 2; ++n) acc[a][b][m][n] = (f32x4){0.f, 0.f, 0.f, 0.f};
        cur = nxt; cA = nA; cB = nB; ++ui;
        _Pragma("unroll") for (int hh_ = 0; hh_ < 2; ++hh_) _Pragma("unroll") for (int i_ = 0; i_ < 2; ++i_) gAc[hh_][i_] = gAn[hh_][i_];
        if constexpr (ALIGN_EPI) { if (wr == 1) PG8_BAR; }
    }
    PG8_WAIT_V(0);
    if constexpr (!ALIGN_EPI) { if (wr == 0) PG8_BAR; }
    PG8_BAR;
    if constexpr (Epi::AFTER_DRAIN) { E.fused(acc, cur, wr, wc, fr, fq, lds, wid, lane); S.done(cur); }
#undef PG8_GATHER
#undef PG8_STAGE_GA
#undef PG8_SA
#undef PG8_SB
#undef PG8_STAGE
#undef PG8_LDA
#undef PG8_LDB
#undef PG8_MMA
#undef PG8_WAIT_V
#undef PG8_WAIT_L
#undef PG8_BAR
#undef PG8_SCHED
}
}
#define XB_TMO      128
#define XB_XCNT(j)  (256  + 64 * (j))
#define XB_XSUB(j)  (1280 + 64 * (j))
#define XB_XGEN(j)  (2304 + 64 * (j))
#define XB_TOP      3328
#define XB_TOPGEN   3392
#define XCD_BAR_WORDS 3456
#define XB_SPIN_CAP (1u << 18)

__device__ __forceinline__ unsigned xb_ld(unsigned* p)              { return __hip_atomic_load(p, __ATOMIC_RELAXED, __HIP_MEMORY_SCOPE_AGENT); }
__device__ __forceinline__ unsigned xb_add(unsigned* p, unsigned v) { return __hip_atomic_fetch_add(p, v, __ATOMIC_RELAXED, __HIP_MEMORY_SCOPE_AGENT); }
__device__ __forceinline__ unsigned xb_xcc_id() { return (unsigned)__builtin_amdgcn_s_getreg((3 << 11) | 20) & 0xFu; }
#define XB_SPIN(cond, bar) do { unsigned _sp = 0; while (cond) { __builtin_amdgcn_s_sleep(1); \
    if ((++_sp & 255u) == 0u) { if (xb_ld(&(bar)[XB_TMO])) break; if (_sp > XB_SPIN_CAP) { atomicAdd(&(bar)[XB_TMO], 1u); break; } } } } while (0)

struct XcdBarrier {
    unsigned* bar; unsigned x;
    volatile LAS unsigned* st;
};

__device__ __forceinline__ XcdBarrier xcd_barrier_post(unsigned* bar, volatile LAS unsigned* st) {
    XcdBarrier b; b.bar = bar; b.x = xb_xcc_id(); b.st = st;
    if (threadIdx.x == 0) (void)xb_add(&bar[XB_XCNT(b.x)], 1u);
    return b;
}
__device__ __forceinline__ void xcd_barrier_complete(unsigned* bar, unsigned x, unsigned& nloc, unsigned& nx) {
    const unsigned G = gridDim.x * gridDim.y * gridDim.z;
    unsigned sum, cnt, mine, sp = 0u;
    for (;;) {
        sum = 0u; cnt = 0u; mine = 0u;
#pragma unroll
        for (unsigned j = 0; j < 16; ++j) { const unsigned c = xb_ld(&bar[XB_XCNT(j)]); sum += c; cnt += (c > 0u) ? 1u : 0u; mine = (j == x) ? c : mine; }
        if (sum == G) break;
        __builtin_amdgcn_s_sleep(1);
        if ((++sp & 255u) == 0u) { if (xb_ld(&bar[XB_TMO])) break; if (sp > XB_SPIN_CAP) { atomicAdd(&bar[XB_TMO], 1u); break; } }
    }
    nloc = mine > 0u ? mine : 1u; nx = cnt > 0u ? cnt : 1u;
}

__device__ __forceinline__ void xcd_barrier(const XcdBarrier& b) {
    asm volatile("s_waitcnt vmcnt(0)" ::: "memory");
    __syncthreads();
    if (threadIdx.x == 0) {
        unsigned* bar = b.bar;
        __builtin_amdgcn_s_waitcnt(0);
        unsigned nloc = b.st[0], nx = b.st[1];
        if (nloc == 0u) { xcd_barrier_complete(bar, b.x, nloc, nx); b.st[0] = nloc; b.st[1] = nx; }
        const unsigned old = xb_add(&bar[XB_XSUB(b.x)], 1u);
        const unsigned gen = old / nloc;
        if (old + 1u == (gen + 1u) * nloc) {
            __builtin_amdgcn_fence(__ATOMIC_RELEASE, "agent");
            asm volatile("s_waitcnt vmcnt(0)" ::: "memory");
            const unsigned og = xb_add(&bar[XB_TOP], 1u);
            const unsigned tg = og / nx;
            if (og + 1u == (tg + 1u) * nx) xb_add(&bar[XB_TOPGEN], 1u);
            else XB_SPIN(xb_ld(&bar[XB_TOPGEN]) == tg, bar);
            __builtin_amdgcn_fence(__ATOMIC_ACQUIRE, "agent");
            xb_add(&bar[XB_XGEN(b.x)], 1u);
            asm volatile("s_waitcnt vmcnt(0)" ::: "memory");
        } else {
            XB_SPIN(xb_ld(&bar[XB_XGEN(b.x)]) == gen, bar);
            __builtin_amdgcn_fence(__ATOMIC_ACQUIRE, "agent");
            asm volatile("s_waitcnt vmcnt(0)" ::: "memory");
        }
    }
    __syncthreads();
}

struct Params {
    const float* in[33];
    float* out; unsigned char* ws;
    int ph_lo, ph_hi;
};
struct Frame {
    LAS unsigned char* lds;
    int blk, G, wv;
    float* out; unsigned char* ws;
};
constexpr int PTAB_OFF = LDSCTL_OFF + 1024;
__device__ __forceinline__ int lane_id() { int l; asm volatile("v_mbcnt_lo_u32_b32 %0, -1, 0\n\tv_mbcnt_hi_u32_b32 %0, -1, %0" : "=v"(l)); return l; }
__device__ __forceinline__ int mytid(const Frame& F) { int t = F.wv * 64 + lane_id(); asm volatile("" : "+v"(t)); return t; }
__device__ __forceinline__ const float* inptr(const Frame& F, int k) {
    volatile LAS unsigned* t = (volatile LAS unsigned*)(F.lds + PTAB_OFF) + 2 * k;
    const unsigned lo = __builtin_amdgcn_readfirstlane(t[0]), hi = __builtin_amdgcn_readfirstlane(t[1]);
    const GAS float* gp = (const GAS float*)(((unsigned long long)hi << 32) | (unsigned long long)lo);
    return (const float*)gp;
}
#define IN_X 0
#define IN_RELB 1
#define IN_MIXG 2
#define IN_WIN 3
#define IN_WOUT 4
#define IN_FFNG 5
#define IN_QG 6
#define IN_KG 7
#define IN_CW 8
#define IN_CB 9
#define IN_CLG 10
#define IN_CLB 11
#define IN_MU 12
#define IN_W0 13
#define IN_W2 14
#define IN_A0 15
#define IN_A2 16
#define IN_G2 17
#define IN_KK 18
#define IN_KA 19
#define IN_RK 20
#define IN_RLG 21
#define IN_RLB 22
#define IN_GG2 23
#define IN_GGB 24
#define IN_GNG 25
#define IN_FWG 26
#define IN_FWU 27
#define IN_FWD 28
#define IN_ROUTER 29
#define IN_MWG 30
#define IN_MWU 31
#define IN_MWD 32

__device__ __forceinline__ void p0_transpose_item(const float* W, int K, int N, int nblk, const float* gk, bf16* WT, int mode, LAS float* scr, int item, int lane) {
    const int kb = item / nblk, nb = item % nblk, k0 = 64 * kb, n0 = 64 * nb, kr = lane >> 4, n4 = (lane & 15) * 4;
    const bool valid = (n0 + n4) < N;
    f32x4 v[16];
#pragma unroll
    for (int i = 0; i < 16; ++i) v[i] = valid ? *(const f32x4*)(W + (size_t)(k0 + 4 * i + kr) * N + n0 + n4) : (f32x4){0.f, 0.f, 0.f, 0.f};
    if (gk) {
#pragma unroll
        for (int i = 0; i < 16; ++i) v[i] = v[i] * gk[k0 + 4 * i + kr]; }
    const int rowbase = (mode == 0) ? n0 : ((n0 >> 7) * 256 + (mode == 2 ? 128 : 0) + (n0 & 127));
    const int c = lane & 3;
#pragma unroll
    for (int half = 0; half < 2; ++half) {
#pragma unroll
        for (int i = 0; i < 8; ++i) { LAS float* d = scr + (4 * i + kr) * 65 + n4; const f32x4 x = v[half * 8 + i]; d[0] = x[0]; d[1] = x[1]; d[2] = x[2]; d[3] = x[3]; }
        LDS_WAIT(); asm volatile("" ::: "memory");
#pragma unroll
        for (int j = 0; j < 4; ++j) { const int nn = (lane >> 2) + 16 * j; const LAS float* s = scr + (8 * c) * 65 + nn;
            u32x4 o; o.x = pk2(s[0 * 65], s[1 * 65]); o.y = pk2(s[2 * 65], s[3 * 65]); o.z = pk2(s[4 * 65], s[5 * 65]); o.w = pk2(s[6 * 65], s[7 * 65]);
            *(u32x4*)(WT + (size_t)(rowbase + nn) * K + k0 + half * 32 + 8 * c) = o; }
        LDS_WAIT(); asm volatile("" ::: "memory"); }
}
__device__ __forceinline__ void p0_prologue(Frame& F, const int part) {
    const int tid = mytid(F), lane = tid & 63, wave = __builtin_amdgcn_readfirstlane(tid >> 6); (void)lane; (void)wave;
    LAS float* scr = (LAS float*)(F.lds + wave * 16384);
    const int gw = F.blk * NWAVES + wave, NGW = F.G * NWAVES;
    constexpr int I_IN = 16 * 48, I_OUT = 16 * 16, I_GU = 16 * 44, I_D = 44 * 16, I_SET = 2 * I_GU + I_D;
    constexpr int NITEMS = 2 * I_IN + 2 * I_OUT + 9 * I_SET;
    unsigned char* ws = F.ws;
    constexpr int NPART0 = 2 * I_IN + 2 * I_OUT + I_SET;
    for (int it = (part == 0 ? 0 : NPART0) + gw; it < (part == 0 ? NPART0 : NITEMS); it += NGW) {
        int r = it;
        if (r < 2 * I_IN) { const int l = r / I_IN; r -= l * I_IN;
            p0_transpose_item(inptr(F, IN_WIN) + (size_t)l * DM * INW, DM, INW, 48, inptr(F, IN_MIXG) + l * DM, (bf16*)(ws + WS_WIN) + (size_t)l * NPADW * DM, 0, scr, r, lane); continue; }
        r -= 2 * I_IN;
        if (r < 2 * I_OUT) { const int l = r / I_OUT; r -= l * I_OUT;
            p0_transpose_item(inptr(F, IN_WOUT) + (size_t)l * DM * DM, DM, DM, 16, nullptr, (bf16*)(ws + WS_WOUT) + (size_t)l * DM * DM, 0, scr, r, lane); continue; }
        r -= 2 * I_OUT;
        const int set = r / I_SET; r -= set * I_SET;
        const float* wg = set == 0 ? inptr(F, IN_FWG) : inptr(F, IN_MWG) + (size_t)(set - 1) * DM * DFF;
        const float* wu = set == 0 ? inptr(F, IN_FWU) : inptr(F, IN_MWU) + (size_t)(set - 1) * DM * DFF;
        const float* wd = set == 0 ? inptr(F, IN_FWD) : inptr(F, IN_MWD) + (size_t)(set - 1) * DFF * DM;
        const float* gk = inptr(F, IN_FFNG) + (set == 0 ? 0 : DM);
        bf16* dgu = set == 0 ? (bf16*)(ws + WS_WGU) : (bf16*)(ws + WS_MOEW + (size_t)(set - 1) * MOEW_E_BYTES);
        bf16* dd = set == 0 ? (bf16*)(ws + WS_WD) : (bf16*)(ws + WS_MOEW + (size_t)(set - 1) * MOEW_E_BYTES + MOEW_GU_BYTES);
        if (r < I_GU) { p0_transpose_item(wg, DM, DFF, 44, gk, dgu, 1, scr, r, lane); continue; } r -= I_GU;
        if (r < I_GU) { p0_transpose_item(wu, DM, DFF, 44, gk, dgu, 2, scr, r, lane); continue; } r -= I_GU;
        p0_transpose_item(wd, DFF, DM, 16, nullptr, dd, 0, scr, r, lane);
    }
    if (part != 0) return;
    const float* x = inptr(F, IN_X); bf16* hb = (bf16*)(ws + WS_HB); float* ssq = (float*)(ws + WS_SSQ);
    for (int m = gw; m < NTOK; m += NGW) {
        const f32x4* xr = (const f32x4*)(x + (size_t)m * DM) + lane; f32x4 v[4]; float s = 0.f;
#pragma unroll
        for (int j = 0; j < 4; ++j) { v[j] = xr[64 * j]; s += (v[j][0] * v[j][0] + v[j][1] * v[j][1]) + (v[j][2] * v[j][2] + v[j][3] * v[j][3]); }
        s = wave_sum(s);
        u32x2* o8 = (u32x2*)(hb + (size_t)m * DM) + lane;
#pragma unroll
        for (int j = 0; j < 4; ++j) { u32x2 w; w.x = pk2(v[j][0], v[j][1]); w.y = pk2(v[j][2], v[j][3]); o8[64 * j] = w; }
        if (lane < 16) ssq[(size_t)m * 16 + lane] = (lane == 0) ? s : 0.f;
    }
}

__device__ const unsigned char T5B[3][132] = {
 {0,1,2,3,4,5,6,7,8,9,10,11,12,13,14,15,16,16,16,16,16,16,17,17,17,17,17,17,17,17,18,18,18,18,18,18,18,18,18,18,19,19,19,19,19,19,19,19,19,19,19,19,19,19,20,20,20,20,20,20,20,20,20,20,20,20,20,20,20,20,20,20,20,21,21,21,21,21,21,21,21,21,21,21,21,21,21,21,21,21,21,21,21,21,21,21,21,21,21,22,22,22,22,22,22,22,22,22,22,22,22,22,22,22,22,22,22,22,22,22,22,22,22,22,22,22,22,22,22,0,0,0},
 {0,4,8,12,16,16,17,17,18,18,19,19,19,19,20,20,20,20,20,21,21,21,21,21,21,22,22,22,22,22,22,22,22,22,23,23,23,23,23,23,23,23,23,23,23,23,24,24,24,24,24,24,24,24,24,24,24,24,24,24,24,24,25,25,25,25,25,25,25,25,25,25,25,25,25,25,25,25,25,25,25,25,25,26,26,26,26,26,26,26,26,26,26,26,26,26,26,26,26,26,26,26,26,26,26,26,26,26,26,26,26,26,26,27,27,27,27,27,27,27,27,27,27,27,27,27,27,27,27,0,0,0},
 {0,16,18,19,20,21,21,22,22,23,23,23,24,24,24,24,25,25,25,25,25,26,26,26,26,26,26,26,26,27,27,27,27,27,27,27,27,27,27,28,28,28,28,28,28,28,28,28,28,28,28,28,29,29,29,29,29,29,29,29,29,29,29,29,29,29,29,29,29,29,30,30,30,30,30,30,30,30,30,30,30,30,30,30,30,30,30,30,30,30,30,30,30,30,30,31,31,31,31,31,31,31,31,31,31,31,31,31,31,31,31,31,31,31,31,31,31,31,31,31,31,31,31,31,31,31,31,31,31,0,0,0}};

__device__ __forceinline__ void attn_qknorm(Frame& F, bf16* Z, const float* qg, const float* kg) {
    const int tid = mytid(F); const int gt = F.blk * NTHREADS + tid, NGT = F.G * NTHREADS;
    for (int idx = gt; idx < NTOK * 64; idx += NGT) { const int tok = idx >> 6, seg = (idx >> 3) & 7, c8 = idx & 7;
        u32x4* ptr = (u32x4*)(Z + (size_t)tok * INW + (seg >> 2) * 256 + (seg & 3) * 64 + c8 * 8); const u32x4 p = *ptr; float f[8]; unpack8(p, f);
        float ss = 0.f;
#pragma unroll
        for (int e2 = 0; e2 < 8; ++e2) ss += f[e2] * f[e2];
        ss = red8(ss);
        const float rs = __builtin_amdgcn_rsqf(ss * (1.0f / 64.0f) + NORM_EPS) * (seg < 4 ? 0.125f : 1.0f); const float* gp = (seg < 4 ? qg : kg) + c8 * 8;
        u32x4 o; o.x = pk2(f[0] * rs * gp[0], f[1] * rs * gp[1]); o.y = pk2(f[2] * rs * gp[2], f[3] * rs * gp[3]); o.z = pk2(f[4] * rs * gp[4], f[5] * rs * gp[5]); o.w = pk2(f[6] * rs * gp[6], f[7] * rs * gp[7]);
        *ptr = o; }
}
typedef short v4i16 __attribute__((ext_vector_type(4)));
__device__ __forceinline__ void attn_tile(LAS unsigned char* lds, const bf16* Z, bf16* OP, float* LSE, const float* rel_bias, int tile, int tid) {
    const int lane = tid & 63, w = __builtin_amdgcn_readfirstlane(tid >> 6), fr = lane & 15, g = lane >> 4;
    const int br = tile >> 10, rem = tile & 1023, b = rem >> 7, h = (rem >> 5) & 3, sub = rem & 31;
    const int dsh = 2 * br, nbl = 32 >> dsh, r = sub >> (5 - dsh), n = sub & (nbl - 1);
    LAS unsigned char* Qs = lds;
    LAS unsigned char* Ks = lds + 16384;
    LAS unsigned char* Vs = lds + 49152;
    LAS float* BT = (LAS float*)(lds + 81920);
    const size_t zrow0 = (size_t)b * SEQ;
    if (tid < 383) { const int delta = tid - 127; BT[tid] = (delta >= 0 && delta <= 128) ? rel_bias[(int)T5B[br][delta] * 4 + h] : -3.0e38f; }
    { const int rl = lane >> 3, cp = lane & 7;
#pragma unroll
        for (int i = 0; i < 4; ++i) { const int R0 = (w * 4 + i) * 8, row = R0 + rl; int lk = 128 * (n - 1) + row; lk = lk < 0 ? 0 : lk;
            const bf16* zr = Z + (zrow0 + ((size_t)lk << dsh) + r) * INW + h * 64;
            __builtin_amdgcn_global_load_lds((const unsigned*)(zr + 256 + ((cp ^ (row & 7)) * 8)), (LAS unsigned*)(Ks + R0 * 128), 16, 0, 0);
            __builtin_amdgcn_global_load_lds((const unsigned*)(zr + 512 + ((2 * ((cp >> 1) ^ ((row >> 1) & 3)) + (cp & 1)) * 8)), (LAS unsigned*)(Vs + R0 * 128), 16, 0, 0); }
#pragma unroll
        for (int i = 0; i < 2; ++i) { const int R0 = (w * 2 + i) * 8, row = R0 + rl; const int lq = 128 * n + row;
            const bf16* zr = Z + (zrow0 + ((size_t)lq << dsh) + r) * INW + h * 64;
            __builtin_amdgcn_global_load_lds((const unsigned*)(zr + ((cp ^ (row & 7)) * 8)), (LAS unsigned*)(Qs + R0 * 128), 16, 0, 0); } }
    asm volatile("s_waitcnt vmcnt(0)" ::: "memory");
    BAR();
    bf16x8 qf[2];
#pragma unroll
    for (int ks = 0; ks < 2; ++ks) qf[ks] = *(const LAS bf16x8*)(Qs + (16 * w + fr) * 128 + (((ks * 4 + g) ^ (fr & 7)) << 4));
    f32x4 s[16];
#pragma unroll
    for (int kb = 0; kb < 16; ++kb) { s[kb] = (f32x4){0.f, 0.f, 0.f, 0.f};
#pragma unroll
        for (int ks = 0; ks < 2; ++ks) { const bf16x8 kf = *(const LAS bf16x8*)(Ks + (16 * kb + fr) * 128 + (((ks * 4 + g) ^ (fr & 7)) << 4));
            s[kb] = __builtin_amdgcn_mfma_f32_16x16x32_bf16(kf, qf[ks], s[kb], 0, 0, 0); } }
    const int q = 16 * w + fr; float mx = -3.0e38f;
    const LAS float* btq = BT + (q + 255 - 4 * g);
#pragma unroll
    for (int kb = 0; kb < 16; ++kb)
#pragma unroll
        for (int rg = 0; rg < 4; ++rg) { float v = s[kb][rg] + btq[-(16 * kb + rg)];
            if (kb < 8) v = (n > 0) ? v : -3.0e38f;
            s[kb][rg] = v; mx = fmaxf(mx, v); }
    mx = fmaxf(mx, __shfl_xor(mx, 16)); mx = fmaxf(mx, __shfl_xor(mx, 32));
    float den = 0.f;
#pragma unroll
    for (int kb = 0; kb < 16; ++kb)
#pragma unroll
        for (int rg = 0; rg < 4; ++rg) { const float p = __expf(s[kb][rg] - mx); s[kb][rg] = p; den += p; }
    den += __shfl_xor(den, 16); den += __shfl_xor(den, 32);
    f32x4 o[4];
#pragma unroll
    for (int eb = 0; eb < 4; ++eb) o[eb] = (f32x4){0.f, 0.f, 0.f, 0.f};
    const int trq = fr >> 2, trp = fr & 3;
#pragma unroll
    for (int s8 = 0; s8 < 8; ++s8) {
        u32x4 pw; pw.x = pk2(s[2 * s8][0], s[2 * s8][1]); pw.y = pk2(s[2 * s8][2], s[2 * s8][3]); pw.z = pk2(s[2 * s8 + 1][0], s[2 * s8 + 1][1]); pw.w = pk2(s[2 * s8 + 1][2], s[2 * s8 + 1][3]);
        const bf16x8 pb = __builtin_bit_cast(bf16x8, pw);
        const int rowA = 32 * s8 + 4 * g + trq, swz = (rowA >> 1) & 3;
#pragma unroll
        for (int eb = 0; eb < 4; ++eb) { const LAS unsigned char* vp = Vs + rowA * 128 + ((eb ^ swz) * 32) + 8 * trp;
            const v4i16 lo = __builtin_amdgcn_ds_read_tr16_b64_v4i16((LAS v4i16*)vp), hi = __builtin_amdgcn_ds_read_tr16_b64_v4i16((LAS v4i16*)(vp + 16 * 128));
            bf16x8 af; af[0] = lo[0]; af[1] = lo[1]; af[2] = lo[2]; af[3] = lo[3]; af[4] = hi[0]; af[5] = hi[1]; af[6] = hi[2]; af[7] = hi[3];
            o[eb] = __builtin_amdgcn_mfma_f32_16x16x32_bf16(af, pb, o[eb], 0, 0, 0); } }
    const float inv = 1.0f / den; const size_t tokq = zrow0 + ((size_t)(128 * n + q) << dsh) + r;
    bf16* op = OP + ((size_t)br * NTOK + tokq) * 256 + h * 64 + 4 * g;
#pragma unroll
    for (int eb = 0; eb < 4; ++eb) { u32x2 wv; wv.x = pk2(o[eb][0] * inv, o[eb][1] * inv); wv.y = pk2(o[eb][2] * inv, o[eb][3] * inv); *(u32x2*)(op + 16 * eb) = wv; }
    if (g == 0) LSE[((size_t)br * NTOK + tokq) * 4 + h] = mx + __logf(den);
    BAR();
}

__device__ __forceinline__ void attn_merge(Frame& F, const bf16* OP, const float* LSE, bf16* Y, int wi, int nw) {
    const int tid = mytid(F), lane = tid & 63, wave = __builtin_amdgcn_readfirstlane(tid >> 6); (void)lane; (void)wave;
    const int gt = wi * NTHREADS + tid, NGT = nw * NTHREADS;
    for (int idx = gt; idx < NTOK * 32; idx += NGT) { const int tok = idx >> 5, c8 = idx & 31, h = c8 >> 3;
        const float l0 = LSE[((size_t)0 * NTOK + tok) * 4 + h], l1 = LSE[((size_t)1 * NTOK + tok) * 4 + h], l2 = LSE[((size_t)2 * NTOK + tok) * 4 + h];
        const float m = fmaxf(l0, fmaxf(l1, l2)); float w0 = __expf(l0 - m), w1 = __expf(l1 - m), w2 = __expf(l2 - m); const float inv = 1.0f / (w0 + w1 + w2); w0 *= inv; w1 *= inv; w2 *= inv;
        const u32x4 a = *(const u32x4*)(OP + ((size_t)0 * NTOK + tok) * 256 + c8 * 8), bq = *(const u32x4*)(OP + ((size_t)1 * NTOK + tok) * 256 + c8 * 8), c = *(const u32x4*)(OP + ((size_t)2 * NTOK + tok) * 256 + c8 * 8);
        float fa[8], fb[8], fc[8]; unpack8(a, fa); unpack8(bq, fb); unpack8(c, fc); float r[8];
#pragma unroll
        for (int e = 0; e < 8; ++e) r[e] = w0 * fa[e] + w1 * fb[e] + w2 * fc[e];
        u32x4 o; o.x = pk2(r[0], r[1]); o.y = pk2(r[2], r[3]); o.z = pk2(r[4], r[5]); o.w = pk2(r[6], r[7]);
        *(u32x4*)(Y + (size_t)tok * DM + c8 * 8) = o; }
}

__device__ __forceinline__ void conv_item(Frame& F, const bf16* Z, bf16* Y, const float* cw, const float* cb, const float* lg, const float* lb, int item) {
    const int tid = mytid(F), b = item >> 6, t0 = (item & 63) * 64;
    LAS float* HG = (LAS float*)F.lds;
    LAS float* WL = (LAS float*)(F.lds + 96256);
    f32x4 wq[4]; u32x4 uu[6], gg[6];
#pragma unroll
    for (int i = 0; i < 4; ++i) { const int q = tid + NTHREADS * i; wq[i] = (q < 31 * 64) ? *(const f32x4*)(cw + 4 * q) : (f32x4){0.f, 0.f, 0.f, 0.f}; }
#pragma unroll
    for (int i = 0; i < 6; ++i) { const int p = tid + NTHREADS * i, row = p >> 5, c8 = p & 31, t = t0 - 30 + row; uu[i] = (u32x4){0u, 0u, 0u, 0u}; gg[i] = uu[i];
        if (p < 94 * 32 && t >= 0) { const bf16* zr = Z + ((size_t)b * SEQ + t) * INW + ZB + c8 * 8; uu[i] = *(const u32x4*)zr; gg[i] = *(const u32x4*)(zr + 256); } }
#pragma unroll
    for (int i = 0; i < 4; ++i) { const int q = tid + NTHREADS * i; if (q < 31 * 64) *(LAS f32x4*)(WL + 4 * q) = wq[i]; }
#pragma unroll
    for (int i = 0; i < 6; ++i) { const int p = tid + NTHREADS * i, row = p >> 5, c8 = p & 31;
        if (p < 94 * 32) { float fu[8], fg[8], hv[8]; unpack8(uu[i], fu); unpack8(gg[i], fg);
#pragma unroll
            for (int e = 0; e < 8; ++e) hv[e] = fu[e] * __builtin_amdgcn_rcpf(1.0f + __expf(-fg[e]));
            LAS f32x4* d = (LAS f32x4*)(HG + row * 256 + c8 * 8); d[0] = (f32x4){hv[0], hv[1], hv[2], hv[3]}; d[1] = (f32x4){hv[4], hv[5], hv[6], hv[7]}; } }
    BAR();
    const int tg = tid >> 5, co = tid & 31;
    f32x4 acc[4][2];
    { const f32x4 b0 = *(const f32x4*)(cb + 8 * co), b1 = *(const f32x4*)(cb + 8 * co + 4);
#pragma unroll
        for (int t = 0; t < 4; ++t) { acc[t][0] = b0; acc[t][1] = b1; } }
    f32x4 wv[4][2];
#pragma unroll
    for (int d = 0; d < 4; ++d) { wv[d][0] = (f32x4){0.f, 0.f, 0.f, 0.f}; wv[d][1] = wv[d][0]; }
#pragma unroll 2
    for (int r = 0; r < 34; ++r) {
        const LAS float* hp = HG + (4 * tg + r) * 256 + 8 * co; const f32x4 h0 = *(const LAS f32x4*)hp, h1 = *(const LAS f32x4*)(hp + 4);
#pragma unroll
        for (int d = 3; d > 0; --d) { wv[d][0] = wv[d - 1][0]; wv[d][1] = wv[d - 1][1]; }
        if (r < 31) { wv[0][0] = *(const LAS f32x4*)(WL + r * 256 + 8 * co); wv[0][1] = *(const LAS f32x4*)(WL + r * 256 + 8 * co + 4); } else { wv[0][0] = (f32x4){0.f, 0.f, 0.f, 0.f}; wv[0][1] = wv[0][0]; }
#pragma unroll
        for (int t = 0; t < 4; ++t) { acc[t][0] += h0 * wv[t][0]; acc[t][1] += h1 * wv[t][1]; } }
    const f32x4 g0 = *(const f32x4*)(lg + 8 * co), g1 = *(const f32x4*)(lg + 8 * co + 4), be0 = *(const f32x4*)(lb + 8 * co), be1 = *(const f32x4*)(lb + 8 * co + 4);
#pragma unroll
    for (int t = 0; t < 4; ++t) { const f32x4 x0 = acc[t][0], x1 = acc[t][1];
        float s = ((x0[0] + x0[1]) + (x0[2] + x0[3])) + ((x1[0] + x1[1]) + (x1[2] + x1[3])); s = red8(s);
        const float mean = s * (1.0f / 64.0f); const f32x4 d0 = x0 - mean, d1 = x1 - mean;
        float ss = ((d0[0] * d0[0] + d0[1] * d0[1]) + (d0[2] * d0[2] + d0[3] * d0[3])) + ((d1[0] * d1[0] + d1[1] * d1[1]) + (d1[2] * d1[2] + d1[3] * d1[3])); ss = red8(ss);
        const float rstd = __builtin_amdgcn_rsqf(ss * (1.0f / 64.0f) + 1e-5f); float y[8];
#pragma unroll
        for (int e2 = 0; e2 < 4; ++e2) { const float a = d0[e2] * rstd * g0[e2] + be0[e2], c = d1[e2] * rstd * g1[e2] + be1[e2]; y[e2] = a * __builtin_amdgcn_rcpf(1.0f + __expf(-a)); y[4 + e2] = c * __builtin_amdgcn_rcpf(1.0f + __expf(-c)); }
        u32x4 o; o.x = pk2(y[0], y[1]); o.y = pk2(y[2], y[3]); o.z = pk2(y[4], y[5]); o.w = pk2(y[6], y[7]);
        *(u32x4*)(Y + ((size_t)b * SEQ + t0 + 4 * tg + t) * DM + 256 + 8 * co) = o; }
    BAR();
}

__device__ __forceinline__ bf16x8 ldfrag(const LAS unsigned char* base, int stride, int row0, int kb0, int fr, int g) {
    return *(const LAS bf16x8*)(base + (row0 + fr) * stride + kb0 + 16 * g);
}
#define MFMA16(a, b, c) __builtin_amdgcn_mfma_f32_16x16x32_bf16((a), (b), (c), 0, 0, 0)

constexpr int GL_G2 = 0, GL_Q = 2048, GL_K = 6144, GL_GK = 10240, GL_GD = 14336, GL_OG = 16384, GL_QT = 24576, GL_KB = 27136, GL_KHT = 29696, GL_VT = 32256, GL_ATT = 37376, GL_ST = 39936, GL_EC = 45056,
              GL_OB = 45184, GL_GB = 53376, GL_END = 53504;
struct GlaRaw { u32x4 p[2]; u32x4 s; };
__device__ __forceinline__ void gla_decode(int tid, int h, int it, int& tt, int& col, int& kind, int& off, bool& ok) {
    const int p = tid + 512 * it; ok = p < 832; tt = p / 26; const int qd = p % 26;
    if (qd < 4) { col = ZD + h * 32 + 8 * qd; kind = 0; off = tt * 32 + 8 * qd; }
    else if (qd < 8) { col = ZD + 128 + h * 32 + 8 * (qd - 4); kind = 1; off = tt * 32 + 8 * (qd - 4); }
    else if (qd < 16) { col = ZD + 256 + h * 64 + 8 * (qd - 8); kind = 2; off = 8 * (qd - 8); }
    else if (qd < 18) { col = ZD + 512 + 8 * (qd - 16); kind = 3; off = tt * 16 + 8 * (qd - 16); }
    else { col = ZD + 528 + h * 64 + 8 * (qd - 18); kind = 4; off = tt * 64 + 8 * (qd - 18); }
}
struct GlaAux { const unsigned char* qt; const unsigned char* kb; };
template <int STEP> __device__ __forceinline__ void gla_load(const bf16* Z, const unsigned char* sst, const GlaAux ax, int b, int h, int ch, int tid, GlaRaw& r) {
    const size_t item = (size_t)((b * 4 + h) * (SEQ / 32) + ch);
    if (STEP == 0) {
#pragma unroll
        for (int it = 0; it < 2; ++it) { int tt, col, kind, off; bool ok; gla_decode(tid, h, it, tt, col, kind, off, ok);
            r.p[it] = ok ? *(const u32x4*)(Z + ((size_t)b * SEQ + ch * 32 + tt) * INW + col) : (u32x4){0u, 0u, 0u, 0u}; }
    } else {
#pragma unroll
        for (int it = 0; it < 2; ++it) { const int p = tid + 512 * it;
            if (p < 128) r.p[it] = *(const u32x4*)(ax.qt + item * 2048 + 16 * p);
            else if (p < 256) r.p[it] = *(const u32x4*)(ax.kb + item * 2048 + 16 * (p - 128));
            else if (p < 768) { const int q = (p - 256) & 255, tt = q >> 3, c8 = q & 7; r.p[it] = *(const u32x4*)(Z + ((size_t)b * SEQ + ch * 32 + tt) * INW + ZD + (p < 512 ? 256 : 528) + h * 64 + 8 * c8); }
            else r.p[it] = *(const u32x4*)(sst + item * 4096 + 16 * (p - 768)); }
    }
}
template <int STEP> __device__ __forceinline__ void gla_item(Frame& F, const GlaRaw& raw, unsigned char* con, float* ecg, const GlaAux ax, bf16* Y, const float* ng, int b, int h, int ch) {
    const int tid = mytid(F), lane = tid & 63, w = __builtin_amdgcn_readfirstlane(tid >> 6), fr = lane & 15, g = lane >> 4;
    LAS unsigned char* L = F.lds;
    LAS float *G2 = (LAS float*)(L + GL_G2), *QF = (LAS float*)(L + GL_Q), *KF = (LAS float*)(L + GL_K), *GK = (LAS float*)(L + GL_GK), *GD = (LAS float*)(L + GL_GD), *OG = (LAS float*)(L + GL_OG),
              *OB = (LAS float*)(L + GL_OB), *GB = (LAS float*)(L + GL_GB);
    LAS unsigned char *QT = L + GL_QT, *KB = L + GL_KB, *KHT = L + GL_KHT, *VT = L + GL_VT, *ATT = L + GL_ATT, *ST = L + GL_ST;
    const size_t item = (size_t)((b * 4 + h) * (SEQ / 32) + ch);
    if (STEP == 0) {
#pragma unroll
        for (int it = 0; it < 2; ++it) { int tt, col, kind, off; bool ok; gla_decode(tid, h, it, tt, col, kind, off, ok);
            if (ok) { float f[8]; unpack8(raw.p[it], f);
                if (kind == 2) { LAS unsigned short* vp = (LAS unsigned short*)(VT + off * 80 + tt * 2); const u32x4 pr = raw.p[it];
                    vp[0 * 40] = (unsigned short)(pr.x & 0xffffu); vp[1 * 40] = (unsigned short)(pr.x >> 16); vp[2 * 40] = (unsigned short)(pr.y & 0xffffu); vp[3 * 40] = (unsigned short)(pr.y >> 16);
                    vp[4 * 40] = (unsigned short)(pr.z & 0xffffu); vp[5 * 40] = (unsigned short)(pr.z >> 16); vp[6 * 40] = (unsigned short)(pr.w & 0xffffu); vp[7 * 40] = (unsigned short)(pr.w >> 16); }
                else if (kind != 4) { LAS float* dst = (kind == 0 ? QF : kind == 1 ? KF : GD) + off; const float sc = kind == 0 ? 0.17677669529663687f : 1.0f;
                    ((LAS f32x4*)dst)[0] = (f32x4){f[0] * sc, f[1] * sc, f[2] * sc, f[3] * sc}; ((LAS f32x4*)dst)[1] = (f32x4){f[4] * sc, f[5] * sc, f[6] * sc, f[7] * sc}; } } }
        BAR();
#pragma unroll
        for (int it = 0; it < 2; ++it) { const int o = tid + 512 * it, tt = o >> 5, kk = o & 31; float x = GB[kk];
#pragma unroll
            for (int j = 0; j < 16; ++j) x += GD[tt * 16 + j] * G2[j * 32 + kk];
            GK[tt * 32 + kk] = -softplusf_(-x) * (1.0f / 16.0f); }
        BAR();
        { const int t = tid >> 4, k2 = (tid & 15) * 2; float c0 = 0.f, c1 = 0.f, b0 = 0.f, b1 = 0.f;
#pragma unroll 8
            for (int s = 0; s < 32; ++s) { const f32x2 gk = *(const LAS f32x2*)(GK + s * 32 + k2); c0 += gk[0]; c1 += gk[1]; if (s == t) { b0 = c0; b1 = c1; } }
            const f32x2 q = *(const LAS f32x2*)(QF + t * 32 + k2), k = *(const LAS f32x2*)(KF + t * 32 + k2);
            *(unsigned*)(ax.qt + item * 2048 + t * 64 + k2 * 2) = pk2(q[0] * __expf(b0), q[1] * __expf(b1)); *(unsigned*)(ax.kb + item * 2048 + t * 64 + k2 * 2) = pk2(k[0] * __expf(-b0), k[1] * __expf(-b1));
            *(LAS unsigned short*)(KHT + k2 * 80 + t * 2) = (unsigned short)f2bf(k[0] * __expf(c0 - b0)); *(LAS unsigned short*)(KHT + (k2 + 1) * 80 + t * 2) = (unsigned short)f2bf(k[1] * __expf(c1 - b1));
            if (t == 0) { ecg[item * 32 + k2] = __expf(c0); ecg[item * 32 + k2 + 1] = __expf(c1); } }
        BAR();
        { const int kb = w >> 2, vb = w & 3; f32x4 d = (f32x4){0.f, 0.f, 0.f, 0.f};
            d = MFMA16(ldfrag(KHT, 80, 16 * kb, 0, fr, g), ldfrag(VT, 80, 16 * vb, 0, fr, g), d);
            u32x2 so; so.x = pk2(d[0], d[1]); so.y = pk2(d[2], d[3]); *(u32x2*)(con + item * 4096 + (16 * vb + fr) * 64 + (16 * kb + 4 * g) * 2) = so; }
        BAR();
    } else {
#pragma unroll
        for (int it = 0; it < 2; ++it) { const int p = tid + 512 * it; const u32x4 pr = raw.p[it];
            if (p < 128) *(LAS u32x4*)(QT + (p >> 2) * 80 + (p & 3) * 16) = pr;
            else if (p < 256) { const int q = p - 128; *(LAS u32x4*)(KB + (q >> 2) * 80 + (q & 3) * 16) = pr; }
            else if (p < 512) { const int q = p - 256, tt = q >> 3, c8 = q & 7; LAS unsigned short* vp = (LAS unsigned short*)(VT + (8 * c8) * 80 + tt * 2);
                vp[0 * 40] = (unsigned short)(pr.x & 0xffffu); vp[1 * 40] = (unsigned short)(pr.x >> 16); vp[2 * 40] = (unsigned short)(pr.y & 0xffffu); vp[3 * 40] = (unsigned short)(pr.y >> 16);
                vp[4 * 40] = (unsigned short)(pr.z & 0xffffu); vp[5 * 40] = (unsigned short)(pr.z >> 16); vp[6 * 40] = (unsigned short)(pr.w & 0xffffu); vp[7 * 40] = (unsigned short)(pr.w >> 16); }
            else if (p < 768) { const int q = p - 512; float f[8]; unpack8(pr, f); LAS f32x4* dst = (LAS f32x4*)(OG + q * 8); dst[0] = (f32x4){f[0], f[1], f[2], f[3]}; dst[1] = (f32x4){f[4], f[5], f[6], f[7]}; }
            else { const int q = p - 768; *(LAS u32x4*)(ST + (q >> 2) * 80 + (q & 3) * 16) = pr; } }
        BAR();
        if (w < 3) { const int atb = w == 0 ? 0 : 1, asb = w == 2 ? 1 : 0;
            f32x4 d = (f32x4){0.f, 0.f, 0.f, 0.f}; d = MFMA16(ldfrag(KB, 80, 16 * asb, 0, fr, g), ldfrag(QT, 80, 16 * atb, 0, fr, g), d);
            const int t = 16 * atb + fr; float v[4];
#pragma unroll
            for (int r = 0; r < 4; ++r) { const int s = 16 * asb + 4 * g + r; v[r] = (s <= t) ? d[r] : 0.f; }
            u32x2 o; o.x = pk2(v[0], v[1]); o.y = pk2(v[2], v[3]); *(LAS u32x2*)(ATT + t * 80 + (16 * asb + 4 * g) * 2) = o; }
        else if (w == 3) { *(LAS u32x2*)(ATT + fr * 80 + (16 + 4 * g) * 2) = (u32x2){0u, 0u}; }
        BAR();
        { const int tb = w >> 2, vb = w & 3; f32x4 o = (f32x4){0.f, 0.f, 0.f, 0.f};
            o = MFMA16(ldfrag(ATT, 80, 16 * tb, 0, fr, g), ldfrag(VT, 80, 16 * vb, 0, fr, g), o);
            o = MFMA16(ldfrag(QT, 80, 16 * tb, 0, fr, g), ldfrag(ST, 80, 16 * vb, 0, fr, g), o);
#pragma unroll
            for (int r = 0; r < 4; ++r) OB[(16 * tb + 4 * g + r) * 64 + 16 * vb + fr] = o[r]; }
        BAR();
        { const int tt = tid >> 4, v4 = (tid & 15) * 4; const f32x4 o = *(const LAS f32x4*)(OB + tt * 64 + v4);
            float ss = (o[0] * o[0] + o[1] * o[1]) + (o[2] * o[2] + o[3] * o[3]); ss = red16(ss);
            const float rs = __builtin_amdgcn_rsqf(ss * (1.0f / 64.0f) + NORM_EPS); const f32x4 gv = *(const f32x4*)(ng + v4), og = *(const LAS f32x4*)(OG + tt * 64 + v4); float y[4];
#pragma unroll
            for (int e = 0; e < 4; ++e) y[e] = o[e] * rs * gv[e] * og[e] * __builtin_amdgcn_rcpf(1.0f + __expf(-og[e]));
            u32x2 wv; wv.x = pk2(y[0], y[1]); wv.y = pk2(y[2], y[3]); *(u32x2*)(Y + ((size_t)b * SEQ + ch * 32 + tt) * DM + 768 + h * 64 + v4) = wv; }
        BAR();
    }
}
__device__ __forceinline__ int gla_sched(int k, int wi, int nw, int skip) { const int full = 1024 / nw, rem = 1024 - full * nw; if (k < full) return k * nw + wi; if (k == full && wi >= skip && wi - skip < rem) return full * nw + wi - skip; return -1; }
template <int STEP> __device__ __forceinline__ void gla_items(Frame& F, const bf16* Z, unsigned char* con, float* ecg, const GlaAux ax, bf16* Y, const float* g2, const float* gb, const float* ng, int wi, int nw, int skip) {
    const int tid = mytid(F);
#pragma unroll 1
    for (int h = 0; h < 4; ++h) {
        ((LAS float*)(F.lds + GL_G2))[tid] = g2[(tid >> 5) * 128 + h * 32 + (tid & 31)]; if (tid < 32) ((LAS float*)(F.lds + GL_GB))[tid] = gb[h * 32 + tid];
        BAR();
        GlaRaw cur, nxt; cur.p[0] = (u32x4){0u, 0u, 0u, 0u}; cur.p[1] = cur.p[0]; cur.s = cur.p[0]; nxt = cur;
        int it = gla_sched(0, wi, nw, skip);
        if (it >= 0) gla_load<STEP>(Z, con, ax, it >> 7, h, it & 127, tid, cur);
#pragma unroll 1
        for (int k = 0; it >= 0; ++k) { const int nx = gla_sched(k + 1, wi, nw, skip);
            if (nx >= 0) gla_load<STEP>(Z, con, ax, nx >> 7, h, nx & 127, tid, nxt);
            gla_item<STEP>(F, cur, con, ecg, ax, Y, ng, it >> 7, h, it & 127);
            cur = nxt; it = nx; }
        BAR(); }
}
__device__ __forceinline__ void gla_scan(Frame& F, unsigned char* con, const float* ecg, int b, int h) {
    const int tid = mytid(F); const int k4 = (tid & 7) * 4;
    unsigned char* base = con + (size_t)((b * 4 + h) * (SEQ / 32)) * 4096 + 8 * tid; const float* eb = ecg + (size_t)((b * 4 + h) * (SEQ / 32)) * 32 + k4;
    float s[4] = {0.f, 0.f, 0.f, 0.f};
    u32x2 cn[4]; f32x4 ec[4];
#pragma unroll
    for (int j = 0; j < 4; ++j) { cn[j] = *(const u32x2*)(base + (size_t)j * 4096); ec[j] = *(const f32x4*)(eb + j * 32); }
#pragma unroll 1
    for (int c0 = 0; c0 < SEQ / 32; c0 += 4) {
        u32x2 cc[4]; f32x4 ee[4];
#pragma unroll
        for (int j = 0; j < 4; ++j) { cc[j] = cn[j]; ee[j] = ec[j]; }
        if (c0 + 4 < SEQ / 32) {
#pragma unroll
            for (int j = 0; j < 4; ++j) { cn[j] = *(const u32x2*)(base + (size_t)(c0 + 4 + j) * 4096); ec[j] = *(const f32x4*)(eb + (c0 + 4 + j) * 32); } }
#pragma unroll
        for (int j = 0; j < 4; ++j) { u32x2 o; o.x = pk2(s[0], s[1]); o.y = pk2(s[2], s[3]); *(u32x2*)(base + (size_t)(c0 + j) * 4096) = o;
            s[0] = ee[j][0] * s[0] + bflo(cc[j].x); s[1] = ee[j][1] * s[1] + bfhi(cc[j].x); s[2] = ee[j][2] * s[2] + bflo(cc[j].y); s[3] = ee[j][3] * s[3] + bfhi(cc[j].y); } }
}

struct RwkvP { const float *mu, *w0, *w2, *a0, *a2, *g2, *kk, *ka, *rk, *lg, *lb; };
constexpr int RC_AT = 0  , RC_RT = 2048  , RC_ZT = 4096, RC_RBK = 5120, RC_BKT = 6144  , RC_VT4 = 10240  ,
              RC_GC = 12288  , RC_G = 12544  , RC_BON = 14592  , RC_BYTES = 14656, RC_STRIDE = 14848;
constexpr int RC_CHUNKS16 = RC_BYTES / 16;
static_assert((size_t)NB * 4 * (SEQ / 16) * RC_STRIDE <= NEXP * MOEW_E_BYTES, "RWKV records overlay the (not yet converted) MoE weight region");
constexpr int RW_W2T = 0, RW_A2T = 5120, RW_G2T = 10240, RW_MU = 19456  , RW_TW = 23040, RW_AD = 24320, RW_SG = 25600, RW_R = 27904  , RW_K = 32256  , RW_V = 36608  , RW_WL = 40704  , RW_AL = 45056  ,
              RW_G = 49408  , RW_SS = 53504  , RW_BONP = 53568  , RW_BON = 60672, RW_GC = 60736, RW_AR = 60992, RW_BK = 65600, RW_BKT = 70208, RW_ZAK = 75328, RW_RBK = 76608, RW_AAB = 77888, RW_TT = 78912  , RW_PAR = 80192  , RW_END = 81472;

__device__ __forceinline__ void rwkv_prep_init(Frame& F, const RwkvP P, int h) {
    const int tid = mytid(F); LAS unsigned char* L = F.lds;
    for (int i = tid; i < 64 * 32; i += NTHREADS) { const int c = i >> 5, j = i & 31;
        *(LAS unsigned short*)(L + RW_W2T + c * 80 + j * 2) = (unsigned short)f2bf(P.w2[j * 256 + h * 64 + c]); *(LAS unsigned short*)(L + RW_A2T + c * 80 + j * 2) = (unsigned short)f2bf(P.a2[j * 256 + h * 64 + c]); }
    for (int i = tid; i < 64 * 64; i += NTHREADS) { const int c = i >> 6, j = i & 63; *(LAS unsigned short*)(L + RW_G2T + c * 144 + j * 2) = (unsigned short)f2bf(P.g2[j * 256 + h * 64 + c]); }
    for (int i = tid; i < 896; i += NTHREADS) ((LAS float*)(L + RW_MU))[i] = P.mu[i];
    if (tid < 320) { const int q = tid >> 6, c = tid & 63; const float* src = q == 0 ? P.w0 : q == 1 ? P.a0 : q == 2 ? P.kk : q == 3 ? P.ka : P.rk; ((LAS float*)(L + RW_PAR))[tid] = src[h * 64 + c]; }
}
__device__ __forceinline__ void rwkv_prep_load(const bf16* Z, int b, int h, int ch, int w, int lane, u32x4 (&cur)[2], u32x4 (&prv)[2]) {
    const int kind = w & 3, p = (w >> 2) * 64 + lane, tt = p >> 3, j = p & 7;
    const int col = (kind < 3 ? ZC + kind * 256 + h * 64 : ZC + 832) + 8 * j;
    const int t = ch * 16 + tt; const bf16* zr = Z + ((size_t)b * SEQ + t) * INW + col;
    cur[0] = *(const u32x4*)zr; prv[0] = (t > 0) ? *(const u32x4*)(zr - INW) : (u32x4){0u, 0u, 0u, 0u};
    if (w < 2) { const int t2 = ch * 16 + (lane >> 2); const bf16* z2 = Z + ((size_t)b * SEQ + t2) * INW + ZC + 768 + w * 32 + 8 * (lane & 3);
        cur[1] = *(const u32x4*)z2; prv[1] = (t2 > 0) ? *(const u32x4*)(z2 - INW) : (u32x4){0u, 0u, 0u, 0u}; }
    else { cur[1] = (u32x4){0u, 0u, 0u, 0u}; prv[1] = cur[1]; }
}
__device__ __forceinline__ void rwkv_prep_item(Frame& F, unsigned char* rec, const RwkvP P, int h, const u32x4 (&cur)[2], const u32x4 (&prv)[2]) {
    const int tid = mytid(F), lane = tid & 63, w = __builtin_amdgcn_readfirstlane(tid >> 6), fr = lane & 15, g = lane >> 4;
    LAS unsigned char* L = F.lds;
#if defined(PROBE_PI)
    unsigned long long tl_ = __builtin_amdgcn_s_memrealtime(), ta_ = 0;
#define PIT(k) do { const unsigned long long tn_ = __builtin_amdgcn_s_memrealtime(); if ((k) == PROBE_PI) ta_ += tn_ - tl_; tl_ = tn_; } while (0)
#else
#define PIT(k) do { } while (0)
#endif
    LAS float *R = (LAS float*)(L + RW_R), *KR = (LAS float*)(L + RW_K), *V = (LAS float*)(L + RW_V), *WL = (LAS float*)(L + RW_WL), *AL = (LAS float*)(L + RW_AL), *G = (LAS float*)(L + RW_G),
              *SS = (LAS float*)(L + RW_SS), *BONP = (LAS float*)(L + RW_BONP), *GC = (LAS float*)(L + RW_GC), *AAB = (LAS float*)(L + RW_AAB), *MU = (LAS float*)(L + RW_MU);
    { const int kind = w & 3, p = (w >> 2) * 64 + lane, tt = p >> 3, j = p & 7; float fc[8], fp[8], x[8]; unpack8(cur[0], fc); unpack8(prv[0], fp);
        const LAS float* mu = MU + (kind < 3 ? kind * 256 + h * 64 : 832) + 8 * j;
#pragma unroll
        for (int e = 0; e < 8; ++e) x[e] = fc[e] + (fp[e] - fc[e]) * mu[e];
        if (kind < 3) { LAS f32x4* d = (LAS f32x4*)((kind == 0 ? R : kind == 1 ? KR : V) + tt * (kind == 2 ? 64 : 68) + 8 * j); d[0] = (f32x4){x[0], x[1], x[2], x[3]}; d[1] = (f32x4){x[4], x[5], x[6], x[7]};
            if (kind == 1) { const LAS float* kkp = (const LAS float*)(L + RW_PAR) + 128 + 8 * j; float ss = 0.f;
#pragma unroll
                for (int e = 0; e < 8; ++e) { const float kv = x[e] * kkp[e]; ss += kv * kv; }
                ss = red8(ss); if (j == 0) SS[tt] = ss; } }
        else {
#pragma unroll
            for (int e = 0; e < 8; ++e) x[e] = __builtin_amdgcn_rcpf(1.0f + __expf(-x[e]));
            u32x4 o; o.x = pk2(x[0], x[1]); o.y = pk2(x[2], x[3]); o.z = pk2(x[4], x[5]); o.w = pk2(x[6], x[7]); *(LAS u32x4*)(L + RW_SG + tt * 144 + 16 * j) = o; }
        if (w < 2) { const int t2 = lane >> 2, j2 = lane & 3; unpack8(cur[1], fc); unpack8(prv[1], fp); const LAS float* mu2 = MU + 768 + w * 32 + 8 * j2;
#pragma unroll
            for (int e = 0; e < 8; ++e) { x[e] = fc[e] + (fp[e] - fc[e]) * mu2[e]; if (w == 0) x[e] = 2.0f * __builtin_amdgcn_rcpf(1.0f + __expf(-2.0f * x[e])) - 1.0f; }
            u32x4 o; o.x = pk2(x[0], x[1]); o.y = pk2(x[2], x[3]); o.z = pk2(x[4], x[5]); o.w = pk2(x[6], x[7]); *(LAS u32x4*)(L + (w == 0 ? RW_TW : RW_AD) + t2 * 80 + 16 * j2) = o; } }
    BAR(); PIT(0);
    if (w < 4) { f32x4 dw = (f32x4){0.f, 0.f, 0.f, 0.f}, da = dw;
        dw = MFMA16(ldfrag(L + RW_W2T, 80, 16 * w, 0, fr, g), ldfrag(L + RW_TW, 80, 0, 0, fr, g), dw);
        da = MFMA16(ldfrag(L + RW_A2T, 80, 16 * w, 0, fr, g), ldfrag(L + RW_AD, 80, 0, 0, fr, g), da);
        *(LAS f32x4*)(WL + fr * 68 + 16 * w + 4 * g) = dw; *(LAS f32x4*)(AL + fr * 68 + 16 * w + 4 * g) = da; }
    else { const int cb = w - 4; f32x4 dg = (f32x4){0.f, 0.f, 0.f, 0.f};
        dg = MFMA16(ldfrag(L + RW_G2T, 144, 16 * cb, 0, fr, g), ldfrag(L + RW_SG, 144, 0, 0, fr, g), dg);
        dg = MFMA16(ldfrag(L + RW_G2T, 144, 16 * cb, 64, fr, g), ldfrag(L + RW_SG, 144, 0, 64, fr, g), dg);
        *(LAS f32x4*)(G + fr * 64 + 16 * cb + 4 * g) = dg; }
    BAR(); PIT(1);
    { const int cp = tid >> 4, t = tid & 15, c2 = 2 * cp; const LAS float* PAR = (const LAS float*)(L + RW_PAR) + c2;
        const f32x2 wl = *(const LAS f32x2*)(WL + t * 68 + c2) + *(const LAS f32x2*)(PAR), al = *(const LAS f32x2*)(AL + t * 68 + c2) + *(const LAS f32x2*)(PAR + 64);
        const f32x2 kr = *(const LAS f32x2*)(KR + t * 68 + c2), rr = *(const LAS f32x2*)(R + t * 68 + c2);
        const f32x2 kkw = *(const LAS f32x2*)(PAR + 128), kaw = *(const LAS f32x2*)(PAR + 192), rkw = *(const LAS f32x2*)(PAR + 256);
        const float inv = 1.0f / fmaxf(sqrtf(SS[t]), 1e-12f);
        float lw[2], a[2], kk[2], kp[2], cs[2], tot[2]; float bon = 0.f;
#pragma unroll
        for (int e = 0; e < 2; ++e) { const float wlog = -softplusf_(-wl[e]) - 0.5f; lw[e] = -__expf(wlog); a[e] = __builtin_amdgcn_rcpf(1.0f + __expf(-al[e])); kk[e] = kr[e] * kkw[e] * inv;
            kp[e] = kr[e] * (1.0f + (a[e] - 1.0f) * kaw[e]); bon += rr[e] * kp[e] * rkw[e];
            float x = lw[e];
            x += __builtin_bit_cast(float, __builtin_amdgcn_update_dpp(0, __builtin_bit_cast(int, x), 0x111, 0xf, 0xf, true));
            x += __builtin_bit_cast(float, __builtin_amdgcn_update_dpp(0, __builtin_bit_cast(int, x), 0x112, 0xf, 0xf, true));
            x += __builtin_bit_cast(float, __builtin_amdgcn_update_dpp(0, __builtin_bit_cast(int, x), 0x114, 0xf, 0xf, true));
            x += __builtin_bit_cast(float, __builtin_amdgcn_update_dpp(0, __builtin_bit_cast(int, x), 0x118, 0xf, 0xf, true));
            cs[e] = x; tot[e] = __shfl(x, lane | 15); }
        bon += __shfl_xor(bon, 16); bon += __shfl_xor(bon, 32); if (lane < 16) BONP[t * 8 + w] = bon;
        float at[2], rt[2], bb[2], kb[2], bh[2], kh[2];
#pragma unroll
        for (int e = 0; e < 2; ++e) { const float eP = __expf(cs[e] - lw[e]), eT = __expf(cs[e]), eI = __expf(-cs[e]), eC = __expf(tot[e] - cs[e]); const float bv = kk[e] * a[e];
            at[e] = -kk[e] * eP; rt[e] = rr[e] * eT; bb[e] = bv * eI; kb[e] = kp[e] * eI; bh[e] = bv * eC; kh[e] = kp[e] * eC; }
        *(LAS unsigned*)(L + RW_AR + t * 144 + c2 * 2) = pk2(at[0], at[1]); *(LAS unsigned*)(L + RW_AR + (16 + t) * 144 + c2 * 2) = pk2(rt[0], rt[1]);
        *(LAS unsigned*)(L + RW_BK + t * 144 + c2 * 2) = pk2(bb[0], bb[1]); *(LAS unsigned*)(L + RW_BK + (16 + t) * 144 + c2 * 2) = pk2(kb[0], kb[1]);
#pragma unroll
        for (int e = 0; e < 2; ++e) { *(LAS unsigned short*)(L + RW_BKT + (c2 + e) * 80 + t * 2) = (unsigned short)f2bf(bh[e]); *(LAS unsigned short*)(L + RW_BKT + (c2 + e) * 80 + (16 + t) * 2) = (unsigned short)f2bf(kh[e]); }
        if (t == 15) { GC[c2] = __expf(cs[0]); GC[c2 + 1] = __expf(cs[1]); } }
    BAR(); PIT(2);
    PIT(3);
    if (w < 4) { const int arow = (w & 1) ? 16 : 0  , brow = (w & 2) ? 16 : 0  ;
        f32x4 d = (f32x4){0.f, 0.f, 0.f, 0.f};
        d = MFMA16(ldfrag(L + RW_BK, 144, arow, 0, fr, g), ldfrag(L + RW_AR, 144, brow, 0, fr, g), d);
        d = MFMA16(ldfrag(L + RW_BK, 144, arow, 64, fr, g), ldfrag(L + RW_AR, 144, brow, 64, fr, g), d);
        const int t = fr; float v[4];
#pragma unroll
        for (int r = 0; r < 4; ++r) { const int s = 4 * g + r; const bool keep = (w < 2) ? (s < t) : (s <= t); v[r] = keep ? d[r] : 0.f; }
        if (w == 0) { AAB[(4 * g + 0) * 16 + t] = v[0]; AAB[(4 * g + 1) * 16 + t] = v[1]; AAB[(4 * g + 2) * 16 + t] = v[2]; AAB[(4 * g + 3) * 16 + t] = v[3]; }
        else { u32x2 o; o.x = pk2(v[0], v[1]); o.y = pk2(v[2], v[3]);
            LAS unsigned char* dst = (w == 1) ? (L + RW_ZAK + t * 80 + (16 + 4 * g) * 2) : (w == 2) ? (L + RW_RBK + t * 80 + (4 * g) * 2) : (L + RW_RBK + t * 80 + (16 + 4 * g) * 2);
            *(LAS u32x2*)dst = o; } }
    BAR(); PIT(4);
    if (w == 7) { if (lane < 16) { float col[16];
#pragma unroll
            for (int t = 0; t < 16; ++t) col[t] = (t == lane) ? 1.0f : 0.f;
#pragma unroll
            for (int s = 0; s < 15; ++s) { const f32x4 a0 = *(const LAS f32x4*)(AAB + s * 16), a1 = *(const LAS f32x4*)(AAB + s * 16 + 4), a2 = *(const LAS f32x4*)(AAB + s * 16 + 8), a3 = *(const LAS f32x4*)(AAB + s * 16 + 12);
                const float as[16] = {a0[0], a0[1], a0[2], a0[3], a1[0], a1[1], a1[2], a1[3], a2[0], a2[1], a2[2], a2[3], a3[0], a3[1], a3[2], a3[3]};
#pragma unroll
                for (int t = s + 1; t < 16; ++t) col[t] += as[t] * col[s]; }
#pragma unroll
            for (int t = 0; t < 16; ++t) *(LAS unsigned short*)(L + RW_TT + t * 80 + lane * 2) = (unsigned short)f2bf(col[t]); }
        LDS_WAIT();
        { const u32x2 lo = *(const LAS u32x2*)(L + RW_TT + fr * 80 + 8 * g), hi = *(const LAS u32x2*)(L + RW_ZAK + fr * 80 + 32 + 8 * g); u32x4 o; o.x = lo.x; o.y = lo.y; o.z = hi.x; o.w = hi.y;
            *(u32x4*)(rec + RC_ZT + fr * 64 + 16 * g) = o; } }
    else {
#pragma unroll 1
        for (int job = w; job < 16; job += 7) {
            if (job < 9) { int src, stride, row0, ka, kb2, dst;
                if (job < 4) { src = RW_AR; stride = 144; row0 = (job >> 1) * 16; ka = 32 * (job & 1); kb2 = ka + 16; dst = (job >> 1 ? RC_RT : RC_AT) + (job & 1) * 1024; }
                else if (job == 4) { src = RW_RBK; stride = 80; row0 = 0; ka = 0; kb2 = 16; dst = RC_RBK; }
                else { src = RW_BKT; stride = 80; row0 = 16 * (job - 5); ka = 0; kb2 = 16; dst = RC_BKT + (job - 5) * 1024; }
                const LAS unsigned char* rp = L + src + (row0 + fr) * stride + 8 * g; const u32x2 lo = *(const LAS u32x2*)(rp + ka * 2), hi = *(const LAS u32x2*)(rp + kb2 * 2);
                u32x4 o; o.x = lo.x; o.y = lo.y; o.z = hi.x; o.w = hi.y; *(u32x4*)(rec + dst + fr * 64 + 16 * g) = o; }
            else if (job < 13) { const int vb = job - 9; const LAS float* vp = V + (4 * g) * 64 + 16 * vb + fr; u32x2 o; o.x = pk2(vp[0], vp[64]); o.y = pk2(vp[128], vp[192]); *(u32x2*)(rec + RC_VT4 + vb * 512 + lane * 8) = o; }
            else { const int p = (job - 13) * 64 + lane;
                if (p < 16) *(f32x4*)(rec + RC_GC + 16 * p) = *(const LAS f32x4*)(GC + 4 * p);
                else if (p < 144) { const int q = p - 16; const f32x4 a = *(const LAS f32x4*)(G + q * 8), c = *(const LAS f32x4*)(G + q * 8 + 4); u32x4 o; o.x = pk2(a[0], a[1]); o.y = pk2(a[2], a[3]); o.z = pk2(c[0], c[1]); o.w = pk2(c[2], c[3]); *(u32x4*)(rec + RC_G + 16 * q) = o; }
                else if (p < 160) { const int t = p - 144; float bsum = 0.f;
#pragma unroll
                    for (int ww = 0; ww < 8; ++ww) bsum += BONP[t * 8 + ww];
                    ((float*)(rec + RC_BON))[t] = bsum; } } } }
    BAR(); PIT(5);
#if defined(PROBE_PI)
    if (blockIdx.x == 0 && threadIdx.x == 0) ((unsigned long long*)(F.ws + 32768))[0] += ta_;
#endif
}

constexpr int SB_STRIDE = 16384, SB_NBUF = 7, SB_AHEAD = 5, ST_OB = SB_NBUF * SB_STRIDE  , ST_END = ST_OB + 8192;
static_assert(ST_END <= RING_BYTES && RC_BYTES <= SB_STRIDE, "state pass LDS");
__device__ __forceinline__ void rwkv_state(Frame& F, const unsigned char* recs, bf16* Y, const RwkvP P, int b, int h) {
    const int tid = mytid(F), lane = tid & 63, w = __builtin_amdgcn_readfirstlane(tid >> 6), fr = lane & 15, g = lane >> 4;
    LAS unsigned char* L = F.lds;
    const unsigned char* rbase = recs + (size_t)(b * 4 + h) * (SEQ / 16) * RC_STRIDE;
    const int lt = tid - 256;
    const f32x4 plg = *(const f32x4*)(P.lg + h * 64 + (tid & 15) * 4), plb = *(const f32x4*)(P.lb + h * 64 + (tid & 15) * 4);
    asm volatile("s_waitcnt vmcnt(0)" ::: "memory");
    f32x4 accS[4];
#pragma unroll
    for (int i = 0; i < 4; ++i) accS[i] = (f32x4){0.f, 0.f, 0.f, 0.f};
    constexpr int NCH = SEQ / 16;
#define RW_ISSUE(r) do { const unsigned char* gp_ = rbase + (size_t)(r) * RC_STRIDE + (w * 256 + lane) * 16; LAS unsigned char* lp_ = L + ((r) % SB_NBUF) * SB_STRIDE + w * 4096; \
        _Pragma("unroll") for (int i_ = 0; i_ < 4; ++i_) __builtin_amdgcn_global_load_lds((const unsigned*)(gp_ + i_ * 1024), (LAS unsigned*)(lp_ + i_ * 1024), 16, 0, 0); } while (0)
    if (w < 4) {
#pragma unroll 1
        for (int r = 0; r < SB_AHEAD; ++r) RW_ISSUE(r);
        asm volatile("s_waitcnt vmcnt(16)" ::: "memory"); }
    BAR();
#pragma unroll 1
    for (int c = 0; c <= NCH; ++c) {
        if (w >= 4) {
            if (c >= 1) { const int ce = c - 1; const LAS unsigned char* B = L + (ce % SB_NBUF) * SB_STRIDE; const LAS float* OB = (const LAS float*)(L + ST_OB + (ce & 1) * 4096);
                const int tt = lt >> 4, c4 = (lt & 15) * 4; const f32x4 o = *(const LAS f32x4*)(OB + tt * 64 + c4);
                float s = (o[0] + o[1]) + (o[2] + o[3]); s = red16(s); const float mean = s * (1.0f / 64.0f); const f32x4 d = o - mean;
                float ss = (d[0] * d[0] + d[1] * d[1]) + (d[2] * d[2] + d[3] * d[3]); ss = red16(ss); const float rstd = __builtin_amdgcn_rsqf(ss * (1.0f / 64.0f) + 64e-5f);
                const u32x2 gw = *(const LAS u32x2*)(B + RC_G + tt * 128 + c4 * 2); const float bon = ((const LAS float*)(B + RC_BON))[tt];
                const LAS unsigned short* vq = (const LAS unsigned short*)(B + RC_VT4 + (c4 >> 4) * 512 + ((tt >> 2) * 16 + (c4 & 15)) * 8 + (tt & 3) * 2);
                const float vv[4] = {bf1(vq[0]), bf1(vq[4]), bf1(vq[8]), bf1(vq[12])}, gg[4] = {bflo(gw.x), bfhi(gw.x), bflo(gw.y), bfhi(gw.y)}; float y[4];
#pragma unroll
                for (int e = 0; e < 4; ++e) y[e] = (d[e] * rstd * plg[e] + plb[e] + bon * vv[e]) * gg[e];
                u32x2 wv; wv.x = pk2(y[0], y[1]); wv.y = pk2(y[2], y[3]); *(u32x2*)(Y + ((size_t)b * SEQ + ce * 16 + tt) * DM + 512 + h * 64 + c4) = wv; }
        } else {
            if (c + SB_AHEAD < NCH) RW_ISSUE(c + SB_AHEAD);
            if (c < NCH) { const int vb = w; const LAS unsigned char* B = L + (c % SB_NBUF) * SB_STRIDE; LAS float* OB = (LAS float*)(L + ST_OB + (c & 1) * 4096); const int fo = fr * 64 + 16 * g;
                const bf16x8 at0 = *(const LAS bf16x8*)(B + RC_AT + fo), at1 = *(const LAS bf16x8*)(B + RC_AT + 1024 + fo), rt0 = *(const LAS bf16x8*)(B + RC_RT + fo), rt1 = *(const LAS bf16x8*)(B + RC_RT + 1024 + fo);
                const bf16x8 zt = *(const LAS bf16x8*)(B + RC_ZT + fo), rbk = *(const LAS bf16x8*)(B + RC_RBK + fo); const u32x2 v4 = *(const LAS u32x2*)(B + RC_VT4 + vb * 512 + lane * 8);
                u32x4 sw0, sw1; sw0.x = pk2(accS[0][0], accS[0][1]); sw0.y = pk2(accS[0][2], accS[0][3]); sw0.z = pk2(accS[1][0], accS[1][1]); sw0.w = pk2(accS[1][2], accS[1][3]);
                sw1.x = pk2(accS[2][0], accS[2][1]); sw1.y = pk2(accS[2][2], accS[2][3]); sw1.z = pk2(accS[3][0], accS[3][1]); sw1.w = pk2(accS[3][2], accS[3][3]);
                const bf16x8 s0 = __builtin_bit_cast(bf16x8, sw0), s1 = __builtin_bit_cast(bf16x8, sw1);
                f32x4 y = (f32x4){0.f, 0.f, 0.f, 0.f}, accO = y;
                y = MFMA16(at0, s0, y); y = MFMA16(at1, s1, y); accO = MFMA16(rt0, s0, accO); accO = MFMA16(rt1, s1, accO);
                u32x4 bw; bw.x = 0u; bw.y = 0u; bw.z = v4.x; bw.w = v4.y; y = MFMA16(zt, __builtin_bit_cast(bf16x8, bw), y);
                bw.x = pk2(y[0], y[1]); bw.y = pk2(y[2], y[3]); bw.z = 0u; bw.w = 0u; f32x4 u = (f32x4){0.f, 0.f, 0.f, 0.f}; u = MFMA16(zt, __builtin_bit_cast(bf16x8, bw), u);
                bw.x = pk2(u[0], u[1]); bw.y = pk2(u[2], u[3]); bw.z = v4.x; bw.w = v4.y; const bf16x8 uv = __builtin_bit_cast(bf16x8, bw);
                accO = MFMA16(rbk, uv, accO);
#pragma unroll
                for (int r = 0; r < 4; ++r) OB[(4 * g + r) * 64 + 16 * vb + fr] = accO[r];
#pragma unroll
                for (int kb = 0; kb < 4; ++kb) { const f32x4 gc = *(const LAS f32x4*)(B + RC_GC + (16 * kb + 4 * g) * 4); accS[kb] = accS[kb] * gc; accS[kb] = MFMA16(*(const LAS bf16x8*)(B + RC_BKT + kb * 1024 + fo), uv, accS[kb]); } }
            if (c + SB_AHEAD < NCH) asm volatile("s_waitcnt vmcnt(16)" ::: "memory"); else asm volatile("s_waitcnt vmcnt(0)" ::: "memory");
        }
        BAR();
    }
#undef RW_ISSUE
}

__device__ __forceinline__ void moe_route(Frame& F, const bf16* hres, const float* gffn, const float* router) {
    const int tid = mytid(F), lane = tid & 63, wave = __builtin_amdgcn_readfirstlane(tid >> 6); (void)lane; (void)wave;
    unsigned char* rt = F.ws + WS_RT;
    int* tope = (int*)(rt + RT_TOPE); float* gate = (float*)(rt + RT_GATE); int* rank = (int*)(rt + RT_RANK); float* rstd = (float*)(rt + RT_RSTD); int* hist = (int*)(rt + RT_HIST); int* rowtok = (int*)(rt + RT_ROWTOK);
    LAS float* RW = (LAS float*)F.lds;
    LAS int* LH = (LAS int*)(F.lds + 32768);
    for (int i = tid; i < 8192; i += NTHREADS) RW[i] = router[i];
    if (tid < 16) LH[tid] = 0;
    for (int i = F.blk * NTHREADS + tid; i < 2 * MOE_ROWS; i += F.G * NTHREADS) rowtok[i] = -1;
    __syncthreads();
    const int tpb = NTOK / F.G;
    for (int i = wave; i < tpb; i += NWAVES) { const int t = F.blk * tpb + i;
        const u32x2* hr = (const u32x2*)(hres + (size_t)t * DM) + lane; f32x4 v[4]; float ss = 0.f;
#pragma unroll
        for (int j = 0; j < 4; ++j) { const u32x2 hw = hr[64 * j]; v[j] = (f32x4){bflo(hw.x), bfhi(hw.x), bflo(hw.y), bfhi(hw.y)}; ss += (v[j][0] * v[j][0] + v[j][1] * v[j][1]) + (v[j][2] * v[j][2] + v[j][3] * v[j][3]); }
        ss = wave_sum(ss); const float rs = __builtin_amdgcn_rsqf(ss * (1.0f / DM) + NORM_EPS);
        float lg[8];
#pragma unroll
        for (int e = 0; e < 8; ++e) lg[e] = 0.f;
#pragma unroll
        for (int j = 0; j < 4; ++j) { const f32x4 gv = *((const f32x4*)gffn + 64 * j + lane);
#pragma unroll
            for (int c = 0; c < 4; ++c) { const int k = 256 * j + 4 * lane + c; const float xn = v[j][c] * rs * gv[c]; const f32x4 r0 = *(const LAS f32x4*)(RW + k * 8), r1 = *(const LAS f32x4*)(RW + k * 8 + 4);
                lg[0] += xn * r0[0]; lg[1] += xn * r0[1]; lg[2] += xn * r0[2]; lg[3] += xn * r0[3]; lg[4] += xn * r1[0]; lg[5] += xn * r1[1]; lg[6] += xn * r1[2]; lg[7] += xn * r1[3]; } }
#pragma unroll
        for (int e = 0; e < 8; ++e) lg[e] = wave_sum(lg[e]);
        int i1 = 0; float m1 = lg[0];
#pragma unroll
        for (int e = 1; e < 8; ++e) if (lg[e] > m1) { m1 = lg[e]; i1 = e; }
        int i2 = -1; float m2 = -3.0e38f;
#pragma unroll
        for (int e = 0; e < 8; ++e) if (e != i1 && lg[e] > m2) { m2 = lg[e]; i2 = e; }
        if (lane == 0) { const float g1 = 1.0f / (1.0f + __expf(m2 - m1));
            const int r1 = atomicAdd((int*)&LH[i1], 1), r2 = atomicAdd((int*)&LH[8 + i2], 1);
            tope[2 * t] = i1; tope[2 * t + 1] = i2; gate[2 * t] = g1; gate[2 * t + 1] = 1.0f - g1; rank[2 * t] = r1; rank[2 * t + 1] = r2; rstd[t] = rs; }
    }
    __syncthreads();
    if (tid < 16) hist[F.blk * 16 + tid] = LH[tid];
}
__device__ __forceinline__ void moe_gather(Frame& F, int slot, const bf16* hb, bf16* asort) {
    const int tid = mytid(F), lane = tid & 63, wave = __builtin_amdgcn_readfirstlane(tid >> 6); (void)lane; (void)wave;
    unsigned char* rt = F.ws + WS_RT;
    const int* tope = (const int*)(rt + RT_TOPE); const float* gate = (const float*)(rt + RT_GATE); const int* rank = (const int*)(rt + RT_RANK); const float* rstd = (const float*)(rt + RT_RSTD); const int* hist = (const int*)(rt + RT_HIST);
    int* rowtok = (int*)(rt + RT_ROWTOK) + slot * MOE_ROWS; float* rowgate = (float*)(rt + RT_ROWGATE) + slot * MOE_ROWS; float* rowrstd = (float*)(rt + RT_ROWRSTD) + slot * MOE_ROWS;
    int* tilee = (int*)(rt + RT_TILEE) + slot * 256; int* ntiles = (int*)(rt + RT_NTILES);
    LAS int* BASE = (LAS int*)(F.lds + 40960);
    LAS int* TOT = BASE + 8;
    __syncthreads();
    LAS int* HL = (LAS int*)(F.lds + 49152);
    for (int i = tid; i < F.G * 8; i += NTHREADS) HL[i] = hist[(i >> 3) * 16 + slot * 8 + (i & 7)];
    __syncthreads();
    { const int e = tid & 7, part = tid >> 3;
        const int per = (F.G + 63) / 64; int sb = 0, st = 0;
        for (int j = 0; j < per; ++j) { const int bb = part * per + j; if (bb < F.G) { const int c = HL[bb * 8 + e]; st += c; if (bb < F.blk) sb += c; } }
        LAS int* PB = (LAS int*)(F.lds + 49152 + 16384); PB[tid] = sb; PB[512 + tid] = st; }
    __syncthreads();
    if (tid < 8) { const LAS int* PB = (const LAS int*)(F.lds + 49152 + 16384); int before = 0, tot = 0;
        for (int p = 0; p < 64; ++p) { before += PB[p * 8 + tid]; tot += PB[512 + p * 8 + tid]; }
        BASE[tid] = before; TOT[tid] = tot; }
    __syncthreads();
    if (tid == 0) { int ps = 0, nt = 0;
        for (int e = 0; e < 8; ++e) { const int tl = (TOT[e] + 255) >> 8; BASE[e] += ps; if (F.blk == 0) for (int i = 0; i < tl; ++i) tilee[nt + i] = e; ps += tl * 256; nt += tl; }
        if (F.blk == 0) ntiles[slot] = nt; }
    __syncthreads();
    const int tpb = NTOK / F.G;
    for (int i = wave; i < tpb; i += NWAVES) { const int t = F.blk * tpb + i; const int e = tope[2 * t + slot]; const int dest = BASE[e] + rank[2 * t + slot];
        if (lane == 0) { rowtok[dest] = t; rowgate[dest] = gate[2 * t + slot]; rowrstd[dest] = rstd[t]; }
        (void)hb; (void)asort; }
}


__device__ __forceinline__ void mk_publish(unsigned* ctr) {
    asm volatile("s_waitcnt vmcnt(0)" ::: "memory");
    __syncthreads();
    if (threadIdx.x == 0) { __builtin_amdgcn_fence(__ATOMIC_RELEASE, "agent"); asm volatile("s_waitcnt vmcnt(0)" ::: "memory"); (void)__hip_atomic_fetch_add(ctr, 1u, __ATOMIC_RELAXED, __HIP_MEMORY_SCOPE_AGENT); }
}
__device__ __forceinline__ void mk_wait(unsigned* ctr, unsigned need) {
    if (threadIdx.x == 0) { unsigned sp = 0;
        while (__hip_atomic_load(ctr, __ATOMIC_RELAXED, __HIP_MEMORY_SCOPE_AGENT) < need) { __builtin_amdgcn_s_sleep(4); if (++sp > (1u << 24)) break; }
        __builtin_amdgcn_fence(__ATOMIC_ACQUIRE, "agent"); asm volatile("s_waitcnt vmcnt(0)" ::: "memory"); }
    __syncthreads();
}

#ifndef MK_PER_PHASE
#define MK_PER_PHASE 0
#endif
constexpr int N_PHASES = 17;
__global__ void __launch_bounds__(NTHREADS, 2) mk_fwd(Params prm) {
    extern __shared__ __attribute__((aligned(16))) unsigned char lds_raw[];
    Frame F;
    F.lds = (LAS unsigned char*)lds_raw;
    F.blk = blockIdx.x; F.G = gridDim.x; F.out = prm.out; F.ws = prm.ws; F.wv = __builtin_amdgcn_readfirstlane(threadIdx.x >> 6);
    volatile LAS unsigned* MISC = (volatile LAS unsigned*)(F.lds + MISC_OFF);
    for (int u = threadIdx.x; u < (LDS_BYTES - LDSCTL_OFF) / 4; u += NTHREADS) ((LAS unsigned*)(F.lds + LDSCTL_OFF))[u] = 0u;
    __syncthreads();
    if (threadIdx.x == 0) { LAS unsigned long long* tab = (LAS unsigned long long*)(F.lds + PTAB_OFF);
#pragma unroll
        for (int i_ = 0; i_ < 33; ++i_) tab[i_] = (unsigned long long)prm.in[i_]; }
    __syncthreads();
    const int lo = prm.ph_lo, hi = prm.ph_hi;
    unsigned* ctl = (unsigned*)(F.ws + WS_CTL);
    XcdBarrier bar; bar.bar = ctl + CW_BAR; bar.x = 0; bar.st = nullptr;
    if (hi - lo > 1) bar = xcd_barrier_post(ctl + CW_BAR, MISC + 8);
    unsigned char* ws = F.ws;
    bf16* hb = (bf16*)(ws + WS_HB); bf16* z = (bf16*)(ws + WS_Z); bf16* act = (bf16*)(ws + WS_Z); bf16* y = (bf16*)(ws + WS_Y); bf16* asort = (bf16*)(ws + WS_Y);
    float* ssq = (float*)(ws + WS_SSQ);
    bf16* opart = (bf16*)F.out; float* lse = (float*)((unsigned char*)F.out + 48 * MiB);
    unsigned char* rt = ws + WS_RT;
#define IN(k) (lo <= (k) && (k) < hi)
#ifndef PROBE_MASK
#define PROBE_MASK 0
#endif
#if PROBE_MASK
#define STAMP(k) do { if (blockIdx.x == 0 && threadIdx.x == 0) ((volatile LAS unsigned long long*)(F.lds + LDSCTL_OFF + 2048))[k] = __builtin_amdgcn_s_memrealtime(); } while (0)
#else
#define STAMP(k) do { } while (0)
#endif
#define SEAM(k) do { if (IN(k) && IN((k) + 1)) xcd_barrier(bar); STAMP((k) + 1); } while (0)

    STAMP(0);
    if (IN(0)) p0_prologue(F, 0);
    SEAM(0);
#pragma unroll 1
    for (int layer = 0; layer < 2; ++layer) {
        const int pb = layer == 0 ? 1 : 7;
        if (IN(pb)) {
            pg8::Gemm g{hb, (const bf16*)(ws + WS_WIN) + (size_t)layer * NPADW * DM, NTOK, NPADW, DM, F.wv}; pg8::StaticOrder S; S.init(NTOK / 256, NPADW / 256, F.G, F.blk);
            pg8::EpiZ E{z, INW, INW, ssq};
            pg8::gemm_phase<pg8::EpiZ, pg8::StaticOrder, true, true>(F.lds, g, S, E);
        }
        SEAM(pb);
#if defined(PROBE_SUB)
        const unsigned long long tsub0 = __builtin_amdgcn_s_memrealtime();
#define PSUB(cls, t0) do { if (threadIdx.x == 0) ((unsigned long long*)(F.ws + 32768))[layer * 4 + (cls)] = __builtin_amdgcn_s_memrealtime() - (t0); } while (0)
#else
#define PSUB(cls, t0) do { } while (0)
#endif
        unsigned char* recs = ws + WS_MOEW;
        unsigned char* gcon = ws + WS_MOEW + (size_t)NB * 4 * (SEQ / 16) * RC_STRIDE;
        const GlaAux gax{ws + WS_GLAQT, ws + WS_GLAKB};
        if (IN(pb + 1)) {
            const int wi = F.blk, nw = F.G;
            { const RwkvP RP{inptr(F, IN_MU) + layer * 896, inptr(F, IN_W0) + layer * 256, inptr(F, IN_W2) + layer * 32 * 256, inptr(F, IN_A0) + layer * 256, inptr(F, IN_A2) + layer * 32 * 256, inptr(F, IN_G2) + layer * 64 * 256,
                             inptr(F, IN_KK) + layer * 256, inptr(F, IN_KA) + layer * 256, inptr(F, IN_RK) + layer * 256, inptr(F, IN_RLG) + layer * 256, inptr(F, IN_RLB) + layer * 256};
                const int tid_ = mytid(F), lane_ = tid_ & 63, w_ = __builtin_amdgcn_readfirstlane(tid_ >> 6);
#pragma unroll 1
                for (int h = 0; h < 4; ++h) {
                    rwkv_prep_init(F, RP, h); BAR();
                    u32x4 cur[2], prv[2], ncur[2], nprv[2];
#pragma unroll
                    for (int q = 0; q < 2; ++q) { cur[q] = (u32x4){0u, 0u, 0u, 0u}; prv[q] = cur[q]; ncur[q] = cur[q]; nprv[q] = cur[q]; }
                    if (wi < 2048) rwkv_prep_load(z, wi >> 8, h, wi & 255, w_, lane_, cur, prv);
#pragma unroll 1
                    for (int it = wi; it < 2048; it += nw) { const int nx = it + nw;
                        if (nx < 2048) rwkv_prep_load(z, nx >> 8, h, nx & 255, w_, lane_, ncur, nprv);
                        rwkv_prep_item(F, recs + (size_t)(((it >> 8) * 4 + h) * 256 + (it & 255)) * RC_STRIDE, RP, h, cur, prv);
#pragma unroll
                        for (int q = 0; q < 2; ++q) { cur[q] = ncur[q]; prv[q] = nprv[q]; } }
                    BAR(); } }
#if defined(PROBE_SUB)
            if (F.blk == 0) PSUB(2, tsub0);
#endif
            attn_qknorm(F, z, inptr(F, IN_QG) + layer * 64, inptr(F, IN_KG) + layer * 64);
#if defined(PROBE_SUB)
            if (F.blk == 0) PSUB(1, tsub0);
#endif
            for (int item = wi; item < 512; item += nw) conv_item(F, z, y, inptr(F, IN_CW) + layer * 31 * 256, inptr(F, IN_CB) + layer * 256, inptr(F, IN_CLG) + layer * 256, inptr(F, IN_CLB) + layer * 256, item);
#if defined(PROBE_SUB)
            if (F.blk == 0) PSUB(3, tsub0);
#endif
            gla_items<0>(F, z, gcon, (float*)(ws + WS_GLAEC), gax, y, inptr(F, IN_GG2) + layer * 16 * 128, inptr(F, IN_GGB) + layer * 128, inptr(F, IN_GNG) + layer * 64, wi, nw, 0);
        }
        SEAM(pb + 1);
        if (IN(pb + 2)) {
            unsigned* cA = ctl + 12288 + layer * 128;
            unsigned* cB = ctl + 12288 + layer * 128 + 64;
            if (F.blk < 32) {
                const RwkvP RP{inptr(F, IN_MU) + layer * 896, inptr(F, IN_W0) + layer * 256, inptr(F, IN_W2) + layer * 32 * 256, inptr(F, IN_A0) + layer * 256, inptr(F, IN_A2) + layer * 32 * 256, inptr(F, IN_G2) + layer * 64 * 256,
                               inptr(F, IN_KK) + layer * 256, inptr(F, IN_KA) + layer * 256, inptr(F, IN_RK) + layer * 256, inptr(F, IN_RLG) + layer * 256, inptr(F, IN_RLB) + layer * 256};
                rwkv_state(F, recs, y, RP, F.blk >> 2, F.blk & 3);
            } else {
                const int wi = F.blk - 32, nw = F.G - 32;
                if (F.blk < 64) { gla_scan(F, gcon, (const float*)(ws + WS_GLAEC), (F.blk - 32) >> 2, (F.blk - 32) & 3); mk_publish(cA); }
                { const int full = 3072 / nw, rem = 3072 - full * nw;
                    for (int rd = 0; rd < full; ++rd) attn_tile(F.lds, z, opart, lse, inptr(F, IN_RELB), rd * nw + wi, mytid(F));
                    if (wi >= 32 && wi - 32 < rem) attn_tile(F.lds, z, opart, lse, inptr(F, IN_RELB), full * nw + wi - 32, mytid(F)); }
                mk_publish(cB);
                mk_wait(cA, 32u);
                gla_items<1>(F, z, gcon, (float*)(ws + WS_GLAEC), gax, y, inptr(F, IN_GG2) + layer * 16 * 128, inptr(F, IN_GGB) + layer * 128, inptr(F, IN_GNG) + layer * 64, wi, nw, 32);
                mk_wait(cB, (unsigned)nw);
                attn_merge(F, opart, lse, y, wi, nw);
            }
        }
        SEAM(pb + 2);
        if (IN(pb + 3)) {
            pg8::Gemm g{y, (const bf16*)(ws + WS_WOUT) + (size_t)layer * DM * DM, NTOK, DM, DM, F.wv}; pg8::StaticOrder S; S.init(NTOK / 256, DM / 256, F.G, F.blk);
            pg8::EpiRes E{layer == 0 ? inptr(F, IN_X) : (const float*)nullptr, hb, (float*)nullptr, hb, ssq};
            pg8::gemm_phase<pg8::EpiRes, pg8::StaticOrder, true, true>(F.lds, g, S, E);
        }
        SEAM(pb + 3);
        if (layer == 0) {
            if (IN(5)) {
                pg8::Gemm g{hb, (const bf16*)(ws + WS_WGU), NTOK, 2 * DFF, DM, F.wv}; pg8::StaticOrder S; S.init(NTOK / 256, 2 * DFF / 256, F.G, F.blk);
                pg8::EpiSwiGLU<false> E{act, ssq, nullptr};
                pg8::gemm_phase<pg8::EpiSwiGLU<false>, pg8::StaticOrder, true, true>(F.lds, g, S, E);
            }
            SEAM(5);
            if (IN(6)) {
                pg8::Gemm g{act, (const bf16*)(ws + WS_WD), NTOK, DM, DFF, F.wv}; pg8::StaticOrder S; S.init(NTOK / 256, DM / 256, F.G, F.blk);
                pg8::EpiRes E{nullptr, hb, nullptr, hb, ssq};
                pg8::gemm_phase<pg8::EpiRes, pg8::StaticOrder, true, true>(F.lds, g, S, E);
            }
            SEAM(6);
        }
    }
    if (IN(11)) { moe_route(F, hb, inptr(F, IN_FFNG) + DM, inptr(F, IN_ROUTER)); __syncthreads(); p0_prologue(F, 1); }
    SEAM(11);
    if (IN(12)) moe_gather(F, 0, hb, asort);
    SEAM(12);
#pragma unroll 1
    for (int slot = 0; slot < 2; ++slot) {
        const int pg = 13 + 2 * slot;
        const int* tilee = (const int*)(rt + RT_TILEE) + slot * 256;
        if (IN(pg)) {
            const int nt = __builtin_amdgcn_readfirstlane(((const int*)(rt + RT_NTILES))[slot]);
            pg8::Gemm g{hb, (const bf16*)(ws + WS_MOEW), nt * 256, 2 * DFF, DM, F.wv}; pg8::StaticOrder S; S.init(nt, 2 * DFF / 256, F.G, F.blk, tilee, MOEW_E_BYTES);
            pg8::EpiSwiGLU<true> E{act, nullptr, (const float*)(rt + RT_ROWRSTD) + slot * MOE_ROWS};
            pg8::gemm_phase_g<pg8::EpiSwiGLU<true>, pg8::StaticOrder, true, true>(F.lds, g, S, E, (const int*)(rt + RT_ROWTOK) + slot * MOE_ROWS);
        }
        SEAM(pg);
        if (IN(pg + 1)) {
            const int nt = __builtin_amdgcn_readfirstlane(((const int*)(rt + RT_NTILES))[slot]);
            pg8::Gemm g{act, (const bf16*)(ws + WS_MOEW + MOEW_GU_BYTES), nt * 256, DM, DFF, F.wv}; pg8::StaticOrder S; S.init(nt, DM / 256, F.G, F.blk, tilee, MOEW_E_BYTES);
            pg8::EpiMoeDown E{F.out, slot == 0 ? (const bf16*)hb : (const bf16*)nullptr, (const int*)(rt + RT_ROWTOK) + slot * MOE_ROWS, (const float*)(rt + RT_ROWGATE) + slot * MOE_ROWS};
            pg8::gemm_phase<pg8::EpiMoeDown, pg8::StaticOrder, true, true>(F.lds, g, S, E);
            if (slot == 0) moe_gather(F, 1, hb, asort);
        }
        if (slot == 0) SEAM(pg + 1);
    }
#if PROBE_MASK
    __syncthreads();
    if (blockIdx.x == 0 && threadIdx.x == 0) { STAMP(N_PHASES); volatile LAS unsigned long long* ts = (volatile LAS unsigned long long*)(F.lds + LDSCTL_OFF + 2048); unsigned long long tot = 0;
        for (int k = 0; k < N_PHASES; ++k) if ((PROBE_MASK >> k) & 1) tot += ts[k + 1] - ts[k];
#if defined(PROBE_SUB)
        tot = (PROBE_SUB == 0) ? ((volatile unsigned long long*)(F.ws + 32768))[0] : ((volatile unsigned long long*)(F.ws + 32768))[PROBE_SUB] + ((volatile unsigned long long*)(F.ws + 32768))[4 + PROBE_SUB];
#endif
        const unsigned long long t0 = __builtin_amdgcn_s_memrealtime(); while (__builtin_amdgcn_s_memrealtime() - t0 < tot) __builtin_amdgcn_s_sleep(8); }
#endif
#undef IN
#undef SEAM
}

extern "C" void kernel_launch(void* const* d_in, const int* in_sizes, int n_in, void* d_out, int out_size, void* d_ws, size_t ws_size, hipStream_t stream) {
    static int grid = 0;
    if (grid == 0) {
        if (n_in != 33 || out_size != NTOK * DM || ws_size < WS_TOTAL) { fprintf(stderr, "kernel_launch: unexpected problem (n_in %d out %d ws %zu)\n", n_in, out_size, ws_size); grid = -1; return; }
        int dev = 0, cus = 0;
        if (hipGetDevice(&dev) != hipSuccess || hipDeviceGetAttribute(&cus, hipDeviceAttributeMultiprocessorCount, dev) != hipSuccess) { grid = -1; return; }
        if (hipFuncSetAttribute((const void*)mk_fwd, hipFuncAttributeMaxDynamicSharedMemorySize, LDS_BYTES) != hipSuccess) { fprintf(stderr, "kernel_launch: hipFuncSetAttribute failed\n"); grid = -1; return; }
        (void)hipGetLastError();
        grid = cus < 256 ? cus : 256;
        if (grid != 256) fprintf(stderr, "kernel_launch: %d CUs (built for 256)\n", cus);
    }
    if (grid < 0) return;
    (void)hipMemsetAsync((char*)d_ws + WS_CTL, 0, CTL_ZERO_BYTES, stream);
    Params p{};
    for (int i = 0; i < 33; ++i) p.in[i] = (const float*)d_in[i];
    p.out = (float*)d_out; p.ws = (unsigned char*)d_ws;
#if MK_PER_PHASE
    for (int k = 0; k < N_PHASES; ++k) { p.ph_lo = k; p.ph_hi = k + 1; hipLaunchKernelGGL(mk_fwd, dim3(grid), dim3(NTHREADS), LDS_BYTES, stream, p); }
#else
    p.ph_lo = 0; p.ph_hi = N_PHASES;
    hipLaunchKernelGGL(mk_fwd, dim3(grid), dim3(NTHREADS), LDS_BYTES, stream, p);
#endif
}
```

```cpp
#include <hip/hip_runtime.h>
#include <cstdio>
#include <cstdint>

#define LAS __attribute__((address_space(3)))
#define GAS __attribute__((address_space(1)))
typedef unsigned short bf16;
typedef short bf16x8 __attribute__((ext_vector_type(8)));
typedef short s16x4 __attribute__((ext_vector_type(4)));
typedef float f32x4 __attribute__((ext_vector_type(4)));
typedef float f32x2 __attribute__((ext_vector_type(2)));
typedef unsigned u32x4 __attribute__((ext_vector_type(4)));
typedef unsigned u32x2 __attribute__((ext_vector_type(2)));

constexpr int DM = 1024, NB = 8, SEQ = 4096, NTOK = NB * SEQ, INW = 2960, NPADW = 3072, DFF = 2816, NEXP = 8;
constexpr int ZA = 0, ZB = 768, ZC = 1280, ZD = 2176;
constexpr float NORM_EPS = 1e-6f;
constexpr int MOE_ROWS = NTOK + NEXP * 256;

constexpr size_t MiB = 1u << 20;
constexpr size_t WS_CTL = 0, CTL_ZERO_BYTES = 64 * 1024;
constexpr size_t WS_WIN = 1 * MiB;
constexpr size_t WS_WOUT = 13 * MiB;
constexpr size_t WS_WGU = 17 * MiB;
constexpr size_t WS_WD = 28 * MiB;
constexpr size_t WS_SSQ = 34 * MiB;
constexpr size_t WS_RT = 36 * MiB;
constexpr size_t WS_HB = 40 * MiB;
constexpr size_t WS_Z = 104 * MiB;
constexpr size_t WS_Y = 297 * MiB;
constexpr size_t WS_MOEW = 367 * MiB;
constexpr size_t WS_END = 499 * MiB;
constexpr size_t WS_GLAEC = 499 * MiB;
constexpr size_t WS_GLAQT = 500 * MiB;
constexpr size_t WS_GLAKB = 289 * MiB;
constexpr size_t WS_TOTAL = 508 * MiB;
constexpr size_t MOEW_GU_BYTES = (size_t)2 * DFF * DM * 2, MOEW_D_BYTES = (size_t)DM * DFF * 2, MOEW_E_BYTES = MOEW_GU_BYTES + MOEW_D_BYTES;
static_assert(WS_Z + (size_t)MOE_ROWS * DFF * 2 <= WS_Y && WS_Y + (size_t)MOE_ROWS * DM * 2 <= WS_MOEW && WS_MOEW + NEXP * MOEW_E_BYTES <= WS_END, "ws map");
constexpr size_t WS_OP = WS_HB;
constexpr size_t WS_LSE = WS_HB + 48 * MiB;
constexpr size_t RT_TOPE = 0;
constexpr size_t RT_GATE = RT_TOPE + (size_t)NTOK * 8;
constexpr size_t RT_RANK = RT_GATE + (size_t)NTOK * 8;
constexpr size_t RT_RSTD = RT_RANK + (size_t)NTOK * 8;
constexpr size_t RT_HIST = RT_RSTD + (size_t)NTOK * 4;
constexpr size_t RT_ROWTOK = RT_HIST + 256 * 16 * 4;
constexpr size_t RT_ROWGATE = RT_ROWTOK + (size_t)2 * MOE_ROWS * 4;
constexpr size_t RT_ROWRSTD = RT_ROWGATE + (size_t)2 * MOE_ROWS * 4;
constexpr size_t RT_TILEE = RT_ROWRSTD + (size_t)2 * MOE_ROWS * 4;
constexpr size_t RT_NTILES = RT_TILEE + 2 * 256 * 4;
static_assert(RT_NTILES + 64 <= 4 * MiB, "routing arrays");

constexpr int CW_BAR = 1024;

constexpr int RING_BYTES = 131072, LDSCTL_OFF = RING_BYTES, MISC_OFF = LDSCTL_OFF + 320, LDS_BYTES = 147456;
constexpr int NWAVES = 8, NTHREADS = 512;

#define LDS_WAIT() asm volatile("s_waitcnt lgkmcnt(0)" ::: "memory")
#define VM_WAIT() asm volatile("s_waitcnt vmcnt(0)" ::: "memory")
#define BAR() do { asm volatile("s_waitcnt lgkmcnt(0)" ::: "memory"); __builtin_amdgcn_s_barrier(); asm volatile("" ::: "memory"); } while (0)
__device__ __forceinline__ unsigned f2bf(float f) { unsigned u = __builtin_bit_cast(unsigned, f); return (u + 0x7fffu + ((u >> 16) & 1u)) >> 16; }
typedef __bf16 bf16x2_hw __attribute__((ext_vector_type(2)));
__device__ __forceinline__ unsigned pk2(float lo, float hi) { const f32x2 v = {lo, hi}; const bf16x2_hw b = __builtin_convertvector(v, bf16x2_hw); return __builtin_bit_cast(unsigned, b); }
__device__ __forceinline__ float bflo(unsigned w) { return __builtin_bit_cast(float, w << 16); }
__device__ __forceinline__ float bfhi(unsigned w) { return __builtin_bit_cast(float, w & 0xffff0000u); }
__device__ __forceinline__ float bf1(bf16 b) { return __builtin_bit_cast(float, (unsigned)b << 16); }

#define DPP_ADD(v, ctrl) ((v) + __builtin_bit_cast(float, __builtin_amdgcn_update_dpp(0, __builtin_bit_cast(int, (v)), (ctrl), 0xf, 0xf, true)))
__device__ __forceinline__ float red8(float v) { v = DPP_ADD(v, 0xB1); v = DPP_ADD(v, 0x4E); v = DPP_ADD(v, 0x141); return v; }
__device__ __forceinline__ float red16(float v) { v = DPP_ADD(v, 0xB1); v = DPP_ADD(v, 0x4E); v = DPP_ADD(v, 0x141); v = DPP_ADD(v, 0x140); return v; }
__device__ __forceinline__ float wave_sum(float v) { v = red16(v); v += __shfl_xor(v, 16); v += __shfl_xor(v, 32); return v; }
__device__ __forceinline__ float sigmoidf_(float x) { return 1.0f / (1.0f + __expf(-x)); }
__device__ __forceinline__ float siluf_(float x) { return x / (1.0f + __expf(-x)); }
__device__ __forceinline__ float softplusf_(float x) { return fmaxf(x, 0.f) + __logf(1.0f + __expf(-fabsf(x))); }
__device__ __forceinline__ float tanhf_(float x) { const float e = __expf(2.0f * x); return 1.0f - 2.0f / (e + 1.0f); }
__device__ __forceinline__ void unpack8(const u32x4 w, float (&f)[8]) {
    f[0] = bflo(w.x); f[1] = bfhi(w.x); f[2] = bflo(w.y); f[3] = bfhi(w.y); f[4] = bflo(w.z); f[5] = bfhi(w.z); f[6] = bflo(w.w); f[7] = bfhi(w.w);
}

namespace pg8 {
#define PG8_LAS __attribute__((address_space(3)))
typedef unsigned short bf16_t;
constexpr int BM = 256, BK = 64, HALF = 128, HTB = HALF * BK * 2  , STAGE_BYTES = 8 * HTB, NXCD = 8, WGM = 8;

__host__ __device__ __forceinline__ int lds_byte(int r, int c) { const int st = (r >> 4) * 2 + (c >> 5), rr = r & 15, cc = c & 31, ob = rr * 64 + cc * 2; return st * 1024 + (ob ^ (((ob >> 9) & 1) << 5)); }
__host__ __device__ __forceinline__ void stage_rc(int b, int& R, int& C) { const int st = b / 1024, sb = b % 1024, swz = sb ^ (((sb >> 9) & 1) << 5); R = (st >> 1) * 16 + swz / 64; C = (st & 1) * 32 + (swz % 64) / 2; }
__host__ __device__ __forceinline__ int perm32(int rho) { const int n = rho >> 4, i = rho & 15; return 8 * (i >> 2) + 4 * n + (i & 3); }

struct Unit { int pm, pn; };
struct Gemm { const bf16_t* A; const bf16_t* Bt; int M, N, K, wv; };

struct StaticOrder {
    int nM, nN, nwg, G, c, pm0, nb, R0, a_s1, a_s2, rev; const int* tile_e; size_t estride; long a_d1, a_d2;
    __device__ void init(int nM_, int nN_, int G_, int c_, const int* te = nullptr, size_t es = 0, int pm0_ = 0, int nb_ = 0, int r0_ = 2) {
        R0 = r0_; rev = 0; nM = nM_; nN = nN_; nwg = nM * nN; G = G_; c = c_; tile_e = te; estride = es; pm0 = pm0_; nb = nb_; a_s1 = 0; a_s2 = 0; a_d1 = 0; a_d2 = 0; }
    __device__ void asplit(int s1, long d1, int s2, long d2) { a_s1 = s1; a_d1 = d1; a_s2 = s2; a_d2 = d2; }
    __device__ bool next(int i, Unit& u) const {
        long L;
        if (nb == 0) L = (long)i * G + c;
        else if (c >= nb) L = i < R0 ? (long)i * (G - nb) + (c - nb) : (long)R0 * (G - nb) + (long)(i - R0) * G + (c - nb);
        else L = (long)R0 * (G - nb) + (long)i * G + (G - nb + c);
        if (L >= nwg) return false;
        int wgid = (int)L; { const int q = nwg / NXCD, r = nwg % NXCD, xcd = wgid % NXCD, off = wgid / NXCD; wgid = (xcd < r ? xcd * (q + 1) : r * (q + 1) + (xcd - r) * q) + off; }
        const int nig = WGM * nN, gid = wgid / nig, fm = gid * WGM, gsz = (nM - fm) < WGM ? (nM - fm) : WGM;
        { const int pl = fm + ((wgid % nig) % gsz); u.pm = pm0 + (rev ? nM - 1 - pl : pl); } u.pn = (wgid % nig) / gsz; return true;
    }
    __device__ __forceinline__ size_t bofs(const Unit& u, size_t tstep) const { return (size_t)u.pn * tstep + (tile_e ? (size_t)__builtin_amdgcn_readfirstlane(tile_e[u.pm]) * estride : (size_t)0); }
    __device__ __forceinline__ long aofs(const Unit& u, size_t tstep) const { return (long)((size_t)u.pm * tstep) + (u.pm < a_s1 ? a_d1 : (u.pm < a_s2 ? a_d2 : 0L)); }
    __device__ __forceinline__ void a_ready(const Unit&) const {}
    __device__ __forceinline__ void done(const Unit&) const {}
};

__device__ __forceinline__ unsigned cvt_pk_bf16(float lo, float hi) { unsigned r; asm volatile("v_cvt_pk_bf16_f32 %0, %1, %2" : "=v"(r) : "v"(lo), "v"(hi)); return r; }

__device__ __forceinline__ float row_rstd16(const float* ssq, int r, int fq) {
    const f32x4 p = *(const f32x4*)(ssq + (size_t)r * 16 + 4 * fq);
    float s = (p[0] + p[1]) + (p[2] + p[3]); s += __shfl_xor(s, 16); s += __shfl_xor(s, 32);
    return __builtin_amdgcn_rsqf(s * (1.0f / DM) + NORM_EPS);
}

#define PG8_KEEP8(a) asm volatile("" : "+v"(a[0]), "+v"(a[1]), "+v"(a[2]), "+v"(a[3]), "+v"(a[4]), "+v"(a[5]), "+v"(a[6]), "+v"(a[7]))
__device__ __forceinline__ void rows_rstd16(const float* ssq, int row0, int fq, float (&rsv)[2][4]) {
    f32x4 pp[8];
#pragma unroll
    for (int i = 0; i < 8; ++i) pp[i] = *(const f32x4*)(ssq + (size_t)(row0 + (i >> 2) * HALF + (i & 3) * 16) * 16 + 4 * fq);
    PG8_KEEP8(pp);
#pragma unroll
    for (int i = 0; i < 8; ++i) { float s = (pp[i][0] + pp[i][1]) + (pp[i][2] + pp[i][3]); s += __shfl_xor(s, 16); s += __shfl_xor(s, 32); rsv[i >> 2][i & 3] = __builtin_amdgcn_rsqf(s * (1.0f / DM) + NORM_EPS); }
}
__device__ __forceinline__ void rows_load8(const float* v, int row0, float (&rsv)[2][4]) {
    float pp[8];
#pragma unroll
    for (int i = 0; i < 8; ++i) pp[i] = v[row0 + (i >> 2) * HALF + (i & 3) * 16];
    PG8_KEEP8(pp);
#pragma unroll
    for (int i = 0; i < 8; ++i) rsv[i >> 2][i & 3] = pp[i];
}
struct EpiZ {
    static constexpr bool PERM = true, AFTER_DRAIN = false;
    bf16_t* Z; int ldc, ncols; const float* ssq;
    __device__ __forceinline__ void operator()(const f32x4 (&acc)[2][2][4][2], const Unit& u, int wr, int wc, int fr, int fq) const {
        const int row0 = u.pm * BM + wr * 64 + fr, col0 = u.pn * BM + wc * 32 + 8 * fq;
        float rsv[2][4];
        rows_rstd16(ssq, row0, fq, rsv);
#pragma unroll
        for (int ai = 0; ai < 2; ++ai)
#pragma unroll
            for (int m = 0; m < 4; ++m) { const int r = row0 + ai * HALF + m * 16; const float rs = rsv[ai][m]; bf16_t* rowp = Z + (size_t)r * ldc + col0;
#pragma unroll
                for (int bj = 0; bj < 2; ++bj) { const f32x4 v0 = acc[ai][bj][m][0] * rs, v1 = acc[ai][bj][m][1] * rs;
                    u32x4 w; w.x = cvt_pk_bf16(v0[0], v0[1]); w.y = cvt_pk_bf16(v0[2], v0[3]); w.z = cvt_pk_bf16(v1[0], v1[1]); w.w = cvt_pk_bf16(v1[2], v1[3]);
                    if (col0 + bj * HALF < ncols) *(u32x4*)(rowp + bj * HALF) = w; } }
    }
};
template <bool MOE> struct EpiSwiGLU {
    static constexpr bool PERM = true, AFTER_DRAIN = false;
    bf16_t* O; const float* ssq; const float* row_rstd; int s1, s2; long d1, d2;
    __device__ __forceinline__ void operator()(const f32x4 (&acc)[2][2][4][2], const Unit& u, int wr, int wc, int fr, int fq) const {
        const int row0 = u.pm * BM + wr * 64 + fr, col0 = u.pn * HALF + wc * 32 + 8 * fq;
        float rsv[2][4];
        if (MOE) rows_load8(row_rstd, row0, rsv); else rows_rstd16(ssq, row0, fq, rsv);
#pragma unroll
        for (int ai = 0; ai < 2; ++ai)
#pragma unroll
            for (int m = 0; m < 4; ++m) { const int r = row0 + ai * HALF + m * 16; const float rs = rsv[ai][m];
                const f32x4 g0 = acc[ai][0][m][0] * rs, g1 = acc[ai][0][m][1] * rs, u0 = acc[ai][1][m][0] * rs, u1 = acc[ai][1][m][1] * rs; f32x4 a0, a1;
#pragma unroll
                for (int j = 0; j < 4; ++j) { a0[j] = g0[j] * __builtin_amdgcn_rcpf(1.0f + __expf(-g0[j])) * u0[j]; a1[j] = g1[j] * __builtin_amdgcn_rcpf(1.0f + __expf(-g1[j])) * u1[j]; }
                u32x4 w; w.x = cvt_pk_bf16(a0[0], a0[1]); w.y = cvt_pk_bf16(a0[2], a0[3]); w.z = cvt_pk_bf16(a1[0], a1[1]); w.w = cvt_pk_bf16(a1[2], a1[3]);
                *(u32x4*)((char*)(O + (size_t)r * DFF + col0) + (u.pm < s1 ? d1 : (u.pm < s2 ? d2 : 0L))) = w; }
    }
};
struct EpiRes {
    static constexpr bool PERM = false, AFTER_DRAIN = false;
    const float* base; const bf16_t* baseb; float* out; bf16_t* hb; float* ssq;
    __device__ __forceinline__ void row(const f32x4 (&bv)[2][2], const f32x4 (&a)[2][2], int r, size_t off, int pn, int wc, int fq) const {
        float ss = 0.f;
#pragma unroll
        for (int bj = 0; bj < 2; ++bj)
#pragma unroll
            for (int n = 0; n < 2; ++n) {
                const f32x4 v = bv[bj][n] + a[bj][n];
                if (out) *(f32x4*)(out + off + bj * HALF + n * 16) = v;
                ss += (v[0] * v[0] + v[1] * v[1]) + (v[2] * v[2] + v[3] * v[3]);
                { u32x2 w; w.x = cvt_pk_bf16(v[0], v[1]); w.y = cvt_pk_bf16(v[2], v[3]); *(u32x2*)(hb + off + bj * HALF + n * 16) = w; } }
        ss += __shfl_xor(ss, 16); ss += __shfl_xor(ss, 32);
        if (fq == 0) ssq[(size_t)r * 16 + pn * 4 + wc] = ss;
    }
    __device__ __forceinline__ void operator()(const f32x4 (&acc)[2][2][4][2], const Unit& u, int wr, int wc, int fr, int fq) const {
        const int col0 = u.pn * BM + wc * 32 + 4 * fq;
        if (base) {
#pragma unroll
            for (int ai = 0; ai < 2; ++ai)
#pragma unroll
                for (int m = 0; m < 4; ++m) { const int r = u.pm * BM + ai * HALF + wr * 64 + m * 16 + fr; const size_t off = (size_t)r * DM + col0; f32x4 bv[2][2];
#pragma unroll
                    for (int bj = 0; bj < 2; ++bj)
#pragma unroll
                        for (int n = 0; n < 2; ++n) bv[bj][n] = *(const f32x4*)(base + off + bj * HALF + n * 16);
                    const f32x4 a[2][2] = {{acc[ai][0][m][0], acc[ai][0][m][1]}, {acc[ai][1][m][0], acc[ai][1][m][1]}};
                    row(bv, a, r, off, u.pn, wc, fq);
                    if (m & 1) asm volatile("" ::: "memory"); }
        } else {
#pragma unroll
            for (int ai = 0; ai < 2; ++ai)
#pragma unroll
            for (int mh = 0; mh < 2; ++mh) {
                const size_t off0 = (size_t)(u.pm * BM + ai * HALF + wr * 64 + mh * 32 + fr) * DM + col0; u32x2 bw[2][2][2];
#pragma unroll
                for (int m = 0; m < 2; ++m)
#pragma unroll
                    for (int bj = 0; bj < 2; ++bj)
#pragma unroll
                        for (int n = 0; n < 2; ++n) bw[m][bj][n] = *(const u32x2*)(baseb + off0 + (size_t)m * 16 * DM + bj * HALF + n * 16);
#pragma unroll
                for (int m = 0; m < 2; ++m) { f32x4 bv[2][2];
#pragma unroll
                    for (int bj = 0; bj < 2; ++bj)
#pragma unroll
                        for (int n = 0; n < 2; ++n) bv[bj][n] = (f32x4){bflo(bw[m][bj][n].x), bfhi(bw[m][bj][n].x), bflo(bw[m][bj][n].y), bfhi(bw[m][bj][n].y)};
                    const f32x4 a[2][2] = {{acc[ai][0][mh * 2 + m][0], acc[ai][0][mh * 2 + m][1]}, {acc[ai][1][mh * 2 + m][0], acc[ai][1][mh * 2 + m][1]}};
                    row(bv, a, u.pm * BM + ai * HALF + wr * 64 + (mh * 2 + m) * 16 + fr, off0 + (size_t)m * 16 * DM, u.pn, wc, fq); }
                asm volatile("" ::: "memory");
            }
        }
    }
};
struct EpiMoeDown {
    static constexpr bool PERM = false, AFTER_DRAIN = false;
    float* out; const bf16_t* baseb; const int* row_tok; const float* row_gate; float* dummy;
    __device__ __forceinline__ void operator()(const f32x4 (&acc)[2][2][4][2], const Unit& u, int wr, int wc, int fr, int fq) const {
        const int col0 = u.pn * BM + wc * 32 + 4 * fq;
        int tk8[8]; float gt8[8];
#pragma unroll
        for (int i = 0; i < 8; ++i) { const int r = u.pm * BM + (i >> 2) * HALF + wr * 64 + (i & 3) * 16 + fr; tk8[i] = row_tok[r]; gt8[i] = row_gate[r]; }
        PG8_KEEP8(tk8); PG8_KEEP8(gt8);
#pragma unroll
        for (int ai = 0; ai < 2; ++ai) {
            int tok[4]; float gt[4];
#pragma unroll
            for (int m = 0; m < 4; ++m) { tok[m] = tk8[ai * 4 + m]; gt[m] = gt8[ai * 4 + m]; }
            f32x4 bv[4][2][2];
#pragma unroll
            for (int m = 0; m < 4; ++m) { const int tk = tok[m] < 0 ? 0 : tok[m]; const float* ip = (tok[m] < 0 ? dummy : out + (size_t)tk * DM) + col0; const bf16_t* bp = baseb + (size_t)tk * DM + col0;
#pragma unroll
                for (int bj = 0; bj < 2; ++bj)
#pragma unroll
                    for (int n = 0; n < 2; ++n) {
                        if (baseb) { const u32x2 bw = *(const u32x2*)(bp + bj * HALF + n * 16); bv[m][bj][n] = (f32x4){bflo(bw.x), bfhi(bw.x), bflo(bw.y), bfhi(bw.y)}; } else bv[m][bj][n] = *(const f32x4*)(ip + bj * HALF + n * 16); } }
#pragma unroll
            for (int m = 0; m < 4; ++m) { float* op = (tok[m] < 0 ? dummy : out + (size_t)tok[m] * DM) + col0;
#pragma unroll
                for (int bj = 0; bj < 2; ++bj)
#pragma unroll
                    for (int n = 0; n < 2; ++n) *(f32x4*)(op + bj * HALF + n * 16) = bv[m][bj][n] + acc[ai][bj][m][n] * gt[m]; }
            asm volatile("" ::: "memory");
        }
    }
};

template <class Epi, class Sched, bool ALIGN_EPI = false, bool SP2 = false>
__device__ __forceinline__ void gemm_phase(PG8_LAS unsigned char* lds, const Gemm g, const Sched& S, const Epi& E) {
    int lid_; asm volatile("v_mbcnt_lo_u32_b32 %0, -1, 0\n\tv_mbcnt_hi_u32_b32 %0, -1, %0" : "=v"(lid_)); int tid_ = g.wv * 64 + lid_; asm volatile("" : "+v"(tid_));
    const int tid = tid_, wid = __builtin_amdgcn_readfirstlane(tid >> 6), lane = tid & 63, wr = wid >> 2, wc = wid & 3, fr = lane & 15, fq = lane >> 4;
    const int K = g.K, nt = K / BK;
    unsigned voffA[2], voffB[2];
#pragma unroll
    for (int i = 0; i < 2; ++i) { int R, C; stage_rc(tid * 16 + i * 8192, R, C); const int Rb = Epi::PERM ? ((R & ~31) + perm32(R & 31)) : R;
        voffA[i] = (unsigned)(R * K + C) * 2u; voffB[i] = (unsigned)(Rb * K + C) * 2u; }
    const size_t kstep = (size_t)(BK * 2);
    const size_t hstep = (size_t)HALF * K * 2;
    const size_t tstep = 2 * hstep;
    const unsigned ldsw = (unsigned)wid * 1024u;
    const int aoff = lds_byte(wr * 64 + fr, fq * 8), boff = lds_byte(wc * 32 + fr, fq * 8);
#define PG8_SA(b, h) (((b) * 2 + (h)) * HTB)
#define PG8_SB(b, h) ((4 + (b) * 2 + (h)) * HTB)
#define PG8_STAGE(bufoff, gbase, voff) do { _Pragma("unroll") for (int _i = 0; _i < 2; ++_i) \
        __builtin_amdgcn_global_load_lds((const unsigned*)((const char*)(gbase) + (voff)[_i]), (PG8_LAS unsigned*)(lds + (bufoff) + ldsw + _i * 8192), 16, 0, 0); } while (0)
#define PG8_LDA(dst, b, h) do { _Pragma("unroll") for (int m = 0; m < 4; ++m) _Pragma("unroll") for (int k = 0; k < 2; ++k) dst[m][k] = *(const PG8_LAS bf16x8*)(lds + PG8_SA(b, h) + aoff + m * 2048 + k * 1024); } while (0)
#define PG8_LDB(dst, b, h) do { _Pragma("unroll") for (int n = 0; n < 2; ++n) _Pragma("unroll") for (int k = 0; k < 2; ++k) dst[n][k] = *(const PG8_LAS bf16x8*)(lds + PG8_SB(b, h) + boff + n * 2048 + k * 1024); } while (0)
#define PG8_MMA(ai, bj, At, Bt) do { __builtin_amdgcn_s_setprio(1); _Pragma("unroll") for (int m = 0; m < 4; ++m) _Pragma("unroll") for (int n = 0; n < 2; ++n) _Pragma("unroll") for (int k = 0; k < 2; ++k) \
        acc[ai][bj][m][n] = __builtin_amdgcn_mfma_f32_16x16x32_bf16(Bt[n][k], At[m][k], acc[ai][bj][m][n], 0, 0, 0); __builtin_amdgcn_s_setprio(0); } while (0)
#define PG8_WAIT_V(n) asm volatile("s_waitcnt vmcnt(" #n ")" ::: "memory")
#define PG8_WAIT_L(n) asm volatile("s_waitcnt lgkmcnt(" #n ")" ::: "memory")
#define PG8_BAR __builtin_amdgcn_s_barrier()
#define PG8_SCHED __builtin_amdgcn_sched_barrier(0)
    Unit cur, nxt; int ui = 0;
    if (!S.next(0, cur)) return;
    f32x4 acc[2][2][4][2];
#pragma unroll
    for (int a = 0; a < 2; ++a)
#pragma unroll
        for (int b = 0; b < 2; ++b)
#pragma unroll
            for (int m = 0; m < 4; ++m)
#pragma unroll
                for (int n = 0; n < 2; ++n) acc[a][b][m][n] = (f32x4){0.f, 0.f, 0.f, 0.f};
    bf16x8 At[4][2], B0[2][2], B1[2][2];
    const char* cA = (const char*)g.A + S.aofs(cur, tstep); const char* cB = (const char*)g.Bt + S.bofs(cur, tstep);
    S.a_ready(cur);
    if constexpr (SP2) {
        PG8_STAGE(PG8_SB(0, 0), cB, voffB); PG8_STAGE(PG8_SB(0, 1), cB + hstep, voffB); PG8_STAGE(PG8_SA(0, 0), cA, voffA); PG8_STAGE(PG8_SA(0, 1), cA + hstep, voffA);
        if (wr == 1) PG8_BAR;
        PG8_WAIT_V(2); PG8_BAR;
        PG8_STAGE(PG8_SB(1, 0), cB + kstep, voffB); PG8_STAGE(PG8_SA(1, 0), cA + kstep, voffA); PG8_STAGE(PG8_SB(1, 1), cB + hstep + kstep, voffB);
        PG8_WAIT_V(6); PG8_BAR;
    } else {
        PG8_STAGE(PG8_SB(0, 0), cB, voffB); PG8_STAGE(PG8_SA(0, 0), cA, voffA); PG8_STAGE(PG8_SB(0, 1), cB + hstep, voffB); PG8_STAGE(PG8_SA(0, 1), cA + hstep, voffA);
        if (wr == 1) PG8_BAR;
        PG8_WAIT_V(4); PG8_BAR;
        PG8_STAGE(PG8_SB(1, 0), cB + kstep, voffB); PG8_STAGE(PG8_SA(1, 0), cA + kstep, voffA); PG8_STAGE(PG8_SB(1, 1), cB + hstep + kstep, voffB);
        PG8_WAIT_V(6); PG8_BAR;
    }
    for (;;) {
        const bool has_next = S.next(ui + 1, nxt);
        const char* nA = has_next ? (const char*)g.A + S.aofs(nxt, tstep) : cA; const char* nB = has_next ? (const char*)g.Bt + S.bofs(nxt, tstep) : cB;
        for (int t = 0; t < nt; t += 2) {
            const bool last = (t == nt - 2);
            const char* a1 = cA + (size_t)(t + 1) * kstep;
            const char* a2 = last ? nA : cA + (size_t)(t + 2) * kstep; const char* b2 = last ? nB : cB + (size_t)(t + 2) * kstep;
            const char* a3 = a2 + kstep; const char* b3 = b2 + kstep;
            if (last && has_next) S.a_ready(nxt);
            if constexpr (SP2) {
            PG8_LDB(B0, 0, 0); PG8_LDB(B1, 0, 1); PG8_SCHED; PG8_LDA(At, 0, 0); PG8_STAGE(PG8_SA(1, 1), a1 + hstep, voffA);
            PG8_WAIT_V(8); PG8_WAIT_L(0); PG8_BAR; PG8_MMA(0, 0, At, B0); PG8_MMA(0, 1, At, B1); PG8_BAR; PG8_SCHED;
            PG8_LDA(At, 0, 1); PG8_STAGE(PG8_SB(0, 0), b2, voffB); PG8_STAGE(PG8_SB(0, 1), b2 + hstep, voffB); PG8_STAGE(PG8_SA(0, 0), a2, voffA);
            PG8_WAIT_V(8); PG8_WAIT_L(0); PG8_BAR; PG8_MMA(1, 0, At, B0); PG8_MMA(1, 1, At, B1); PG8_BAR; PG8_SCHED;
            PG8_LDB(B0, 1, 0); PG8_LDB(B1, 1, 1); PG8_SCHED; PG8_LDA(At, 1, 0); PG8_STAGE(PG8_SA(0, 1), a2 + hstep, voffA);
            PG8_WAIT_V(8); PG8_WAIT_L(0); PG8_BAR; PG8_MMA(0, 0, At, B0); PG8_MMA(0, 1, At, B1); PG8_BAR; PG8_SCHED;
            PG8_LDA(At, 1, 1); PG8_STAGE(PG8_SB(1, 0), b3, voffB); PG8_STAGE(PG8_SB(1, 1), b3 + hstep, voffB); PG8_STAGE(PG8_SA(1, 0), a3, voffA);
            PG8_WAIT_V(8); PG8_WAIT_L(0); PG8_BAR; PG8_MMA(1, 0, At, B0); PG8_MMA(1, 1, At, B1); PG8_BAR; PG8_SCHED;
            } else {
            PG8_LDB(B0, 0, 0); PG8_SCHED; PG8_LDA(At, 0, 0); PG8_STAGE(PG8_SA(1, 1), a1 + hstep, voffA);
            PG8_WAIT_L(8); PG8_BAR; PG8_WAIT_L(0); PG8_MMA(0, 0, At, B0); PG8_BAR; PG8_SCHED;
            PG8_LDB(B1, 0, 1); PG8_STAGE(PG8_SB(0, 0), b2, voffB);
            PG8_BAR; PG8_WAIT_L(0); PG8_MMA(0, 1, At, B1); PG8_BAR;
            PG8_LDA(At, 0, 1); PG8_STAGE(PG8_SA(0, 0), a2, voffA);
            PG8_BAR; PG8_WAIT_L(0); PG8_MMA(1, 0, At, B0); PG8_BAR; PG8_SCHED;
            PG8_STAGE(PG8_SB(0, 1), b2 + hstep, voffB);
            PG8_WAIT_V(6); PG8_BAR; PG8_MMA(1, 1, At, B1); PG8_BAR;
            PG8_LDB(B0, 1, 0); PG8_SCHED; PG8_LDA(At, 1, 0); PG8_STAGE(PG8_SA(0, 1), a2 + hstep, voffA);
            PG8_WAIT_L(8); PG8_BAR; PG8_WAIT_L(0); PG8_MMA(0, 0, At, B0); PG8_BAR; PG8_SCHED;
            PG8_LDB(B1, 1, 1); PG8_STAGE(PG8_SB(1, 0), b3, voffB);
            PG8_BAR; PG8_WAIT_L(0); PG8_MMA(0, 1, At, B1); PG8_BAR;
            PG8_LDA(At, 1, 1); PG8_STAGE(PG8_SA(1, 0), a3, voffA);
            PG8_BAR; PG8_WAIT_L(0); PG8_MMA(1, 0, At, B0); PG8_BAR; PG8_SCHED;
            PG8_STAGE(PG8_SB(1, 1), b3 + hstep, voffB);
            PG8_WAIT_V(6); PG8_BAR; PG8_MMA(1, 1, At, B1); PG8_BAR;
            }
        }
        if constexpr (ALIGN_EPI) { if (wr == 0) PG8_BAR; }
        if constexpr (!Epi::AFTER_DRAIN) { E(acc, cur, wr, wc, fr, fq); S.done(cur); }
        if (!has_next) break;
#pragma unroll
        for (int a = 0; a < 2; ++a)
#pragma unroll
            for (int b = 0; b < 2; ++b)
#pragma unroll
                for (int m = 0; m < 4; ++m)
#pragma unroll
                    for (int n = 0; n < 2; ++n) acc[a][b][m][n] = (f32x4){0.f, 0.f, 0.f, 0.f};
        cur = nxt; cA = nA; cB = nB; ++ui;
        if constexpr (ALIGN_EPI) { if (wr == 1) PG8_BAR; }
    }
    PG8_WAIT_V(0);
    if constexpr (!ALIGN_EPI) { if (wr == 0) PG8_BAR; }
    PG8_BAR;
    if constexpr (Epi::AFTER_DRAIN) { E.fused(acc, cur, wr, wc, fr, fq, lds, wid, lane); S.done(cur); }
#undef PG8_SA
#undef PG8_SB
#undef PG8_STAGE
#undef PG8_LDA
#undef PG8_LDB
#undef PG8_MMA
#undef PG8_WAIT_V
#undef PG8_WAIT_L
#undef PG8_BAR
#undef PG8_SCHED
}
template <class Epi, class Sched, bool ALIGN_EPI = false, bool SP2 = false>
__device__ __forceinline__ void gemm_phase_g(PG8_LAS unsigned char* lds, const Gemm g, const Sched& S, const Epi& E, const int* rowtok) {
    int lid_; asm volatile("v_mbcnt_lo_u32_b32 %0, -1, 0\n\tv_mbcnt_hi_u32_b32 %0, -1, %0" : "=v"(lid_)); int tid_ = g.wv * 64 + lid_; asm volatile("" : "+v"(tid_));
    const int tid = tid_, wid = __builtin_amdgcn_readfirstlane(tid >> 6), lane = tid & 63, wr = wid >> 2, wc = wid & 3, fr = lane & 15, fq = lane >> 4;
    const int K = g.K, nt = K / BK;
    unsigned voffA[2], voffB[2];
#pragma unroll
    for (int i = 0; i < 2; ++i) { int R, C; stage_rc(tid * 16 + i * 8192, R, C); const int Rb = Epi::PERM ? ((R & ~31) + perm32(R & 31)) : R;
        voffA[i] = (unsigned)(R * K + C) * 2u; voffB[i] = (unsigned)(Rb * K + C) * 2u; }
    const size_t kstep = (size_t)(BK * 2);
    const size_t hstep = (size_t)HALF * K * 2;
    const size_t tstep = 2 * hstep;
    const unsigned ldsw = (unsigned)wid * 1024u;
    const int aoff = lds_byte(wr * 64 + fr, fq * 8), boff = lds_byte(wc * 32 + fr, fq * 8);
#define PG8_SA(b, h) (((b) * 2 + (h)) * HTB)
#define PG8_SB(b, h) ((4 + (b) * 2 + (h)) * HTB)
#define PG8_STAGE(bufoff, gbase, voff) do { _Pragma("unroll") for (int _i = 0; _i < 2; ++_i) \
        __builtin_amdgcn_global_load_lds((const unsigned*)((const char*)(gbase) + (voff)[_i]), (PG8_LAS unsigned*)(lds + (bufoff) + ldsw + _i * 8192), 16, 0, 0); } while (0)
#define PG8_LDA(dst, b, h) do { _Pragma("unroll") for (int m = 0; m < 4; ++m) _Pragma("unroll") for (int k = 0; k < 2; ++k) dst[m][k] = *(const PG8_LAS bf16x8*)(lds + PG8_SA(b, h) + aoff + m * 2048 + k * 1024); } while (0)
#define PG8_LDB(dst, b, h) do { _Pragma("unroll") for (int n = 0; n < 2; ++n) _Pragma("unroll") for (int k = 0; k < 2; ++k) dst[n][k] = *(const PG8_LAS bf16x8*)(lds + PG8_SB(b, h) + boff + n * 2048 + k * 1024); } while (0)
#define PG8_MMA(ai, bj, At, Bt) do { __builtin_amdgcn_s_setprio(1); _Pragma("unroll") for (int m = 0; m < 4; ++m) _Pragma("unroll") for (int n = 0; n < 2; ++n) _Pragma("unroll") for (int k = 0; k < 2; ++k) \
        acc[ai][bj][m][n] = __builtin_amdgcn_mfma_f32_16x16x32_bf16(Bt[n][k], At[m][k], acc[ai][bj][m][n], 0, 0, 0); __builtin_amdgcn_s_setprio(0); } while (0)
#define PG8_WAIT_V(n) asm volatile("s_waitcnt vmcnt(" #n ")" ::: "memory")
#define PG8_WAIT_L(n) asm volatile("s_waitcnt lgkmcnt(" #n ")" ::: "memory")
#define PG8_BAR __builtin_amdgcn_s_barrier()
#define PG8_SCHED __builtin_amdgcn_sched_barrier(0)
    unsigned gAc[2][2], gAn[2][2];
#define PG8_GATHER(dst, un) do { _Pragma("unroll") for (int hh_ = 0; hh_ < 2; ++hh_) _Pragma("unroll") for (int i_ = 0; i_ < 2; ++i_) { \
        const int tok_ = rowtok[(un).pm * BM + hh_ * HALF + (int)(voffA[i_] >> 11)]; dst[hh_][i_] = (unsigned)(tok_ < 0 ? 0 : tok_) * 2048u + (voffA[i_] & 2047u); } } while (0)
#define PG8_STAGE_GA(bufoff, kptr, hh, NX) do { _Pragma("unroll") for (int _i = 0; _i < 2; ++_i) \
        __builtin_amdgcn_global_load_lds((const unsigned*)((const char*)(kptr) + ((NX) ? gAn[hh][_i] : gAc[hh][_i])), (PG8_LAS unsigned*)(lds + (bufoff) + ldsw + _i * 8192), 16, 0, 0); } while (0)
    Unit cur, nxt; int ui = 0;
    if (!S.next(0, cur)) return;
    PG8_GATHER(gAc, cur);
    f32x4 acc[2][2][4][2];
#pragma unroll
    for (int a = 0; a < 2; ++a)
#pragma unroll
        for (int b = 0; b < 2; ++b)
#pragma unroll
            for (int m = 0; m < 4; ++m)
#pragma unroll
                for (int n = 0; n < 2; ++n) acc[a][b][m][n] = (f32x4){0.f, 0.f, 0.f, 0.f};
    bf16x8 At[4][2], B0[2][2], B1[2][2];
    const char* cA = (const char*)g.A; const char* cB = (const char*)g.Bt + S.bofs(cur, tstep);
    S.a_ready(cur);
    if constexpr (SP2) {
        PG8_STAGE(PG8_SB(0, 0), cB, voffB); PG8_STAGE(PG8_SB(0, 1), cB + hstep, voffB); PG8_STAGE_GA(PG8_SA(0, 0), cA, 0, false); PG8_STAGE_GA(PG8_SA(0, 1), cA, 1, false);
        if (wr == 1) PG8_BAR;
        PG8_WAIT_V(2); PG8_BAR;
        PG8_STAGE(PG8_SB(1, 0), cB + kstep, voffB); PG8_STAGE_GA(PG8_SA(1, 0), cA + kstep, 0, false); PG8_STAGE(PG8_SB(1, 1), cB + hstep + kstep, voffB);
        PG8_WAIT_V(6); PG8_BAR;
    } else {
        PG8_STAGE(PG8_SB(0, 0), cB, voffB); PG8_STAGE_GA(PG8_SA(0, 0), cA, 0, false); PG8_STAGE(PG8_SB(0, 1), cB + hstep, voffB); PG8_STAGE_GA(PG8_SA(0, 1), cA, 1, false);
        if (wr == 1) PG8_BAR;
        PG8_WAIT_V(4); PG8_BAR;
        PG8_STAGE(PG8_SB(1, 0), cB + kstep, voffB); PG8_STAGE_GA(PG8_SA(1, 0), cA + kstep, 0, false); PG8_STAGE(PG8_SB(1, 1), cB + hstep + kstep, voffB);
        PG8_WAIT_V(6); PG8_BAR;
    }
    for (;;) {
        const bool has_next = S.next(ui + 1, nxt);
        if (has_next) PG8_GATHER(gAn, nxt); else { _Pragma("unroll") for (int hh_ = 0; hh_ < 2; ++hh_) _Pragma("unroll") for (int i_ = 0; i_ < 2; ++i_) gAn[hh_][i_] = gAc[hh_][i_]; }
        const char* nA = (const char*)g.A; const char* nB = has_next ? (const char*)g.Bt + S.bofs(nxt, tstep) : cB;
        for (int t = 0; t < nt; t += 2) {
            const bool last = (t == nt - 2);
            const char* a1 = cA + (size_t)(t + 1) * kstep;
            const char* a2 = last ? nA : cA + (size_t)(t + 2) * kstep; const char* b2 = last ? nB : cB + (size_t)(t + 2) * kstep;
            const char* a3 = a2 + kstep; const char* b3 = b2 + kstep;
            if (last && has_next) S.a_ready(nxt);
            if constexpr (SP2) {
            PG8_LDB(B0, 0, 0); PG8_LDB(B1, 0, 1); PG8_SCHED; PG8_LDA(At, 0, 0); PG8_STAGE_GA(PG8_SA(1, 1), a1, 1, false);
            PG8_WAIT_V(8); PG8_WAIT_L(0); PG8_BAR; PG8_MMA(0, 0, At, B0); PG8_MMA(0, 1, At, B1); PG8_BAR; PG8_SCHED;
            PG8_LDA(At, 0, 1); PG8_STAGE(PG8_SB(0, 0), b2, voffB); PG8_STAGE(PG8_SB(0, 1), b2 + hstep, voffB); PG8_STAGE_GA(PG8_SA(0, 0), a2, 0, last);
            PG8_WAIT_V(8); PG8_WAIT_L(0); PG8_BAR; PG8_MMA(1, 0, At, B0); PG8_MMA(1, 1, At, B1); PG8_BAR; PG8_SCHED;
            PG8_LDB(B0, 1, 0); PG8_LDB(B1, 1, 1); PG8_SCHED; PG8_LDA(At, 1, 0); PG8_STAGE_GA(PG8_SA(0, 1), a2, 1, last);
            PG8_WAIT_V(8); PG8_WAIT_L(0); PG8_BAR; PG8_MMA(0, 0, At, B0); PG8_MMA(0, 1, At, B1); PG8_BAR; PG8_SCHED;
            PG8_LDA(At, 1, 1); PG8_STAGE(PG8_SB(1, 0), b3, voffB); PG8_STAGE(PG8_SB(1, 1), b3 + hstep, voffB); PG8_STAGE_GA(PG8_SA(1, 0), a3, 0, last);
            PG8_WAIT_V(8); PG8_WAIT_L(0); PG8_BAR; PG8_MMA(1, 0, At, B0); PG8_MMA(1, 1, At, B1); PG8_BAR; PG8_SCHED;
            } else {
            PG8_LDB(B0, 0, 0); PG8_SCHED; PG8_LDA(At, 0, 0); PG8_STAGE_GA(PG8_SA(1, 1), a1, 1, false);
            PG8_WAIT_L(8); PG8_BAR; PG8_WAIT_L(0); PG8_MMA(0, 0, At, B0); PG8_BAR; PG8_SCHED;
            PG8_LDB(B1, 0, 1); PG8_STAGE(PG8_SB(0, 0), b2, voffB);
            PG8_BAR; PG8_WAIT_L(0); PG8_MMA(0, 1, At, B1); PG8_BAR;
            PG8_LDA(At, 0, 1); PG8_STAGE_GA(PG8_SA(0, 0), a2, 0, last);
            PG8_BAR; PG8_WAIT_L(0); PG8_MMA(1, 0, At, B0); PG8_BAR; PG8_SCHED;
            PG8_STAGE(PG8_SB(0, 1), b2 + hstep, voffB);
            PG8_WAIT_V(6); PG8_BAR; PG8_MMA(1, 1, At, B1); PG8_BAR;
            PG8_LDB(B0, 1, 0); PG8_SCHED; PG8_LDA(At, 1, 0); PG8_STAGE_GA(PG8_SA(0, 1), a2, 1, last);
            PG8_WAIT_L(8); PG8_BAR; PG8_WAIT_L(0); PG8_MMA(0, 0, At, B0); PG8_BAR; PG8_SCHED;
            PG8_LDB(B1, 1, 1); PG8_STAGE(PG8_SB(1, 0), b3, voffB);
            PG8_BAR; PG8_WAIT_L(0); PG8_MMA(0, 1, At, B1); PG8_BAR;
            PG8_LDA(At, 1, 1); PG8_STAGE_GA(PG8_SA(1, 0), a3, 0, last);
            PG8_BAR; PG8_WAIT_L(0); PG8_MMA(1, 0, At, B0); PG8_BAR; PG8_SCHED;
            PG8_STAGE(PG8_SB(1, 1), b3 + hstep, voffB);
            PG8_WAIT_V(6); PG8_BAR; PG8_MMA(1, 1, At, B1); PG8_BAR;
            }
        }
        if constexpr (ALIGN_EPI) { if (wr == 0) PG8_BAR; }
        if constexpr (!Epi::AFTER_DRAIN) { E(acc, cur, wr, wc, fr, fq); S.done(cur); }
        if (!has_next) break;
#pragma unroll
        for (int a = 0; a < 2; ++a)
#pragma unroll
            for (int b = 0; b < 2; ++b)
#pragma unroll
                for (int m = 0; m < 4; ++m)
#pragma unroll
                    for (int n = 0; n < 2; ++n) acc[a][b][m][n] = (f32x4){0.f, 0.f, 0.f, 0.f};
        cur = nxt; cA = nA; cB = nB; ++ui;
        _Pragma("unroll") for (int hh_ = 0; hh_ < 2; ++hh_) _Pragma("unroll") for (int i_ = 0; i_ < 2; ++i_) gAc[hh_][i_] = gAn[hh_][i_];
        if constexpr (ALIGN_EPI) { if (wr == 1) PG8_BAR; }
    }
    PG8_WAIT_V(0);
    if constexpr (!ALIGN_EPI) { if (wr == 0) PG8_BAR; }
    PG8_BAR;
    if constexpr (Epi::AFTER_DRAIN) { E.fused(acc, cur, wr, wc, fr, fq, lds, wid, lane); S.done(cur); }
#undef PG8_GATHER
#undef PG8_STAGE_GA
#undef PG8_SA
#undef PG8_SB
#undef PG8_STAGE
#undef PG8_LDA
#undef PG8_LDB
#undef PG8_MMA
#undef PG8_WAIT_V
#undef PG8_WAIT_L
#undef PG8_BAR
#undef PG8_SCHED
}
}
#define XB_TMO      128
#define XB_XCNT(j)  (256  + 64 * (j))
#define XB_XSUB(j)  (1280 + 64 * (j))
#define XB_XGEN(j)  (2304 + 64 * (j))
#define XB_TOP      3328
#define XB_TOPGEN   3392
#define XCD_BAR_WORDS 3456
#define XB_SPIN_CAP (1u << 18)

__device__ __forceinline__ unsigned xb_ld(unsigned* p)              { return __hip_atomic_load(p, __ATOMIC_RELAXED, __HIP_MEMORY_SCOPE_AGENT); }
__device__ __forceinline__ unsigned xb_add(unsigned* p, unsigned v) { return __hip_atomic_fetch_add(p, v, __ATOMIC_RELAXED, __HIP_MEMORY_SCOPE_AGENT); }
__device__ __forceinline__ unsigned xb_xcc_id() { return (unsigned)__builtin_amdgcn_s_getreg((3 << 11) | 20) & 0xFu; }
#define XB_SPIN(cond, bar) do { unsigned _sp = 0; while (cond) { __builtin_amdgcn_s_sleep(1); \
    if ((++_sp & 255u) == 0u) { if (xb_ld(&(bar)[XB_TMO])) break; if (_sp > XB_SPIN_CAP) { atomicAdd(&(bar)[XB_TMO], 1u); break; } } } } while (0)

struct XcdBarrier {
    unsigned* bar; unsigned x;
    volatile LAS unsigned* st;
};

__device__ __forceinline__ XcdBarrier xcd_barrier_post(unsigned* bar, volatile LAS unsigned* st) {
    XcdBarrier b; b.bar = bar; b.x = xb_xcc_id(); b.st = st;
    if (threadIdx.x == 0) (void)xb_add(&bar[XB_XCNT(b.x)], 1u);
    return b;
}
__device__ __forceinline__ void xcd_barrier_complete(unsigned* bar, unsigned x, unsigned& nloc, unsigned& nx) {
    const unsigned G = gridDim.x * gridDim.y * gridDim.z;
    unsigned sum, cnt, mine, sp = 0u;
    for (;;) {
        sum = 0u; cnt = 0u; mine = 0u;
#pragma unroll
        for (unsigned j = 0; j < 16; ++j) { const unsigned c = xb_ld(&bar[XB_XCNT(j)]); sum += c; cnt += (c > 0u) ? 1u : 0u; mine = (j == x) ? c : mine; }
        if (sum == G) break;
        __builtin_amdgcn_s_sleep(1);
        if ((++sp & 255u) == 0u) { if (xb_ld(&bar[XB_TMO])) break; if (sp > XB_SPIN_CAP) { atomicAdd(&bar[XB_TMO], 1u); break; } }
    }
    nloc = mine > 0u ? mine : 1u; nx = cnt > 0u ? cnt : 1u;
}

__device__ __forceinline__ void xcd_barrier(const XcdBarrier& b) {
    asm volatile("s_waitcnt vmcnt(0)" ::: "memory");
    __syncthreads();
    if (threadIdx.x == 0) {
        unsigned* bar = b.bar;
        __builtin_amdgcn_s_waitcnt(0);
        unsigned nloc = b.st[0], nx = b.st[1];
        if (nloc == 0u) { xcd_barrier_complete(bar, b.x, nloc, nx); b.st[0] = nloc; b.st[1] = nx; }
        const unsigned old = xb_add(&bar[XB_XSUB(b.x)], 1u);
        const unsigned gen = old / nloc;
        if (old + 1u == (gen + 1u) * nloc) {
            __builtin_amdgcn_fence(__ATOMIC_RELEASE, "agent");
            asm volatile("s_waitcnt vmcnt(0)" ::: "memory");
            const unsigned og = xb_add(&bar[XB_TOP], 1u);
            const unsigned tg = og / nx;
            if (og + 1u == (tg + 1u) * nx) xb_add(&bar[XB_TOPGEN], 1u);
            else XB_SPIN(xb_ld(&bar[XB_TOPGEN]) == tg, bar);
            __builtin_amdgcn_fence(__ATOMIC_ACQUIRE, "agent");
            xb_add(&bar[XB_XGEN(b.x)], 1u);
            asm volatile("s_waitcnt vmcnt(0)" ::: "memory");
        } else {
            XB_SPIN(xb_ld(&bar[XB_XGEN(b.x)]) == gen, bar);
            __builtin_amdgcn_fence(__ATOMIC_ACQUIRE, "agent");
            asm volatile("s_waitcnt vmcnt(0)" ::: "memory");
        }
    }
    __syncthreads();
}

struct Params {
    const float* in[33];
    float* out; unsigned char* ws;
    int ph_lo, ph_hi;
};
struct Frame {
    LAS unsigned char* lds;
    int blk, G, wv;
    float* out; unsigned char* ws;
};
constexpr int PTAB_OFF = LDSCTL_OFF + 1024;
__device__ __forceinline__ int lane_id() { int l; asm volatile("v_mbcnt_lo_u32_b32 %0, -1, 0\n\tv_mbcnt_hi_u32_b32 %0, -1, %0" : "=v"(l)); return l; }
__device__ __forceinline__ int mytid(const Frame& F) { int t = F.wv * 64 + lane_id(); asm volatile("" : "+v"(t)); return t; }
__device__ __forceinline__ const float* inptr(const Frame& F, int k) {
    volatile LAS unsigned* t = (volatile LAS unsigned*)(F.lds + PTAB_OFF) + 2 * k;
    const unsigned lo = __builtin_amdgcn_readfirstlane(t[0]), hi = __builtin_amdgcn_readfirstlane(t[1]);
    const GAS float* gp = (const GAS float*)(((unsigned long long)hi << 32) | (unsigned long long)lo);
    return (const float*)gp;
}
#define IN_X 0
#define IN_RELB 1
#define IN_MIXG 2
#define IN_WIN 3
#define IN_WOUT 4
#define IN_FFNG 5
#define IN_QG 6
#define IN_KG 7
#define IN_CW 8
#define IN_CB 9
#define IN_CLG 10
#define IN_CLB 11
#define IN_MU 12
#define IN_W0 13
#define IN_W2 14
#define IN_A0 15
#define IN_A2 16
#define IN_G2 17
#define IN_KK 18
#define IN_KA 19
#define IN_RK 20
#define IN_RLG 21
#define IN_RLB 22
#define IN_GG2 23
#define IN_GGB 24
#define IN_GNG 25
#define IN_FWG 26
#define IN_FWU 27
#define IN_FWD 28
#define IN_ROUTER 29
#define IN_MWG 30
#define IN_MWU 31
#define IN_MWD 32

__device__ __forceinline__ void p0_transpose_item(const float* W, int K, int N, int nblk, const float* gk, bf16* WT, int mode, LAS float* scr, int item, int lane) {
    (void)scr;
    const int kb = item / nblk, nb = item % nblk, k0 = 64 * kb, n0 = 64 * nb, kq = lane >> 4, n4 = (lane & 15) * 4;
    const bool valid = (n0 + n4) < N;
    f32x4 v[16]; float gg[16];
#pragma unroll
    for (int i = 0; i < 16; ++i) gg[i] = gk ? gk[k0 + 16 * kq + i] : 1.0f;
#pragma unroll
    for (int i = 0; i < 16; ++i) v[i] = valid ? *(const f32x4*)(W + (size_t)(k0 + 16 * kq + i) * N + n0 + n4) : (f32x4){0.f, 0.f, 0.f, 0.f};
    asm volatile("" : "+v"(gg[0]), "+v"(gg[1]), "+v"(gg[2]), "+v"(gg[3]), "+v"(gg[4]), "+v"(gg[5]), "+v"(gg[6]), "+v"(gg[7]));
    asm volatile("" : "+v"(gg[8]), "+v"(gg[9]), "+v"(gg[10]), "+v"(gg[11]), "+v"(gg[12]), "+v"(gg[13]), "+v"(gg[14]), "+v"(gg[15]));
#pragma unroll
    for (int i = 0; i < 16; ++i) v[i] = v[i] * gg[i];
    const int rowbase = (mode == 0) ? n0 : ((n0 >> 7) * 256 + (mode == 2 ? 128 : 0) + (n0 & 127));
#pragma unroll
    for (int e = 0; e < 4; ++e) { bf16* dst = WT + (size_t)(rowbase + n4 + e) * K + k0 + 16 * kq;
        u32x4 o0, o1; o0.x = pk2(v[0][e], v[1][e]); o0.y = pk2(v[2][e], v[3][e]); o0.z = pk2(v[4][e], v[5][e]); o0.w = pk2(v[6][e], v[7][e]);
        o1.x = pk2(v[8][e], v[9][e]); o1.y = pk2(v[10][e], v[11][e]); o1.z = pk2(v[12][e], v[13][e]); o1.w = pk2(v[14][e], v[15][e]);
        *(u32x4*)dst = o0; *(u32x4*)(dst + 8) = o1; }
}
__device__ __forceinline__ void p0_prologue(Frame& F, const int part) {
    const int tid = mytid(F), lane = tid & 63, wave = __builtin_amdgcn_readfirstlane(tid >> 6); (void)lane; (void)wave;
    LAS float* scr = (LAS float*)(F.lds + wave * 16384);
    const int gw = F.blk * NWAVES + wave, NGW = F.G * NWAVES;
    constexpr int I_IN = 16 * 48, I_OUT = 16 * 16, I_GU = 16 * 44, I_D = 44 * 16, I_SET = 2 * I_GU + I_D;
    constexpr int NITEMS = 2 * I_IN + 2 * I_OUT + 9 * I_SET;
    unsigned char* ws = F.ws;
    constexpr int NPART0 = 2 * I_IN + 2 * I_OUT + I_SET;
    for (int it = (part == 0 ? 0 : NPART0) + gw; it < (part == 0 ? NPART0 : NITEMS); it += NGW) {
        int r = it;
        if (r < 2 * I_IN) { const int l = r / I_IN; r -= l * I_IN;
            p0_transpose_item(inptr(F, IN_WIN) + (size_t)l * DM * INW, DM, INW, 48, inptr(F, IN_MIXG) + l * DM, (bf16*)(ws + WS_WIN) + (size_t)l * NPADW * DM, 0, scr, r, lane); continue; }
        r -= 2 * I_IN;
        if (r < 2 * I_OUT) { const int l = r / I_OUT; r -= l * I_OUT;
            p0_transpose_item(inptr(F, IN_WOUT) + (size_t)l * DM * DM, DM, DM, 16, nullptr, (bf16*)(ws + WS_WOUT) + (size_t)l * DM * DM, 0, scr, r, lane); continue; }
        r -= 2 * I_OUT;
        const int set = r / I_SET; r -= set * I_SET;
        const float* wg = set == 0 ? inptr(F, IN_FWG) : inptr(F, IN_MWG) + (size_t)(set - 1) * DM * DFF;
        const float* wu = set == 0 ? inptr(F, IN_FWU) : inptr(F, IN_MWU) + (size_t)(set - 1) * DM * DFF;
        const float* wd = set == 0 ? inptr(F, IN_FWD) : inptr(F, IN_MWD) + (size_t)(set - 1) * DFF * DM;
        const float* gk = inptr(F, IN_FFNG) + (set == 0 ? 0 : DM);
        bf16* dgu = set == 0 ? (bf16*)(ws + WS_WGU) : (bf16*)(ws + WS_MOEW + (size_t)(set - 1) * MOEW_E_BYTES);
        bf16* dd = set == 0 ? (bf16*)(ws + WS_WD) : (bf16*)(ws + WS_MOEW + (size_t)(set - 1) * MOEW_E_BYTES + MOEW_GU_BYTES);
        if (r < I_GU) { p0_transpose_item(wg, DM, DFF, 44, gk, dgu, 1, scr, r, lane); continue; } r -= I_GU;
        if (r < I_GU) { p0_transpose_item(wu, DM, DFF, 44, gk, dgu, 2, scr, r, lane); continue; } r -= I_GU;
        p0_transpose_item(wd, DFF, DM, 16, nullptr, dd, 0, scr, r, lane);
    }
    if (part != 0) return;
    const float* x = inptr(F, IN_X); bf16* hb = (bf16*)(ws + WS_HB); float* ssq = (float*)(ws + WS_SSQ);
    for (int m = gw; m < NTOK; m += NGW) {
        const f32x4* xr = (const f32x4*)(x + (size_t)m * DM) + lane; f32x4 v[4]; float s = 0.f;
#pragma unroll
        for (int j = 0; j < 4; ++j) { v[j] = xr[64 * j]; s += (v[j][0] * v[j][0] + v[j][1] * v[j][1]) + (v[j][2] * v[j][2] + v[j][3] * v[j][3]); }
        s = wave_sum(s);
        u32x2* o8 = (u32x2*)(hb + (size_t)m * DM) + lane;
#pragma unroll
        for (int j = 0; j < 4; ++j) { u32x2 w; w.x = pk2(v[j][0], v[j][1]); w.y = pk2(v[j][2], v[j][3]); o8[64 * j] = w; }
        if (lane < 16) ssq[(size_t)m * 16 + lane] = (lane == 0) ? s : 0.f;
    }
}

__device__ const unsigned char T5B[3][132] = {
 {0,1,2,3,4,5,6,7,8,9,10,11,12,13,14,15,16,16,16,16,16,16,17,17,17,17,17,17,17,17,18,18,18,18,18,18,18,18,18,18,19,19,19,19,19,19,19,19,19,19,19,19,19,19,20,20,20,20,20,20,20,20,20,20,20,20,20,20,20,20,20,20,20,21,21,21,21,21,21,21,21,21,21,21,21,21,21,21,21,21,21,21,21,21,21,21,21,21,21,22,22,22,22,22,22,22,22,22,22,22,22,22,22,22,22,22,22,22,22,22,22,22,22,22,22,22,22,22,22,0,0,0},
 {0,4,8,12,16,16,17,17,18,18,19,19,19,19,20,20,20,20,20,21,21,21,21,21,21,22,22,22,22,22,22,22,22,22,23,23,23,23,23,23,23,23,23,23,23,23,24,24,24,24,24,24,24,24,24,24,24,24,24,24,24,24,25,25,25,25,25,25,25,25,25,25,25,25,25,25,25,25,25,25,25,25,25,26,26,26,26,26,26,26,26,26,26,26,26,26,26,26,26,26,26,26,26,26,26,26,26,26,26,26,26,26,26,27,27,27,27,27,27,27,27,27,27,27,27,27,27,27,27,0,0,0},
 {0,16,18,19,20,21,21,22,22,23,23,23,24,24,24,24,25,25,25,25,25,26,26,26,26,26,26,26,26,27,27,27,27,27,27,27,27,27,27,28,28,28,28,28,28,28,28,28,28,28,28,28,29,29,29,29,29,29,29,29,29,29,29,29,29,29,29,29,29,29,30,30,30,30,30,30,30,30,30,30,30,30,30,30,30,30,30,30,30,30,30,30,30,30,30,31,31,31,31,31,31,31,31,31,31,31,31,31,31,31,31,31,31,31,31,31,31,31,31,31,31,31,31,31,31,31,31,31,31,0,0,0}};

__device__ __forceinline__ void attn_qknorm(Frame& F, bf16* Z, const float* qg, const float* kg) {
    const int tid = mytid(F); const int gt = F.blk * NTHREADS + tid, NGT = F.G * NTHREADS;
    const int c8 = gt & 7, seg = (gt >> 3) & 7;
    const float* gp = (seg < 4 ? qg : kg) + c8 * 8; float gq[8];
#pragma unroll
    for (int e2 = 0; e2 < 8; ++e2) gq[e2] = gp[e2] * (seg < 4 ? 0.125f : 1.0f);
    for (int base = gt; base < NTOK * 64; base += 4 * NGT) {
        u32x4* ptr[4]; u32x4 p[4];
#pragma unroll
        for (int k = 0; k < 4; ++k) { const int idx = base + k * NGT; ptr[k] = (u32x4*)(Z + (size_t)(idx >> 6) * INW + (seg >> 2) * 256 + (seg & 3) * 64 + c8 * 8); p[k] = (idx < NTOK * 64) ? *ptr[k] : (u32x4){0u, 0u, 0u, 0u}; }
#pragma unroll
        for (int k = 0; k < 4; ++k) { float f[8]; unpack8(p[k], f); float ss = 0.f;
#pragma unroll
            for (int e2 = 0; e2 < 8; ++e2) ss += f[e2] * f[e2];
            ss = red8(ss);
            const float rs = __builtin_amdgcn_rsqf(ss * (1.0f / 64.0f) + NORM_EPS);
            u32x4 o; o.x = pk2(f[0] * rs * gq[0], f[1] * rs * gq[1]); o.y = pk2(f[2] * rs * gq[2], f[3] * rs * gq[3]); o.z = pk2(f[4] * rs * gq[4], f[5] * rs * gq[5]); o.w = pk2(f[6] * rs * gq[6], f[7] * rs * gq[7]);
            if (base + k * NGT < NTOK * 64) *ptr[k] = o; } }
}
typedef short v4i16 __attribute__((ext_vector_type(4)));
__device__ __forceinline__ void attn_tile(LAS unsigned char* lds, const bf16* Z, bf16* OP, float* LSE, const float* rel_bias, int tile, int tid) {
    const int lane = tid & 63, w = __builtin_amdgcn_readfirstlane(tid >> 6), fr = lane & 15, g = lane >> 4;
    const int br = tile >> 10, rem = tile & 1023, b = rem >> 7, h = (rem >> 5) & 3, sub = rem & 31;
    const int dsh = 2 * br, nbl = 32 >> dsh, r = sub >> (5 - dsh), n = sub & (nbl - 1);
    LAS unsigned char* Qs = lds;
    LAS unsigned char* Ks = lds + 16384;
    LAS unsigned char* Vs = lds + 49152;
    LAS float* BT = (LAS float*)(lds + 81920);
    const size_t zrow0 = (size_t)b * SEQ;
    { const int rl = lane >> 3, cp = lane & 7;
#pragma unroll
        for (int i = 0; i < 4; ++i) { const int R0 = (w * 4 + i) * 8, row = R0 + rl; int lk = 128 * (n - 1) + row; lk = lk < 0 ? 0 : lk;
            const bf16* zr = Z + (zrow0 + ((size_t)lk << dsh) + r) * INW + h * 64;
            __builtin_amdgcn_global_load_lds((const unsigned*)(zr + 256 + ((cp ^ (row & 7)) * 8)), (LAS unsigned*)(Ks + R0 * 128), 16, 0, 0);
            __builtin_amdgcn_global_load_lds((const unsigned*)(zr + 512 + ((2 * ((cp >> 1) ^ ((row >> 1) & 3)) + (cp & 1)) * 8)), (LAS unsigned*)(Vs + R0 * 128), 16, 0, 0); }
#pragma unroll
        for (int i = 0; i < 2; ++i) { const int R0 = (w * 2 + i) * 8, row = R0 + rl; const int lq = 128 * n + row;
            const bf16* zr = Z + (zrow0 + ((size_t)lq << dsh) + r) * INW + h * 64;
            __builtin_amdgcn_global_load_lds((const unsigned*)(zr + ((cp ^ (row & 7)) * 8)), (LAS unsigned*)(Qs + R0 * 128), 16, 0, 0); } }
    if (tid < 383) { const int delta = tid - 127; BT[tid] = (delta >= 0 && delta <= 128) ? rel_bias[(int)T5B[br][delta] * 4 + h] : -3.0e38f; }
    asm volatile("s_waitcnt vmcnt(0)" ::: "memory");
    BAR();
    bf16x8 qf[2];
#pragma unroll
    for (int ks = 0; ks < 2; ++ks) qf[ks] = *(const LAS bf16x8*)(Qs + (16 * w + fr) * 128 + (((ks * 4 + g) ^ (fr & 7)) << 4));
    f32x4 s[16];
#pragma unroll
    for (int kb = 0; kb < 16; ++kb) { s[kb] = (f32x4){0.f, 0.f, 0.f, 0.f};
#pragma unroll
        for (int ks = 0; ks < 2; ++ks) { const bf16x8 kf = *(const LAS bf16x8*)(Ks + (16 * kb + fr) * 128 + (((ks * 4 + g) ^ (fr & 7)) << 4));
            s[kb] = __builtin_amdgcn_mfma_f32_16x16x32_bf16(kf, qf[ks], s[kb], 0, 0, 0); } }
    const int q = 16 * w + fr; float mx = -3.0e38f;
    const LAS float* btq = BT + (q + 255 - 4 * g);
#pragma unroll
    for (int kb = 0; kb < 16; ++kb)
#pragma unroll
        for (int rg = 0; rg < 4; ++rg) { float v = s[kb][rg] + btq[-(16 * kb + rg)];
            if (kb < 8) v = (n > 0) ? v : -3.0e38f;
            s[kb][rg] = v; mx = fmaxf(mx, v); }
    mx = fmaxf(mx, __shfl_xor(mx, 16)); mx = fmaxf(mx, __shfl_xor(mx, 32));
    float den = 0.f;
#pragma unroll
    for (int kb = 0; kb < 16; ++kb)
#pragma unroll
        for (int rg = 0; rg < 4; ++rg) { const float p = __expf(s[kb][rg] - mx); s[kb][rg] = p; den += p; }
    den += __shfl_xor(den, 16); den += __shfl_xor(den, 32);
    f32x4 o[4];
#pragma unroll
    for (int eb = 0; eb < 4; ++eb) o[eb] = (f32x4){0.f, 0.f, 0.f, 0.f};
    const int trq = fr >> 2, trp = fr & 3;
#pragma unroll
    for (int s8 = 0; s8 < 8; ++s8) {
        u32x4 pw; pw.x = pk2(s[2 * s8][0], s[2 * s8][1]); pw.y = pk2(s[2 * s8][2], s[2 * s8][3]); pw.z = pk2(s[2 * s8 + 1][0], s[2 * s8 + 1][1]); pw.w = pk2(s[2 * s8 + 1][2], s[2 * s8 + 1][3]);
        const bf16x8 pb = __builtin_bit_cast(bf16x8, pw);
        const int rowA = 32 * s8 + 4 * g + trq, swz = (rowA >> 1) & 3;
#pragma unroll
        for (int eb = 0; eb < 4; ++eb) { const LAS unsigned char* vp = Vs + rowA * 128 + ((eb ^ swz) * 32) + 8 * trp;
            const v4i16 lo = __builtin_amdgcn_ds_read_tr16_b64_v4i16((LAS v4i16*)vp), hi = __builtin_amdgcn_ds_read_tr16_b64_v4i16((LAS v4i16*)(vp + 16 * 128));
            bf16x8 af; af[0] = lo[0]; af[1] = lo[1]; af[2] = lo[2]; af[3] = lo[3]; af[4] = hi[0]; af[5] = hi[1]; af[6] = hi[2]; af[7] = hi[3];
            o[eb] = __builtin_amdgcn_mfma_f32_16x16x32_bf16(af, pb, o[eb], 0, 0, 0); } }
    const float inv = 1.0f / den; const size_t tokq = zrow0 + ((size_t)(128 * n + q) << dsh) + r;
    bf16* op = OP + ((size_t)br * NTOK + tokq) * 256 + h * 64 + 4 * g;
#pragma unroll
    for (int eb = 0; eb < 4; ++eb) { u32x2 wv; wv.x = pk2(o[eb][0] * inv, o[eb][1] * inv); wv.y = pk2(o[eb][2] * inv, o[eb][3] * inv); *(u32x2*)(op + 16 * eb) = wv; }
    if (g == 0) LSE[((size_t)br * NTOK + tokq) * 4 + h] = mx + __logf(den);
    BAR();
}

__device__ __forceinline__ void attn_merge(Frame& F, const bf16* OP, const float* LSE, bf16* Y, int wi, int nw) {
    const int tid = mytid(F); const int gt = wi * NTHREADS + tid, NGT = nw * NTHREADS;
    for (int base = gt; base < NTOK * 32; base += 2 * NGT) {
        u32x4 a[2], bq[2], c[2]; float l0[2], l1[2], l2[2];
#pragma unroll
        for (int k = 0; k < 2; ++k) { const int idx = base + k * NGT < NTOK * 32 ? base + k * NGT : base; const int tok = idx >> 5, c8 = idx & 31, h = c8 >> 3;
            l0[k] = LSE[((size_t)0 * NTOK + tok) * 4 + h]; l1[k] = LSE[((size_t)1 * NTOK + tok) * 4 + h]; l2[k] = LSE[((size_t)2 * NTOK + tok) * 4 + h];
            a[k] = *(const u32x4*)(OP + ((size_t)0 * NTOK + tok) * 256 + c8 * 8); bq[k] = *(const u32x4*)(OP + ((size_t)1 * NTOK + tok) * 256 + c8 * 8); c[k] = *(const u32x4*)(OP + ((size_t)2 * NTOK + tok) * 256 + c8 * 8); }
#pragma unroll
        for (int k = 0; k < 2; ++k) { const int idx = base + k * NGT; if (idx < NTOK * 32) { const int tok = idx >> 5, c8 = idx & 31;
            const float m = fmaxf(l0[k], fmaxf(l1[k], l2[k])); float w0 = __expf(l0[k] - m), w1 = __expf(l1[k] - m), w2 = __expf(l2[k] - m); const float inv = 1.0f / (w0 + w1 + w2); w0 *= inv; w1 *= inv; w2 *= inv;
            float fa[8], fb[8], fc[8]; unpack8(a[k], fa); unpack8(bq[k], fb); unpack8(c[k], fc); float r[8];
#pragma unroll
            for (int e = 0; e < 8; ++e) r[e] = w0 * fa[e] + w1 * fb[e] + w2 * fc[e];
            u32x4 o; o.x = pk2(r[0], r[1]); o.y = pk2(r[2], r[3]); o.z = pk2(r[4], r[5]); o.w = pk2(r[6], r[7]);
            *(u32x4*)(Y + (size_t)tok * DM + c8 * 8) = o; } } }
}

__device__ __forceinline__ void conv_item(Frame& F, const bf16* Z, bf16* Y, const float* cw, const float* cb, const float* lg, const float* lb, int item) {
    const int tid = mytid(F), b = item >> 6, t0 = (item & 63) * 64;
    LAS float* HG = (LAS float*)F.lds;
    LAS float* WL = (LAS float*)(F.lds + 96256);
    f32x4 wq[4]; u32x4 uu[6], gg[6];
#pragma unroll
    for (int i = 0; i < 4; ++i) { const int q = tid + NTHREADS * i; wq[i] = (q < 31 * 64) ? *(const f32x4*)(cw + 4 * q) : (f32x4){0.f, 0.f, 0.f, 0.f}; }
#pragma unroll
    for (int i = 0; i < 6; ++i) { const int p = tid + NTHREADS * i, row = p >> 5, c8 = p & 31, t = t0 - 30 + row; uu[i] = (u32x4){0u, 0u, 0u, 0u}; gg[i] = uu[i];
        if (p < 94 * 32 && t >= 0) { const bf16* zr = Z + ((size_t)b * SEQ + t) * INW + ZB + c8 * 8; uu[i] = *(const u32x4*)zr; gg[i] = *(const u32x4*)(zr + 256); } }
#pragma unroll
    for (int i = 0; i < 4; ++i) { const int q = tid + NTHREADS * i; if (q < 31 * 64) *(LAS f32x4*)(WL + 4 * q) = wq[i]; }
#pragma unroll
    for (int i = 0; i < 6; ++i) { const int p = tid + NTHREADS * i, row = p >> 5, c8 = p & 31;
        if (p < 94 * 32) { float fu[8], fg[8], hv[8]; unpack8(uu[i], fu); unpack8(gg[i], fg);
#pragma unroll
            for (int e = 0; e < 8; ++e) hv[e] = fu[e] * __builtin_amdgcn_rcpf(1.0f + __expf(-fg[e]));
            LAS f32x4* d = (LAS f32x4*)(HG + row * 256 + c8 * 8); d[0] = (f32x4){hv[0], hv[1], hv[2], hv[3]}; d[1] = (f32x4){hv[4], hv[5], hv[6], hv[7]}; } }
    BAR();
    const int tg = tid >> 5, co = tid & 31;
    f32x4 acc[4][2];
    { const f32x4 b0 = *(const f32x4*)(cb + 8 * co), b1 = *(const f32x4*)(cb + 8 * co + 4);
#pragma unroll
        for (int t = 0; t < 4; ++t) { acc[t][0] = b0; acc[t][1] = b1; } }
    f32x4 wv[4][2];
#pragma unroll
    for (int d = 0; d < 4; ++d) { wv[d][0] = (f32x4){0.f, 0.f, 0.f, 0.f}; wv[d][1] = wv[d][0]; }
#pragma unroll 2
    for (int r = 0; r < 34; ++r) {
        const LAS float* hp = HG + (4 * tg + r) * 256 + 8 * co; const f32x4 h0 = *(const LAS f32x4*)hp, h1 = *(const LAS f32x4*)(hp + 4);
#pragma unroll
        for (int d = 3; d > 0; --d) { wv[d][0] = wv[d - 1][0]; wv[d][1] = wv[d - 1][1]; }
        if (r < 31) { wv[0][0] = *(const LAS f32x4*)(WL + r * 256 + 8 * co); wv[0][1] = *(const LAS f32x4*)(WL + r * 256 + 8 * co + 4); } else { wv[0][0] = (f32x4){0.f, 0.f, 0.f, 0.f}; wv[0][1] = wv[0][0]; }
#pragma unroll
        for (int t = 0; t < 4; ++t) { acc[t][0] += h0 * wv[t][0]; acc[t][1] += h1 * wv[t][1]; } }
    const f32x4 g0 = *(const f32x4*)(lg + 8 * co), g1 = *(const f32x4*)(lg + 8 * co + 4), be0 = *(const f32x4*)(lb + 8 * co), be1 = *(const f32x4*)(lb + 8 * co + 4);
#pragma unroll
    for (int t = 0; t < 4; ++t) { const f32x4 x0 = acc[t][0], x1 = acc[t][1];
        float s = ((x0[0] + x0[1]) + (x0[2] + x0[3])) + ((x1[0] + x1[1]) + (x1[2] + x1[3])); s = red8(s);
        const float mean = s * (1.0f / 64.0f); const f32x4 d0 = x0 - mean, d1 = x1 - mean;
        float ss = ((d0[0] * d0[0] + d0[1] * d0[1]) + (d0[2] * d0[2] + d0[3] * d0[3])) + ((d1[0] * d1[0] + d1[1] * d1[1]) + (d1[2] * d1[2] + d1[3] * d1[3])); ss = red8(ss);
        const float rstd = __builtin_amdgcn_rsqf(ss * (1.0f / 64.0f) + 1e-5f); float y[8];
#pragma unroll
        for (int e2 = 0; e2 < 4; ++e2) { const float a = d0[e2] * rstd * g0[e2] + be0[e2], c = d1[e2] * rstd * g1[e2] + be1[e2]; y[e2] = a * __builtin_amdgcn_rcpf(1.0f + __expf(-a)); y[4 + e2] = c * __builtin_amdgcn_rcpf(1.0f + __expf(-c)); }
        u32x4 o; o.x = pk2(y[0], y[1]); o.y = pk2(y[2], y[3]); o.z = pk2(y[4], y[5]); o.w = pk2(y[6], y[7]);
        *(u32x4*)(Y + ((size_t)b * SEQ + t0 + 4 * tg + t) * DM + 256 + 8 * co) = o; }
    BAR();
}

__device__ __forceinline__ bf16x8 ldfrag(const LAS unsigned char* base, int stride, int row0, int kb0, int fr, int g) {
    return *(const LAS bf16x8*)(base + (row0 + fr) * stride + kb0 + 16 * g);
}
#define MFMA16(a, b, c) __builtin_amdgcn_mfma_f32_16x16x32_bf16((a), (b), (c), 0, 0, 0)

constexpr int GL_G2 = 0, GL_Q = 2048, GL_K = 6144, GL_GK = 10240, GL_GD = 14336, GL_OG = 16384, GL_QT = 24576, GL_KB = 27136, GL_KHT = 29696, GL_VT = 32256, GL_ATT = 37376, GL_ST = 39936, GL_EC = 45056,
              GL_OB = 45184, GL_GB = 53376, GL_END = 53504;
struct GlaRaw { u32x4 p[2]; u32x4 s; };
__device__ __forceinline__ void gla_decode(int tid, int h, int it, int& tt, int& col, int& kind, int& off, bool& ok) {
    const int p = tid + 512 * it; ok = p < 832; tt = p / 26; const int qd = p % 26;
    if (qd < 4) { col = ZD + h * 32 + 8 * qd; kind = 0; off = tt * 32 + 8 * qd; }
    else if (qd < 8) { col = ZD + 128 + h * 32 + 8 * (qd - 4); kind = 1; off = tt * 32 + 8 * (qd - 4); }
    else if (qd < 16) { col = ZD + 256 + h * 64 + 8 * (qd - 8); kind = 2; off = 8 * (qd - 8); }
    else if (qd < 18) { col = ZD + 512 + 8 * (qd - 16); kind = 3; off = tt * 16 + 8 * (qd - 16); }
    else { col = ZD + 528 + h * 64 + 8 * (qd - 18); kind = 4; off = tt * 64 + 8 * (qd - 18); }
}
struct GlaAux { const unsigned char* qt; const unsigned char* kb; };
template <int STEP> __device__ __forceinline__ void gla_load(const bf16* Z, const unsigned char* sst, const GlaAux ax, int b, int h, int ch, int tid, GlaRaw& r) {
    const size_t item = (size_t)((b * 4 + h) * (SEQ / 32) + ch);
    if (STEP == 0) {
#pragma unroll
        for (int it = 0; it < 2; ++it) { int tt, col, kind, off; bool ok; gla_decode(tid, h, it, tt, col, kind, off, ok);
            r.p[it] = ok ? *(const u32x4*)(Z + ((size_t)b * SEQ + ch * 32 + tt) * INW + col) : (u32x4){0u, 0u, 0u, 0u}; }
    } else {
#pragma unroll
        for (int it = 0; it < 2; ++it) { const int p = tid + 512 * it;
            if (p < 128) r.p[it] = *(const u32x4*)(ax.qt + item * 2048 + 16 * p);
            else if (p < 256) r.p[it] = *(const u32x4*)(ax.kb + item * 2048 + 16 * (p - 128));
            else if (p < 768) { const int q = (p - 256) & 255, tt = q >> 3, c8 = q & 7; r.p[it] = *(const u32x4*)(Z + ((size_t)b * SEQ + ch * 32 + tt) * INW + ZD + (p < 512 ? 256 : 528) + h * 64 + 8 * c8); }
            else r.p[it] = *(const u32x4*)(sst + item * 4096 + 16 * (p - 768)); }
    }
}
template <int STEP> __device__ __forceinline__ void gla_item(Frame& F, const GlaRaw& raw, GlaRaw& nraw, unsigned char* con, float* ecg, const GlaAux ax, bf16* Y, const float* ng, int b, int h, int ch) {
    const int tid = mytid(F), lane = tid & 63, w = __builtin_amdgcn_readfirstlane(tid >> 6), fr = lane & 15, g = lane >> 4;
    LAS unsigned char* L = F.lds;
    LAS float *G2 = (LAS float*)(L + GL_G2), *QF = (LAS float*)(L + GL_Q), *KF = (LAS float*)(L + GL_K), *GK = (LAS float*)(L + GL_GK), *GD = (LAS float*)(L + GL_GD), *OG = (LAS float*)(L + GL_OG),
              *OB = (LAS float*)(L + GL_OB), *GB = (LAS float*)(L + GL_GB);
    LAS unsigned char *QT = L + GL_QT, *KB = L + GL_KB, *KHT = L + GL_KHT, *VT = L + GL_VT, *ATT = L + GL_ATT, *ST = L + GL_ST;
    const size_t item = (size_t)((b * 4 + h) * (SEQ / 32) + ch);
    if (STEP == 0) {
#pragma unroll
        for (int it = 0; it < 2; ++it) { int tt, col, kind, off; bool ok; gla_decode(tid, h, it, tt, col, kind, off, ok);
            if (ok) { float f[8]; unpack8(raw.p[it], f);
                if (kind == 2) { LAS unsigned short* vp = (LAS unsigned short*)(VT + off * 80 + tt * 2); const u32x4 pr = raw.p[it];
                    vp[0 * 40] = (unsigned short)(pr.x & 0xffffu); vp[1 * 40] = (unsigned short)(pr.x >> 16); vp[2 * 40] = (unsigned short)(pr.y & 0xffffu); vp[3 * 40] = (unsigned short)(pr.y >> 16);
                    vp[4 * 40] = (unsigned short)(pr.z & 0xffffu); vp[5 * 40] = (unsigned short)(pr.z >> 16); vp[6 * 40] = (unsigned short)(pr.w & 0xffffu); vp[7 * 40] = (unsigned short)(pr.w >> 16); }
                else if (kind != 4) { LAS float* dst = (kind == 0 ? QF : kind == 1 ? KF : GD) + off; const float sc = kind == 0 ? 0.17677669529663687f : 1.0f;
                    ((LAS f32x4*)dst)[0] = (f32x4){f[0] * sc, f[1] * sc, f[2] * sc, f[3] * sc}; ((LAS f32x4*)dst)[1] = (f32x4){f[4] * sc, f[5] * sc, f[6] * sc, f[7] * sc}; } } }
        BAR();
#pragma unroll
        for (int it = 0; it < 2; ++it) { const int o = tid + 512 * it, tt = o >> 5, kk = o & 31; float x = GB[kk];
#pragma unroll
            for (int j = 0; j < 16; ++j) x += GD[tt * 16 + j] * G2[j * 32 + kk];
            GK[tt * 32 + kk] = -softplusf_(-x) * (1.0f / 16.0f); }
        BAR();
        { const int t = tid >> 4, k2 = (tid & 15) * 2; float c0 = 0.f, c1 = 0.f, b0 = 0.f, b1 = 0.f;
#pragma unroll 8
            for (int s = 0; s < 32; ++s) { const f32x2 gk = *(const LAS f32x2*)(GK + s * 32 + k2); c0 += gk[0]; c1 += gk[1]; if (s == t) { b0 = c0; b1 = c1; } }
            const f32x2 q = *(const LAS f32x2*)(QF + t * 32 + k2), k = *(const LAS f32x2*)(KF + t * 32 + k2);
            *(unsigned*)(ax.qt + item * 2048 + t * 64 + k2 * 2) = pk2(q[0] * __expf(b0), q[1] * __expf(b1)); *(unsigned*)(ax.kb + item * 2048 + t * 64 + k2 * 2) = pk2(k[0] * __expf(-b0), k[1] * __expf(-b1));
            *(LAS unsigned short*)(KHT + k2 * 80 + t * 2) = (unsigned short)f2bf(k[0] * __expf(c0 - b0)); *(LAS unsigned short*)(KHT + (k2 + 1) * 80 + t * 2) = (unsigned short)f2bf(k[1] * __expf(c1 - b1));
            if (t == 0) { ecg[item * 32 + k2] = __expf(c0); ecg[item * 32 + k2 + 1] = __expf(c1); } }
        BAR();
        { const int kb = w >> 2, vb = w & 3; f32x4 d = (f32x4){0.f, 0.f, 0.f, 0.f};
            d = MFMA16(ldfrag(KHT, 80, 16 * kb, 0, fr, g), ldfrag(VT, 80, 16 * vb, 0, fr, g), d);
            u32x2 so; so.x = pk2(d[0], d[1]); so.y = pk2(d[2], d[3]); *(u32x2*)(con + item * 4096 + (16 * vb + fr) * 64 + (16 * kb + 4 * g) * 2) = so; }
        BAR();
    } else {
#pragma unroll
        for (int it = 0; it < 2; ++it) { const int p = tid + 512 * it; const u32x4 pr = raw.p[it];
            if (p < 128) *(LAS u32x4*)(QT + (p >> 2) * 80 + (p & 3) * 16) = pr;
            else if (p < 256) { const int q = p - 128; *(LAS u32x4*)(KB + (q >> 2) * 80 + (q & 3) * 16) = pr; }
            else if (p < 512) { const int q = p - 256, tt = q >> 3, c8 = q & 7; LAS unsigned short* vp = (LAS unsigned short*)(VT + (8 * c8) * 80 + tt * 2);
                vp[0 * 40] = (unsigned short)(pr.x & 0xffffu); vp[1 * 40] = (unsigned short)(pr.x >> 16); vp[2 * 40] = (unsigned short)(pr.y & 0xffffu); vp[3 * 40] = (unsigned short)(pr.y >> 16);
                vp[4 * 40] = (unsigned short)(pr.z & 0xffffu); vp[5 * 40] = (unsigned short)(pr.z >> 16); vp[6 * 40] = (unsigned short)(pr.w & 0xffffu); vp[7 * 40] = (unsigned short)(pr.w >> 16); }
            else if (p < 768) { const int q = p - 512; float f[8]; unpack8(pr, f); LAS f32x4* dst = (LAS f32x4*)(OG + q * 8); dst[0] = (f32x4){f[0], f[1], f[2], f[3]}; dst[1] = (f32x4){f[4], f[5], f[6], f[7]}; }
            else { const int q = p - 768; *(LAS u32x4*)(ST + (q >> 2) * 80 + (q & 3) * 16) = pr; } }
        BAR();
        if (w < 3) { const int atb = w == 0 ? 0 : 1, asb = w == 2 ? 1 : 0;
            f32x4 d = (f32x4){0.f, 0.f, 0.f, 0.f}; d = MFMA16(ldfrag(KB, 80, 16 * asb, 0, fr, g), ldfrag(QT, 80, 16 * atb, 0, fr, g), d);
            const int t = 16 * atb + fr; float v[4];
#pragma unroll
            for (int r = 0; r < 4; ++r) { const int s = 16 * asb + 4 * g + r; v[r] = (s <= t) ? d[r] : 0.f; }
            u32x2 o; o.x = pk2(v[0], v[1]); o.y = pk2(v[2], v[3]); *(LAS u32x2*)(ATT + t * 80 + (16 * asb + 4 * g) * 2) = o; }
        else if (w == 3) { *(LAS u32x2*)(ATT + fr * 80 + (16 + 4 * g) * 2) = (u32x2){0u, 0u}; }
        BAR();
        { const int tb = w >> 2, vb = w & 3; f32x4 o = (f32x4){0.f, 0.f, 0.f, 0.f};
            o = MFMA16(ldfrag(ATT, 80, 16 * tb, 0, fr, g), ldfrag(VT, 80, 16 * vb, 0, fr, g), o);
            o = MFMA16(ldfrag(QT, 80, 16 * tb, 0, fr, g), ldfrag(ST, 80, 16 * vb, 0, fr, g), o);
#pragma unroll
            for (int r = 0; r < 4; ++r) OB[(16 * tb + 4 * g + r) * 64 + 16 * vb + fr] = o[r]; }
        BAR();
        { const int tt = tid >> 4, v4 = (tid & 15) * 4; const f32x4 o = *(const LAS f32x4*)(OB + tt * 64 + v4);
            float ss = (o[0] * o[0] + o[1] * o[1]) + (o[2] * o[2] + o[3] * o[3]); ss = red16(ss);
            const float rs = __builtin_amdgcn_rsqf(ss * (1.0f / 64.0f) + NORM_EPS); const f32x4 gv = *(const f32x4*)(ng + v4), og = *(const LAS f32x4*)(OG + tt * 64 + v4); float y[4];
#pragma unroll
            for (int e = 0; e < 4; ++e) y[e] = o[e] * rs * gv[e] * og[e] * __builtin_amdgcn_rcpf(1.0f + __expf(-og[e]));
            asm volatile("" : "+v"(nraw.p[0]), "+v"(nraw.p[1]));
            u32x2 wv; wv.x = pk2(y[0], y[1]); wv.y = pk2(y[2], y[3]); *(u32x2*)(Y + ((size_t)b * SEQ + ch * 32 + tt) * DM + 768 + h * 64 + v4) = wv; }
        BAR();
    }
}
__device__ __forceinline__ int gla_sched(int k, int wi, int nw, int skip) { const int full = 1024 / nw, rem = 1024 - full * nw; if (k < full) return k * nw + wi; if (k == full && wi >= skip && wi - skip < rem) return full * nw + wi - skip; return -1; }
template <int STEP> __device__ __forceinline__ void gla_items(Frame& F, const bf16* Z, unsigned char* con, float* ecg, const GlaAux ax, bf16* Y, const float* g2, const float* gb, const float* ng, int wi, int nw, int skip) {
    const int tid = mytid(F);
#pragma unroll 1
    for (int h = 0; h < 4; ++h) {
        ((LAS float*)(F.lds + GL_G2))[tid] = g2[(tid >> 5) * 128 + h * 32 + (tid & 31)]; if (tid < 32) ((LAS float*)(F.lds + GL_GB))[tid] = gb[h * 32 + tid];
        BAR();
        GlaRaw cur, nxt; cur.p[0] = (u32x4){0u, 0u, 0u, 0u}; cur.p[1] = cur.p[0]; cur.s = cur.p[0]; nxt = cur;
        int it = gla_sched(0, wi, nw, skip);
        if (it >= 0) gla_load<STEP>(Z, con, ax, it >> 7, h, it & 127, tid, cur);
        asm volatile("" : "+v"(cur.p[0]), "+v"(cur.p[1]));
#pragma unroll 1
        for (int k = 0; it >= 0; ++k) { const int i1 = gla_sched(k + 1, wi, nw, skip);
            if (i1 >= 0) gla_load<STEP>(Z, con, ax, i1 >> 7, h, i1 & 127, tid, nxt);
            gla_item<STEP>(F, cur, nxt, con, ecg, ax, Y, ng, it >> 7, h, it & 127);
            cur = nxt; it = i1; }
        BAR(); }
}
constexpr int GW_Q = 0, GW_K = 2048, GW_GD = 4096, GW_VT = 6144, GW_KHT = 11264, GW_BYTES = 16384;
#define WAVE_LDS_SYNC() do { asm volatile("s_waitcnt lgkmcnt(0)" ::: "memory"); __builtin_amdgcn_wave_barrier(); } while (0)
__device__ __forceinline__ void gla0_decode(int p, int h, int& tt, int& qd, int& col) {
    tt = p / 18; qd = p - tt * 18;
    col = qd < 4 ? ZD + h * 32 + 8 * qd : qd < 8 ? ZD + 128 + h * 32 + 8 * (qd - 4) : qd < 16 ? ZD + 256 + h * 64 + 8 * (qd - 8) : ZD + 512 + 8 * (qd - 16);
}
__device__ __forceinline__ void gla0_load(const bf16* Z, int it, int h, int lane, u32x4 (&pc)[9]) {
    const int rest = it >> 2, b = rest >> 7, ch = rest & 127;
#pragma unroll
    for (int i = 0; i < 9; ++i) { int tt, qd, col; gla0_decode(lane + 64 * i, h, tt, qd, col); pc[i] = *(const u32x4*)(Z + ((size_t)b * SEQ + ch * 32 + tt) * INW + col); }
}
__device__ __forceinline__ void gla0_wave_items(Frame& F, const bf16* Z, unsigned char* con, float* ecg, const GlaAux ax, const float* g2, const float* gb) {
    const int tid = mytid(F), lane = tid & 63, w = __builtin_amdgcn_readfirstlane(tid >> 6), fr = lane & 15, g = lane >> 4, kk = lane & 31, half = lane >> 5;
    LAS unsigned char* L = F.lds + w * GW_BYTES;
    const int gw = F.blk * NWAVES + w, NGW = F.G * NWAVES, h = gw & 3;
    float g2c[16];
#pragma unroll
    for (int j = 0; j < 16; ++j) g2c[j] = g2[j * 128 + h * 32 + kk];
    const float gbk = gb[h * 32 + kk];
    u32x4 pc[9], pn[9];
#pragma unroll
    for (int i = 0; i < 9; ++i) { pc[i] = (u32x4){0u, 0u, 0u, 0u}; pn[i] = pc[i]; }
    if (gw < 4096) gla0_load(Z, gw, h, lane, pc);
    asm volatile("" : "+v"(pc[0]), "+v"(pc[1]), "+v"(pc[2]), "+v"(pc[3]), "+v"(pc[4]), "+v"(pc[5]), "+v"(pc[6]), "+v"(pc[7]), "+v"(pc[8]));
#pragma unroll 1
    for (int it = gw; it < 4096; it += NGW) {
        if (it + NGW < 4096) gla0_load(Z, it + NGW, h, lane, pn);
        const int rest = it >> 2, b = rest >> 7, ch = rest & 127; const size_t item = (size_t)((b * 4 + h) * (SEQ / 32) + ch);
#pragma unroll
        for (int i = 0; i < 9; ++i) { int tt, qd, col; gla0_decode(lane + 64 * i, h, tt, qd, col); const u32x4 pr = pc[i];
            if (qd < 4) *(LAS u32x4*)(L + GW_Q + tt * 64 + qd * 16) = pr;
            else if (qd < 8) *(LAS u32x4*)(L + GW_K + tt * 64 + (qd - 4) * 16) = pr;
            else if (qd < 16) { LAS unsigned short* vp = (LAS unsigned short*)(L + GW_VT + (8 * (qd - 8)) * 80 + tt * 2);
                vp[0 * 40] = (unsigned short)(pr.x & 0xffffu); vp[1 * 40] = (unsigned short)(pr.x >> 16); vp[2 * 40] = (unsigned short)(pr.y & 0xffffu); vp[3 * 40] = (unsigned short)(pr.y >> 16);
                vp[4 * 40] = (unsigned short)(pr.z & 0xffffu); vp[5 * 40] = (unsigned short)(pr.z >> 16); vp[6 * 40] = (unsigned short)(pr.w & 0xffffu); vp[7 * 40] = (unsigned short)(pr.w >> 16); }
            else { float f[8]; unpack8(pr, f); LAS f32x4* dst = (LAS f32x4*)(L + GW_GD + tt * 64 + (qd - 16) * 32); dst[0] = (f32x4){f[0], f[1], f[2], f[3]}; dst[1] = (f32x4){f[4], f[5], f[6], f[7]}; } }
        WAVE_LDS_SYNC();
        float pre[16]; float run = 0.f;
#pragma unroll
        for (int i = 0; i < 16; ++i) { const int t = 16 * half + i; const LAS f32x4* gd = (const LAS f32x4*)(L + GW_GD + t * 64); float x = gbk;
#pragma unroll
            for (int j4 = 0; j4 < 4; ++j4) { const f32x4 gv = gd[j4]; x += gv[0] * g2c[4 * j4] + gv[1] * g2c[4 * j4 + 1] + gv[2] * g2c[4 * j4 + 2] + gv[3] * g2c[4 * j4 + 3]; }
            run += -softplusf_(-x) * (1.0f / 16.0f); pre[i] = run; }
        const float oth = __shfl_xor(run, 32); const float bofs = half ? oth : 0.f, ctot = run + oth;
        asm volatile("" : "+v"(pn[0]), "+v"(pn[1]), "+v"(pn[2]), "+v"(pn[3]), "+v"(pn[4]), "+v"(pn[5]), "+v"(pn[6]), "+v"(pn[7]), "+v"(pn[8]));
#pragma unroll
        for (int i = 0; i < 16; ++i) { const int t = 16 * half + i; const float bt = pre[i] + bofs;
            const float q = bf1(*(const LAS unsigned short*)(L + GW_Q + t * 64 + kk * 2)), k = bf1(*(const LAS unsigned short*)(L + GW_K + t * 64 + kk * 2));
            *(LAS unsigned short*)(L + GW_Q + t * 64 + kk * 2) = (unsigned short)f2bf(q * 0.17677669529663687f * __expf(bt));
            *(LAS unsigned short*)(L + GW_K + t * 64 + kk * 2) = (unsigned short)f2bf(k * __expf(-bt));
            *(LAS unsigned short*)(L + GW_KHT + kk * 80 + t * 2) = (unsigned short)f2bf(k * __expf(ctot - bt)); }
        if (half == 0) ecg[item * 32 + kk] = __expf(ctot);
        WAVE_LDS_SYNC();
#pragma unroll
        for (int i = 0; i < 2; ++i) { const int pz = lane + 64 * i;
            *(u32x4*)(ax.qt + item * 2048 + 16 * pz) = *(const LAS u32x4*)(L + GW_Q + 16 * pz); *(u32x4*)(ax.kb + item * 2048 + 16 * pz) = *(const LAS u32x4*)(L + GW_K + 16 * pz); }
#pragma unroll
        for (int kb = 0; kb < 2; ++kb) { const bf16x8 a = ldfrag(L + GW_KHT, 80, 16 * kb, 0, fr, g);
#pragma unroll
            for (int vb = 0; vb < 4; ++vb) { f32x4 d = (f32x4){0.f, 0.f, 0.f, 0.f}; d = MFMA16(a, ldfrag(L + GW_VT, 80, 16 * vb, 0, fr, g), d);
                u32x2 so; so.x = pk2(d[0], d[1]); so.y = pk2(d[2], d[3]); *(u32x2*)(con + item * 4096 + (16 * vb + fr) * 64 + (16 * kb + 4 * g) * 2) = so; } }
        WAVE_LDS_SYNC();
#pragma unroll
        for (int i = 0; i < 9; ++i) pc[i] = pn[i];
    }
}
__device__ __forceinline__ void gla_scan(Frame& F, unsigned char* con, const float* ecg, int b, int h) {
    const int tid = mytid(F); const int k4 = (tid & 7) * 4;
    unsigned char* base = con + (size_t)((b * 4 + h) * (SEQ / 32)) * 4096 + 8 * tid; const float* eb = ecg + (size_t)((b * 4 + h) * (SEQ / 32)) * 32 + k4;
    float s[4] = {0.f, 0.f, 0.f, 0.f};
    constexpr int NC = SEQ / 32;
    u32x2 cn[8]; f32x4 ec[8];
#pragma unroll
    for (int j = 0; j < 8; ++j) { cn[j] = *(const u32x2*)(base + (size_t)j * 4096); ec[j] = *(const f32x4*)(eb + j * 32); }
#pragma unroll 1
    for (int c0 = 0; c0 < NC; c0 += 8) {
        u32x2 cc[8]; f32x4 ee[8];
#pragma unroll
        for (int j = 0; j < 8; ++j) { cc[j] = cn[j]; ee[j] = ec[j]; }
#pragma unroll
        for (int j = 0; j < 8; ++j) { const int cx = c0 + 8 + j < NC ? c0 + 8 + j : NC - 1; cn[j] = *(const u32x2*)(base + (size_t)cx * 4096); ec[j] = *(const f32x4*)(eb + cx * 32); }
#pragma unroll
        for (int j = 0; j < 8; ++j) { u32x2 o; o.x = pk2(s[0], s[1]); o.y = pk2(s[2], s[3]); *(u32x2*)(base + (size_t)(c0 + j) * 4096) = o;
            s[0] = ee[j][0] * s[0] + bflo(cc[j].x); s[1] = ee[j][1] * s[1] + bfhi(cc[j].x); s[2] = ee[j][2] * s[2] + bflo(cc[j].y); s[3] = ee[j][3] * s[3] + bfhi(cc[j].y); } }
}

struct RwkvP { const float *mu, *w0, *w2, *a0, *a2, *g2, *kk, *ka, *rk, *lg, *lb; };
constexpr int RC_AT = 0  , RC_RT = 2048  , RC_ZT = 4096, RC_RBK = 5120, RC_BKT = 6144  , RC_VT4 = 10240  ,
              RC_GC = 12288  , RC_G = 12544  , RC_BON = 14592  , RC_BYTES = 14656, RC_STRIDE = 14848;
constexpr int RC_CHUNKS16 = RC_BYTES / 16;
static_assert((size_t)NB * 4 * (SEQ / 16) * RC_STRIDE <= NEXP * MOEW_E_BYTES, "RWKV records overlay the (not yet converted) MoE weight region");
constexpr int RW_W2T = 0, RW_A2T = 5120, RW_G2T = 10240, RW_MU = 19456  , RW_TW = 23040, RW_AD = 24320, RW_SG = 25600, RW_R = 27904  , RW_K = 32256  , RW_V = 36608  , RW_WL = 40704  , RW_AL = 45056  ,
              RW_G = 49408  , RW_SS = 53504  , RW_BONP = 53568  , RW_BON = 60672, RW_GC = 60736, RW_AR = 60992, RW_BK = 65600, RW_BKT = 70208, RW_ZAK = 75328, RW_RBK = 76608, RW_AAB = 77888, RW_TT = 78912  , RW_PAR = 80192  , RW_END = 81472;

__device__ __forceinline__ void rwkv_prep_init(Frame& F, const RwkvP P, int h) {
    const int tid = mytid(F); LAS unsigned char* L = F.lds;
    float lw2[4], la2[4], lg2[8], lmu[2], lpar = 0.f;
#pragma unroll
    for (int q = 0; q < 4; ++q) { const int i = tid + NTHREADS * q, c = i >> 5, j = i & 31; lw2[q] = P.w2[j * 256 + h * 64 + c]; la2[q] = P.a2[j * 256 + h * 64 + c]; }
#pragma unroll
    for (int q = 0; q < 8; ++q) { const int i = tid + NTHREADS * q, c = i >> 6, j = i & 63; lg2[q] = P.g2[j * 256 + h * 64 + c]; }
#pragma unroll
    for (int q = 0; q < 2; ++q) { const int i = tid + NTHREADS * q; lmu[q] = i < 896 ? P.mu[i] : 0.f; }
    if (tid < 320) { const int q = tid >> 6, c = tid & 63; const float* src = q == 0 ? P.w0 : q == 1 ? P.a0 : q == 2 ? P.kk : q == 3 ? P.ka : P.rk; lpar = src[h * 64 + c]; }
    asm volatile("" : "+v"(lw2[0]), "+v"(lw2[1]), "+v"(lw2[2]), "+v"(lw2[3]), "+v"(la2[0]), "+v"(la2[1]), "+v"(la2[2]), "+v"(la2[3]), "+v"(lmu[0]), "+v"(lmu[1]), "+v"(lpar));
    asm volatile("" : "+v"(lg2[0]), "+v"(lg2[1]), "+v"(lg2[2]), "+v"(lg2[3]), "+v"(lg2[4]), "+v"(lg2[5]), "+v"(lg2[6]), "+v"(lg2[7]));
#pragma unroll
    for (int q = 0; q < 4; ++q) { const int i = tid + NTHREADS * q, c = i >> 5, j = i & 31;
        *(LAS unsigned short*)(L + RW_W2T + c * 80 + j * 2) = (unsigned short)f2bf(lw2[q]); *(LAS unsigned short*)(L + RW_A2T + c * 80 + j * 2) = (unsigned short)f2bf(la2[q]); }
#pragma unroll
    for (int q = 0; q < 8; ++q) { const int i = tid + NTHREADS * q, c = i >> 6, j = i & 63; *(LAS unsigned short*)(L + RW_G2T + c * 144 + j * 2) = (unsigned short)f2bf(lg2[q]); }
#pragma unroll
    for (int q = 0; q < 2; ++q) { const int i = tid + NTHREADS * q; if (i < 896) ((LAS float*)(L + RW_MU))[i] = lmu[q]; }
    if (tid < 320) ((LAS float*)(L + RW_PAR))[tid] = lpar;
}
__device__ __forceinline__ void rwkv_prep_load(const bf16* Z, int b, int h, int ch, int w, int lane, u32x4 (&cur)[2], u32x4 (&prv)[2]) {
    const int kind = w & 3, p = (w >> 2) * 64 + lane, tt = p >> 3, j = p & 7;
    const int col = (kind < 3 ? ZC + kind * 256 + h * 64 : ZC + 832) + 8 * j;
    const int t = ch * 16 + tt; const bf16* zr = Z + ((size_t)b * SEQ + t) * INW + col;
    cur[0] = *(const u32x4*)zr; prv[0] = (t > 0) ? *(const u32x4*)(zr - INW) : (u32x4){0u, 0u, 0u, 0u};
    if (w < 2) { const int t2 = ch * 16 + (lane >> 2); const bf16* z2 = Z + ((size_t)b * SEQ + t2) * INW + ZC + 768 + w * 32 + 8 * (lane & 3);
        cur[1] = *(const u32x4*)z2; prv[1] = (t2 > 0) ? *(const u32x4*)(z2 - INW) : (u32x4){0u, 0u, 0u, 0u}; }
    else { cur[1] = (u32x4){0u, 0u, 0u, 0u}; prv[1] = cur[1]; }
}
__device__ __forceinline__ void rwkv_prep_item(Frame& F, unsigned char* rec, const RwkvP P, int h, const u32x4 (&cur)[2], const u32x4 (&prv)[2], u32x4 (&ncur)[2], u32x4 (&nprv)[2]) {
    const int tid = mytid(F), lane = tid & 63, w = __builtin_amdgcn_readfirstlane(tid >> 6), fr = lane & 15, g = lane >> 4;
    LAS unsigned char* L = F.lds;
#if defined(PROBE_PI)
    unsigned long long tl_ = __builtin_amdgcn_s_memrealtime(), ta_ = 0;
#define PIT(k) do { const unsigned long long tn_ = __builtin_amdgcn_s_memrealtime(); if ((k) == PROBE_PI) ta_ += tn_ - tl_; tl_ = tn_; } while (0)
#else
#define PIT(k) do { } while (0)
#endif
    LAS float *R = (LAS float*)(L + RW_R), *KR = (LAS float*)(L + RW_K), *V = (LAS float*)(L + RW_V), *WL = (LAS float*)(L + RW_WL), *AL = (LAS float*)(L + RW_AL), *G = (LAS float*)(L + RW_G),
              *SS = (LAS float*)(L + RW_SS), *BONP = (LAS float*)(L + RW_BONP), *GC = (LAS float*)(L + RW_GC), *AAB = (LAS float*)(L + RW_AAB), *MU = (LAS float*)(L + RW_MU);
    { const int kind = w & 3, p = (w >> 2) * 64 + lane, tt = p >> 3, j = p & 7; float fc[8], fp[8], x[8]; unpack8(cur[0], fc); unpack8(prv[0], fp);
        const LAS float* mu = MU + (kind < 3 ? kind * 256 + h * 64 : 832) + 8 * j;
#pragma unroll
        for (int e = 0; e < 8; ++e) x[e] = fc[e] + (fp[e] - fc[e]) * mu[e];
        if (kind < 3) { LAS f32x4* d = (LAS f32x4*)((kind == 0 ? R : kind == 1 ? KR : V) + tt * (kind == 2 ? 64 : 68) + 8 * j); d[0] = (f32x4){x[0], x[1], x[2], x[3]}; d[1] = (f32x4){x[4], x[5], x[6], x[7]};
            if (kind == 1) { const LAS float* kkp = (const LAS float*)(L + RW_PAR) + 128 + 8 * j; float ss = 0.f;
#pragma unroll
                for (int e = 0; e < 8; ++e) { const float kv = x[e] * kkp[e]; ss += kv * kv; }
                ss = red8(ss); if (j == 0) SS[tt] = ss; } }
        else {
#pragma unroll
            for (int e = 0; e < 8; ++e) x[e] = __builtin_amdgcn_rcpf(1.0f + __expf(-x[e]));
            u32x4 o; o.x = pk2(x[0], x[1]); o.y = pk2(x[2], x[3]); o.z = pk2(x[4], x[5]); o.w = pk2(x[6], x[7]); *(LAS u32x4*)(L + RW_SG + tt * 144 + 16 * j) = o; }
        if (w < 2) { const int t2 = lane >> 2, j2 = lane & 3; unpack8(cur[1], fc); unpack8(prv[1], fp); const LAS float* mu2 = MU + 768 + w * 32 + 8 * j2;
#pragma unroll
            for (int e = 0; e < 8; ++e) { x[e] = fc[e] + (fp[e] - fc[e]) * mu2[e]; if (w == 0) x[e] = 2.0f * __builtin_amdgcn_rcpf(1.0f + __expf(-2.0f * x[e])) - 1.0f; }
            u32x4 o; o.x = pk2(x[0], x[1]); o.y = pk2(x[2], x[3]); o.z = pk2(x[4], x[5]); o.w = pk2(x[6], x[7]); *(LAS u32x4*)(L + (w == 0 ? RW_TW : RW_AD) + t2 * 80 + 16 * j2) = o; } }
    BAR(); PIT(0);
    if (w < 4) { f32x4 dw = (f32x4){0.f, 0.f, 0.f, 0.f}, da = dw;
        dw = MFMA16(ldfrag(L + RW_W2T, 80, 16 * w, 0, fr, g), ldfrag(L + RW_TW, 80, 0, 0, fr, g), dw);
        da = MFMA16(ldfrag(L + RW_A2T, 80, 16 * w, 0, fr, g), ldfrag(L + RW_AD, 80, 0, 0, fr, g), da);
        *(LAS f32x4*)(WL + fr * 68 + 16 * w + 4 * g) = dw; *(LAS f32x4*)(AL + fr * 68 + 16 * w + 4 * g) = da; }
    else { const int cb = w - 4; f32x4 dg = (f32x4){0.f, 0.f, 0.f, 0.f};
        dg = MFMA16(ldfrag(L + RW_G2T, 144, 16 * cb, 0, fr, g), ldfrag(L + RW_SG, 144, 0, 0, fr, g), dg);
        dg = MFMA16(ldfrag(L + RW_G2T, 144, 16 * cb, 64, fr, g), ldfrag(L + RW_SG, 144, 0, 64, fr, g), dg);
        *(LAS f32x4*)(G + fr * 64 + 16 * cb + 4 * g) = dg; }
    BAR(); PIT(1);
    { const int cp = tid >> 4, t = tid & 15, c2 = 2 * cp; const LAS float* PAR = (const LAS float*)(L + RW_PAR) + c2;
        const f32x2 wl = *(const LAS f32x2*)(WL + t * 68 + c2) + *(const LAS f32x2*)(PAR), al = *(const LAS f32x2*)(AL + t * 68 + c2) + *(const LAS f32x2*)(PAR + 64);
        const f32x2 kr = *(const LAS f32x2*)(KR + t * 68 + c2), rr = *(const LAS f32x2*)(R + t * 68 + c2);
        const f32x2 kkw = *(const LAS f32x2*)(PAR + 128), kaw = *(const LAS f32x2*)(PAR + 192), rkw = *(const LAS f32x2*)(PAR + 256);
        const float inv = 1.0f / fmaxf(sqrtf(SS[t]), 1e-12f);
        float lw[2], a[2], kk[2], kp[2], cs[2], tot[2]; float bon = 0.f;
#pragma unroll
        for (int e = 0; e < 2; ++e) { const float wlog = -softplusf_(-wl[e]) - 0.5f; lw[e] = -__expf(wlog); a[e] = __builtin_amdgcn_rcpf(1.0f + __expf(-al[e])); kk[e] = kr[e] * kkw[e] * inv;
            kp[e] = kr[e] * (1.0f + (a[e] - 1.0f) * kaw[e]); bon += rr[e] * kp[e] * rkw[e];
            float x = lw[e];
            x += __builtin_bit_cast(float, __builtin_amdgcn_update_dpp(0, __builtin_bit_cast(int, x), 0x111, 0xf, 0xf, true));
            x += __builtin_bit_cast(float, __builtin_amdgcn_update_dpp(0, __builtin_bit_cast(int, x), 0x112, 0xf, 0xf, true));
            x += __builtin_bit_cast(float, __builtin_amdgcn_update_dpp(0, __builtin_bit_cast(int, x), 0x114, 0xf, 0xf, true));
            x += __builtin_bit_cast(float, __builtin_amdgcn_update_dpp(0, __builtin_bit_cast(int, x), 0x118, 0xf, 0xf, true));
            cs[e] = x; tot[e] = __shfl(x, lane | 15); }
        bon += __shfl_xor(bon, 16); bon += __shfl_xor(bon, 32); if (lane < 16) BONP[t * 8 + w] = bon;
        float at[2], rt[2], bb[2], kb[2], bh[2], kh[2];
#pragma unroll
        for (int e = 0; e < 2; ++e) { const float eP = __expf(cs[e] - lw[e]), eT = __expf(cs[e]), eI = __expf(-cs[e]), eC = __expf(tot[e] - cs[e]); const float bv = kk[e] * a[e];
            at[e] = -kk[e] * eP; rt[e] = rr[e] * eT; bb[e] = bv * eI; kb[e] = kp[e] * eI; bh[e] = bv * eC; kh[e] = kp[e] * eC; }
        *(LAS unsigned*)(L + RW_AR + t * 144 + c2 * 2) = pk2(at[0], at[1]); *(LAS unsigned*)(L + RW_AR + (16 + t) * 144 + c2 * 2) = pk2(rt[0], rt[1]);
        *(LAS unsigned*)(L + RW_BK + t * 144 + c2 * 2) = pk2(bb[0], bb[1]); *(LAS unsigned*)(L + RW_BK + (16 + t) * 144 + c2 * 2) = pk2(kb[0], kb[1]);
#pragma unroll
        for (int e = 0; e < 2; ++e) { *(LAS unsigned short*)(L + RW_BKT + (c2 + e) * 80 + t * 2) = (unsigned short)f2bf(bh[e]); *(LAS unsigned short*)(L + RW_BKT + (c2 + e) * 80 + (16 + t) * 2) = (unsigned short)f2bf(kh[e]); }
        if (t == 15) { GC[c2] = __expf(cs[0]); GC[c2 + 1] = __expf(cs[1]); } }
    BAR(); PIT(2);
    PIT(3);
    if (w < 4) { const int arow = (w & 1) ? 16 : 0  , brow = (w & 2) ? 16 : 0  ;
        f32x4 d = (f32x4){0.f, 0.f, 0.f, 0.f};
        d = MFMA16(ldfrag(L + RW_BK, 144, arow, 0, fr, g), ldfrag(L + RW_AR, 144, brow, 0, fr, g), d);
        d = MFMA16(ldfrag(L + RW_BK, 144, arow, 64, fr, g), ldfrag(L + RW_AR, 144, brow, 64, fr, g), d);
        const int t = fr; float v[4];
#pragma unroll
        for (int r = 0; r < 4; ++r) { const int s = 4 * g + r; const bool keep = (w < 2) ? (s < t) : (s <= t); v[r] = keep ? d[r] : 0.f; }
        if (w == 0) { AAB[(4 * g + 0) * 16 + t] = v[0]; AAB[(4 * g + 1) * 16 + t] = v[1]; AAB[(4 * g + 2) * 16 + t] = v[2]; AAB[(4 * g + 3) * 16 + t] = v[3]; }
        else { u32x2 o; o.x = pk2(v[0], v[1]); o.y = pk2(v[2], v[3]);
            LAS unsigned char* dst = (w == 1) ? (L + RW_ZAK + t * 80 + (16 + 4 * g) * 2) : (w == 2) ? (L + RW_RBK + t * 80 + (4 * g) * 2) : (L + RW_RBK + t * 80 + (16 + 4 * g) * 2);
            *(LAS u32x2*)dst = o; } }
    BAR(); PIT(4);
    asm volatile("" : "+v"(ncur[0]), "+v"(ncur[1]), "+v"(nprv[0]), "+v"(nprv[1]));
    if (w == 7) { if (lane < 16) { float col[16];
#pragma unroll
            for (int t = 0; t < 16; ++t) col[t] = (t == lane) ? 1.0f : 0.f;
            f32x4 ar[15][4];
#pragma unroll
            for (int s = 0; s < 15; ++s)
#pragma unroll
                for (int c = 0; c < 4; ++c) if (4 * c + 3 > s) ar[s][c] = *(const LAS f32x4*)(AAB + s * 16 + 4 * c);
#pragma unroll
            for (int s = 0; s < 15; ++s)
#pragma unroll
                for (int t = s + 1; t < 16; ++t) col[t] += ar[s][t >> 2][t & 3] * col[s];
#pragma unroll
            for (int t = 0; t < 16; ++t) *(LAS unsigned short*)(L + RW_TT + t * 80 + lane * 2) = (unsigned short)f2bf(col[t]); }
        LDS_WAIT();
        { const u32x2 lo = *(const LAS u32x2*)(L + RW_TT + fr * 80 + 8 * g), hi = *(const LAS u32x2*)(L + RW_ZAK + fr * 80 + 32 + 8 * g); u32x4 o; o.x = lo.x; o.y = lo.y; o.z = hi.x; o.w = hi.y;
            *(u32x4*)(rec + RC_ZT + fr * 64 + 16 * g) = o; } }
    else {
#pragma unroll
        for (int jj = 0; jj < 3; ++jj) { const int job = w + 7 * jj; if (job >= 16) break;
            if (job < 9) { int src, stride, row0, ka, kb2, dst;
                if (job < 4) { src = RW_AR; stride = 144; row0 = (job >> 1) * 16; ka = 32 * (job & 1); kb2 = ka + 16; dst = (job >> 1 ? RC_RT : RC_AT) + (job & 1) * 1024; }
                else if (job == 4) { src = RW_RBK; stride = 80; row0 = 0; ka = 0; kb2 = 16; dst = RC_RBK; }
                else { src = RW_BKT; stride = 80; row0 = 16 * (job - 5); ka = 0; kb2 = 16; dst = RC_BKT + (job - 5) * 1024; }
                const LAS unsigned char* rp = L + src + (row0 + fr) * stride + 8 * g; const u32x2 lo = *(const LAS u32x2*)(rp + ka * 2), hi = *(const LAS u32x2*)(rp + kb2 * 2);
                u32x4 o; o.x = lo.x; o.y = lo.y; o.z = hi.x; o.w = hi.y; *(u32x4*)(rec + dst + fr * 64 + 16 * g) = o; }
            else if (job < 13) { const int vb = job - 9; const LAS float* vp = V + (4 * g) * 64 + 16 * vb + fr; u32x2 o; o.x = pk2(vp[0], vp[64]); o.y = pk2(vp[128], vp[192]); *(u32x2*)(rec + RC_VT4 + vb * 512 + lane * 8) = o; }
            else { const int p = (job - 13) * 64 + lane;
                if (p < 16) *(f32x4*)(rec + RC_GC + 16 * p) = *(const LAS f32x4*)(GC + 4 * p);
                else if (p < 144) { const int q = p - 16; const f32x4 a = *(const LAS f32x4*)(G + q * 8), c = *(const LAS f32x4*)(G + q * 8 + 4); u32x4 o; o.x = pk2(a[0], a[1]); o.y = pk2(a[2], a[3]); o.z = pk2(c[0], c[1]); o.w = pk2(c[2], c[3]); *(u32x4*)(rec + RC_G + 16 * q) = o; }
                else if (p < 160) { const int t = p - 144; float bsum = 0.f;
#pragma unroll
                    for (int ww = 0; ww < 8; ++ww) bsum += BONP[t * 8 + ww];
                    ((float*)(rec + RC_BON))[t] = bsum; } } } }
    BAR(); PIT(5);
#if defined(PROBE_PI)
    if (blockIdx.x == 0 && threadIdx.x == 0) ((unsigned long long*)(F.ws + 32768))[0] += ta_;
#endif
}

constexpr int SB_STRIDE = 16384, SB_NBUF = 7, SB_AHEAD = 5, ST_OB = SB_NBUF * SB_STRIDE  , ST_END = ST_OB + 8192;
static_assert(ST_END <= RING_BYTES && RC_BYTES <= SB_STRIDE, "state pass LDS");
__device__ __forceinline__ void rwkv_state(Frame& F, const unsigned char* recs, bf16* Y, const RwkvP P, int b, int h) {
    const int tid = mytid(F), lane = tid & 63, w = __builtin_amdgcn_readfirstlane(tid >> 6), fr = lane & 15, g = lane >> 4;
    LAS unsigned char* L = F.lds;
    const unsigned char* rbase = recs + (size_t)(b * 4 + h) * (SEQ / 16) * RC_STRIDE;
    const int lt = tid - 256;
    const f32x4 plg = *(const f32x4*)(P.lg + h * 64 + (tid & 15) * 4), plb = *(const f32x4*)(P.lb + h * 64 + (tid & 15) * 4);
    asm volatile("s_waitcnt vmcnt(0)" ::: "memory");
    f32x4 accS[4];
#pragma unroll
    for (int i = 0; i < 4; ++i) accS[i] = (f32x4){0.f, 0.f, 0.f, 0.f};
    constexpr int NCH = SEQ / 16;
#define RW_ISSUE(r) do { const unsigned char* gp_ = rbase + (size_t)(r) * RC_STRIDE + (w * 256 + lane) * 16; LAS unsigned char* lp_ = L + ((r) % SB_NBUF) * SB_STRIDE + w * 4096; \
        _Pragma("unroll") for (int i_ = 0; i_ < 4; ++i_) __builtin_amdgcn_global_load_lds((const unsigned*)(gp_ + i_ * 1024), (LAS unsigned*)(lp_ + i_ * 1024), 16, 0, 0); } while (0)
    if (w < 4) {
#pragma unroll 1
        for (int r = 0; r < SB_AHEAD; ++r) RW_ISSUE(r);
        asm volatile("s_waitcnt vmcnt(16)" ::: "memory"); }
    BAR();
#pragma unroll 1
    for (int c = 0; c <= NCH; ++c) {
        if (w >= 4) {
            if (c >= 1) { const int ce = c - 1; const LAS unsigned char* B = L + (ce % SB_NBUF) * SB_STRIDE; const LAS float* OB = (const LAS float*)(L + ST_OB + (ce & 1) * 4096);
                const int tt = lt >> 4, c4 = (lt & 15) * 4; const f32x4 o = *(const LAS f32x4*)(OB + tt * 64 + c4);
                float s = (o[0] + o[1]) + (o[2] + o[3]); s = red16(s); const float mean = s * (1.0f / 64.0f); const f32x4 d = o - mean;
                float ss = (d[0] * d[0] + d[1] * d[1]) + (d[2] * d[2] + d[3] * d[3]); ss = red16(ss); const float rstd = __builtin_amdgcn_rsqf(ss * (1.0f / 64.0f) + 64e-5f);
                const u32x2 gw = *(const LAS u32x2*)(B + RC_G + tt * 128 + c4 * 2); const float bon = ((const LAS float*)(B + RC_BON))[tt];
                const LAS unsigned short* vq = (const LAS unsigned short*)(B + RC_VT4 + (c4 >> 4) * 512 + ((tt >> 2) * 16 + (c4 & 15)) * 8 + (tt & 3) * 2);
                const float vv[4] = {bf1(vq[0]), bf1(vq[4]), bf1(vq[8]), bf1(vq[12])}, gg[4] = {bflo(gw.x), bfhi(gw.x), bflo(gw.y), bfhi(gw.y)}; float y[4];
#pragma unroll
                for (int e = 0; e < 4; ++e) y[e] = (d[e] * rstd * plg[e] + plb[e] + bon * vv[e]) * gg[e];
                u32x2 wv; wv.x = pk2(y[0], y[1]); wv.y = pk2(y[2], y[3]); *(u32x2*)(Y + ((size_t)b * SEQ + ce * 16 + tt) * DM + 512 + h * 64 + c4) = wv; }
        } else {
            if (c + SB_AHEAD < NCH) RW_ISSUE(c + SB_AHEAD);
            if (c < NCH) { const int vb = w; const LAS unsigned char* B = L + (c % SB_NBUF) * SB_STRIDE; LAS float* OB = (LAS float*)(L + ST_OB + (c & 1) * 4096); const int fo = fr * 64 + 16 * g;
                const bf16x8 at0 = *(const LAS bf16x8*)(B + RC_AT + fo), at1 = *(const LAS bf16x8*)(B + RC_AT + 1024 + fo), rt0 = *(const LAS bf16x8*)(B + RC_RT + fo), rt1 = *(const LAS bf16x8*)(B + RC_RT + 1024 + fo);
                const bf16x8 zt = *(const LAS bf16x8*)(B + RC_ZT + fo), rbk = *(const LAS bf16x8*)(B + RC_RBK + fo); const u32x2 v4 = *(const LAS u32x2*)(B + RC_VT4 + vb * 512 + lane * 8);
                f32x4 gcv[4]; bf16x8 bkt[4];
#pragma unroll
                for (int kb = 0; kb < 4; ++kb) { gcv[kb] = *(const LAS f32x4*)(B + RC_GC + (16 * kb + 4 * g) * 4); bkt[kb] = *(const LAS bf16x8*)(B + RC_BKT + kb * 1024 + fo); }
                u32x4 sw0, sw1; sw0.x = pk2(accS[0][0], accS[0][1]); sw0.y = pk2(accS[0][2], accS[0][3]); sw0.z = pk2(accS[1][0], accS[1][1]); sw0.w = pk2(accS[1][2], accS[1][3]);
                sw1.x = pk2(accS[2][0], accS[2][1]); sw1.y = pk2(accS[2][2], accS[2][3]); sw1.z = pk2(accS[3][0], accS[3][1]); sw1.w = pk2(accS[3][2], accS[3][3]);
                const bf16x8 s0 = __builtin_bit_cast(bf16x8, sw0), s1 = __builtin_bit_cast(bf16x8, sw1);
                f32x4 y = (f32x4){0.f, 0.f, 0.f, 0.f}, accO = y;
                y = MFMA16(at0, s0, y); y = MFMA16(at1, s1, y); accO = MFMA16(rt0, s0, accO); accO = MFMA16(rt1, s1, accO);
                u32x4 bw; bw.x = 0u; bw.y = 0u; bw.z = v4.x; bw.w = v4.y; y = MFMA16(zt, __builtin_bit_cast(bf16x8, bw), y);
                bw.x = pk2(y[0], y[1]); bw.y = pk2(y[2], y[3]); bw.z = 0u; bw.w = 0u; f32x4 u = (f32x4){0.f, 0.f, 0.f, 0.f}; u = MFMA16(zt, __builtin_bit_cast(bf16x8, bw), u);
                bw.x = pk2(u[0], u[1]); bw.y = pk2(u[2], u[3]); bw.z = v4.x; bw.w = v4.y; const bf16x8 uv = __builtin_bit_cast(bf16x8, bw);
                accO = MFMA16(rbk, uv, accO);
#pragma unroll
                for (int r = 0; r < 4; ++r) OB[(4 * g + r) * 64 + 16 * vb + fr] = accO[r];
#pragma unroll
                for (int kb = 0; kb < 4; ++kb) { accS[kb] = accS[kb] * gcv[kb]; accS[kb] = MFMA16(bkt[kb], uv, accS[kb]); } }
            if (c + SB_AHEAD < NCH) asm volatile("s_waitcnt vmcnt(16)" ::: "memory"); else asm volatile("s_waitcnt vmcnt(0)" ::: "memory");
        }
        BAR();
    }
#undef RW_ISSUE
}

__device__ __forceinline__ void moe_route(Frame& F, const bf16* hres, const float* gffn, const float* router) {
    const int tid = mytid(F), lane = tid & 63, wave = __builtin_amdgcn_readfirstlane(tid >> 6); (void)lane; (void)wave;
    unsigned char* rt = F.ws + WS_RT;
    int* tope = (int*)(rt + RT_TOPE); float* gate = (float*)(rt + RT_GATE); int* rank = (int*)(rt + RT_RANK); float* rstd = (float*)(rt + RT_RSTD); int* hist = (int*)(rt + RT_HIST); int* rowtok = (int*)(rt + RT_ROWTOK);
    LAS float* RW = (LAS float*)F.lds;
    LAS int* LH = (LAS int*)(F.lds + 32768);
    { f32x4 rw4[4];
#pragma unroll
        for (int q = 0; q < 4; ++q) rw4[q] = *((const f32x4*)router + tid + NTHREADS * q);
        asm volatile("" : "+v"(rw4[0]), "+v"(rw4[1]), "+v"(rw4[2]), "+v"(rw4[3]));
#pragma unroll
        for (int q = 0; q < 4; ++q) *((LAS f32x4*)RW + tid + NTHREADS * q) = rw4[q]; }
    if (tid < 16) LH[tid] = 0;
    for (int i = F.blk * NTHREADS + tid; i < 2 * MOE_ROWS; i += F.G * NTHREADS) rowtok[i] = -1;
    __syncthreads();
    const int tpb = NTOK / F.G;
    f32x4 gv[4];
#pragma unroll
    for (int j = 0; j < 4; ++j) gv[j] = *((const f32x4*)gffn + 64 * j + lane);
    u32x2 hw[4][4], hn[4][4];
#define ROUTE_LOAD(dst, i0_) do { _Pragma("unroll") for (int q = 0; q < 4; ++q) { const int iq = (i0_) + q * NWAVES < tpb ? (i0_) + q * NWAVES : wave; const u32x2* hr = (const u32x2*)(hres + (size_t)(F.blk * tpb + iq) * DM) + lane; \
        _Pragma("unroll") for (int j = 0; j < 4; ++j) dst[q][j] = hr[64 * j]; } } while (0)
    ROUTE_LOAD(hw, wave);
#pragma unroll 1
    for (int i0 = wave; i0 < tpb; i0 += 4 * NWAVES) {
        float rs[4], lg[4][8];
        ROUTE_LOAD(hn, i0 + 4 * NWAVES);
#pragma unroll
        for (int q = 0; q < 4; ++q) { float ss = 0.f;
#pragma unroll
            for (int j = 0; j < 4; ++j) { const float a = bflo(hw[q][j].x), b = bfhi(hw[q][j].x), c = bflo(hw[q][j].y), d = bfhi(hw[q][j].y); ss += (a * a + b * b) + (c * c + d * d); }
            rs[q] = ss; }
#pragma unroll
        for (int q = 0; q < 4; ++q) rs[q] = wave_sum(rs[q]);
#pragma unroll
        for (int q = 0; q < 4; ++q) { rs[q] = __builtin_amdgcn_rsqf(rs[q] * (1.0f / DM) + NORM_EPS);
#pragma unroll
            for (int e = 0; e < 8; ++e) lg[q][e] = 0.f; }
#pragma unroll
        for (int j = 0; j < 4; ++j)
#pragma unroll
            for (int c = 0; c < 4; ++c) { const int k = 256 * j + 4 * lane + c; const f32x4 r0 = *(const LAS f32x4*)(RW + k * 8), r1 = *(const LAS f32x4*)(RW + k * 8 + 4);
#pragma unroll
                for (int q = 0; q < 4; ++q) { const unsigned w = (c < 2) ? hw[q][j].x : hw[q][j].y; const float xv = (c & 1) ? bfhi(w) : bflo(w); const float xn = xv * rs[q] * gv[j][c];
                    lg[q][0] += xn * r0[0]; lg[q][1] += xn * r0[1]; lg[q][2] += xn * r0[2]; lg[q][3] += xn * r0[3]; lg[q][4] += xn * r1[0]; lg[q][5] += xn * r1[1]; lg[q][6] += xn * r1[2]; lg[q][7] += xn * r1[3]; } }
#pragma unroll
        for (int q = 0; q < 4; ++q)
#pragma unroll
            for (int e = 0; e < 8; ++e) lg[q][e] = wave_sum(lg[q][e]);
#pragma unroll
        for (int q = 0; q < 4; ++q) asm volatile("" : "+v"(hn[q][0]), "+v"(hn[q][1]), "+v"(hn[q][2]), "+v"(hn[q][3]));
#pragma unroll
        for (int q = 0; q < 4; ++q) { if (i0 + q * NWAVES < tpb) { const int t = F.blk * tpb + i0 + q * NWAVES;
            int i1 = 0; float m1 = lg[q][0];
#pragma unroll
            for (int e = 1; e < 8; ++e) if (lg[q][e] > m1) { m1 = lg[q][e]; i1 = e; }
            int i2 = -1; float m2 = -3.0e38f;
#pragma unroll
            for (int e = 0; e < 8; ++e) if (e != i1 && lg[q][e] > m2) { m2 = lg[q][e]; i2 = e; }
            if (lane == 0) { const float g1 = 1.0f / (1.0f + __expf(m2 - m1));
                const int r1 = atomicAdd((int*)&LH[i1], 1), r2 = atomicAdd((int*)&LH[8 + i2], 1);
                tope[2 * t] = i1; tope[2 * t + 1] = i2; gate[2 * t] = g1; gate[2 * t + 1] = 1.0f - g1; rank[2 * t] = r1; rank[2 * t + 1] = r2; rstd[t] = rs[q]; } } }
#pragma unroll
        for (int q = 0; q < 4; ++q)
#pragma unroll
            for (int j = 0; j < 4; ++j) hw[q][j] = hn[q][j];
    }
#undef ROUTE_LOAD
    __syncthreads();
    if (tid < 16) hist[F.blk * 16 + tid] = LH[tid];
}
__device__ __forceinline__ void moe_gather(Frame& F, int slot, const bf16* hb, bf16* asort) {
    const int tid = mytid(F), lane = tid & 63, wave = __builtin_amdgcn_readfirstlane(tid >> 6); (void)lane; (void)wave;
    unsigned char* rt = F.ws + WS_RT;
    const int* tope = (const int*)(rt + RT_TOPE); const float* gate = (const float*)(rt + RT_GATE); const int* rank = (const int*)(rt + RT_RANK); const float* rstd = (const float*)(rt + RT_RSTD); const int* hist = (const int*)(rt + RT_HIST);
    int* rowtok = (int*)(rt + RT_ROWTOK) + slot * MOE_ROWS; float* rowgate = (float*)(rt + RT_ROWGATE) + slot * MOE_ROWS; float* rowrstd = (float*)(rt + RT_ROWRSTD) + slot * MOE_ROWS;
    int* tilee = (int*)(rt + RT_TILEE) + slot * 256; int* ntiles = (int*)(rt + RT_NTILES);
    LAS int* BASE = (LAS int*)(F.lds + 40960);
    LAS int* TOT = BASE + 8;
    __syncthreads();
    LAS int* HL = (LAS int*)(F.lds + 49152);
    for (int i = tid; i < F.G * 8; i += NTHREADS) HL[i] = hist[(i >> 3) * 16 + slot * 8 + (i & 7)];
    __syncthreads();
    { const int e = tid & 7, part = tid >> 3;
        const int per = (F.G + 63) / 64; int sb = 0, st = 0;
        for (int j = 0; j < per; ++j) { const int bb = part * per + j; if (bb < F.G) { const int c = HL[bb * 8 + e]; st += c; if (bb < F.blk) sb += c; } }
        LAS int* PB = (LAS int*)(F.lds + 49152 + 16384); PB[tid] = sb; PB[512 + tid] = st; }
    __syncthreads();
    if (tid < 8) { const LAS int* PB = (const LAS int*)(F.lds + 49152 + 16384); int before = 0, tot = 0;
        for (int p = 0; p < 64; ++p) { before += PB[p * 8 + tid]; tot += PB[512 + p * 8 + tid]; }
        BASE[tid] = before; TOT[tid] = tot; }
    __syncthreads();
    if (tid == 0) { int ps = 0, nt = 0;
        for (int e = 0; e < 8; ++e) { const int tl = (TOT[e] + 255) >> 8; BASE[e] += ps; if (F.blk == 0) for (int i = 0; i < tl; ++i) tilee[nt + i] = e; ps += tl * 256; nt += tl; }
        if (F.blk == 0) ntiles[slot] = nt; }
    __syncthreads();
    const int tpb = NTOK / F.G;
    for (int i = tid; i < tpb; i += NTHREADS) { const int t = F.blk * tpb + i; const int e = tope[2 * t + slot]; const int dest = BASE[e] + rank[2 * t + slot];
        rowtok[dest] = t; rowgate[dest] = gate[2 * t + slot]; rowrstd[dest] = rstd[t];
        (void)hb; (void)asort; }
}


__device__ __forceinline__ void mk_publish(unsigned* ctr) {
    asm volatile("s_waitcnt vmcnt(0)" ::: "memory");
    __syncthreads();
    if (threadIdx.x == 0) { __builtin_amdgcn_fence(__ATOMIC_RELEASE, "agent"); asm volatile("s_waitcnt vmcnt(0)" ::: "memory"); (void)__hip_atomic_fetch_add(ctr, 1u, __ATOMIC_RELAXED, __HIP_MEMORY_SCOPE_AGENT); }
}
__device__ __forceinline__ void mk_wait(unsigned* ctr, unsigned need) {
    if (threadIdx.x == 0) { unsigned sp = 0;
        while (__hip_atomic_load(ctr, __ATOMIC_RELAXED, __HIP_MEMORY_SCOPE_AGENT) < need) { __builtin_amdgcn_s_sleep(4); if (++sp > (1u << 24)) break; }
        __builtin_amdgcn_fence(__ATOMIC_ACQUIRE, "agent"); asm volatile("s_waitcnt vmcnt(0)" ::: "memory"); }
    __syncthreads();
}

#ifndef MK_PER_PHASE
#define MK_PER_PHASE 0
#endif
constexpr int N_PHASES = 17;
constexpr size_t ACT_TILE_B = (size_t)256 * DFF * 2;
#ifndef MOE_SWAP
#define MOE_SWAP 0
#endif
#ifndef MOE_REV
#define MOE_REV 0
#endif
#ifndef MOE_R0
#define MOE_R0 3
#endif
struct MoePlan { int nt0, nt1, k0, ns1, n_a, nb13, nb14, nb15; long d_a, d_b; };
__device__ __forceinline__ int moe_extra_blocks(int nu, int G) { const int maxb = (nu + G - 1) / G; int nb = nu - (maxb - 1) * G; if (nb >= G) nb = 0; nb = (nb + 7) & ~7; if (nb >= G) nb = 0; return nb; }
__device__ __forceinline__ MoePlan moe_plan(const unsigned char* rt, int G) {
    MoePlan P; P.nt0 = __builtin_amdgcn_readfirstlane(((const int*)(rt + RT_NTILES))[0]); P.nt1 = __builtin_amdgcn_readfirstlane(((const int*)(rt + RT_NTILES))[1]);
    const int ntm = P.nt0 > P.nt1 ? P.nt0 : P.nt1;
    const int cap_a = (int)((WS_MOEW - WS_Z) / ACT_TILE_B) - ntm, cap_b = (int)((WS_SSQ - WS_WIN) / ACT_TILE_B);
    int ns1 = P.nt1 - G / (DM / 256); if (ns1 < 0) ns1 = 0; if (ns1 > cap_a + cap_b) ns1 = cap_a + cap_b;
#ifdef MOE_NS_FIXED
    ns1 = MOE_NS_FIXED < P.nt1 ? MOE_NS_FIXED : P.nt1;
#endif
    P.ns1 = ns1; P.n_a = ns1 < cap_a ? ns1 : cap_a;
    P.d_a = (long)((size_t)ntm * ACT_TILE_B);
    P.d_b = (long)WS_WIN - (long)WS_Z - (long)((size_t)P.n_a * ACT_TILE_B);
    P.nb14 = moe_extra_blocks(P.nt0 * (DM / 256), G); P.nb15 = moe_extra_blocks(ns1 * (DM / 256), G);
    { const int nn = 2 * DFF / 256, nu = P.nt0 * nn, room = ((nu + G - 1) / G) * G - nu; int k = room / nn; if (k > ns1) k = ns1;
#ifdef MOE_NO_FILL
      k = 0;
#endif
      P.k0 = k; P.nb13 = moe_extra_blocks(nu, G); }
    return P;
}
__global__ void __launch_bounds__(NTHREADS, 2) mk_fwd(Params prm) {
    extern __shared__ __attribute__((aligned(16))) unsigned char lds_raw[];
    Frame F;
    F.lds = (LAS unsigned char*)lds_raw;
    F.blk = blockIdx.x; F.G = gridDim.x; F.out = prm.out; F.ws = prm.ws; F.wv = __builtin_amdgcn_readfirstlane(threadIdx.x >> 6);
    volatile LAS unsigned* MISC = (volatile LAS unsigned*)(F.lds + MISC_OFF);
    for (int u = threadIdx.x; u < (LDS_BYTES - LDSCTL_OFF) / 4; u += NTHREADS) ((LAS unsigned*)(F.lds + LDSCTL_OFF))[u] = 0u;
    __syncthreads();
    if (threadIdx.x == 0) { LAS unsigned long long* tab = (LAS unsigned long long*)(F.lds + PTAB_OFF);
#pragma unroll
        for (int i_ = 0; i_ < 33; ++i_) tab[i_] = (unsigned long long)prm.in[i_]; }
    __syncthreads();
    const int lo = prm.ph_lo, hi = prm.ph_hi;
    unsigned* ctl = (unsigned*)(F.ws + WS_CTL);
    XcdBarrier bar; bar.bar = ctl + CW_BAR; bar.x = 0; bar.st = nullptr;
    if (hi - lo > 1) bar = xcd_barrier_post(ctl + CW_BAR, MISC + 8);
    unsigned char* ws = F.ws;
    bf16* hb = (bf16*)(ws + WS_HB); bf16* z = (bf16*)(ws + WS_Z); bf16* act = (bf16*)(ws + WS_Z); bf16* y = (bf16*)(ws + WS_Y); bf16* asort = (bf16*)(ws + WS_Y);
    float* ssq = (float*)(ws + WS_SSQ);
    bf16* opart = (bf16*)F.out; float* lse = (float*)((unsigned char*)F.out + 48 * MiB);
    unsigned char* rt = ws + WS_RT;
#define IN(k) (lo <= (k) && (k) < hi)
#ifndef PROBE_MASK
#define PROBE_MASK 0
#endif
#if PROBE_MASK
#define STAMP(k) do { if (blockIdx.x == 0 && threadIdx.x == 0) ((volatile LAS unsigned long long*)(F.lds + LDSCTL_OFF + 2048))[k] = __builtin_amdgcn_s_memrealtime(); } while (0)
#else
#define STAMP(k) do { } while (0)
#endif
#define SEAM(k) do { if (IN(k) && IN((k) + 1)) xcd_barrier(bar); STAMP((k) + 1); } while (0)

    STAMP(0);
    if (IN(0)) p0_prologue(F, 0);
    SEAM(0);
#pragma unroll 1
    for (int layer = 0; layer < 2; ++layer) {
        const int pb = layer == 0 ? 1 : 7;
        if (IN(pb)) {
            pg8::Gemm g{hb, (const bf16*)(ws + WS_WIN) + (size_t)layer * NPADW * DM, NTOK, NPADW, DM, F.wv}; pg8::StaticOrder S; S.init(NTOK / 256, NPADW / 256, F.G, F.blk);
            pg8::EpiZ E{z, INW, INW, ssq};
            pg8::gemm_phase<pg8::EpiZ, pg8::StaticOrder, true, true>(F.lds, g, S, E);
        }
        SEAM(pb);
#if defined(PROBE_SUB)
        const unsigned long long tsub0 = __builtin_amdgcn_s_memrealtime();
#define PSUB(cls, t0) do { if (threadIdx.x == 0) ((unsigned long long*)(F.ws + 32768))[layer * 4 + (cls)] = __builtin_amdgcn_s_memrealtime() - (t0); } while (0)
#else
#define PSUB(cls, t0) do { } while (0)
#endif
        unsigned char* recs = ws + WS_MOEW;
        unsigned char* gcon = ws + WS_MOEW + (size_t)NB * 4 * (SEQ / 16) * RC_STRIDE;
        const GlaAux gax{ws + WS_GLAQT, ws + WS_GLAKB};
        if (IN(pb + 1)) {
            const int wi = F.blk, nw = F.G;
#ifdef GLA0_WG
            gla_items<0>(F, z, gcon, (float*)(ws + WS_GLAEC), gax, y, inptr(F, IN_GG2) + layer * 16 * 128, inptr(F, IN_GGB) + layer * 128, inptr(F, IN_GNG) + layer * 64, wi, nw, 0);
#else
            BAR(); gla0_wave_items(F, z, gcon, (float*)(ws + WS_GLAEC), gax, inptr(F, IN_GG2) + layer * 16 * 128, inptr(F, IN_GGB) + layer * 128); BAR();
#endif
            STAMP(20 + layer * 5);
            { const RwkvP RP{inptr(F, IN_MU) + layer * 896, inptr(F, IN_W0) + layer * 256, inptr(F, IN_W2) + layer * 32 * 256, inptr(F, IN_A0) + layer * 256, inptr(F, IN_A2) + layer * 32 * 256, inptr(F, IN_G2) + layer * 64 * 256,
                             inptr(F, IN_KK) + layer * 256, inptr(F, IN_KA) + layer * 256, inptr(F, IN_RK) + layer * 256, inptr(F, IN_RLG) + layer * 256, inptr(F, IN_RLB) + layer * 256};
                const int tid_ = mytid(F), lane_ = tid_ & 63, w_ = __builtin_amdgcn_readfirstlane(tid_ >> 6);
#pragma unroll 1
                for (int h = 0; h < 4; ++h) {
                    rwkv_prep_init(F, RP, h); BAR();
                    u32x4 cur[2], prv[2], ncur[2], nprv[2];
#pragma unroll
                    for (int q = 0; q < 2; ++q) { cur[q] = (u32x4){0u, 0u, 0u, 0u}; prv[q] = cur[q]; ncur[q] = cur[q]; nprv[q] = cur[q]; }
                    if (wi < 2048) rwkv_prep_load(z, wi >> 8, h, wi & 255, w_, lane_, cur, prv);
                    asm volatile("" : "+v"(cur[0]), "+v"(cur[1]), "+v"(prv[0]), "+v"(prv[1]));
#pragma unroll 1
                    for (int it = wi; it < 2048; it += nw) { const int nx = it + nw;
                        if (nx < 2048) rwkv_prep_load(z, nx >> 8, h, nx & 255, w_, lane_, ncur, nprv);
                        rwkv_prep_item(F, recs + (size_t)(((it >> 8) * 4 + h) * 256 + (it & 255)) * RC_STRIDE, RP, h, cur, prv, ncur, nprv);
#pragma unroll
                        for (int q = 0; q < 2; ++q) { cur[q] = ncur[q]; prv[q] = nprv[q]; } }
                    BAR(); } }
#if defined(PROBE_SUB)
            if (F.blk == 0) PSUB(2, tsub0);
#endif
            STAMP(21 + layer * 5);
            attn_qknorm(F, z, inptr(F, IN_QG) + layer * 64, inptr(F, IN_KG) + layer * 64);
            STAMP(22 + layer * 5);
#if defined(PROBE_SUB)
            if (F.blk == 0) PSUB(1, tsub0);
#endif
            for (int item = wi; item < 512; item += nw) conv_item(F, z, y, inptr(F, IN_CW) + layer * 31 * 256, inptr(F, IN_CB) + layer * 256, inptr(F, IN_CLG) + layer * 256, inptr(F, IN_CLB) + layer * 256, item);
#if defined(PROBE_SUB)
            if (F.blk == 0) PSUB(3, tsub0);
#endif
            STAMP(23 + layer * 5);
        }
        if (IN(pb + 1)) STAMP(24 + layer * 5);
        SEAM(pb + 1);
        if (IN(pb + 2)) {
            unsigned* cA = ctl + 12288 + layer * 128;
            unsigned* cB = ctl + 12288 + layer * 128 + 64;
            if (F.blk < 32) {
                const RwkvP RP{inptr(F, IN_MU) + layer * 896, inptr(F, IN_W0) + layer * 256, inptr(F, IN_W2) + layer * 32 * 256, inptr(F, IN_A0) + layer * 256, inptr(F, IN_A2) + layer * 32 * 256, inptr(F, IN_G2) + layer * 64 * 256,
                               inptr(F, IN_KK) + layer * 256, inptr(F, IN_KA) + layer * 256, inptr(F, IN_RK) + layer * 256, inptr(F, IN_RLG) + layer * 256, inptr(F, IN_RLB) + layer * 256};
                rwkv_state(F, recs, y, RP, F.blk >> 2, F.blk & 3);
                STAMP(30 + layer);
            } else {
                const int wi = F.blk - 32, nw = F.G - 32;
#if defined(PROBE_M2)
                const unsigned long long tm2_ = __builtin_amdgcn_s_memrealtime();
#endif
                if (F.blk < 64) { gla_scan(F, gcon, (const float*)(ws + WS_GLAEC), (F.blk - 32) >> 2, (F.blk - 32) & 3); mk_publish(cA); }
                { const int full = 3072 / nw, rem = 3072 - full * nw;
                    const int wx = (nw & 7) == 0 ? (wi & 7) * (nw >> 3) + (wi >> 3) : wi;
                    for (int rd = 0; rd < full; ++rd) attn_tile(F.lds, z, opart, lse, inptr(F, IN_RELB), rd * nw + wx, mytid(F));
                    if (wi >= 32 && wi - 32 < rem) attn_tile(F.lds, z, opart, lse, inptr(F, IN_RELB), full * nw + wi - 32, mytid(F)); }
                mk_publish(cB);
                mk_wait(cA, 32u);
                gla_items<1>(F, z, gcon, (float*)(ws + WS_GLAEC), gax, y, inptr(F, IN_GG2) + layer * 16 * 128, inptr(F, IN_GGB) + layer * 128, inptr(F, IN_GNG) + layer * 64, wi, nw, 32);
                mk_wait(cB, (unsigned)nw);
                attn_merge(F, opart, lse, y, wi, nw);
#if defined(PROBE_M2)
                if (F.blk == PROBE_M2 && threadIdx.x == 0) ((volatile unsigned long long*)(F.ws + 32768))[40 + layer] = __builtin_amdgcn_s_memrealtime() - tm2_;
#endif
            }
        }
        SEAM(pb + 2);
        if (IN(pb + 3)) {
            pg8::Gemm g{y, (const bf16*)(ws + WS_WOUT) + (size_t)layer * DM * DM, NTOK, DM, DM, F.wv}; pg8::StaticOrder S; S.init(NTOK / 256, DM / 256, F.G, F.blk);
            pg8::EpiRes E{(const float*)nullptr, hb, (float*)nullptr, hb, ssq};
            if (layer == 1 && (F.blk & 1)) { p0_prologue(F, 1); __syncthreads(); }
            pg8::gemm_phase<pg8::EpiRes, pg8::StaticOrder, true, true>(F.lds, g, S, E);
            if (layer == 1 && !(F.blk & 1)) { __syncthreads(); p0_prologue(F, 1); }
        }
        SEAM(pb + 3);
        if (layer == 0) {
            if (IN(5)) {
                pg8::Gemm g{hb, (const bf16*)(ws + WS_WGU), NTOK, 2 * DFF, DM, F.wv}; pg8::StaticOrder S; S.init(NTOK / 256, 2 * DFF / 256, F.G, F.blk);
                pg8::EpiSwiGLU<false> E{act, ssq, nullptr, 0, 0, 0L, 0L};
                pg8::gemm_phase<pg8::EpiSwiGLU<false>, pg8::StaticOrder, true, true>(F.lds, g, S, E);
            }
            SEAM(5);
            if (IN(6)) {
                pg8::Gemm g{act, (const bf16*)(ws + WS_WD), NTOK, DM, DFF, F.wv}; pg8::StaticOrder S; S.init(NTOK / 256, DM / 256, F.G, F.blk);
                pg8::EpiRes E{nullptr, hb, nullptr, hb, ssq};
                pg8::gemm_phase<pg8::EpiRes, pg8::StaticOrder, true, true>(F.lds, g, S, E);
            }
            SEAM(6);
        }
    }
    if (IN(11)) moe_route(F, hb, inptr(F, IN_FFNG) + DM, inptr(F, IN_ROUTER));
    SEAM(11);
    if (IN(12)) { moe_gather(F, 0, hb, asort); moe_gather(F, 1, hb, asort); }
    SEAM(12);
    const int* tile0 = (const int*)(rt + RT_TILEE); const int* tile1 = tile0 + 256;
    const int* rtok0 = (const int*)(rt + RT_ROWTOK); const int* rtok1 = rtok0 + MOE_ROWS;
    const float* rgate0 = (const float*)(rt + RT_ROWGATE); const float* rgate1 = rgate0 + MOE_ROWS;
    const float* rrs0 = (const float*)(rt + RT_ROWRSTD); const float* rrs1 = rrs0 + MOE_ROWS;
    const bf16* wgu = (const bf16*)(ws + WS_MOEW); const bf16* wdn = (const bf16*)(ws + WS_MOEW + MOEW_GU_BYTES);
    if (IN(13)) {
        const MoePlan P = moe_plan(rt, F.G);
        pg8::Gemm g{hb, wgu, P.nt0 * 256, 2 * DFF, DM, F.wv}; pg8::StaticOrder S; S.init(P.nt0, 2 * DFF / 256, F.G, F.blk, tile0, MOEW_E_BYTES);
        pg8::EpiSwiGLU<true> E{act, nullptr, rrs0, 0, 0, 0L, 0L};
        pg8::gemm_phase_g<pg8::EpiSwiGLU<true>, pg8::StaticOrder, true, true>(F.lds, g, S, E, rtok0);
        if (P.k0 > 0) {
            __syncthreads();
            pg8::Gemm g1{hb, wgu, P.nt1 * 256, 2 * DFF, DM, F.wv}; pg8::StaticOrder S1; S1.init(P.k0, 2 * DFF / 256, F.G, F.blk, tile1, MOEW_E_BYTES, 0, P.nb13, 1);
            pg8::EpiSwiGLU<true> E1{act, nullptr, rrs1, P.n_a, P.ns1, P.d_a, P.d_b};
            pg8::gemm_phase_g<pg8::EpiSwiGLU<true>, pg8::StaticOrder, true, true>(F.lds, g1, S1, E1, rtok1);
        }
    }
    SEAM(13);
    if (IN(14)) {
        const MoePlan P = moe_plan(rt, F.G);
#pragma unroll 1
        for (int part = 0; part < 2; ++part) {
            if ((part ^ (F.blk & MOE_SWAP)) == 0) {
                pg8::Gemm g{act, wdn, P.nt0 * 256, DM, DFF, F.wv}; pg8::StaticOrder S; S.init(P.nt0, DM / 256, F.G, F.blk, tile0, MOEW_E_BYTES); S.rev = MOE_REV;
                pg8::EpiMoeDown E{F.out, (const bf16*)hb, rtok0, rgate0, (float*)(ws + WS_SSQ)};
                pg8::gemm_phase<pg8::EpiMoeDown, pg8::StaticOrder, true, true>(F.lds, g, S, E);
            } else {
                pg8::Gemm g{hb, wgu, P.nt1 * 256, 2 * DFF, DM, F.wv}; pg8::StaticOrder S; S.init(P.ns1 - P.k0, 2 * DFF / 256, F.G, F.blk, tile1, MOEW_E_BYTES, P.k0, P.nb14, MOE_R0);
                pg8::EpiSwiGLU<true> E{act, nullptr, rrs1, P.n_a, P.ns1, P.d_a, P.d_b};
                pg8::gemm_phase_g<pg8::EpiSwiGLU<true>, pg8::StaticOrder, true, true>(F.lds, g, S, E, rtok1);
            }
            __syncthreads();
        }
    }
    SEAM(14);
    if (IN(15)) {
        const MoePlan P = moe_plan(rt, F.G);
#pragma unroll 1
        for (int part = 0; part < 2; ++part) {
            if ((part ^ (F.blk & MOE_SWAP)) == 0) {
                pg8::Gemm g{act, wdn, P.nt1 * 256, DM, DFF, F.wv}; pg8::StaticOrder S; S.init(P.ns1, DM / 256, F.G, F.blk, tile1, MOEW_E_BYTES); S.asplit(P.n_a, P.d_a, P.ns1, P.d_b);
                pg8::EpiMoeDown E{F.out, (const bf16*)nullptr, rtok1, rgate1, (float*)(ws + WS_SSQ)};
                pg8::gemm_phase<pg8::EpiMoeDown, pg8::StaticOrder, true, true>(F.lds, g, S, E);
            } else {
                pg8::Gemm g{hb, wgu, P.nt1 * 256, 2 * DFF, DM, F.wv}; pg8::StaticOrder S; S.init(P.nt1 - P.ns1, 2 * DFF / 256, F.G, F.blk, tile1, MOEW_E_BYTES, P.ns1, P.nb15, MOE_R0);
                pg8::EpiSwiGLU<true> E{act, nullptr, rrs1, 0, 0, 0L, 0L};
                pg8::gemm_phase_g<pg8::EpiSwiGLU<true>, pg8::StaticOrder, true, true>(F.lds, g, S, E, rtok1);
            }
            __syncthreads();
        }
    }
    SEAM(15);
    if (IN(16)) {
        const MoePlan P = moe_plan(rt, F.G);
        pg8::Gemm g{act, wdn, P.nt1 * 256, DM, DFF, F.wv}; pg8::StaticOrder S; S.init(P.nt1 - P.ns1, DM / 256, F.G, F.blk, tile1, MOEW_E_BYTES, P.ns1);
        pg8::EpiMoeDown E{F.out, (const bf16*)nullptr, rtok1, rgate1, (float*)(ws + WS_SSQ)};
        pg8::gemm_phase<pg8::EpiMoeDown, pg8::StaticOrder, true, true>(F.lds, g, S, E);
    }
#if PROBE_MASK
    __syncthreads();
    if (blockIdx.x == 0 && threadIdx.x == 0) { STAMP(N_PHASES); volatile LAS unsigned long long* ts = (volatile LAS unsigned long long*)(F.lds + LDSCTL_OFF + 2048); unsigned long long tot = 0;
        for (int k = 0; k < N_PHASES; ++k) if ((PROBE_MASK >> k) & 1) tot += ts[k + 1] - ts[k];
#if defined(PROBE_NT)
        tot = (unsigned long long)(((const int*)(rt + RT_NTILES))[0] - 128) * 1000ull + (unsigned long long)(((const int*)(rt + RT_NTILES))[1] - 128) * 10000ull;
#endif
#if defined(PROBE_M2)
        tot = (PROBE_M2 == 1) ? (ts[30] - ts[3]) + (ts[31] - ts[9]) : ((volatile unsigned long long*)(F.ws + 32768))[40] + ((volatile unsigned long long*)(F.ws + 32768))[41];
#endif
#if defined(PROBE_M1)
        tot = (ts[20 + PROBE_M1 + 1] - ts[20 + PROBE_M1]) + (ts[25 + PROBE_M1 + 1] - ts[25 + PROBE_M1]);
#endif
#if defined(PROBE_SUB)
        tot = (PROBE_SUB == 0) ? ((volatile unsigned long long*)(F.ws + 32768))[0] : ((volatile unsigned long long*)(F.ws + 32768))[PROBE_SUB] + ((volatile unsigned long long*)(F.ws + 32768))[4 + PROBE_SUB];
#endif
        const unsigned long long t0 = __builtin_amdgcn_s_memrealtime(); while (__builtin_amdgcn_s_memrealtime() - t0 < tot) __builtin_amdgcn_s_sleep(8); }
#endif
#undef IN
#undef SEAM
}

extern "C" void kernel_launch(void* const* d_in, const int* in_sizes, int n_in, void* d_out, int out_size, void* d_ws, size_t ws_size, hipStream_t stream) {
    static int grid = 0;
    if (grid == 0) {
        if (n_in != 33 || out_size != NTOK * DM || ws_size < WS_TOTAL) { fprintf(stderr, "kernel_launch: unexpected problem (n_in %d out %d ws %zu)\n", n_in, out_size, ws_size); grid = -1; return; }
        int dev = 0, cus = 0;
        if (hipGetDevice(&dev) != hipSuccess || hipDeviceGetAttribute(&cus, hipDeviceAttributeMultiprocessorCount, dev) != hipSuccess) { grid = -1; return; }
        if (hipFuncSetAttribute((const void*)mk_fwd, hipFuncAttributeMaxDynamicSharedMemorySize, LDS_BYTES) != hipSuccess) { fprintf(stderr, "kernel_launch: hipFuncSetAttribute failed\n"); grid = -1; return; }
        (void)hipGetLastError();
        int per_cu = 0;
        if (hipOccupancyMaxActiveBlocksPerMultiprocessor(&per_cu, (const void*)mk_fwd, NTHREADS, LDS_BYTES) != hipSuccess || per_cu < 1) { fprintf(stderr, "kernel_launch: occupancy query failed (%d)\n", per_cu); (void)hipGetLastError(); grid = -1; return; }
        grid = cus < 256 ? cus : 256;
        if (grid != 256) fprintf(stderr, "kernel_launch: %d CUs (built for 256)\n", cus);
    }
    if (grid < 0) return;
    (void)hipMemsetAsync((char*)d_ws + WS_CTL, 0, CTL_ZERO_BYTES, stream);
    Params p{};
    for (int i = 0; i < 33; ++i) p.in[i] = (const float*)d_in[i];
    p.out = (float*)d_out; p.ws = (unsigned char*)d_ws;
#if MK_PER_PHASE
    for (int k = 0; k < N_PHASES; ++k) { p.ph_lo = k; p.ph_hi = k + 1; hipLaunchKernelGGL(mk_fwd, dim3(grid), dim3(NTHREADS), LDS_BYTES, stream, p); }
#else
    p.ph_lo = 0; p.ph_hi = N_PHASES;
    hipLaunchKernelGGL(mk_fwd, dim3(grid), dim3(NTHREADS), LDS_BYTES, stream, p);
#endif
}
```
